# Optimizing an MI355X kernel written in HIP

```python
import jax, jax.numpy as jnp
from jax import lax
import numpy as np

D_MODEL = 1024
BATCH = 32
SEQ = 256
DEPTH = 2
DEC_BATCH = 2
DEC_SEQ = 2048
PAST_LEN = 512

GRID_W = 64
EPS = 1e-6
N_BRANCH = 3
D_RNN = 1024
LRU_HEADS = 8
LRU_BLOCK = D_RNN // LRU_HEADS
LRU_CONV_W = 4
LRU_C = 8.0
N_HEADS = 8
N_KV_HEADS = 2
KV_GROUPS = N_HEADS // N_KV_HEADS
HEAD_DIM = 128
D_ATTN = N_HEADS * HEAD_DIM
D_KV = N_KV_HEADS * HEAD_DIM
WINDOW = 128
BLOCK_Q = 128
ROPE_BASE = 10000.0
NEG_INF = -1e30
D_POOL = 1024
POOL_WINDOWS = (2, 4, 8, 16)
POOL_GROUP = D_POOL // len(POOL_WINDOWS)
D_IN = D_RNN + D_ATTN + 2 * D_KV + D_POOL + N_BRANCH * D_MODEL
D_FF = 2816
FFN_CONV_W = 3

kernel_name = 'hybrid_flow_prefix_trunk_step'


def rmsnorm(x, g):
    xf = x.astype(jnp.float32)
    xf = xf * lax.rsqrt(jnp.mean(xf * xf, axis=-1, keepdims=True) + EPS)
    return xf.astype(x.dtype) * g


def dwconv(x, w, b, pad_left):
    T = x.shape[1]
    width = w.shape[0]
    xp = jnp.pad(x, ((0, 0), (pad_left, width - 1 - pad_left), (0, 0)))
    y = xp[:, 0:T] * w[0]
    for k in range(1, width):
        y = y + xp[:, k:k + T] * w[k]
    return y + b


def linear_scan(a, b, h0):
    b = b.at[:, 0].add(a[:, 0] * h0)

    def combine(left, right):
        a_l, b_l = left
        a_r, b_r = right
        return a_l * a_r, a_r * b_l + b_r

    _, h = lax.associative_scan(combine, (a, b), axis=1)
    return h


def rglru_direction(x, wa, ba, wx, bx, lam, h0):
    B, T, _ = x.shape
    xb = x.reshape(B, T, LRU_HEADS, LRU_BLOCK)
    r = jax.nn.sigmoid(jnp.einsum('bthi,hij->bthj', xb, wa).reshape(B, T, D_RNN) + ba)
    i = jax.nn.sigmoid(jnp.einsum('bthi,hij->bthj', xb, wx).reshape(B, T, D_RNN) + bx)
    log_a = -LRU_C * r * jax.nn.softplus(-lam)
    a = jnp.exp(log_a)
    b = jnp.sqrt(-jnp.expm1(2.0 * log_a)) * (i * x)
    return linear_scan(a, b, h0)


def rglru_bidir(x, p, h0):
    xf = x.astype(jnp.float32)
    h0 = h0.astype(jnp.float32)
    hf = rglru_direction(xf, p['lru_wa'][0], p['lru_ba'][0], p['lru_wx'][0], p['lru_bx'][0],
                         p['lru_lambda'][0], h0[:, 0])
    hb = jnp.flip(rglru_direction(jnp.flip(xf, 1), p['lru_wa'][1], p['lru_ba'][1], p['lru_wx'][1],
                                  p['lru_bx'][1], p['lru_lambda'][1], h0[:, 1]), 1)
    final = jnp.stack([hf[:, -1], hb[:, 0]], axis=1)
    return (hf + hb).astype(x.dtype), final.astype(x.dtype)


def rope_half(x, pos):
    nf = x.shape[-1] // 2
    freqs = ROPE_BASE ** (-jnp.arange(nf, dtype=jnp.float32) / nf)
    ang = pos.astype(jnp.float32)[:, None] * freqs[None, :]
    cos = jnp.cos(ang)[None, :, None, :]
    sin = jnp.sin(ang)[None, :, None, :]
    xf = x.astype(jnp.float32)
    x1, x2 = xf[..., :nf], xf[..., nf:]
    return jnp.concatenate([x1 * cos - x2 * sin, x1 * sin + x2 * cos], axis=-1)


def axial_rope(x):
    T = x.shape[1]
    rows = T // GRID_W
    row, col = jnp.meshgrid(jnp.arange(rows), jnp.arange(GRID_W), indexing='ij')
    half = x.shape[-1] // 2
    out = jnp.concatenate([rope_half(x[..., :half], row.reshape(-1)),
                           rope_half(x[..., half:], col.reshape(-1))], axis=-1)
    return out.astype(x.dtype)


def sink_logits(sink, B):
    return jnp.broadcast_to(sink.astype(jnp.float32).reshape(1, N_KV_HEADS, KV_GROUPS, 1, 1),
                            (B, N_KV_HEADS, KV_GROUPS, BLOCK_Q, 1))


def attn_context(q, k, v, sink):
    B, S = q.shape[:2]
    scale = HEAD_DIM ** -0.5
    sink_b = sink_logits(sink, B)

    def block(j):
        qj = lax.dynamic_slice_in_dim(q, j * BLOCK_Q, BLOCK_Q, axis=1)
        qj = qj.reshape(B, BLOCK_Q, N_KV_HEADS, KV_GROUPS, HEAD_DIM)
        s = jnp.einsum('bqkgd,bckd->bkgqc', qj, k).astype(jnp.float32) * scale
        pr = jax.nn.softmax(jnp.concatenate([s, sink_b], axis=-1), axis=-1)[..., :S]
        o = jnp.einsum('bkgqc,bckd->bqkgd', pr.astype(v.dtype), v)
        return o.reshape(B, BLOCK_Q, D_ATTN)

    out = lax.map(block, jnp.arange(S // BLOCK_Q))
    return jnp.transpose(out, (1, 0, 2, 3)).reshape(B, S, D_ATTN)


def attn_latent(q, k, v, kc, vc, sink):
    B, T = q.shape[:2]
    Lc = kc.shape[1]
    span = BLOCK_Q + 2 * WINDOW
    scale = HEAD_DIM ** -0.5
    kp = jnp.pad(k, ((0, 0), (WINDOW, WINDOW), (0, 0), (0, 0)))
    vp = jnp.pad(v, ((0, 0), (WINDOW, WINDOW), (0, 0), (0, 0)))
    sink_b = sink_logits(sink, B)

    def block(j):
        start = j * BLOCK_Q
        qj = lax.dynamic_slice_in_dim(q, start, BLOCK_Q, axis=1)
        qj = qj.reshape(B, BLOCK_Q, N_KV_HEADS, KV_GROUPS, HEAD_DIM)
        kj = lax.dynamic_slice_in_dim(kp, start, span, axis=1)
        vj = lax.dynamic_slice_in_dim(vp, start, span, axis=1)
        qpos = start + jnp.arange(BLOCK_Q)
        kpos = start - WINDOW + jnp.arange(span)
        valid = ((jnp.abs(qpos[:, None] - kpos[None, :]) <= WINDOW)
                 & (kpos >= 0)[None, :] & (kpos < T)[None, :])
        s_w = jnp.einsum('bqkgd,bwkd->bkgqw', qj, kj).astype(jnp.float32) * scale
        s_w = jnp.where(valid, s_w, NEG_INF)
        s_c = jnp.einsum('bqkgd,bckd->bkgqc', qj, kc).astype(jnp.float32) * scale
        pr = jax.nn.softmax(jnp.concatenate([s_w, s_c, sink_b], axis=-1), axis=-1)
        o = (jnp.einsum('bkgqw,bwkd->bqkgd', pr[..., :span].astype(vj.dtype), vj)
             + jnp.einsum('bkgqc,bckd->bqkgd', pr[..., span:span + Lc].astype(vc.dtype), vc))
        return o.reshape(B, BLOCK_Q, D_ATTN)

    out = lax.map(block, jnp.arange(T // BLOCK_Q))
    return jnp.transpose(out, (1, 0, 2, 3)).reshape(B, T, D_ATTN)


def multiscale_pool(x, w, scale):
    B, T, _ = x.shape
    xf = x.astype(jnp.float32)
    csum = jnp.concatenate([jnp.zeros((B, 1, D_POOL), jnp.float32), jnp.cumsum(xf, axis=1)], axis=1)
    t = jnp.arange(T)
    parts = []
    for gi, win in enumerate(POOL_WINDOWS):
        c0, c1 = gi * POOL_GROUP, (gi + 1) * POOL_GROUP
        lo = jnp.clip(t - win // 2, 0, T)
        hi = jnp.clip(t + win // 2, 0, T)
        cnt = (hi - lo).astype(jnp.float32)[None, :, None]
        mean = (csum[:, hi, c0:c1] - csum[:, lo, c0:c1]) / cnt
        parts.append(mean - xf[..., c0:c1])
    pooled = jnp.stack(parts, axis=2).astype(x.dtype)
    y = jnp.einsum('btgi,gij->btgj', pooled, w).reshape(B, T, D_POOL)
    return y * scale


def trunk_layer(x, mod, p, ctx_k, ctx_v, ctx_h):
    latent = ctx_k is not None
    B, T, _ = x.shape
    shift1, scale1, gate1, shift2, scale2, gate2 = jnp.split(mod, 6, axis=-1)
    h = rmsnorm(x, p['norm1']) * (1.0 + scale1) + shift1
    proj = h @ p['w_in']
    s0 = D_RNN
    s1 = s0 + D_ATTN
    s2 = s1 + D_KV
    s3 = s2 + D_KV
    s4 = s3 + D_POOL
    xa, q, k, v, xc, g = (proj[..., :s0], proj[..., s0:s1], proj[..., s1:s2],
                          proj[..., s2:s3], proj[..., s3:s4], proj[..., s4:])
    xa = dwconv(xa, p['lru_conv'], p['lru_conv_b'], LRU_CONV_W // 2)
    h0 = ctx_h if latent else jnp.zeros((B, 2, D_RNN), x.dtype)
    ya, h_final = rglru_bidir(xa, p, h0)
    q = q.reshape(B, T, N_HEADS, HEAD_DIM)
    k = k.reshape(B, T, N_KV_HEADS, HEAD_DIM)
    v = v.reshape(B, T, N_KV_HEADS, HEAD_DIM)
    if latent:
        yb = attn_latent(axial_rope(q), axial_rope(k), v, ctx_k, ctx_v, p['attn_sink'])
    else:
        yb = attn_context(q, k, v, p['attn_sink'])
    yc = multiscale_pool(xc, p['pool_w'], p['pool_scale'])
    gates = jax.nn.sigmoid(g + p['b_gate']).reshape(B, T, N_BRANCH, D_MODEL)
    merged = (gates[:, :, 0] * (ya @ p['w_branch'][0])
              + gates[:, :, 1] * (yb @ p['w_branch'][1])
              + gates[:, :, 2] * (yc @ p['w_branch'][2]))
    x = x + gate1 * (merged @ p['w_out'])
    h2 = rmsnorm(x, p['norm2']) * (1.0 + scale2) + shift2
    up = h2 @ p['ffn_up']
    gff = dwconv(up[..., :D_FF], p['ffn_conv'], p['ffn_conv_b'], FFN_CONV_W // 2)
    x = x + gate2 * ((jax.nn.gelu(gff) * up[..., D_FF:]) @ p['ffn_down'])
    return x, k, v, h_final


def setup_inputs(seed: int = 0) -> dict:
    key = jax.random.key(seed)
    ks = iter(jax.random.split(key, 32))

    def nrm(shape, s):
        return jax.random.normal(next(ks), shape, jnp.float32) * s

    u = jax.random.uniform(next(ks), (DEPTH, 2, D_RNN), jnp.float32, minval=0.9, maxval=0.999)
    a0 = u ** (1.0 / LRU_C)
    lru_lambda = jnp.log(a0) - jnp.log1p(-a0)
    return {
        'x_prompt': nrm((BATCH, SEQ, D_MODEL), 1.0),
        'x_sample': nrm((DEC_BATCH, DEC_SEQ, D_MODEL), 1.0),
        'cache_k': nrm((DEC_BATCH, DEPTH, PAST_LEN, N_KV_HEADS, HEAD_DIM), 1.0),
        'cache_v': nrm((DEC_BATCH, DEPTH, PAST_LEN, N_KV_HEADS, HEAD_DIM), 1.0),
        'state_lru': nrm((DEC_BATCH, DEPTH, 2, D_RNN), 0.5),
        'c': nrm((DEC_BATCH, D_MODEL), 1.0),
        'c_ctx': nrm((D_MODEL,), 1.0),
        'w_ada': nrm((DEPTH, D_MODEL, 6 * D_MODEL), 0.5 * D_MODEL ** -0.5),
        'b_ada': nrm((DEPTH, 6 * D_MODEL), 0.02),
        'norm1': 1.0 + nrm((DEPTH, D_MODEL), 0.05),
        'norm2': 1.0 + nrm((DEPTH, D_MODEL), 0.05),
        'w_in': nrm((DEPTH, D_MODEL, D_IN), D_MODEL ** -0.5),
        'b_gate': nrm((DEPTH, N_BRANCH * D_MODEL), 0.1),
        'lru_conv': nrm((DEPTH, LRU_CONV_W, D_RNN), LRU_CONV_W ** -0.5),
        'lru_conv_b': nrm((DEPTH, D_RNN), 0.02),
        'lru_wa': nrm((DEPTH, 2, LRU_HEADS, LRU_BLOCK, LRU_BLOCK), LRU_BLOCK ** -0.5),
        'lru_ba': nrm((DEPTH, 2, D_RNN), 0.1),
        'lru_wx': nrm((DEPTH, 2, LRU_HEADS, LRU_BLOCK, LRU_BLOCK), LRU_BLOCK ** -0.5),
        'lru_bx': nrm((DEPTH, 2, D_RNN), 0.1),
        'lru_lambda': lru_lambda,
        'attn_sink': nrm((DEPTH, N_HEADS), 0.5),
        'pool_w': nrm((DEPTH, len(POOL_WINDOWS), POOL_GROUP, POOL_GROUP), POOL_GROUP ** -0.5),
        'pool_scale': 1.0 + nrm((DEPTH, D_POOL), 0.05),
        'w_branch': nrm((DEPTH, N_BRANCH, D_MODEL, D_MODEL), D_MODEL ** -0.5),
        'w_out': nrm((DEPTH, D_MODEL, D_MODEL), D_MODEL ** -0.5),
        'ffn_up': nrm((DEPTH, D_MODEL, 2 * D_FF), D_MODEL ** -0.5),
        'ffn_conv': nrm((DEPTH, FFN_CONV_W, D_FF), FFN_CONV_W ** -0.5),
        'ffn_conv_b': nrm((DEPTH, D_FF), 0.02),
        'ffn_down': nrm((DEPTH, D_FF, D_MODEL), D_FF ** -0.5),
        'final_norm': 1.0 + nrm((D_MODEL,), 0.05),
    }


def reference(x_prompt, x_sample, cache_k, cache_v, state_lru, c, c_ctx, w_ada, b_ada, norm1, norm2,
              w_in, b_gate, lru_conv, lru_conv_b, lru_wa, lru_ba, lru_wx, lru_bx, lru_lambda, attn_sink,
              pool_w, pool_scale, w_branch, w_out, ffn_up, ffn_conv, ffn_conv_b, ffn_down, final_norm):
    xp = x_prompt
    xs = x_sample
    ks, vs, hs = [], [], []
    for l in range(DEPTH):
        p = {
            'norm1': norm1[l], 'norm2': norm2[l], 'w_in': w_in[l], 'b_gate': b_gate[l],
            'lru_conv': lru_conv[l], 'lru_conv_b': lru_conv_b[l], 'lru_wa': lru_wa[l], 'lru_ba': lru_ba[l],
            'lru_wx': lru_wx[l], 'lru_bx': lru_bx[l], 'lru_lambda': lru_lambda[l], 'attn_sink': attn_sink[l],
            'pool_w': pool_w[l], 'pool_scale': pool_scale[l], 'w_branch': w_branch[l], 'w_out': w_out[l],
            'ffn_up': ffn_up[l], 'ffn_conv': ffn_conv[l], 'ffn_conv_b': ffn_conv_b[l], 'ffn_down': ffn_down[l],
        }
        mod_ctx = jax.nn.silu(c_ctx) @ w_ada[l] + b_ada[l]
        mod_lat = (jax.nn.silu(c) @ w_ada[l] + b_ada[l])[:, None, :]
        xp, k_l, v_l, h_l = trunk_layer(xp, mod_ctx, p, None, None, None)
        xs, _, _, _ = trunk_layer(xs, mod_lat, p, cache_k[:, l], cache_v[:, l], state_lru[:, l])
        ks.append(k_l)
        vs.append(v_l)
        hs.append(h_l)
    y_prompt = rmsnorm(xp, final_norm)
    y_sample = rmsnorm(xs, final_norm)
    new_cache_k = jnp.stack(ks, axis=1)
    new_cache_v = jnp.stack(vs, axis=1)
    new_state_lru = jnp.stack(hs, axis=1)
    return (y_prompt, y_sample, new_cache_k, new_cache_v, new_state_lru)
```

```cpp
#include <hip/hip_runtime.h>
#include <hip/hip_cooperative_groups.h>
#include <cstdio>
namespace cg = cooperative_groups;

#define LAS __attribute__((address_space(3)))
typedef unsigned short bf16_t;
typedef short bf16x8 __attribute__((ext_vector_type(8)));
typedef float f32x4 __attribute__((ext_vector_type(4)));
typedef unsigned u32x4 __attribute__((ext_vector_type(4)));
typedef unsigned u32x2 __attribute__((ext_vector_type(2)));
typedef short bf16x4 __attribute__((ext_vector_type(4)));

constexpr int MROWS = 12288, MCTX = 8192;
constexpr size_t S24 = (size_t)MROWS * 1024 * 2;
constexpr size_t OFF_WIN = 0;
constexpr size_t OFF_WBR = OFF_WIN + (size_t)6656 * 1024 * 2;
constexpr size_t OFF_WOUT = OFF_WBR + (size_t)3 * 1024 * 1024 * 2;
constexpr size_t OFF_WUP = OFF_WOUT + (size_t)1024 * 1024 * 2;
constexpr size_t OFF_WDN = OFF_WUP + (size_t)5632 * 1024 * 2;
constexpr size_t OFF_GW = OFF_WDN + (size_t)1024 * 2816 * 2;
constexpr size_t OFF_PW = OFF_GW + (size_t)2 * 8 * 256 * 128 * 2;
constexpr size_t OFF_MOD = OFF_PW + (size_t)4 * 256 * 256 * 2;
constexpr size_t OFF_CK = OFF_MOD + (size_t)2 * 3 * 6144 * 4;
constexpr size_t OFF_CV = OFF_CK + (size_t)2 * 2 * 512 * 256 * 2;
constexpr size_t OFF_ROPE = OFF_CV + (size_t)2 * 2 * 512 * 256 * 2;
constexpr size_t OFF_SUMM = OFF_ROPE + (size_t)2 * 64 * 32 * 4;
constexpr size_t OFF_ACT0 = OFF_SUMM + (size_t)2 * 2 * 8 * 1024 * 2 * 4;
constexpr size_t OFF_XAQ = OFF_ACT0;
constexpr size_t OFF_XC = OFF_XAQ + 2 * S24;
constexpr size_t OFF_KB = OFF_XC + S24;
constexpr size_t OFF_VB = OFF_KB + (size_t)MROWS * 256 * 2;
constexpr size_t OFF_GT = OFF_VB + (size_t)MROWS * 256 * 2;
constexpr size_t OFF_YB = OFF_GT + S24;
constexpr size_t OFF_PL = OFF_YB + S24;
constexpr size_t OFF_YA = OFF_PL + S24;
constexpr size_t OFF_H = OFF_YA + S24;
constexpr size_t OFF_END = OFF_H + S24;
constexpr size_t OFF_U = OFF_XAQ;
constexpr size_t OFF_ACT = OFF_PL;
constexpr size_t OUT_K = (size_t)MROWS * 1024;
constexpr size_t OUT_V = OUT_K + (size_t)32 * 2 * 256 * 256;
constexpr size_t OUT_H = OUT_V + (size_t)32 * 2 * 256 * 256;

struct Params {
    const float *x_prompt, *x_sample, *cache_k, *cache_v, *state_lru, *c, *c_ctx, *w_ada, *b_ada, *norm1, *norm2,
        *w_in, *b_gate, *lru_conv, *lru_conv_b, *lru_wa, *lru_ba, *lru_wx, *lru_bx, *lru_lambda, *attn_sink,
        *pool_w, *pool_scale, *w_branch, *w_out, *ffn_up, *ffn_conv, *ffn_conv_b, *ffn_down, *final_norm;
    float* out; unsigned char* ws;
};

__device__ __forceinline__ unsigned short f2bf(float f) { unsigned u = __float_as_uint(f); u += 0x7FFFu + ((u >> 16) & 1u); return (unsigned short)(u >> 16); }
__device__ __forceinline__ float bf2f(unsigned short b) { return __uint_as_float(((unsigned)b) << 16); }
__device__ __forceinline__ unsigned pack2(float a, float b) { return (unsigned)f2bf(a) | ((unsigned)f2bf(b) << 16); }
__device__ __forceinline__ int otid() { int t = threadIdx.x; asm volatile("" : "+v"(t)); return t; }
__device__ __forceinline__ float sigmoidf_(float x) { return __builtin_amdgcn_rcpf(1.0f + __expf(-x)); }

constexpr int HTB = 128 * 64 * 2;
__device__ __forceinline__ int lds_byte(int r, int c) { const int st = (r >> 4) * 2 + (c >> 5), rr = r & 15, cc = c & 31, ob = rr * 64 + cc * 2; return st * 1024 + (ob ^ (((ob >> 9) & 1) << 5)); }
__device__ __forceinline__ void stage_rc(int b, int& R, int& C) { const int st = b / 1024, sb = b % 1024, swz = sb ^ (((sb >> 9) & 1) << 5); R = (st >> 1) * 16 + swz / 64; C = (st & 1) * 32 + (swz % 64) / 2; }

struct Unit { const char* a; const char* b; int pm, pn; };
struct Sched {
    const char* A; const char* B; int lda, ldb, acol, nM, nN, G, c;
    __device__ __forceinline__ bool next(int i, Unit& u) const {
        const long L = (long)i * G + c; const int nwg = nM * nN; if (L >= nwg) return false;
        int wgid = (int)L; { const int q = nwg / 8, r = nwg % 8, xcd = wgid % 8, off = wgid / 8; wgid = (xcd < r ? xcd * (q + 1) : r * (q + 1) + (xcd - r) * q) + off; }
        const int nig = 8 * nN, gid = wgid / nig, fm = gid * 8, gsz = (nM - fm) < 8 ? (nM - fm) : 8;
        u.pm = fm + ((wgid % nig) % gsz); u.pn = (wgid % nig) / gsz;
        u.a = A + ((size_t)u.pm * 256 * lda + (size_t)u.pn * acol) * 2; u.b = B + (size_t)u.pn * 256 * ldb * 2; return true;
    }
};

template <class Epi>
__device__ __forceinline__ void gemm_phase(LAS unsigned char* lds, const Sched& S, const int K_, const Epi& E) {
    int K = K_; asm volatile("" : "+s"(K));
    int tid_ = threadIdx.x; asm volatile("" : "+v"(tid_));
    const int tid = tid_, wid = __builtin_amdgcn_readfirstlane(tid >> 6), lane = tid & 63, wr = wid >> 2, wc = wid & 3, fr = lane & 15, fq = lane >> 4;
    const int nt = K / 64;
    unsigned voffA[2], voffB[2];
#pragma unroll
    for (int i = 0; i < 2; ++i) { int R, C; stage_rc(tid * 16 + i * 8192, R, C); voffA[i] = (unsigned)(R * S.lda + C) * 2u; voffB[i] = (unsigned)(R * S.ldb + C) * 2u; }
    const size_t kstep = 128;
    const size_t hstepA = (size_t)128 * S.lda * 2, hstepB = (size_t)128 * S.ldb * 2;
    const unsigned ldsw = (unsigned)wid * 1024u;
    const int aoff = lds_byte(wr * 64 + fr, fq * 8), boff = lds_byte(wc * 32 + fr, fq * 8);
#define G_SA(b, h) (((b) * 2 + (h)) * HTB)
#define G_SB(b, h) ((4 + (b) * 2 + (h)) * HTB)
#define G_STAGE(bufoff, gbase, voff) do { _Pragma("unroll") for (int _i = 0; _i < 2; ++_i) \
        __builtin_amdgcn_global_load_lds((const unsigned*)((const char*)(gbase) + (voff)[_i]), (LAS unsigned*)(lds + (bufoff) + ldsw + _i * 8192), 16, 0, 0); } while (0)
#define G_LDA(dst, b, h) do { _Pragma("unroll") for (int m = 0; m < 4; ++m) _Pragma("unroll") for (int k = 0; k < 2; ++k) dst[m][k] = *(const LAS bf16x8*)(lds + G_SA(b, h) + aoff + m * 2048 + k * 1024); } while (0)
#define G_LDB(dst, b, h) do { _Pragma("unroll") for (int n = 0; n < 2; ++n) _Pragma("unroll") for (int k = 0; k < 2; ++k) dst[n][k] = *(const LAS bf16x8*)(lds + G_SB(b, h) + boff + n * 2048 + k * 1024); } while (0)
#define G_MMA(ai, bj, At, Bt) do { __builtin_amdgcn_s_setprio(1); _Pragma("unroll") for (int m = 0; m < 4; ++m) _Pragma("unroll") for (int n = 0; n < 2; ++n) _Pragma("unroll") for (int k = 0; k < 2; ++k) \
        acc[ai][bj][m][n] = __builtin_amdgcn_mfma_f32_16x16x32_bf16(Bt[n][k], At[m][k], acc[ai][bj][m][n], 0, 0, 0); __builtin_amdgcn_s_setprio(0); } while (0)
#define G_WAIT_V(n) asm volatile("s_waitcnt vmcnt(" #n ")" ::: "memory")
#define G_WAIT_L(n) asm volatile("s_waitcnt lgkmcnt(" #n ")" ::: "memory")
#define G_BAR __builtin_amdgcn_s_barrier()
#define G_SCHED __builtin_amdgcn_sched_barrier(0)
    Unit cur, nxt; int ui = 0;
    if (!S.next(0, cur)) return;
    f32x4 acc[2][2][4][2];
#pragma unroll
    for (int a = 0; a < 2; ++a)
#pragma unroll
        for (int b = 0; b < 2; ++b)
#pragma unroll
            for (int m = 0; m < 4; ++m)
#pragma unroll
                for (int n = 0; n < 2; ++n) acc[a][b][m][n] = (f32x4){0.f, 0.f, 0.f, 0.f};
    bf16x8 At[4][2], B0[2][2], B1[2][2];
    const char* cA = cur.a; const char* cB = cur.b;
    G_STAGE(G_SB(0, 0), cB, voffB); G_STAGE(G_SA(0, 0), cA, voffA); G_STAGE(G_SB(0, 1), cB + hstepB, voffB); G_STAGE(G_SA(0, 1), cA + hstepA, voffA);
    if (wr == 1) G_BAR;
    G_WAIT_V(4); G_BAR;
    G_STAGE(G_SB(1, 0), cB + kstep, voffB); G_STAGE(G_SA(1, 0), cA + kstep, voffA); G_STAGE(G_SB(1, 1), cB + hstepB + kstep, voffB);
    G_WAIT_V(6); G_BAR;
    for (;;) {
        const bool has_next = S.next(ui + 1, nxt);
        const char* nA = has_next ? nxt.a : cA; const char* nB = has_next ? nxt.b : cB;
        for (int t = 0; t < nt; t += 2) {
            const bool last = (t == nt - 2);
            const char* a1 = cA + (size_t)(t + 1) * kstep;
            const char* a2 = last ? nA : cA + (size_t)(t + 2) * kstep; const char* b2 = last ? nB : cB + (size_t)(t + 2) * kstep;
            const char* a3 = a2 + kstep; const char* b3 = b2 + kstep;
            G_LDB(B0, 0, 0); G_SCHED; G_LDA(At, 0, 0); G_STAGE(G_SA(1, 1), a1 + hstepA, voffA);
            G_WAIT_L(8); G_BAR; G_WAIT_L(0); G_MMA(0, 0, At, B0); G_BAR; G_SCHED;
            G_LDB(B1, 0, 1); G_STAGE(G_SB(0, 0), b2, voffB);
            G_BAR; G_WAIT_L(0); G_MMA(0, 1, At, B1); G_BAR;
            G_LDA(At, 0, 1); G_STAGE(G_SA(0, 0), a2, voffA);
            G_BAR; G_WAIT_L(0); G_MMA(1, 0, At, B0); G_BAR; G_SCHED;
            G_STAGE(G_SB(0, 1), b2 + hstepB, voffB);
            G_WAIT_V(6); G_BAR; G_MMA(1, 1, At, B1); G_BAR;
            G_LDB(B0, 1, 0); G_SCHED; G_LDA(At, 1, 0); G_STAGE(G_SA(0, 1), a2 + hstepA, voffA);
            G_WAIT_L(8); G_BAR; G_WAIT_L(0); G_MMA(0, 0, At, B0); G_BAR; G_SCHED;
            G_LDB(B1, 1, 1); G_STAGE(G_SB(1, 0), b3, voffB);
            G_BAR; G_WAIT_L(0); G_MMA(0, 1, At, B1); G_BAR;
            G_LDA(At, 1, 1); G_STAGE(G_SA(1, 0), a3, voffA);
            G_BAR; G_WAIT_L(0); G_MMA(1, 0, At, B0); G_BAR; G_SCHED;
            G_STAGE(G_SB(1, 1), b3 + hstepB, voffB);
            G_WAIT_V(6); G_BAR; G_MMA(1, 1, At, B1); G_BAR;
        }
        E(acc, cur, wr, wc, fr, fq);
        if (!has_next) break;
#pragma unroll
        for (int a = 0; a < 2; ++a)
#pragma unroll
            for (int b = 0; b < 2; ++b)
#pragma unroll
                for (int m = 0; m < 4; ++m)
#pragma unroll
                    for (int n = 0; n < 2; ++n) acc[a][b][m][n] = (f32x4){0.f, 0.f, 0.f, 0.f};
        cur = nxt; cA = nA; cB = nB; ++ui;
    }
    G_WAIT_V(0);
    if (wr == 0) G_BAR;
    G_BAR;
#undef G_SA
#undef G_SB
#undef G_STAGE
#undef G_LDA
#undef G_LDB
#undef G_MMA
#undef G_WAIT_V
#undef G_WAIT_L
#undef G_BAR
#undef G_SCHED
}

#define EPI_LOOP_BEGIN \
    _Pragma("unroll") for (int ai = 0; ai < 2; ++ai) _Pragma("unroll") for (int m = 0; m < 4; ++m) { const int row = u.pm * 256 + wr * 64 + fr + ai * 128 + m * 16; \
    _Pragma("unroll") for (int bj = 0; bj < 2; ++bj) _Pragma("unroll") for (int n = 0; n < 2; ++n) { const int cl = wc * 32 + 4 * fq + bj * 128 + n * 16; const f32x4 v = acc[ai][bj][m][n];
#define EPI_LOOP_END } }

__device__ __forceinline__ int seq_group(int row) { return row < MCTX ? 0 : 1 + ((row - MCTX) >> 11); }

struct EpiIn {
    bf16_t* xaq; bf16_t* xc; bf16_t* kb; bf16_t* vb; float* outk; float* outv; int l;
    __device__ __forceinline__ void operator()(const f32x4 (&acc)[2][2][4][2], const Unit& u, int wr, int wc, int fr, int fq) const {
        bf16_t* dst; int ld, cbase; float* fo = nullptr;
        if (u.pn < 4) { dst = xaq; ld = 1024; cbase = u.pn * 256; }
        else if (u.pn < 8) { dst = xaq + (size_t)MROWS * 1024; ld = 1024; cbase = u.pn * 256 - 1024; }
        else if (u.pn == 8) { dst = kb; ld = 256; cbase = 0; fo = outk; }
        else if (u.pn == 9) { dst = vb; ld = 256; cbase = 0; fo = outv; }
        else { dst = xc; ld = 1024; cbase = u.pn * 256 - 2560; }
        EPI_LOOP_BEGIN
            const int col = cbase + cl;
            uint2 pk; pk.x = pack2(v[0], v[1]); pk.y = pack2(v[2], v[3]);
            *(uint2*)(dst + (size_t)row * ld + col) = pk;
            if (fo != nullptr && row < MCTX) { const int b = row >> 8, t = row & 255; *(f32x4*)(fo + ((size_t)((b * 2 + l) * 256 + t)) * 256 + col) = v; }
        EPI_LOOP_END
    }
};
struct EpiGate {
    bf16_t* gt; const float* bias;
    __device__ __forceinline__ void operator()(const f32x4 (&acc)[2][2][4][2], const Unit& u, int wr, int wc, int fr, int fq) const {
        EPI_LOOP_BEGIN
            const int col = u.pn * 256 + cl;
            const f32x4 bb = *(const f32x4*)(bias + col);
            uint2 pk; pk.x = pack2(sigmoidf_(v[0] + bb[0]), sigmoidf_(v[1] + bb[1])); pk.y = pack2(sigmoidf_(v[2] + bb[2]), sigmoidf_(v[3] + bb[3]));
            *(uint2*)(gt + (size_t)row * 1024 + col) = pk;
        EPI_LOOP_END
    }
};
struct EpiBranch {
    const bf16_t* gt; float* tmp; bf16_t* mg; int j;
    __device__ __forceinline__ void operator()(const f32x4 (&acc)[2][2][4][2], const Unit& u, int wr, int wc, int fr, int fq) const {
        EPI_LOOP_BEGIN
            const int col = u.pn * 256 + cl;
            const uint2 gp = *(const uint2*)(gt + (size_t)row * 1024 + col);
            f32x4 r;
            r[0] = v[0] * bf2f((unsigned short)(gp.x & 0xffff)); r[1] = v[1] * bf2f((unsigned short)(gp.x >> 16));
            r[2] = v[2] * bf2f((unsigned short)(gp.y & 0xffff)); r[3] = v[3] * bf2f((unsigned short)(gp.y >> 16));
            float* tp = tmp + (size_t)row * 1024 + col;
            if (j == 0) { *(f32x4*)tp = r; }
            else if (j == 1) { f32x4 o = *(const f32x4*)tp; *(f32x4*)tp = o + r; }
            else { f32x4 o = *(const f32x4*)tp; o = o + r; uint2 pk; pk.x = pack2(o[0], o[1]); pk.y = pack2(o[2], o[3]); *(uint2*)(mg + (size_t)row * 1024 + col) = pk; }
        EPI_LOOP_END
    }
};
struct EpiRes {
    float* x; const float* mod; int goff;
    __device__ __forceinline__ void operator()(const f32x4 (&acc)[2][2][4][2], const Unit& u, int wr, int wc, int fr, int fq) const {
        const float* g = mod + seq_group(u.pm * 256) * 6144 + goff;
        EPI_LOOP_BEGIN
            const int col = u.pn * 256 + cl;
            const f32x4 gg = *(const f32x4*)(g + col);
            float* xp = x + (size_t)row * 1024 + col;
            f32x4 o = *(const f32x4*)xp;
            *(f32x4*)xp = o + gg * v;
        EPI_LOOP_END
    }
};
struct EpiBf {
    bf16_t* dst; int ld;
    __device__ __forceinline__ void operator()(const f32x4 (&acc)[2][2][4][2], const Unit& u, int wr, int wc, int fr, int fq) const {
        EPI_LOOP_BEGIN
            const int col = u.pn * 256 + cl;
            uint2 pk; pk.x = pack2(v[0], v[1]); pk.y = pack2(v[2], v[3]);
            *(uint2*)(dst + (size_t)row * ld + col) = pk;
        EPI_LOOP_END
    }
};
struct EpiPool {
    bf16_t* dst; const float* scale;
    __device__ __forceinline__ void operator()(const f32x4 (&acc)[2][2][4][2], const Unit& u, int wr, int wc, int fr, int fq) const {
        EPI_LOOP_BEGIN
            const int col = u.pn * 256 + cl;
            const f32x4 s = *(const f32x4*)(scale + col);
            uint2 pk; pk.x = pack2(v[0] * s[0], v[1] * s[1]); pk.y = pack2(v[2] * s[2], v[3] * s[3]);
            *(uint2*)(dst + (size_t)row * 1024 + col) = pk;
        EPI_LOOP_END
    }
};

__device__ __forceinline__ void transpose_tile(const float* __restrict__ src, int lds_, bf16_t* __restrict__ dst, int ldd, int k0, int n0, LAS unsigned char* lds) {
    LAS bf16_t* sm = (LAS bf16_t*)lds;
    const int tid = otid();
#pragma unroll
    for (int i = 0; i < 2; ++i) {
        const int idx = tid + i * 512, kk = idx >> 4, n4 = (idx & 15) * 4;
        const float4 v = *(const float4*)(src + (size_t)(k0 + kk) * lds_ + n0 + n4);
        sm[(n4 + 0) * 72 + kk] = f2bf(v.x); sm[(n4 + 1) * 72 + kk] = f2bf(v.y); sm[(n4 + 2) * 72 + kk] = f2bf(v.z); sm[(n4 + 3) * 72 + kk] = f2bf(v.w);
    }
    __syncthreads();
    { const int nn = tid >> 3, ck = tid & 7;
      const u32x4 v = *(const LAS u32x4*)(sm + nn * 72 + ck * 8);
      *(u32x4*)(dst + (size_t)(n0 + nn) * ldd + k0 + ck * 8) = v; }
    __syncthreads();
}
__device__ void convert_weights(const Params& P, int l, LAS unsigned char* lds) {
    unsigned char* ws = P.ws;
    for (int t = blockIdx.x; t < 4992; t += gridDim.x) {
        const float* src; int lds_; bf16_t* dst; int ldd, k0, n0; int r = t;
        if (r < 1664) { src = P.w_in + (size_t)l * 1024 * 6656; lds_ = 6656; dst = (bf16_t*)(ws + OFF_WIN); ldd = 1024; k0 = (r / 104) * 64; n0 = (r % 104) * 64; }
        else if ((r -= 1664) < 768) { const int j = r / 256; r %= 256; src = P.w_branch + (size_t)(l * 3 + j) * 1024 * 1024; lds_ = 1024; dst = (bf16_t*)(ws + OFF_WBR) + (size_t)j * 1024 * 1024; ldd = 1024; k0 = (r / 16) * 64; n0 = (r % 16) * 64; }
        else if ((r -= 768) < 256) { src = P.w_out + (size_t)l * 1024 * 1024; lds_ = 1024; dst = (bf16_t*)(ws + OFF_WOUT); ldd = 1024; k0 = (r / 16) * 64; n0 = (r % 16) * 64; }
        else if ((r -= 256) < 1408) { src = P.ffn_up + (size_t)l * 1024 * 5632; lds_ = 5632; dst = (bf16_t*)(ws + OFF_WUP); ldd = 1024; k0 = (r / 88) * 64; n0 = (r % 88) * 64; }
        else if ((r -= 1408) < 704) { src = P.ffn_down + (size_t)l * 2816 * 1024; lds_ = 1024; dst = (bf16_t*)(ws + OFF_WDN); ldd = 2816; k0 = (r / 16) * 64; n0 = (r % 16) * 64; }
        else if ((r -= 704) < 128) { const int mat = r / 64; r %= 64; const int dh = r / 4; r %= 4;
            src = (mat ? P.lru_wx : P.lru_wa) + (size_t)(l * 16 + dh) * 128 * 128; lds_ = 128; dst = (bf16_t*)(ws + OFF_GW) + (size_t)dh * 256 * 128 + (size_t)mat * 128 * 128; ldd = 128; k0 = (r / 2) * 64; n0 = (r % 2) * 64; }
        else { r -= 128; const int g = r / 16; r %= 16; src = P.pool_w + (size_t)(l * 4 + g) * 256 * 256; lds_ = 256; dst = (bf16_t*)(ws + OFF_PW) + (size_t)g * 256 * 256; ldd = 256; k0 = (r / 4) * 64; n0 = (r % 4) * 64; }
        transpose_tile(src, lds_, dst, ldd, k0, n0, lds);
    }
}

__device__ void phase0(const Params& P, LAS unsigned char* lds) {
    const int tid = otid(), G = gridDim.x, c = blockIdx.x;
    { const size_t n4 = (size_t)MROWS * 1024 / 4, nc4 = (size_t)MCTX * 1024 / 4;
      for (size_t i = (size_t)c * 512 + tid; i < n4; i += (size_t)G * 512) {
          const float4 v = i < nc4 ? ((const float4*)P.x_prompt)[i] : ((const float4*)P.x_sample)[i - nc4];
          ((float4*)P.out)[i] = v; } }
    { bf16_t* ck = (bf16_t*)(P.ws + OFF_CK); bf16_t* cv = (bf16_t*)(P.ws + OFF_CV);
      for (int i = c * 512 + tid; i < 2 * 2 * 512 * 256; i += G * 512) {
          const int e = i & 255, t = (i >> 8) & 511, b = (i >> 17) & 1, l = i >> 18;
          const size_t si = ((size_t)((b * 2 + l) * 512 + t)) * 256 + e;
          ck[i] = f2bf(P.cache_k[si]); cv[i] = f2bf(P.cache_v[si]); } }
    { float* rc = (float*)(P.ws + OFF_ROPE); float* rs = rc + 2048;
      for (int i = c * 512 + tid; i < 2048; i += G * 512) {
          const int pos = i >> 5, k = i & 31; const float fr = powf(10000.0f, -(float)k / 32.0f); const float ang = (float)pos * fr;
          rc[i] = cosf(ang); rs[i] = sinf(ang); } }
    { LAS float* sv = (LAS float*)lds;
      LAS float* red = sv + 3072;
      __syncthreads();
      for (int i = tid; i < 3072; i += 512) { const int s = i >> 10, k = i & 1023; const float x = s == 0 ? P.c_ctx[k] : P.c[(s - 1) * 1024 + k]; sv[i] = x / (1.0f + expf(-x)); }
      __syncthreads();
      float* mod = (float*)(P.ws + OFF_MOD);
      for (int it = c; it < 384; it += G) {
          const int l = it / 192, cg_ = it % 192, cl = tid & 31, kg = tid >> 5, col = cg_ * 32 + cl;
          const float* w = P.w_ada + (size_t)l * 1024 * 6144 + col;
          float a0 = 0.f, a1 = 0.f, a2 = 0.f;
#pragma unroll 16
          for (int k = kg * 64; k < kg * 64 + 64; ++k) { const float wv = w[(size_t)k * 6144]; a0 += sv[k] * wv; a1 += sv[1024 + k] * wv; a2 += sv[2048 + k] * wv; }
          red[(kg * 3 + 0) * 32 + cl] = a0; red[(kg * 3 + 1) * 32 + cl] = a1; red[(kg * 3 + 2) * 32 + cl] = a2;
          __syncthreads();
          if (tid < 96) { const int s = tid >> 5, cc = tid & 31; float sum = 0.f;
#pragma unroll
              for (int g = 0; g < 16; ++g) sum += red[(g * 3 + s) * 32 + cc];
              mod[(size_t)(l * 3 + s) * 6144 + cg_ * 32 + cc] = sum + P.b_ada[l * 6144 + cg_ * 32 + cc]; }
          __syncthreads();
      } }
}

__device__ void norm_phase(const float* __restrict__ X, const float* __restrict__ gw, const float* __restrict__ mod, int shift_off, int scale_off, bf16_t* __restrict__ H) {
    const int tid = otid(); const int lane = tid & 63, wv = blockIdx.x * 8 + (tid >> 6), nw = gridDim.x * 8;
    for (int row = wv; row < MROWS; row += nw) {
        const float* md = mod + seq_group(row) * 6144;
        f32x4 v[4]; float ss = 0.f;
#pragma unroll
        for (int i = 0; i < 4; ++i) { v[i] = *(const f32x4*)(X + (size_t)row * 1024 + i * 256 + lane * 4); ss += v[i][0] * v[i][0] + v[i][1] * v[i][1] + v[i][2] * v[i][2] + v[i][3] * v[i][3]; }
#pragma unroll
        for (int o = 32; o >= 1; o >>= 1) ss += __shfl_xor(ss, o);
        const float rstd = rsqrtf(ss * (1.0f / 1024.0f) + 1e-6f);
#pragma unroll
        for (int i = 0; i < 4; ++i) { const int col = i * 256 + lane * 4;
            const f32x4 g = *(const f32x4*)(gw + col), sc = *(const f32x4*)(md + scale_off + col), sh = *(const f32x4*)(md + shift_off + col);
            f32x4 h;
#pragma unroll
            for (int e = 0; e < 4; ++e) h[e] = v[i][e] * rstd * g[e] * (1.0f + sc[e]) + sh[e];
            uint2 pk; pk.x = pack2(h[0], h[1]); pk.y = pack2(h[2], h[3]);
            *(uint2*)(H + (size_t)row * 1024 + col) = pk; }
    }
}
__device__ void final_norm_phase(float* X, const float* __restrict__ gw) {
    const int tid = otid(); const int lane = tid & 63, wv = blockIdx.x * 8 + (tid >> 6), nw = gridDim.x * 8;
    for (int row = wv; row < MROWS; row += nw) {
        f32x4 v[4]; float ss = 0.f;
#pragma unroll
        for (int i = 0; i < 4; ++i) { v[i] = *(const f32x4*)(X + (size_t)row * 1024 + i * 256 + lane * 4); ss += v[i][0] * v[i][0] + v[i][1] * v[i][1] + v[i][2] * v[i][2] + v[i][3] * v[i][3]; }
#pragma unroll
        for (int o = 32; o >= 1; o >>= 1) ss += __shfl_xor(ss, o);
        const float rstd = rsqrtf(ss * (1.0f / 1024.0f) + 1e-6f);
#pragma unroll
        for (int i = 0; i < 4; ++i) { const int col = i * 256 + lane * 4; const f32x4 g = *(const f32x4*)(gw + col);
            f32x4 h;
#pragma unroll
            for (int e = 0; e < 4; ++e) h[e] = v[i][e] * rstd * g[e];
            *(f32x4*)(X + (size_t)row * 1024 + col) = h; }
    }
}

__device__ void pool_phase(const bf16_t* __restrict__ XC, bf16_t* __restrict__ PL) {
    const int tid = otid();
    for (int idx = blockIdx.x * 512 + tid; idx < MROWS * 128; idx += gridDim.x * 512) {
        const int row = idx >> 7, ch = (idx & 127) * 8, g = ch >> 8, half = 1 << g;
        const int T = row < MCTX ? 256 : 2048, row0 = row < MCTX ? (row & ~255) : MCTX + ((row - MCTX) & ~2047), tl = row - row0;
        const int lo = max(tl - half, 0), hi = min(tl + half, T);
        float s[8];
#pragma unroll
        for (int e = 0; e < 8; ++e) s[e] = 0.f;
        for (int t = lo; t < hi; ++t) { const bf16x8 x = *(const bf16x8*)(XC + (size_t)(row0 + t) * 1024 + ch);
#pragma unroll
            for (int e = 0; e < 8; ++e) s[e] += bf2f((unsigned short)x[e]); }
        const bf16x8 xs = *(const bf16x8*)(XC + (size_t)row * 1024 + ch);
        const float inv = 1.0f / (float)(hi - lo);
        uint4 o; o.x = pack2(s[0] * inv - bf2f((unsigned short)xs[0]), s[1] * inv - bf2f((unsigned short)xs[1])); o.y = pack2(s[2] * inv - bf2f((unsigned short)xs[2]), s[3] * inv - bf2f((unsigned short)xs[3]));
        o.z = pack2(s[4] * inv - bf2f((unsigned short)xs[4]), s[5] * inv - bf2f((unsigned short)xs[5])); o.w = pack2(s[6] * inv - bf2f((unsigned short)xs[6]), s[7] * inv - bf2f((unsigned short)xs[7]));
        *(uint4*)(PL + (size_t)row * 1024 + ch) = o;
    }
}
__device__ __forceinline__ float gelu_tanh(float x) { const float y = 0.7978845608028654f * (x + 0.044715f * x * x * x); const float t = 1.0f - 2.0f * __builtin_amdgcn_rcpf(1.0f + __expf(2.0f * y)); return 0.5f * x * (1.0f + t); }
__device__ void act_phase(const bf16_t* __restrict__ U, bf16_t* __restrict__ ACT, const float* __restrict__ cw, const float* __restrict__ cb) {
    const int tid = otid();
    for (int idx = blockIdx.x * 512 + tid; idx < MROWS * 352; idx += gridDim.x * 512) {
        const int row = idx / 352, ch = (idx % 352) * 8;
        const int T = row < MCTX ? 256 : 2048, row0 = row < MCTX ? (row & ~255) : MCTX + ((row - MCTX) & ~2047), tl = row - row0;
        const bf16_t* up = U + (size_t)row * 5632 + ch;
        const bf16x8 u0 = *(const bf16x8*)up, vv = *(const bf16x8*)(up + 2816);
        bf16x8 um = (bf16x8){0, 0, 0, 0, 0, 0, 0, 0}, upn = um;
        if (tl > 0) um = *(const bf16x8*)(up - 5632);
        if (tl < T - 1) upn = *(const bf16x8*)(up + 5632);
        float r[8];
#pragma unroll
        for (int e = 0; e < 8; ++e) { const float gff = cw[ch + e] * bf2f((unsigned short)um[e]) + cw[2816 + ch + e] * bf2f((unsigned short)u0[e]) + cw[5632 + ch + e] * bf2f((unsigned short)upn[e]) + cb[ch + e];
            r[e] = gelu_tanh(gff) * bf2f((unsigned short)vv[e]); }
        uint4 o; o.x = pack2(r[0], r[1]); o.y = pack2(r[2], r[3]); o.z = pack2(r[4], r[5]); o.w = pack2(r[6], r[7]);
        *(uint4*)(ACT + (size_t)row * 2816 + ch) = o;
    }
}

__device__ __forceinline__ void rope8(bf16x8& x1, bf16x8& x2, const float* __restrict__ cs, const float* __restrict__ sn) {
#pragma unroll
    for (int e = 0; e < 8; ++e) { const float a = bf2f((unsigned short)x1[e]), b = bf2f((unsigned short)x2[e]); const float c = cs[e], s = sn[e];
        x1[e] = (short)f2bf(a * c - b * s); x2[e] = (short)f2bf(a * s + b * c); }
}
constexpr int VT_OFF = 64 * 272;
__device__ void attn_unit(const Params& P, int l, int u, LAS unsigned char* lds) {
    int tid_ = threadIdx.x; asm volatile("" : "+v"(tid_));
    const int tid = tid_, w = tid >> 6, lane = tid & 63, fr = lane & 15, fq = lane >> 4;
    const bf16_t* Q = (const bf16_t*)(P.ws + OFF_XAQ) + (size_t)MROWS * 1024;
    const bf16_t* KB = (const bf16_t*)(P.ws + OFF_KB); const bf16_t* VB = (const bf16_t*)(P.ws + OFF_VB);
    const bf16_t* CK = (const bf16_t*)(P.ws + OFF_CK); const bf16_t* CV = (const bf16_t*)(P.ws + OFF_CV);
    bf16_t* YB = (bf16_t*)(P.ws + OFF_YB);
    const float* rc = (const float*)(P.ws + OFF_ROPE); const float* rs = rc + 2048;
    bool lat; int head, row0, T, qstart, bidx;
    if (u < 256) { lat = true; bidx = u >> 7; const int rem = u & 127; head = rem >> 4; qstart = (rem & 15) * 128; T = 2048; row0 = MCTX + bidx * 2048; }
    else { const int v = u - 256; lat = false; bidx = 0; const int seq = v >> 4, rem = v & 15; head = rem >> 1; qstart = (rem & 1) * 128; T = 256; row0 = seq * 256; }
    const int kvh = head >> 2;
    const int qpos = qstart + w * 16 + fr;
    bf16x8 qf[4];
    { const bf16_t* qp = Q + (size_t)(row0 + qpos) * 1024 + head * 128 + fq * 8;
#pragma unroll
      for (int kk = 0; kk < 4; ++kk) qf[kk] = *(const bf16x8*)(qp + kk * 32);
      if (lat) { rope8(qf[0], qf[1], rc + (qpos >> 6) * 32 + fq * 8, rs + (qpos >> 6) * 32 + fq * 8); rope8(qf[2], qf[3], rc + (qpos & 63) * 32 + fq * 8, rs + (qpos & 63) * 32 + fq * 8); } }
    float m_run = P.attn_sink[l * 8 + head]; float l_run = (fq == 0) ? 1.0f : 0.0f;
    f32x4 o[8];
#pragma unroll
    for (int dt = 0; dt < 8; ++dt) o[dt] = (f32x4){0.f, 0.f, 0.f, 0.f};
    int wlo = 0, nwt = 4;
    if (lat) { wlo = max(0, qstart - 128); const int whi = min(T, qstart + 256); nwt = (whi - wlo) >> 6; }
    const int ntiles = nwt + (lat ? 8 : 0);
    const float scale = 0.08838834764831845f;
    for (int ti = 0; ti < ntiles; ++ti) {
        const bool win = ti < nwt; int k0; const bf16_t *ksrc, *vsrc;
        if (win) { k0 = wlo + ti * 64; ksrc = KB + (size_t)(row0 + k0) * 256 + kvh * 128; vsrc = VB + (size_t)(row0 + k0) * 256 + kvh * 128; }
        else { k0 = (ti - nwt) * 64; const size_t o_ = ((size_t)((l * 2 + bidx) * 512 + k0)) * 256 + kvh * 128; ksrc = CK + o_; vsrc = CV + o_; }
        __syncthreads();
        { const int key = tid >> 3, p = tid & 7, cidx = p < 4 ? p : p + 4;
          const bf16_t* kr = ksrc + (size_t)key * 256;
          bf16x8 x1 = *(const bf16x8*)(kr + cidx * 8), x2 = *(const bf16x8*)(kr + (cidx + 4) * 8);
          if (lat && win) { const int kp = k0 + key; const int pos = (cidx < 8) ? (kp >> 6) : (kp & 63); const int i0 = (cidx & 3) * 8; rope8(x1, x2, rc + pos * 32 + i0, rs + pos * 32 + i0); }
          *(LAS bf16x8*)(lds + key * 272 + cidx * 16) = x1; *(LAS bf16x8*)(lds + key * 272 + (cidx + 4) * 16) = x2; }
#pragma unroll
        for (int h2 = 0; h2 < 2; ++h2) { const int cidx = w + h2 * 8; const bf16x8 vv = *(const bf16x8*)(vsrc + (size_t)lane * 256 + cidx * 8);
#pragma unroll
            for (int e = 0; e < 8; ++e) *(LAS bf16_t*)(lds + VT_OFF + (cidx * 8 + e) * 144 + lane * 2) = (bf16_t)vv[e]; }
        __syncthreads();
        f32x4 s[4];
#pragma unroll
        for (int nt = 0; nt < 4; ++nt) { s[nt] = (f32x4){0.f, 0.f, 0.f, 0.f};
#pragma unroll
            for (int kk = 0; kk < 4; ++kk) { const bf16x8 a = *(const LAS bf16x8*)(lds + (nt * 16 + fr) * 272 + kk * 64 + fq * 16); s[nt] = __builtin_amdgcn_mfma_f32_16x16x32_bf16(a, qf[kk], s[nt], 0, 0, 0); } }
        float mt = -3.0e38f;
#pragma unroll
        for (int nt = 0; nt < 4; ++nt)
#pragma unroll
            for (int j = 0; j < 4; ++j) { float v = s[nt][j] * scale;
                if (lat && win) { const int kp = k0 + nt * 16 + fq * 4 + j; const int dd = qpos - kp; if (dd > 128 || dd < -128) v = -1.0e30f; }
                s[nt][j] = v; mt = fmaxf(mt, v); }
        mt = fmaxf(mt, __shfl_xor(mt, 16)); mt = fmaxf(mt, __shfl_xor(mt, 32));
        const float mn = fmaxf(m_run, mt); const float alpha = __expf(m_run - mn); m_run = mn;
        float ps = 0.f;
#pragma unroll
        for (int nt = 0; nt < 4; ++nt)
#pragma unroll
            for (int j = 0; j < 4; ++j) { const float p = __expf(s[nt][j] - mn); ps += p; s[nt][j] = p; }
        l_run = l_run * alpha + ps;
#pragma unroll
        for (int dt = 0; dt < 8; ++dt) o[dt] = o[dt] * alpha;
#pragma unroll
        for (int s2 = 0; s2 < 2; ++s2) {
            u32x4 pu; pu[0] = pack2(s[2 * s2][0], s[2 * s2][1]); pu[1] = pack2(s[2 * s2][2], s[2 * s2][3]); pu[2] = pack2(s[2 * s2 + 1][0], s[2 * s2 + 1][1]); pu[3] = pack2(s[2 * s2 + 1][2], s[2 * s2 + 1][3]);
            const bf16x8 pf = __builtin_bit_cast(bf16x8, pu);
#pragma unroll
            for (int dt = 0; dt < 8; ++dt) {
                const bf16x4 lo = *(const LAS bf16x4*)(lds + VT_OFF + (dt * 16 + fr) * 144 + (s2 * 32 + fq * 4) * 2);
                const bf16x4 hi = *(const LAS bf16x4*)(lds + VT_OFF + (dt * 16 + fr) * 144 + (s2 * 32 + 16 + fq * 4) * 2);
                const bf16x8 af = __builtin_shufflevector(lo, hi, 0, 1, 2, 3, 4, 5, 6, 7);
                o[dt] = __builtin_amdgcn_mfma_f32_16x16x32_bf16(af, pf, o[dt], 0, 0, 0);
            }
        }
    }
    float lt = l_run; lt += __shfl_xor(lt, 16); lt += __shfl_xor(lt, 32);
    const float inv = 1.0f / lt;
    bf16_t* yp = YB + (size_t)(row0 + qpos) * 1024 + head * 128 + fq * 4;
#pragma unroll
    for (int dt = 0; dt < 8; ++dt) { uint2 pk; pk.x = pack2(o[dt][0] * inv, o[dt][1] * inv); pk.y = pack2(o[dt][2] * inv, o[dt][3] * inv); *(uint2*)(yp + dt * 16) = pk; }
}

template <int MODE, int D>
__device__ __forceinline__ void lru_dir(const Params& P, int l, int s, int cchunk, int h, LAS unsigned char* lds, int w, int fr, int fq) {
    const bool lat = s >= 32; const int row0 = lat ? MCTX + (s - 32) * 2048 : s * 256; const int t0 = cchunk * 256;
    const bf16_t* GW = (const bf16_t*)(P.ws + OFF_GW);
    bf16_t* YA = (bf16_t*)(P.ws + OFF_YA);
    float* SUMM = (float*)(P.ws + OFF_SUMM);
    const int chl = 16 * w + fr, ch = h * 128 + chl;
    bf16x8 bwa[4], bwx[4];
    { const bf16_t* gp = GW + ((size_t)(D * 8 + h) * 256 + chl) * 128 + fq * 8;
#pragma unroll
      for (int kk = 0; kk < 4; ++kk) { bwa[kk] = *(const bf16x8*)(gp + kk * 32); bwx[kk] = *(const bf16x8*)(gp + 128 * 128 + kk * 32); } }
    const int pidx = (l * 2 + D) * 1024 + ch;
    const float ba = P.lru_ba[pidx], bx = P.lru_bx[pidx];
    const float lam = P.lru_lambda[pidx];
    const float c8 = -8.0f * log1pf(expf(-lam));
    float carry = 0.f;
    if (MODE == 0 && lat) {
        const int b = s - 32;
        carry = P.state_lru[((size_t)(b * 2 + l) * 2 + D) * 1024 + ch];
        if (D == 0) { for (int cc = 0; cc < cchunk; ++cc) { const float* sp = SUMM + ((size_t)((b * 2 + 0) * 8 + cc) * 1024 + ch) * 2; carry = sp[1] + sp[0] * carry; } }
        else { for (int cc = 7; cc > cchunk; --cc) { const float* sp = SUMM + ((size_t)((b * 2 + 1) * 8 + cc) * 1024 + ch) * 2; carry = sp[1] + sp[0] * carry; } }
    }
    float ptot = 1.0f;
#pragma unroll 1
    for (int sci = 0; sci < 4; ++sci) {
        const int sc = D == 0 ? sci : 3 - sci;
        f32x4 r[4], g[4];
#pragma unroll
        for (int m = 0; m < 4; ++m) { r[m] = (f32x4){0.f, 0.f, 0.f, 0.f}; g[m] = (f32x4){0.f, 0.f, 0.f, 0.f};
#pragma unroll
            for (int kk = 0; kk < 4; ++kk) { const bf16x8 a = *(const LAS bf16x8*)(lds + (sc * 64 + m * 16 + fr) * 272 + kk * 64 + fq * 16);
                r[m] = __builtin_amdgcn_mfma_f32_16x16x32_bf16(a, bwa[kk], r[m], 0, 0, 0); g[m] = __builtin_amdgcn_mfma_f32_16x16x32_bf16(a, bwx[kk], g[m], 0, 0, 0); } }
#pragma unroll
        for (int mi = 0; mi < 4; ++mi) {
            const int m = D == 0 ? mi : 3 - mi;
            float av[4], bv[4];
#pragma unroll
            for (int j = 0; j < 4; ++j) {
                const float rr = sigmoidf_(r[m][j] + ba), ii = sigmoidf_(g[m][j] + bx);
                const float la = c8 * rr; const float a = __expf(la); const float z = 2.0f * la;
                const float em = (z > -0.05f) ? -z * (1.0f + z * (0.5f + z * (0.16666667f + z * 0.041666667f))) : 1.0f - __expf(z);
                const float x = bf2f(*(const LAS bf16_t*)(lds + (sc * 64 + m * 16 + fq * 4 + j) * 272 + chl * 2));
                av[j] = a; bv[j] = sqrtf(em) * ii * x;
            }
            float p4, h4;
            p4 = av[0] * av[1] * av[2] * av[3];
            if (D == 0) h4 = ((bv[0] * av[1] + bv[1]) * av[2] + bv[2]) * av[3] + bv[3];
            else h4 = ((bv[3] * av[2] + bv[2]) * av[1] + bv[1]) * av[0] + bv[0];
            float pq[4], hq[4];
#pragma unroll
            for (int f = 0; f < 4; ++f) { pq[f] = __shfl(p4, fr + 16 * f); hq[f] = __shfl(h4, fr + 16 * f); }
            float cin = carry, mycin = 0.f;
#pragma unroll
            for (int fi = 0; fi < 4; ++fi) { const int f = D == 0 ? fi : 3 - fi; if (f == fq) mycin = cin; cin = hq[f] + pq[f] * cin; }
            carry = cin;
            if (MODE == 1) ptot *= pq[0] * pq[1] * pq[2] * pq[3];
            if (MODE == 0) {
                float hh = mycin; float y[4];
#pragma unroll
                for (int ji = 0; ji < 4; ++ji) { const int j = D == 0 ? ji : 3 - ji; hh = av[j] * hh + bv[j]; y[j] = hh; }
#pragma unroll
                for (int j = 0; j < 4; ++j) {
                    bf16_t* yp = YA + (size_t)(row0 + t0 + sc * 64 + m * 16 + fq * 4 + j) * 1024 + ch;
                    if (D == 0) *yp = f2bf(y[j]);
                    else *yp = f2bf(bf2f(*yp) + y[j]);
                }
            }
        }
    }
    if (MODE == 0 && !lat && fq == 0) P.out[OUT_H + ((size_t)(s * 2 + l) * 2 + D) * 1024 + ch] = carry;
    if (MODE == 1 && fq == 0) { float* sp = SUMM + ((size_t)(((s - 32) * 2 + D) * 8 + cchunk) * 1024 + ch) * 2; sp[0] = ptot; sp[1] = carry; }
}
template <int MODE>
__device__ void lru_unit(const Params& P, int l, int s, int cchunk, int h, LAS unsigned char* lds) {
    int tid_ = threadIdx.x; asm volatile("" : "+v"(tid_));
    const int tid = tid_, w = tid >> 6, lane = tid & 63, fr = lane & 15, fq = lane >> 4;
    const bool lat = s >= 32; const int T = lat ? 2048 : 256; const int row0 = lat ? MCTX + (s - 32) * 2048 : s * 256; const int t0 = cchunk * 256;
    const bf16_t* XA = (const bf16_t*)(P.ws + OFF_XAQ);
    __syncthreads();
    {
        const float* cw = P.lru_conv + (size_t)l * 4096; const float* cb = P.lru_conv_b + l * 1024;
#pragma unroll 1
        for (int it = 0; it < 8; ++it) {
            const int idx = tid + it * 512, t = idx >> 4, ck = idx & 15, ch = h * 128 + ck * 8;
            float a8[8];
#pragma unroll
            for (int e = 0; e < 8; ++e) a8[e] = cb[ch + e];
#pragma unroll
            for (int k = 0; k < 4; ++k) { const int tt = t0 + t + k - 2;
                if (tt >= 0 && tt < T) { const bf16x8 x = *(const bf16x8*)(XA + (size_t)(row0 + tt) * 1024 + ch);
#pragma unroll
                    for (int e = 0; e < 8; ++e) a8[e] += cw[k * 1024 + ch + e] * bf2f((unsigned short)x[e]); } }
            u32x4 o; o.x = pack2(a8[0], a8[1]); o.y = pack2(a8[2], a8[3]); o.z = pack2(a8[4], a8[5]); o.w = pack2(a8[6], a8[7]);
            *(LAS u32x4*)(lds + t * 272 + ck * 16) = o;
        }
    }
    __syncthreads();
    lru_dir<MODE, 0>(P, l, s, cchunk, h, lds, w, fr, fq);
    lru_dir<MODE, 1>(P, l, s, cchunk, h, lds, w, fr, fq);
}

__global__ __launch_bounds__(512, 2) void mega(Params P) {
    extern __shared__ __attribute__((aligned(16))) unsigned char shm[];
    LAS unsigned char* lds = (LAS unsigned char*)shm;
    cg::grid_group grid = cg::this_grid();
    const int G = gridDim.x, c = blockIdx.x;
    unsigned char* ws = P.ws;
    float* X = P.out;
    bf16_t* H = (bf16_t*)(ws + OFF_H);
    const float* MOD = (const float*)(ws + OFF_MOD);

    phase0(P, lds);
    grid.sync();
    for (int l = 0; l < 2; ++l) {
        const float* mod = MOD + (size_t)l * 3 * 6144;
        convert_weights(P, l, lds);
        norm_phase(X, P.norm1 + l * 1024, mod, 0, 1024, H);
        grid.sync();
        { Sched S{(const char*)H, (const char*)(ws + OFF_WIN), 1024, 1024, 0, 48, 14, G, c};
          EpiIn E{(bf16_t*)(ws + OFF_XAQ), (bf16_t*)(ws + OFF_XC), (bf16_t*)(ws + OFF_KB), (bf16_t*)(ws + OFF_VB), P.out + OUT_K, P.out + OUT_V, l};
          gemm_phase(lds, S, 1024, E); }
        grid.sync();
        pool_phase((const bf16_t*)(ws + OFF_XC), (bf16_t*)(ws + OFF_PL));
        for (int it = c; it < 1152; it += G) {
#ifndef NO_ATTN
            if (it < 256) attn_unit(P, l, it, lds);
            else if (it >= 640) attn_unit(P, l, it - 640 + 256, lds);
#endif
#ifndef NO_LRU
            if (it >= 256 && it < 640) { const int v = it - 256;
                if (v < 256) lru_unit<0>(P, l, v >> 3, 0, v & 7, lds);
                else { const int q = v - 256; lru_unit<1>(P, l, 32 + (q >> 6), (q >> 3) & 7, q & 7, lds); } }
#endif
        }
        grid.sync();
        { Sched S{(const char*)(ws + OFF_PL), (const char*)(ws + OFF_PW), 1024, 256, 256, 48, 4, G, c};
          EpiPool E{(bf16_t*)(ws + OFF_XC), P.pool_scale + l * 1024};
          gemm_phase(lds, S, 256, E); }
#ifndef NO_LRU
        for (int it = G - 1 - c; it < 128; it += G) lru_unit<0>(P, l, 32 + (it >> 6), (it >> 3) & 7, it & 7, lds);
#endif
        grid.sync();
        for (int j = 0; j < 3; ++j) {
            { Sched S{(const char*)H, (const char*)(ws + OFF_WIN) + (size_t)(3584 + j * 1024) * 1024 * 2, 1024, 1024, 0, 48, 4, G, c};
              EpiGate E{(bf16_t*)(ws + OFF_GT), P.b_gate + l * 3072 + j * 1024};
              gemm_phase(lds, S, 1024, E); }
            { const char* Aj = (const char*)(ws + (j == 0 ? OFF_YA : (j == 1 ? OFF_YB : OFF_XC)));
              Sched S{Aj, (const char*)(ws + OFF_WBR) + (size_t)j * 1024 * 1024 * 2, 1024, 1024, 0, 48, 4, G, c};
              EpiBranch E{(const bf16_t*)(ws + OFF_GT), (float*)(ws + OFF_XAQ), (bf16_t*)(ws + OFF_PL), j};
              gemm_phase(lds, S, 1024, E); }
        }
        grid.sync();
        { Sched S{(const char*)(ws + OFF_PL), (const char*)(ws + OFF_WOUT), 1024, 1024, 0, 48, 4, G, c};
          EpiRes E{X, mod, 2048};
          gemm_phase(lds, S, 1024, E); }
        grid.sync();
        norm_phase(X, P.norm2 + l * 1024, mod, 3072, 4096, H);
        grid.sync();
        { Sched S{(const char*)H, (const char*)(ws + OFF_WUP), 1024, 1024, 0, 48, 22, G, c};
          EpiBf E{(bf16_t*)(ws + OFF_U), 5632};
          gemm_phase(lds, S, 1024, E); }
        grid.sync();
        act_phase((const bf16_t*)(ws + OFF_U), (bf16_t*)(ws + OFF_ACT), P.ffn_conv + (size_t)l * 3 * 2816, P.ffn_conv_b + l * 2816);
        grid.sync();
        { Sched S{(const char*)(ws + OFF_ACT), (const char*)(ws + OFF_WDN), 2816, 2816, 0, 48, 4, G, c};
          EpiRes E{X, mod, 5120};
          gemm_phase(lds, S, 2816, E); }
        grid.sync();
    }
    final_norm_phase(X, P.final_norm);
}

extern "C" void kernel_launch(void* const* d_in, const int* in_sizes, int n_in, void* d_out, int out_size, void* d_ws, size_t ws_size, hipStream_t stream) {
    constexpr size_t kDynLds = 131072;
    static int grid_blocks = 0;
    if (!grid_blocks) {
        int dev = 0, cus = 0, per_cu = 0;
        hipGetDevice(&dev);
        hipDeviceGetAttribute(&cus, hipDeviceAttributeMultiprocessorCount, dev);
        hipFuncSetAttribute((const void*)mega, hipFuncAttributeMaxDynamicSharedMemorySize, (int)kDynLds);
        hipOccupancyMaxActiveBlocksPerMultiprocessor(&per_cu, mega, 512, kDynLds);
        if (per_cu < 1) per_cu = 1;
        if (per_cu > 1) per_cu = 1;
        grid_blocks = cus * per_cu;
    }
    Params p{};
    const float** pp = (const float**)&p;
    for (int i = 0; i < 30; ++i) pp[i] = (const float*)d_in[i];
    p.out = (float*)d_out; p.ws = (unsigned char*)d_ws;
    if (ws_size < OFF_END) { fprintf(stderr, "workspace too small: %zu < %zu\n", ws_size, (size_t)OFF_END); }
    void* args[] = {&p};
    hipError_t e = hipLaunchCooperativeKernel((void*)mega, dim3(grid_blocks), dim3(512), args, kDynLds, stream);
    if (e != hipSuccess) fprintf(stderr, "cooperative launch failed: %s (grid %d)\n", hipGetErrorString(e), grid_blocks);
}

#ifdef TESTK
__global__ __launch_bounds__(512, 2) void tk(Params P) {
    extern __shared__ __attribute__((aligned(16))) unsigned char shm[];
    LAS unsigned char* lds = (LAS unsigned char*)shm;
    const int G = gridDim.x, c = blockIdx.x; unsigned char* ws = P.ws; float* X = P.out; bf16_t* H = (bf16_t*)(ws + OFF_H);
    const float* mod = (const float*)(ws + OFF_MOD); int l = 0;
#if TESTK == 1
        { Sched S{(const char*)H, (const char*)(ws + OFF_WUP), 1024, 1024, 0, 48, 22, G, c};
          EpiBf E{(bf16_t*)(ws + OFF_U), 5632};
          gemm_phase(lds, S, 1024, E); }
#elif TESTK == 2
        { Sched S{(const char*)(ws + OFF_ACT), (const char*)(ws + OFF_WDN), 2816, 2816, 0, 48, 4, G, c};
          EpiRes E{X, mod, 5120};
          gemm_phase(lds, S, 2816, E); }
#elif TESTK == 3
        { Sched S{(const char*)H, (const char*)(ws + OFF_WIN), 1024, 1024, 0, 48, 14, G, c};
          EpiIn E{(bf16_t*)(ws + OFF_XAQ), (bf16_t*)(ws + OFF_XC), (bf16_t*)(ws + OFF_KB), (bf16_t*)(ws + OFF_VB), P.out + OUT_K, P.out + OUT_V, l};
          gemm_phase(lds, S, 1024, E); }
#elif TESTK == 4
            { int j = 1; const char* Aj = (const char*)(ws + (j == 0 ? OFF_YA : (j == 1 ? OFF_YB : OFF_XC)));
              Sched S{Aj, (const char*)(ws + OFF_WBR) + (size_t)j * 1024 * 1024 * 2, 1024, 1024, 0, 48, 4, G, c};
              EpiBranch E{(const bf16_t*)(ws + OFF_GT), (float*)(ws + OFF_XAQ), (bf16_t*)(ws + OFF_PL), P.x_prompt[0] > 0 ? 1 : 2};
              gemm_phase(lds, S, 1024, E); }
#elif TESTK == 5
        attn_unit(P, l, c, lds);
#elif TESTK == 6
        lru_unit<0>(P, l, c >> 3, 0, c & 7, lds);
#elif TESTK == 7
        lru_unit<1>(P, l, 32, c >> 3, c & 7, lds);
#elif TESTK == 8
            { Sched S{(const char*)H, (const char*)(ws + OFF_WIN) + (size_t)(3584 + 1 * 1024) * 1024 * 2, 1024, 1024, 0, 48, 4, G, c};
              EpiGate E{(bf16_t*)(ws + OFF_GT), P.b_gate + l * 3072 + 1 * 1024};
              gemm_phase(lds, S, 1024, E); }
#elif TESTK == 9
        { Sched S{(const char*)(ws + OFF_PL), (const char*)(ws + OFF_PW), 1024, 256, 256, 48, 4, G, c};
          EpiPool E{(bf16_t*)(ws + OFF_XC), P.pool_scale + l * 1024};
          gemm_phase(lds, S, 256, E); }
#endif
}
#endif
```

```cpp
#include <hip/hip_runtime.h>
#include <hip/hip_cooperative_groups.h>
#include <cstdio>
namespace cg = cooperative_groups;

#define LAS __attribute__((address_space(3)))
typedef unsigned short bf16_t;
typedef short bf16x8 __attribute__((ext_vector_type(8)));
typedef float f32x4 __attribute__((ext_vector_type(4)));
typedef unsigned u32x4 __attribute__((ext_vector_type(4)));
typedef unsigned u32x2 __attribute__((ext_vector_type(2)));
typedef short bf16x4 __attribute__((ext_vector_type(4)));

constexpr int MROWS = 12288, MCTX = 8192;
constexpr size_t S24 = (size_t)MROWS * 1024 * 2;
constexpr size_t OFF_WIN = 0;
constexpr size_t OFF_WBR = OFF_WIN + (size_t)6656 * 1024 * 2;
constexpr size_t OFF_WOUT = OFF_WBR + (size_t)3 * 1024 * 1024 * 2;
constexpr size_t OFF_WUP = OFF_WOUT + (size_t)1024 * 1024 * 2;
constexpr size_t OFF_WDN = OFF_WUP + (size_t)5632 * 1024 * 2;
constexpr size_t OFF_GW = OFF_WDN + (size_t)1024 * 2816 * 2;
constexpr size_t OFF_PW = OFF_GW + (size_t)2 * 8 * 256 * 128 * 2;
constexpr size_t OFF_MOD = OFF_PW + (size_t)4 * 256 * 256 * 2;
constexpr size_t OFF_CK = OFF_MOD + (size_t)2 * 3 * 6144 * 4;
constexpr size_t OFF_CV = OFF_CK + (size_t)2 * 2 * 512 * 256 * 2;
constexpr size_t OFF_ROPE = OFF_CV + (size_t)2 * 2 * 512 * 256 * 2;
constexpr size_t OFF_SUMM = OFF_ROPE + (size_t)2 * 64 * 32 * 4;
constexpr size_t OFF_BAR = OFF_SUMM + (size_t)2 * 2 * 8 * 1024 * 2 * 4;
constexpr size_t OFF_ACT0 = OFF_BAR + 16384;
constexpr size_t OFF_XAQ = OFF_ACT0;
constexpr size_t OFF_XC = OFF_XAQ + 2 * S24;
constexpr size_t OFF_KB = OFF_XC + S24;
constexpr size_t OFF_VB = OFF_KB + (size_t)MROWS * 256 * 2;
constexpr size_t OFF_GT = OFF_VB + (size_t)MROWS * 256 * 2;
constexpr size_t OFF_YB = OFF_GT + S24;
constexpr size_t OFF_PL = OFF_YB + S24;
constexpr size_t OFF_YA = OFF_PL + S24;
constexpr size_t OFF_H = OFF_YA + S24;
constexpr size_t OFF_END = OFF_H + S24;
constexpr size_t OFF_U = OFF_XAQ;
constexpr size_t OFF_ACT = OFF_PL;
constexpr size_t OUT_K = (size_t)MROWS * 1024;
constexpr size_t OUT_V = OUT_K + (size_t)32 * 2 * 256 * 256;
constexpr size_t OUT_H = OUT_V + (size_t)32 * 2 * 256 * 256;

struct Params {
    const float *x_prompt, *x_sample, *cache_k, *cache_v, *state_lru, *c, *c_ctx, *w_ada, *b_ada, *norm1, *norm2,
        *w_in, *b_gate, *lru_conv, *lru_conv_b, *lru_wa, *lru_ba, *lru_wx, *lru_bx, *lru_lambda, *attn_sink,
        *pool_w, *pool_scale, *w_branch, *w_out, *ffn_up, *ffn_conv, *ffn_conv_b, *ffn_down, *final_norm;
    float* out; unsigned char* ws;
};

__device__ __forceinline__ unsigned short f2bf(float f) { unsigned u = __float_as_uint(f); u += 0x7FFFu + ((u >> 16) & 1u); return (unsigned short)(u >> 16); }
__device__ __forceinline__ float bf2f(unsigned short b) { return __uint_as_float(((unsigned)b) << 16); }
__device__ __forceinline__ unsigned pack2(float a, float b) { return (unsigned)f2bf(a) | ((unsigned)f2bf(b) << 16); }
__device__ __forceinline__ int otid() { int t = threadIdx.x; asm volatile("" : "+v"(t)); return t; }
__device__ __forceinline__ float sigmoidf_(float x) { return __builtin_amdgcn_rcpf(1.0f + __expf(-x)); }

constexpr int HTB = 128 * 64 * 2;
__device__ __forceinline__ int lds_byte(int r, int c) { const int st = (r >> 4) * 2 + (c >> 5), rr = r & 15, cc = c & 31, ob = rr * 64 + cc * 2; return st * 1024 + (ob ^ (((ob >> 9) & 1) << 5)); }
__device__ __forceinline__ void stage_rc(int b, int& R, int& C) { const int st = b / 1024, sb = b % 1024, swz = sb ^ (((sb >> 9) & 1) << 5); R = (st >> 1) * 16 + swz / 64; C = (st & 1) * 32 + (swz % 64) / 2; }

struct Unit { const char* a; const char* b; int pm, pn; };
struct Sched {
    const char* A; const char* B; int lda, ldb, acol, nM, nN, G, c;
    __device__ __forceinline__ bool next(int i, Unit& u) const {
        const long L = (long)i * G + c; const int nwg = nM * nN; if (L >= nwg) return false;
        int wgid = (int)L; { const int q = nwg / 8, r = nwg % 8, xcd = wgid % 8, off = wgid / 8; wgid = (xcd < r ? xcd * (q + 1) : r * (q + 1) + (xcd - r) * q) + off; }
        const int nig = 8 * nN, gid = wgid / nig, fm = gid * 8, gsz = (nM - fm) < 8 ? (nM - fm) : 8;
        u.pm = fm + ((wgid % nig) % gsz); u.pn = (wgid % nig) / gsz;
        u.a = A + ((size_t)u.pm * 256 * lda + (size_t)u.pn * acol) * 2; u.b = B + (size_t)u.pn * 256 * ldb * 2; return true;
    }
};

template <class Epi>
__device__ __forceinline__ void gemm_phase(LAS unsigned char* lds, const Sched& S, const int K_, const Epi& E) {
    int K = K_; asm volatile("" : "+s"(K));
    int tid_ = threadIdx.x; asm volatile("" : "+v"(tid_));
    const int tid = tid_, wid = __builtin_amdgcn_readfirstlane(tid >> 6), lane = tid & 63, wr = wid >> 2, wc = wid & 3, fr = lane & 15, fq = lane >> 4;
    const int nt = K / 64;
    unsigned voffA[2], voffB[2];
#pragma unroll
    for (int i = 0; i < 2; ++i) { int R, C; stage_rc(tid * 16 + i * 8192, R, C); voffA[i] = (unsigned)(R * S.lda + C) * 2u; voffB[i] = (unsigned)(R * S.ldb + C) * 2u; }
    const size_t kstep = 128;
    const size_t hstepA = (size_t)128 * S.lda * 2, hstepB = (size_t)128 * S.ldb * 2;
    const unsigned ldsw = (unsigned)wid * 1024u;
    const int aoff = lds_byte(wr * 64 + fr, fq * 8), boff = lds_byte(wc * 32 + fr, fq * 8);
#define G_SA(b, h) (((b) * 2 + (h)) * HTB)
#define G_SB(b, h) ((4 + (b) * 2 + (h)) * HTB)
#define G_STAGE(bufoff, gbase, voff) do { _Pragma("unroll") for (int _i = 0; _i < 2; ++_i) \
        __builtin_amdgcn_global_load_lds((const unsigned*)((const char*)(gbase) + (voff)[_i]), (LAS unsigned*)(lds + (bufoff) + ldsw + _i * 8192), 16, 0, 0); } while (0)
#define G_LDA(dst, b, h) do { _Pragma("unroll") for (int m = 0; m < 4; ++m) _Pragma("unroll") for (int k = 0; k < 2; ++k) dst[m][k] = *(const LAS bf16x8*)(lds + G_SA(b, h) + aoff + m * 2048 + k * 1024); } while (0)
#define G_LDB(dst, b, h) do { _Pragma("unroll") for (int n = 0; n < 2; ++n) _Pragma("unroll") for (int k = 0; k < 2; ++k) dst[n][k] = *(const LAS bf16x8*)(lds + G_SB(b, h) + boff + n * 2048 + k * 1024); } while (0)
#define G_MMA(ai, bj, At, Bt) do { __builtin_amdgcn_s_setprio(1); _Pragma("unroll") for (int m = 0; m < 4; ++m) _Pragma("unroll") for (int n = 0; n < 2; ++n) _Pragma("unroll") for (int k = 0; k < 2; ++k) \
        acc[ai][bj][m][n] = __builtin_amdgcn_mfma_f32_16x16x32_bf16(Bt[n][k], At[m][k], acc[ai][bj][m][n], 0, 0, 0); __builtin_amdgcn_s_setprio(0); } while (0)
#define G_WAIT_V(n) asm volatile("s_waitcnt vmcnt(" #n ")" ::: "memory")
#define G_WAIT_L(n) asm volatile("s_waitcnt lgkmcnt(" #n ")" ::: "memory")
#define G_BAR __builtin_amdgcn_s_barrier()
#define G_SCHED __builtin_amdgcn_sched_barrier(0)
    Unit cur, nxt; int ui = 0;
    if (!S.next(0, cur)) return;
    f32x4 acc[2][2][4][2];
#pragma unroll
    for (int a = 0; a < 2; ++a)
#pragma unroll
        for (int b = 0; b < 2; ++b)
#pragma unroll
            for (int m = 0; m < 4; ++m)
#pragma unroll
                for (int n = 0; n < 2; ++n) acc[a][b][m][n] = (f32x4){0.f, 0.f, 0.f, 0.f};
    bf16x8 At[4][2], B0[2][2], B1[2][2];
    const char* cA = cur.a; const char* cB = cur.b;
    G_STAGE(G_SB(0, 0), cB, voffB); G_STAGE(G_SA(0, 0), cA, voffA); G_STAGE(G_SB(0, 1), cB + hstepB, voffB); G_STAGE(G_SA(0, 1), cA + hstepA, voffA);
    if (wr == 1) G_BAR;
    G_WAIT_V(4); G_BAR;
    G_STAGE(G_SB(1, 0), cB + kstep, voffB); G_STAGE(G_SA(1, 0), cA + kstep, voffA); G_STAGE(G_SB(1, 1), cB + hstepB + kstep, voffB);
    G_WAIT_V(6); G_BAR;
    for (;;) {
        const bool has_next = S.next(ui + 1, nxt);
        const char* nA = has_next ? nxt.a : cA; const char* nB = has_next ? nxt.b : cB;
        for (int t = 0; t < nt; t += 2) {
            const bool last = (t == nt - 2);
            const char* a1 = cA + (size_t)(t + 1) * kstep;
            const char* a2 = last ? nA : cA + (size_t)(t + 2) * kstep; const char* b2 = last ? nB : cB + (size_t)(t + 2) * kstep;
            const char* a3 = a2 + kstep; const char* b3 = b2 + kstep;
            G_LDB(B0, 0, 0); G_SCHED; G_LDA(At, 0, 0); G_STAGE(G_SA(1, 1), a1 + hstepA, voffA);
            G_WAIT_L(8); G_BAR; G_WAIT_L(0); G_MMA(0, 0, At, B0); G_BAR; G_SCHED;
            G_LDB(B1, 0, 1); G_STAGE(G_SB(0, 0), b2, voffB);
            G_BAR; G_WAIT_L(0); G_MMA(0, 1, At, B1); G_BAR;
            G_LDA(At, 0, 1); G_STAGE(G_SA(0, 0), a2, voffA);
            G_BAR; G_WAIT_L(0); G_MMA(1, 0, At, B0); G_BAR; G_SCHED;
            G_STAGE(G_SB(0, 1), b2 + hstepB, voffB);
            G_WAIT_V(6); G_BAR; G_MMA(1, 1, At, B1); G_BAR;
            G_LDB(B0, 1, 0); G_SCHED; G_LDA(At, 1, 0); G_STAGE(G_SA(0, 1), a2 + hstepA, voffA);
            G_WAIT_L(8); G_BAR; G_WAIT_L(0); G_MMA(0, 0, At, B0); G_BAR; G_SCHED;
            G_LDB(B1, 1, 1); G_STAGE(G_SB(1, 0), b3, voffB);
            G_BAR; G_WAIT_L(0); G_MMA(0, 1, At, B1); G_BAR;
            G_LDA(At, 1, 1); G_STAGE(G_SA(1, 0), a3, voffA);
            G_BAR; G_WAIT_L(0); G_MMA(1, 0, At, B0); G_BAR; G_SCHED;
            G_STAGE(G_SB(1, 1), b3 + hstepB, voffB);
            G_WAIT_V(6); G_BAR; G_MMA(1, 1, At, B1); G_BAR;
        }
        E(acc, cur, wr, wc, fr, fq);
        if (!has_next) break;
#pragma unroll
        for (int a = 0; a < 2; ++a)
#pragma unroll
            for (int b = 0; b < 2; ++b)
#pragma unroll
                for (int m = 0; m < 4; ++m)
#pragma unroll
                    for (int n = 0; n < 2; ++n) acc[a][b][m][n] = (f32x4){0.f, 0.f, 0.f, 0.f};
        cur = nxt; cA = nA; cB = nB; ++ui;
    }
    G_WAIT_V(0);
    if (wr == 0) G_BAR;
    G_BAR;
#undef G_SA
#undef G_SB
#undef G_STAGE
#undef G_LDA
#undef G_LDB
#undef G_MMA
#undef G_WAIT_V
#undef G_WAIT_L
#undef G_BAR
#undef G_SCHED
}

#define EPI_LOOP_BEGIN \
    _Pragma("unroll") for (int ai = 0; ai < 2; ++ai) _Pragma("unroll") for (int m = 0; m < 4; ++m) { const int row = u.pm * 256 + wr * 64 + fr + ai * 128 + m * 16; \
    _Pragma("unroll") for (int bj = 0; bj < 2; ++bj) _Pragma("unroll") for (int n = 0; n < 2; ++n) { const int cl = wc * 32 + 4 * fq + bj * 128 + n * 16; const f32x4 v = acc[ai][bj][m][n];
#define EPI_LOOP_END } }

__device__ __forceinline__ int seq_group(int row) { return row < MCTX ? 0 : 1 + ((row - MCTX) >> 11); }

struct EpiIn {
    bf16_t* xaq; bf16_t* xc; bf16_t* kb; bf16_t* vb; float* outk; float* outv; int l;
    __device__ __forceinline__ void operator()(const f32x4 (&acc)[2][2][4][2], const Unit& u, int wr, int wc, int fr, int fq) const {
        bf16_t* dst; int ld, cbase; float* fo = nullptr;
        if (u.pn < 4) { dst = xaq; ld = 1024; cbase = u.pn * 256; }
        else if (u.pn < 8) { dst = xaq + (size_t)MROWS * 1024; ld = 1024; cbase = u.pn * 256 - 1024; }
        else if (u.pn == 8) { dst = kb; ld = 256; cbase = 0; fo = outk; }
        else if (u.pn == 9) { dst = vb; ld = 256; cbase = 0; fo = outv; }
        else { dst = xc; ld = 1024; cbase = u.pn * 256 - 2560; }
        EPI_LOOP_BEGIN
            const int col = cbase + cl;
            uint2 pk; pk.x = pack2(v[0], v[1]); pk.y = pack2(v[2], v[3]);
            *(uint2*)(dst + (size_t)row * ld + col) = pk;
            if (fo != nullptr && row < MCTX) { const int b = row >> 8, t = row & 255; *(f32x4*)(fo + ((size_t)((b * 2 + l) * 256 + t)) * 256 + col) = v; }
        EPI_LOOP_END
    }
};
struct EpiGate {
    bf16_t* gt; const float* bias;
    __device__ __forceinline__ void operator()(const f32x4 (&acc)[2][2][4][2], const Unit& u, int wr, int wc, int fr, int fq) const {
        EPI_LOOP_BEGIN
            const int col = u.pn * 256 + cl;
            const f32x4 bb = *(const f32x4*)(bias + col);
            uint2 pk; pk.x = pack2(sigmoidf_(v[0] + bb[0]), sigmoidf_(v[1] + bb[1])); pk.y = pack2(sigmoidf_(v[2] + bb[2]), sigmoidf_(v[3] + bb[3]));
            *(uint2*)(gt + (size_t)row * 1024 + col) = pk;
        EPI_LOOP_END
    }
};
struct EpiBranch {
    const bf16_t* gt; float* tmp; bf16_t* mg; int j;
    __device__ __forceinline__ void operator()(const f32x4 (&acc)[2][2][4][2], const Unit& u, int wr, int wc, int fr, int fq) const {
        EPI_LOOP_BEGIN
            const int col = u.pn * 256 + cl;
            const uint2 gp = *(const uint2*)(gt + (size_t)row * 1024 + col);
            f32x4 r;
            r[0] = v[0] * bf2f((unsigned short)(gp.x & 0xffff)); r[1] = v[1] * bf2f((unsigned short)(gp.x >> 16));
            r[2] = v[2] * bf2f((unsigned short)(gp.y & 0xffff)); r[3] = v[3] * bf2f((unsigned short)(gp.y >> 16));
            float* tp = tmp + (size_t)row * 1024 + col;
            if (j == 0) { *(f32x4*)tp = r; }
            else if (j == 1) { f32x4 o = *(const f32x4*)tp; *(f32x4*)tp = o + r; }
            else { f32x4 o = *(const f32x4*)tp; o = o + r; uint2 pk; pk.x = pack2(o[0], o[1]); pk.y = pack2(o[2], o[3]); *(uint2*)(mg + (size_t)row * 1024 + col) = pk; }
        EPI_LOOP_END
    }
};
struct EpiRes {
    float* x; const float* mod; int goff;
    __device__ __forceinline__ void operator()(const f32x4 (&acc)[2][2][4][2], const Unit& u, int wr, int wc, int fr, int fq) const {
        const float* g = mod + seq_group(u.pm * 256) * 6144 + goff;
        EPI_LOOP_BEGIN
            const int col = u.pn * 256 + cl;
            const f32x4 gg = *(const f32x4*)(g + col);
            float* xp = x + (size_t)row * 1024 + col;
            f32x4 o = *(const f32x4*)xp;
            *(f32x4*)xp = o + gg * v;
        EPI_LOOP_END
    }
};
struct EpiBf {
    bf16_t* dst; int ld;
    __device__ __forceinline__ void operator()(const f32x4 (&acc)[2][2][4][2], const Unit& u, int wr, int wc, int fr, int fq) const {
        EPI_LOOP_BEGIN
            const int col = u.pn * 256 + cl;
            uint2 pk; pk.x = pack2(v[0], v[1]); pk.y = pack2(v[2], v[3]);
            *(uint2*)(dst + (size_t)row * ld + col) = pk;
        EPI_LOOP_END
    }
};
struct EpiPool {
    bf16_t* dst; const float* scale;
    __device__ __forceinline__ void operator()(const f32x4 (&acc)[2][2][4][2], const Unit& u, int wr, int wc, int fr, int fq) const {
        EPI_LOOP_BEGIN
            const int col = u.pn * 256 + cl;
            const f32x4 s = *(const f32x4*)(scale + col);
            uint2 pk; pk.x = pack2(v[0] * s[0], v[1] * s[1]); pk.y = pack2(v[2] * s[2], v[3] * s[3]);
            *(uint2*)(dst + (size_t)row * 1024 + col) = pk;
        EPI_LOOP_END
    }
};

__device__ __forceinline__ void transpose_tile(const float* __restrict__ src, int lds_, bf16_t* __restrict__ dst, int ldd, int k0, int n0, LAS unsigned char* lds) {
    LAS bf16_t* sm = (LAS bf16_t*)lds;
    const int tid = otid();
#pragma unroll
    for (int i = 0; i < 2; ++i) {
        const int idx = tid + i * 512, kk = idx >> 4, n4 = (idx & 15) * 4;
        const float4 v = *(const float4*)(src + (size_t)(k0 + kk) * lds_ + n0 + n4);
        sm[(n4 + 0) * 72 + kk] = f2bf(v.x); sm[(n4 + 1) * 72 + kk] = f2bf(v.y); sm[(n4 + 2) * 72 + kk] = f2bf(v.z); sm[(n4 + 3) * 72 + kk] = f2bf(v.w);
    }
    __syncthreads();
    { const int nn = tid >> 3, ck = tid & 7;
      const u32x4 v = *(const LAS u32x4*)(sm + nn * 72 + ck * 8);
      *(u32x4*)(dst + (size_t)(n0 + nn) * ldd + k0 + ck * 8) = v; }
    __syncthreads();
}
__device__ void convert_weights(const Params& P, int l, LAS unsigned char* lds) {
    unsigned char* ws = P.ws;
    for (int t = blockIdx.x; t < 4992; t += gridDim.x) {
        const float* src; int lds_; bf16_t* dst; int ldd, k0, n0; int r = t;
        if (r < 1664) { src = P.w_in + (size_t)l * 1024 * 6656; lds_ = 6656; dst = (bf16_t*)(ws + OFF_WIN); ldd = 1024; k0 = (r / 104) * 64; n0 = (r % 104) * 64; }
        else if ((r -= 1664) < 768) { const int j = r / 256; r %= 256; src = P.w_branch + (size_t)(l * 3 + j) * 1024 * 1024; lds_ = 1024; dst = (bf16_t*)(ws + OFF_WBR) + (size_t)j * 1024 * 1024; ldd = 1024; k0 = (r / 16) * 64; n0 = (r % 16) * 64; }
        else if ((r -= 768) < 256) { src = P.w_out + (size_t)l * 1024 * 1024; lds_ = 1024; dst = (bf16_t*)(ws + OFF_WOUT); ldd = 1024; k0 = (r / 16) * 64; n0 = (r % 16) * 64; }
        else if ((r -= 256) < 1408) { src = P.ffn_up + (size_t)l * 1024 * 5632; lds_ = 5632; dst = (bf16_t*)(ws + OFF_WUP); ldd = 1024; k0 = (r / 88) * 64; n0 = (r % 88) * 64; }
        else if ((r -= 1408) < 704) { src = P.ffn_down + (size_t)l * 2816 * 1024; lds_ = 1024; dst = (bf16_t*)(ws + OFF_WDN); ldd = 2816; k0 = (r / 16) * 64; n0 = (r % 16) * 64; }
        else if ((r -= 704) < 128) { const int mat = r / 64; r %= 64; const int dh = r / 4; r %= 4;
            src = (mat ? P.lru_wx : P.lru_wa) + (size_t)(l * 16 + dh) * 128 * 128; lds_ = 128; dst = (bf16_t*)(ws + OFF_GW) + (size_t)dh * 256 * 128 + (size_t)mat * 128 * 128; ldd = 128; k0 = (r / 2) * 64; n0 = (r % 2) * 64; }
        else { r -= 128; const int g = r / 16; r %= 16; src = P.pool_w + (size_t)(l * 4 + g) * 256 * 256; lds_ = 256; dst = (bf16_t*)(ws + OFF_PW) + (size_t)g * 256 * 256; ldd = 256; k0 = (r / 4) * 64; n0 = (r % 4) * 64; }
        transpose_tile(src, lds_, dst, ldd, k0, n0, lds);
    }
}

__device__ void phase0(const Params& P, LAS unsigned char* lds) {
    const int tid = otid(), G = gridDim.x, c = blockIdx.x;
    { const size_t n4 = (size_t)MROWS * 1024 / 4, nc4 = (size_t)MCTX * 1024 / 4;
      for (size_t i = (size_t)c * 512 + tid; i < n4; i += (size_t)G * 512) {
          const float4 v = i < nc4 ? ((const float4*)P.x_prompt)[i] : ((const float4*)P.x_sample)[i - nc4];
          ((float4*)P.out)[i] = v; } }
    { bf16_t* ck = (bf16_t*)(P.ws + OFF_CK); bf16_t* cv = (bf16_t*)(P.ws + OFF_CV);
      for (int i = c * 512 + tid; i < 2 * 2 * 512 * 256; i += G * 512) {
          const int e = i & 255, t = (i >> 8) & 511, b = (i >> 17) & 1, l = i >> 18;
          const size_t si = ((size_t)((b * 2 + l) * 512 + t)) * 256 + e;
          ck[i] = f2bf(P.cache_k[si]); cv[i] = f2bf(P.cache_v[si]); } }
    { float* rc = (float*)(P.ws + OFF_ROPE); float* rs = rc + 2048;
      for (int i = c * 512 + tid; i < 2048; i += G * 512) {
          const int pos = i >> 5, k = i & 31; const float fr = powf(10000.0f, -(float)k / 32.0f); const float ang = (float)pos * fr;
          rc[i] = cosf(ang); rs[i] = sinf(ang); } }
    { LAS float* sv = (LAS float*)lds;
      LAS float* red = sv + 3072;
      __syncthreads();
      for (int i = tid; i < 3072; i += 512) { const int s = i >> 10, k = i & 1023; const float x = s == 0 ? P.c_ctx[k] : P.c[(s - 1) * 1024 + k]; sv[i] = x / (1.0f + expf(-x)); }
      __syncthreads();
      float* mod = (float*)(P.ws + OFF_MOD);
      for (int it = c; it < 384; it += G) {
          const int l = it / 192, cg_ = it % 192, cl = tid & 31, kg = tid >> 5, col = cg_ * 32 + cl;
          const float* w = P.w_ada + (size_t)l * 1024 * 6144 + col;
          float a0 = 0.f, a1 = 0.f, a2 = 0.f;
#pragma unroll 16
          for (int k = kg * 64; k < kg * 64 + 64; ++k) { const float wv = w[(size_t)k * 6144]; a0 += sv[k] * wv; a1 += sv[1024 + k] * wv; a2 += sv[2048 + k] * wv; }
          red[(kg * 3 + 0) * 32 + cl] = a0; red[(kg * 3 + 1) * 32 + cl] = a1; red[(kg * 3 + 2) * 32 + cl] = a2;
          __syncthreads();
          if (tid < 96) { const int s = tid >> 5, cc = tid & 31; float sum = 0.f;
#pragma unroll
              for (int g = 0; g < 16; ++g) sum += red[(g * 3 + s) * 32 + cc];
              mod[(size_t)(l * 3 + s) * 6144 + cg_ * 32 + cc] = sum + P.b_ada[l * 6144 + cg_ * 32 + cc]; }
          __syncthreads();
      } }
}

__device__ void norm_phase(const float* __restrict__ X, const float* __restrict__ gw, const float* __restrict__ mod, int shift_off, int scale_off, bf16_t* __restrict__ H) {
    const int tid = otid(); const int lane = tid & 63, wv = blockIdx.x * 8 + (tid >> 6), nw = gridDim.x * 8;
    for (int row = wv; row < MROWS; row += nw) {
        const float* md = mod + seq_group(row) * 6144;
        f32x4 v[4]; float ss = 0.f;
#pragma unroll
        for (int i = 0; i < 4; ++i) { v[i] = *(const f32x4*)(X + (size_t)row * 1024 + i * 256 + lane * 4); ss += v[i][0] * v[i][0] + v[i][1] * v[i][1] + v[i][2] * v[i][2] + v[i][3] * v[i][3]; }
#pragma unroll
        for (int o = 32; o >= 1; o >>= 1) ss += __shfl_xor(ss, o);
        const float rstd = rsqrtf(ss * (1.0f / 1024.0f) + 1e-6f);
#pragma unroll
        for (int i = 0; i < 4; ++i) { const int col = i * 256 + lane * 4;
            const f32x4 g = *(const f32x4*)(gw + col), sc = *(const f32x4*)(md + scale_off + col), sh = *(const f32x4*)(md + shift_off + col);
            f32x4 h;
#pragma unroll
            for (int e = 0; e < 4; ++e) h[e] = v[i][e] * rstd * g[e] * (1.0f + sc[e]) + sh[e];
            uint2 pk; pk.x = pack2(h[0], h[1]); pk.y = pack2(h[2], h[3]);
            *(uint2*)(H + (size_t)row * 1024 + col) = pk; }
    }
}
__device__ void final_norm_phase(float* X, const float* __restrict__ gw) {
    const int tid = otid(); const int lane = tid & 63, wv = blockIdx.x * 8 + (tid >> 6), nw = gridDim.x * 8;
    for (int row = wv; row < MROWS; row += nw) {
        f32x4 v[4]; float ss = 0.f;
#pragma unroll
        for (int i = 0; i < 4; ++i) { v[i] = *(const f32x4*)(X + (size_t)row * 1024 + i * 256 + lane * 4); ss += v[i][0] * v[i][0] + v[i][1] * v[i][1] + v[i][2] * v[i][2] + v[i][3] * v[i][3]; }
#pragma unroll
        for (int o = 32; o >= 1; o >>= 1) ss += __shfl_xor(ss, o);
        const float rstd = rsqrtf(ss * (1.0f / 1024.0f) + 1e-6f);
#pragma unroll
        for (int i = 0; i < 4; ++i) { const int col = i * 256 + lane * 4; const f32x4 g = *(const f32x4*)(gw + col);
            f32x4 h;
#pragma unroll
            for (int e = 0; e < 4; ++e) h[e] = v[i][e] * rstd * g[e];
            *(f32x4*)(X + (size_t)row * 1024 + col) = h; }
    }
}

__device__ void pool_phase(const bf16_t* __restrict__ XC, bf16_t* __restrict__ PL) {
    const int tid = otid();
    for (int idx = blockIdx.x * 512 + tid; idx < MROWS * 128; idx += gridDim.x * 512) {
        const int row = idx >> 7, ch = (idx & 127) * 8, g = ch >> 8, half = 1 << g;
        const int T = row < MCTX ? 256 : 2048, row0 = row < MCTX ? (row & ~255) : MCTX + ((row - MCTX) & ~2047), tl = row - row0;
        const int lo = max(tl - half, 0), hi = min(tl + half, T);
        float s[8];
#pragma unroll
        for (int e = 0; e < 8; ++e) s[e] = 0.f;
        for (int t = lo; t < hi; ++t) { const bf16x8 x = *(const bf16x8*)(XC + (size_t)(row0 + t) * 1024 + ch);
#pragma unroll
            for (int e = 0; e < 8; ++e) s[e] += bf2f((unsigned short)x[e]); }
        const bf16x8 xs = *(const bf16x8*)(XC + (size_t)row * 1024 + ch);
        const float inv = 1.0f / (float)(hi - lo);
        uint4 o; o.x = pack2(s[0] * inv - bf2f((unsigned short)xs[0]), s[1] * inv - bf2f((unsigned short)xs[1])); o.y = pack2(s[2] * inv - bf2f((unsigned short)xs[2]), s[3] * inv - bf2f((unsigned short)xs[3]));
        o.z = pack2(s[4] * inv - bf2f((unsigned short)xs[4]), s[5] * inv - bf2f((unsigned short)xs[5])); o.w = pack2(s[6] * inv - bf2f((unsigned short)xs[6]), s[7] * inv - bf2f((unsigned short)xs[7]));
        *(uint4*)(PL + (size_t)row * 1024 + ch) = o;
    }
}
__device__ __forceinline__ float gelu_tanh(float x) { const float y = 0.7978845608028654f * (x + 0.044715f * x * x * x); const float t = 1.0f - 2.0f * __builtin_amdgcn_rcpf(1.0f + __expf(2.0f * y)); return 0.5f * x * (1.0f + t); }
__device__ void act_phase(const bf16_t* __restrict__ U, bf16_t* __restrict__ ACT, const float* __restrict__ cw, const float* __restrict__ cb) {
    const int tid = otid();
    for (int idx = blockIdx.x * 512 + tid; idx < MROWS * 352; idx += gridDim.x * 512) {
        const int row = idx / 352, ch = (idx % 352) * 8;
        const int T = row < MCTX ? 256 : 2048, row0 = row < MCTX ? (row & ~255) : MCTX + ((row - MCTX) & ~2047), tl = row - row0;
        const bf16_t* up = U + (size_t)row * 5632 + ch;
        const bf16x8 u0 = *(const bf16x8*)up, vv = *(const bf16x8*)(up + 2816);
        bf16x8 um = (bf16x8){0, 0, 0, 0, 0, 0, 0, 0}, upn = um;
        if (tl > 0) um = *(const bf16x8*)(up - 5632);
        if (tl < T - 1) upn = *(const bf16x8*)(up + 5632);
        float r[8];
#pragma unroll
        for (int e = 0; e < 8; ++e) { const float gff = cw[ch + e] * bf2f((unsigned short)um[e]) + cw[2816 + ch + e] * bf2f((unsigned short)u0[e]) + cw[5632 + ch + e] * bf2f((unsigned short)upn[e]) + cb[ch + e];
            r[e] = gelu_tanh(gff) * bf2f((unsigned short)vv[e]); }
        uint4 o; o.x = pack2(r[0], r[1]); o.y = pack2(r[2], r[3]); o.z = pack2(r[4], r[5]); o.w = pack2(r[6], r[7]);
        *(uint4*)(ACT + (size_t)row * 2816 + ch) = o;
    }
}

__device__ __forceinline__ void rope8(bf16x8& x1, bf16x8& x2, const float* __restrict__ cs, const float* __restrict__ sn) {
#pragma unroll
    for (int e = 0; e < 8; ++e) { const float a = bf2f((unsigned short)x1[e]), b = bf2f((unsigned short)x2[e]); const float c = cs[e], s = sn[e];
        x1[e] = (short)f2bf(a * c - b * s); x2[e] = (short)f2bf(a * s + b * c); }
}
constexpr int VT_OFF = 64 * 272;
__device__ void attn_unit(const Params& P, int l, int u, LAS unsigned char* lds) {
    int tid_ = threadIdx.x; asm volatile("" : "+v"(tid_));
    const int tid = tid_, w = tid >> 6, lane = tid & 63, fr = lane & 15, fq = lane >> 4;
    const bf16_t* Q = (const bf16_t*)(P.ws + OFF_XAQ) + (size_t)MROWS * 1024;
    const bf16_t* KB = (const bf16_t*)(P.ws + OFF_KB); const bf16_t* VB = (const bf16_t*)(P.ws + OFF_VB);
    const bf16_t* CK = (const bf16_t*)(P.ws + OFF_CK); const bf16_t* CV = (const bf16_t*)(P.ws + OFF_CV);
    bf16_t* YB = (bf16_t*)(P.ws + OFF_YB);
    const float* rc = (const float*)(P.ws + OFF_ROPE); const float* rs = rc + 2048;
    bool lat; int head, row0, T, qstart, bidx;
    if (u < 256) { lat = true; bidx = u >> 7; const int rem = u & 127; head = rem >> 4; qstart = (rem & 15) * 128; T = 2048; row0 = MCTX + bidx * 2048; }
    else { const int v = u - 256; lat = false; bidx = 0; const int seq = v >> 4, rem = v & 15; head = rem >> 1; qstart = (rem & 1) * 128; T = 256; row0 = seq * 256; }
    const int kvh = head >> 2;
    const int qpos = qstart + w * 16 + fr;
    bf16x8 qf[4];
    { const bf16_t* qp = Q + (size_t)(row0 + qpos) * 1024 + head * 128 + fq * 8;
#pragma unroll
      for (int kk = 0; kk < 4; ++kk) qf[kk] = *(const bf16x8*)(qp + kk * 32);
      if (lat) { rope8(qf[0], qf[1], rc + (qpos >> 6) * 32 + fq * 8, rs + (qpos >> 6) * 32 + fq * 8); rope8(qf[2], qf[3], rc + (qpos & 63) * 32 + fq * 8, rs + (qpos & 63) * 32 + fq * 8); } }
    float m_run = P.attn_sink[l * 8 + head]; float l_run = (fq == 0) ? 1.0f : 0.0f;
    f32x4 o[8];
#pragma unroll
    for (int dt = 0; dt < 8; ++dt) o[dt] = (f32x4){0.f, 0.f, 0.f, 0.f};
    int wlo = 0, nwt = 4;
    if (lat) { wlo = max(0, qstart - 128); const int whi = min(T, qstart + 256); nwt = (whi - wlo) >> 6; }
    const int ntiles = nwt + (lat ? 8 : 0);
    const float scale = 0.08838834764831845f;
    for (int ti = 0; ti < ntiles; ++ti) {
        const bool win = ti < nwt; int k0; const bf16_t *ksrc, *vsrc;
        if (win) { k0 = wlo + ti * 64; ksrc = KB + (size_t)(row0 + k0) * 256 + kvh * 128; vsrc = VB + (size_t)(row0 + k0) * 256 + kvh * 128; }
        else { k0 = (ti - nwt) * 64; const size_t o_ = ((size_t)((l * 2 + bidx) * 512 + k0)) * 256 + kvh * 128; ksrc = CK + o_; vsrc = CV + o_; }
        __syncthreads();
        { const int key = tid >> 3, p = tid & 7, cidx = p < 4 ? p : p + 4;
          const bf16_t* kr = ksrc + (size_t)key * 256;
          bf16x8 x1 = *(const bf16x8*)(kr + cidx * 8), x2 = *(const bf16x8*)(kr + (cidx + 4) * 8);
          if (lat && win) { const int kp = k0 + key; const int pos = (cidx < 8) ? (kp >> 6) : (kp & 63); const int i0 = (cidx & 3) * 8; rope8(x1, x2, rc + pos * 32 + i0, rs + pos * 32 + i0); }
          *(LAS bf16x8*)(lds + key * 272 + cidx * 16) = x1; *(LAS bf16x8*)(lds + key * 272 + (cidx + 4) * 16) = x2; }
#pragma unroll
        for (int h2 = 0; h2 < 2; ++h2) { const int cidx = w + h2 * 8; const bf16x8 vv = *(const bf16x8*)(vsrc + (size_t)lane * 256 + cidx * 8);
#pragma unroll
            for (int e = 0; e < 8; ++e) *(LAS bf16_t*)(lds + VT_OFF + (cidx * 8 + e) * 144 + lane * 2) = (bf16_t)vv[e]; }
        __syncthreads();
        f32x4 s[4];
#pragma unroll
        for (int nt = 0; nt < 4; ++nt) { s[nt] = (f32x4){0.f, 0.f, 0.f, 0.f};
#pragma unroll
            for (int kk = 0; kk < 4; ++kk) { const bf16x8 a = *(const LAS bf16x8*)(lds + (nt * 16 + fr) * 272 + kk * 64 + fq * 16); s[nt] = __builtin_amdgcn_mfma_f32_16x16x32_bf16(a, qf[kk], s[nt], 0, 0, 0); } }
        float mt = -3.0e38f;
#pragma unroll
        for (int nt = 0; nt < 4; ++nt)
#pragma unroll
            for (int j = 0; j < 4; ++j) { float v = s[nt][j] * scale;
                if (lat && win) { const int kp = k0 + nt * 16 + fq * 4 + j; const int dd = qpos - kp; if (dd > 128 || dd < -128) v = -1.0e30f; }
                s[nt][j] = v; mt = fmaxf(mt, v); }
        mt = fmaxf(mt, __shfl_xor(mt, 16)); mt = fmaxf(mt, __shfl_xor(mt, 32));
        const float mn = fmaxf(m_run, mt); const float alpha = __expf(m_run - mn); m_run = mn;
        float ps = 0.f;
#pragma unroll
        for (int nt = 0; nt < 4; ++nt)
#pragma unroll
            for (int j = 0; j < 4; ++j) { const float p = __expf(s[nt][j] - mn); ps += p; s[nt][j] = p; }
        l_run = l_run * alpha + ps;
#pragma unroll
        for (int dt = 0; dt < 8; ++dt) o[dt] = o[dt] * alpha;
#pragma unroll
        for (int s2 = 0; s2 < 2; ++s2) {
            u32x4 pu; pu[0] = pack2(s[2 * s2][0], s[2 * s2][1]); pu[1] = pack2(s[2 * s2][2], s[2 * s2][3]); pu[2] = pack2(s[2 * s2 + 1][0], s[2 * s2 + 1][1]); pu[3] = pack2(s[2 * s2 + 1][2], s[2 * s2 + 1][3]);
            const bf16x8 pf = __builtin_bit_cast(bf16x8, pu);
#pragma unroll
            for (int dt = 0; dt < 8; ++dt) {
                const bf16x4 lo = *(const LAS bf16x4*)(lds + VT_OFF + (dt * 16 + fr) * 144 + (s2 * 32 + fq * 4) * 2);
                const bf16x4 hi = *(const LAS bf16x4*)(lds + VT_OFF + (dt * 16 + fr) * 144 + (s2 * 32 + 16 + fq * 4) * 2);
                const bf16x8 af = __builtin_shufflevector(lo, hi, 0, 1, 2, 3, 4, 5, 6, 7);
                o[dt] = __builtin_amdgcn_mfma_f32_16x16x32_bf16(af, pf, o[dt], 0, 0, 0);
            }
        }
    }
    float lt = l_run; lt += __shfl_xor(lt, 16); lt += __shfl_xor(lt, 32);
    const float inv = 1.0f / lt;
    bf16_t* yp = YB + (size_t)(row0 + qpos) * 1024 + head * 128 + fq * 4;
#pragma unroll
    for (int dt = 0; dt < 8; ++dt) { uint2 pk; pk.x = pack2(o[dt][0] * inv, o[dt][1] * inv); pk.y = pack2(o[dt][2] * inv, o[dt][3] * inv); *(uint2*)(yp + dt * 16) = pk; }
}

template <int MODE, int D>
__device__ __forceinline__ void lru_dir(const Params& P, int l, int s, int cchunk, int h, LAS unsigned char* lds, int w, int fr, int fq) {
    const bool lat = s >= 32; const int row0 = lat ? MCTX + (s - 32) * 2048 : s * 256; const int t0 = cchunk * 256;
    const bf16_t* GW = (const bf16_t*)(P.ws + OFF_GW);
    bf16_t* YA = (bf16_t*)(P.ws + OFF_YA);
    float* SUMM = (float*)(P.ws + OFF_SUMM);
    const int chl = 16 * w + fr, ch = h * 128 + chl;
    bf16x8 bwa[4], bwx[4];
    { const bf16_t* gp = GW + ((size_t)(D * 8 + h) * 256 + chl) * 128 + fq * 8;
#pragma unroll
      for (int kk = 0; kk < 4; ++kk) { bwa[kk] = *(const bf16x8*)(gp + kk * 32); bwx[kk] = *(const bf16x8*)(gp + 128 * 128 + kk * 32); } }
    const int pidx = (l * 2 + D) * 1024 + ch;
    const float ba = P.lru_ba[pidx], bx = P.lru_bx[pidx];
    const float lam = P.lru_lambda[pidx];
    const float c8 = -8.0f * log1pf(expf(-lam));
    float carry = 0.f;
    if (MODE == 0 && lat) {
        const int b = s - 32;
        carry = P.state_lru[((size_t)(b * 2 + l) * 2 + D) * 1024 + ch];
        if (D == 0) { for (int cc = 0; cc < cchunk; ++cc) { const float* sp = SUMM + ((size_t)((b * 2 + 0) * 8 + cc) * 1024 + ch) * 2; carry = sp[1] + sp[0] * carry; } }
        else { for (int cc = 7; cc > cchunk; --cc) { const float* sp = SUMM + ((size_t)((b * 2 + 1) * 8 + cc) * 1024 + ch) * 2; carry = sp[1] + sp[0] * carry; } }
    }
    float ptot = 1.0f;
#pragma unroll 1
    for (int sci = 0; sci < 4; ++sci) {
        const int sc = D == 0 ? sci : 3 - sci;
        f32x4 r[4], g[4];
#pragma unroll
        for (int m = 0; m < 4; ++m) { r[m] = (f32x4){0.f, 0.f, 0.f, 0.f}; g[m] = (f32x4){0.f, 0.f, 0.f, 0.f};
#pragma unroll
            for (int kk = 0; kk < 4; ++kk) { const bf16x8 a = *(const LAS bf16x8*)(lds + (sc * 64 + m * 16 + fr) * 272 + kk * 64 + fq * 16);
                r[m] = __builtin_amdgcn_mfma_f32_16x16x32_bf16(a, bwa[kk], r[m], 0, 0, 0); g[m] = __builtin_amdgcn_mfma_f32_16x16x32_bf16(a, bwx[kk], g[m], 0, 0, 0); } }
#pragma unroll
        for (int mi = 0; mi < 4; ++mi) {
            const int m = D == 0 ? mi : 3 - mi;
            float av[4], bv[4];
#pragma unroll
            for (int j = 0; j < 4; ++j) {
                const float rr = sigmoidf_(r[m][j] + ba), ii = sigmoidf_(g[m][j] + bx);
                const float la = c8 * rr; const float a = __expf(la); const float z = 2.0f * la;
                const float em = (z > -0.05f) ? -z * (1.0f + z * (0.5f + z * (0.16666667f + z * 0.041666667f))) : 1.0f - __expf(z);
                const float x = bf2f(*(const LAS bf16_t*)(lds + (sc * 64 + m * 16 + fq * 4 + j) * 272 + chl * 2));
                av[j] = a; bv[j] = sqrtf(em) * ii * x;
            }
            float p4, h4;
            p4 = av[0] * av[1] * av[2] * av[3];
            if (D == 0) h4 = ((bv[0] * av[1] + bv[1]) * av[2] + bv[2]) * av[3] + bv[3];
            else h4 = ((bv[3] * av[2] + bv[2]) * av[1] + bv[1]) * av[0] + bv[0];
            float pq[4], hq[4];
#pragma unroll
            for (int f = 0; f < 4; ++f) { pq[f] = __shfl(p4, fr + 16 * f); hq[f] = __shfl(h4, fr + 16 * f); }
            float cin = carry, mycin = 0.f;
#pragma unroll
            for (int fi = 0; fi < 4; ++fi) { const int f = D == 0 ? fi : 3 - fi; if (f == fq) mycin = cin; cin = hq[f] + pq[f] * cin; }
            carry = cin;
            if (MODE == 1) ptot *= pq[0] * pq[1] * pq[2] * pq[3];
            if (MODE == 0) {
                float hh = mycin; float y[4];
#pragma unroll
                for (int ji = 0; ji < 4; ++ji) { const int j = D == 0 ? ji : 3 - ji; hh = av[j] * hh + bv[j]; y[j] = hh; }
#pragma unroll
                for (int j = 0; j < 4; ++j) {
                    bf16_t* yp = YA + (size_t)(row0 + t0 + sc * 64 + m * 16 + fq * 4 + j) * 1024 + ch;
                    if (D == 0) *yp = f2bf(y[j]);
                    else *yp = f2bf(bf2f(*yp) + y[j]);
                }
            }
        }
    }
    if (MODE == 0 && !lat && fq == 0) P.out[OUT_H + ((size_t)(s * 2 + l) * 2 + D) * 1024 + ch] = carry;
    if (MODE == 1 && fq == 0) { float* sp = SUMM + ((size_t)(((s - 32) * 2 + D) * 8 + cchunk) * 1024 + ch) * 2; sp[0] = ptot; sp[1] = carry; }
}
template <int MODE>
__device__ void lru_unit(const Params& P, int l, int s, int cchunk, int h, LAS unsigned char* lds) {
    int tid_ = threadIdx.x; asm volatile("" : "+v"(tid_));
    const int tid = tid_, w = tid >> 6, lane = tid & 63, fr = lane & 15, fq = lane >> 4;
    const bool lat = s >= 32; const int T = lat ? 2048 : 256; const int row0 = lat ? MCTX + (s - 32) * 2048 : s * 256; const int t0 = cchunk * 256;
    const bf16_t* XA = (const bf16_t*)(P.ws + OFF_XAQ);
    __syncthreads();
    {
        const float* cw = P.lru_conv + (size_t)l * 4096; const float* cb = P.lru_conv_b + l * 1024;
#pragma unroll 1
        for (int it = 0; it < 8; ++it) {
            const int idx = tid + it * 512, t = idx >> 4, ck = idx & 15, ch = h * 128 + ck * 8;
            float a8[8];
#pragma unroll
            for (int e = 0; e < 8; ++e) a8[e] = cb[ch + e];
#pragma unroll
            for (int k = 0; k < 4; ++k) { const int tt = t0 + t + k - 2;
                if (tt >= 0 && tt < T) { const bf16x8 x = *(const bf16x8*)(XA + (size_t)(row0 + tt) * 1024 + ch);
#pragma unroll
                    for (int e = 0; e < 8; ++e) a8[e] += cw[k * 1024 + ch + e] * bf2f((unsigned short)x[e]); } }
            u32x4 o; o.x = pack2(a8[0], a8[1]); o.y = pack2(a8[2], a8[3]); o.z = pack2(a8[4], a8[5]); o.w = pack2(a8[6], a8[7]);
            *(LAS u32x4*)(lds + t * 272 + ck * 16) = o;
        }
    }
    __syncthreads();
    lru_dir<MODE, 0>(P, l, s, cchunk, h, lds, w, fr, fq);
    lru_dir<MODE, 1>(P, l, s, cchunk, h, lds, w, fr, fq);
}


#define XB_TMO      128
#define XB_XCNT(j)  (256  + 64 * (j))
#define XB_XSUB(j)  (1280 + 64 * (j))
#define XB_XGEN(j)  (2304 + 64 * (j))
#define XB_TOP      3328
#define XB_TOPGEN   3392
#define XCD_BAR_WORDS 3456
#define XB_SPIN_CAP (1u << 18)
__device__ __forceinline__ unsigned xb_ld(unsigned* p)              { return __hip_atomic_load(p, __ATOMIC_RELAXED, __HIP_MEMORY_SCOPE_AGENT); }
__device__ __forceinline__ unsigned xb_add(unsigned* p, unsigned v) { return __hip_atomic_fetch_add(p, v, __ATOMIC_RELAXED, __HIP_MEMORY_SCOPE_AGENT); }
__device__ __forceinline__ unsigned xb_xcc_id() { return (unsigned)__builtin_amdgcn_s_getreg((3 << 11) | 20) & 0xFu; }
#define XB_SPIN(cond, bar) do { unsigned _sp = 0; while (cond) { __builtin_amdgcn_s_sleep(1); \
    if ((++_sp & 255u) == 0u) { if (xb_ld(&(bar)[XB_TMO])) break; if (_sp > XB_SPIN_CAP) { atomicAdd(&(bar)[XB_TMO], 1u); break; } } } } while (0)
struct XcdBarrier { unsigned* bar; unsigned x; volatile LAS unsigned* st; };
__device__ __forceinline__ XcdBarrier xcd_barrier_post(unsigned* bar, volatile LAS unsigned* st) {
    XcdBarrier b; b.bar = bar; b.x = xb_xcc_id(); b.st = st;
    if (threadIdx.x == 0) (void)xb_add(&bar[XB_XCNT(b.x)], 1u);
    return b;
}
__device__ __forceinline__ void xcd_barrier_complete(unsigned* bar, unsigned x, unsigned& nloc, unsigned& nx) {
    const unsigned G = gridDim.x * gridDim.y * gridDim.z;
    unsigned sum, cnt, mine, sp = 0u;
    for (;;) {
        sum = 0u; cnt = 0u; mine = 0u;
#pragma unroll
        for (unsigned j = 0; j < 16; ++j) { const unsigned c = xb_ld(&bar[XB_XCNT(j)]); sum += c; cnt += (c > 0u) ? 1u : 0u; mine = (j == x) ? c : mine; }
        if (sum == G) break;
        __builtin_amdgcn_s_sleep(1);
        if ((++sp & 255u) == 0u) { if (xb_ld(&bar[XB_TMO])) break; if (sp > XB_SPIN_CAP) { atomicAdd(&bar[XB_TMO], 1u); break; } }
    }
    nloc = mine > 0u ? mine : 1u; nx = cnt > 0u ? cnt : 1u;
}
__device__ __noinline__ void xcd_barrier_(unsigned* bbar, unsigned bx, volatile LAS unsigned* bst) {
    XcdBarrier b; b.bar = bbar; b.x = bx; b.st = bst;
    asm volatile("s_waitcnt vmcnt(0)" ::: "memory");
    __syncthreads();
    if (threadIdx.x == 0) {
        unsigned* bar = b.bar;
        __builtin_amdgcn_s_waitcnt(0);
        unsigned nloc = b.st[0], nx = b.st[1];
        if (nloc == 0u) { xcd_barrier_complete(bar, b.x, nloc, nx); b.st[0] = nloc; b.st[1] = nx; }
        const unsigned old = xb_add(&bar[XB_XSUB(b.x)], 1u);
        const unsigned gen = old / nloc;
        if (old + 1u == (gen + 1u) * nloc) {
            __builtin_amdgcn_fence(__ATOMIC_RELEASE, "agent");
            asm volatile("s_waitcnt vmcnt(0)" ::: "memory");
            const unsigned og = xb_add(&bar[XB_TOP], 1u);
            const unsigned tg = og / nx;
            if (og + 1u == (tg + 1u) * nx) xb_add(&bar[XB_TOPGEN], 1u);
            else XB_SPIN(xb_ld(&bar[XB_TOPGEN]) == tg, bar);
            __builtin_amdgcn_fence(__ATOMIC_ACQUIRE, "agent");
            xb_add(&bar[XB_XGEN(b.x)], 1u);
            asm volatile("s_waitcnt vmcnt(0)" ::: "memory");
        } else {
            XB_SPIN(xb_ld(&bar[XB_XGEN(b.x)]) == gen, bar);
            __builtin_amdgcn_fence(__ATOMIC_ACQUIRE, "agent");
            asm volatile("s_waitcnt vmcnt(0)" ::: "memory");
        }
    }
    __syncthreads();
}

#ifndef REPMASK
#define REPMASK 0
#endif
#define REPLOOP(i) _Pragma("unroll 1") for (int rep_ = 0; rep_ < 1 + ((REPMASK >> (i)) & 1); ++rep_)
__global__ __launch_bounds__(512, 2) void mega(Params P) {
    extern __shared__ __attribute__((aligned(16))) unsigned char shm[];
    LAS unsigned char* lds = (LAS unsigned char*)shm;
    cg::grid_group grid = cg::this_grid();
    if (threadIdx.x == 0) *(LAS u32x4*)(lds + 131072) = (u32x4){0u, 0u, 0u, 0u};
    __syncthreads();
    const XcdBarrier xb = xcd_barrier_post((unsigned*)(P.ws + OFF_BAR), (volatile LAS unsigned*)(lds + 131072));
    const int G = gridDim.x, c = blockIdx.x;
    unsigned char* ws = P.ws;
    float* X = P.out;
    bf16_t* H = (bf16_t*)(ws + OFF_H);
    const float* MOD = (const float*)(ws + OFF_MOD);

    phase0(P, lds);
    grid.sync();
    for (int l = 0; l < 2; ++l) {
        const float* mod = MOD + (size_t)l * 3 * 6144;
        REPLOOP(0) convert_weights(P, l, lds);
        REPLOOP(1) norm_phase(X, P.norm1 + l * 1024, mod, 0, 1024, H);
        xcd_barrier_(xb.bar, xb.x, xb.st);
        REPLOOP(2) { Sched S{(const char*)H, (const char*)(ws + OFF_WIN), 1024, 1024, 0, 48, 14, G, c};
          EpiIn E{(bf16_t*)(ws + OFF_XAQ), (bf16_t*)(ws + OFF_XC), (bf16_t*)(ws + OFF_KB), (bf16_t*)(ws + OFF_VB), P.out + OUT_K, P.out + OUT_V, l};
          gemm_phase(lds, S, 1024, E); }
        xcd_barrier_(xb.bar, xb.x, xb.st);
        REPLOOP(3) {
        pool_phase((const bf16_t*)(ws + OFF_XC), (bf16_t*)(ws + OFF_PL));
        for (int it = c; it < 1152; it += G) {
#ifndef NO_ATTN
            if (it < 256) attn_unit(P, l, it, lds);
            else if (it >= 640) attn_unit(P, l, it - 640 + 256, lds);
#endif
#ifndef NO_LRU
            if (it >= 256 && it < 640) { const int v = it - 256;
                if (v < 256) lru_unit<0>(P, l, v >> 3, 0, v & 7, lds);
                else { const int q = v - 256; lru_unit<1>(P, l, 32 + (q >> 6), (q >> 3) & 7, q & 7, lds); } }
#endif
        }
        }
        xcd_barrier_(xb.bar, xb.x, xb.st);
        { Sched S{(const char*)(ws + OFF_PL), (const char*)(ws + OFF_PW), 1024, 256, 256, 48, 4, G, c};
          EpiPool E{(bf16_t*)(ws + OFF_XC), P.pool_scale + l * 1024};
          gemm_phase(lds, S, 256, E); }
#ifndef NO_LRU
        for (int it = G - 1 - c; it < 128; it += G) lru_unit<0>(P, l, 32 + (it >> 6), (it >> 3) & 7, it & 7, lds);
#endif
        xcd_barrier_(xb.bar, xb.x, xb.st);
        REPLOOP(6) for (int j = 0; j < 3; ++j) {
            { Sched S{(const char*)H, (const char*)(ws + OFF_WIN) + (size_t)(3584 + j * 1024) * 1024 * 2, 1024, 1024, 0, 48, 4, G, c};
              EpiGate E{(bf16_t*)(ws + OFF_GT), P.b_gate + l * 3072 + j * 1024};
              gemm_phase(lds, S, 1024, E); }
            { const char* Aj = (const char*)(ws + (j == 0 ? OFF_YA : (j == 1 ? OFF_YB : OFF_XC)));
              Sched S{Aj, (const char*)(ws + OFF_WBR) + (size_t)j * 1024 * 1024 * 2, 1024, 1024, 0, 48, 4, G, c};
              EpiBranch E{(const bf16_t*)(ws + OFF_GT), (float*)(ws + OFF_XAQ), (bf16_t*)(ws + OFF_PL), j};
              gemm_phase(lds, S, 1024, E); }
        }
        xcd_barrier_(xb.bar, xb.x, xb.st);
        { Sched S{(const char*)(ws + OFF_PL), (const char*)(ws + OFF_WOUT), 1024, 1024, 0, 48, 4, G, c};
          EpiRes E{X, mod, 2048};
          gemm_phase(lds, S, 1024, E); }
        xcd_barrier_(xb.bar, xb.x, xb.st);
        norm_phase(X, P.norm2 + l * 1024, mod, 3072, 4096, H);
        xcd_barrier_(xb.bar, xb.x, xb.st);
        REPLOOP(9) { Sched S{(const char*)H, (const char*)(ws + OFF_WUP), 1024, 1024, 0, 48, 22, G, c};
          EpiBf E{(bf16_t*)(ws + OFF_U), 5632};
          gemm_phase(lds, S, 1024, E); }
        xcd_barrier_(xb.bar, xb.x, xb.st);
        REPLOOP(10) act_phase((const bf16_t*)(ws + OFF_U), (bf16_t*)(ws + OFF_ACT), P.ffn_conv + (size_t)l * 3 * 2816, P.ffn_conv_b + l * 2816);
        xcd_barrier_(xb.bar, xb.x, xb.st);
        { Sched S{(const char*)(ws + OFF_ACT), (const char*)(ws + OFF_WDN), 2816, 2816, 0, 48, 4, G, c};
          EpiRes E{X, mod, 5120};
          gemm_phase(lds, S, 2816, E); }
        xcd_barrier_(xb.bar, xb.x, xb.st);
    }
    final_norm_phase(X, P.final_norm);
}

extern "C" void kernel_launch(void* const* d_in, const int* in_sizes, int n_in, void* d_out, int out_size, void* d_ws, size_t ws_size, hipStream_t stream) {
    constexpr size_t kDynLds = 131072 + 16;
    static int grid_blocks = 0;
    if (!grid_blocks) {
        int dev = 0, cus = 0, per_cu = 0;
        hipGetDevice(&dev);
        hipDeviceGetAttribute(&cus, hipDeviceAttributeMultiprocessorCount, dev);
        hipFuncSetAttribute((const void*)mega, hipFuncAttributeMaxDynamicSharedMemorySize, (int)kDynLds);
        hipOccupancyMaxActiveBlocksPerMultiprocessor(&per_cu, mega, 512, kDynLds);
        if (per_cu < 1) per_cu = 1;
        if (per_cu > 1) per_cu = 1;
        grid_blocks = cus * per_cu;
    }
    Params p{};
    const float** pp = (const float**)&p;
    for (int i = 0; i < 30; ++i) pp[i] = (const float*)d_in[i];
    p.out = (float*)d_out; p.ws = (unsigned char*)d_ws;
    if (ws_size < OFF_END) { fprintf(stderr, "workspace too small: %zu < %zu\n", ws_size, (size_t)OFF_END); }
    hipMemsetAsync((unsigned char*)d_ws + OFF_BAR, 0, 16384, stream);
    void* args[] = {&p};
    hipError_t e = hipLaunchCooperativeKernel((void*)mega, dim3(grid_blocks), dim3(512), args, kDynLds, stream);
    if (e != hipSuccess) fprintf(stderr, "cooperative launch failed: %s (grid %d)\n", hipGetErrorString(e), grid_blocks);
}
```

```cpp
#include <hip/hip_runtime.h>
#include <hip/hip_cooperative_groups.h>
#include <cstdio>
namespace cg = cooperative_groups;

#define LAS __attribute__((address_space(3)))
typedef unsigned short bf16_t;
typedef short bf16x8 __attribute__((ext_vector_type(8)));
typedef float f32x4 __attribute__((ext_vector_type(4)));
typedef unsigned u32x4 __attribute__((ext_vector_type(4)));
typedef unsigned u32x2 __attribute__((ext_vector_type(2)));
typedef short bf16x4 __attribute__((ext_vector_type(4)));

constexpr int MROWS = 12288, MCTX = 8192;
constexpr size_t S24 = (size_t)MROWS * 1024 * 2;
constexpr size_t OFF_WIN = 0;
constexpr size_t OFF_WBR = OFF_WIN + (size_t)6656 * 1024 * 2;
constexpr size_t OFF_WOUT = OFF_WBR + (size_t)3 * 1024 * 1024 * 2;
constexpr size_t OFF_WUP = OFF_WOUT + (size_t)1024 * 1024 * 2;
constexpr size_t OFF_WDN = OFF_WUP + (size_t)5632 * 1024 * 2;
constexpr size_t OFF_GW = OFF_WDN + (size_t)1024 * 2816 * 2;
constexpr size_t OFF_PW = OFF_GW + (size_t)2 * 8 * 256 * 128 * 2;
constexpr size_t OFF_MOD = OFF_PW + (size_t)4 * 256 * 256 * 2;
constexpr size_t OFF_CK = OFF_MOD + (size_t)2 * 3 * 6144 * 4;
constexpr size_t OFF_CV = OFF_CK + (size_t)2 * 2 * 512 * 256 * 2;
constexpr size_t OFF_ROPE = OFF_CV + (size_t)2 * 2 * 512 * 256 * 2;
constexpr size_t OFF_SUMM = OFF_ROPE + (size_t)2 * 64 * 32 * 4;
constexpr size_t OFF_BAR = OFF_SUMM + (size_t)2 * 2 * 8 * 1024 * 2 * 4;
constexpr size_t OFF_ACT0 = OFF_BAR + 16384;
constexpr size_t OFF_XAQ = OFF_ACT0;
constexpr size_t OFF_XC = OFF_XAQ + 2 * S24;
constexpr size_t OFF_KB = OFF_XC + S24;
constexpr size_t OFF_VB = OFF_KB + (size_t)MROWS * 256 * 2;
constexpr size_t OFF_GT = OFF_VB + (size_t)MROWS * 256 * 2;
constexpr size_t OFF_YB = OFF_GT + S24;
constexpr size_t OFF_PL = OFF_YB + S24;
constexpr size_t OFF_YA = OFF_PL + S24;
constexpr size_t OFF_H = OFF_YA + S24;
constexpr size_t OFF_END = OFF_H + S24;
constexpr size_t OFF_U = OFF_XAQ;
constexpr size_t OFF_ACT = OFF_PL;
constexpr size_t OUT_K = (size_t)MROWS * 1024;
constexpr size_t OUT_V = OUT_K + (size_t)32 * 2 * 256 * 256;
constexpr size_t OUT_H = OUT_V + (size_t)32 * 2 * 256 * 256;

struct Params {
    const float *x_prompt, *x_sample, *cache_k, *cache_v, *state_lru, *c, *c_ctx, *w_ada, *b_ada, *norm1, *norm2,
        *w_in, *b_gate, *lru_conv, *lru_conv_b, *lru_wa, *lru_ba, *lru_wx, *lru_bx, *lru_lambda, *attn_sink,
        *pool_w, *pool_scale, *w_branch, *w_out, *ffn_up, *ffn_conv, *ffn_conv_b, *ffn_down, *final_norm;
    float* out; unsigned char* ws;
};

__device__ __forceinline__ unsigned short f2bf(float f) { unsigned u = __float_as_uint(f); u += 0x7FFFu + ((u >> 16) & 1u); return (unsigned short)(u >> 16); }
__device__ __forceinline__ float bf2f(unsigned short b) { return __uint_as_float(((unsigned)b) << 16); }
__device__ __forceinline__ unsigned pack2(float a, float b) { return (unsigned)f2bf(a) | ((unsigned)f2bf(b) << 16); }
__device__ __forceinline__ int otid() { int t = threadIdx.x; asm volatile("" : "+v"(t)); return t; }
__device__ __forceinline__ float sigmoidf_(float x) { return __builtin_amdgcn_rcpf(1.0f + __expf(-x)); }

constexpr int HTB = 128 * 64 * 2;
__device__ __forceinline__ int lds_byte(int r, int c) { const int st = (r >> 4) * 2 + (c >> 5), rr = r & 15, cc = c & 31, ob = rr * 64 + cc * 2; return st * 1024 + (ob ^ (((ob >> 9) & 1) << 5)); }
__device__ __forceinline__ void stage_rc(int b, int& R, int& C) { const int st = b / 1024, sb = b % 1024, swz = sb ^ (((sb >> 9) & 1) << 5); R = (st >> 1) * 16 + swz / 64; C = (st & 1) * 32 + (swz % 64) / 2; }

struct Unit { const char* a; const char* b; int pm, pn, z; };
struct Sched {
    const char* A; const char* B; int lda, ldb, acol, nM, nN, G, c;
    __device__ __forceinline__ bool next(int i, Unit& u) const {
        const long L = (long)i * G + c; const int nwg = nM * nN; if (L >= nwg) return false;
        int wgid = (int)L; { const int q = nwg / 8, r = nwg % 8, xcd = wgid % 8, off = wgid / 8; wgid = (xcd < r ? xcd * (q + 1) : r * (q + 1) + (xcd - r) * q) + off; }
        const int nig = 8 * nN, gid = wgid / nig, fm = gid * 8, gsz = (nM - fm) < 8 ? (nM - fm) : 8;
        u.pm = fm + ((wgid % nig) % gsz); u.pn = (wgid % nig) / gsz;
        u.a = A + ((size_t)u.pm * 256 * lda + (size_t)u.pn * acol) * 2; u.b = B + (size_t)u.pn * 256 * ldb * 2; u.z = 0; return true;
    }
};
struct MergeSched {
    const char* ws; int lda, ldb, c;
    __device__ __forceinline__ bool next(int i, Unit& u) const {
        if (c >= 192 || i >= 6) return false;
        const int nwg = 192, nN = 4, nM = 48;
        int wgid = c; { const int q = nwg / 8, xcd = wgid % 8, off = wgid / 8; wgid = xcd * q + off; }
        const int nig = 8 * nN, gid = wgid / nig, fm = gid * 8, gsz = (nM - fm) < 8 ? (nM - fm) : 8;
        u.pm = fm + ((wgid % nig) % gsz); u.pn = (wgid % nig) / gsz; u.z = i;
        const int j = i >> 1;
        const size_t aoff = (size_t)u.pm * 256 * 1024 * 2;
        size_t ao = OFF_H, bo = OFF_WIN + (size_t)3584 * 1024 * 2;
        if (i & 1) { bo = OFF_WBR; ao = OFF_YA; if (j == 1) ao = OFF_YB; if (j == 2) ao = OFF_XC; }
        u.a = ws + ao + aoff; u.b = ws + bo + ((size_t)j * 1024 + (size_t)u.pn * 256) * 1024 * 2;
        return true;
    }
};

template <class Epi, class SchedT>
__device__ __forceinline__ void gemm_phase(LAS unsigned char* lds, const SchedT& S, const int K_, const Epi& E) {
    int K = K_; asm volatile("" : "+s"(K));
    int tid_ = threadIdx.x; asm volatile("" : "+v"(tid_));
    const int tid = tid_, wid = __builtin_amdgcn_readfirstlane(tid >> 6), lane = tid & 63, wr = wid >> 2, wc = wid & 3, fr = lane & 15, fq = lane >> 4;
    const int nt = K / 64;
    unsigned voffA[2], voffB[2];
#pragma unroll
    for (int i = 0; i < 2; ++i) { int R, C; stage_rc(tid * 16 + i * 8192, R, C); voffA[i] = (unsigned)(R * S.lda + C) * 2u; voffB[i] = (unsigned)(R * S.ldb + C) * 2u; }
    const size_t kstep = 128;
    const size_t hstepA = (size_t)128 * S.lda * 2, hstepB = (size_t)128 * S.ldb * 2;
    const unsigned ldsw = (unsigned)wid * 1024u;
    const int aoff = lds_byte(wr * 64 + fr, fq * 8), boff = lds_byte(wc * 32 + fr, fq * 8);
#define G_SA(b, h) (((b) * 2 + (h)) * HTB)
#define G_SB(b, h) ((4 + (b) * 2 + (h)) * HTB)
#define G_STAGE(bufoff, gbase, voff) do { _Pragma("unroll") for (int _i = 0; _i < 2; ++_i) \
        __builtin_amdgcn_global_load_lds((const unsigned*)((const char*)(gbase) + (voff)[_i]), (LAS unsigned*)(lds + (bufoff) + ldsw + _i * 8192), 16, 0, 0); } while (0)
#define G_LDA(dst, b, h) do { _Pragma("unroll") for (int m = 0; m < 4; ++m) _Pragma("unroll") for (int k = 0; k < 2; ++k) dst[m][k] = *(const LAS bf16x8*)(lds + G_SA(b, h) + aoff + m * 2048 + k * 1024); } while (0)
#define G_LDB(dst, b, h) do { _Pragma("unroll") for (int n = 0; n < 2; ++n) _Pragma("unroll") for (int k = 0; k < 2; ++k) dst[n][k] = *(const LAS bf16x8*)(lds + G_SB(b, h) + boff + n * 2048 + k * 1024); } while (0)
#define G_MMA(ai, bj, At, Bt) do { __builtin_amdgcn_s_setprio(1); _Pragma("unroll") for (int m = 0; m < 4; ++m) _Pragma("unroll") for (int n = 0; n < 2; ++n) _Pragma("unroll") for (int k = 0; k < 2; ++k) \
        acc[ai][bj][m][n] = __builtin_amdgcn_mfma_f32_16x16x32_bf16(Bt[n][k], At[m][k], acc[ai][bj][m][n], 0, 0, 0); __builtin_amdgcn_s_setprio(0); } while (0)
#define G_WAIT_V(n) asm volatile("s_waitcnt vmcnt(" #n ")" ::: "memory")
#define G_WAIT_L(n) asm volatile("s_waitcnt lgkmcnt(" #n ")" ::: "memory")
#define G_BAR __builtin_amdgcn_s_barrier()
#define G_SCHED __builtin_amdgcn_sched_barrier(0)
    Unit cur, nxt; int ui = 0;
    if (!S.next(0, cur)) return;
    f32x4 acc[2][2][4][2];
#pragma unroll
    for (int a = 0; a < 2; ++a)
#pragma unroll
        for (int b = 0; b < 2; ++b)
#pragma unroll
            for (int m = 0; m < 4; ++m)
#pragma unroll
                for (int n = 0; n < 2; ++n) acc[a][b][m][n] = (f32x4){0.f, 0.f, 0.f, 0.f};
    bf16x8 At[4][2], B0[2][2], B1[2][2];
    const char* cA = cur.a; const char* cB = cur.b;
    G_STAGE(G_SB(0, 0), cB, voffB); G_STAGE(G_SA(0, 0), cA, voffA); G_STAGE(G_SB(0, 1), cB + hstepB, voffB); G_STAGE(G_SA(0, 1), cA + hstepA, voffA);
    if (wr == 1) G_BAR;
    G_WAIT_V(4); G_BAR;
    G_STAGE(G_SB(1, 0), cB + kstep, voffB); G_STAGE(G_SA(1, 0), cA + kstep, voffA); G_STAGE(G_SB(1, 1), cB + hstepB + kstep, voffB);
    G_WAIT_V(6); G_BAR;
    for (;;) {
        const bool has_next = S.next(ui + 1, nxt);
        const char* nA = has_next ? nxt.a : cA; const char* nB = has_next ? nxt.b : cB;
        for (int t = 0; t < nt; t += 2) {
            const bool last = (t == nt - 2);
            const char* a1 = cA + (size_t)(t + 1) * kstep;
            const char* a2 = last ? nA : cA + (size_t)(t + 2) * kstep; const char* b2 = last ? nB : cB + (size_t)(t + 2) * kstep;
            const char* a3 = a2 + kstep; const char* b3 = b2 + kstep;
            G_LDB(B0, 0, 0); G_SCHED; G_LDA(At, 0, 0); G_STAGE(G_SA(1, 1), a1 + hstepA, voffA);
            G_WAIT_L(8); G_BAR; G_WAIT_L(0); G_MMA(0, 0, At, B0); G_BAR; G_SCHED;
            G_LDB(B1, 0, 1); G_STAGE(G_SB(0, 0), b2, voffB);
            G_BAR; G_WAIT_L(0); G_MMA(0, 1, At, B1); G_BAR;
            G_LDA(At, 0, 1); G_STAGE(G_SA(0, 0), a2, voffA);
            G_BAR; G_WAIT_L(0); G_MMA(1, 0, At, B0); G_BAR; G_SCHED;
            G_STAGE(G_SB(0, 1), b2 + hstepB, voffB);
            G_WAIT_V(6); G_BAR; G_MMA(1, 1, At, B1); G_BAR;
            G_LDB(B0, 1, 0); G_SCHED; G_LDA(At, 1, 0); G_STAGE(G_SA(0, 1), a2 + hstepA, voffA);
            G_WAIT_L(8); G_BAR; G_WAIT_L(0); G_MMA(0, 0, At, B0); G_BAR; G_SCHED;
            G_LDB(B1, 1, 1); G_STAGE(G_SB(1, 0), b3, voffB);
            G_BAR; G_WAIT_L(0); G_MMA(0, 1, At, B1); G_BAR;
            G_LDA(At, 1, 1); G_STAGE(G_SA(1, 0), a3, voffA);
            G_BAR; G_WAIT_L(0); G_MMA(1, 0, At, B0); G_BAR; G_SCHED;
            G_STAGE(G_SB(1, 1), b3 + hstepB, voffB);
            G_WAIT_V(6); G_BAR; G_MMA(1, 1, At, B1); G_BAR;
        }
        E(acc, cur, wr, wc, fr, fq);
        if (!has_next) break;
#pragma unroll
        for (int a = 0; a < 2; ++a)
#pragma unroll
            for (int b = 0; b < 2; ++b)
#pragma unroll
                for (int m = 0; m < 4; ++m)
#pragma unroll
                    for (int n = 0; n < 2; ++n) acc[a][b][m][n] = (f32x4){0.f, 0.f, 0.f, 0.f};
        cur = nxt; cA = nA; cB = nB; ++ui;
    }
    G_WAIT_V(0);
    if (wr == 0) G_BAR;
    G_BAR;
#undef G_SA
#undef G_SB
#undef G_STAGE
#undef G_LDA
#undef G_LDB
#undef G_MMA
#undef G_WAIT_V
#undef G_WAIT_L
#undef G_BAR
#undef G_SCHED
}

#define EPI_LOOP_BEGIN \
    _Pragma("unroll") for (int ai = 0; ai < 2; ++ai) _Pragma("unroll") for (int m = 0; m < 4; ++m) { const int row = u.pm * 256 + wr * 64 + fr + ai * 128 + m * 16; \
    _Pragma("unroll") for (int bj = 0; bj < 2; ++bj) _Pragma("unroll") for (int n = 0; n < 2; ++n) { const int cl = wc * 32 + 4 * fq + bj * 128 + n * 16; const f32x4 v = acc[ai][bj][m][n];
#define EPI_LOOP_END } }

__device__ __forceinline__ int seq_group(int row) { return row < MCTX ? 0 : 1 + ((row - MCTX) >> 11); }

struct EpiIn {
    bf16_t* xaq; bf16_t* xc; bf16_t* kb; bf16_t* vb; float* outk; float* outv; int l;
    __device__ __forceinline__ void operator()(const f32x4 (&acc)[2][2][4][2], const Unit& u, int wr, int wc, int fr, int fq) const {
        bf16_t* dst; int ld, cbase; float* fo = nullptr;
        if (u.pn < 4) { dst = xaq; ld = 1024; cbase = u.pn * 256; }
        else if (u.pn < 8) { dst = xaq + (size_t)MROWS * 1024; ld = 1024; cbase = u.pn * 256 - 1024; }
        else if (u.pn == 8) { dst = kb; ld = 256; cbase = 0; fo = outk; }
        else if (u.pn == 9) { dst = vb; ld = 256; cbase = 0; fo = outv; }
        else { dst = xc; ld = 1024; cbase = u.pn * 256 - 2560; }
        EPI_LOOP_BEGIN
            const int col = cbase + cl;
            uint2 pk; pk.x = pack2(v[0], v[1]); pk.y = pack2(v[2], v[3]);
            *(uint2*)(dst + (size_t)row * ld + col) = pk;
            if (fo != nullptr && row < MCTX) { const int b = row >> 8, t = row & 255; *(f32x4*)(fo + ((size_t)((b * 2 + l) * 256 + t)) * 256 + col) = v; }
        EPI_LOOP_END
    }
};
struct EpiGate {
    bf16_t* gt; const float* bias;
    __device__ __forceinline__ void operator()(const f32x4 (&acc)[2][2][4][2], const Unit& u, int wr, int wc, int fr, int fq) const {
        EPI_LOOP_BEGIN
            const int col = u.pn * 256 + cl;
            const f32x4 bb = *(const f32x4*)(bias + col);
            uint2 pk; pk.x = pack2(sigmoidf_(v[0] + bb[0]), sigmoidf_(v[1] + bb[1])); pk.y = pack2(sigmoidf_(v[2] + bb[2]), sigmoidf_(v[3] + bb[3]));
            *(uint2*)(gt + (size_t)row * 1024 + col) = pk;
        EPI_LOOP_END
    }
};
struct EpiBranch {
    const bf16_t* gt; float* tmp; bf16_t* mg; int j;
    __device__ __forceinline__ void operator()(const f32x4 (&acc)[2][2][4][2], const Unit& u, int wr, int wc, int fr, int fq) const {
        EPI_LOOP_BEGIN
            const int col = u.pn * 256 + cl;
            const uint2 gp = *(const uint2*)(gt + (size_t)row * 1024 + col);
            f32x4 r;
            r[0] = v[0] * bf2f((unsigned short)(gp.x & 0xffff)); r[1] = v[1] * bf2f((unsigned short)(gp.x >> 16));
            r[2] = v[2] * bf2f((unsigned short)(gp.y & 0xffff)); r[3] = v[3] * bf2f((unsigned short)(gp.y >> 16));
            float* tp = tmp + (size_t)row * 1024 + col;
            if (j == 0) { *(f32x4*)tp = r; }
            else if (j == 1) { f32x4 o = *(const f32x4*)tp; *(f32x4*)tp = o + r; }
            else { f32x4 o = *(const f32x4*)tp; o = o + r; uint2 pk; pk.x = pack2(o[0], o[1]); pk.y = pack2(o[2], o[3]); *(uint2*)(mg + (size_t)row * 1024 + col) = pk; }
        EPI_LOOP_END
    }
};
struct EpiMerge {
    bf16_t* gt; const float* bgate; float* tmp; bf16_t* mg;
    __device__ __forceinline__ void operator()(const f32x4 (&acc)[2][2][4][2], const Unit& u, int wr, int wc, int fr, int fq) const {
        const int j = u.z >> 1;
        if ((u.z & 1) == 0) { EpiGate E{gt, bgate + j * 1024}; E(acc, u, wr, wc, fr, fq); }
        else { EpiBranch E{gt, tmp, mg, j}; E(acc, u, wr, wc, fr, fq); }
    }
};
struct EpiRes {
    float* x; const float* mod; int goff;
    __device__ __forceinline__ void operator()(const f32x4 (&acc)[2][2][4][2], const Unit& u, int wr, int wc, int fr, int fq) const {
        const float* g = mod + seq_group(u.pm * 256) * 6144 + goff;
        EPI_LOOP_BEGIN
            const int col = u.pn * 256 + cl;
            const f32x4 gg = *(const f32x4*)(g + col);
            float* xp = x + (size_t)row * 1024 + col;
            f32x4 o = *(const f32x4*)xp;
            *(f32x4*)xp = o + gg * v;
        EPI_LOOP_END
    }
};
struct EpiBf {
    bf16_t* dst; int ld;
    __device__ __forceinline__ void operator()(const f32x4 (&acc)[2][2][4][2], const Unit& u, int wr, int wc, int fr, int fq) const {
        EPI_LOOP_BEGIN
            const int col = u.pn * 256 + cl;
            uint2 pk; pk.x = pack2(v[0], v[1]); pk.y = pack2(v[2], v[3]);
            *(uint2*)(dst + (size_t)row * ld + col) = pk;
        EPI_LOOP_END
    }
};
struct EpiPool {
    bf16_t* dst; const float* scale;
    __device__ __forceinline__ void operator()(const f32x4 (&acc)[2][2][4][2], const Unit& u, int wr, int wc, int fr, int fq) const {
        EPI_LOOP_BEGIN
            const int col = u.pn * 256 + cl;
            const f32x4 s = *(const f32x4*)(scale + col);
            uint2 pk; pk.x = pack2(v[0] * s[0], v[1] * s[1]); pk.y = pack2(v[2] * s[2], v[3] * s[3]);
            *(uint2*)(dst + (size_t)row * 1024 + col) = pk;
        EPI_LOOP_END
    }
};

struct TileDesc { const float* src; int lds_; bf16_t* dst; int ldd, k0, n0; };
__device__ __forceinline__ TileDesc weight_tile(const Params& P, int l, int t) {
    unsigned char* ws = P.ws; TileDesc d; int r = t;
    if (r < 1664) { d.src = P.w_in + (size_t)l * 1024 * 6656; d.lds_ = 6656; d.dst = (bf16_t*)(ws + OFF_WIN); d.ldd = 1024; d.k0 = (r / 104) * 64; d.n0 = (r % 104) * 64; }
    else if ((r -= 1664) < 768) { const int j = r / 256; r %= 256; d.src = P.w_branch + (size_t)(l * 3 + j) * 1024 * 1024; d.lds_ = 1024; d.dst = (bf16_t*)(ws + OFF_WBR) + (size_t)j * 1024 * 1024; d.ldd = 1024; d.k0 = (r / 16) * 64; d.n0 = (r % 16) * 64; }
    else if ((r -= 768) < 128) { const int mat = r / 64; r %= 64; const int dh = r / 4; r %= 4;
        d.src = (mat ? P.lru_wx : P.lru_wa) + (size_t)(l * 16 + dh) * 128 * 128; d.lds_ = 128; d.dst = (bf16_t*)(ws + OFF_GW) + (size_t)dh * 256 * 128 + (size_t)mat * 128 * 128; d.ldd = 128; d.k0 = (r / 2) * 64; d.n0 = (r % 2) * 64; }
    else if ((r -= 128) < 64) { const int g = r / 16; r %= 16; d.src = P.pool_w + (size_t)(l * 4 + g) * 256 * 256; d.lds_ = 256; d.dst = (bf16_t*)(ws + OFF_PW) + (size_t)g * 256 * 256; d.ldd = 256; d.k0 = (r / 4) * 64; d.n0 = (r % 4) * 64; }
    else if ((r -= 64) < 256) { d.src = P.w_out + (size_t)l * 1024 * 1024; d.lds_ = 1024; d.dst = (bf16_t*)(ws + OFF_WOUT); d.ldd = 1024; d.k0 = (r / 16) * 64; d.n0 = (r % 16) * 64; }
    else if ((r -= 256) < 1408) { d.src = P.ffn_up + (size_t)l * 1024 * 5632; d.lds_ = 5632; d.dst = (bf16_t*)(ws + OFF_WUP); d.ldd = 1024; d.k0 = (r / 88) * 64; d.n0 = (r % 88) * 64; }
    else { r -= 1408; d.src = P.ffn_down + (size_t)l * 2816 * 1024; d.lds_ = 1024; d.dst = (bf16_t*)(ws + OFF_WDN); d.ldd = 2816; d.k0 = (r / 16) * 64; d.n0 = (r % 16) * 64; }
    return d;
}
__device__ void convert_weights(const Params& P, int l, LAS unsigned char* lds, int t_begin, int t_end, int first, int stride) {
    LAS bf16_t* sm = (LAS bf16_t*)lds;
    const int tid = otid();
    const int kk0 = tid >> 4, n4 = (tid & 15) * 4, nn = tid >> 3, ck = tid & 7;
    int t = t_begin + first;
    if (t >= t_end) return;
    TileDesc d = weight_tile(P, l, t);
    f32x4 v0 = *(const f32x4*)(d.src + (size_t)(d.k0 + kk0) * d.lds_ + d.n0 + n4), v1 = *(const f32x4*)(d.src + (size_t)(d.k0 + kk0 + 32) * d.lds_ + d.n0 + n4);
    for (;;) {
        __syncthreads();
#pragma unroll
        for (int e = 0; e < 4; ++e) { sm[(n4 + e) * 72 + kk0] = f2bf(v0[e]); sm[(n4 + e) * 72 + kk0 + 32] = f2bf(v1[e]); }
        __syncthreads();
        const TileDesc cur = d; const int tn = t + stride; const bool more = tn < t_end;
        if (more) { d = weight_tile(P, l, tn); v0 = *(const f32x4*)(d.src + (size_t)(d.k0 + kk0) * d.lds_ + d.n0 + n4); v1 = *(const f32x4*)(d.src + (size_t)(d.k0 + kk0 + 32) * d.lds_ + d.n0 + n4); }
        const u32x4 o = *(const LAS u32x4*)(sm + nn * 72 + ck * 8);
        *(u32x4*)(cur.dst + (size_t)(cur.n0 + nn) * cur.ldd + cur.k0 + ck * 8) = o;
        if (!more) break;
        t = tn;
    }
    __syncthreads();
}

__device__ void phase0(const Params& P, LAS unsigned char* lds) {
    const int tid = otid(), G = gridDim.x, c = blockIdx.x;
    { const size_t n4 = (size_t)MROWS * 1024 / 4, nc4 = (size_t)MCTX * 1024 / 4;
      for (size_t i = (size_t)c * 512 + tid; i < n4; i += (size_t)G * 512) {
          const float4 v = i < nc4 ? ((const float4*)P.x_prompt)[i] : ((const float4*)P.x_sample)[i - nc4];
          ((float4*)P.out)[i] = v; } }
    { bf16_t* ck = (bf16_t*)(P.ws + OFF_CK); bf16_t* cv = (bf16_t*)(P.ws + OFF_CV);
      for (int i = c * 512 + tid; i < 2 * 2 * 512 * 256; i += G * 512) {
          const int e = i & 255, t = (i >> 8) & 511, b = (i >> 17) & 1, l = i >> 18;
          const size_t si = ((size_t)((b * 2 + l) * 512 + t)) * 256 + e;
          ck[i] = f2bf(P.cache_k[si]); cv[i] = f2bf(P.cache_v[si]); } }
    { float* rc = (float*)(P.ws + OFF_ROPE); float* rs = rc + 2048;
      for (int i = c * 512 + tid; i < 2048; i += G * 512) {
          const int pos = i >> 5, k = i & 31; const float fr = powf(10000.0f, -(float)k / 32.0f); const float ang = (float)pos * fr;
          rc[i] = cosf(ang); rs[i] = sinf(ang); } }
    { LAS float* sv = (LAS float*)lds;
      LAS float* red = sv + 3072;
      __syncthreads();
      for (int i = tid; i < 3072; i += 512) { const int s = i >> 10, k = i & 1023; const float x = s == 0 ? P.c_ctx[k] : P.c[(s - 1) * 1024 + k]; sv[i] = x / (1.0f + expf(-x)); }
      __syncthreads();
      float* mod = (float*)(P.ws + OFF_MOD);
      for (int it = c; it < 384; it += G) {
          const int l = it / 192, cg_ = it % 192, cl = tid & 31, kg = tid >> 5, col = cg_ * 32 + cl;
          const float* w = P.w_ada + (size_t)l * 1024 * 6144 + col;
          float a0 = 0.f, a1 = 0.f, a2 = 0.f;
#pragma unroll 16
          for (int k = kg * 64; k < kg * 64 + 64; ++k) { const float wv = w[(size_t)k * 6144]; a0 += sv[k] * wv; a1 += sv[1024 + k] * wv; a2 += sv[2048 + k] * wv; }
          red[(kg * 3 + 0) * 32 + cl] = a0; red[(kg * 3 + 1) * 32 + cl] = a1; red[(kg * 3 + 2) * 32 + cl] = a2;
          __syncthreads();
          if (tid < 96) { const int s = tid >> 5, cc = tid & 31; float sum = 0.f;
#pragma unroll
              for (int g = 0; g < 16; ++g) sum += red[(g * 3 + s) * 32 + cc];
              mod[(size_t)(l * 3 + s) * 6144 + cg_ * 32 + cc] = sum + P.b_ada[l * 6144 + cg_ * 32 + cc]; }
          __syncthreads();
      } }
}

__device__ void norm_phase(const float* __restrict__ X, const float* __restrict__ gw, const float* __restrict__ mod, int shift_off, int scale_off, bf16_t* __restrict__ H) {
    const int tid = otid(); const int lane = tid & 63, wv = blockIdx.x * 8 + (tid >> 6), nw = gridDim.x * 8;
    for (int row = wv; row < MROWS; row += nw) {
        const float* md = mod + seq_group(row) * 6144;
        f32x4 v[4]; float ss = 0.f;
#pragma unroll
        for (int i = 0; i < 4; ++i) { v[i] = *(const f32x4*)(X + (size_t)row * 1024 + i * 256 + lane * 4); ss += v[i][0] * v[i][0] + v[i][1] * v[i][1] + v[i][2] * v[i][2] + v[i][3] * v[i][3]; }
#pragma unroll
        for (int o = 32; o >= 1; o >>= 1) ss += __shfl_xor(ss, o);
        const float rstd = rsqrtf(ss * (1.0f / 1024.0f) + 1e-6f);
#pragma unroll
        for (int i = 0; i < 4; ++i) { const int col = i * 256 + lane * 4;
            const f32x4 g = *(const f32x4*)(gw + col), sc = *(const f32x4*)(md + scale_off + col), sh = *(const f32x4*)(md + shift_off + col);
            f32x4 h;
#pragma unroll
            for (int e = 0; e < 4; ++e) h[e] = v[i][e] * rstd * g[e] * (1.0f + sc[e]) + sh[e];
            uint2 pk; pk.x = pack2(h[0], h[1]); pk.y = pack2(h[2], h[3]);
            *(uint2*)(H + (size_t)row * 1024 + col) = pk; }
    }
}
__device__ void final_norm_phase(float* X, const float* __restrict__ gw) {
    const int tid = otid(); const int lane = tid & 63, wv = blockIdx.x * 8 + (tid >> 6), nw = gridDim.x * 8;
    for (int row = wv; row < MROWS; row += nw) {
        f32x4 v[4]; float ss = 0.f;
#pragma unroll
        for (int i = 0; i < 4; ++i) { v[i] = *(const f32x4*)(X + (size_t)row * 1024 + i * 256 + lane * 4); ss += v[i][0] * v[i][0] + v[i][1] * v[i][1] + v[i][2] * v[i][2] + v[i][3] * v[i][3]; }
#pragma unroll
        for (int o = 32; o >= 1; o >>= 1) ss += __shfl_xor(ss, o);
        const float rstd = rsqrtf(ss * (1.0f / 1024.0f) + 1e-6f);
#pragma unroll
        for (int i = 0; i < 4; ++i) { const int col = i * 256 + lane * 4; const f32x4 g = *(const f32x4*)(gw + col);
            f32x4 h;
#pragma unroll
            for (int e = 0; e < 4; ++e) h[e] = v[i][e] * rstd * g[e];
            *(f32x4*)(X + (size_t)row * 1024 + col) = h; }
    }
}

__device__ void pool_phase(const bf16_t* __restrict__ XC, bf16_t* __restrict__ PL) {
    const int tid = otid();
    for (int idx = blockIdx.x * 512 + tid; idx < MROWS * 128; idx += gridDim.x * 512) {
        const int row = idx >> 7, ch = (idx & 127) * 8, g = ch >> 8, half = 1 << g;
        const int T = row < MCTX ? 256 : 2048, row0 = row < MCTX ? (row & ~255) : MCTX + ((row - MCTX) & ~2047), tl = row - row0;
        const int lo = max(tl - half, 0), hi = min(tl + half, T);
        float s[8];
#pragma unroll
        for (int e = 0; e < 8; ++e) s[e] = 0.f;
        for (int t = lo; t < hi; ++t) { const bf16x8 x = *(const bf16x8*)(XC + (size_t)(row0 + t) * 1024 + ch);
#pragma unroll
            for (int e = 0; e < 8; ++e) s[e] += bf2f((unsigned short)x[e]); }
        const bf16x8 xs = *(const bf16x8*)(XC + (size_t)row * 1024 + ch);
        const float inv = 1.0f / (float)(hi - lo);
        uint4 o; o.x = pack2(s[0] * inv - bf2f((unsigned short)xs[0]), s[1] * inv - bf2f((unsigned short)xs[1])); o.y = pack2(s[2] * inv - bf2f((unsigned short)xs[2]), s[3] * inv - bf2f((unsigned short)xs[3]));
        o.z = pack2(s[4] * inv - bf2f((unsigned short)xs[4]), s[5] * inv - bf2f((unsigned short)xs[5])); o.w = pack2(s[6] * inv - bf2f((unsigned short)xs[6]), s[7] * inv - bf2f((unsigned short)xs[7]));
        *(uint4*)(PL + (size_t)row * 1024 + ch) = o;
    }
}
__device__ __forceinline__ float gelu_tanh(float x) { const float y = 0.7978845608028654f * (x + 0.044715f * x * x * x); const float t = 1.0f - 2.0f * __builtin_amdgcn_rcpf(1.0f + __expf(2.0f * y)); return 0.5f * x * (1.0f + t); }
__device__ void act_phase(const bf16_t* __restrict__ U, bf16_t* __restrict__ ACT, const float* __restrict__ cw, const float* __restrict__ cb) {
    const int tid = otid();
    for (int idx = blockIdx.x * 512 + tid; idx < MROWS * 352; idx += gridDim.x * 512) {
        const int row = idx / 352, ch = (idx % 352) * 8;
        const int T = row < MCTX ? 256 : 2048, row0 = row < MCTX ? (row & ~255) : MCTX + ((row - MCTX) & ~2047), tl = row - row0;
        const bf16_t* up = U + (size_t)row * 5632 + ch;
        const bf16x8 u0 = *(const bf16x8*)up, vv = *(const bf16x8*)(up + 2816);
        bf16x8 um = (bf16x8){0, 0, 0, 0, 0, 0, 0, 0}, upn = um;
        if (tl > 0) um = *(const bf16x8*)(up - 5632);
        if (tl < T - 1) upn = *(const bf16x8*)(up + 5632);
        float r[8];
#pragma unroll
        for (int e = 0; e < 8; ++e) { const float gff = cw[ch + e] * bf2f((unsigned short)um[e]) + cw[2816 + ch + e] * bf2f((unsigned short)u0[e]) + cw[5632 + ch + e] * bf2f((unsigned short)upn[e]) + cb[ch + e];
            r[e] = gelu_tanh(gff) * bf2f((unsigned short)vv[e]); }
        uint4 o; o.x = pack2(r[0], r[1]); o.y = pack2(r[2], r[3]); o.z = pack2(r[4], r[5]); o.w = pack2(r[6], r[7]);
        *(uint4*)(ACT + (size_t)row * 2816 + ch) = o;
    }
}

__device__ __forceinline__ void rope8(bf16x8& x1, bf16x8& x2, const float* __restrict__ cs, const float* __restrict__ sn) {
#pragma unroll
    for (int e = 0; e < 8; ++e) { const float a = bf2f((unsigned short)x1[e]), b = bf2f((unsigned short)x2[e]); const float c = cs[e], s = sn[e];
        x1[e] = (short)f2bf(a * c - b * s); x2[e] = (short)f2bf(a * s + b * c); }
}
constexpr int VT_OFF = 64 * 272;
__device__ void attn_unit(const Params& P, int l, int u, LAS unsigned char* lds) {
    int tid_ = threadIdx.x; asm volatile("" : "+v"(tid_));
    const int tid = tid_, w = tid >> 6, lane = tid & 63, fr = lane & 15, fq = lane >> 4;
    const bf16_t* Q = (const bf16_t*)(P.ws + OFF_XAQ) + (size_t)MROWS * 1024;
    const bf16_t* KB = (const bf16_t*)(P.ws + OFF_KB); const bf16_t* VB = (const bf16_t*)(P.ws + OFF_VB);
    const bf16_t* CK = (const bf16_t*)(P.ws + OFF_CK); const bf16_t* CV = (const bf16_t*)(P.ws + OFF_CV);
    bf16_t* YB = (bf16_t*)(P.ws + OFF_YB);
    const float* rc = (const float*)(P.ws + OFF_ROPE); const float* rs = rc + 2048;
    bool lat; int head, row0, T, qstart, bidx;
    if (u < 256) { lat = true; bidx = u >> 7; const int rem = u & 127; head = rem >> 4; qstart = (rem & 15) * 128; T = 2048; row0 = MCTX + bidx * 2048; }
    else { const int v = u - 256; lat = false; bidx = 0; const int seq = v >> 4, rem = v & 15; head = rem >> 1; qstart = (rem & 1) * 128; T = 256; row0 = seq * 256; }
    const int kvh = head >> 2;
    const int qpos = qstart + w * 16 + fr;
    bf16x8 qf[4];
    { const bf16_t* qp = Q + (size_t)(row0 + qpos) * 1024 + head * 128 + fq * 8;
#pragma unroll
      for (int kk = 0; kk < 4; ++kk) qf[kk] = *(const bf16x8*)(qp + kk * 32);
      if (lat) { rope8(qf[0], qf[1], rc + (qpos >> 6) * 32 + fq * 8, rs + (qpos >> 6) * 32 + fq * 8); rope8(qf[2], qf[3], rc + (qpos & 63) * 32 + fq * 8, rs + (qpos & 63) * 32 + fq * 8); } }
    float m_run = P.attn_sink[l * 8 + head]; float l_run = (fq == 0) ? 1.0f : 0.0f;
    f32x4 o[8];
#pragma unroll
    for (int dt = 0; dt < 8; ++dt) o[dt] = (f32x4){0.f, 0.f, 0.f, 0.f};
    int wlo = 0, nwt = 4;
    if (lat) { wlo = max(0, qstart - 128); const int whi = min(T, qstart + 256); nwt = (whi - wlo) >> 6; }
    const int ntiles = nwt + (lat ? 8 : 0);
    const float scale = 0.08838834764831845f;
    const int lkey = tid >> 3, lp = tid & 7, lcidx = lp < 4 ? lp : lp + 4;
    bf16x8 pk1, pk2, pv0, pv1;
    auto tile_src = [&](int ti, const bf16_t*& ksrc, const bf16_t*& vsrc, int& k0) {
        if (ti < nwt) { k0 = wlo + ti * 64; ksrc = KB + (size_t)(row0 + k0) * 256 + kvh * 128; vsrc = VB + (size_t)(row0 + k0) * 256 + kvh * 128; }
        else { k0 = (ti - nwt) * 64; const size_t o_ = ((size_t)((l * 2 + bidx) * 512 + k0)) * 256 + kvh * 128; ksrc = CK + o_; vsrc = CV + o_; } };
    { const bf16_t *ksrc, *vsrc; int k0; tile_src(0, ksrc, vsrc, k0);
      const bf16_t* kr = ksrc + (size_t)lkey * 256; pk1 = *(const bf16x8*)(kr + lcidx * 8); pk2 = *(const bf16x8*)(kr + (lcidx + 4) * 8);
      pv0 = *(const bf16x8*)(vsrc + (size_t)lane * 256 + w * 8); pv1 = *(const bf16x8*)(vsrc + (size_t)lane * 256 + (w + 8) * 8); }
    for (int ti = 0; ti < ntiles; ++ti) {
        const bool win = ti < nwt; const int k0 = win ? wlo + ti * 64 : (ti - nwt) * 64;
        __syncthreads();
        { bf16x8 x1 = pk1, x2 = pk2;
          if (lat && win) { const int kp = k0 + lkey; const int pos = (lcidx < 8) ? (kp >> 6) : (kp & 63); const int i0 = (lcidx & 3) * 8; rope8(x1, x2, rc + pos * 32 + i0, rs + pos * 32 + i0); }
          *(LAS bf16x8*)(lds + lkey * 272 + lcidx * 16) = x1; *(LAS bf16x8*)(lds + lkey * 272 + (lcidx + 4) * 16) = x2; }
#pragma unroll
        for (int e = 0; e < 8; ++e) { *(LAS bf16_t*)(lds + VT_OFF + (w * 8 + e) * 144 + lane * 2) = (bf16_t)pv0[e]; *(LAS bf16_t*)(lds + VT_OFF + ((w + 8) * 8 + e) * 144 + lane * 2) = (bf16_t)pv1[e]; }
        __syncthreads();
        if (ti + 1 < ntiles) { const bf16_t *ksrc, *vsrc; int k0n; tile_src(ti + 1, ksrc, vsrc, k0n);
          const bf16_t* kr = ksrc + (size_t)lkey * 256; pk1 = *(const bf16x8*)(kr + lcidx * 8); pk2 = *(const bf16x8*)(kr + (lcidx + 4) * 8);
          pv0 = *(const bf16x8*)(vsrc + (size_t)lane * 256 + w * 8); pv1 = *(const bf16x8*)(vsrc + (size_t)lane * 256 + (w + 8) * 8); }
        f32x4 s[4];
#pragma unroll
        for (int nt = 0; nt < 4; ++nt) { s[nt] = (f32x4){0.f, 0.f, 0.f, 0.f};
#pragma unroll
            for (int kk = 0; kk < 4; ++kk) { const bf16x8 a = *(const LAS bf16x8*)(lds + (nt * 16 + fr) * 272 + kk * 64 + fq * 16); s[nt] = __builtin_amdgcn_mfma_f32_16x16x32_bf16(a, qf[kk], s[nt], 0, 0, 0); } }
        float mt = -3.0e38f;
#pragma unroll
        for (int nt = 0; nt < 4; ++nt)
#pragma unroll
            for (int j = 0; j < 4; ++j) { float v = s[nt][j] * scale;
                if (lat && win) { const int kp = k0 + nt * 16 + fq * 4 + j; const int dd = qpos - kp; if (dd > 128 || dd < -128) v = -1.0e30f; }
                s[nt][j] = v; mt = fmaxf(mt, v); }
        mt = fmaxf(mt, __shfl_xor(mt, 16)); mt = fmaxf(mt, __shfl_xor(mt, 32));
        const float mn = fmaxf(m_run, mt); const float alpha = __expf(m_run - mn); m_run = mn;
        float ps = 0.f;
#pragma unroll
        for (int nt = 0; nt < 4; ++nt)
#pragma unroll
            for (int j = 0; j < 4; ++j) { const float p = __expf(s[nt][j] - mn); ps += p; s[nt][j] = p; }
        l_run = l_run * alpha + ps;
#pragma unroll
        for (int dt = 0; dt < 8; ++dt) o[dt] = o[dt] * alpha;
#pragma unroll
        for (int s2 = 0; s2 < 2; ++s2) {
            u32x4 pu; pu[0] = pack2(s[2 * s2][0], s[2 * s2][1]); pu[1] = pack2(s[2 * s2][2], s[2 * s2][3]); pu[2] = pack2(s[2 * s2 + 1][0], s[2 * s2 + 1][1]); pu[3] = pack2(s[2 * s2 + 1][2], s[2 * s2 + 1][3]);
            const bf16x8 pf = __builtin_bit_cast(bf16x8, pu);
#pragma unroll
            for (int dt = 0; dt < 8; ++dt) {
                const bf16x4 lo = *(const LAS bf16x4*)(lds + VT_OFF + (dt * 16 + fr) * 144 + (s2 * 32 + fq * 4) * 2);
                const bf16x4 hi = *(const LAS bf16x4*)(lds + VT_OFF + (dt * 16 + fr) * 144 + (s2 * 32 + 16 + fq * 4) * 2);
                const bf16x8 af = __builtin_shufflevector(lo, hi, 0, 1, 2, 3, 4, 5, 6, 7);
                o[dt] = __builtin_amdgcn_mfma_f32_16x16x32_bf16(af, pf, o[dt], 0, 0, 0);
            }
        }
    }
    float lt = l_run; lt += __shfl_xor(lt, 16); lt += __shfl_xor(lt, 32);
    const float inv = 1.0f / lt;
    bf16_t* yp = YB + (size_t)(row0 + qpos) * 1024 + head * 128 + fq * 4;
#pragma unroll
    for (int dt = 0; dt < 8; ++dt) { uint2 pk; pk.x = pack2(o[dt][0] * inv, o[dt][1] * inv); pk.y = pack2(o[dt][2] * inv, o[dt][3] * inv); *(uint2*)(yp + dt * 16) = pk; }
}

template <int MODE, int D>
__device__ __forceinline__ void lru_dir(const Params& P, int l, int s, int cchunk, int h, LAS unsigned char* lds, int w, int fr, int fq) {
    const bool lat = s >= 32; const int row0 = lat ? MCTX + (s - 32) * 2048 : s * 256; const int t0 = cchunk * 256;
    const bf16_t* GW = (const bf16_t*)(P.ws + OFF_GW);
    bf16_t* YA = (bf16_t*)(P.ws + OFF_YA);
    float* SUMM = (float*)(P.ws + OFF_SUMM);
    const int chl = 16 * w + fr, ch = h * 128 + chl;
    bf16x8 bwa[4], bwx[4];
    { const bf16_t* gp = GW + ((size_t)(D * 8 + h) * 256 + chl) * 128 + fq * 8;
#pragma unroll
      for (int kk = 0; kk < 4; ++kk) { bwa[kk] = *(const bf16x8*)(gp + kk * 32); bwx[kk] = *(const bf16x8*)(gp + 128 * 128 + kk * 32); } }
    const int pidx = (l * 2 + D) * 1024 + ch;
    const float ba = P.lru_ba[pidx], bx = P.lru_bx[pidx];
    const float lam = P.lru_lambda[pidx];
    const float c8 = -8.0f * log1pf(expf(-lam));
    float carry = 0.f;
    if (MODE == 0 && lat) {
        const int b = s - 32;
        carry = P.state_lru[((size_t)(b * 2 + l) * 2 + D) * 1024 + ch];
        if (D == 0) { for (int cc = 0; cc < cchunk; ++cc) { const float* sp = SUMM + ((size_t)((b * 2 + 0) * 8 + cc) * 1024 + ch) * 2; carry = sp[1] + sp[0] * carry; } }
        else { for (int cc = 7; cc > cchunk; --cc) { const float* sp = SUMM + ((size_t)((b * 2 + 1) * 8 + cc) * 1024 + ch) * 2; carry = sp[1] + sp[0] * carry; } }
    }
    float ptot = 1.0f;
#pragma unroll 1
    for (int sci = 0; sci < 4; ++sci) {
        const int sc = D == 0 ? sci : 3 - sci;
        f32x4 r[4], g[4];
#pragma unroll
        for (int m = 0; m < 4; ++m) { r[m] = (f32x4){0.f, 0.f, 0.f, 0.f}; g[m] = (f32x4){0.f, 0.f, 0.f, 0.f};
#pragma unroll
            for (int kk = 0; kk < 4; ++kk) { const bf16x8 a = *(const LAS bf16x8*)(lds + (sc * 64 + m * 16 + fr) * 272 + kk * 64 + fq * 16);
                r[m] = __builtin_amdgcn_mfma_f32_16x16x32_bf16(a, bwa[kk], r[m], 0, 0, 0); g[m] = __builtin_amdgcn_mfma_f32_16x16x32_bf16(a, bwx[kk], g[m], 0, 0, 0); } }
#pragma unroll
        for (int mi = 0; mi < 4; ++mi) {
            const int m = D == 0 ? mi : 3 - mi;
            float av[4], bv[4];
#pragma unroll
            for (int j = 0; j < 4; ++j) {
                const float ea = 1.0f + __expf(-(r[m][j] + ba)), eb = 1.0f + __expf(-(g[m][j] + bx));
                const float inv = __builtin_amdgcn_rcpf(ea * eb);
                const float rr = inv * eb, ii = inv * ea;
                const float la = c8 * rr; const float a = __expf(la); const float z = 2.0f * la;
                const float em = (z > -0.05f) ? -z * (1.0f + z * (0.5f + z * (0.16666667f + z * 0.041666667f))) : 1.0f - a * a;
                const float x = bf2f(*(const LAS bf16_t*)(lds + (sc * 64 + m * 16 + fq * 4 + j) * 272 + chl * 2));
                av[j] = a; bv[j] = __builtin_amdgcn_sqrtf(em) * ii * x;
            }
            float p4, h4;
            p4 = av[0] * av[1] * av[2] * av[3];
            if (D == 0) h4 = ((bv[0] * av[1] + bv[1]) * av[2] + bv[2]) * av[3] + bv[3];
            else h4 = ((bv[3] * av[2] + bv[2]) * av[1] + bv[1]) * av[0] + bv[0];
            float pq[4], hq[4];
#pragma unroll
            for (int f = 0; f < 4; ++f) { pq[f] = __shfl(p4, fr + 16 * f); hq[f] = __shfl(h4, fr + 16 * f); }
            float cin = carry, mycin = 0.f;
#pragma unroll
            for (int fi = 0; fi < 4; ++fi) { const int f = D == 0 ? fi : 3 - fi; if (f == fq) mycin = cin; cin = hq[f] + pq[f] * cin; }
            carry = cin;
            if (MODE == 1) ptot *= pq[0] * pq[1] * pq[2] * pq[3];
            if (MODE == 0) {
                float hh = mycin; float y[4];
#pragma unroll
                for (int ji = 0; ji < 4; ++ji) { const int j = D == 0 ? ji : 3 - ji; hh = av[j] * hh + bv[j]; y[j] = hh; }
#pragma unroll
                for (int j = 0; j < 4; ++j) {
                    bf16_t* yp = YA + (size_t)(row0 + t0 + sc * 64 + m * 16 + fq * 4 + j) * 1024 + ch;
                    if (D == 0) *yp = f2bf(y[j]);
                    else *yp = f2bf(bf2f(*yp) + y[j]);
                }
            }
        }
    }
    if (MODE == 0 && !lat && fq == 0) P.out[OUT_H + ((size_t)(s * 2 + l) * 2 + D) * 1024 + ch] = carry;
    if (MODE == 1 && fq == 0) { float* sp = SUMM + ((size_t)(((s - 32) * 2 + D) * 8 + cchunk) * 1024 + ch) * 2; sp[0] = ptot; sp[1] = carry; }
}
template <int MODE>
__device__ void lru_unit(const Params& P, int l, int s, int cchunk, int h, LAS unsigned char* lds) {
    int tid_ = threadIdx.x; asm volatile("" : "+v"(tid_));
    const int tid = tid_, w = tid >> 6, lane = tid & 63, fr = lane & 15, fq = lane >> 4;
    const bool lat = s >= 32; const int T = lat ? 2048 : 256; const int row0 = lat ? MCTX + (s - 32) * 2048 : s * 256; const int t0 = cchunk * 256;
    const bf16_t* XA = (const bf16_t*)(P.ws + OFF_XAQ);
    __syncthreads();
    {
        const int ck = tid & 15, ch = h * 128 + ck * 8;
        const float* cw = P.lru_conv + (size_t)l * 4096 + ch; const float* cb = P.lru_conv_b + l * 1024 + ch;
        float wk[4][8], bk[8];
#pragma unroll
        for (int e = 0; e < 8; ++e) { bk[e] = cb[e];
#pragma unroll
            for (int k = 0; k < 4; ++k) wk[k][e] = cw[k * 1024 + e]; }
#pragma unroll 2
        for (int it = 0; it < 8; ++it) {
            const int t = (tid >> 4) + it * 32;
            float a8[8];
#pragma unroll
            for (int e = 0; e < 8; ++e) a8[e] = bk[e];
#pragma unroll
            for (int k = 0; k < 4; ++k) { const int tt = t0 + t + k - 2;
                if (tt >= 0 && tt < T) { const bf16x8 x = *(const bf16x8*)(XA + (size_t)(row0 + tt) * 1024 + ch);
#pragma unroll
                    for (int e = 0; e < 8; ++e) a8[e] += wk[k][e] * bf2f((unsigned short)x[e]); } }
            u32x4 o; o.x = pack2(a8[0], a8[1]); o.y = pack2(a8[2], a8[3]); o.z = pack2(a8[4], a8[5]); o.w = pack2(a8[6], a8[7]);
            *(LAS u32x4*)(lds + t * 272 + ck * 16) = o;
        }
    }
    __syncthreads();
    lru_dir<MODE, 0>(P, l, s, cchunk, h, lds, w, fr, fq);
    lru_dir<MODE, 1>(P, l, s, cchunk, h, lds, w, fr, fq);
}


#define XB_TMO      128
#define XB_XCNT(j)  (256  + 64 * (j))
#define XB_XSUB(j)  (1280 + 64 * (j))
#define XB_XGEN(j)  (2304 + 64 * (j))
#define XB_TOP      3328
#define XB_TOPGEN   3392
#define XCD_BAR_WORDS 3456
#define XB_SPIN_CAP (1u << 18)
__device__ __forceinline__ unsigned xb_ld(unsigned* p)              { return __hip_atomic_load(p, __ATOMIC_RELAXED, __HIP_MEMORY_SCOPE_AGENT); }
__device__ __forceinline__ unsigned xb_add(unsigned* p, unsigned v) { return __hip_atomic_fetch_add(p, v, __ATOMIC_RELAXED, __HIP_MEMORY_SCOPE_AGENT); }
__device__ __forceinline__ unsigned xb_xcc_id() { return (unsigned)__builtin_amdgcn_s_getreg((3 << 11) | 20) & 0xFu; }
#define XB_SPIN(cond, bar) do { unsigned _sp = 0; while (cond) { __builtin_amdgcn_s_sleep(1); \
    if ((++_sp & 255u) == 0u) { if (xb_ld(&(bar)[XB_TMO])) break; if (_sp > XB_SPIN_CAP) { atomicAdd(&(bar)[XB_TMO], 1u); break; } } } } while (0)
struct XcdBarrier { unsigned* bar; unsigned x; volatile LAS unsigned* st; };
__device__ __forceinline__ XcdBarrier xcd_barrier_post(unsigned* bar, volatile LAS unsigned* st) {
    XcdBarrier b; b.bar = bar; b.x = xb_xcc_id(); b.st = st;
    if (threadIdx.x == 0) (void)xb_add(&bar[XB_XCNT(b.x)], 1u);
    return b;
}
__device__ __forceinline__ void xcd_barrier_complete(unsigned* bar, unsigned x, unsigned& nloc, unsigned& nx) {
    const unsigned G = gridDim.x * gridDim.y * gridDim.z;
    unsigned sum, cnt, mine, sp = 0u;
    for (;;) {
        sum = 0u; cnt = 0u; mine = 0u;
#pragma unroll
        for (unsigned j = 0; j < 16; ++j) { const unsigned c = xb_ld(&bar[XB_XCNT(j)]); sum += c; cnt += (c > 0u) ? 1u : 0u; mine = (j == x) ? c : mine; }
        if (sum == G) break;
        __builtin_amdgcn_s_sleep(1);
        if ((++sp & 255u) == 0u) { if (xb_ld(&bar[XB_TMO])) break; if (sp > XB_SPIN_CAP) { atomicAdd(&bar[XB_TMO], 1u); break; } }
    }
    nloc = mine > 0u ? mine : 1u; nx = cnt > 0u ? cnt : 1u;
}
__device__ __noinline__ void xcd_barrier_(unsigned* bbar, unsigned bx, volatile LAS unsigned* bst) {
    XcdBarrier b; b.bar = bbar; b.x = bx; b.st = bst;
    asm volatile("s_waitcnt vmcnt(0)" ::: "memory");
    __syncthreads();
    if (threadIdx.x == 0) {
        unsigned* bar = b.bar;
        __builtin_amdgcn_s_waitcnt(0);
        unsigned nloc = b.st[0], nx = b.st[1];
        if (nloc == 0u) { xcd_barrier_complete(bar, b.x, nloc, nx); b.st[0] = nloc; b.st[1] = nx; }
        const unsigned old = xb_add(&bar[XB_XSUB(b.x)], 1u);
        const unsigned gen = old / nloc;
        if (old + 1u == (gen + 1u) * nloc) {
            __builtin_amdgcn_fence(__ATOMIC_RELEASE, "agent");
            asm volatile("s_waitcnt vmcnt(0)" ::: "memory");
            const unsigned og = xb_add(&bar[XB_TOP], 1u);
            const unsigned tg = og / nx;
            if (og + 1u == (tg + 1u) * nx) xb_add(&bar[XB_TOPGEN], 1u);
            else XB_SPIN(xb_ld(&bar[XB_TOPGEN]) == tg, bar);
            __builtin_amdgcn_fence(__ATOMIC_ACQUIRE, "agent");
            xb_add(&bar[XB_XGEN(b.x)], 1u);
            asm volatile("s_waitcnt vmcnt(0)" ::: "memory");
        } else {
            XB_SPIN(xb_ld(&bar[XB_XGEN(b.x)]) == gen, bar);
            __builtin_amdgcn_fence(__ATOMIC_ACQUIRE, "agent");
            asm volatile("s_waitcnt vmcnt(0)" ::: "memory");
        }
    }
    __syncthreads();
}

#ifndef REPMASK
#define REPMASK 0
#endif
#define REPLOOP(i) _Pragma("unroll 1") for (int rep_ = 0; rep_ < 1 + ((REPMASK >> (i)) & 1); ++rep_)
__global__ __launch_bounds__(512, 2) void mega(Params P) {
    extern __shared__ __attribute__((aligned(16))) unsigned char shm[];
    LAS unsigned char* lds = (LAS unsigned char*)shm;
    cg::grid_group grid = cg::this_grid();
    if (threadIdx.x == 0) *(LAS u32x4*)(lds + 131072) = (u32x4){0u, 0u, 0u, 0u};
    __syncthreads();
    const XcdBarrier xb = xcd_barrier_post((unsigned*)(P.ws + OFF_BAR), (volatile LAS unsigned*)(lds + 131072));
    const int G = gridDim.x, c = blockIdx.x;
    unsigned char* ws = P.ws;
    float* X = P.out;
    bf16_t* H = (bf16_t*)(ws + OFF_H);
    const float* MOD = (const float*)(ws + OFF_MOD);

    phase0(P, lds);
    grid.sync();
    for (int l = 0; l < 2; ++l) {
        const float* mod = MOD + (size_t)l * 3 * 6144;
        REPLOOP(0) convert_weights(P, l, lds, 0, (G > 192) ? 2624 : 4992, c, G);
        REPLOOP(1) norm_phase(X, P.norm1 + l * 1024, mod, 0, 1024, H);
        xcd_barrier_(xb.bar, xb.x, xb.st);
        REPLOOP(2) { Sched S{(const char*)H, (const char*)(ws + OFF_WIN), 1024, 1024, 0, 48, 14, G, c};
          EpiIn E{(bf16_t*)(ws + OFF_XAQ), (bf16_t*)(ws + OFF_XC), (bf16_t*)(ws + OFF_KB), (bf16_t*)(ws + OFF_VB), P.out + OUT_K, P.out + OUT_V, l};
          gemm_phase(lds, S, 1024, E); }
        xcd_barrier_(xb.bar, xb.x, xb.st);
        REPLOOP(3) pool_phase((const bf16_t*)(ws + OFF_XC), (bf16_t*)(ws + OFF_PL));
        for (int it = c; it < 1152; it += G) {
            if (it < 256) { REPLOOP(4) attn_unit(P, l, it, lds); }
            else if (it < 640) { const int v = it - 256;
                if (v < 256) { REPLOOP(5) lru_unit<0>(P, l, v >> 3, 0, v & 7, lds); }
                else { const int q = v - 256; REPLOOP(5) lru_unit<1>(P, l, 32 + (q >> 6), (q >> 3) & 7, q & 7, lds); } }
            else { REPLOOP(7) attn_unit(P, l, it - 640 + 256, lds); }
        }
        xcd_barrier_(xb.bar, xb.x, xb.st);
        { Sched S{(const char*)(ws + OFF_PL), (const char*)(ws + OFF_PW), 1024, 256, 256, 48, 4, G, c};
          EpiPool E{(bf16_t*)(ws + OFF_XC), P.pool_scale + l * 1024};
          gemm_phase(lds, S, 256, E); }
#ifndef NO_LRU
        for (int it = G - 1 - c; it < 128; it += G) lru_unit<0>(P, l, 32 + (it >> 6), (it >> 3) & 7, it & 7, lds);
#endif
        xcd_barrier_(xb.bar, xb.x, xb.st);
        REPLOOP(6) { MergeSched S{(const char*)ws, 1024, 1024, c};
          EpiMerge E{(bf16_t*)(ws + OFF_GT), P.b_gate + l * 3072, (float*)(ws + OFF_XAQ), (bf16_t*)(ws + OFF_PL)};
          gemm_phase(lds, S, 1024, E); }
        if (G > 192 && c >= 192) convert_weights(P, l, lds, 2624, 4992, c - 192, G - 192);
        xcd_barrier_(xb.bar, xb.x, xb.st);
        { Sched S{(const char*)(ws + OFF_PL), (const char*)(ws + OFF_WOUT), 1024, 1024, 0, 48, 4, G, c};
          EpiRes E{X, mod, 2048};
          gemm_phase(lds, S, 1024, E); }
        xcd_barrier_(xb.bar, xb.x, xb.st);
        norm_phase(X, P.norm2 + l * 1024, mod, 3072, 4096, H);
        xcd_barrier_(xb.bar, xb.x, xb.st);
        REPLOOP(9) { Sched S{(const char*)H, (const char*)(ws + OFF_WUP), 1024, 1024, 0, 48, 22, G, c};
          EpiBf E{(bf16_t*)(ws + OFF_U), 5632};
          gemm_phase(lds, S, 1024, E); }
        xcd_barrier_(xb.bar, xb.x, xb.st);
        REPLOOP(10) act_phase((const bf16_t*)(ws + OFF_U), (bf16_t*)(ws + OFF_ACT), P.ffn_conv + (size_t)l * 3 * 2816, P.ffn_conv_b + l * 2816);
        xcd_barrier_(xb.bar, xb.x, xb.st);
        { Sched S{(const char*)(ws + OFF_ACT), (const char*)(ws + OFF_WDN), 2816, 2816, 0, 48, 4, G, c};
          EpiRes E{X, mod, 5120};
          gemm_phase(lds, S, 2816, E); }
        xcd_barrier_(xb.bar, xb.x, xb.st);
    }
    final_norm_phase(X, P.final_norm);
}

extern "C" void kernel_launch(void* const* d_in, const int* in_sizes, int n_in, void* d_out, int out_size, void* d_ws, size_t ws_size, hipStream_t stream) {
    constexpr size_t kDynLds = 131072 + 16;
    static int grid_blocks = 0;
    if (!grid_blocks) {
        int dev = 0, cus = 0, per_cu = 0;
        hipGetDevice(&dev);
        hipDeviceGetAttribute(&cus, hipDeviceAttributeMultiprocessorCount, dev);
        hipFuncSetAttribute((const void*)mega, hipFuncAttributeMaxDynamicSharedMemorySize, (int)kDynLds);
        hipOccupancyMaxActiveBlocksPerMultiprocessor(&per_cu, mega, 512, kDynLds);
        if (per_cu < 1) per_cu = 1;
        if (per_cu > 1) per_cu = 1;
        grid_blocks = cus * per_cu;
    }
    Params p{};
    const float** pp = (const float**)&p;
    for (int i = 0; i < 30; ++i) pp[i] = (const float*)d_in[i];
    p.out = (float*)d_out; p.ws = (unsigned char*)d_ws;
    if (ws_size < OFF_END) { fprintf(stderr, "workspace too small: %zu < %zu\n", ws_size, (size_t)OFF_END); }
    hipMemsetAsync((unsigned char*)d_ws + OFF_BAR, 0, 16384, stream);
    void* args[] = {&p};
    hipError_t e = hipLaunchCooperativeKernel((void*)mega, dim3(grid_blocks), dim3(512), args, kDynLds, stream);
    if (e != hipSuccess) fprintf(stderr, "cooperative launch failed: %s (grid %d)\n", hipGetErrorString(e), grid_blocks);
}
```

```cpp
#include <hip/hip_runtime.h>
#include <hip/hip_cooperative_groups.h>
#include <cstdio>
namespace cg = cooperative_groups;

#define LAS __attribute__((address_space(3)))
typedef unsigned short bf16_t;
typedef short bf16x8 __attribute__((ext_vector_type(8)));
typedef float f32x4 __attribute__((ext_vector_type(4)));
typedef unsigned u32x4 __attribute__((ext_vector_type(4)));
typedef unsigned u32x2 __attribute__((ext_vector_type(2)));
typedef short bf16x4 __attribute__((ext_vector_type(4)));

constexpr int MROWS = 12288, MCTX = 8192;
constexpr size_t S24 = (size_t)MROWS * 1024 * 2;
constexpr size_t OFF_WIN = 0;
constexpr size_t OFF_WBR = OFF_WIN + (size_t)6656 * 1024 * 2;
constexpr size_t OFF_WOUT = OFF_WBR + (size_t)3 * 1024 * 1024 * 2;
constexpr size_t OFF_WUP = OFF_WOUT + (size_t)1024 * 1024 * 2;
constexpr size_t OFF_WDN = OFF_WUP + (size_t)5632 * 1024 * 2;
constexpr size_t OFF_GW = OFF_WDN + (size_t)1024 * 2816 * 2;
constexpr size_t OFF_PW = OFF_GW + (size_t)2 * 8 * 256 * 128 * 2;
constexpr size_t OFF_MOD = OFF_PW + (size_t)4 * 256 * 256 * 2;
constexpr size_t OFF_CK = OFF_MOD + (size_t)2 * 3 * 6144 * 4;
constexpr size_t OFF_CV = OFF_CK + (size_t)2 * 2 * 512 * 256 * 2;
constexpr size_t OFF_ROPE = OFF_CV + (size_t)2 * 2 * 512 * 256 * 2;
constexpr size_t OFF_SUMM = OFF_ROPE + (size_t)2 * 64 * 32 * 4;
constexpr size_t OFF_BAR = OFF_SUMM + (size_t)2 * 2 * 16 * 1024 * 2 * 4;
constexpr size_t OFF_ACT0 = OFF_BAR + 16384;
constexpr size_t OFF_XAQ = OFF_ACT0;
constexpr size_t OFF_XC = OFF_XAQ + 2 * S24;
constexpr size_t OFF_KB = OFF_XC + S24;
constexpr size_t OFF_VB = OFF_KB + (size_t)MROWS * 256 * 2;
constexpr size_t OFF_GT = OFF_VB + (size_t)MROWS * 256 * 2;
constexpr size_t OFF_YB = OFF_GT + S24;
constexpr size_t OFF_PL = OFF_YB + S24;
constexpr size_t OFF_YA = OFF_PL + S24;
constexpr size_t OFF_H = OFF_YA + S24;
constexpr size_t OFF_END = OFF_H + S24;
constexpr size_t OFF_U = OFF_XAQ;
constexpr size_t OFF_ACT = OFF_PL;
constexpr size_t OUT_K = (size_t)MROWS * 1024;
constexpr size_t OUT_V = OUT_K + (size_t)32 * 2 * 256 * 256;
constexpr size_t OUT_H = OUT_V + (size_t)32 * 2 * 256 * 256;

struct Params {
    const float *x_prompt, *x_sample, *cache_k, *cache_v, *state_lru, *c, *c_ctx, *w_ada, *b_ada, *norm1, *norm2,
        *w_in, *b_gate, *lru_conv, *lru_conv_b, *lru_wa, *lru_ba, *lru_wx, *lru_bx, *lru_lambda, *attn_sink,
        *pool_w, *pool_scale, *w_branch, *w_out, *ffn_up, *ffn_conv, *ffn_conv_b, *ffn_down, *final_norm;
    float* out; unsigned char* ws;
};

__device__ __forceinline__ unsigned short f2bf(float f) { unsigned u = __float_as_uint(f); u += 0x7FFFu + ((u >> 16) & 1u); return (unsigned short)(u >> 16); }
__device__ __forceinline__ float bf2f(unsigned short b) { return __uint_as_float(((unsigned)b) << 16); }
__device__ __forceinline__ unsigned pack2(float a, float b) { return (unsigned)f2bf(a) | ((unsigned)f2bf(b) << 16); }
__device__ __forceinline__ int otid() { int t = threadIdx.x; asm volatile("" : "+v"(t)); return t; }
__device__ __forceinline__ float sigmoidf_(float x) { return __builtin_amdgcn_rcpf(1.0f + __expf(-x)); }

constexpr int HTB = 128 * 64 * 2;
__device__ __forceinline__ int lds_byte(int r, int c) { const int st = (r >> 4) * 2 + (c >> 5), rr = r & 15, cc = c & 31, ob = rr * 64 + cc * 2; return st * 1024 + (ob ^ (((ob >> 9) & 1) << 5)); }
__device__ __forceinline__ void stage_rc(int b, int& R, int& C) { const int st = b / 1024, sb = b % 1024, swz = sb ^ (((sb >> 9) & 1) << 5); R = (st >> 1) * 16 + swz / 64; C = (st & 1) * 32 + (swz % 64) / 2; }

struct Unit { const char* a; const char* b; int pm, pn, z; };
struct Sched {
    const char* A; const char* B; int lda, ldb, acol, nM, nN, G, c;
    __device__ __forceinline__ bool next(int i, Unit& u) const {
        const long L = (long)i * G + c; const int nwg = nM * nN; if (L >= nwg) return false;
        int wgid = (int)L; { const int q = nwg / 8, r = nwg % 8, xcd = wgid % 8, off = wgid / 8; wgid = (xcd < r ? xcd * (q + 1) : r * (q + 1) + (xcd - r) * q) + off; }
        const int nig = 8 * nN, gid = wgid / nig, fm = gid * 8, gsz = (nM - fm) < 8 ? (nM - fm) : 8;
        u.pm = fm + ((wgid % nig) % gsz); u.pn = (wgid % nig) / gsz;
        u.a = A + ((size_t)u.pm * 256 * lda + (size_t)u.pn * acol) * 2; u.b = B + (size_t)u.pn * 256 * ldb * 2; u.z = 0; return true;
    }
};
struct MergeSched {
    const char* ws; int lda, ldb, c;
    __device__ __forceinline__ bool next(int i, Unit& u) const {
        if (c >= 192 || i >= 6) return false;
        const int nwg = 192, nN = 4, nM = 48;
        int wgid = c; { const int q = nwg / 8, xcd = wgid % 8, off = wgid / 8; wgid = xcd * q + off; }
        const int nig = 8 * nN, gid = wgid / nig, fm = gid * 8, gsz = (nM - fm) < 8 ? (nM - fm) : 8;
        u.pm = fm + ((wgid % nig) % gsz); u.pn = (wgid % nig) / gsz; u.z = i;
        const int j = i >> 1;
        const size_t aoff = (size_t)u.pm * 256 * 1024 * 2;
        size_t ao = OFF_H, bo = OFF_WIN + (size_t)3584 * 1024 * 2;
        if (i & 1) { bo = OFF_WBR; ao = OFF_YA; if (j == 1) ao = OFF_YB; if (j == 2) ao = OFF_XC; }
        u.a = ws + ao + aoff; u.b = ws + bo + ((size_t)j * 1024 + (size_t)u.pn * 256) * 1024 * 2;
        return true;
    }
};

template <class Epi, class SchedT>
__device__ __forceinline__ void gemm_phase(LAS unsigned char* lds, const SchedT& S, const int K_, const Epi& E) {
    int K = K_; asm volatile("" : "+s"(K));
    int tid_ = threadIdx.x; asm volatile("" : "+v"(tid_));
    const int tid = tid_, wid = __builtin_amdgcn_readfirstlane(tid >> 6), lane = tid & 63, wr = wid >> 2, wc = wid & 3, fr = lane & 15, fq = lane >> 4;
    const int nt = K / 64;
    unsigned voffA[2], voffB[2];
#pragma unroll
    for (int i = 0; i < 2; ++i) { int R, C; stage_rc(tid * 16 + i * 8192, R, C); voffA[i] = (unsigned)(R * S.lda + C) * 2u; voffB[i] = (unsigned)(R * S.ldb + C) * 2u; }
    const size_t kstep = 128;
    const size_t hstepA = (size_t)128 * S.lda * 2, hstepB = (size_t)128 * S.ldb * 2;
    const unsigned ldsw = (unsigned)wid * 1024u;
    const int aoff = lds_byte(wr * 64 + fr, fq * 8), boff = lds_byte(wc * 32 + fr, fq * 8);
#define G_SA(b, h) (((b) * 2 + (h)) * HTB)
#define G_SB(b, h) ((4 + (b) * 2 + (h)) * HTB)
#define G_STAGE(bufoff, gbase, voff) do { _Pragma("unroll") for (int _i = 0; _i < 2; ++_i) \
        __builtin_amdgcn_global_load_lds((const unsigned*)((const char*)(gbase) + (voff)[_i]), (LAS unsigned*)(lds + (bufoff) + ldsw + _i * 8192), 16, 0, 0); } while (0)
#define G_LDA(dst, b, h) do { _Pragma("unroll") for (int m = 0; m < 4; ++m) _Pragma("unroll") for (int k = 0; k < 2; ++k) dst[m][k] = *(const LAS bf16x8*)(lds + G_SA(b, h) + aoff + m * 2048 + k * 1024); } while (0)
#define G_LDB(dst, b, h) do { _Pragma("unroll") for (int n = 0; n < 2; ++n) _Pragma("unroll") for (int k = 0; k < 2; ++k) dst[n][k] = *(const LAS bf16x8*)(lds + G_SB(b, h) + boff + n * 2048 + k * 1024); } while (0)
#define G_MMA(ai, bj, At, Bt) do { __builtin_amdgcn_s_setprio(1); _Pragma("unroll") for (int m = 0; m < 4; ++m) _Pragma("unroll") for (int n = 0; n < 2; ++n) _Pragma("unroll") for (int k = 0; k < 2; ++k) \
        acc[ai][bj][m][n] = __builtin_amdgcn_mfma_f32_16x16x32_bf16(Bt[n][k], At[m][k], acc[ai][bj][m][n], 0, 0, 0); __builtin_amdgcn_s_setprio(0); } while (0)
#define G_WAIT_V(n) asm volatile("s_waitcnt vmcnt(" #n ")" ::: "memory")
#define G_WAIT_L(n) asm volatile("s_waitcnt lgkmcnt(" #n ")" ::: "memory")
#define G_BAR __builtin_amdgcn_s_barrier()
#define G_SCHED __builtin_amdgcn_sched_barrier(0)
    Unit cur, nxt; int ui = 0;
    if (!S.next(0, cur)) return;
    f32x4 acc[2][2][4][2];
#pragma unroll
    for (int a = 0; a < 2; ++a)
#pragma unroll
        for (int b = 0; b < 2; ++b)
#pragma unroll
            for (int m = 0; m < 4; ++m)
#pragma unroll
                for (int n = 0; n < 2; ++n) acc[a][b][m][n] = (f32x4){0.f, 0.f, 0.f, 0.f};
    bf16x8 At[4][2], B0[2][2], B1[2][2];
    const char* cA = cur.a; const char* cB = cur.b;
    G_STAGE(G_SB(0, 0), cB, voffB); G_STAGE(G_SA(0, 0), cA, voffA); G_STAGE(G_SB(0, 1), cB + hstepB, voffB); G_STAGE(G_SA(0, 1), cA + hstepA, voffA);
    if (wr == 1) G_BAR;
    G_WAIT_V(4); G_BAR;
    G_STAGE(G_SB(1, 0), cB + kstep, voffB); G_STAGE(G_SA(1, 0), cA + kstep, voffA); G_STAGE(G_SB(1, 1), cB + hstepB + kstep, voffB);
    G_WAIT_V(6); G_BAR;
    for (;;) {
        const bool has_next = S.next(ui + 1, nxt);
        const char* nA = has_next ? nxt.a : cA; const char* nB = has_next ? nxt.b : cB;
        for (int t = 0; t < nt; t += 2) {
            const bool last = (t == nt - 2);
            const char* a1 = cA + (size_t)(t + 1) * kstep;
            const char* a2 = last ? nA : cA + (size_t)(t + 2) * kstep; const char* b2 = last ? nB : cB + (size_t)(t + 2) * kstep;
            const char* a3 = a2 + kstep; const char* b3 = b2 + kstep;
            G_LDB(B0, 0, 0); G_SCHED; G_LDA(At, 0, 0); G_STAGE(G_SA(1, 1), a1 + hstepA, voffA);
            G_WAIT_L(8); G_BAR; G_WAIT_L(0); G_MMA(0, 0, At, B0); G_BAR; G_SCHED;
            G_LDB(B1, 0, 1); G_STAGE(G_SB(0, 0), b2, voffB);
            G_BAR; G_WAIT_L(0); G_MMA(0, 1, At, B1); G_BAR;
            G_LDA(At, 0, 1); G_STAGE(G_SA(0, 0), a2, voffA);
            G_BAR; G_WAIT_L(0); G_MMA(1, 0, At, B0); G_BAR; G_SCHED;
            G_STAGE(G_SB(0, 1), b2 + hstepB, voffB);
            G_WAIT_V(6); G_BAR; G_MMA(1, 1, At, B1); G_BAR;
            G_LDB(B0, 1, 0); G_SCHED; G_LDA(At, 1, 0); G_STAGE(G_SA(0, 1), a2 + hstepA, voffA);
            G_WAIT_L(8); G_BAR; G_WAIT_L(0); G_MMA(0, 0, At, B0); G_BAR; G_SCHED;
            G_LDB(B1, 1, 1); G_STAGE(G_SB(1, 0), b3, voffB);
            G_BAR; G_WAIT_L(0); G_MMA(0, 1, At, B1); G_BAR;
            G_LDA(At, 1, 1); G_STAGE(G_SA(1, 0), a3, voffA);
            G_BAR; G_WAIT_L(0); G_MMA(1, 0, At, B0); G_BAR; G_SCHED;
            G_STAGE(G_SB(1, 1), b3 + hstepB, voffB);
            G_WAIT_V(6); G_BAR; G_MMA(1, 1, At, B1); G_BAR;
        }
        E(acc, cur, wr, wc, fr, fq);
        if (!has_next) break;
#pragma unroll
        for (int a = 0; a < 2; ++a)
#pragma unroll
            for (int b = 0; b < 2; ++b)
#pragma unroll
                for (int m = 0; m < 4; ++m)
#pragma unroll
                    for (int n = 0; n < 2; ++n) acc[a][b][m][n] = (f32x4){0.f, 0.f, 0.f, 0.f};
        cur = nxt; cA = nA; cB = nB; ++ui;
    }
    G_WAIT_V(0);
    if (wr == 0) G_BAR;
    G_BAR;
#undef G_SA
#undef G_SB
#undef G_STAGE
#undef G_LDA
#undef G_LDB
#undef G_MMA
#undef G_WAIT_V
#undef G_WAIT_L
#undef G_BAR
#undef G_SCHED
}

#define EPI_LOOP_BEGIN \
    _Pragma("unroll") for (int ai = 0; ai < 2; ++ai) _Pragma("unroll") for (int m = 0; m < 4; ++m) { const int row = u.pm * 256 + wr * 64 + fr + ai * 128 + m * 16; \
    _Pragma("unroll") for (int bj = 0; bj < 2; ++bj) _Pragma("unroll") for (int n = 0; n < 2; ++n) { const int cl = wc * 32 + 4 * fq + bj * 128 + n * 16; const f32x4 v = acc[ai][bj][m][n];
#define EPI_LOOP_END } }

__device__ __forceinline__ int seq_group(int row) { return row < MCTX ? 0 : 1 + ((row - MCTX) >> 11); }

struct EpiIn {
    bf16_t* xaq; bf16_t* xc; bf16_t* kb; bf16_t* vb; float* outk; float* outv; const float* rc; int l;
    __device__ __forceinline__ void operator()(const f32x4 (&acc)[2][2][4][2], const Unit& u, int wr, int wc, int fr, int fq) const {
        const int pn = u.pn; const bool qk = pn >= 4 && pn <= 8;
        bf16_t* dst; int ld, cbase; float* fo = nullptr;
        if (pn < 4) { dst = xaq; ld = 1024; cbase = pn * 256; }
        else if (pn < 8) { dst = xaq + (size_t)MROWS * 1024; ld = 1024; cbase = pn * 256 - 1024; }
        else if (pn == 8) { dst = kb; ld = 256; cbase = 0; fo = outk; }
        else if (pn == 9) { dst = vb; ld = 256; cbase = 0; fo = outv; }
        else { dst = xc; ld = 1024; cbase = pn * 256 - 2560; }
        const int hh = wc >> 1, i0 = 16 * (wc & 1) + 4 * fq;
        const int c1 = cbase + (qk ? 64 * hh + i0 : wc * 32 + 4 * fq), dc = qk ? 32 : 16;
        const bool rope = qk && u.pm >= 32;
#pragma unroll
        for (int ai = 0; ai < 2; ++ai)
#pragma unroll
            for (int m = 0; m < 4; ++m) {
                const int row = u.pm * 256 + wr * 64 + fr + ai * 128 + m * 16;
                f32x4 cs = (f32x4){1.f, 1.f, 1.f, 1.f}, sn = (f32x4){0.f, 0.f, 0.f, 0.f};
                if (rope) { const int t = (row - MCTX) & 2047; const int pos = hh == 0 ? (t >> 6) : (t & 63); cs = *(const f32x4*)(rc + pos * 32 + i0); sn = *(const f32x4*)(rc + 2048 + pos * 32 + i0); }
                bf16_t* dp = dst + (size_t)row * ld + c1;
                float* fp = fo + ((size_t)(((row >> 8) * 2 + l) * 256 + (row & 255))) * 256 + c1;
#pragma unroll
                for (int bj = 0; bj < 2; ++bj) {
                    const f32x4 x1 = acc[ai][bj][m][0], x2 = acc[ai][bj][m][1];
                    const f32x4 o1 = x1 * cs - x2 * sn, o2 = x1 * sn + x2 * cs;
                    uint2 p1, p2; p1.x = pack2(o1[0], o1[1]); p1.y = pack2(o1[2], o1[3]); p2.x = pack2(o2[0], o2[1]); p2.y = pack2(o2[2], o2[3]);
                    *(uint2*)(dp + bj * 128) = p1; *(uint2*)(dp + bj * 128 + dc) = p2;
                    if (fo != nullptr && row < MCTX) { *(f32x4*)(fp + bj * 128) = o1; *(f32x4*)(fp + bj * 128 + dc) = o2; }
                }
            }
    }
};
struct EpiGate {
    bf16_t* gt; const float* bias;
    __device__ __forceinline__ void operator()(const f32x4 (&acc)[2][2][4][2], const Unit& u, int wr, int wc, int fr, int fq) const {
        EPI_LOOP_BEGIN
            const int col = u.pn * 256 + cl;
            const f32x4 bb = *(const f32x4*)(bias + col);
            uint2 pk; pk.x = pack2(sigmoidf_(v[0] + bb[0]), sigmoidf_(v[1] + bb[1])); pk.y = pack2(sigmoidf_(v[2] + bb[2]), sigmoidf_(v[3] + bb[3]));
            *(uint2*)(gt + (size_t)row * 1024 + col) = pk;
        EPI_LOOP_END
    }
};
struct EpiBranch {
    const bf16_t* gt; float* tmp; bf16_t* mg; int j;
    __device__ __forceinline__ void operator()(const f32x4 (&acc)[2][2][4][2], const Unit& u, int wr, int wc, int fr, int fq) const {
        EPI_LOOP_BEGIN
            const int col = u.pn * 256 + cl;
            const uint2 gp = *(const uint2*)(gt + (size_t)row * 1024 + col);
            f32x4 r;
            r[0] = v[0] * bf2f((unsigned short)(gp.x & 0xffff)); r[1] = v[1] * bf2f((unsigned short)(gp.x >> 16));
            r[2] = v[2] * bf2f((unsigned short)(gp.y & 0xffff)); r[3] = v[3] * bf2f((unsigned short)(gp.y >> 16));
            float* tp = tmp + (size_t)row * 1024 + col;
            if (j == 0) { *(f32x4*)tp = r; }
            else if (j == 1) { f32x4 o = *(const f32x4*)tp; *(f32x4*)tp = o + r; }
            else { f32x4 o = *(const f32x4*)tp; o = o + r; uint2 pk; pk.x = pack2(o[0], o[1]); pk.y = pack2(o[2], o[3]); *(uint2*)(mg + (size_t)row * 1024 + col) = pk; }
        EPI_LOOP_END
    }
};
struct EpiMerge {
    bf16_t* gt; const float* bgate; float* tmp; bf16_t* mg;
    __device__ __forceinline__ void operator()(const f32x4 (&acc)[2][2][4][2], const Unit& u, int wr, int wc, int fr, int fq) const {
        const int j = u.z >> 1;
        if ((u.z & 1) == 0) { EpiGate E{gt, bgate + j * 1024}; E(acc, u, wr, wc, fr, fq); }
        else { EpiBranch E{gt, tmp, mg, j}; E(acc, u, wr, wc, fr, fq); }
    }
};
struct EpiRes {
    float* x; const float* mod; int goff;
    __device__ __forceinline__ void operator()(const f32x4 (&acc)[2][2][4][2], const Unit& u, int wr, int wc, int fr, int fq) const {
        const float* g = mod + seq_group(u.pm * 256) * 6144 + goff;
        EPI_LOOP_BEGIN
            const int col = u.pn * 256 + cl;
            const f32x4 gg = *(const f32x4*)(g + col);
            float* xp = x + (size_t)row * 1024 + col;
            f32x4 o = *(const f32x4*)xp;
            *(f32x4*)xp = o + gg * v;
        EPI_LOOP_END
    }
};
struct EpiBf {
    bf16_t* dst; int ld;
    __device__ __forceinline__ void operator()(const f32x4 (&acc)[2][2][4][2], const Unit& u, int wr, int wc, int fr, int fq) const {
        EPI_LOOP_BEGIN
            const int col = u.pn * 256 + cl;
            uint2 pk; pk.x = pack2(v[0], v[1]); pk.y = pack2(v[2], v[3]);
            *(uint2*)(dst + (size_t)row * ld + col) = pk;
        EPI_LOOP_END
    }
};
struct EpiPool {
    bf16_t* dst; const float* scale;
    __device__ __forceinline__ void operator()(const f32x4 (&acc)[2][2][4][2], const Unit& u, int wr, int wc, int fr, int fq) const {
        EPI_LOOP_BEGIN
            const int col = u.pn * 256 + cl;
            const f32x4 s = *(const f32x4*)(scale + col);
            uint2 pk; pk.x = pack2(v[0] * s[0], v[1] * s[1]); pk.y = pack2(v[2] * s[2], v[3] * s[3]);
            *(uint2*)(dst + (size_t)row * 1024 + col) = pk;
        EPI_LOOP_END
    }
};

struct TileDesc { const float* src; int lds_; bf16_t* dst; int ldd, k0, n0, perm; };
__device__ __forceinline__ int swap45(int p) { return (p & ~48) | ((p & 16) << 1) | ((p & 32) >> 1); }
__device__ __forceinline__ TileDesc weight_tile(const Params& P, int l, int t) {
    unsigned char* ws = P.ws; TileDesc d; int r = t; d.perm = 0;
    if (r < 1664) { d.src = P.w_in + (size_t)l * 1024 * 6656; d.lds_ = 6656; d.dst = (bf16_t*)(ws + OFF_WIN); d.ldd = 1024; d.k0 = (r / 104) * 64; d.n0 = (r % 104) * 64; d.perm = (d.n0 >= 1024 && d.n0 < 2304) ? 1 : 0; }
    else if ((r -= 1664) < 768) { const int j = r / 256; r %= 256; d.src = P.w_branch + (size_t)(l * 3 + j) * 1024 * 1024; d.lds_ = 1024; d.dst = (bf16_t*)(ws + OFF_WBR) + (size_t)j * 1024 * 1024; d.ldd = 1024; d.k0 = (r / 16) * 64; d.n0 = (r % 16) * 64; }
    else if ((r -= 768) < 128) { const int mat = r / 64; r %= 64; const int dh = r / 4; r %= 4;
        d.src = (mat ? P.lru_wx : P.lru_wa) + (size_t)(l * 16 + dh) * 128 * 128; d.lds_ = 128; d.dst = (bf16_t*)(ws + OFF_GW) + (size_t)dh * 256 * 128 + (size_t)mat * 128 * 128; d.ldd = 128; d.k0 = (r / 2) * 64; d.n0 = (r % 2) * 64; }
    else if ((r -= 128) < 64) { const int g = r / 16; r %= 16; d.src = P.pool_w + (size_t)(l * 4 + g) * 256 * 256; d.lds_ = 256; d.dst = (bf16_t*)(ws + OFF_PW) + (size_t)g * 256 * 256; d.ldd = 256; d.k0 = (r / 4) * 64; d.n0 = (r % 4) * 64; }
    else if ((r -= 64) < 256) { d.src = P.w_out + (size_t)l * 1024 * 1024; d.lds_ = 1024; d.dst = (bf16_t*)(ws + OFF_WOUT); d.ldd = 1024; d.k0 = (r / 16) * 64; d.n0 = (r % 16) * 64; }
    else if ((r -= 256) < 1408) { d.src = P.ffn_up + (size_t)l * 1024 * 5632; d.lds_ = 5632; d.dst = (bf16_t*)(ws + OFF_WUP); d.ldd = 1024; d.k0 = (r / 88) * 64; d.n0 = (r % 88) * 64; }
    else { r -= 1408; d.src = P.ffn_down + (size_t)l * 2816 * 1024; d.lds_ = 1024; d.dst = (bf16_t*)(ws + OFF_WDN); d.ldd = 2816; d.k0 = (r / 16) * 64; d.n0 = (r % 16) * 64; }
    return d;
}
__device__ void convert_weights(const Params& P, int l, LAS unsigned char* lds, int t_begin, int t_end, int first, int stride) {
    LAS bf16_t* sm = (LAS bf16_t*)lds;
    const int tid = otid();
    const int kk0 = tid >> 4, n4 = (tid & 15) * 4, nn = tid >> 3, ck = tid & 7;
    int t = t_begin + first;
    if (t >= t_end) return;
    TileDesc d = weight_tile(P, l, t);
    f32x4 v0 = *(const f32x4*)(d.src + (size_t)(d.k0 + kk0) * d.lds_ + d.n0 + n4), v1 = *(const f32x4*)(d.src + (size_t)(d.k0 + kk0 + 32) * d.lds_ + d.n0 + n4);
    for (;;) {
        __syncthreads();
#pragma unroll
        for (int e = 0; e < 4; ++e) { sm[(n4 + e) * 72 + kk0] = f2bf(v0[e]); sm[(n4 + e) * 72 + kk0 + 32] = f2bf(v1[e]); }
        __syncthreads();
        const TileDesc cur = d; const int tn = t + stride; const bool more = tn < t_end;
        if (more) { d = weight_tile(P, l, tn); v0 = *(const f32x4*)(d.src + (size_t)(d.k0 + kk0) * d.lds_ + d.n0 + n4); v1 = *(const f32x4*)(d.src + (size_t)(d.k0 + kk0 + 32) * d.lds_ + d.n0 + n4); }
        const u32x4 o = *(const LAS u32x4*)(sm + nn * 72 + ck * 8);
        const int nrow = cur.perm ? swap45(cur.n0 + nn) : (cur.n0 + nn);
        *(u32x4*)(cur.dst + (size_t)nrow * cur.ldd + cur.k0 + ck * 8) = o;
        if (!more) break;
        t = tn;
    }
    __syncthreads();
}

__device__ void phase0(const Params& P, LAS unsigned char* lds) {
    const int tid = otid(), G = gridDim.x, c = blockIdx.x;
    { const size_t n4 = (size_t)MROWS * 1024 / 4, nc4 = (size_t)MCTX * 1024 / 4;
      for (size_t i = (size_t)c * 512 + tid; i < n4; i += (size_t)G * 512) {
          const float4 v = i < nc4 ? ((const float4*)P.x_prompt)[i] : ((const float4*)P.x_sample)[i - nc4];
          ((float4*)P.out)[i] = v; } }
    { bf16_t* ck = (bf16_t*)(P.ws + OFF_CK); bf16_t* cv = (bf16_t*)(P.ws + OFF_CV);
      for (int i = c * 512 + tid; i < 2 * 2 * 512 * 256; i += G * 512) {
          const int e = i & 255, t = (i >> 8) & 511, b = (i >> 17) & 1, l = i >> 18;
          const size_t si = ((size_t)((b * 2 + l) * 512 + t)) * 256 + e;
          ck[i] = f2bf(P.cache_k[si]); cv[i] = f2bf(P.cache_v[si]); } }
    { float* rc = (float*)(P.ws + OFF_ROPE); float* rs = rc + 2048;
      for (int i = c * 512 + tid; i < 2048; i += G * 512) {
          const int pos = i >> 5, k = i & 31; const float fr = powf(10000.0f, -(float)k / 32.0f); const float ang = (float)pos * fr;
          rc[i] = cosf(ang); rs[i] = sinf(ang); } }
    { LAS float* sv = (LAS float*)lds;
      LAS float* red = sv + 3072;
      __syncthreads();
      for (int i = tid; i < 3072; i += 512) { const int s = i >> 10, k = i & 1023; const float x = s == 0 ? P.c_ctx[k] : P.c[(s - 1) * 1024 + k]; sv[i] = x / (1.0f + expf(-x)); }
      __syncthreads();
      float* mod = (float*)(P.ws + OFF_MOD);
      for (int it = c; it < 384; it += G) {
          const int l = it / 192, cg_ = it % 192, cl = tid & 31, kg = tid >> 5, col = cg_ * 32 + cl;
          const float* w = P.w_ada + (size_t)l * 1024 * 6144 + col;
          float a0 = 0.f, a1 = 0.f, a2 = 0.f;
#pragma unroll 16
          for (int k = kg * 64; k < kg * 64 + 64; ++k) { const float wv = w[(size_t)k * 6144]; a0 += sv[k] * wv; a1 += sv[1024 + k] * wv; a2 += sv[2048 + k] * wv; }
          red[(kg * 3 + 0) * 32 + cl] = a0; red[(kg * 3 + 1) * 32 + cl] = a1; red[(kg * 3 + 2) * 32 + cl] = a2;
          __syncthreads();
          if (tid < 96) { const int s = tid >> 5, cc = tid & 31; float sum = 0.f;
#pragma unroll
              for (int g = 0; g < 16; ++g) sum += red[(g * 3 + s) * 32 + cc];
              mod[(size_t)(l * 3 + s) * 6144 + cg_ * 32 + cc] = sum + P.b_ada[l * 6144 + cg_ * 32 + cc]; }
          __syncthreads();
      } }
}

__device__ void norm_phase(const float* __restrict__ X, const float* __restrict__ gw, const float* __restrict__ mod, int shift_off, int scale_off, bf16_t* __restrict__ H) {
    const int tid = otid(); const int lane = tid & 63, wv = blockIdx.x * 8 + (tid >> 6), nw = gridDim.x * 8;
    for (int row = wv; row < MROWS; row += nw) {
        const float* md = mod + seq_group(row) * 6144;
        f32x4 v[4]; float ss = 0.f;
#pragma unroll
        for (int i = 0; i < 4; ++i) { v[i] = *(const f32x4*)(X + (size_t)row * 1024 + i * 256 + lane * 4); ss += v[i][0] * v[i][0] + v[i][1] * v[i][1] + v[i][2] * v[i][2] + v[i][3] * v[i][3]; }
#pragma unroll
        for (int o = 32; o >= 1; o >>= 1) ss += __shfl_xor(ss, o);
        const float rstd = rsqrtf(ss * (1.0f / 1024.0f) + 1e-6f);
#pragma unroll
        for (int i = 0; i < 4; ++i) { const int col = i * 256 + lane * 4;
            const f32x4 g = *(const f32x4*)(gw + col), sc = *(const f32x4*)(md + scale_off + col), sh = *(const f32x4*)(md + shift_off + col);
            f32x4 h;
#pragma unroll
            for (int e = 0; e < 4; ++e) h[e] = v[i][e] * rstd * g[e] * (1.0f + sc[e]) + sh[e];
            uint2 pk; pk.x = pack2(h[0], h[1]); pk.y = pack2(h[2], h[3]);
            *(uint2*)(H + (size_t)row * 1024 + col) = pk; }
    }
}
__device__ void final_norm_phase(float* X, const float* __restrict__ gw) {
    const int tid = otid(); const int lane = tid & 63, wv = blockIdx.x * 8 + (tid >> 6), nw = gridDim.x * 8;
    for (int row = wv; row < MROWS; row += nw) {
        f32x4 v[4]; float ss = 0.f;
#pragma unroll
        for (int i = 0; i < 4; ++i) { v[i] = *(const f32x4*)(X + (size_t)row * 1024 + i * 256 + lane * 4); ss += v[i][0] * v[i][0] + v[i][1] * v[i][1] + v[i][2] * v[i][2] + v[i][3] * v[i][3]; }
#pragma unroll
        for (int o = 32; o >= 1; o >>= 1) ss += __shfl_xor(ss, o);
        const float rstd = rsqrtf(ss * (1.0f / 1024.0f) + 1e-6f);
#pragma unroll
        for (int i = 0; i < 4; ++i) { const int col = i * 256 + lane * 4; const f32x4 g = *(const f32x4*)(gw + col);
            f32x4 h;
#pragma unroll
            for (int e = 0; e < 4; ++e) h[e] = v[i][e] * rstd * g[e];
            *(f32x4*)(X + (size_t)row * 1024 + col) = h; }
    }
}

__device__ void pool_phase(const bf16_t* __restrict__ XC, bf16_t* __restrict__ PL) {
    const int tid = otid();
    for (int idx = blockIdx.x * 512 + tid; idx < MROWS * 128; idx += gridDim.x * 512) {
        const int row = idx >> 7, ch = (idx & 127) * 8, g = ch >> 8, half = 1 << g;
        const int T = row < MCTX ? 256 : 2048, row0 = row < MCTX ? (row & ~255) : MCTX + ((row - MCTX) & ~2047), tl = row - row0;
        const int lo = max(tl - half, 0), hi = min(tl + half, T);
        float s[8];
#pragma unroll
        for (int e = 0; e < 8; ++e) s[e] = 0.f;
        for (int t = lo; t < hi; ++t) { const bf16x8 x = *(const bf16x8*)(XC + (size_t)(row0 + t) * 1024 + ch);
#pragma unroll
            for (int e = 0; e < 8; ++e) s[e] += bf2f((unsigned short)x[e]); }
        const bf16x8 xs = *(const bf16x8*)(XC + (size_t)row * 1024 + ch);
        const float inv = 1.0f / (float)(hi - lo);
        uint4 o; o.x = pack2(s[0] * inv - bf2f((unsigned short)xs[0]), s[1] * inv - bf2f((unsigned short)xs[1])); o.y = pack2(s[2] * inv - bf2f((unsigned short)xs[2]), s[3] * inv - bf2f((unsigned short)xs[3]));
        o.z = pack2(s[4] * inv - bf2f((unsigned short)xs[4]), s[5] * inv - bf2f((unsigned short)xs[5])); o.w = pack2(s[6] * inv - bf2f((unsigned short)xs[6]), s[7] * inv - bf2f((unsigned short)xs[7]));
        *(uint4*)(PL + (size_t)row * 1024 + ch) = o;
    }
}
__device__ __forceinline__ float gelu_tanh(float x) { const float y = 0.7978845608028654f * (x + 0.044715f * x * x * x); const float t = 1.0f - 2.0f * __builtin_amdgcn_rcpf(1.0f + __expf(2.0f * y)); return 0.5f * x * (1.0f + t); }
__device__ void act_phase(const bf16_t* __restrict__ U, bf16_t* __restrict__ ACT, const float* __restrict__ cw, const float* __restrict__ cb) {
    const int tid = otid();
    for (int idx = blockIdx.x * 512 + tid; idx < MROWS * 352; idx += gridDim.x * 512) {
        const int row = idx / 352, ch = (idx % 352) * 8;
        const int T = row < MCTX ? 256 : 2048, row0 = row < MCTX ? (row & ~255) : MCTX + ((row - MCTX) & ~2047), tl = row - row0;
        const bf16_t* up = U + (size_t)row * 5632 + ch;
        const bf16x8 u0 = *(const bf16x8*)up, vv = *(const bf16x8*)(up + 2816);
        bf16x8 um = (bf16x8){0, 0, 0, 0, 0, 0, 0, 0}, upn = um;
        if (tl > 0) um = *(const bf16x8*)(up - 5632);
        if (tl < T - 1) upn = *(const bf16x8*)(up + 5632);
        float r[8];
#pragma unroll
        for (int e = 0; e < 8; ++e) { const float gff = cw[ch + e] * bf2f((unsigned short)um[e]) + cw[2816 + ch + e] * bf2f((unsigned short)u0[e]) + cw[5632 + ch + e] * bf2f((unsigned short)upn[e]) + cb[ch + e];
            r[e] = gelu_tanh(gff) * bf2f((unsigned short)vv[e]); }
        uint4 o; o.x = pack2(r[0], r[1]); o.y = pack2(r[2], r[3]); o.z = pack2(r[4], r[5]); o.w = pack2(r[6], r[7]);
        *(uint4*)(ACT + (size_t)row * 2816 + ch) = o;
    }
}

__device__ __forceinline__ void rope8(bf16x8& x1, bf16x8& x2, const float* __restrict__ cs, const float* __restrict__ sn) {
#pragma unroll
    for (int e = 0; e < 8; ++e) { const float a = bf2f((unsigned short)x1[e]), b = bf2f((unsigned short)x2[e]); const float c = cs[e], s = sn[e];
        x1[e] = (short)f2bf(a * c - b * s); x2[e] = (short)f2bf(a * s + b * c); }
}
constexpr int VT_OFF = 64 * 272;
constexpr int ABUF = 64 * 272 + 128 * 144;
__device__ void attn_unit(const Params& P, int l, int u, LAS unsigned char* lds) {
    int tid_ = threadIdx.x; asm volatile("" : "+v"(tid_));
    const int tid = tid_, w = tid >> 6, lane = tid & 63, fr = lane & 15, fq = lane >> 4;
    const bf16_t* Q = (const bf16_t*)(P.ws + OFF_XAQ) + (size_t)MROWS * 1024;
    const bf16_t* KB = (const bf16_t*)(P.ws + OFF_KB); const bf16_t* VB = (const bf16_t*)(P.ws + OFF_VB);
    const bf16_t* CK = (const bf16_t*)(P.ws + OFF_CK); const bf16_t* CV = (const bf16_t*)(P.ws + OFF_CV);
    bf16_t* YB = (bf16_t*)(P.ws + OFF_YB);
    bool lat; int head, row0, T, qstart, bidx;
    if (u < 256) { lat = true; bidx = u >> 7; const int rem = u & 127; head = rem >> 4; qstart = (rem & 15) * 128; T = 2048; row0 = MCTX + bidx * 2048; }
    else { const int v = u - 256; lat = false; bidx = 0; const int seq = v >> 4, rem = v & 15; head = rem >> 1; qstart = (rem & 1) * 128; T = 256; row0 = seq * 256; }
    const int kvh = head >> 2;
    const int qpos = qstart + w * 16 + fr;
    bf16x8 qf[4];
    { const bf16_t* qp = Q + (size_t)(row0 + qpos) * 1024 + head * 128 + fq * 8;
#pragma unroll
      for (int kk = 0; kk < 4; ++kk) qf[kk] = *(const bf16x8*)(qp + kk * 32); }
    float m_run = P.attn_sink[l * 8 + head]; float l_run = (fq == 0) ? 1.0f : 0.0f;
    f32x4 o[8];
#pragma unroll
    for (int dt = 0; dt < 8; ++dt) o[dt] = (f32x4){0.f, 0.f, 0.f, 0.f};
    int wlo = 0, nwt = 4;
    if (lat) { wlo = max(0, qstart - 128); const int whi = min(T, qstart + 256); nwt = (whi - wlo) >> 6; }
    const int ntiles = nwt + (lat ? 8 : 0);
    const float scale = 0.08838834764831845f;
    const int lkey = tid >> 3, lp = tid & 7;
    bf16x8 pk1, pk2, pv0, pv1;
    auto tile_load = [&](int ti) {
        const bf16_t* ksrc; const bf16_t* vsrc;
        if (ti < nwt) { const int k0 = wlo + ti * 64; ksrc = KB + (size_t)(row0 + k0) * 256 + kvh * 128; vsrc = VB + (size_t)(row0 + k0) * 256 + kvh * 128; }
        else { const int k0 = (ti - nwt) * 64; const size_t o_ = ((size_t)((l * 2 + bidx) * 512 + k0)) * 256 + kvh * 128; ksrc = CK + o_; vsrc = CV + o_; }
        const bf16_t* kr = ksrc + (size_t)lkey * 256; pk1 = *(const bf16x8*)(kr + lp * 8); pk2 = *(const bf16x8*)(kr + (lp + 8) * 8);
        pv0 = *(const bf16x8*)(vsrc + (size_t)lane * 256 + w * 8); pv1 = *(const bf16x8*)(vsrc + (size_t)lane * 256 + (w + 8) * 8); };
    auto tile_store = [&](int b) {
        LAS unsigned char* kb_ = lds + b * ABUF; LAS unsigned char* vb_ = kb_ + VT_OFF;
        *(LAS bf16x8*)(kb_ + lkey * 272 + lp * 16) = pk1; *(LAS bf16x8*)(kb_ + lkey * 272 + (lp + 8) * 16) = pk2;
#pragma unroll
        for (int e = 0; e < 8; ++e) { *(LAS bf16_t*)(vb_ + (w * 8 + e) * 144 + lane * 2) = (bf16_t)pv0[e]; *(LAS bf16_t*)(vb_ + ((w + 8) * 8 + e) * 144 + lane * 2) = (bf16_t)pv1[e]; } };
    tile_load(0);
    __syncthreads();
    tile_store(0);
    if (ntiles > 1) tile_load(1);
    for (int ti = 0; ti < ntiles; ++ti) {
        const bool win = ti < nwt; const int k0 = win ? wlo + ti * 64 : (ti - nwt) * 64;
        __syncthreads();
        if (ti + 1 < ntiles) tile_store((ti + 1) & 1);
        if (ti + 2 < ntiles) tile_load(ti + 2);
        LAS unsigned char* kb_ = lds + (ti & 1) * ABUF; LAS unsigned char* vb_ = kb_ + VT_OFF;
        f32x4 s[4];
#pragma unroll
        for (int nt = 0; nt < 4; ++nt) { s[nt] = (f32x4){0.f, 0.f, 0.f, 0.f};
#pragma unroll
            for (int kk = 0; kk < 4; ++kk) { const bf16x8 a = *(const LAS bf16x8*)(kb_ + (nt * 16 + fr) * 272 + kk * 64 + fq * 16); s[nt] = __builtin_amdgcn_mfma_f32_16x16x32_bf16(a, qf[kk], s[nt], 0, 0, 0); } }
        float mt = -3.0e38f;
#pragma unroll
        for (int nt = 0; nt < 4; ++nt)
#pragma unroll
            for (int j = 0; j < 4; ++j) { float v = s[nt][j] * scale;
                if (lat && win) { const int kp = k0 + nt * 16 + fq * 4 + j; const int dd = qpos - kp; if (dd > 128 || dd < -128) v = -1.0e30f; }
                s[nt][j] = v; mt = fmaxf(mt, v); }
        mt = fmaxf(mt, __shfl_xor(mt, 16)); mt = fmaxf(mt, __shfl_xor(mt, 32));
        const float mn = fmaxf(m_run, mt); const float alpha = __expf(m_run - mn); m_run = mn;
        float ps = 0.f;
#pragma unroll
        for (int nt = 0; nt < 4; ++nt)
#pragma unroll
            for (int j = 0; j < 4; ++j) { const float p = __expf(s[nt][j] - mn); ps += p; s[nt][j] = p; }
        l_run = l_run * alpha + ps;
#pragma unroll
        for (int dt = 0; dt < 8; ++dt) o[dt] = o[dt] * alpha;
#pragma unroll
        for (int s2 = 0; s2 < 2; ++s2) {
            u32x4 pu; pu[0] = pack2(s[2 * s2][0], s[2 * s2][1]); pu[1] = pack2(s[2 * s2][2], s[2 * s2][3]); pu[2] = pack2(s[2 * s2 + 1][0], s[2 * s2 + 1][1]); pu[3] = pack2(s[2 * s2 + 1][2], s[2 * s2 + 1][3]);
            const bf16x8 pf = __builtin_bit_cast(bf16x8, pu);
#pragma unroll
            for (int dt = 0; dt < 8; ++dt) {
                const bf16x4 lo = *(const LAS bf16x4*)(vb_ + (dt * 16 + fr) * 144 + (s2 * 32 + fq * 4) * 2);
                const bf16x4 hi = *(const LAS bf16x4*)(vb_ + (dt * 16 + fr) * 144 + (s2 * 32 + 16 + fq * 4) * 2);
                const bf16x8 af = __builtin_shufflevector(lo, hi, 0, 1, 2, 3, 4, 5, 6, 7);
                o[dt] = __builtin_amdgcn_mfma_f32_16x16x32_bf16(af, pf, o[dt], 0, 0, 0);
            }
        }
    }
    float lt = l_run; lt += __shfl_xor(lt, 16); lt += __shfl_xor(lt, 32);
    const float inv = 1.0f / lt;
    bf16_t* yp = YB + (size_t)(row0 + qpos) * 1024 + head * 128 + fq * 4;
#pragma unroll
    for (int dt = 0; dt < 8; ++dt) { uint2 pk; pk.x = pack2(o[dt][0] * inv, o[dt][1] * inv); pk.y = pack2(o[dt][2] * inv, o[dt][3] * inv); *(uint2*)(yp + dt * 16) = pk; }
}

template <int MODE, int D, int NSC>
__device__ __forceinline__ void lru_dir(const Params& P, int l, int s, int cchunk, int h, LAS unsigned char* lds, int w, int fr, int fq) {
    const bool lat = s >= 32; const int row0 = lat ? MCTX + (s - 32) * 2048 : s * 256; const int t0 = cchunk * (NSC * 64);
    constexpr int NCH = 2048 / (NSC * 64);
    const bf16_t* GW = (const bf16_t*)(P.ws + OFF_GW);
    bf16_t* YA = (bf16_t*)(P.ws + OFF_YA);
    float* SUMM = (float*)(P.ws + OFF_SUMM);
    const int chl = 16 * w + fr, ch = h * 128 + chl;
    bf16x8 bwa[4], bwx[4];
    { const bf16_t* gp = GW + ((size_t)(D * 8 + h) * 256 + chl) * 128 + fq * 8;
#pragma unroll
      for (int kk = 0; kk < 4; ++kk) { bwa[kk] = *(const bf16x8*)(gp + kk * 32); bwx[kk] = *(const bf16x8*)(gp + 128 * 128 + kk * 32); } }
    const int pidx = (l * 2 + D) * 1024 + ch;
    const float ba = P.lru_ba[pidx], bx = P.lru_bx[pidx];
    const float lam = P.lru_lambda[pidx];
    const float c8 = -8.0f * log1pf(expf(-lam));
    float carry = 0.f;
    if (MODE == 0 && lat) {
        const int b = s - 32;
        carry = P.state_lru[((size_t)(b * 2 + l) * 2 + D) * 1024 + ch];
        if (D == 0) { for (int cc = 0; cc < cchunk; ++cc) { const float* sp = SUMM + ((size_t)((b * 2 + 0) * 16 + cc) * 1024 + ch) * 2; carry = sp[1] + sp[0] * carry; } }
        else { for (int cc = NCH - 1; cc > cchunk; --cc) { const float* sp = SUMM + ((size_t)((b * 2 + 1) * 16 + cc) * 1024 + ch) * 2; carry = sp[1] + sp[0] * carry; } }
    }
    float ptot = 1.0f;
#pragma unroll 1
    for (int sci = 0; sci < NSC; ++sci) {
        const int sc = D == 0 ? sci : NSC - 1 - sci;
        f32x4 r[4], g[4];
#pragma unroll
        for (int m = 0; m < 4; ++m) { r[m] = (f32x4){0.f, 0.f, 0.f, 0.f}; g[m] = (f32x4){0.f, 0.f, 0.f, 0.f};
#pragma unroll
            for (int kk = 0; kk < 4; ++kk) { const bf16x8 a = *(const LAS bf16x8*)(lds + (sc * 64 + m * 16 + fr) * 272 + kk * 64 + fq * 16);
                r[m] = __builtin_amdgcn_mfma_f32_16x16x32_bf16(a, bwa[kk], r[m], 0, 0, 0); g[m] = __builtin_amdgcn_mfma_f32_16x16x32_bf16(a, bwx[kk], g[m], 0, 0, 0); } }
#pragma unroll
        for (int mi = 0; mi < 4; ++mi) {
            const int m = D == 0 ? mi : 3 - mi;
            float av[4], bv[4];
#pragma unroll
            for (int j = 0; j < 4; ++j) {
                const float ea = 1.0f + __expf(-(r[m][j] + ba)), eb = 1.0f + __expf(-(g[m][j] + bx));
                const float inv = __builtin_amdgcn_rcpf(ea * eb);
                const float rr = inv * eb, ii = inv * ea;
                const float la = c8 * rr; const float a = __expf(la); const float z = 2.0f * la;
                const float em = (z > -0.05f) ? -z * (1.0f + z * (0.5f + z * (0.16666667f + z * 0.041666667f))) : 1.0f - a * a;
                const float x = bf2f(*(const LAS bf16_t*)(lds + (sc * 64 + m * 16 + fq * 4 + j) * 272 + chl * 2));
                av[j] = a; bv[j] = __builtin_amdgcn_sqrtf(em) * ii * x;
            }
            float p4, h4;
            p4 = av[0] * av[1] * av[2] * av[3];
            if (D == 0) h4 = ((bv[0] * av[1] + bv[1]) * av[2] + bv[2]) * av[3] + bv[3];
            else h4 = ((bv[3] * av[2] + bv[2]) * av[1] + bv[1]) * av[0] + bv[0];
            float pq[4], hq[4];
#pragma unroll
            for (int f = 0; f < 4; ++f) { pq[f] = __shfl(p4, fr + 16 * f); hq[f] = __shfl(h4, fr + 16 * f); }
            float cin = carry, mycin = 0.f;
#pragma unroll
            for (int fi = 0; fi < 4; ++fi) { const int f = D == 0 ? fi : 3 - fi; if (f == fq) mycin = cin; cin = hq[f] + pq[f] * cin; }
            carry = cin;
            if (MODE == 1) ptot *= pq[0] * pq[1] * pq[2] * pq[3];
            if (MODE == 0) {
                float hh = mycin; float y[4];
#pragma unroll
                for (int ji = 0; ji < 4; ++ji) { const int j = D == 0 ? ji : 3 - ji; hh = av[j] * hh + bv[j]; y[j] = hh; }
#pragma unroll
                for (int j = 0; j < 4; ++j) {
                    bf16_t* yp = YA + (size_t)(row0 + t0 + sc * 64 + m * 16 + fq * 4 + j) * 1024 + ch;
                    if (D == 0) *yp = f2bf(y[j]);
                    else *yp = f2bf(bf2f(*yp) + y[j]);
                }
            }
        }
    }
    if (MODE == 0 && !lat && fq == 0) P.out[OUT_H + ((size_t)(s * 2 + l) * 2 + D) * 1024 + ch] = carry;
    if (MODE == 1 && fq == 0) { float* sp = SUMM + ((size_t)(((s - 32) * 2 + D) * 16 + cchunk) * 1024 + ch) * 2; sp[0] = ptot; sp[1] = carry; }
}
template <int MODE, int NSC>
__device__ void lru_unit(const Params& P, int l, int s, int cchunk, int h, LAS unsigned char* lds) {
    int tid_ = threadIdx.x; asm volatile("" : "+v"(tid_));
    const int tid = tid_, w = tid >> 6, lane = tid & 63, fr = lane & 15, fq = lane >> 4;
    const bool lat = s >= 32; const int T = lat ? 2048 : 256; const int row0 = lat ? MCTX + (s - 32) * 2048 : s * 256; const int t0 = cchunk * (NSC * 64);
    const bf16_t* XA = (const bf16_t*)(P.ws + OFF_XAQ);
    __syncthreads();
    {
        const int ck = tid & 15, ch = h * 128 + ck * 8;
        const float* cw = P.lru_conv + (size_t)l * 4096 + ch; const float* cb = P.lru_conv_b + l * 1024 + ch;
        float wk[4][8], bk[8];
#pragma unroll
        for (int e = 0; e < 8; ++e) { bk[e] = cb[e];
#pragma unroll
            for (int k = 0; k < 4; ++k) wk[k][e] = cw[k * 1024 + e]; }
#pragma unroll 2
        for (int it = 0; it < 2 * NSC; ++it) {
            const int t = (tid >> 4) + it * 32;
            float a8[8];
#pragma unroll
            for (int e = 0; e < 8; ++e) a8[e] = bk[e];
#pragma unroll
            for (int k = 0; k < 4; ++k) { const int tt = t0 + t + k - 2;
                if (tt >= 0 && tt < T) { const bf16x8 x = *(const bf16x8*)(XA + (size_t)(row0 + tt) * 1024 + ch);
#pragma unroll
                    for (int e = 0; e < 8; ++e) a8[e] += wk[k][e] * bf2f((unsigned short)x[e]); } }
            u32x4 o; o.x = pack2(a8[0], a8[1]); o.y = pack2(a8[2], a8[3]); o.z = pack2(a8[4], a8[5]); o.w = pack2(a8[6], a8[7]);
            *(LAS u32x4*)(lds + t * 272 + ck * 16) = o;
        }
    }
    __syncthreads();
    lru_dir<MODE, 0, NSC>(P, l, s, cchunk, h, lds, w, fr, fq);
    lru_dir<MODE, 1, NSC>(P, l, s, cchunk, h, lds, w, fr, fq);
}


#define XB_TMO      128
#define XB_XCNT(j)  (256  + 64 * (j))
#define XB_XSUB(j)  (1280 + 64 * (j))
#define XB_XGEN(j)  (2304 + 64 * (j))
#define XB_TOP      3328
#define XB_TOPGEN   3392
#define XCD_BAR_WORDS 3456
#define XB_SPIN_CAP (1u << 18)
__device__ __forceinline__ unsigned xb_ld(unsigned* p)              { return __hip_atomic_load(p, __ATOMIC_RELAXED, __HIP_MEMORY_SCOPE_AGENT); }
__device__ __forceinline__ unsigned xb_add(unsigned* p, unsigned v) { return __hip_atomic_fetch_add(p, v, __ATOMIC_RELAXED, __HIP_MEMORY_SCOPE_AGENT); }
__device__ __forceinline__ unsigned xb_xcc_id() { return (unsigned)__builtin_amdgcn_s_getreg((3 << 11) | 20) & 0xFu; }
#define XB_SPIN(cond, bar) do { unsigned _sp = 0; while (cond) { __builtin_amdgcn_s_sleep(1); \
    if ((++_sp & 255u) == 0u) { if (xb_ld(&(bar)[XB_TMO])) break; if (_sp > XB_SPIN_CAP) { atomicAdd(&(bar)[XB_TMO], 1u); break; } } } } while (0)
struct XcdBarrier { unsigned* bar; unsigned x; volatile LAS unsigned* st; };
__device__ __forceinline__ XcdBarrier xcd_barrier_post(unsigned* bar, volatile LAS unsigned* st) {
    XcdBarrier b; b.bar = bar; b.x = xb_xcc_id(); b.st = st;
    if (threadIdx.x == 0) (void)xb_add(&bar[XB_XCNT(b.x)], 1u);
    return b;
}
__device__ __forceinline__ void xcd_barrier_complete(unsigned* bar, unsigned x, unsigned& nloc, unsigned& nx) {
    const unsigned G = gridDim.x * gridDim.y * gridDim.z;
    unsigned sum, cnt, mine, sp = 0u;
    for (;;) {
        sum = 0u; cnt = 0u; mine = 0u;
#pragma unroll
        for (unsigned j = 0; j < 16; ++j) { const unsigned c = xb_ld(&bar[XB_XCNT(j)]); sum += c; cnt += (c > 0u) ? 1u : 0u; mine = (j == x) ? c : mine; }
        if (sum == G) break;
        __builtin_amdgcn_s_sleep(1);
        if ((++sp & 255u) == 0u) { if (xb_ld(&bar[XB_TMO])) break; if (sp > XB_SPIN_CAP) { atomicAdd(&bar[XB_TMO], 1u); break; } }
    }
    nloc = mine > 0u ? mine : 1u; nx = cnt > 0u ? cnt : 1u;
}
__device__ __noinline__ void xcd_barrier_(unsigned* bbar, unsigned bx, volatile LAS unsigned* bst) {
    XcdBarrier b; b.bar = bbar; b.x = bx; b.st = bst;
    asm volatile("s_waitcnt vmcnt(0)" ::: "memory");
    __syncthreads();
    if (threadIdx.x == 0) {
        unsigned* bar = b.bar;
        __builtin_amdgcn_s_waitcnt(0);
        unsigned nloc = b.st[0], nx = b.st[1];
        if (nloc == 0u) { xcd_barrier_complete(bar, b.x, nloc, nx); b.st[0] = nloc; b.st[1] = nx; }
        const unsigned old = xb_add(&bar[XB_XSUB(b.x)], 1u);
        const unsigned gen = old / nloc;
        if (old + 1u == (gen + 1u) * nloc) {
            __builtin_amdgcn_fence(__ATOMIC_RELEASE, "agent");
            asm volatile("s_waitcnt vmcnt(0)" ::: "memory");
            const unsigned og = xb_add(&bar[XB_TOP], 1u);
            const unsigned tg = og / nx;
            if (og + 1u == (tg + 1u) * nx) xb_add(&bar[XB_TOPGEN], 1u);
            else XB_SPIN(xb_ld(&bar[XB_TOPGEN]) == tg, bar);
            __builtin_amdgcn_fence(__ATOMIC_ACQUIRE, "agent");
            xb_add(&bar[XB_XGEN(b.x)], 1u);
            asm volatile("s_waitcnt vmcnt(0)" ::: "memory");
        } else {
            XB_SPIN(xb_ld(&bar[XB_XGEN(b.x)]) == gen, bar);
            __builtin_amdgcn_fence(__ATOMIC_ACQUIRE, "agent");
            asm volatile("s_waitcnt vmcnt(0)" ::: "memory");
        }
    }
    __syncthreads();
}

#ifndef REPMASK
#define REPMASK 0
#endif
#define REPLOOP(i) _Pragma("unroll 1") for (int rep_ = 0; rep_ < 1 + ((REPMASK >> (i)) & 1); ++rep_)
__global__ __launch_bounds__(512, 2) void mega(Params P) {
    extern __shared__ __attribute__((aligned(16))) unsigned char shm[];
    LAS unsigned char* lds = (LAS unsigned char*)shm;
    cg::grid_group grid = cg::this_grid();
    if (threadIdx.x == 0) *(LAS u32x4*)(lds + 131072) = (u32x4){0u, 0u, 0u, 0u};
    __syncthreads();
    const XcdBarrier xb = xcd_barrier_post((unsigned*)(P.ws + OFF_BAR), (volatile LAS unsigned*)(lds + 131072));
    const int G = gridDim.x, c = blockIdx.x;
    unsigned char* ws = P.ws;
    float* X = P.out;
    bf16_t* H = (bf16_t*)(ws + OFF_H);
    const float* MOD = (const float*)(ws + OFF_MOD);

    phase0(P, lds);
    grid.sync();
    for (int l = 0; l < 2; ++l) {
        const float* mod = MOD + (size_t)l * 3 * 6144;
        REPLOOP(0) convert_weights(P, l, lds, 0, (G > 192) ? 2624 : 4992, c, G);
        REPLOOP(1) norm_phase(X, P.norm1 + l * 1024, mod, 0, 1024, H);
        xcd_barrier_(xb.bar, xb.x, xb.st);
        REPLOOP(2) { Sched S{(const char*)H, (const char*)(ws + OFF_WIN), 1024, 1024, 0, 48, 14, G, c};
          EpiIn E{(bf16_t*)(ws + OFF_XAQ), (bf16_t*)(ws + OFF_XC), (bf16_t*)(ws + OFF_KB), (bf16_t*)(ws + OFF_VB), P.out + OUT_K, P.out + OUT_V, (const float*)(ws + OFF_ROPE), l};
          gemm_phase(lds, S, 1024, E); }
        xcd_barrier_(xb.bar, xb.x, xb.st);
        REPLOOP(3) pool_phase((const bf16_t*)(ws + OFF_XC), (bf16_t*)(ws + OFF_PL));
        for (int it = c; it < 1280; it += G) {
            if (it < 256) { REPLOOP(4) attn_unit(P, l, it, lds); }
            else if (it < 512) { const int v = it - 256; REPLOOP(5) lru_unit<0, 4>(P, l, v >> 3, 0, v & 7, lds); }
            else if (it < 768) { const int q = it - 512; REPLOOP(5) lru_unit<1, 2>(P, l, 32 + (q >> 7), (q >> 3) & 15, q & 7, lds); }
            else { REPLOOP(7) attn_unit(P, l, it - 768 + 256, lds); }
        }
        xcd_barrier_(xb.bar, xb.x, xb.st);
        { Sched S{(const char*)(ws + OFF_PL), (const char*)(ws + OFF_PW), 1024, 256, 256, 48, 4, G, c};
          EpiPool E{(bf16_t*)(ws + OFF_XC), P.pool_scale + l * 1024};
          gemm_phase(lds, S, 256, E); }
#ifndef NO_LRU
        for (int it = G - 1 - c; it < 256; it += G) lru_unit<0, 2>(P, l, 32 + (it >> 7), (it >> 3) & 15, it & 7, lds);
#endif
        xcd_barrier_(xb.bar, xb.x, xb.st);
        REPLOOP(6) { MergeSched S{(const char*)ws, 1024, 1024, c};
          EpiMerge E{(bf16_t*)(ws + OFF_GT), P.b_gate + l * 3072, (float*)(ws + OFF_XAQ), (bf16_t*)(ws + OFF_PL)};
          gemm_phase(lds, S, 1024, E); }
        if (G > 192 && c >= 192) convert_weights(P, l, lds, 2624, 4992, c - 192, G - 192);
        xcd_barrier_(xb.bar, xb.x, xb.st);
        { Sched S{(const char*)(ws + OFF_PL), (const char*)(ws + OFF_WOUT), 1024, 1024, 0, 48, 4, G, c};
          EpiRes E{X, mod, 2048};
          gemm_phase(lds, S, 1024, E); }
        xcd_barrier_(xb.bar, xb.x, xb.st);
        norm_phase(X, P.norm2 + l * 1024, mod, 3072, 4096, H);
        xcd_barrier_(xb.bar, xb.x, xb.st);
        REPLOOP(9) { Sched S{(const char*)H, (const char*)(ws + OFF_WUP), 1024, 1024, 0, 48, 22, G, c};
          EpiBf E{(bf16_t*)(ws + OFF_U), 5632};
          gemm_phase(lds, S, 1024, E); }
        xcd_barrier_(xb.bar, xb.x, xb.st);
        REPLOOP(10) act_phase((const bf16_t*)(ws + OFF_U), (bf16_t*)(ws + OFF_ACT), P.ffn_conv + (size_t)l * 3 * 2816, P.ffn_conv_b + l * 2816);
        xcd_barrier_(xb.bar, xb.x, xb.st);
        { Sched S{(const char*)(ws + OFF_ACT), (const char*)(ws + OFF_WDN), 2816, 2816, 0, 48, 4, G, c};
          EpiRes E{X, mod, 5120};
          gemm_phase(lds, S, 2816, E); }
        xcd_barrier_(xb.bar, xb.x, xb.st);
    }
    final_norm_phase(X, P.final_norm);
}

extern "C" void kernel_launch(void* const* d_in, const int* in_sizes, int n_in, void* d_out, int out_size, void* d_ws, size_t ws_size, hipStream_t stream) {
    constexpr size_t kDynLds = 131072 + 16;
    static int grid_blocks = 0;
    if (!grid_blocks) {
        int dev = 0, cus = 0, per_cu = 0;
        hipGetDevice(&dev);
        hipDeviceGetAttribute(&cus, hipDeviceAttributeMultiprocessorCount, dev);
        hipFuncSetAttribute((const void*)mega, hipFuncAttributeMaxDynamicSharedMemorySize, (int)kDynLds);
        hipOccupancyMaxActiveBlocksPerMultiprocessor(&per_cu, mega, 512, kDynLds);
        if (per_cu < 1) per_cu = 1;
        if (per_cu > 1) per_cu = 1;
        grid_blocks = cus * per_cu;
    }
    Params p{};
    const float** pp = (const float**)&p;
    for (int i = 0; i < 30; ++i) pp[i] = (const float*)d_in[i];
    p.out = (float*)d_out; p.ws = (unsigned char*)d_ws;
    if (ws_size < OFF_END) { fprintf(stderr, "workspace too small: %zu < %zu\n", ws_size, (size_t)OFF_END); }
    hipMemsetAsync((unsigned char*)d_ws + OFF_BAR, 0, 16384, stream);
    void* args[] = {&p};
    hipError_t e = hipLaunchCooperativeKernel((void*)mega, dim3(grid_blocks), dim3(512), args, kDynLds, stream);
    if (e != hipSuccess) fprintf(stderr, "cooperative launch failed: %s (grid %d)\n", hipGetErrorString(e), grid_blocks);
}
```

```cpp
#include <hip/hip_runtime.h>
#include <hip/hip_cooperative_groups.h>
#include <cstdio>
namespace cg = cooperative_groups;

#define LAS __attribute__((address_space(3)))
typedef unsigned short bf16_t;
typedef short bf16x8 __attribute__((ext_vector_type(8)));
typedef float f32x4 __attribute__((ext_vector_type(4)));
typedef unsigned u32x4 __attribute__((ext_vector_type(4)));
typedef unsigned u32x2 __attribute__((ext_vector_type(2)));
typedef short bf16x4 __attribute__((ext_vector_type(4)));

constexpr int MROWS = 12288, MCTX = 8192;
constexpr size_t S24 = (size_t)MROWS * 1024 * 2;
constexpr size_t OFF_WIN = 0;
constexpr size_t OFF_WBR = OFF_WIN + (size_t)6656 * 1024 * 2;
constexpr size_t OFF_WOUT = OFF_WBR + (size_t)3 * 1024 * 1024 * 2;
constexpr size_t OFF_WUP = OFF_WOUT + (size_t)1024 * 1024 * 2;
constexpr size_t OFF_WDN = OFF_WUP + (size_t)5632 * 1024 * 2;
constexpr size_t OFF_GW = OFF_WDN + (size_t)1024 * 2816 * 2;
constexpr size_t OFF_PW = OFF_GW + (size_t)2 * 8 * 256 * 128 * 2;
constexpr size_t OFF_MOD = OFF_PW + (size_t)4 * 256 * 256 * 2;
constexpr size_t OFF_CK = OFF_MOD + (size_t)2 * 3 * 6144 * 4;
constexpr size_t OFF_CV = OFF_CK + (size_t)2 * 2 * 512 * 256 * 2;
constexpr size_t OFF_ROPE = OFF_CV + (size_t)2 * 2 * 512 * 256 * 2;
constexpr size_t OFF_SUMM = OFF_ROPE + (size_t)2 * 64 * 32 * 4;
constexpr size_t OFF_BAR = OFF_SUMM + (size_t)2 * 2 * 16 * 1024 * 2 * 4;
constexpr size_t OFF_ACT0 = OFF_BAR + 16384;
constexpr size_t OFF_XAQ = OFF_ACT0;
constexpr size_t OFF_XC = OFF_XAQ + 2 * S24;
constexpr size_t OFF_KB = OFF_XC + S24;
constexpr size_t OFF_VB = OFF_KB + (size_t)MROWS * 256 * 2;
constexpr size_t OFF_GT = OFF_VB + (size_t)MROWS * 256 * 2;
constexpr size_t OFF_YB = OFF_GT + S24;
constexpr size_t OFF_PL = OFF_YB + S24;
constexpr size_t OFF_YA = OFF_PL + S24;
constexpr size_t OFF_H = OFF_YA + S24;
constexpr size_t OFF_END = OFF_H + S24;
constexpr size_t OFF_U = OFF_XAQ;
constexpr size_t OFF_ACT = OFF_PL;
constexpr size_t OUT_K = (size_t)MROWS * 1024;
constexpr size_t OUT_V = OUT_K + (size_t)32 * 2 * 256 * 256;
constexpr size_t OUT_H = OUT_V + (size_t)32 * 2 * 256 * 256;

struct Params {
    const float *x_prompt, *x_sample, *cache_k, *cache_v, *state_lru, *c, *c_ctx, *w_ada, *b_ada, *norm1, *norm2,
        *w_in, *b_gate, *lru_conv, *lru_conv_b, *lru_wa, *lru_ba, *lru_wx, *lru_bx, *lru_lambda, *attn_sink,
        *pool_w, *pool_scale, *w_branch, *w_out, *ffn_up, *ffn_conv, *ffn_conv_b, *ffn_down, *final_norm;
    float* out; unsigned char* ws;
};

__device__ __forceinline__ unsigned short f2bf(float f) { unsigned u = __float_as_uint(f); u += 0x7FFFu + ((u >> 16) & 1u); return (unsigned short)(u >> 16); }
__device__ __forceinline__ float bf2f(unsigned short b) { return __uint_as_float(((unsigned)b) << 16); }
__device__ __forceinline__ unsigned pack2(float a, float b) { return (unsigned)f2bf(a) | ((unsigned)f2bf(b) << 16); }
__device__ __forceinline__ int otid() { int t = threadIdx.x; asm volatile("" : "+v"(t)); return t; }
__device__ __forceinline__ float sigmoidf_(float x) { return __builtin_amdgcn_rcpf(1.0f + __expf(-x)); }

constexpr int HTB = 128 * 64 * 2;
__device__ __forceinline__ int lds_byte(int r, int c) { const int st = (r >> 4) * 2 + (c >> 5), rr = r & 15, cc = c & 31, ob = rr * 64 + cc * 2; return st * 1024 + (ob ^ (((ob >> 9) & 1) << 5)); }
__device__ __forceinline__ void stage_rc(int b, int& R, int& C) { const int st = b / 1024, sb = b % 1024, swz = sb ^ (((sb >> 9) & 1) << 5); R = (st >> 1) * 16 + swz / 64; C = (st & 1) * 32 + (swz % 64) / 2; }

struct Unit { const char* a; const char* b; int pm, pn, z; };
struct Sched {
    const char* A; const char* B; int lda, ldb, acol, nM, nN, G, c;
    __device__ __forceinline__ bool next(int i, Unit& u) const {
        const long L = (long)i * G + c; const int nwg = nM * nN; if (L >= nwg) return false;
        int wgid = (int)L; { const int q = nwg / 8, r = nwg % 8, xcd = wgid % 8, off = wgid / 8; wgid = (xcd < r ? xcd * (q + 1) : r * (q + 1) + (xcd - r) * q) + off; }
        const int nig = 8 * nN, gid = wgid / nig, fm = gid * 8, gsz = (nM - fm) < 8 ? (nM - fm) : 8;
        u.pm = fm + ((wgid % nig) % gsz); u.pn = (wgid % nig) / gsz;
        u.a = A + ((size_t)u.pm * 256 * lda + (size_t)u.pn * acol) * 2; u.b = B + (size_t)u.pn * 256 * ldb * 2; u.z = 0; return true;
    }
};
struct MergeSched {
    const char* ws; int lda, ldb, c;
    __device__ __forceinline__ bool next(int i, Unit& u) const {
        if (c >= 192 || i >= 6) return false;
        const int nwg = 192, nN = 4, nM = 48;
        int wgid = c; { const int q = nwg / 8, xcd = wgid % 8, off = wgid / 8; wgid = xcd * q + off; }
        const int nig = 8 * nN, gid = wgid / nig, fm = gid * 8, gsz = (nM - fm) < 8 ? (nM - fm) : 8;
        u.pm = fm + ((wgid % nig) % gsz); u.pn = (wgid % nig) / gsz; u.z = i;
        const int j = i >> 1;
        const size_t aoff = (size_t)u.pm * 256 * 1024 * 2;
        size_t ao = OFF_H, bo = OFF_WIN + (size_t)3584 * 1024 * 2;
        if (i & 1) { bo = OFF_WBR; ao = OFF_YA; if (j == 1) ao = OFF_YB; if (j == 2) ao = OFF_XC; }
        u.a = ws + ao + aoff; u.b = ws + bo + ((size_t)j * 1024 + (size_t)u.pn * 256) * 1024 * 2;
        return true;
    }
};

template <class Epi, class SchedT>
__device__ __forceinline__ void gemm_phase(LAS unsigned char* lds, const SchedT& S, const int K_, const Epi& E) {
    int K = K_; asm volatile("" : "+s"(K));
    int tid_ = threadIdx.x; asm volatile("" : "+v"(tid_));
    const int tid = tid_, wid = __builtin_amdgcn_readfirstlane(tid >> 6), lane = tid & 63, wr = wid >> 2, wc = wid & 3, fr = lane & 15, fq = lane >> 4;
    const int nt = K / 64;
    unsigned voffA[2], voffB[2];
#pragma unroll
    for (int i = 0; i < 2; ++i) { int R, C; stage_rc(tid * 16 + i * 8192, R, C); voffA[i] = (unsigned)(R * S.lda + C) * 2u; voffB[i] = (unsigned)(R * S.ldb + C) * 2u; }
    const size_t kstep = 128;
    const size_t hstepA = (size_t)128 * S.lda * 2, hstepB = (size_t)128 * S.ldb * 2;
    const unsigned ldsw = (unsigned)wid * 1024u;
    const int aoff = lds_byte(wr * 64 + fr, fq * 8), boff = lds_byte(wc * 32 + fr, fq * 8);
#define G_SA(b, h) (((b) * 2 + (h)) * HTB)
#define G_SB(b, h) ((4 + (b) * 2 + (h)) * HTB)
#define G_STAGE(bufoff, gbase, voff) do { _Pragma("unroll") for (int _i = 0; _i < 2; ++_i) \
        __builtin_amdgcn_global_load_lds((const unsigned*)((const char*)(gbase) + (voff)[_i]), (LAS unsigned*)(lds + (bufoff) + ldsw + _i * 8192), 16, 0, 0); } while (0)
#define G_LDA(dst, b, h) do { _Pragma("unroll") for (int m = 0; m < 4; ++m) _Pragma("unroll") for (int k = 0; k < 2; ++k) dst[m][k] = *(const LAS bf16x8*)(lds + G_SA(b, h) + aoff + m * 2048 + k * 1024); } while (0)
#define G_LDB(dst, b, h) do { _Pragma("unroll") for (int n = 0; n < 2; ++n) _Pragma("unroll") for (int k = 0; k < 2; ++k) dst[n][k] = *(const LAS bf16x8*)(lds + G_SB(b, h) + boff + n * 2048 + k * 1024); } while (0)
#define G_MMA(ai, bj, At, Bt) do { __builtin_amdgcn_s_setprio(1); _Pragma("unroll") for (int m = 0; m < 4; ++m) _Pragma("unroll") for (int n = 0; n < 2; ++n) _Pragma("unroll") for (int k = 0; k < 2; ++k) \
        acc[ai][bj][m][n] = __builtin_amdgcn_mfma_f32_16x16x32_bf16(Bt[n][k], At[m][k], acc[ai][bj][m][n], 0, 0, 0); __builtin_amdgcn_s_setprio(0); } while (0)
#define G_WAIT_V(n) asm volatile("s_waitcnt vmcnt(" #n ")" ::: "memory")
#define G_WAIT_L(n) asm volatile("s_waitcnt lgkmcnt(" #n ")" ::: "memory")
#define G_BAR __builtin_amdgcn_s_barrier()
#define G_SCHED __builtin_amdgcn_sched_barrier(0)
    Unit cur, nxt; int ui = 0;
    if (!S.next(0, cur)) return;
    f32x4 acc[2][2][4][2];
#pragma unroll
    for (int a = 0; a < 2; ++a)
#pragma unroll
        for (int b = 0; b < 2; ++b)
#pragma unroll
            for (int m = 0; m < 4; ++m)
#pragma unroll
                for (int n = 0; n < 2; ++n) acc[a][b][m][n] = (f32x4){0.f, 0.f, 0.f, 0.f};
    bf16x8 At[4][2], B0[2][2], B1[2][2];
    const char* cA = cur.a; const char* cB = cur.b;
    G_STAGE(G_SB(0, 0), cB, voffB); G_STAGE(G_SA(0, 0), cA, voffA); G_STAGE(G_SB(0, 1), cB + hstepB, voffB); G_STAGE(G_SA(0, 1), cA + hstepA, voffA);
    if (wr == 1) G_BAR;
    G_WAIT_V(4); G_BAR;
    G_STAGE(G_SB(1, 0), cB + kstep, voffB); G_STAGE(G_SA(1, 0), cA + kstep, voffA); G_STAGE(G_SB(1, 1), cB + hstepB + kstep, voffB);
    G_WAIT_V(6); G_BAR;
    for (;;) {
        const bool has_next = S.next(ui + 1, nxt);
        const char* nA = has_next ? nxt.a : cA; const char* nB = has_next ? nxt.b : cB;
        for (int t = 0; t < nt; t += 2) {
            const bool last = (t == nt - 2);
            const char* a1 = cA + (size_t)(t + 1) * kstep;
            const char* a2 = last ? nA : cA + (size_t)(t + 2) * kstep; const char* b2 = last ? nB : cB + (size_t)(t + 2) * kstep;
            const char* a3 = a2 + kstep; const char* b3 = b2 + kstep;
            G_LDB(B0, 0, 0); G_SCHED; G_LDA(At, 0, 0); G_STAGE(G_SA(1, 1), a1 + hstepA, voffA);
            G_WAIT_L(8); G_BAR; G_WAIT_L(0); G_MMA(0, 0, At, B0); G_BAR; G_SCHED;
            G_LDB(B1, 0, 1); G_STAGE(G_SB(0, 0), b2, voffB);
            G_BAR; G_WAIT_L(0); G_MMA(0, 1, At, B1); G_BAR;
            G_LDA(At, 0, 1); G_STAGE(G_SA(0, 0), a2, voffA);
            G_BAR; G_WAIT_L(0); G_MMA(1, 0, At, B0); G_BAR; G_SCHED;
            G_STAGE(G_SB(0, 1), b2 + hstepB, voffB);
            G_WAIT_V(6); G_BAR; G_MMA(1, 1, At, B1); G_BAR;
            G_LDB(B0, 1, 0); G_SCHED; G_LDA(At, 1, 0); G_STAGE(G_SA(0, 1), a2 + hstepA, voffA);
            G_WAIT_L(8); G_BAR; G_WAIT_L(0); G_MMA(0, 0, At, B0); G_BAR; G_SCHED;
            G_LDB(B1, 1, 1); G_STAGE(G_SB(1, 0), b3, voffB);
            G_BAR; G_WAIT_L(0); G_MMA(0, 1, At, B1); G_BAR;
            G_LDA(At, 1, 1); G_STAGE(G_SA(1, 0), a3, voffA);
            G_BAR; G_WAIT_L(0); G_MMA(1, 0, At, B0); G_BAR; G_SCHED;
            G_STAGE(G_SB(1, 1), b3 + hstepB, voffB);
            G_WAIT_V(6); G_BAR; G_MMA(1, 1, At, B1); G_BAR;
        }
        E(acc, cur, wr, wc, fr, fq);
        if (!has_next) break;
#pragma unroll
        for (int a = 0; a < 2; ++a)
#pragma unroll
            for (int b = 0; b < 2; ++b)
#pragma unroll
                for (int m = 0; m < 4; ++m)
#pragma unroll
                    for (int n = 0; n < 2; ++n) acc[a][b][m][n] = (f32x4){0.f, 0.f, 0.f, 0.f};
        cur = nxt; cA = nA; cB = nB; ++ui;
    }
    G_WAIT_V(0);
    if (wr == 0) G_BAR;
    G_BAR;
#undef G_SA
#undef G_SB
#undef G_STAGE
#undef G_LDA
#undef G_LDB
#undef G_MMA
#undef G_WAIT_V
#undef G_WAIT_L
#undef G_BAR
#undef G_SCHED
}

#define EPI_LOOP_BEGIN \
    _Pragma("unroll") for (int ai = 0; ai < 2; ++ai) _Pragma("unroll") for (int m = 0; m < 4; ++m) { const int row = u.pm * 256 + wr * 64 + fr + ai * 128 + m * 16; \
    _Pragma("unroll") for (int bj = 0; bj < 2; ++bj) _Pragma("unroll") for (int n = 0; n < 2; ++n) { const int cl = wc * 32 + 4 * fq + bj * 128 + n * 16; const f32x4 v = acc[ai][bj][m][n];
#define EPI_LOOP_END } }

__device__ __forceinline__ int seq_group(int row) { return row < MCTX ? 0 : 1 + ((row - MCTX) >> 11); }

struct EpiIn {
    bf16_t* xaq; bf16_t* xc; bf16_t* kb; bf16_t* vb; float* outk; float* outv; const float* rc; int l;
    __device__ __forceinline__ void operator()(const f32x4 (&acc)[2][2][4][2], const Unit& u, int wr, int wc, int fr, int fq) const {
        const int pn = u.pn; const bool qk = pn >= 4 && pn <= 8;
        bf16_t* dst; int ld, cbase; float* fo = nullptr;
        if (pn < 4) { dst = xaq; ld = 1024; cbase = pn * 256; }
        else if (pn < 8) { dst = xaq + (size_t)MROWS * 1024; ld = 1024; cbase = pn * 256 - 1024; }
        else if (pn == 8) { dst = kb; ld = 256; cbase = 0; fo = outk; }
        else if (pn == 9) { dst = vb; ld = 256; cbase = 0; fo = outv; }
        else { dst = xc; ld = 1024; cbase = pn * 256 - 2560; }
        const int hh = wc >> 1, i0 = 16 * (wc & 1) + 4 * fq;
        const int c1 = cbase + (qk ? 64 * hh + i0 : wc * 32 + 4 * fq), dc = qk ? 32 : 16;
        const bool rope = qk && u.pm >= 32;
#pragma unroll
        for (int ai = 0; ai < 2; ++ai)
#pragma unroll
            for (int m = 0; m < 4; ++m) {
                const int row = u.pm * 256 + wr * 64 + fr + ai * 128 + m * 16;
                f32x4 cs = (f32x4){1.f, 1.f, 1.f, 1.f}, sn = (f32x4){0.f, 0.f, 0.f, 0.f};
                if (rope) { const int t = (row - MCTX) & 2047; const int pos = hh == 0 ? (t >> 6) : (t & 63); cs = *(const f32x4*)(rc + pos * 32 + i0); sn = *(const f32x4*)(rc + 2048 + pos * 32 + i0); }
                bf16_t* dp = dst + (size_t)row * ld + c1;
                float* fp = fo + ((size_t)(((row >> 8) * 2 + l) * 256 + (row & 255))) * 256 + c1;
#pragma unroll
                for (int bj = 0; bj < 2; ++bj) {
                    const f32x4 x1 = acc[ai][bj][m][0], x2 = acc[ai][bj][m][1];
                    const f32x4 o1 = x1 * cs - x2 * sn, o2 = x1 * sn + x2 * cs;
                    uint2 p1, p2; p1.x = pack2(o1[0], o1[1]); p1.y = pack2(o1[2], o1[3]); p2.x = pack2(o2[0], o2[1]); p2.y = pack2(o2[2], o2[3]);
                    *(uint2*)(dp + bj * 128) = p1; *(uint2*)(dp + bj * 128 + dc) = p2;
                    if (fo != nullptr && row < MCTX) { *(f32x4*)(fp + bj * 128) = o1; *(f32x4*)(fp + bj * 128 + dc) = o2; }
                }
            }
    }
};
struct EpiGate {
    bf16_t* gt; const float* bias;
    __device__ __forceinline__ void operator()(const f32x4 (&acc)[2][2][4][2], const Unit& u, int wr, int wc, int fr, int fq) const {
        EPI_LOOP_BEGIN
            const int col = u.pn * 256 + cl;
            const f32x4 bb = *(const f32x4*)(bias + col);
            uint2 pk; pk.x = pack2(sigmoidf_(v[0] + bb[0]), sigmoidf_(v[1] + bb[1])); pk.y = pack2(sigmoidf_(v[2] + bb[2]), sigmoidf_(v[3] + bb[3]));
            *(uint2*)(gt + (size_t)row * 1024 + col) = pk;
        EPI_LOOP_END
    }
};
struct EpiBranch {
    const bf16_t* gt; float* tmp; bf16_t* mg; int j;
    __device__ __forceinline__ void operator()(const f32x4 (&acc)[2][2][4][2], const Unit& u, int wr, int wc, int fr, int fq) const {
        EPI_LOOP_BEGIN
            const int col = u.pn * 256 + cl;
            const uint2 gp = *(const uint2*)(gt + (size_t)row * 1024 + col);
            f32x4 r;
            r[0] = v[0] * bf2f((unsigned short)(gp.x & 0xffff)); r[1] = v[1] * bf2f((unsigned short)(gp.x >> 16));
            r[2] = v[2] * bf2f((unsigned short)(gp.y & 0xffff)); r[3] = v[3] * bf2f((unsigned short)(gp.y >> 16));
            float* tp = tmp + (size_t)row * 1024 + col;
            if (j == 0) { *(f32x4*)tp = r; }
            else if (j == 1) { f32x4 o = *(const f32x4*)tp; *(f32x4*)tp = o + r; }
            else { f32x4 o = *(const f32x4*)tp; o = o + r; uint2 pk; pk.x = pack2(o[0], o[1]); pk.y = pack2(o[2], o[3]); *(uint2*)(mg + (size_t)row * 1024 + col) = pk; }
        EPI_LOOP_END
    }
};
struct EpiMerge {
    bf16_t* gt; const float* bgate; float* tmp; bf16_t* mg;
    __device__ __forceinline__ void operator()(const f32x4 (&acc)[2][2][4][2], const Unit& u, int wr, int wc, int fr, int fq) const {
        const int j = u.z >> 1;
        if ((u.z & 1) == 0) { EpiGate E{gt, bgate + j * 1024}; E(acc, u, wr, wc, fr, fq); }
        else { EpiBranch E{gt, tmp, mg, j}; E(acc, u, wr, wc, fr, fq); }
    }
};
struct EpiRes {
    float* x; const float* mod; int goff;
    __device__ __forceinline__ void operator()(const f32x4 (&acc)[2][2][4][2], const Unit& u, int wr, int wc, int fr, int fq) const {
        const float* g = mod + seq_group(u.pm * 256) * 6144 + goff;
        EPI_LOOP_BEGIN
            const int col = u.pn * 256 + cl;
            const f32x4 gg = *(const f32x4*)(g + col);
            float* xp = x + (size_t)row * 1024 + col;
            f32x4 o = *(const f32x4*)xp;
            *(f32x4*)xp = o + gg * v;
        EPI_LOOP_END
    }
};
struct EpiBf {
    bf16_t* dst; int ld;
    __device__ __forceinline__ void operator()(const f32x4 (&acc)[2][2][4][2], const Unit& u, int wr, int wc, int fr, int fq) const {
        EPI_LOOP_BEGIN
            const int col = u.pn * 256 + cl;
            uint2 pk; pk.x = pack2(v[0], v[1]); pk.y = pack2(v[2], v[3]);
            *(uint2*)(dst + (size_t)row * ld + col) = pk;
        EPI_LOOP_END
    }
};
struct EpiPool {
    bf16_t* dst; const float* scale;
    __device__ __forceinline__ void operator()(const f32x4 (&acc)[2][2][4][2], const Unit& u, int wr, int wc, int fr, int fq) const {
        EPI_LOOP_BEGIN
            const int col = u.pn * 256 + cl;
            const f32x4 s = *(const f32x4*)(scale + col);
            uint2 pk; pk.x = pack2(v[0] * s[0], v[1] * s[1]); pk.y = pack2(v[2] * s[2], v[3] * s[3]);
            *(uint2*)(dst + (size_t)row * 1024 + col) = pk;
        EPI_LOOP_END
    }
};

struct TileDesc { const float* src; int lds_; bf16_t* dst; int ldd, k0, n0, perm; };
__device__ __forceinline__ int swap45(int p) { return (p & ~48) | ((p & 16) << 1) | ((p & 32) >> 1); }
__device__ __forceinline__ TileDesc weight_tile(const Params& P, int l, int t) {
    unsigned char* ws = P.ws; TileDesc d; int r = t; d.perm = 0;
    if (r < 1664) { d.src = P.w_in + (size_t)l * 1024 * 6656; d.lds_ = 6656; d.dst = (bf16_t*)(ws + OFF_WIN); d.ldd = 1024; d.k0 = (r / 104) * 64; d.n0 = (r % 104) * 64; d.perm = (d.n0 >= 1024 && d.n0 < 2304) ? 1 : 0; }
    else if ((r -= 1664) < 768) { const int j = r / 256; r %= 256; d.src = P.w_branch + (size_t)(l * 3 + j) * 1024 * 1024; d.lds_ = 1024; d.dst = (bf16_t*)(ws + OFF_WBR) + (size_t)j * 1024 * 1024; d.ldd = 1024; d.k0 = (r / 16) * 64; d.n0 = (r % 16) * 64; }
    else if ((r -= 768) < 128) { const int mat = r / 64; r %= 64; const int dh = r / 4; r %= 4;
        d.src = (mat ? P.lru_wx : P.lru_wa) + (size_t)(l * 16 + dh) * 128 * 128; d.lds_ = 128; d.dst = (bf16_t*)(ws + OFF_GW) + (size_t)dh * 256 * 128 + (size_t)mat * 128 * 128; d.ldd = 128; d.k0 = (r / 2) * 64; d.n0 = (r % 2) * 64; }
    else if ((r -= 128) < 64) { const int g = r / 16; r %= 16; d.src = P.pool_w + (size_t)(l * 4 + g) * 256 * 256; d.lds_ = 256; d.dst = (bf16_t*)(ws + OFF_PW) + (size_t)g * 256 * 256; d.ldd = 256; d.k0 = (r / 4) * 64; d.n0 = (r % 4) * 64; }
    else if ((r -= 64) < 256) { d.src = P.w_out + (size_t)l * 1024 * 1024; d.lds_ = 1024; d.dst = (bf16_t*)(ws + OFF_WOUT); d.ldd = 1024; d.k0 = (r / 16) * 64; d.n0 = (r % 16) * 64; }
    else if ((r -= 256) < 1408) { d.src = P.ffn_up + (size_t)l * 1024 * 5632; d.lds_ = 5632; d.dst = (bf16_t*)(ws + OFF_WUP); d.ldd = 1024; d.k0 = (r / 88) * 64; d.n0 = (r % 88) * 64; }
    else { r -= 1408; d.src = P.ffn_down + (size_t)l * 2816 * 1024; d.lds_ = 1024; d.dst = (bf16_t*)(ws + OFF_WDN); d.ldd = 2816; d.k0 = (r / 16) * 64; d.n0 = (r % 16) * 64; }
    return d;
}
__device__ void convert_weights(const Params& P, int l, LAS unsigned char* lds, int t_begin, int t_end, int first, int stride) {
    LAS bf16_t* sm = (LAS bf16_t*)lds;
    const int tid = otid();
    const int kk0 = tid >> 4, n4 = (tid & 15) * 4, nn = tid >> 3, ck = tid & 7;
    int t = t_begin + first;
    if (t >= t_end) return;
    TileDesc d = weight_tile(P, l, t);
    f32x4 v0 = *(const f32x4*)(d.src + (size_t)(d.k0 + kk0) * d.lds_ + d.n0 + n4), v1 = *(const f32x4*)(d.src + (size_t)(d.k0 + kk0 + 32) * d.lds_ + d.n0 + n4);
    for (;;) {
        __syncthreads();
#pragma unroll
        for (int e = 0; e < 4; ++e) { sm[(n4 + e) * 72 + kk0] = f2bf(v0[e]); sm[(n4 + e) * 72 + kk0 + 32] = f2bf(v1[e]); }
        __syncthreads();
        const TileDesc cur = d; const int tn = t + stride; const bool more = tn < t_end;
        if (more) { d = weight_tile(P, l, tn); v0 = *(const f32x4*)(d.src + (size_t)(d.k0 + kk0) * d.lds_ + d.n0 + n4); v1 = *(const f32x4*)(d.src + (size_t)(d.k0 + kk0 + 32) * d.lds_ + d.n0 + n4); }
        const u32x4 o = *(const LAS u32x4*)(sm + nn * 72 + ck * 8);
        const int nrow = cur.perm ? swap45(cur.n0 + nn) : (cur.n0 + nn);
        *(u32x4*)(cur.dst + (size_t)nrow * cur.ldd + cur.k0 + ck * 8) = o;
        if (!more) break;
        t = tn;
    }
    __syncthreads();
}

__device__ void phase0(const Params& P, LAS unsigned char* lds) {
    const int tid = otid(), G = gridDim.x, c = blockIdx.x;
    { const size_t n4 = (size_t)MROWS * 1024 / 4, nc4 = (size_t)MCTX * 1024 / 4;
      for (size_t i = (size_t)c * 512 + tid; i < n4; i += (size_t)G * 512) {
          const float4 v = i < nc4 ? ((const float4*)P.x_prompt)[i] : ((const float4*)P.x_sample)[i - nc4];
          ((float4*)P.out)[i] = v; } }
    { bf16_t* ck = (bf16_t*)(P.ws + OFF_CK); bf16_t* cv = (bf16_t*)(P.ws + OFF_CV);
      for (int i = c * 512 + tid; i < 2 * 2 * 512 * 256; i += G * 512) {
          const int e = i & 255, t = (i >> 8) & 511, b = (i >> 17) & 1, l = i >> 18;
          const size_t si = ((size_t)((b * 2 + l) * 512 + t)) * 256 + e;
          ck[i] = f2bf(P.cache_k[si]); cv[i] = f2bf(P.cache_v[si]); } }
    { float* rc = (float*)(P.ws + OFF_ROPE); float* rs = rc + 2048;
      for (int i = c * 512 + tid; i < 2048; i += G * 512) {
          const int pos = i >> 5, k = i & 31; const float fr = powf(10000.0f, -(float)k / 32.0f); const float ang = (float)pos * fr;
          rc[i] = cosf(ang); rs[i] = sinf(ang); } }
    { LAS float* sv = (LAS float*)lds;
      LAS float* red = sv + 3072;
      __syncthreads();
      for (int i = tid; i < 3072; i += 512) { const int s = i >> 10, k = i & 1023; const float x = s == 0 ? P.c_ctx[k] : P.c[(s - 1) * 1024 + k]; sv[i] = x / (1.0f + expf(-x)); }
      __syncthreads();
      float* mod = (float*)(P.ws + OFF_MOD);
      for (int it = c; it < 384; it += G) {
          const int l = it / 192, cg_ = it % 192, cl = tid & 31, kg = tid >> 5, col = cg_ * 32 + cl;
          const float* w = P.w_ada + (size_t)l * 1024 * 6144 + col;
          float a0 = 0.f, a1 = 0.f, a2 = 0.f;
#pragma unroll 16
          for (int k = kg * 64; k < kg * 64 + 64; ++k) { const float wv = w[(size_t)k * 6144]; a0 += sv[k] * wv; a1 += sv[1024 + k] * wv; a2 += sv[2048 + k] * wv; }
          red[(kg * 3 + 0) * 32 + cl] = a0; red[(kg * 3 + 1) * 32 + cl] = a1; red[(kg * 3 + 2) * 32 + cl] = a2;
          __syncthreads();
          if (tid < 96) { const int s = tid >> 5, cc = tid & 31; float sum = 0.f;
#pragma unroll
              for (int g = 0; g < 16; ++g) sum += red[(g * 3 + s) * 32 + cc];
              mod[(size_t)(l * 3 + s) * 6144 + cg_ * 32 + cc] = sum + P.b_ada[l * 6144 + cg_ * 32 + cc]; }
          __syncthreads();
      } }
}

__device__ void norm_phase(const float* __restrict__ X, const float* __restrict__ gw, const float* __restrict__ mod, int shift_off, int scale_off, bf16_t* __restrict__ H) {
    const int tid = otid(); const int lane = tid & 63, wv = blockIdx.x * 8 + (tid >> 6), nw = gridDim.x * 8;
    for (int row = wv; row < MROWS; row += nw) {
        const float* md = mod + seq_group(row) * 6144;
        f32x4 v[4]; float ss = 0.f;
#pragma unroll
        for (int i = 0; i < 4; ++i) { v[i] = *(const f32x4*)(X + (size_t)row * 1024 + i * 256 + lane * 4); ss += v[i][0] * v[i][0] + v[i][1] * v[i][1] + v[i][2] * v[i][2] + v[i][3] * v[i][3]; }
#pragma unroll
        for (int o = 32; o >= 1; o >>= 1) ss += __shfl_xor(ss, o);
        const float rstd = rsqrtf(ss * (1.0f / 1024.0f) + 1e-6f);
#pragma unroll
        for (int i = 0; i < 4; ++i) { const int col = i * 256 + lane * 4;
            const f32x4 g = *(const f32x4*)(gw + col), sc = *(const f32x4*)(md + scale_off + col), sh = *(const f32x4*)(md + shift_off + col);
            f32x4 h;
#pragma unroll
            for (int e = 0; e < 4; ++e) h[e] = v[i][e] * rstd * g[e] * (1.0f + sc[e]) + sh[e];
            uint2 pk; pk.x = pack2(h[0], h[1]); pk.y = pack2(h[2], h[3]);
            *(uint2*)(H + (size_t)row * 1024 + col) = pk; }
    }
}
__device__ void final_norm_phase(float* X, const float* __restrict__ gw) {
    const int tid = otid(); const int lane = tid & 63, wv = blockIdx.x * 8 + (tid >> 6), nw = gridDim.x * 8;
    for (int row = wv; row < MROWS; row += nw) {
        f32x4 v[4]; float ss = 0.f;
#pragma unroll
        for (int i = 0; i < 4; ++i) { v[i] = *(const f32x4*)(X + (size_t)row * 1024 + i * 256 + lane * 4); ss += v[i][0] * v[i][0] + v[i][1] * v[i][1] + v[i][2] * v[i][2] + v[i][3] * v[i][3]; }
#pragma unroll
        for (int o = 32; o >= 1; o >>= 1) ss += __shfl_xor(ss, o);
        const float rstd = rsqrtf(ss * (1.0f / 1024.0f) + 1e-6f);
#pragma unroll
        for (int i = 0; i < 4; ++i) { const int col = i * 256 + lane * 4; const f32x4 g = *(const f32x4*)(gw + col);
            f32x4 h;
#pragma unroll
            for (int e = 0; e < 4; ++e) h[e] = v[i][e] * rstd * g[e];
            *(f32x4*)(X + (size_t)row * 1024 + col) = h; }
    }
}

__device__ void pool_phase(const bf16_t* __restrict__ XC, bf16_t* __restrict__ PL) {
    const int tid = otid();
    for (int idx = blockIdx.x * 512 + tid; idx < (MROWS / 16) * 128; idx += gridDim.x * 512) {
        const int rs = (idx >> 7) * 16, ch = (idx & 127) * 8, g = ch >> 8, half = 1 << g;
        const int T = rs < MCTX ? 256 : 2048, row0 = rs < MCTX ? (rs & ~255) : MCTX + ((rs - MCTX) & ~2047), tl0 = rs - row0;
        const bf16_t* base = XC + (size_t)row0 * 1024 + ch;
        float s[8];
#pragma unroll
        for (int e = 0; e < 8; ++e) s[e] = 0.f;
        { const int lo = max(tl0 - half, 0), hi = min(tl0 + half, T);
          for (int t = lo; t < hi; ++t) { const bf16x8 x = *(const bf16x8*)(base + (size_t)t * 1024);
#pragma unroll
              for (int e = 0; e < 8; ++e) s[e] += bf2f((unsigned short)x[e]); } }
#pragma unroll 4
        for (int i = 0; i < 16; ++i) {
            const int t = tl0 + i;
            const int lo = max(t - half, 0), hi = min(t + half, T);
            const bf16x8 xs = *(const bf16x8*)(base + (size_t)t * 1024);
            const float inv = 1.0f / (float)(hi - lo);
            u32x4 o; o.x = pack2(s[0] * inv - bf2f((unsigned short)xs[0]), s[1] * inv - bf2f((unsigned short)xs[1])); o.y = pack2(s[2] * inv - bf2f((unsigned short)xs[2]), s[3] * inv - bf2f((unsigned short)xs[3]));
            o.z = pack2(s[4] * inv - bf2f((unsigned short)xs[4]), s[5] * inv - bf2f((unsigned short)xs[5])); o.w = pack2(s[6] * inv - bf2f((unsigned short)xs[6]), s[7] * inv - bf2f((unsigned short)xs[7]));
            *(u32x4*)(PL + (size_t)(row0 + t) * 1024 + ch) = o;
            if (t + half < T) { const bf16x8 x = *(const bf16x8*)(base + (size_t)(t + half) * 1024);
#pragma unroll
                for (int e = 0; e < 8; ++e) s[e] += bf2f((unsigned short)x[e]); }
            if (t - half >= 0) { const bf16x8 x = *(const bf16x8*)(base + (size_t)(t - half) * 1024);
#pragma unroll
                for (int e = 0; e < 8; ++e) s[e] -= bf2f((unsigned short)x[e]); }
        }
    }
}
__device__ __forceinline__ float gelu_tanh(float x) { const float y = 0.7978845608028654f * (x + 0.044715f * x * x * x); const float t = 1.0f - 2.0f * __builtin_amdgcn_rcpf(1.0f + __expf(2.0f * y)); return 0.5f * x * (1.0f + t); }
__device__ void act_phase(const bf16_t* __restrict__ U, bf16_t* __restrict__ ACT, const float* __restrict__ cw, const float* __restrict__ cb) {
    const int tid = otid();
    for (int idx = blockIdx.x * 512 + tid; idx < MROWS * 352; idx += gridDim.x * 512) {
        const int row = idx / 352, ch = (idx % 352) * 8;
        const int T = row < MCTX ? 256 : 2048, row0 = row < MCTX ? (row & ~255) : MCTX + ((row - MCTX) & ~2047), tl = row - row0;
        const bf16_t* up = U + (size_t)row * 5632 + ch;
        const bf16x8 u0 = *(const bf16x8*)up, vv = *(const bf16x8*)(up + 2816);
        bf16x8 um = (bf16x8){0, 0, 0, 0, 0, 0, 0, 0}, upn = um;
        if (tl > 0) um = *(const bf16x8*)(up - 5632);
        if (tl < T - 1) upn = *(const bf16x8*)(up + 5632);
        float r[8];
#pragma unroll
        for (int e = 0; e < 8; ++e) { const float gff = cw[ch + e] * bf2f((unsigned short)um[e]) + cw[2816 + ch + e] * bf2f((unsigned short)u0[e]) + cw[5632 + ch + e] * bf2f((unsigned short)upn[e]) + cb[ch + e];
            r[e] = gelu_tanh(gff) * bf2f((unsigned short)vv[e]); }
        uint4 o; o.x = pack2(r[0], r[1]); o.y = pack2(r[2], r[3]); o.z = pack2(r[4], r[5]); o.w = pack2(r[6], r[7]);
        *(uint4*)(ACT + (size_t)row * 2816 + ch) = o;
    }
}

__device__ __forceinline__ void rope8(bf16x8& x1, bf16x8& x2, const float* __restrict__ cs, const float* __restrict__ sn) {
#pragma unroll
    for (int e = 0; e < 8; ++e) { const float a = bf2f((unsigned short)x1[e]), b = bf2f((unsigned short)x2[e]); const float c = cs[e], s = sn[e];
        x1[e] = (short)f2bf(a * c - b * s); x2[e] = (short)f2bf(a * s + b * c); }
}
constexpr int VT_OFF = 64 * 272;
constexpr int ABUF = 64 * 272 + 128 * 144;
__device__ void attn_unit(const Params& P, int l, int u, LAS unsigned char* lds) {
    int tid_ = threadIdx.x; asm volatile("" : "+v"(tid_));
    const int tid = tid_, w = tid >> 6, lane = tid & 63, fr = lane & 15, fq = lane >> 4;
    const bf16_t* Q = (const bf16_t*)(P.ws + OFF_XAQ) + (size_t)MROWS * 1024;
    const bf16_t* KB = (const bf16_t*)(P.ws + OFF_KB); const bf16_t* VB = (const bf16_t*)(P.ws + OFF_VB);
    const bf16_t* CK = (const bf16_t*)(P.ws + OFF_CK); const bf16_t* CV = (const bf16_t*)(P.ws + OFF_CV);
    bf16_t* YB = (bf16_t*)(P.ws + OFF_YB);
    bool lat; int head, row0, T, qstart, bidx;
    if (u < 256) { lat = true; bidx = u >> 7; const int rem = u & 127; head = rem >> 4; qstart = (rem & 15) * 128; T = 2048; row0 = MCTX + bidx * 2048; }
    else { const int v = u - 256; lat = false; bidx = 0; const int seq = v >> 4, rem = v & 15; head = rem >> 1; qstart = (rem & 1) * 128; T = 256; row0 = seq * 256; }
    const int kvh = head >> 2;
    const int qpos = qstart + w * 16 + fr;
    bf16x8 qf[4];
    { const bf16_t* qp = Q + (size_t)(row0 + qpos) * 1024 + head * 128 + fq * 8;
#pragma unroll
      for (int kk = 0; kk < 4; ++kk) qf[kk] = *(const bf16x8*)(qp + kk * 32); }
    float m_run = P.attn_sink[l * 8 + head]; float l_run = (fq == 0) ? 1.0f : 0.0f;
    f32x4 o[8];
#pragma unroll
    for (int dt = 0; dt < 8; ++dt) o[dt] = (f32x4){0.f, 0.f, 0.f, 0.f};
    int wlo = 0, nwt = 4;
    if (lat) { wlo = max(0, qstart - 128); const int whi = min(T, qstart + 256); nwt = (whi - wlo) >> 6; }
    const int ntiles = nwt + (lat ? 8 : 0);
    const float scale = 0.08838834764831845f;
    const int lkey = tid >> 3, lp = tid & 7;
    bf16x8 pk1, pk2, pv0, pv1;
    auto tile_load = [&](int ti) {
        const bf16_t* ksrc; const bf16_t* vsrc;
        if (ti < nwt) { const int k0 = wlo + ti * 64; ksrc = KB + (size_t)(row0 + k0) * 256 + kvh * 128; vsrc = VB + (size_t)(row0 + k0) * 256 + kvh * 128; }
        else { const int k0 = (ti - nwt) * 64; const size_t o_ = ((size_t)((l * 2 + bidx) * 512 + k0)) * 256 + kvh * 128; ksrc = CK + o_; vsrc = CV + o_; }
        const bf16_t* kr = ksrc + (size_t)lkey * 256; pk1 = *(const bf16x8*)(kr + lp * 8); pk2 = *(const bf16x8*)(kr + (lp + 8) * 8);
        pv0 = *(const bf16x8*)(vsrc + (size_t)lane * 256 + w * 8); pv1 = *(const bf16x8*)(vsrc + (size_t)lane * 256 + (w + 8) * 8); };
    auto tile_store = [&](int b) {
        LAS unsigned char* kb_ = lds + b * ABUF; LAS unsigned char* vb_ = kb_ + VT_OFF;
        *(LAS bf16x8*)(kb_ + lkey * 272 + lp * 16) = pk1; *(LAS bf16x8*)(kb_ + lkey * 272 + (lp + 8) * 16) = pk2;
#pragma unroll
        for (int e = 0; e < 8; ++e) { *(LAS bf16_t*)(vb_ + (w * 8 + e) * 144 + lane * 2) = (bf16_t)pv0[e]; *(LAS bf16_t*)(vb_ + ((w + 8) * 8 + e) * 144 + lane * 2) = (bf16_t)pv1[e]; } };
    tile_load(0);
    __syncthreads();
    tile_store(0);
    if (ntiles > 1) tile_load(1);
    for (int ti = 0; ti < ntiles; ++ti) {
        const bool win = ti < nwt; const int k0 = win ? wlo + ti * 64 : (ti - nwt) * 64;
        __syncthreads();
        if (ti + 1 < ntiles) tile_store((ti + 1) & 1);
        if (ti + 2 < ntiles) tile_load(ti + 2);
        LAS unsigned char* kb_ = lds + (ti & 1) * ABUF; LAS unsigned char* vb_ = kb_ + VT_OFF;
        f32x4 s[4];
#pragma unroll
        for (int nt = 0; nt < 4; ++nt) { s[nt] = (f32x4){0.f, 0.f, 0.f, 0.f};
#pragma unroll
            for (int kk = 0; kk < 4; ++kk) { const bf16x8 a = *(const LAS bf16x8*)(kb_ + (nt * 16 + fr) * 272 + kk * 64 + fq * 16); s[nt] = __builtin_amdgcn_mfma_f32_16x16x32_bf16(a, qf[kk], s[nt], 0, 0, 0); } }
        float mt = -3.0e38f;
#pragma unroll
        for (int nt = 0; nt < 4; ++nt)
#pragma unroll
            for (int j = 0; j < 4; ++j) { float v = s[nt][j] * scale;
                if (lat && win) { const int kp = k0 + nt * 16 + fq * 4 + j; const int dd = qpos - kp; if (dd > 128 || dd < -128) v = -1.0e30f; }
                s[nt][j] = v; mt = fmaxf(mt, v); }
        mt = fmaxf(mt, __shfl_xor(mt, 16)); mt = fmaxf(mt, __shfl_xor(mt, 32));
        const float mn = fmaxf(m_run, mt); const float alpha = __expf(m_run - mn); m_run = mn;
        float ps = 0.f;
#pragma unroll
        for (int nt = 0; nt < 4; ++nt)
#pragma unroll
            for (int j = 0; j < 4; ++j) { const float p = __expf(s[nt][j] - mn); ps += p; s[nt][j] = p; }
        l_run = l_run * alpha + ps;
#pragma unroll
        for (int dt = 0; dt < 8; ++dt) o[dt] = o[dt] * alpha;
#pragma unroll
        for (int s2 = 0; s2 < 2; ++s2) {
            u32x4 pu; pu[0] = pack2(s[2 * s2][0], s[2 * s2][1]); pu[1] = pack2(s[2 * s2][2], s[2 * s2][3]); pu[2] = pack2(s[2 * s2 + 1][0], s[2 * s2 + 1][1]); pu[3] = pack2(s[2 * s2 + 1][2], s[2 * s2 + 1][3]);
            const bf16x8 pf = __builtin_bit_cast(bf16x8, pu);
#pragma unroll
            for (int dt = 0; dt < 8; ++dt) {
                const bf16x4 lo = *(const LAS bf16x4*)(vb_ + (dt * 16 + fr) * 144 + (s2 * 32 + fq * 4) * 2);
                const bf16x4 hi = *(const LAS bf16x4*)(vb_ + (dt * 16 + fr) * 144 + (s2 * 32 + 16 + fq * 4) * 2);
                const bf16x8 af = __builtin_shufflevector(lo, hi, 0, 1, 2, 3, 4, 5, 6, 7);
                o[dt] = __builtin_amdgcn_mfma_f32_16x16x32_bf16(af, pf, o[dt], 0, 0, 0);
            }
        }
    }
    float lt = l_run; lt += __shfl_xor(lt, 16); lt += __shfl_xor(lt, 32);
    const float inv = 1.0f / lt;
    bf16_t* yp = YB + (size_t)(row0 + qpos) * 1024 + head * 128 + fq * 4;
#pragma unroll
    for (int dt = 0; dt < 8; ++dt) { uint2 pk; pk.x = pack2(o[dt][0] * inv, o[dt][1] * inv); pk.y = pack2(o[dt][2] * inv, o[dt][3] * inv); *(uint2*)(yp + dt * 16) = pk; }
}

constexpr int YT_OFF = 256 * 272;
template <int MODE, int D, int NSC>
__device__ __forceinline__ void lru_dir(const Params& P, int l, int s, int cchunk, int h, LAS unsigned char* lds, int w, int fr, int fq) {
    const bool lat = s >= 32; const int row0 = lat ? MCTX + (s - 32) * 2048 : s * 256; const int t0 = cchunk * (NSC * 64);
    constexpr int NCH = 2048 / (NSC * 64);
    const bf16_t* GW = (const bf16_t*)(P.ws + OFF_GW);
    bf16_t* YA = (bf16_t*)(P.ws + OFF_YA);
    float* SUMM = (float*)(P.ws + OFF_SUMM);
    const int chl = 16 * w + fr, ch = h * 128 + chl;
    bf16x8 bwa[4], bwx[4];
    { const bf16_t* gp = GW + ((size_t)(D * 8 + h) * 256 + chl) * 128 + fq * 8;
#pragma unroll
      for (int kk = 0; kk < 4; ++kk) { bwa[kk] = *(const bf16x8*)(gp + kk * 32); bwx[kk] = *(const bf16x8*)(gp + 128 * 128 + kk * 32); } }
    const int pidx = (l * 2 + D) * 1024 + ch;
    const float ba = P.lru_ba[pidx], bx = P.lru_bx[pidx];
    const float lam = P.lru_lambda[pidx];
    const float c8 = -8.0f * log1pf(expf(-lam));
    float carry = 0.f;
    if (MODE == 0 && lat) {
        const int b = s - 32;
        carry = P.state_lru[((size_t)(b * 2 + l) * 2 + D) * 1024 + ch];
        if (D == 0) { for (int cc = 0; cc < cchunk; ++cc) { const float* sp = SUMM + ((size_t)((b * 2 + 0) * 16 + cc) * 1024 + ch) * 2; carry = sp[1] + sp[0] * carry; } }
        else { for (int cc = NCH - 1; cc > cchunk; --cc) { const float* sp = SUMM + ((size_t)((b * 2 + 1) * 16 + cc) * 1024 + ch) * 2; carry = sp[1] + sp[0] * carry; } }
    }
    float ptot = 1.0f;
#pragma unroll 1
    for (int sci = 0; sci < NSC; ++sci) {
        const int sc = D == 0 ? sci : NSC - 1 - sci;
        f32x4 r[4], g[4];
#pragma unroll
        for (int m = 0; m < 4; ++m) { r[m] = (f32x4){0.f, 0.f, 0.f, 0.f}; g[m] = (f32x4){0.f, 0.f, 0.f, 0.f};
#pragma unroll
            for (int kk = 0; kk < 4; ++kk) { const bf16x8 a = *(const LAS bf16x8*)(lds + (sc * 64 + m * 16 + fr) * 272 + kk * 64 + fq * 16);
                r[m] = __builtin_amdgcn_mfma_f32_16x16x32_bf16(a, bwa[kk], r[m], 0, 0, 0); g[m] = __builtin_amdgcn_mfma_f32_16x16x32_bf16(a, bwx[kk], g[m], 0, 0, 0); } }
#pragma unroll
        for (int mi = 0; mi < 4; ++mi) {
            const int m = D == 0 ? mi : 3 - mi;
            float av[4], bv[4];
#pragma unroll
            for (int j = 0; j < 4; ++j) {
                const float ea = 1.0f + __expf(-(r[m][j] + ba)), eb = 1.0f + __expf(-(g[m][j] + bx));
                const float inv = __builtin_amdgcn_rcpf(ea * eb);
                const float rr = inv * eb, ii = inv * ea;
                const float la = c8 * rr; const float a = __expf(la); const float z = 2.0f * la;
                const float em = (z > -0.05f) ? -z * (1.0f + z * (0.5f + z * (0.16666667f + z * 0.041666667f))) : 1.0f - a * a;
                const float x = bf2f(*(const LAS bf16_t*)(lds + (sc * 64 + m * 16 + fq * 4 + j) * 272 + chl * 2));
                av[j] = a; bv[j] = __builtin_amdgcn_sqrtf(em) * ii * x;
            }
            float p4, h4;
            p4 = av[0] * av[1] * av[2] * av[3];
            if (D == 0) h4 = ((bv[0] * av[1] + bv[1]) * av[2] + bv[2]) * av[3] + bv[3];
            else h4 = ((bv[3] * av[2] + bv[2]) * av[1] + bv[1]) * av[0] + bv[0];
            float pq[4], hq[4];
#pragma unroll
            for (int f = 0; f < 4; ++f) { pq[f] = __shfl(p4, fr + 16 * f); hq[f] = __shfl(h4, fr + 16 * f); }
            float cin = carry, mycin = 0.f;
#pragma unroll
            for (int fi = 0; fi < 4; ++fi) { const int f = D == 0 ? fi : 3 - fi; if (f == fq) mycin = cin; cin = hq[f] + pq[f] * cin; }
            carry = cin;
            if (MODE == 1) ptot *= pq[0] * pq[1] * pq[2] * pq[3];
            if (MODE == 0) {
                float hh = mycin; float y[4];
#pragma unroll
                for (int ji = 0; ji < 4; ++ji) { const int j = D == 0 ? ji : 3 - ji; hh = av[j] * hh + bv[j]; y[j] = hh; }
#pragma unroll
                for (int j = 0; j < 4; ++j) {
                    LAS bf16_t* yp = (LAS bf16_t*)(lds + YT_OFF + (sc * 64 + m * 16 + fq * 4 + j) * 272 + chl * 2);
                    if (D == 0) *yp = f2bf(y[j]);
                    else *yp = f2bf(bf2f(*yp) + y[j]);
                }
            }
        }
    }
    if (MODE == 0 && !lat && fq == 0) P.out[OUT_H + ((size_t)(s * 2 + l) * 2 + D) * 1024 + ch] = carry;
    if (MODE == 1 && fq == 0) { float* sp = SUMM + ((size_t)(((s - 32) * 2 + D) * 16 + cchunk) * 1024 + ch) * 2; sp[0] = ptot; sp[1] = carry; }
}
template <int MODE, int NSC>
__device__ void lru_unit(const Params& P, int l, int s, int cchunk, int h, LAS unsigned char* lds) {
    int tid_ = threadIdx.x; asm volatile("" : "+v"(tid_));
    const int tid = tid_, w = tid >> 6, lane = tid & 63, fr = lane & 15, fq = lane >> 4;
    const bool lat = s >= 32; const int T = lat ? 2048 : 256; const int row0 = lat ? MCTX + (s - 32) * 2048 : s * 256; const int t0 = cchunk * (NSC * 64);
    const bf16_t* XA = (const bf16_t*)(P.ws + OFF_XAQ);
    __syncthreads();
    {
        const int ck = tid & 15, ch = h * 128 + ck * 8;
        const float* cw = P.lru_conv + (size_t)l * 4096 + ch; const float* cb = P.lru_conv_b + l * 1024 + ch;
        float wk[4][8], bk[8];
#pragma unroll
        for (int e = 0; e < 8; ++e) { bk[e] = cb[e];
#pragma unroll
            for (int k = 0; k < 4; ++k) wk[k][e] = cw[k * 1024 + e]; }
#pragma unroll 2
        for (int it = 0; it < 2 * NSC; ++it) {
            const int t = (tid >> 4) + it * 32;
            float a8[8];
#pragma unroll
            for (int e = 0; e < 8; ++e) a8[e] = bk[e];
#pragma unroll
            for (int k = 0; k < 4; ++k) { const int tt = t0 + t + k - 2;
                if (tt >= 0 && tt < T) { const bf16x8 x = *(const bf16x8*)(XA + (size_t)(row0 + tt) * 1024 + ch);
#pragma unroll
                    for (int e = 0; e < 8; ++e) a8[e] += wk[k][e] * bf2f((unsigned short)x[e]); } }
            u32x4 o; o.x = pack2(a8[0], a8[1]); o.y = pack2(a8[2], a8[3]); o.z = pack2(a8[4], a8[5]); o.w = pack2(a8[6], a8[7]);
            *(LAS u32x4*)(lds + t * 272 + ck * 16) = o;
        }
    }
    __syncthreads();
    lru_dir<MODE, 0, NSC>(P, l, s, cchunk, h, lds, w, fr, fq);
    lru_dir<MODE, 1, NSC>(P, l, s, cchunk, h, lds, w, fr, fq);
    if (MODE == 0) {
        bf16_t* YA = (bf16_t*)(P.ws + OFF_YA);
        __syncthreads();
#pragma unroll
        for (int it = 0; it < 2 * NSC; ++it) { const int t = (tid >> 4) + it * 32, ck = tid & 15;
            const u32x4 v = *(const LAS u32x4*)(lds + YT_OFF + t * 272 + ck * 16);
            *(u32x4*)(YA + (size_t)(row0 + t0 + t) * 1024 + h * 128 + ck * 8) = v; }
    }
}


#define XB_TMO      128
#define XB_XCNT(j)  (256  + 64 * (j))
#define XB_XSUB(j)  (1280 + 64 * (j))
#define XB_XGEN(j)  (2304 + 64 * (j))
#define XB_TOP      3328
#define XB_TOPGEN   3392
#define XCD_BAR_WORDS 3456
#define XB_SPIN_CAP (1u << 18)
__device__ __forceinline__ unsigned xb_ld(unsigned* p)              { return __hip_atomic_load(p, __ATOMIC_RELAXED, __HIP_MEMORY_SCOPE_AGENT); }
__device__ __forceinline__ unsigned xb_add(unsigned* p, unsigned v) { return __hip_atomic_fetch_add(p, v, __ATOMIC_RELAXED, __HIP_MEMORY_SCOPE_AGENT); }
__device__ __forceinline__ unsigned xb_xcc_id() { return (unsigned)__builtin_amdgcn_s_getreg((3 << 11) | 20) & 0xFu; }
#define XB_SPIN(cond, bar) do { unsigned _sp = 0; while (cond) { __builtin_amdgcn_s_sleep(1); \
    if ((++_sp & 255u) == 0u) { if (xb_ld(&(bar)[XB_TMO])) break; if (_sp > XB_SPIN_CAP) { atomicAdd(&(bar)[XB_TMO], 1u); break; } } } } while (0)
struct XcdBarrier { unsigned* bar; unsigned x; volatile LAS unsigned* st; };
__device__ __forceinline__ XcdBarrier xcd_barrier_post(unsigned* bar, volatile LAS unsigned* st) {
    XcdBarrier b; b.bar = bar; b.x = xb_xcc_id(); b.st = st;
    if (threadIdx.x == 0) (void)xb_add(&bar[XB_XCNT(b.x)], 1u);
    return b;
}
__device__ __forceinline__ void xcd_barrier_complete(unsigned* bar, unsigned x, unsigned& nloc, unsigned& nx) {
    const unsigned G = gridDim.x * gridDim.y * gridDim.z;
    unsigned sum, cnt, mine, sp = 0u;
    for (;;) {
        sum = 0u; cnt = 0u; mine = 0u;
#pragma unroll
        for (unsigned j = 0; j < 16; ++j) { const unsigned c = xb_ld(&bar[XB_XCNT(j)]); sum += c; cnt += (c > 0u) ? 1u : 0u; mine = (j == x) ? c : mine; }
        if (sum == G) break;
        __builtin_amdgcn_s_sleep(1);
        if ((++sp & 255u) == 0u) { if (xb_ld(&bar[XB_TMO])) break; if (sp > XB_SPIN_CAP) { atomicAdd(&bar[XB_TMO], 1u); break; } }
    }
    nloc = mine > 0u ? mine : 1u; nx = cnt > 0u ? cnt : 1u;
}
__device__ __noinline__ void xcd_barrier_(unsigned* bbar, unsigned bx, volatile LAS unsigned* bst) {
    XcdBarrier b; b.bar = bbar; b.x = bx; b.st = bst;
    asm volatile("s_waitcnt vmcnt(0)" ::: "memory");
    __syncthreads();
    if (threadIdx.x == 0) {
        unsigned* bar = b.bar;
        __builtin_amdgcn_s_waitcnt(0);
        unsigned nloc = b.st[0], nx = b.st[1];
        if (nloc == 0u) { xcd_barrier_complete(bar, b.x, nloc, nx); b.st[0] = nloc; b.st[1] = nx; }
        const unsigned old = xb_add(&bar[XB_XSUB(b.x)], 1u);
        const unsigned gen = old / nloc;
        if (old + 1u == (gen + 1u) * nloc) {
            __builtin_amdgcn_fence(__ATOMIC_RELEASE, "agent");
            asm volatile("s_waitcnt vmcnt(0)" ::: "memory");
            const unsigned og = xb_add(&bar[XB_TOP], 1u);
            const unsigned tg = og / nx;
            if (og + 1u == (tg + 1u) * nx) xb_add(&bar[XB_TOPGEN], 1u);
            else XB_SPIN(xb_ld(&bar[XB_TOPGEN]) == tg, bar);
            __builtin_amdgcn_fence(__ATOMIC_ACQUIRE, "agent");
            xb_add(&bar[XB_XGEN(b.x)], 1u);
            asm volatile("s_waitcnt vmcnt(0)" ::: "memory");
        } else {
            XB_SPIN(xb_ld(&bar[XB_XGEN(b.x)]) == gen, bar);
            __builtin_amdgcn_fence(__ATOMIC_ACQUIRE, "agent");
            asm volatile("s_waitcnt vmcnt(0)" ::: "memory");
        }
    }
    __syncthreads();
}

#ifndef REPMASK
#define REPMASK 0
#endif
#define REPLOOP(i) _Pragma("unroll 1") for (int rep_ = 0; rep_ < 1 + ((REPMASK >> (i)) & 1); ++rep_)
__global__ __launch_bounds__(512, 2) void mega(Params P) {
    extern __shared__ __attribute__((aligned(16))) unsigned char shm[];
    LAS unsigned char* lds = (LAS unsigned char*)shm;
    cg::grid_group grid = cg::this_grid();
    if (threadIdx.x == 0) *(LAS u32x4*)(lds + 147456) = (u32x4){0u, 0u, 0u, 0u};
    __syncthreads();
    const XcdBarrier xb = xcd_barrier_post((unsigned*)(P.ws + OFF_BAR), (volatile LAS unsigned*)(lds + 147456));
    const int G = gridDim.x, c = blockIdx.x;
    unsigned char* ws = P.ws;
    float* X = P.out;
    bf16_t* H = (bf16_t*)(ws + OFF_H);
    const float* MOD = (const float*)(ws + OFF_MOD);

    phase0(P, lds);
    grid.sync();
    for (int l = 0; l < 2; ++l) {
        const float* mod = MOD + (size_t)l * 3 * 6144;
        REPLOOP(0) convert_weights(P, l, lds, 0, (G > 192) ? 2624 : 4992, c, G);
        REPLOOP(1) norm_phase(X, P.norm1 + l * 1024, mod, 0, 1024, H);
        xcd_barrier_(xb.bar, xb.x, xb.st);
        REPLOOP(2) { Sched S{(const char*)H, (const char*)(ws + OFF_WIN), 1024, 1024, 0, 48, 14, G, c};
          EpiIn E{(bf16_t*)(ws + OFF_XAQ), (bf16_t*)(ws + OFF_XC), (bf16_t*)(ws + OFF_KB), (bf16_t*)(ws + OFF_VB), P.out + OUT_K, P.out + OUT_V, (const float*)(ws + OFF_ROPE), l};
          gemm_phase(lds, S, 1024, E); }
        xcd_barrier_(xb.bar, xb.x, xb.st);
        REPLOOP(3) pool_phase((const bf16_t*)(ws + OFF_XC), (bf16_t*)(ws + OFF_PL));
        for (int it = c; it < 1280; it += G) {
            if (it < 256) { REPLOOP(4) attn_unit(P, l, it, lds); }
            else if (it < 512) { const int v = it - 256; REPLOOP(5) lru_unit<0, 4>(P, l, v >> 3, 0, v & 7, lds); }
            else if (it < 768) { const int q = it - 512; REPLOOP(5) lru_unit<1, 2>(P, l, 32 + (q >> 7), (q >> 3) & 15, q & 7, lds); }
            else { REPLOOP(7) attn_unit(P, l, it - 768 + 256, lds); }
        }
        xcd_barrier_(xb.bar, xb.x, xb.st);
        { Sched S{(const char*)(ws + OFF_PL), (const char*)(ws + OFF_PW), 1024, 256, 256, 48, 4, G, c};
          EpiPool E{(bf16_t*)(ws + OFF_XC), P.pool_scale + l * 1024};
          gemm_phase(lds, S, 256, E); }
#ifndef NO_LRU
        for (int it = G - 1 - c; it < 256; it += G) lru_unit<0, 2>(P, l, 32 + (it >> 7), (it >> 3) & 15, it & 7, lds);
#endif
        xcd_barrier_(xb.bar, xb.x, xb.st);
        REPLOOP(6) { MergeSched S{(const char*)ws, 1024, 1024, c};
          EpiMerge E{(bf16_t*)(ws + OFF_GT), P.b_gate + l * 3072, (float*)(ws + OFF_XAQ), (bf16_t*)(ws + OFF_PL)};
          gemm_phase(lds, S, 1024, E); }
        if (G > 192 && c >= 192) convert_weights(P, l, lds, 2624, 4992, c - 192, G - 192);
        xcd_barrier_(xb.bar, xb.x, xb.st);
        { Sched S{(const char*)(ws + OFF_PL), (const char*)(ws + OFF_WOUT), 1024, 1024, 0, 48, 4, G, c};
          EpiRes E{X, mod, 2048};
          gemm_phase(lds, S, 1024, E); }
        xcd_barrier_(xb.bar, xb.x, xb.st);
        norm_phase(X, P.norm2 + l * 1024, mod, 3072, 4096, H);
        xcd_barrier_(xb.bar, xb.x, xb.st);
        REPLOOP(9) { Sched S{(const char*)H, (const char*)(ws + OFF_WUP), 1024, 1024, 0, 48, 22, G, c};
          EpiBf E{(bf16_t*)(ws + OFF_U), 5632};
          gemm_phase(lds, S, 1024, E); }
        xcd_barrier_(xb.bar, xb.x, xb.st);
        REPLOOP(10) act_phase((const bf16_t*)(ws + OFF_U), (bf16_t*)(ws + OFF_ACT), P.ffn_conv + (size_t)l * 3 * 2816, P.ffn_conv_b + l * 2816);
        xcd_barrier_(xb.bar, xb.x, xb.st);
        { Sched S{(const char*)(ws + OFF_ACT), (const char*)(ws + OFF_WDN), 2816, 2816, 0, 48, 4, G, c};
          EpiRes E{X, mod, 5120};
          gemm_phase(lds, S, 2816, E); }
        xcd_barrier_(xb.bar, xb.x, xb.st);
    }
    final_norm_phase(X, P.final_norm);
}

extern "C" void kernel_launch(void* const* d_in, const int* in_sizes, int n_in, void* d_out, int out_size, void* d_ws, size_t ws_size, hipStream_t stream) {
    constexpr size_t kDynLds = 147456 + 16;
    static int grid_blocks = 0;
    if (!grid_blocks) {
        int dev = 0, cus = 0, per_cu = 0;
        hipGetDevice(&dev);
        hipDeviceGetAttribute(&cus, hipDeviceAttributeMultiprocessorCount, dev);
        hipFuncSetAttribute((const void*)mega, hipFuncAttributeMaxDynamicSharedMemorySize, (int)kDynLds);
        hipOccupancyMaxActiveBlocksPerMultiprocessor(&per_cu, mega, 512, kDynLds);
        if (per_cu < 1) per_cu = 1;
        if (per_cu > 1) per_cu = 1;
        grid_blocks = cus * per_cu;
    }
    Params p{};
    const float** pp = (const float**)&p;
    for (int i = 0; i < 30; ++i) pp[i] = (const float*)d_in[i];
    p.out = (float*)d_out; p.ws = (unsigned char*)d_ws;
    if (ws_size < OFF_END) { fprintf(stderr, "workspace too small: %zu < %zu\n", ws_size, (size_t)OFF_END); }
    hipMemsetAsync((unsigned char*)d_ws + OFF_BAR, 0, 16384, stream);
    void* args[] = {&p};
    hipError_t e = hipLaunchCooperativeKernel((void*)mega, dim3(grid_blocks), dim3(512), args, kDynLds, stream);
    if (e != hipSuccess) fprintf(stderr, "cooperative launch failed: %s (grid %d)\n", hipGetErrorString(e), grid_blocks);
}
```

```cpp
#include <hip/hip_runtime.h>
#include <hip/hip_cooperative_groups.h>
#include <cstdio>
namespace cg = cooperative_groups;

#define LAS __attribute__((address_space(3)))
typedef unsigned short bf16_t;
typedef short bf16x8 __attribute__((ext_vector_type(8)));
typedef float f32x4 __attribute__((ext_vector_type(4)));
typedef unsigned u32x4 __attribute__((ext_vector_type(4)));
typedef unsigned u32x2 __attribute__((ext_vector_type(2)));
typedef short bf16x4 __attribute__((ext_vector_type(4)));

constexpr int MROWS = 12288, MCTX = 8192;
constexpr size_t S24 = (size_t)MROWS * 1024 * 2;
constexpr size_t OFF_WIN = 0;
constexpr size_t OFF_WBR = OFF_WIN + (size_t)6656 * 1024 * 2;
constexpr size_t OFF_WOUT = OFF_WBR + (size_t)3 * 1024 * 1024 * 2;
constexpr size_t OFF_WUP = OFF_WOUT + (size_t)1024 * 1024 * 2;
constexpr size_t OFF_WDN = OFF_WUP + (size_t)5632 * 1024 * 2;
constexpr size_t OFF_GW = OFF_WDN + (size_t)1024 * 2816 * 2;
constexpr size_t OFF_PW = OFF_GW + (size_t)2 * 8 * 256 * 128 * 2;
constexpr size_t OFF_MOD = OFF_PW + (size_t)4 * 256 * 256 * 2;
constexpr size_t OFF_CK = OFF_MOD + (size_t)2 * 3 * 6144 * 4;
constexpr size_t OFF_CV = OFF_CK + (size_t)2 * 2 * 512 * 256 * 2;
constexpr size_t OFF_ROPE = OFF_CV + (size_t)2 * 2 * 512 * 256 * 2;
constexpr size_t OFF_SUMM = OFF_ROPE + (size_t)2 * 64 * 32 * 4;
constexpr size_t OFF_BAR = OFF_SUMM + (size_t)2 * 2 * 16 * 1024 * 2 * 4;
constexpr size_t OFF_ACT0 = OFF_BAR + 16384;
constexpr size_t OFF_XAQ = OFF_ACT0;
constexpr size_t OFF_XC = OFF_XAQ + 2 * S24;
constexpr size_t OFF_KB = OFF_XC + S24;
constexpr size_t OFF_VB = OFF_KB + (size_t)MROWS * 256 * 2;
constexpr size_t OFF_GT = OFF_VB + (size_t)MROWS * 256 * 2;
constexpr size_t OFF_YB = OFF_GT + S24;
constexpr size_t OFF_PL = OFF_YB + S24;
constexpr size_t OFF_YA = OFF_PL + S24;
constexpr size_t OFF_H = OFF_YA + S24;
constexpr size_t OFF_END = OFF_H + S24;
constexpr size_t OFF_U = OFF_XAQ;
constexpr size_t OFF_ACT = OFF_PL;
constexpr size_t OUT_K = (size_t)MROWS * 1024;
constexpr size_t OUT_V = OUT_K + (size_t)32 * 2 * 256 * 256;
constexpr size_t OUT_H = OUT_V + (size_t)32 * 2 * 256 * 256;

struct Params {
    const float *x_prompt, *x_sample, *cache_k, *cache_v, *state_lru, *c, *c_ctx, *w_ada, *b_ada, *norm1, *norm2,
        *w_in, *b_gate, *lru_conv, *lru_conv_b, *lru_wa, *lru_ba, *lru_wx, *lru_bx, *lru_lambda, *attn_sink,
        *pool_w, *pool_scale, *w_branch, *w_out, *ffn_up, *ffn_conv, *ffn_conv_b, *ffn_down, *final_norm;
    float* out; unsigned char* ws;
};

__device__ __forceinline__ unsigned short f2bf(float f) { unsigned u = __float_as_uint(f); u += 0x7FFFu + ((u >> 16) & 1u); return (unsigned short)(u >> 16); }
__device__ __forceinline__ float bf2f(unsigned short b) { return __uint_as_float(((unsigned)b) << 16); }
__device__ __forceinline__ unsigned pack2(float a, float b) { return (unsigned)f2bf(a) | ((unsigned)f2bf(b) << 16); }
__device__ __forceinline__ int otid() { int t = threadIdx.x; asm volatile("" : "+v"(t)); return t; }
__device__ __forceinline__ float sigmoidf_(float x) { return __builtin_amdgcn_rcpf(1.0f + __expf(-x)); }

constexpr int HTB = 128 * 64 * 2;
__device__ __forceinline__ int lds_byte(int r, int c) { const int st = (r >> 4) * 2 + (c >> 5), rr = r & 15, cc = c & 31, ob = rr * 64 + cc * 2; return st * 1024 + (ob ^ (((ob >> 9) & 1) << 5)); }
__device__ __forceinline__ void stage_rc(int b, int& R, int& C) { const int st = b / 1024, sb = b % 1024, swz = sb ^ (((sb >> 9) & 1) << 5); R = (st >> 1) * 16 + swz / 64; C = (st & 1) * 32 + (swz % 64) / 2; }

struct Unit { const char* a; const char* b; int pm, pn, z; };
struct Sched {
    const char* A; const char* B; int lda, ldb, acol, nM, nN, G, c;
    __device__ __forceinline__ bool next(int i, Unit& u) const {
        const long L = (long)i * G + c; const int nwg = nM * nN; if (L >= nwg) return false;
        int wgid = (int)L; { const int q = nwg / 8, r = nwg % 8, xcd = wgid % 8, off = wgid / 8; wgid = (xcd < r ? xcd * (q + 1) : r * (q + 1) + (xcd - r) * q) + off; }
        const int nig = 8 * nN, gid = wgid / nig, fm = gid * 8, gsz = (nM - fm) < 8 ? (nM - fm) : 8;
        u.pm = fm + ((wgid % nig) % gsz); u.pn = (wgid % nig) / gsz;
        u.a = A + ((size_t)u.pm * 256 * lda + (size_t)u.pn * acol) * 2; u.b = B + (size_t)u.pn * 256 * ldb * 2; u.z = 0; return true;
    }
};
struct MergeSched {
    const char* ws; int lda, ldb, c;
    __device__ __forceinline__ bool next(int i, Unit& u) const {
        if (c >= 192 || i >= 6) return false;
        const int nwg = 192, nN = 4, nM = 48;
        int wgid = c; { const int q = nwg / 8, xcd = wgid % 8, off = wgid / 8; wgid = xcd * q + off; }
        const int nig = 8 * nN, gid = wgid / nig, fm = gid * 8, gsz = (nM - fm) < 8 ? (nM - fm) : 8;
        u.pm = fm + ((wgid % nig) % gsz); u.pn = (wgid % nig) / gsz; u.z = i;
        const int j = i >> 1;
        const size_t aoff = (size_t)u.pm * 256 * 1024 * 2;
        size_t ao = OFF_H, bo = OFF_WIN + (size_t)3584 * 1024 * 2;
        if (i & 1) { bo = OFF_WBR; ao = OFF_YA; if (j == 1) ao = OFF_YB; if (j == 2) ao = OFF_XC; }
        u.a = ws + ao + aoff; u.b = ws + bo + ((size_t)j * 1024 + (size_t)u.pn * 256) * 1024 * 2;
        return true;
    }
};

template <class Epi, class SchedT>
__device__ __forceinline__ void gemm_phase(LAS unsigned char* lds, const SchedT& S, const int K_, const Epi& E) {
    int K = K_; asm volatile("" : "+s"(K));
    int tid_ = threadIdx.x; asm volatile("" : "+v"(tid_));
    const int tid = tid_, wid = __builtin_amdgcn_readfirstlane(tid >> 6), lane = tid & 63, wr = wid >> 2, wc = wid & 3, fr = lane & 15, fq = lane >> 4;
    const int nt = K / 64;
    unsigned voffA[2], voffB[2];
#pragma unroll
    for (int i = 0; i < 2; ++i) { int R, C; stage_rc(tid * 16 + i * 8192, R, C); voffA[i] = (unsigned)(R * S.lda + C) * 2u; voffB[i] = (unsigned)(R * S.ldb + C) * 2u; }
    const size_t kstep = 128;
    const size_t hstepA = (size_t)128 * S.lda * 2, hstepB = (size_t)128 * S.ldb * 2;
    const unsigned ldsw = (unsigned)wid * 1024u;
    const int aoff = lds_byte(wr * 64 + fr, fq * 8), boff = lds_byte(wc * 32 + fr, fq * 8);
#define G_SA(b, h) (((b) * 2 + (h)) * HTB)
#define G_SB(b, h) ((4 + (b) * 2 + (h)) * HTB)
#define G_STAGE(bufoff, gbase, voff) do { _Pragma("unroll") for (int _i = 0; _i < 2; ++_i) \
        __builtin_amdgcn_global_load_lds((const unsigned*)((const char*)(gbase) + (voff)[_i]), (LAS unsigned*)(lds + (bufoff) + ldsw + _i * 8192), 16, 0, 0); } while (0)
#define G_LDA(dst, b, h) do { _Pragma("unroll") for (int m = 0; m < 4; ++m) _Pragma("unroll") for (int k = 0; k < 2; ++k) dst[m][k] = *(const LAS bf16x8*)(lds + G_SA(b, h) + aoff + m * 2048 + k * 1024); } while (0)
#define G_LDB(dst, b, h) do { _Pragma("unroll") for (int n = 0; n < 2; ++n) _Pragma("unroll") for (int k = 0; k < 2; ++k) dst[n][k] = *(const LAS bf16x8*)(lds + G_SB(b, h) + boff + n * 2048 + k * 1024); } while (0)
#define G_MMA(ai, bj, At, Bt) do { __builtin_amdgcn_s_setprio(1); _Pragma("unroll") for (int m = 0; m < 4; ++m) _Pragma("unroll") for (int n = 0; n < 2; ++n) _Pragma("unroll") for (int k = 0; k < 2; ++k) \
        acc[ai][bj][m][n] = __builtin_amdgcn_mfma_f32_16x16x32_bf16(Bt[n][k], At[m][k], acc[ai][bj][m][n], 0, 0, 0); __builtin_amdgcn_s_setprio(0); } while (0)
#define G_WAIT_V(n) asm volatile("s_waitcnt vmcnt(" #n ")" ::: "memory")
#define G_WAIT_L(n) asm volatile("s_waitcnt lgkmcnt(" #n ")" ::: "memory")
#define G_BAR __builtin_amdgcn_s_barrier()
#define G_SCHED __builtin_amdgcn_sched_barrier(0)
    Unit cur, nxt; int ui = 0;
    if (!S.next(0, cur)) return;
    f32x4 acc[2][2][4][2];
#pragma unroll
    for (int a = 0; a < 2; ++a)
#pragma unroll
        for (int b = 0; b < 2; ++b)
#pragma unroll
            for (int m = 0; m < 4; ++m)
#pragma unroll
                for (int n = 0; n < 2; ++n) acc[a][b][m][n] = (f32x4){0.f, 0.f, 0.f, 0.f};
    bf16x8 At[4][2], B0[2][2], B1[2][2];
    const char* cA = cur.a; const char* cB = cur.b;
    G_STAGE(G_SB(0, 0), cB, voffB); G_STAGE(G_SA(0, 0), cA, voffA); G_STAGE(G_SB(0, 1), cB + hstepB, voffB); G_STAGE(G_SA(0, 1), cA + hstepA, voffA);
    if (wr == 1) G_BAR;
    G_WAIT_V(4); G_BAR;
    G_STAGE(G_SB(1, 0), cB + kstep, voffB); G_STAGE(G_SA(1, 0), cA + kstep, voffA); G_STAGE(G_SB(1, 1), cB + hstepB + kstep, voffB);
    G_WAIT_V(6); G_BAR;
    for (;;) {
        const bool has_next = S.next(ui + 1, nxt);
        const char* nA = has_next ? nxt.a : cA; const char* nB = has_next ? nxt.b : cB;
        for (int t = 0; t < nt; t += 2) {
            const bool last = (t == nt - 2);
            const char* a1 = cA + (size_t)(t + 1) * kstep;
            const char* a2 = last ? nA : cA + (size_t)(t + 2) * kstep; const char* b2 = last ? nB : cB + (size_t)(t + 2) * kstep;
            const char* a3 = a2 + kstep; const char* b3 = b2 + kstep;
            G_LDB(B0, 0, 0); G_SCHED; G_LDA(At, 0, 0); G_STAGE(G_SA(1, 1), a1 + hstepA, voffA);
            G_WAIT_L(8); G_BAR; G_WAIT_L(0); G_MMA(0, 0, At, B0); G_BAR; G_SCHED;
            G_LDB(B1, 0, 1); G_STAGE(G_SB(0, 0), b2, voffB);
            G_BAR; G_WAIT_L(0); G_MMA(0, 1, At, B1); G_BAR;
            G_LDA(At, 0, 1); G_STAGE(G_SA(0, 0), a2, voffA);
            G_BAR; G_WAIT_L(0); G_MMA(1, 0, At, B0); G_BAR; G_SCHED;
            G_STAGE(G_SB(0, 1), b2 + hstepB, voffB);
            G_WAIT_V(6); G_BAR; G_MMA(1, 1, At, B1); G_BAR;
            G_LDB(B0, 1, 0); G_SCHED; G_LDA(At, 1, 0); G_STAGE(G_SA(0, 1), a2 + hstepA, voffA);
            G_WAIT_L(8); G_BAR; G_WAIT_L(0); G_MMA(0, 0, At, B0); G_BAR; G_SCHED;
            G_LDB(B1, 1, 1); G_STAGE(G_SB(1, 0), b3, voffB);
            G_BAR; G_WAIT_L(0); G_MMA(0, 1, At, B1); G_BAR;
            G_LDA(At, 1, 1); G_STAGE(G_SA(1, 0), a3, voffA);
            G_BAR; G_WAIT_L(0); G_MMA(1, 0, At, B0); G_BAR; G_SCHED;
            G_STAGE(G_SB(1, 1), b3 + hstepB, voffB);
            G_WAIT_V(6); G_BAR; G_MMA(1, 1, At, B1); G_BAR;
        }
        E(acc, cur, wr, wc, fr, fq);
        if (!has_next) break;
#pragma unroll
        for (int a = 0; a < 2; ++a)
#pragma unroll
            for (int b = 0; b < 2; ++b)
#pragma unroll
                for (int m = 0; m < 4; ++m)
#pragma unroll
                    for (int n = 0; n < 2; ++n) acc[a][b][m][n] = (f32x4){0.f, 0.f, 0.f, 0.f};
        cur = nxt; cA = nA; cB = nB; ++ui;
    }
    G_WAIT_V(0);
    if (wr == 0) G_BAR;
    G_BAR;
#undef G_SA
#undef G_SB
#undef G_STAGE
#undef G_LDA
#undef G_LDB
#undef G_MMA
#undef G_WAIT_V
#undef G_WAIT_L
#undef G_BAR
#undef G_SCHED
}

#define EPI_LOOP_BEGIN \
    _Pragma("unroll") for (int ai = 0; ai < 2; ++ai) _Pragma("unroll") for (int m = 0; m < 4; ++m) { const int row = u.pm * 256 + wr * 64 + fr + ai * 128 + m * 16; \
    _Pragma("unroll") for (int bj = 0; bj < 2; ++bj) _Pragma("unroll") for (int n = 0; n < 2; ++n) { const int cl = wc * 32 + 4 * fq + bj * 128 + n * 16; const f32x4 v = acc[ai][bj][m][n];
#define EPI_LOOP_END } }

__device__ __forceinline__ int seq_group(int row) { return row < MCTX ? 0 : 1 + ((row - MCTX) >> 11); }

struct EpiIn {
    bf16_t* xaq; bf16_t* xc; bf16_t* kb; bf16_t* vb; float* outk; float* outv; const float* rc; int l;
    __device__ __forceinline__ void operator()(const f32x4 (&acc)[2][2][4][2], const Unit& u, int wr, int wc, int fr, int fq) const {
        const int pn = u.pn; const bool qk = pn >= 4 && pn <= 8;
        bf16_t* dst; int ld, cbase; float* fo = nullptr;
        if (pn < 4) { dst = xaq; ld = 1024; cbase = pn * 256; }
        else if (pn < 8) { dst = xaq + (size_t)MROWS * 1024; ld = 1024; cbase = pn * 256 - 1024; }
        else if (pn == 8) { dst = kb; ld = 256; cbase = 0; fo = outk; }
        else if (pn == 9) { dst = vb; ld = 256; cbase = 0; fo = outv; }
        else { dst = xc; ld = 1024; cbase = pn * 256 - 2560; }
        const int hh = wc >> 1, i0 = 16 * (wc & 1) + 4 * fq;
        const int c1 = cbase + (qk ? 64 * hh + i0 : wc * 32 + 4 * fq), dc = qk ? 32 : 16;
        const bool rope = qk && u.pm >= 32;
#pragma unroll
        for (int ai = 0; ai < 2; ++ai) {
            f32x4 csm[4], snm[4];
#pragma unroll
            for (int m = 0; m < 4; ++m) { csm[m] = (f32x4){1.f, 1.f, 1.f, 1.f}; snm[m] = (f32x4){0.f, 0.f, 0.f, 0.f};
                if (rope) { const int row = u.pm * 256 + wr * 64 + fr + ai * 128 + m * 16; const int t = (row - MCTX) & 2047; const int pos = hh == 0 ? (t >> 6) : (t & 63);
                    csm[m] = *(const f32x4*)(rc + pos * 32 + i0); snm[m] = *(const f32x4*)(rc + 2048 + pos * 32 + i0); } }
#pragma unroll
            for (int m = 0; m < 4; ++m) {
                const int row = u.pm * 256 + wr * 64 + fr + ai * 128 + m * 16;
                const f32x4 cs = csm[m], sn = snm[m];
                bf16_t* dp = dst + (size_t)row * ld + c1;
                float* fp = fo + ((size_t)(((row >> 8) * 2 + l) * 256 + (row & 255))) * 256 + c1;
#pragma unroll
                for (int bj = 0; bj < 2; ++bj) {
                    const f32x4 x1 = acc[ai][bj][m][0], x2 = acc[ai][bj][m][1];
                    const f32x4 o1 = x1 * cs - x2 * sn, o2 = x1 * sn + x2 * cs;
                    uint2 p1, p2; p1.x = pack2(o1[0], o1[1]); p1.y = pack2(o1[2], o1[3]); p2.x = pack2(o2[0], o2[1]); p2.y = pack2(o2[2], o2[3]);
                    *(uint2*)(dp + bj * 128) = p1; *(uint2*)(dp + bj * 128 + dc) = p2;
                    if (fo != nullptr && row < MCTX) { *(f32x4*)(fp + bj * 128) = o1; *(f32x4*)(fp + bj * 128 + dc) = o2; }
                }
            }
        }
    }
};
struct EpiGate {
    bf16_t* gt; const float* bias;
    __device__ __forceinline__ void operator()(const f32x4 (&acc)[2][2][4][2], const Unit& u, int wr, int wc, int fr, int fq) const {
        const int c0 = u.pn * 256 + wc * 32 + 4 * fq;
        f32x4 bb[4];
#pragma unroll
        for (int g = 0; g < 4; ++g) bb[g] = *(const f32x4*)(bias + c0 + (g >> 1) * 128 + (g & 1) * 16);
#pragma unroll
        for (int ai = 0; ai < 2; ++ai)
#pragma unroll
            for (int m = 0; m < 4; ++m) { const int row = u.pm * 256 + wr * 64 + fr + ai * 128 + m * 16;
#pragma unroll
                for (int g = 0; g < 4; ++g) { const f32x4 v = acc[ai][g >> 1][m][g & 1];
                    uint2 pk; pk.x = pack2(sigmoidf_(v[0] + bb[g][0]), sigmoidf_(v[1] + bb[g][1])); pk.y = pack2(sigmoidf_(v[2] + bb[g][2]), sigmoidf_(v[3] + bb[g][3]));
                    *(uint2*)(gt + (size_t)row * 1024 + c0 + (g >> 1) * 128 + (g & 1) * 16) = pk; } }
    }
};
template <int j> struct EpiBranch {
    const bf16_t* gt; float* tmp; bf16_t* mg;
    __device__ __forceinline__ void operator()(const f32x4 (&acc)[2][2][4][2], const Unit& u, int wr, int wc, int fr, int fq) const {
        const int c0 = u.pn * 256 + wc * 32 + 4 * fq;
#pragma unroll
        for (int ai = 0; ai < 2; ++ai)
#pragma unroll
            for (int m = 0; m < 4; ++m) {
                const unsigned ro = (unsigned)(u.pm * 256 + wr * 64 + fr + ai * 128 + m * 16) * 1024u + (unsigned)c0;
                uint2 gp[4]; f32x4 tv[4];
#pragma unroll
                for (int g = 0; g < 4; ++g) { const unsigned o = ro + (g >> 1) * 128 + (g & 1) * 16;
                    gp[g] = *(const uint2*)(gt + o); tv[g] = (f32x4){0.f, 0.f, 0.f, 0.f}; if (j != 0) tv[g] = *(const f32x4*)(tmp + o); }
#pragma unroll
                for (int g = 0; g < 4; ++g) { const unsigned o = ro + (g >> 1) * 128 + (g & 1) * 16;
                    const f32x4 v = acc[ai][g >> 1][m][g & 1];
                    f32x4 r = tv[g];
                    r[0] += v[0] * bf2f((unsigned short)(gp[g].x & 0xffff)); r[1] += v[1] * bf2f((unsigned short)(gp[g].x >> 16));
                    r[2] += v[2] * bf2f((unsigned short)(gp[g].y & 0xffff)); r[3] += v[3] * bf2f((unsigned short)(gp[g].y >> 16));
                    if (j != 2) *(f32x4*)(tmp + o) = r;
                    else { uint2 pk; pk.x = pack2(r[0], r[1]); pk.y = pack2(r[2], r[3]); *(uint2*)(mg + o) = pk; } }
            }
    }
};
struct EpiMerge {
    bf16_t* gt; const float* bgate; float* tmp; bf16_t* mg;
    __device__ __forceinline__ void operator()(const f32x4 (&acc)[2][2][4][2], const Unit& u, int wr, int wc, int fr, int fq) const {
        const int j = u.z >> 1;
        if ((u.z & 1) == 0) { EpiGate E{gt, bgate + j * 1024}; E(acc, u, wr, wc, fr, fq); }
        else if (j == 0) { EpiBranch<0> E{gt, tmp, mg}; E(acc, u, wr, wc, fr, fq); }
        else if (j == 1) { EpiBranch<1> E{gt, tmp, mg}; E(acc, u, wr, wc, fr, fq); }
        else { EpiBranch<2> E{gt, tmp, mg}; E(acc, u, wr, wc, fr, fq); }
    }
};
struct EpiRes {
    float* x; const float* mod; int goff;
    __device__ __forceinline__ void operator()(const f32x4 (&acc)[2][2][4][2], const Unit& u, int wr, int wc, int fr, int fq) const {
        const float* gsrc = mod + seq_group(u.pm * 256) * 6144 + goff;
        const int c0 = u.pn * 256 + wc * 32 + 4 * fq;
        f32x4 gg[4];
#pragma unroll
        for (int g = 0; g < 4; ++g) gg[g] = *(const f32x4*)(gsrc + c0 + (g >> 1) * 128 + (g & 1) * 16);
#pragma unroll
        for (int ai = 0; ai < 2; ++ai)
#pragma unroll
            for (int mp = 0; mp < 2; ++mp) {
                f32x4 xv[8];
#pragma unroll
                for (int k = 0; k < 8; ++k) { const int m = mp * 2 + (k >> 2), g = k & 3; xv[k] = *(const f32x4*)(x + ((unsigned)(u.pm * 256 + wr * 64 + fr + ai * 128 + m * 16) * 1024u + (unsigned)(c0 + (g >> 1) * 128 + (g & 1) * 16))); }
#pragma unroll
                for (int k = 0; k < 8; ++k) { const int m = mp * 2 + (k >> 2), g = k & 3; *(f32x4*)(x + ((unsigned)(u.pm * 256 + wr * 64 + fr + ai * 128 + m * 16) * 1024u + (unsigned)(c0 + (g >> 1) * 128 + (g & 1) * 16))) = xv[k] + gg[g] * acc[ai][g >> 1][m][g & 1]; }
            }
    }
};
struct EpiBf {
    bf16_t* dst; int ld;
    __device__ __forceinline__ void operator()(const f32x4 (&acc)[2][2][4][2], const Unit& u, int wr, int wc, int fr, int fq) const {
        EPI_LOOP_BEGIN
            const int col = u.pn * 256 + cl;
            uint2 pk; pk.x = pack2(v[0], v[1]); pk.y = pack2(v[2], v[3]);
            *(uint2*)(dst + (size_t)row * ld + col) = pk;
        EPI_LOOP_END
    }
};
struct EpiPool {
    bf16_t* dst; const float* scale;
    __device__ __forceinline__ void operator()(const f32x4 (&acc)[2][2][4][2], const Unit& u, int wr, int wc, int fr, int fq) const {
        const int c0 = u.pn * 256 + wc * 32 + 4 * fq;
        f32x4 sc[4];
#pragma unroll
        for (int g = 0; g < 4; ++g) sc[g] = *(const f32x4*)(scale + c0 + (g >> 1) * 128 + (g & 1) * 16);
#pragma unroll
        for (int ai = 0; ai < 2; ++ai)
#pragma unroll
            for (int m = 0; m < 4; ++m) { const int row = u.pm * 256 + wr * 64 + fr + ai * 128 + m * 16;
#pragma unroll
                for (int g = 0; g < 4; ++g) { const f32x4 v = acc[ai][g >> 1][m][g & 1] * sc[g];
                    uint2 pk; pk.x = pack2(v[0], v[1]); pk.y = pack2(v[2], v[3]);
                    *(uint2*)(dst + (size_t)row * 1024 + c0 + (g >> 1) * 128 + (g & 1) * 16) = pk; } }
    }
};

struct TileDesc { const float* src; int lds_; bf16_t* dst; int ldd, k0, n0, perm; };
__device__ __forceinline__ int swap45(int p) { return (p & ~48) | ((p & 16) << 1) | ((p & 32) >> 1); }
__device__ __forceinline__ TileDesc weight_tile(const Params& P, int l, int t) {
    unsigned char* ws = P.ws; TileDesc d; int r = t; d.perm = 0;
    if (r < 1664) { d.src = P.w_in + (size_t)l * 1024 * 6656; d.lds_ = 6656; d.dst = (bf16_t*)(ws + OFF_WIN); d.ldd = 1024; d.k0 = (r / 104) * 64; d.n0 = (r % 104) * 64; d.perm = (d.n0 >= 1024 && d.n0 < 2304) ? 1 : 0; }
    else if ((r -= 1664) < 768) { const int j = r / 256; r %= 256; d.src = P.w_branch + (size_t)(l * 3 + j) * 1024 * 1024; d.lds_ = 1024; d.dst = (bf16_t*)(ws + OFF_WBR) + (size_t)j * 1024 * 1024; d.ldd = 1024; d.k0 = (r / 16) * 64; d.n0 = (r % 16) * 64; }
    else if ((r -= 768) < 128) { const int mat = r / 64; r %= 64; const int dh = r / 4; r %= 4;
        d.src = (mat ? P.lru_wx : P.lru_wa) + (size_t)(l * 16 + dh) * 128 * 128; d.lds_ = 128; d.dst = (bf16_t*)(ws + OFF_GW) + (size_t)dh * 256 * 128 + (size_t)mat * 128 * 128; d.ldd = 128; d.k0 = (r / 2) * 64; d.n0 = (r % 2) * 64; }
    else if ((r -= 128) < 64) { const int g = r / 16; r %= 16; d.src = P.pool_w + (size_t)(l * 4 + g) * 256 * 256; d.lds_ = 256; d.dst = (bf16_t*)(ws + OFF_PW) + (size_t)g * 256 * 256; d.ldd = 256; d.k0 = (r / 4) * 64; d.n0 = (r % 4) * 64; }
    else if ((r -= 64) < 256) { d.src = P.w_out + (size_t)l * 1024 * 1024; d.lds_ = 1024; d.dst = (bf16_t*)(ws + OFF_WOUT); d.ldd = 1024; d.k0 = (r / 16) * 64; d.n0 = (r % 16) * 64; }
    else if ((r -= 256) < 1408) { d.src = P.ffn_up + (size_t)l * 1024 * 5632; d.lds_ = 5632; d.dst = (bf16_t*)(ws + OFF_WUP); d.ldd = 1024; d.k0 = (r / 88) * 64; d.n0 = (r % 88) * 64; }
    else { r -= 1408; d.src = P.ffn_down + (size_t)l * 2816 * 1024; d.lds_ = 1024; d.dst = (bf16_t*)(ws + OFF_WDN); d.ldd = 2816; d.k0 = (r / 16) * 64; d.n0 = (r % 16) * 64; }
    return d;
}
__device__ void convert_weights(const Params& P, int l, LAS unsigned char* lds, int t_begin, int t_end, int first, int stride) {
    LAS bf16_t* sm = (LAS bf16_t*)lds;
    const int tid = otid();
    const int kk0 = tid >> 4, n4 = (tid & 15) * 4, nn = tid >> 3, ck = tid & 7;
    int t = t_begin + first;
    if (t >= t_end) return;
    TileDesc d = weight_tile(P, l, t);
    f32x4 v0 = *(const f32x4*)(d.src + (size_t)(d.k0 + kk0) * d.lds_ + d.n0 + n4), v1 = *(const f32x4*)(d.src + (size_t)(d.k0 + kk0 + 32) * d.lds_ + d.n0 + n4);
    for (;;) {
        __syncthreads();
#pragma unroll
        for (int e = 0; e < 4; ++e) { sm[(n4 + e) * 72 + kk0] = f2bf(v0[e]); sm[(n4 + e) * 72 + kk0 + 32] = f2bf(v1[e]); }
        __syncthreads();
        const TileDesc cur = d; const int tn = t + stride; const bool more = tn < t_end;
        if (more) { d = weight_tile(P, l, tn); v0 = *(const f32x4*)(d.src + (size_t)(d.k0 + kk0) * d.lds_ + d.n0 + n4); v1 = *(const f32x4*)(d.src + (size_t)(d.k0 + kk0 + 32) * d.lds_ + d.n0 + n4); }
        const u32x4 o = *(const LAS u32x4*)(sm + nn * 72 + ck * 8);
        const int nrow = cur.perm ? swap45(cur.n0 + nn) : (cur.n0 + nn);
        *(u32x4*)(cur.dst + (size_t)nrow * cur.ldd + cur.k0 + ck * 8) = o;
        if (!more) break;
        t = tn;
    }
    __syncthreads();
}

__device__ void phase0(const Params& P, LAS unsigned char* lds) {
    const int tid = otid(), G = gridDim.x, c = blockIdx.x;
    { const size_t n4 = (size_t)MROWS * 1024 / 4, nc4 = (size_t)MCTX * 1024 / 4;
      for (size_t i = (size_t)c * 512 + tid; i < n4; i += (size_t)G * 512) {
          const float4 v = i < nc4 ? ((const float4*)P.x_prompt)[i] : ((const float4*)P.x_sample)[i - nc4];
          ((float4*)P.out)[i] = v; } }
    { bf16_t* ck = (bf16_t*)(P.ws + OFF_CK); bf16_t* cv = (bf16_t*)(P.ws + OFF_CV);
      for (int i = c * 512 + tid; i < 2 * 2 * 512 * 256; i += G * 512) {
          const int e = i & 255, t = (i >> 8) & 511, b = (i >> 17) & 1, l = i >> 18;
          const size_t si = ((size_t)((b * 2 + l) * 512 + t)) * 256 + e;
          ck[i] = f2bf(P.cache_k[si]); cv[i] = f2bf(P.cache_v[si]); } }
    { float* rc = (float*)(P.ws + OFF_ROPE); float* rs = rc + 2048;
      for (int i = c * 512 + tid; i < 2048; i += G * 512) {
          const int pos = i >> 5, k = i & 31; const float fr = powf(10000.0f, -(float)k / 32.0f); const float ang = (float)pos * fr;
          rc[i] = cosf(ang); rs[i] = sinf(ang); } }
    { LAS float* sv = (LAS float*)lds;
      LAS float* red = sv + 3072;
      __syncthreads();
      for (int i = tid; i < 3072; i += 512) { const int s = i >> 10, k = i & 1023; const float x = s == 0 ? P.c_ctx[k] : P.c[(s - 1) * 1024 + k]; sv[i] = x / (1.0f + expf(-x)); }
      __syncthreads();
      float* mod = (float*)(P.ws + OFF_MOD);
      for (int it = c; it < 384; it += G) {
          const int l = it / 192, cg_ = it % 192, cl = tid & 31, kg = tid >> 5, col = cg_ * 32 + cl;
          const float* w = P.w_ada + (size_t)l * 1024 * 6144 + col;
          float a0 = 0.f, a1 = 0.f, a2 = 0.f;
#pragma unroll 16
          for (int k = kg * 64; k < kg * 64 + 64; ++k) { const float wv = w[(size_t)k * 6144]; a0 += sv[k] * wv; a1 += sv[1024 + k] * wv; a2 += sv[2048 + k] * wv; }
          red[(kg * 3 + 0) * 32 + cl] = a0; red[(kg * 3 + 1) * 32 + cl] = a1; red[(kg * 3 + 2) * 32 + cl] = a2;
          __syncthreads();
          if (tid < 96) { const int s = tid >> 5, cc = tid & 31; float sum = 0.f;
#pragma unroll
              for (int g = 0; g < 16; ++g) sum += red[(g * 3 + s) * 32 + cc];
              mod[(size_t)(l * 3 + s) * 6144 + cg_ * 32 + cc] = sum + P.b_ada[l * 6144 + cg_ * 32 + cc]; }
          __syncthreads();
      } }
}

__device__ void norm_phase(const float* __restrict__ X, const float* __restrict__ gw, const float* __restrict__ mod, int shift_off, int scale_off, bf16_t* __restrict__ H) {
    const int tid = otid(); const int lane = tid & 63, wv = blockIdx.x * 8 + (tid >> 6), nw = gridDim.x * 8;
    for (int row = wv; row < MROWS; row += nw) {
        const float* md = mod + seq_group(row) * 6144;
        f32x4 v[4]; float ss = 0.f;
#pragma unroll
        for (int i = 0; i < 4; ++i) { v[i] = *(const f32x4*)(X + (size_t)row * 1024 + i * 256 + lane * 4); ss += v[i][0] * v[i][0] + v[i][1] * v[i][1] + v[i][2] * v[i][2] + v[i][3] * v[i][3]; }
#pragma unroll
        for (int o = 32; o >= 1; o >>= 1) ss += __shfl_xor(ss, o);
        const float rstd = rsqrtf(ss * (1.0f / 1024.0f) + 1e-6f);
#pragma unroll
        for (int i = 0; i < 4; ++i) { const int col = i * 256 + lane * 4;
            const f32x4 g = *(const f32x4*)(gw + col), sc = *(const f32x4*)(md + scale_off + col), sh = *(const f32x4*)(md + shift_off + col);
            f32x4 h;
#pragma unroll
            for (int e = 0; e < 4; ++e) h[e] = v[i][e] * rstd * g[e] * (1.0f + sc[e]) + sh[e];
            uint2 pk; pk.x = pack2(h[0], h[1]); pk.y = pack2(h[2], h[3]);
            *(uint2*)(H + (size_t)row * 1024 + col) = pk; }
    }
}
__device__ void final_norm_phase(float* X, const float* __restrict__ gw) {
    const int tid = otid(); const int lane = tid & 63, wv = blockIdx.x * 8 + (tid >> 6), nw = gridDim.x * 8;
    for (int row = wv; row < MROWS; row += nw) {
        f32x4 v[4]; float ss = 0.f;
#pragma unroll
        for (int i = 0; i < 4; ++i) { v[i] = *(const f32x4*)(X + (size_t)row * 1024 + i * 256 + lane * 4); ss += v[i][0] * v[i][0] + v[i][1] * v[i][1] + v[i][2] * v[i][2] + v[i][3] * v[i][3]; }
#pragma unroll
        for (int o = 32; o >= 1; o >>= 1) ss += __shfl_xor(ss, o);
        const float rstd = rsqrtf(ss * (1.0f / 1024.0f) + 1e-6f);
#pragma unroll
        for (int i = 0; i < 4; ++i) { const int col = i * 256 + lane * 4; const f32x4 g = *(const f32x4*)(gw + col);
            f32x4 h;
#pragma unroll
            for (int e = 0; e < 4; ++e) h[e] = v[i][e] * rstd * g[e];
            *(f32x4*)(X + (size_t)row * 1024 + col) = h; }
    }
}

__device__ void pool_phase(const bf16_t* __restrict__ XC, bf16_t* __restrict__ PL) {
    const int tid = otid();
    for (int idx = blockIdx.x * 512 + tid; idx < (MROWS / 16) * 128; idx += gridDim.x * 512) {
        const int rs = (idx >> 7) * 16, ch = (idx & 127) * 8, g = ch >> 8, half = 1 << g;
        const int T = rs < MCTX ? 256 : 2048, row0 = rs < MCTX ? (rs & ~255) : MCTX + ((rs - MCTX) & ~2047), tl0 = rs - row0;
        const bf16_t* base = XC + (size_t)row0 * 1024 + ch;
        float s[8];
#pragma unroll
        for (int e = 0; e < 8; ++e) s[e] = 0.f;
        { const int lo = max(tl0 - half, 0), hi = min(tl0 + half, T);
          for (int t = lo; t < hi; ++t) { const bf16x8 x = *(const bf16x8*)(base + (size_t)t * 1024);
#pragma unroll
              for (int e = 0; e < 8; ++e) s[e] += bf2f((unsigned short)x[e]); } }
#pragma unroll 4
        for (int i = 0; i < 16; ++i) {
            const int t = tl0 + i;
            const int lo = max(t - half, 0), hi = min(t + half, T);
            const bf16x8 xs = *(const bf16x8*)(base + (size_t)t * 1024);
            const float inv = 1.0f / (float)(hi - lo);
            u32x4 o; o.x = pack2(s[0] * inv - bf2f((unsigned short)xs[0]), s[1] * inv - bf2f((unsigned short)xs[1])); o.y = pack2(s[2] * inv - bf2f((unsigned short)xs[2]), s[3] * inv - bf2f((unsigned short)xs[3]));
            o.z = pack2(s[4] * inv - bf2f((unsigned short)xs[4]), s[5] * inv - bf2f((unsigned short)xs[5])); o.w = pack2(s[6] * inv - bf2f((unsigned short)xs[6]), s[7] * inv - bf2f((unsigned short)xs[7]));
            *(u32x4*)(PL + (size_t)(row0 + t) * 1024 + ch) = o;
            if (t + half < T) { const bf16x8 x = *(const bf16x8*)(base + (size_t)(t + half) * 1024);
#pragma unroll
                for (int e = 0; e < 8; ++e) s[e] += bf2f((unsigned short)x[e]); }
            if (t - half >= 0) { const bf16x8 x = *(const bf16x8*)(base + (size_t)(t - half) * 1024);
#pragma unroll
                for (int e = 0; e < 8; ++e) s[e] -= bf2f((unsigned short)x[e]); }
        }
    }
}
__device__ __forceinline__ float gelu_tanh(float x) { const float y = 0.7978845608028654f * (x + 0.044715f * x * x * x); const float t = 1.0f - 2.0f * __builtin_amdgcn_rcpf(1.0f + __expf(2.0f * y)); return 0.5f * x * (1.0f + t); }
__device__ void act_phase(const bf16_t* __restrict__ U, bf16_t* __restrict__ ACT, const float* __restrict__ cw, const float* __restrict__ cb) {
    const int tid = otid();
    for (int idx = blockIdx.x * 512 + tid; idx < (MROWS / 16) * 352; idx += gridDim.x * 512) {
        const int rs = (idx / 352) * 16, ch = (idx % 352) * 8;
        const int T = rs < MCTX ? 256 : 2048, row0 = rs < MCTX ? (rs & ~255) : MCTX + ((rs - MCTX) & ~2047), tl0 = rs - row0;
        float w0[8], w1[8], w2[8], bb[8];
#pragma unroll
        for (int e = 0; e < 8; ++e) { w0[e] = cw[ch + e]; w1[e] = cw[2816 + ch + e]; w2[e] = cw[5632 + ch + e]; bb[e] = cb[ch + e]; }
        const bf16_t* up = U + (size_t)rs * 5632 + ch;
        const bf16x8 zero = (bf16x8){0, 0, 0, 0, 0, 0, 0, 0};
        bf16x8 um = tl0 > 0 ? *(const bf16x8*)(up - 5632) : zero;
        bf16x8 u0 = *(const bf16x8*)up;
#pragma unroll 4
        for (int i = 0; i < 16; ++i) {
            const bf16x8 un = (tl0 + i < T - 1) ? *(const bf16x8*)(up + (size_t)(i + 1) * 5632) : zero;
            const bf16x8 vv = *(const bf16x8*)(up + (size_t)i * 5632 + 2816);
            float r[8];
#pragma unroll
            for (int e = 0; e < 8; ++e) { const float gff = w0[e] * bf2f((unsigned short)um[e]) + w1[e] * bf2f((unsigned short)u0[e]) + w2[e] * bf2f((unsigned short)un[e]) + bb[e];
                r[e] = gelu_tanh(gff) * bf2f((unsigned short)vv[e]); }
            u32x4 o; o.x = pack2(r[0], r[1]); o.y = pack2(r[2], r[3]); o.z = pack2(r[4], r[5]); o.w = pack2(r[6], r[7]);
            *(u32x4*)(ACT + (size_t)(rs + i) * 2816 + ch) = o;
            um = u0; u0 = un;
        }
    }
}

__device__ __forceinline__ void rope8(bf16x8& x1, bf16x8& x2, const float* __restrict__ cs, const float* __restrict__ sn) {
#pragma unroll
    for (int e = 0; e < 8; ++e) { const float a = bf2f((unsigned short)x1[e]), b = bf2f((unsigned short)x2[e]); const float c = cs[e], s = sn[e];
        x1[e] = (short)f2bf(a * c - b * s); x2[e] = (short)f2bf(a * s + b * c); }
}
constexpr int VT_OFF = 64 * 272;
constexpr int ABUF = 64 * 272 + 128 * 144;
__device__ void attn_unit(const Params& P, int l, int u, LAS unsigned char* lds) {
    int tid_ = threadIdx.x; asm volatile("" : "+v"(tid_));
    const int tid = tid_, w = tid >> 6, lane = tid & 63, fr = lane & 15, fq = lane >> 4;
    const bf16_t* Q = (const bf16_t*)(P.ws + OFF_XAQ) + (size_t)MROWS * 1024;
    const bf16_t* KB = (const bf16_t*)(P.ws + OFF_KB); const bf16_t* VB = (const bf16_t*)(P.ws + OFF_VB);
    const bf16_t* CK = (const bf16_t*)(P.ws + OFF_CK); const bf16_t* CV = (const bf16_t*)(P.ws + OFF_CV);
    bf16_t* YB = (bf16_t*)(P.ws + OFF_YB);
    bool lat; int head, row0, T, qstart, bidx;
    if (u < 256) { lat = true; bidx = u >> 7; const int rem = u & 127; head = rem >> 4; qstart = (rem & 15) * 128; T = 2048; row0 = MCTX + bidx * 2048; }
    else { const int v = u - 256; lat = false; bidx = 0; const int seq = v >> 4, rem = v & 15; head = rem >> 1; qstart = (rem & 1) * 128; T = 256; row0 = seq * 256; }
    const int kvh = head >> 2;
    const int qpos = qstart + w * 16 + fr;
    bf16x8 qf[4];
    { const bf16_t* qp = Q + (size_t)(row0 + qpos) * 1024 + head * 128 + fq * 8;
#pragma unroll
      for (int kk = 0; kk < 4; ++kk) qf[kk] = *(const bf16x8*)(qp + kk * 32); }
    float m_run = P.attn_sink[l * 8 + head]; float l_run = (fq == 0) ? 1.0f : 0.0f;
    f32x4 o[8];
#pragma unroll
    for (int dt = 0; dt < 8; ++dt) o[dt] = (f32x4){0.f, 0.f, 0.f, 0.f};
    int wlo = 0, nwt = 4;
    if (lat) { wlo = max(0, qstart - 128); const int whi = min(T, qstart + 256); nwt = (whi - wlo) >> 6; }
    const int ntiles = nwt + (lat ? 8 : 0);
    const float scale = 0.08838834764831845f;
    const int lkey = tid >> 3, lp = tid & 7;
    bf16x8 pk1, pk2, pv0, pv1;
    auto tile_load = [&](int ti) {
        const bf16_t* ksrc; const bf16_t* vsrc;
        if (ti < nwt) { const int k0 = wlo + ti * 64; ksrc = KB + (size_t)(row0 + k0) * 256 + kvh * 128; vsrc = VB + (size_t)(row0 + k0) * 256 + kvh * 128; }
        else { const int k0 = (ti - nwt) * 64; const size_t o_ = ((size_t)((l * 2 + bidx) * 512 + k0)) * 256 + kvh * 128; ksrc = CK + o_; vsrc = CV + o_; }
        const bf16_t* kr = ksrc + (size_t)lkey * 256; pk1 = *(const bf16x8*)(kr + lp * 8); pk2 = *(const bf16x8*)(kr + (lp + 8) * 8);
        pv0 = *(const bf16x8*)(vsrc + (size_t)lane * 256 + w * 8); pv1 = *(const bf16x8*)(vsrc + (size_t)lane * 256 + (w + 8) * 8); };
    auto tile_store = [&](int b) {
        LAS unsigned char* kb_ = lds + b * ABUF; LAS unsigned char* vb_ = kb_ + VT_OFF;
        *(LAS bf16x8*)(kb_ + lkey * 272 + lp * 16) = pk1; *(LAS bf16x8*)(kb_ + lkey * 272 + (lp + 8) * 16) = pk2;
#pragma unroll
        for (int e = 0; e < 8; ++e) { *(LAS bf16_t*)(vb_ + (w * 8 + e) * 144 + lane * 2) = (bf16_t)pv0[e]; *(LAS bf16_t*)(vb_ + ((w + 8) * 8 + e) * 144 + lane * 2) = (bf16_t)pv1[e]; } };
    tile_load(0);
    __syncthreads();
    tile_store(0);
    if (ntiles > 1) tile_load(1);
    for (int ti = 0; ti < ntiles; ++ti) {
        const bool win = ti < nwt; const int k0 = win ? wlo + ti * 64 : (ti - nwt) * 64;
        __syncthreads();
        if (ti + 1 < ntiles) tile_store((ti + 1) & 1);
        if (ti + 2 < ntiles) tile_load(ti + 2);
        LAS unsigned char* kb_ = lds + (ti & 1) * ABUF; LAS unsigned char* vb_ = kb_ + VT_OFF;
        f32x4 s[4];
#pragma unroll
        for (int nt = 0; nt < 4; ++nt) { s[nt] = (f32x4){0.f, 0.f, 0.f, 0.f};
#pragma unroll
            for (int kk = 0; kk < 4; ++kk) { const bf16x8 a = *(const LAS bf16x8*)(kb_ + (nt * 16 + fr) * 272 + kk * 64 + fq * 16); s[nt] = __builtin_amdgcn_mfma_f32_16x16x32_bf16(a, qf[kk], s[nt], 0, 0, 0); } }
        float mt = -3.0e38f;
#pragma unroll
        for (int nt = 0; nt < 4; ++nt)
#pragma unroll
            for (int j = 0; j < 4; ++j) { float v = s[nt][j] * scale;
                if (lat && win) { const int kp = k0 + nt * 16 + fq * 4 + j; const int dd = qpos - kp; if (dd > 128 || dd < -128) v = -1.0e30f; }
                s[nt][j] = v; mt = fmaxf(mt, v); }
        mt = fmaxf(mt, __shfl_xor(mt, 16)); mt = fmaxf(mt, __shfl_xor(mt, 32));
        const float mn = fmaxf(m_run, mt); const float alpha = __expf(m_run - mn); m_run = mn;
        float ps = 0.f;
#pragma unroll
        for (int nt = 0; nt < 4; ++nt)
#pragma unroll
            for (int j = 0; j < 4; ++j) { const float p = __expf(s[nt][j] - mn); ps += p; s[nt][j] = p; }
        l_run = l_run * alpha + ps;
#pragma unroll
        for (int dt = 0; dt < 8; ++dt) o[dt] = o[dt] * alpha;
#pragma unroll
        for (int s2 = 0; s2 < 2; ++s2) {
            u32x4 pu; pu[0] = pack2(s[2 * s2][0], s[2 * s2][1]); pu[1] = pack2(s[2 * s2][2], s[2 * s2][3]); pu[2] = pack2(s[2 * s2 + 1][0], s[2 * s2 + 1][1]); pu[3] = pack2(s[2 * s2 + 1][2], s[2 * s2 + 1][3]);
            const bf16x8 pf = __builtin_bit_cast(bf16x8, pu);
#pragma unroll
            for (int dt = 0; dt < 8; ++dt) {
                const bf16x4 lo = *(const LAS bf16x4*)(vb_ + (dt * 16 + fr) * 144 + (s2 * 32 + fq * 4) * 2);
                const bf16x4 hi = *(const LAS bf16x4*)(vb_ + (dt * 16 + fr) * 144 + (s2 * 32 + 16 + fq * 4) * 2);
                const bf16x8 af = __builtin_shufflevector(lo, hi, 0, 1, 2, 3, 4, 5, 6, 7);
                o[dt] = __builtin_amdgcn_mfma_f32_16x16x32_bf16(af, pf, o[dt], 0, 0, 0);
            }
        }
    }
    float lt = l_run; lt += __shfl_xor(lt, 16); lt += __shfl_xor(lt, 32);
    const float inv = 1.0f / lt;
    bf16_t* yp = YB + (size_t)(row0 + qpos) * 1024 + head * 128 + fq * 4;
#pragma unroll
    for (int dt = 0; dt < 8; ++dt) { uint2 pk; pk.x = pack2(o[dt][0] * inv, o[dt][1] * inv); pk.y = pack2(o[dt][2] * inv, o[dt][3] * inv); *(uint2*)(yp + dt * 16) = pk; }
}

constexpr int YT_OFF = 256 * 272;
template <int MODE, int D, int NSC>
__device__ __forceinline__ void lru_dir(const Params& P, int l, int s, int cchunk, int h, LAS unsigned char* lds, int w, int fr, int fq) {
    const bool lat = s >= 32; const int row0 = lat ? MCTX + (s - 32) * 2048 : s * 256; const int t0 = cchunk * (NSC * 64);
    constexpr int NCH = 2048 / (NSC * 64);
    const bf16_t* GW = (const bf16_t*)(P.ws + OFF_GW);
    bf16_t* YA = (bf16_t*)(P.ws + OFF_YA);
    float* SUMM = (float*)(P.ws + OFF_SUMM);
    const int chl = 16 * w + fr, ch = h * 128 + chl;
    bf16x8 bwa[4], bwx[4];
    { const bf16_t* gp = GW + ((size_t)(D * 8 + h) * 256 + chl) * 128 + fq * 8;
#pragma unroll
      for (int kk = 0; kk < 4; ++kk) { bwa[kk] = *(const bf16x8*)(gp + kk * 32); bwx[kk] = *(const bf16x8*)(gp + 128 * 128 + kk * 32); } }
    const int pidx = (l * 2 + D) * 1024 + ch;
    const float ba = P.lru_ba[pidx], bx = P.lru_bx[pidx];
    const float lam = P.lru_lambda[pidx];
    const float c8 = -8.0f * log1pf(expf(-lam));
    float carry = 0.f;
    if (MODE == 0 && lat) {
        const int b = s - 32;
        carry = P.state_lru[((size_t)(b * 2 + l) * 2 + D) * 1024 + ch];
        if (D == 0) { for (int cc = 0; cc < cchunk; ++cc) { const float* sp = SUMM + ((size_t)((b * 2 + 0) * 16 + cc) * 1024 + ch) * 2; carry = sp[1] + sp[0] * carry; } }
        else { for (int cc = NCH - 1; cc > cchunk; --cc) { const float* sp = SUMM + ((size_t)((b * 2 + 1) * 16 + cc) * 1024 + ch) * 2; carry = sp[1] + sp[0] * carry; } }
    }
    float ptot = 1.0f;
#pragma unroll 1
    for (int sci = 0; sci < NSC; ++sci) {
        const int sc = D == 0 ? sci : NSC - 1 - sci;
        f32x4 r[4], g[4];
#pragma unroll
        for (int m = 0; m < 4; ++m) { r[m] = (f32x4){0.f, 0.f, 0.f, 0.f}; g[m] = (f32x4){0.f, 0.f, 0.f, 0.f};
#pragma unroll
            for (int kk = 0; kk < 4; ++kk) { const bf16x8 a = *(const LAS bf16x8*)(lds + (sc * 64 + m * 16 + fr) * 272 + kk * 64 + fq * 16);
                r[m] = __builtin_amdgcn_mfma_f32_16x16x32_bf16(a, bwa[kk], r[m], 0, 0, 0); g[m] = __builtin_amdgcn_mfma_f32_16x16x32_bf16(a, bwx[kk], g[m], 0, 0, 0); } }
#pragma unroll
        for (int mi = 0; mi < 4; ++mi) {
            const int m = D == 0 ? mi : 3 - mi;
            float av[4], bv[4];
#pragma unroll
            for (int j = 0; j < 4; ++j) {
                const float ea = 1.0f + __expf(-(r[m][j] + ba)), eb = 1.0f + __expf(-(g[m][j] + bx));
                const float inv = __builtin_amdgcn_rcpf(ea * eb);
                const float rr = inv * eb, ii = inv * ea;
                const float la = c8 * rr; const float a = __expf(la); const float z = 2.0f * la;
                const float em = (z > -0.05f) ? -z * (1.0f + z * (0.5f + z * (0.16666667f + z * 0.041666667f))) : 1.0f - a * a;
                const float x = bf2f(*(const LAS bf16_t*)(lds + (sc * 64 + m * 16 + fq * 4 + j) * 272 + chl * 2));
                av[j] = a; bv[j] = __builtin_amdgcn_sqrtf(em) * ii * x;
            }
            float p4, h4;
            p4 = av[0] * av[1] * av[2] * av[3];
            if (D == 0) h4 = ((bv[0] * av[1] + bv[1]) * av[2] + bv[2]) * av[3] + bv[3];
            else h4 = ((bv[3] * av[2] + bv[2]) * av[1] + bv[1]) * av[0] + bv[0];
            float pq[4], hq[4];
#pragma unroll
            for (int f = 0; f < 4; ++f) { pq[f] = __shfl(p4, fr + 16 * f); hq[f] = __shfl(h4, fr + 16 * f); }
            float cin = carry, mycin = 0.f;
#pragma unroll
            for (int fi = 0; fi < 4; ++fi) { const int f = D == 0 ? fi : 3 - fi; if (f == fq) mycin = cin; cin = hq[f] + pq[f] * cin; }
            carry = cin;
            if (MODE == 1) ptot *= pq[0] * pq[1] * pq[2] * pq[3];
            if (MODE == 0) {
                float hh = mycin; float y[4];
#pragma unroll
                for (int ji = 0; ji < 4; ++ji) { const int j = D == 0 ? ji : 3 - ji; hh = av[j] * hh + bv[j]; y[j] = hh; }
#pragma unroll
                for (int j = 0; j < 4; ++j) {
                    LAS bf16_t* yp = (LAS bf16_t*)(lds + YT_OFF + (sc * 64 + m * 16 + fq * 4 + j) * 272 + chl * 2);
                    if (D == 0) *yp = f2bf(y[j]);
                    else *yp = f2bf(bf2f(*yp) + y[j]);
                }
            }
        }
    }
    if (MODE == 0 && !lat && fq == 0) P.out[OUT_H + ((size_t)(s * 2 + l) * 2 + D) * 1024 + ch] = carry;
    if (MODE == 1 && fq == 0) { float* sp = SUMM + ((size_t)(((s - 32) * 2 + D) * 16 + cchunk) * 1024 + ch) * 2; sp[0] = ptot; sp[1] = carry; }
}
template <int MODE, int NSC>
__device__ void lru_unit(const Params& P, int l, int s, int cchunk, int h, LAS unsigned char* lds) {
    int tid_ = threadIdx.x; asm volatile("" : "+v"(tid_));
    const int tid = tid_, w = tid >> 6, lane = tid & 63, fr = lane & 15, fq = lane >> 4;
    const bool lat = s >= 32; const int T = lat ? 2048 : 256; const int row0 = lat ? MCTX + (s - 32) * 2048 : s * 256; const int t0 = cchunk * (NSC * 64);
    const bf16_t* XA = (const bf16_t*)(P.ws + OFF_XAQ);
    __syncthreads();
    {
        const int ck = tid & 15, ch = h * 128 + ck * 8;
        const float* cw = P.lru_conv + (size_t)l * 4096 + ch; const float* cb = P.lru_conv_b + l * 1024 + ch;
        float wk[4][8], bk[8];
#pragma unroll
        for (int e = 0; e < 8; ++e) { bk[e] = cb[e];
#pragma unroll
            for (int k = 0; k < 4; ++k) wk[k][e] = cw[k * 1024 + e]; }
#pragma unroll 2
        for (int it = 0; it < 2 * NSC; ++it) {
            const int t = (tid >> 4) + it * 32;
            float a8[8];
#pragma unroll
            for (int e = 0; e < 8; ++e) a8[e] = bk[e];
#pragma unroll
            for (int k = 0; k < 4; ++k) { const int tt = t0 + t + k - 2;
                if (tt >= 0 && tt < T) { const bf16x8 x = *(const bf16x8*)(XA + (size_t)(row0 + tt) * 1024 + ch);
#pragma unroll
                    for (int e = 0; e < 8; ++e) a8[e] += wk[k][e] * bf2f((unsigned short)x[e]); } }
            u32x4 o; o.x = pack2(a8[0], a8[1]); o.y = pack2(a8[2], a8[3]); o.z = pack2(a8[4], a8[5]); o.w = pack2(a8[6], a8[7]);
            *(LAS u32x4*)(lds + t * 272 + ck * 16) = o;
        }
    }
    __syncthreads();
    lru_dir<MODE, 0, NSC>(P, l, s, cchunk, h, lds, w, fr, fq);
    lru_dir<MODE, 1, NSC>(P, l, s, cchunk, h, lds, w, fr, fq);
    if (MODE == 0) {
        bf16_t* YA = (bf16_t*)(P.ws + OFF_YA);
        __syncthreads();
#pragma unroll
        for (int it = 0; it < 2 * NSC; ++it) { const int t = (tid >> 4) + it * 32, ck = tid & 15;
            const u32x4 v = *(const LAS u32x4*)(lds + YT_OFF + t * 272 + ck * 16);
            *(u32x4*)(YA + (size_t)(row0 + t0 + t) * 1024 + h * 128 + ck * 8) = v; }
    }
}


#define XB_TMO      128
#define XB_XCNT(j)  (256  + 64 * (j))
#define XB_XSUB(j)  (1280 + 64 * (j))
#define XB_XGEN(j)  (2304 + 64 * (j))
#define XB_TOP      3328
#define XB_TOPGEN   3392
#define XCD_BAR_WORDS 3456
#define XB_SPIN_CAP (1u << 18)
__device__ __forceinline__ unsigned xb_ld(unsigned* p)              { return __hip_atomic_load(p, __ATOMIC_RELAXED, __HIP_MEMORY_SCOPE_AGENT); }
__device__ __forceinline__ unsigned xb_add(unsigned* p, unsigned v) { return __hip_atomic_fetch_add(p, v, __ATOMIC_RELAXED, __HIP_MEMORY_SCOPE_AGENT); }
__device__ __forceinline__ unsigned xb_xcc_id() { return (unsigned)__builtin_amdgcn_s_getreg((3 << 11) | 20) & 0xFu; }
#define XB_SPIN(cond, bar) do { unsigned _sp = 0; while (cond) { __builtin_amdgcn_s_sleep(1); \
    if ((++_sp & 255u) == 0u) { if (xb_ld(&(bar)[XB_TMO])) break; if (_sp > XB_SPIN_CAP) { atomicAdd(&(bar)[XB_TMO], 1u); break; } } } } while (0)
struct XcdBarrier { unsigned* bar; unsigned x; volatile LAS unsigned* st; };
__device__ __forceinline__ XcdBarrier xcd_barrier_post(unsigned* bar, volatile LAS unsigned* st) {
    XcdBarrier b; b.bar = bar; b.x = xb_xcc_id(); b.st = st;
    if (threadIdx.x == 0) (void)xb_add(&bar[XB_XCNT(b.x)], 1u);
    return b;
}
__device__ __forceinline__ void xcd_barrier_complete(unsigned* bar, unsigned x, unsigned& nloc, unsigned& nx) {
    const unsigned G = gridDim.x * gridDim.y * gridDim.z;
    unsigned sum, cnt, mine, sp = 0u;
    for (;;) {
        sum = 0u; cnt = 0u; mine = 0u;
#pragma unroll
        for (unsigned j = 0; j < 16; ++j) { const unsigned c = xb_ld(&bar[XB_XCNT(j)]); sum += c; cnt += (c > 0u) ? 1u : 0u; mine = (j == x) ? c : mine; }
        if (sum == G) break;
        __builtin_amdgcn_s_sleep(1);
        if ((++sp & 255u) == 0u) { if (xb_ld(&bar[XB_TMO])) break; if (sp > XB_SPIN_CAP) { atomicAdd(&bar[XB_TMO], 1u); break; } }
    }
    nloc = mine > 0u ? mine : 1u; nx = cnt > 0u ? cnt : 1u;
}
__device__ __noinline__ void xcd_barrier_(unsigned* bbar, unsigned bx, volatile LAS unsigned* bst) {
    XcdBarrier b; b.bar = bbar; b.x = bx; b.st = bst;
    asm volatile("s_waitcnt vmcnt(0)" ::: "memory");
    __syncthreads();
    if (threadIdx.x == 0) {
        unsigned* bar = b.bar;
        __builtin_amdgcn_s_waitcnt(0);
        unsigned nloc = b.st[0], nx = b.st[1];
        if (nloc == 0u) { xcd_barrier_complete(bar, b.x, nloc, nx); b.st[0] = nloc; b.st[1] = nx; }
        const unsigned old = xb_add(&bar[XB_XSUB(b.x)], 1u);
        const unsigned gen = old / nloc;
        if (old + 1u == (gen + 1u) * nloc) {
            __builtin_amdgcn_fence(__ATOMIC_RELEASE, "agent");
            asm volatile("s_waitcnt vmcnt(0)" ::: "memory");
            const unsigned og = xb_add(&bar[XB_TOP], 1u);
            const unsigned tg = og / nx;
            if (og + 1u == (tg + 1u) * nx) xb_add(&bar[XB_TOPGEN], 1u);
            else XB_SPIN(xb_ld(&bar[XB_TOPGEN]) == tg, bar);
            __builtin_amdgcn_fence(__ATOMIC_ACQUIRE, "agent");
            xb_add(&bar[XB_XGEN(b.x)], 1u);
            asm volatile("s_waitcnt vmcnt(0)" ::: "memory");
        } else {
            XB_SPIN(xb_ld(&bar[XB_XGEN(b.x)]) == gen, bar);
            __builtin_amdgcn_fence(__ATOMIC_ACQUIRE, "agent");
            asm volatile("s_waitcnt vmcnt(0)" ::: "memory");
        }
    }
    __syncthreads();
}

#ifndef REPMASK
#define REPMASK 0
#endif
#define REPLOOP(i) _Pragma("unroll 1") for (int rep_ = 0; rep_ < 1 + ((REPMASK >> (i)) & 1); ++rep_)
__global__ __launch_bounds__(512, 2) void mega(Params P) {
    extern __shared__ __attribute__((aligned(16))) unsigned char shm[];
    LAS unsigned char* lds = (LAS unsigned char*)shm;
    cg::grid_group grid = cg::this_grid();
    if (threadIdx.x == 0) *(LAS u32x4*)(lds + 147456) = (u32x4){0u, 0u, 0u, 0u};
    __syncthreads();
    const XcdBarrier xb = xcd_barrier_post((unsigned*)(P.ws + OFF_BAR), (volatile LAS unsigned*)(lds + 147456));
    const int G = gridDim.x, c = blockIdx.x;
    unsigned char* ws = P.ws;
    float* X = P.out;
    bf16_t* H = (bf16_t*)(ws + OFF_H);
    const float* MOD = (const float*)(ws + OFF_MOD);

    phase0(P, lds);
    grid.sync();
    for (int l = 0; l < 2; ++l) {
        const float* mod = MOD + (size_t)l * 3 * 6144;
        REPLOOP(0) convert_weights(P, l, lds, 0, (G > 192) ? 2624 : 4992, c, G);
        REPLOOP(1) norm_phase(X, P.norm1 + l * 1024, mod, 0, 1024, H);
        xcd_barrier_(xb.bar, xb.x, xb.st);
        REPLOOP(2) { Sched S{(const char*)H, (const char*)(ws + OFF_WIN), 1024, 1024, 0, 48, 14, G, c};
          EpiIn E{(bf16_t*)(ws + OFF_XAQ), (bf16_t*)(ws + OFF_XC), (bf16_t*)(ws + OFF_KB), (bf16_t*)(ws + OFF_VB), P.out + OUT_K, P.out + OUT_V, (const float*)(ws + OFF_ROPE), l};
          gemm_phase(lds, S, 1024, E); }
        xcd_barrier_(xb.bar, xb.x, xb.st);
        REPLOOP(3) pool_phase((const bf16_t*)(ws + OFF_XC), (bf16_t*)(ws + OFF_PL));
        for (int it = c; it < 1280; it += G) {
            if (it < 256) { REPLOOP(4) attn_unit(P, l, it, lds); }
            else if (it < 512) { const int v = it - 256; REPLOOP(5) lru_unit<0, 4>(P, l, v >> 3, 0, v & 7, lds); }
            else if (it < 768) { const int q = it - 512; REPLOOP(5) lru_unit<1, 2>(P, l, 32 + (q >> 7), (q >> 3) & 15, q & 7, lds); }
            else { REPLOOP(7) attn_unit(P, l, it - 768 + 256, lds); }
        }
        xcd_barrier_(xb.bar, xb.x, xb.st);
        { Sched S{(const char*)(ws + OFF_PL), (const char*)(ws + OFF_PW), 1024, 256, 256, 48, 4, G, c};
          EpiPool E{(bf16_t*)(ws + OFF_XC), P.pool_scale + l * 1024};
          gemm_phase(lds, S, 256, E); }
#ifndef NO_LRU
        for (int it = G - 1 - c; it < 256; it += G) lru_unit<0, 2>(P, l, 32 + (it >> 7), (it >> 3) & 15, it & 7, lds);
#endif
        xcd_barrier_(xb.bar, xb.x, xb.st);
        REPLOOP(6) { MergeSched S{(const char*)ws, 1024, 1024, c};
          EpiMerge E{(bf16_t*)(ws + OFF_GT), P.b_gate + l * 3072, (float*)(ws + OFF_XAQ), (bf16_t*)(ws + OFF_PL)};
          gemm_phase(lds, S, 1024, E); }
        if (G > 192 && c >= 192) convert_weights(P, l, lds, 2624, 4992, c - 192, G - 192);
        xcd_barrier_(xb.bar, xb.x, xb.st);
        { Sched S{(const char*)(ws + OFF_PL), (const char*)(ws + OFF_WOUT), 1024, 1024, 0, 48, 4, G, c};
          EpiRes E{X, mod, 2048};
          gemm_phase(lds, S, 1024, E); }
        xcd_barrier_(xb.bar, xb.x, xb.st);
        norm_phase(X, P.norm2 + l * 1024, mod, 3072, 4096, H);
        xcd_barrier_(xb.bar, xb.x, xb.st);
        REPLOOP(9) { Sched S{(const char*)H, (const char*)(ws + OFF_WUP), 1024, 1024, 0, 48, 22, G, c};
          EpiBf E{(bf16_t*)(ws + OFF_U), 5632};
          gemm_phase(lds, S, 1024, E); }
        xcd_barrier_(xb.bar, xb.x, xb.st);
        REPLOOP(10) act_phase((const bf16_t*)(ws + OFF_U), (bf16_t*)(ws + OFF_ACT), P.ffn_conv + (size_t)l * 3 * 2816, P.ffn_conv_b + l * 2816);
        xcd_barrier_(xb.bar, xb.x, xb.st);
        { Sched S{(const char*)(ws + OFF_ACT), (const char*)(ws + OFF_WDN), 2816, 2816, 0, 48, 4, G, c};
          EpiRes E{X, mod, 5120};
          gemm_phase(lds, S, 2816, E); }
        xcd_barrier_(xb.bar, xb.x, xb.st);
    }
    final_norm_phase(X, P.final_norm);
}

extern "C" void kernel_launch(void* const* d_in, const int* in_sizes, int n_in, void* d_out, int out_size, void* d_ws, size_t ws_size, hipStream_t stream) {
    constexpr size_t kDynLds = 147456 + 16;
    static int grid_blocks = 0;
    if (!grid_blocks) {
        int dev = 0, cus = 0, per_cu = 0;
        hipGetDevice(&dev);
        hipDeviceGetAttribute(&cus, hipDeviceAttributeMultiprocessorCount, dev);
        hipFuncSetAttribute((const void*)mega, hipFuncAttributeMaxDynamicSharedMemorySize, (int)kDynLds);
        hipOccupancyMaxActiveBlocksPerMultiprocessor(&per_cu, mega, 512, kDynLds);
        if (per_cu < 1) per_cu = 1;
        if (per_cu > 1) per_cu = 1;
        grid_blocks = cus * per_cu;
    }
    Params p{};
    const float** pp = (const float**)&p;
    for (int i = 0; i < 30; ++i) pp[i] = (const float*)d_in[i];
    p.out = (float*)d_out; p.ws = (unsigned char*)d_ws;
    if (ws_size < OFF_END) { fprintf(stderr, "workspace too small: %zu < %zu\n", ws_size, (size_t)OFF_END); }
    hipMemsetAsync((unsigned char*)d_ws + OFF_BAR, 0, 16384, stream);
    void* args[] = {&p};
    hipError_t e = hipLaunchCooperativeKernel((void*)mega, dim3(grid_blocks), dim3(512), args, kDynLds, stream);
    if (e != hipSuccess) fprintf(stderr, "cooperative launch failed: %s (grid %d)\n", hipGetErrorString(e), grid_blocks);
}
```

```cpp
#include <hip/hip_runtime.h>
#include <hip/hip_cooperative_groups.h>
#include <cstdio>
namespace cg = cooperative_groups;

#define LAS __attribute__((address_space(3)))
typedef unsigned short bf16_t;
typedef short bf16x8 __attribute__((ext_vector_type(8)));
typedef float f32x4 __attribute__((ext_vector_type(4)));
typedef unsigned u32x4 __attribute__((ext_vector_type(4)));
typedef unsigned u32x2 __attribute__((ext_vector_type(2)));
typedef short bf16x4 __attribute__((ext_vector_type(4)));

constexpr int MROWS = 12288, MCTX = 8192;
constexpr size_t S24 = (size_t)MROWS * 1024 * 2;
constexpr size_t OFF_WIN = 0;
constexpr size_t OFF_WBR = OFF_WIN + (size_t)6656 * 1024 * 2;
constexpr size_t OFF_WOUT = OFF_WBR + (size_t)3 * 1024 * 1024 * 2;
constexpr size_t OFF_WUP = OFF_WOUT + (size_t)1024 * 1024 * 2;
constexpr size_t OFF_WDN = OFF_WUP + (size_t)5632 * 1024 * 2;
constexpr size_t OFF_GW = OFF_WDN + (size_t)1024 * 2816 * 2;
constexpr size_t OFF_PW = OFF_GW + (size_t)2 * 8 * 256 * 128 * 2;
constexpr size_t OFF_MOD = OFF_PW + (size_t)4 * 256 * 256 * 2;
constexpr size_t OFF_CK = OFF_MOD + (size_t)2 * 3 * 6144 * 4;
constexpr size_t OFF_CV = OFF_CK + (size_t)2 * 2 * 512 * 256 * 2;
constexpr size_t OFF_ROPE = OFF_CV + (size_t)2 * 2 * 512 * 256 * 2;
constexpr size_t OFF_SUMM = OFF_ROPE + (size_t)2 * 64 * 32 * 4;
constexpr size_t OFF_BAR = OFF_SUMM + (size_t)2 * 2 * 16 * 1024 * 2 * 4;
constexpr size_t OFF_ACT0 = OFF_BAR + 16384;
constexpr size_t OFF_XAQ = OFF_ACT0;
constexpr size_t OFF_XC = OFF_XAQ + 2 * S24;
constexpr size_t OFF_KB = OFF_XC + S24;
constexpr size_t OFF_VB = OFF_KB + (size_t)MROWS * 256 * 2;
constexpr size_t OFF_GT = OFF_VB + (size_t)MROWS * 256 * 2;
constexpr size_t OFF_YB = OFF_GT + S24;
constexpr size_t OFF_PL = OFF_YB + S24;
constexpr size_t OFF_YA = OFF_PL + S24;
constexpr size_t OFF_H = OFF_YA + S24;
constexpr size_t OFF_END = OFF_H + S24;
constexpr size_t OFF_U = OFF_XAQ;
constexpr size_t OFF_ACT = OFF_PL;
constexpr size_t OUT_K = (size_t)MROWS * 1024;
constexpr size_t OUT_V = OUT_K + (size_t)32 * 2 * 256 * 256;
constexpr size_t OUT_H = OUT_V + (size_t)32 * 2 * 256 * 256;

struct Params {
    const float *x_prompt, *x_sample, *cache_k, *cache_v, *state_lru, *c, *c_ctx, *w_ada, *b_ada, *norm1, *norm2,
        *w_in, *b_gate, *lru_conv, *lru_conv_b, *lru_wa, *lru_ba, *lru_wx, *lru_bx, *lru_lambda, *attn_sink,
        *pool_w, *pool_scale, *w_branch, *w_out, *ffn_up, *ffn_conv, *ffn_conv_b, *ffn_down, *final_norm;
    float* out; unsigned char* ws;
};

__device__ __forceinline__ unsigned short f2bf(float f) { unsigned u = __float_as_uint(f); u += 0x7FFFu + ((u >> 16) & 1u); return (unsigned short)(u >> 16); }
__device__ __forceinline__ float bf2f(unsigned short b) { return __uint_as_float(((unsigned)b) << 16); }
__device__ __forceinline__ unsigned pack2(float a, float b) { return (unsigned)f2bf(a) | ((unsigned)f2bf(b) << 16); }
__device__ __forceinline__ int otid() { int t = threadIdx.x; asm volatile("" : "+v"(t)); return t; }
__device__ __forceinline__ float sigmoidf_(float x) { return __builtin_amdgcn_rcpf(1.0f + __expf(-x)); }

constexpr int HTB = 128 * 64 * 2;
__device__ __forceinline__ int lds_byte(int r, int c) { const int st = (r >> 4) * 2 + (c >> 5), rr = r & 15, cc = c & 31, ob = rr * 64 + cc * 2; return st * 1024 + (ob ^ (((ob >> 9) & 1) << 5)); }
__device__ __forceinline__ void stage_rc(int b, int& R, int& C) { const int st = b / 1024, sb = b % 1024, swz = sb ^ (((sb >> 9) & 1) << 5); R = (st >> 1) * 16 + swz / 64; C = (st & 1) * 32 + (swz % 64) / 2; }

struct Unit { const char* a; const char* b; int pm, pn, z, row0, m192; };
struct Sched {
    const char* A; const char* B; int lda, ldb, acol, nM, nN, G, c, tm;
    __device__ __forceinline__ bool next(int i, Unit& u) const {
        const long L = (long)i * G + c; const int nwg = nM * nN; if (L >= nwg) return false;
        int wgid = (int)L; { const int q = nwg / 8, r = nwg % 8, xcd = wgid % 8, off = wgid / 8; wgid = (xcd < r ? xcd * (q + 1) : r * (q + 1) + (xcd - r) * q) + off; }
        const int nig = 8 * nN, gid = wgid / nig, fm = gid * 8, gsz = (nM - fm) < 8 ? (nM - fm) : 8;
        u.pm = fm + ((wgid % nig) % gsz); u.pn = (wgid % nig) / gsz;
        u.a = A + ((size_t)u.pm * tm * lda + (size_t)u.pn * acol) * 2; u.b = B + (size_t)u.pn * 256 * ldb * 2; u.z = 0; u.row0 = u.pm * tm; u.m192 = (tm == 192); return true;
    }
};
struct MergeSched {
    const char* ws; int lda, ldb, c;
    __device__ __forceinline__ bool next(int i, Unit& u) const {
        if (c >= 192 || i >= 6) return false;
        const int nN = 4;
        int wgid = c; { const int q = 24, xcd = wgid % 8, off = wgid / 8; wgid = xcd * q + off; }
        const int nig = 8 * nN, gid = wgid / nig, fm = gid * 8;
        u.pm = fm + ((wgid % nig) % 8); u.pn = (wgid % nig) / 8; u.z = i; u.row0 = u.pm * 256; u.m192 = 0;
        const int j = i >> 1;
        const size_t aoff = (size_t)u.row0 * 1024 * 2;
        size_t ao = OFF_H, bo = OFF_WIN + (size_t)3584 * 1024 * 2;
        if (i & 1) { bo = OFF_WBR; ao = OFF_YA; if (j == 1) ao = OFF_YB; if (j == 2) ao = OFF_XC; }
        u.a = ws + ao + aoff; u.b = ws + bo + ((size_t)j * 1024 + (size_t)u.pn * 256) * 1024 * 2;
        return true;
    }
};

template <class Epi, class SchedT, bool M192 = false>
__device__ __forceinline__ void gemm_phase(LAS unsigned char* lds, const SchedT& S, const int K_, const Epi& E) {
    int K = K_; asm volatile("" : "+s"(K));
    int tid_ = threadIdx.x; asm volatile("" : "+v"(tid_));
    const int tid = tid_, wid = __builtin_amdgcn_readfirstlane(tid >> 6), lane = tid & 63, wr = wid >> 2, wc = wid & 3, fr = lane & 15, fq = lane >> 4;
    const int nt = K / 64;
    unsigned voffA[2], voffB[2];
#pragma unroll
    for (int i = 0; i < 2; ++i) { int R, C; stage_rc(tid * 16 + i * 8192, R, C); voffA[i] = (unsigned)(R * S.lda + C) * 2u; voffB[i] = (unsigned)(R * S.ldb + C) * 2u; }
    const size_t kstep = 128;
    const size_t hstepA = (size_t)128 * S.lda * 2, hstepB = (size_t)128 * S.ldb * 2;
    const unsigned ldsw = (unsigned)wid * 1024u;
    const int aoff = lds_byte(wr * 64 + fr, fq * 8), boff = lds_byte(wc * 32 + fr, fq * 8);
#define G_SA(b, h) (((b) * 2 + (h)) * HTB)
#define G_SB(b, h) ((4 + (b) * 2 + (h)) * HTB)
#define G_STAGE(bufoff, gbase, voff) do { _Pragma("unroll") for (int _i = 0; _i < 2; ++_i) \
        __builtin_amdgcn_global_load_lds((const unsigned*)((const char*)(gbase) + (voff)[_i]), (LAS unsigned*)(lds + (bufoff) + ldsw + _i * 8192), 16, 0, 0); } while (0)
#define G_LDA(dst, b, h) do { _Pragma("unroll") for (int m = 0; m < 4; ++m) _Pragma("unroll") for (int k = 0; k < 2; ++k) dst[m][k] = *(const LAS bf16x8*)(lds + G_SA(b, h) + aoff + m * 2048 + k * 1024); } while (0)
#define G_LDB(dst, b, h) do { _Pragma("unroll") for (int n = 0; n < 2; ++n) _Pragma("unroll") for (int k = 0; k < 2; ++k) dst[n][k] = *(const LAS bf16x8*)(lds + G_SB(b, h) + boff + n * 2048 + k * 1024); } while (0)
#define G_MMA(ai, bj, At, Bt) do { if (M192 && (ai) == 1 && wr == 1) break; __builtin_amdgcn_s_setprio(1); _Pragma("unroll") for (int m = 0; m < 4; ++m) _Pragma("unroll") for (int n = 0; n < 2; ++n) _Pragma("unroll") for (int k = 0; k < 2; ++k) \
        acc[ai][bj][m][n] = __builtin_amdgcn_mfma_f32_16x16x32_bf16(Bt[n][k], At[m][k], acc[ai][bj][m][n], 0, 0, 0); __builtin_amdgcn_s_setprio(0); } while (0)
#define G_WAIT_V(n) asm volatile("s_waitcnt vmcnt(" #n ")" ::: "memory")
#define G_WAIT_L(n) asm volatile("s_waitcnt lgkmcnt(" #n ")" ::: "memory")
#define G_BAR __builtin_amdgcn_s_barrier()
#define G_SCHED __builtin_amdgcn_sched_barrier(0)
    Unit cur, nxt; int ui = 0;
    if (!S.next(0, cur)) return;
    f32x4 acc[2][2][4][2];
#pragma unroll
    for (int a = 0; a < 2; ++a)
#pragma unroll
        for (int b = 0; b < 2; ++b)
#pragma unroll
            for (int m = 0; m < 4; ++m)
#pragma unroll
                for (int n = 0; n < 2; ++n) acc[a][b][m][n] = (f32x4){0.f, 0.f, 0.f, 0.f};
    bf16x8 At[4][2], B0[2][2], B1[2][2];
    const char* cA = cur.a; const char* cB = cur.b;
    G_STAGE(G_SB(0, 0), cB, voffB); G_STAGE(G_SA(0, 0), cA, voffA); G_STAGE(G_SB(0, 1), cB + hstepB, voffB); G_STAGE(G_SA(0, 1), cA + hstepA, voffA);
    if (wr == 1) G_BAR;
    G_WAIT_V(4); G_BAR;
    G_STAGE(G_SB(1, 0), cB + kstep, voffB); G_STAGE(G_SA(1, 0), cA + kstep, voffA); G_STAGE(G_SB(1, 1), cB + hstepB + kstep, voffB);
    G_WAIT_V(6); G_BAR;
    for (;;) {
        const bool has_next = S.next(ui + 1, nxt);
        const char* nA = has_next ? nxt.a : cA; const char* nB = has_next ? nxt.b : cB;
        for (int t = 0; t < nt; t += 2) {
            const bool last = (t == nt - 2);
            const char* a1 = cA + (size_t)(t + 1) * kstep;
            const char* a2 = last ? nA : cA + (size_t)(t + 2) * kstep; const char* b2 = last ? nB : cB + (size_t)(t + 2) * kstep;
            const char* a3 = a2 + kstep; const char* b3 = b2 + kstep;
            G_LDB(B0, 0, 0); G_SCHED; G_LDA(At, 0, 0); G_STAGE(G_SA(1, 1), a1 + hstepA, voffA);
            G_WAIT_L(8); G_BAR; G_WAIT_L(0); G_MMA(0, 0, At, B0); G_BAR; G_SCHED;
            G_LDB(B1, 0, 1); G_STAGE(G_SB(0, 0), b2, voffB);
            G_BAR; G_WAIT_L(0); G_MMA(0, 1, At, B1); G_BAR;
            G_LDA(At, 0, 1); G_STAGE(G_SA(0, 0), a2, voffA);
            G_BAR; G_WAIT_L(0); G_MMA(1, 0, At, B0); G_BAR; G_SCHED;
            G_STAGE(G_SB(0, 1), b2 + hstepB, voffB);
            G_WAIT_V(6); G_BAR; G_MMA(1, 1, At, B1); G_BAR;
            G_LDB(B0, 1, 0); G_SCHED; G_LDA(At, 1, 0); G_STAGE(G_SA(0, 1), a2 + hstepA, voffA);
            G_WAIT_L(8); G_BAR; G_WAIT_L(0); G_MMA(0, 0, At, B0); G_BAR; G_SCHED;
            G_LDB(B1, 1, 1); G_STAGE(G_SB(1, 0), b3, voffB);
            G_BAR; G_WAIT_L(0); G_MMA(0, 1, At, B1); G_BAR;
            G_LDA(At, 1, 1); G_STAGE(G_SA(1, 0), a3, voffA);
            G_BAR; G_WAIT_L(0); G_MMA(1, 0, At, B0); G_BAR; G_SCHED;
            G_STAGE(G_SB(1, 1), b3 + hstepB, voffB);
            G_WAIT_V(6); G_BAR; G_MMA(1, 1, At, B1); G_BAR;
        }
        E(acc, cur, wr, wc, fr, fq);
        if (!has_next) break;
#pragma unroll
        for (int a = 0; a < 2; ++a)
#pragma unroll
            for (int b = 0; b < 2; ++b)
#pragma unroll
                for (int m = 0; m < 4; ++m)
#pragma unroll
                    for (int n = 0; n < 2; ++n) acc[a][b][m][n] = (f32x4){0.f, 0.f, 0.f, 0.f};
        cur = nxt; cA = nA; cB = nB; ++ui;
    }
    G_WAIT_V(0);
    if (wr == 0) G_BAR;
    G_BAR;
#undef G_SA
#undef G_SB
#undef G_STAGE
#undef G_LDA
#undef G_LDB
#undef G_MMA
#undef G_WAIT_V
#undef G_WAIT_L
#undef G_BAR
#undef G_SCHED
}

#define EPI_LOOP_BEGIN \
    _Pragma("unroll") for (int ai = 0; ai < 2; ++ai) _Pragma("unroll") for (int m = 0; m < 4; ++m) { const int row = u.pm * 256 + wr * 64 + fr + ai * 128 + m * 16; \
    _Pragma("unroll") for (int bj = 0; bj < 2; ++bj) _Pragma("unroll") for (int n = 0; n < 2; ++n) { const int cl = wc * 32 + 4 * fq + bj * 128 + n * 16; const f32x4 v = acc[ai][bj][m][n];
#define EPI_LOOP_END } }

__device__ __forceinline__ int seq_group(int row) { return row < MCTX ? 0 : 1 + ((row - MCTX) >> 11); }

struct EpiIn {
    bf16_t* xaq; bf16_t* xc; bf16_t* kb; bf16_t* vb; float* outk; float* outv; const float* rc; int l;
    __device__ __forceinline__ void operator()(const f32x4 (&acc)[2][2][4][2], const Unit& u, int wr, int wc, int fr, int fq) const {
        const int pn = u.pn; const bool qk = pn >= 4 && pn <= 8;
        bf16_t* dst; int ld, cbase; float* fo = nullptr;
        if (pn < 4) { dst = xaq; ld = 1024; cbase = pn * 256; }
        else if (pn < 8) { dst = xaq + (size_t)MROWS * 1024; ld = 1024; cbase = pn * 256 - 1024; }
        else if (pn == 8) { dst = kb; ld = 256; cbase = 0; fo = outk; }
        else if (pn == 9) { dst = vb; ld = 256; cbase = 0; fo = outv; }
        else { dst = xc; ld = 1024; cbase = pn * 256 - 2560; }
        const int hh = wc >> 1, i0 = 16 * (wc & 1) + 4 * fq;
        const int c1 = cbase + (qk ? 64 * hh + i0 : wc * 32 + 4 * fq), dc = qk ? 32 : 16;
        const bool rope = qk && u.pm >= 32;
#pragma unroll
        for (int ai = 0; ai < 2; ++ai) {
            f32x4 csm[4], snm[4];
#pragma unroll
            for (int m = 0; m < 4; ++m) { csm[m] = (f32x4){1.f, 1.f, 1.f, 1.f}; snm[m] = (f32x4){0.f, 0.f, 0.f, 0.f};
                if (rope) { const int row = u.pm * 256 + wr * 64 + fr + ai * 128 + m * 16; const int t = (row - MCTX) & 2047; const int pos = hh == 0 ? (t >> 6) : (t & 63);
                    csm[m] = *(const f32x4*)(rc + pos * 32 + i0); snm[m] = *(const f32x4*)(rc + 2048 + pos * 32 + i0); } }
#pragma unroll
            for (int m = 0; m < 4; ++m) {
                const int row = u.pm * 256 + wr * 64 + fr + ai * 128 + m * 16;
                const f32x4 cs = csm[m], sn = snm[m];
                bf16_t* dp = dst + (size_t)row * ld + c1;
                float* fp = fo + ((size_t)(((row >> 8) * 2 + l) * 256 + (row & 255))) * 256 + c1;
#pragma unroll
                for (int bj = 0; bj < 2; ++bj) {
                    const f32x4 x1 = acc[ai][bj][m][0], x2 = acc[ai][bj][m][1];
                    const f32x4 o1 = x1 * cs - x2 * sn, o2 = x1 * sn + x2 * cs;
                    uint2 p1, p2; p1.x = pack2(o1[0], o1[1]); p1.y = pack2(o1[2], o1[3]); p2.x = pack2(o2[0], o2[1]); p2.y = pack2(o2[2], o2[3]);
                    *(uint2*)(dp + bj * 128) = p1; *(uint2*)(dp + bj * 128 + dc) = p2;
                    if (fo != nullptr && row < MCTX) { *(f32x4*)(fp + bj * 128) = o1; *(f32x4*)(fp + bj * 128 + dc) = o2; }
                }
            }
        }
    }
};
struct EpiGate {
    bf16_t* gt; const float* bias;
    __device__ __forceinline__ void operator()(const f32x4 (&acc)[2][2][4][2], const Unit& u, int wr, int wc, int fr, int fq) const {
        const int c0 = u.pn * 256 + wc * 32 + 4 * fq;
        f32x4 bb[4];
#pragma unroll
        for (int g = 0; g < 4; ++g) bb[g] = *(const f32x4*)(bias + c0 + (g >> 1) * 128 + (g & 1) * 16);
#pragma unroll
        for (int ai = 0; ai < 2; ++ai) { if (ai == 1 && u.m192 && wr == 1) continue;
#pragma unroll
            for (int m = 0; m < 4; ++m) { const int row = u.row0 + wr * 64 + fr + ai * 128 + m * 16;
#pragma unroll
                for (int g = 0; g < 4; ++g) { const f32x4 v = acc[ai][g >> 1][m][g & 1];
                    uint2 pk; pk.x = pack2(sigmoidf_(v[0] + bb[g][0]), sigmoidf_(v[1] + bb[g][1])); pk.y = pack2(sigmoidf_(v[2] + bb[g][2]), sigmoidf_(v[3] + bb[g][3]));
                    *(uint2*)(gt + (size_t)row * 1024 + c0 + (g >> 1) * 128 + (g & 1) * 16) = pk; } } }
    }
};
template <int j> struct EpiBranch {
    const bf16_t* gt; float* tmp; bf16_t* mg;
    __device__ __forceinline__ void operator()(const f32x4 (&acc)[2][2][4][2], const Unit& u, int wr, int wc, int fr, int fq) const {
        const int c0 = u.pn * 256 + wc * 32 + 4 * fq;
#pragma unroll
        for (int ai = 0; ai < 2; ++ai) { if (ai == 1 && u.m192 && wr == 1) continue;
#pragma unroll
            for (int m = 0; m < 4; ++m) {
                const unsigned ro = (unsigned)(u.row0 + wr * 64 + fr + ai * 128 + m * 16) * 1024u + (unsigned)c0;
                uint2 gp[4]; f32x4 tv[4];
#pragma unroll
                for (int g = 0; g < 4; ++g) { const unsigned o = ro + (g >> 1) * 128 + (g & 1) * 16;
                    gp[g] = *(const uint2*)(gt + o); tv[g] = (f32x4){0.f, 0.f, 0.f, 0.f}; if (j != 0) tv[g] = *(const f32x4*)(tmp + o); }
#pragma unroll
                for (int g = 0; g < 4; ++g) { const unsigned o = ro + (g >> 1) * 128 + (g & 1) * 16;
                    const f32x4 v = acc[ai][g >> 1][m][g & 1];
                    f32x4 r = tv[g];
                    r[0] += v[0] * bf2f((unsigned short)(gp[g].x & 0xffff)); r[1] += v[1] * bf2f((unsigned short)(gp[g].x >> 16));
                    r[2] += v[2] * bf2f((unsigned short)(gp[g].y & 0xffff)); r[3] += v[3] * bf2f((unsigned short)(gp[g].y >> 16));
                    if (j != 2) *(f32x4*)(tmp + o) = r;
                    else { uint2 pk; pk.x = pack2(r[0], r[1]); pk.y = pack2(r[2], r[3]); *(uint2*)(mg + o) = pk; } }
            } }
    }
};
struct EpiMerge {
    bf16_t* gt; const float* bgate; float* tmp; bf16_t* mg;
    __device__ __forceinline__ void operator()(const f32x4 (&acc)[2][2][4][2], const Unit& u, int wr, int wc, int fr, int fq) const {
        const int j = u.z >> 1;
        if ((u.z & 1) == 0) { EpiGate E{gt, bgate + j * 1024}; E(acc, u, wr, wc, fr, fq); }
        else if (j == 0) { EpiBranch<0> E{gt, tmp, mg}; E(acc, u, wr, wc, fr, fq); }
        else if (j == 1) { EpiBranch<1> E{gt, tmp, mg}; E(acc, u, wr, wc, fr, fq); }
        else { EpiBranch<2> E{gt, tmp, mg}; E(acc, u, wr, wc, fr, fq); }
    }
};
struct EpiRes {
    float* x; const float* mod; int goff;
    __device__ __forceinline__ void operator()(const f32x4 (&acc)[2][2][4][2], const Unit& u, int wr, int wc, int fr, int fq) const {
        const int c0 = u.pn * 256 + wc * 32 + 4 * fq;
        const int sg0 = seq_group(u.row0), sg1 = seq_group(u.row0 + (u.m192 ? 191 : 255));
        if (sg0 == sg1) {
            const float* gsrc = mod + sg0 * 6144 + goff;
            f32x4 gg[4];
#pragma unroll
            for (int g = 0; g < 4; ++g) gg[g] = *(const f32x4*)(gsrc + c0 + (g >> 1) * 128 + (g & 1) * 16);
#pragma unroll
            for (int ai = 0; ai < 2; ++ai) { if (ai == 1 && u.m192 && wr == 1) continue;
#pragma unroll
                for (int mp = 0; mp < 2; ++mp) {
                    const unsigned ro = (unsigned)(u.row0 + wr * 64 + fr + ai * 128 + mp * 32) * 1024u + (unsigned)c0;
                    f32x4 xv[8];
#pragma unroll
                    for (int k = 0; k < 8; ++k) { const int g = k & 3; xv[k] = *(const f32x4*)(x + (ro + (k >> 2) * 16384 + (g >> 1) * 128 + (g & 1) * 16)); }
#pragma unroll
                    for (int k = 0; k < 8; ++k) { const int g = k & 3, m = mp * 2 + (k >> 2); *(f32x4*)(x + (ro + (k >> 2) * 16384 + (g >> 1) * 128 + (g & 1) * 16)) = xv[k] + gg[g] * acc[ai][g >> 1][m][g & 1]; }
                } }
        } else {
#pragma unroll
            for (int ai = 0; ai < 2; ++ai) { if (ai == 1 && u.m192 && wr == 1) continue;
#pragma unroll
                for (int m = 0; m < 4; ++m) {
                    const int row = u.row0 + wr * 64 + fr + ai * 128 + m * 16;
                    const float* gsrc = mod + seq_group(row) * 6144 + goff + c0;
                    const unsigned ro = (unsigned)row * 1024u + (unsigned)c0;
                    f32x4 xv[4], gv[4];
#pragma unroll
                    for (int g = 0; g < 4; ++g) { xv[g] = *(const f32x4*)(x + (ro + (g >> 1) * 128 + (g & 1) * 16)); gv[g] = *(const f32x4*)(gsrc + (g >> 1) * 128 + (g & 1) * 16); }
#pragma unroll
                    for (int g = 0; g < 4; ++g) *(f32x4*)(x + (ro + (g >> 1) * 128 + (g & 1) * 16)) = xv[g] + gv[g] * acc[ai][g >> 1][m][g & 1];
                } }
        }
    }
};
struct EpiBf {
    bf16_t* dst; int ld;
    __device__ __forceinline__ void operator()(const f32x4 (&acc)[2][2][4][2], const Unit& u, int wr, int wc, int fr, int fq) const {
        EPI_LOOP_BEGIN
            const int col = u.pn * 256 + cl;
            uint2 pk; pk.x = pack2(v[0], v[1]); pk.y = pack2(v[2], v[3]);
            *(uint2*)(dst + (size_t)row * ld + col) = pk;
        EPI_LOOP_END
    }
};
struct EpiPool {
    bf16_t* dst; const float* scale;
    __device__ __forceinline__ void operator()(const f32x4 (&acc)[2][2][4][2], const Unit& u, int wr, int wc, int fr, int fq) const {
        const int c0 = u.pn * 256 + wc * 32 + 4 * fq;
        f32x4 sc[4];
#pragma unroll
        for (int g = 0; g < 4; ++g) sc[g] = *(const f32x4*)(scale + c0 + (g >> 1) * 128 + (g & 1) * 16);
#pragma unroll
        for (int ai = 0; ai < 2; ++ai)
#pragma unroll
            for (int m = 0; m < 4; ++m) { const int row = u.pm * 256 + wr * 64 + fr + ai * 128 + m * 16;
#pragma unroll
                for (int g = 0; g < 4; ++g) { const f32x4 v = acc[ai][g >> 1][m][g & 1] * sc[g];
                    uint2 pk; pk.x = pack2(v[0], v[1]); pk.y = pack2(v[2], v[3]);
                    *(uint2*)(dst + (size_t)row * 1024 + c0 + (g >> 1) * 128 + (g & 1) * 16) = pk; } }
    }
};

struct WPtrs { const float *w_in, *w_branch, *lru_wa, *lru_wx, *pool_w, *w_out, *ffn_up, *ffn_down; unsigned char* ws; };
struct TileDesc { const float* src; int lds_; bf16_t* dst; int ldd, k0, n0, perm; };
__device__ __forceinline__ int swap45(int p) { return (p & ~48) | ((p & 16) << 1) | ((p & 32) >> 1); }
__device__ __forceinline__ TileDesc weight_tile(const WPtrs& P, int l, int t) {
    unsigned char* ws = P.ws; TileDesc d; int r = t; d.perm = 0;
    if (r < 1664) { d.src = P.w_in + (size_t)l * 1024 * 6656; d.lds_ = 6656; d.dst = (bf16_t*)(ws + OFF_WIN); d.ldd = 1024; d.k0 = (r / 104) * 64; d.n0 = (r % 104) * 64; d.perm = (d.n0 >= 1024 && d.n0 < 2304) ? 1 : 0; }
    else if ((r -= 1664) < 128) { const int mat = r / 64; r %= 64; const int dh = r / 4; r %= 4;
        d.src = (mat ? P.lru_wx : P.lru_wa) + (size_t)(l * 16 + dh) * 128 * 128; d.lds_ = 128; d.dst = (bf16_t*)(ws + OFF_GW) + (size_t)dh * 256 * 128 + (size_t)mat * 128 * 128; d.ldd = 128; d.k0 = (r / 2) * 64; d.n0 = (r % 2) * 64; }
    else if ((r -= 128) < 64) { const int g = r / 16; r %= 16; d.src = P.pool_w + (size_t)(l * 4 + g) * 256 * 256; d.lds_ = 256; d.dst = (bf16_t*)(ws + OFF_PW) + (size_t)g * 256 * 256; d.ldd = 256; d.k0 = (r / 4) * 64; d.n0 = (r % 4) * 64; }
    else if ((r -= 64) < 768) { const int j = r / 256; r %= 256; d.src = P.w_branch + (size_t)(l * 3 + j) * 1024 * 1024; d.lds_ = 1024; d.dst = (bf16_t*)(ws + OFF_WBR) + (size_t)j * 1024 * 1024; d.ldd = 1024; d.k0 = (r / 16) * 64; d.n0 = (r % 16) * 64; }
    else if ((r -= 768) < 256) { d.src = P.w_out + (size_t)l * 1024 * 1024; d.lds_ = 1024; d.dst = (bf16_t*)(ws + OFF_WOUT); d.ldd = 1024; d.k0 = (r / 16) * 64; d.n0 = (r % 16) * 64; }
    else if ((r -= 256) < 1408) { d.src = P.ffn_up + (size_t)l * 1024 * 5632; d.lds_ = 5632; d.dst = (bf16_t*)(ws + OFF_WUP); d.ldd = 1024; d.k0 = (r / 88) * 64; d.n0 = (r % 88) * 64; }
    else { r -= 1408; d.src = P.ffn_down + (size_t)l * 2816 * 1024; d.lds_ = 1024; d.dst = (bf16_t*)(ws + OFF_WDN); d.ldd = 2816; d.k0 = (r / 16) * 64; d.n0 = (r % 16) * 64; }
    return d;
}
__device__ __noinline__ void convert_weights_(const float* p0, const float* p1, const float* p2, const float* p3, const float* p4, const float* p5, const float* p6, const float* p7, unsigned char* pws,
                                              int l, LAS unsigned char* lds, int t_begin, int t_end, int first, int stride) {
    const WPtrs P{p0, p1, p2, p3, p4, p5, p6, p7, pws};
    LAS bf16_t* sm = (LAS bf16_t*)lds;
    const int tid = otid();
    const int kk0 = tid >> 4, n4 = (tid & 15) * 4, nn = tid >> 3, ck = tid & 7;
    int t = t_begin + first;
    if (t >= t_end) return;
    TileDesc d = weight_tile(P, l, t);
    f32x4 v0 = *(const f32x4*)(d.src + (size_t)(d.k0 + kk0) * d.lds_ + d.n0 + n4), v1 = *(const f32x4*)(d.src + (size_t)(d.k0 + kk0 + 32) * d.lds_ + d.n0 + n4);
    for (;;) {
        __syncthreads();
#pragma unroll
        for (int e = 0; e < 4; ++e) { sm[(n4 + e) * 72 + kk0] = f2bf(v0[e]); sm[(n4 + e) * 72 + kk0 + 32] = f2bf(v1[e]); }
        __syncthreads();
        const TileDesc cur = d; const int tn = t + stride; const bool more = tn < t_end;
        if (more) { d = weight_tile(P, l, tn); v0 = *(const f32x4*)(d.src + (size_t)(d.k0 + kk0) * d.lds_ + d.n0 + n4); v1 = *(const f32x4*)(d.src + (size_t)(d.k0 + kk0 + 32) * d.lds_ + d.n0 + n4); }
        const u32x4 o = *(const LAS u32x4*)(sm + nn * 72 + ck * 8);
        const int nrow = cur.perm ? swap45(cur.n0 + nn) : (cur.n0 + nn);
        *(u32x4*)(cur.dst + (size_t)nrow * cur.ldd + cur.k0 + ck * 8) = o;
        if (!more) break;
        t = tn;
    }
    __syncthreads();
}

__device__ __forceinline__ void convert_weights(const Params& P, int l, LAS unsigned char* lds, int t_begin, int t_end, int first, int stride) {
    convert_weights_(P.w_in, P.w_branch, P.lru_wa, P.lru_wx, P.pool_w, P.w_out, P.ffn_up, P.ffn_down, P.ws, l, lds, t_begin, t_end, first, stride);
}

__device__ void phase0(const Params& P, LAS unsigned char* lds) {
    const int tid = otid(), G = gridDim.x, c = blockIdx.x;
    { const size_t n4 = (size_t)MROWS * 1024 / 4, nc4 = (size_t)MCTX * 1024 / 4;
      for (size_t i = (size_t)c * 512 + tid; i < n4; i += (size_t)G * 512) {
          const float4 v = i < nc4 ? ((const float4*)P.x_prompt)[i] : ((const float4*)P.x_sample)[i - nc4];
          ((float4*)P.out)[i] = v; } }
    { bf16_t* ck = (bf16_t*)(P.ws + OFF_CK); bf16_t* cv = (bf16_t*)(P.ws + OFF_CV);
      for (int i = c * 512 + tid; i < 2 * 2 * 512 * 256; i += G * 512) {
          const int e = i & 255, t = (i >> 8) & 511, b = (i >> 17) & 1, l = i >> 18;
          const size_t si = ((size_t)((b * 2 + l) * 512 + t)) * 256 + e;
          ck[i] = f2bf(P.cache_k[si]); cv[i] = f2bf(P.cache_v[si]); } }
    { float* rc = (float*)(P.ws + OFF_ROPE); float* rs = rc + 2048;
      for (int i = c * 512 + tid; i < 2048; i += G * 512) {
          const int pos = i >> 5, k = i & 31; const float fr = powf(10000.0f, -(float)k / 32.0f); const float ang = (float)pos * fr;
          rc[i] = cosf(ang); rs[i] = sinf(ang); } }
    { LAS float* sv = (LAS float*)lds;
      LAS float* red = sv + 3072;
      __syncthreads();
      for (int i = tid; i < 3072; i += 512) { const int s = i >> 10, k = i & 1023; const float x = s == 0 ? P.c_ctx[k] : P.c[(s - 1) * 1024 + k]; sv[i] = x / (1.0f + expf(-x)); }
      __syncthreads();
      float* mod = (float*)(P.ws + OFF_MOD);
      for (int it = c; it < 384; it += G) {
          const int l = it / 192, cg_ = it % 192, cl = tid & 31, kg = tid >> 5, col = cg_ * 32 + cl;
          const float* w = P.w_ada + (size_t)l * 1024 * 6144 + col;
          float a0 = 0.f, a1 = 0.f, a2 = 0.f;
#pragma unroll 16
          for (int k = kg * 64; k < kg * 64 + 64; ++k) { const float wv = w[(size_t)k * 6144]; a0 += sv[k] * wv; a1 += sv[1024 + k] * wv; a2 += sv[2048 + k] * wv; }
          red[(kg * 3 + 0) * 32 + cl] = a0; red[(kg * 3 + 1) * 32 + cl] = a1; red[(kg * 3 + 2) * 32 + cl] = a2;
          __syncthreads();
          if (tid < 96) { const int s = tid >> 5, cc = tid & 31; float sum = 0.f;
#pragma unroll
              for (int g = 0; g < 16; ++g) sum += red[(g * 3 + s) * 32 + cc];
              mod[(size_t)(l * 3 + s) * 6144 + cg_ * 32 + cc] = sum + P.b_ada[l * 6144 + cg_ * 32 + cc]; }
          __syncthreads();
      } }
}

__device__ void norm_phase(const float* __restrict__ X, const float* __restrict__ gw, const float* __restrict__ mod, int shift_off, int scale_off, bf16_t* __restrict__ H) {
    const int tid = otid(); const int lane = tid & 63, wv = blockIdx.x * 8 + (tid >> 6), nw = gridDim.x * 8;
    for (int row = wv; row < MROWS; row += nw) {
        const float* md = mod + seq_group(row) * 6144;
        f32x4 v[4]; float ss = 0.f;
#pragma unroll
        for (int i = 0; i < 4; ++i) { v[i] = *(const f32x4*)(X + (size_t)row * 1024 + i * 256 + lane * 4); ss += v[i][0] * v[i][0] + v[i][1] * v[i][1] + v[i][2] * v[i][2] + v[i][3] * v[i][3]; }
#pragma unroll
        for (int o = 32; o >= 1; o >>= 1) ss += __shfl_xor(ss, o);
        const float rstd = rsqrtf(ss * (1.0f / 1024.0f) + 1e-6f);
#pragma unroll
        for (int i = 0; i < 4; ++i) { const int col = i * 256 + lane * 4;
            const f32x4 g = *(const f32x4*)(gw + col), sc = *(const f32x4*)(md + scale_off + col), sh = *(const f32x4*)(md + shift_off + col);
            f32x4 h;
#pragma unroll
            for (int e = 0; e < 4; ++e) h[e] = v[i][e] * rstd * g[e] * (1.0f + sc[e]) + sh[e];
            uint2 pk; pk.x = pack2(h[0], h[1]); pk.y = pack2(h[2], h[3]);
            *(uint2*)(H + (size_t)row * 1024 + col) = pk; }
    }
}
__device__ void final_norm_phase(float* X, const float* __restrict__ gw) {
    const int tid = otid(); const int lane = tid & 63, wv = blockIdx.x * 8 + (tid >> 6), nw = gridDim.x * 8;
    for (int row = wv; row < MROWS; row += nw) {
        f32x4 v[4]; float ss = 0.f;
#pragma unroll
        for (int i = 0; i < 4; ++i) { v[i] = *(const f32x4*)(X + (size_t)row * 1024 + i * 256 + lane * 4); ss += v[i][0] * v[i][0] + v[i][1] * v[i][1] + v[i][2] * v[i][2] + v[i][3] * v[i][3]; }
#pragma unroll
        for (int o = 32; o >= 1; o >>= 1) ss += __shfl_xor(ss, o);
        const float rstd = rsqrtf(ss * (1.0f / 1024.0f) + 1e-6f);
#pragma unroll
        for (int i = 0; i < 4; ++i) { const int col = i * 256 + lane * 4; const f32x4 g = *(const f32x4*)(gw + col);
            f32x4 h;
#pragma unroll
            for (int e = 0; e < 4; ++e) h[e] = v[i][e] * rstd * g[e];
            *(f32x4*)(X + (size_t)row * 1024 + col) = h; }
    }
}

__device__ void pool_phase(const bf16_t* __restrict__ XC, bf16_t* __restrict__ PL) {
    const int tid = otid();
    for (int idx = blockIdx.x * 512 + tid; idx < (MROWS / 16) * 128; idx += gridDim.x * 512) {
        const int rs = (idx >> 7) * 16, ch = (idx & 127) * 8, g = ch >> 8, half = 1 << g;
        const int T = rs < MCTX ? 256 : 2048, row0 = rs < MCTX ? (rs & ~255) : MCTX + ((rs - MCTX) & ~2047), tl0 = rs - row0;
        const bf16_t* base = XC + (size_t)row0 * 1024 + ch;
        float s[8];
#pragma unroll
        for (int e = 0; e < 8; ++e) s[e] = 0.f;
        { const int lo = max(tl0 - half, 0), hi = min(tl0 + half, T);
          for (int t = lo; t < hi; ++t) { const bf16x8 x = *(const bf16x8*)(base + (size_t)t * 1024);
#pragma unroll
              for (int e = 0; e < 8; ++e) s[e] += bf2f((unsigned short)x[e]); } }
#pragma unroll 4
        for (int i = 0; i < 16; ++i) {
            const int t = tl0 + i;
            const int lo = max(t - half, 0), hi = min(t + half, T);
            const bf16x8 xs = *(const bf16x8*)(base + (size_t)t * 1024);
            const float inv = 1.0f / (float)(hi - lo);
            u32x4 o; o.x = pack2(s[0] * inv - bf2f((unsigned short)xs[0]), s[1] * inv - bf2f((unsigned short)xs[1])); o.y = pack2(s[2] * inv - bf2f((unsigned short)xs[2]), s[3] * inv - bf2f((unsigned short)xs[3]));
            o.z = pack2(s[4] * inv - bf2f((unsigned short)xs[4]), s[5] * inv - bf2f((unsigned short)xs[5])); o.w = pack2(s[6] * inv - bf2f((unsigned short)xs[6]), s[7] * inv - bf2f((unsigned short)xs[7]));
            *(u32x4*)(PL + (size_t)(row0 + t) * 1024 + ch) = o;
            if (t + half < T) { const bf16x8 x = *(const bf16x8*)(base + (size_t)(t + half) * 1024);
#pragma unroll
                for (int e = 0; e < 8; ++e) s[e] += bf2f((unsigned short)x[e]); }
            if (t - half >= 0) { const bf16x8 x = *(const bf16x8*)(base + (size_t)(t - half) * 1024);
#pragma unroll
                for (int e = 0; e < 8; ++e) s[e] -= bf2f((unsigned short)x[e]); }
        }
    }
}
__device__ __forceinline__ float gelu_tanh(float x) { const float y = 0.7978845608028654f * (x + 0.044715f * x * x * x); const float t = 1.0f - 2.0f * __builtin_amdgcn_rcpf(1.0f + __expf(2.0f * y)); return 0.5f * x * (1.0f + t); }
__device__ void act_phase(const bf16_t* __restrict__ U, bf16_t* __restrict__ ACT, const float* __restrict__ cw, const float* __restrict__ cb) {
    const int tid = otid();
    for (int idx = blockIdx.x * 512 + tid; idx < (MROWS / 16) * 352; idx += gridDim.x * 512) {
        const int rs = (idx / 352) * 16, ch = (idx % 352) * 8;
        const int T = rs < MCTX ? 256 : 2048, row0 = rs < MCTX ? (rs & ~255) : MCTX + ((rs - MCTX) & ~2047), tl0 = rs - row0;
        float w0[8], w1[8], w2[8], bb[8];
#pragma unroll
        for (int e = 0; e < 8; ++e) { w0[e] = cw[ch + e]; w1[e] = cw[2816 + ch + e]; w2[e] = cw[5632 + ch + e]; bb[e] = cb[ch + e]; }
        const bf16_t* up = U + (size_t)rs * 5632 + ch;
        const bf16x8 zero = (bf16x8){0, 0, 0, 0, 0, 0, 0, 0};
        bf16x8 um = tl0 > 0 ? *(const bf16x8*)(up - 5632) : zero;
        bf16x8 u0 = *(const bf16x8*)up;
#pragma unroll 4
        for (int i = 0; i < 16; ++i) {
            const bf16x8 un = (tl0 + i < T - 1) ? *(const bf16x8*)(up + (size_t)(i + 1) * 5632) : zero;
            const bf16x8 vv = *(const bf16x8*)(up + (size_t)i * 5632 + 2816);
            float r[8];
#pragma unroll
            for (int e = 0; e < 8; ++e) { const float gff = w0[e] * bf2f((unsigned short)um[e]) + w1[e] * bf2f((unsigned short)u0[e]) + w2[e] * bf2f((unsigned short)un[e]) + bb[e];
                r[e] = gelu_tanh(gff) * bf2f((unsigned short)vv[e]); }
            u32x4 o; o.x = pack2(r[0], r[1]); o.y = pack2(r[2], r[3]); o.z = pack2(r[4], r[5]); o.w = pack2(r[6], r[7]);
            *(u32x4*)(ACT + (size_t)(rs + i) * 2816 + ch) = o;
            um = u0; u0 = un;
        }
    }
}

__device__ __forceinline__ void rope8(bf16x8& x1, bf16x8& x2, const float* __restrict__ cs, const float* __restrict__ sn) {
#pragma unroll
    for (int e = 0; e < 8; ++e) { const float a = bf2f((unsigned short)x1[e]), b = bf2f((unsigned short)x2[e]); const float c = cs[e], s = sn[e];
        x1[e] = (short)f2bf(a * c - b * s); x2[e] = (short)f2bf(a * s + b * c); }
}
constexpr int VT_OFF = 64 * 272;
constexpr int ABUF = 64 * 272 + 128 * 144;
__device__ void attn_unit(const Params& P, int l, int u, LAS unsigned char* lds) {
    int tid_ = threadIdx.x; asm volatile("" : "+v"(tid_));
    const int tid = tid_, w = tid >> 6, lane = tid & 63, fr = lane & 15, fq = lane >> 4;
    const bf16_t* Q = (const bf16_t*)(P.ws + OFF_XAQ) + (size_t)MROWS * 1024;
    const bf16_t* KB = (const bf16_t*)(P.ws + OFF_KB); const bf16_t* VB = (const bf16_t*)(P.ws + OFF_VB);
    const bf16_t* CK = (const bf16_t*)(P.ws + OFF_CK); const bf16_t* CV = (const bf16_t*)(P.ws + OFF_CV);
    bf16_t* YB = (bf16_t*)(P.ws + OFF_YB);
    bool lat; int head, row0, T, qstart, bidx;
    if (u < 256) { lat = true; bidx = u >> 7; const int rem = u & 127; head = rem >> 4; qstart = (rem & 15) * 128; T = 2048; row0 = MCTX + bidx * 2048; }
    else { const int v = u - 256; lat = false; bidx = 0; const int seq = v >> 4, rem = v & 15; head = rem >> 1; qstart = (rem & 1) * 128; T = 256; row0 = seq * 256; }
    const int kvh = head >> 2;
    const int qpos = qstart + w * 16 + fr;
    bf16x8 qf[4];
    { const bf16_t* qp = Q + (size_t)(row0 + qpos) * 1024 + head * 128 + fq * 8;
#pragma unroll
      for (int kk = 0; kk < 4; ++kk) qf[kk] = *(const bf16x8*)(qp + kk * 32); }
    float m_run = P.attn_sink[l * 8 + head]; float l_run = (fq == 0) ? 1.0f : 0.0f;
    f32x4 o[8];
#pragma unroll
    for (int dt = 0; dt < 8; ++dt) o[dt] = (f32x4){0.f, 0.f, 0.f, 0.f};
    int wlo = 0, nwt = 4;
    if (lat) { wlo = max(0, qstart - 128); const int whi = min(T, qstart + 256); nwt = (whi - wlo) >> 6; }
    const int ntiles = nwt + (lat ? 8 : 0);
    const float scale = 0.08838834764831845f;
    const int lkey = tid >> 3, lp = tid & 7;
    bf16x8 rk[2][2], rv[2][2];
    auto tile_load = [&](int ti, bf16x8 (&k_)[2], bf16x8 (&v_)[2]) {
        const bf16_t* ksrc; const bf16_t* vsrc;
        if (ti < nwt) { const int k0 = wlo + ti * 64; ksrc = KB + (size_t)(row0 + k0) * 256 + kvh * 128; vsrc = VB + (size_t)(row0 + k0) * 256 + kvh * 128; }
        else { const int k0 = (ti - nwt) * 64; const size_t o_ = ((size_t)((l * 2 + bidx) * 512 + k0)) * 256 + kvh * 128; ksrc = CK + o_; vsrc = CV + o_; }
        const bf16_t* kr = ksrc + (size_t)lkey * 256; k_[0] = *(const bf16x8*)(kr + lp * 8); k_[1] = *(const bf16x8*)(kr + (lp + 8) * 8);
        v_[0] = *(const bf16x8*)(vsrc + (size_t)lane * 256 + w * 8); v_[1] = *(const bf16x8*)(vsrc + (size_t)lane * 256 + (w + 8) * 8); };
    auto tile_store = [&](int b, const bf16x8 (&k_)[2], const bf16x8 (&v_)[2]) {
        LAS unsigned char* kb_ = lds + b * ABUF; LAS unsigned char* vb_ = kb_ + VT_OFF;
        *(LAS bf16x8*)(kb_ + lkey * 272 + lp * 16) = k_[0]; *(LAS bf16x8*)(kb_ + lkey * 272 + (lp + 8) * 16) = k_[1];
#pragma unroll
        for (int e = 0; e < 8; ++e) { *(LAS bf16_t*)(vb_ + (w * 8 + e) * 144 + lane * 2) = (bf16_t)v_[0][e]; *(LAS bf16_t*)(vb_ + ((w + 8) * 8 + e) * 144 + lane * 2) = (bf16_t)v_[1][e]; } };
    tile_load(0, rk[0], rv[0]);
    tile_load(1, rk[1], rv[1]);
    __syncthreads();
    tile_store(0, rk[0], rv[0]);
    tile_load(2, rk[0], rv[0]);
#pragma unroll 2
    for (int ti = 0; ti < ntiles; ++ti) {
        const bool win = ti < nwt; const int k0 = win ? wlo + ti * 64 : (ti - nwt) * 64;
        __syncthreads();
        if ((ti & 1) == 0) { if (ti + 1 < ntiles) tile_store(1, rk[1], rv[1]); if (ti + 3 < ntiles) tile_load(ti + 3, rk[1], rv[1]); }
        else { if (ti + 1 < ntiles) tile_store(0, rk[0], rv[0]); if (ti + 3 < ntiles) tile_load(ti + 3, rk[0], rv[0]); }
        LAS unsigned char* kb_ = lds + (ti & 1) * ABUF; LAS unsigned char* vb_ = kb_ + VT_OFF;
        f32x4 s[4];
#pragma unroll
        for (int nt = 0; nt < 4; ++nt) { s[nt] = (f32x4){0.f, 0.f, 0.f, 0.f};
#pragma unroll
            for (int kk = 0; kk < 4; ++kk) { const bf16x8 a = *(const LAS bf16x8*)(kb_ + (nt * 16 + fr) * 272 + kk * 64 + fq * 16); s[nt] = __builtin_amdgcn_mfma_f32_16x16x32_bf16(a, qf[kk], s[nt], 0, 0, 0); } }
        float mt = -3.0e38f;
#pragma unroll
        for (int nt = 0; nt < 4; ++nt)
#pragma unroll
            for (int j = 0; j < 4; ++j) { float v = s[nt][j] * scale;
                if (lat && win) { const int kp = k0 + nt * 16 + fq * 4 + j; const int dd = qpos - kp; if (dd > 128 || dd < -128) v = -1.0e30f; }
                s[nt][j] = v; mt = fmaxf(mt, v); }
        mt = fmaxf(mt, __shfl_xor(mt, 16)); mt = fmaxf(mt, __shfl_xor(mt, 32));
        const float mn = fmaxf(m_run, mt); const float alpha = __expf(m_run - mn); m_run = mn;
        float ps = 0.f;
#pragma unroll
        for (int nt = 0; nt < 4; ++nt)
#pragma unroll
            for (int j = 0; j < 4; ++j) { const float p = __expf(s[nt][j] - mn); ps += p; s[nt][j] = p; }
        l_run = l_run * alpha + ps;
#pragma unroll
        for (int dt = 0; dt < 8; ++dt) o[dt] = o[dt] * alpha;
#pragma unroll
        for (int s2 = 0; s2 < 2; ++s2) {
            u32x4 pu; pu[0] = pack2(s[2 * s2][0], s[2 * s2][1]); pu[1] = pack2(s[2 * s2][2], s[2 * s2][3]); pu[2] = pack2(s[2 * s2 + 1][0], s[2 * s2 + 1][1]); pu[3] = pack2(s[2 * s2 + 1][2], s[2 * s2 + 1][3]);
            const bf16x8 pf = __builtin_bit_cast(bf16x8, pu);
#pragma unroll
            for (int dt = 0; dt < 8; ++dt) {
                const bf16x4 lo = *(const LAS bf16x4*)(vb_ + (dt * 16 + fr) * 144 + (s2 * 32 + fq * 4) * 2);
                const bf16x4 hi = *(const LAS bf16x4*)(vb_ + (dt * 16 + fr) * 144 + (s2 * 32 + 16 + fq * 4) * 2);
                const bf16x8 af = __builtin_shufflevector(lo, hi, 0, 1, 2, 3, 4, 5, 6, 7);
                o[dt] = __builtin_amdgcn_mfma_f32_16x16x32_bf16(af, pf, o[dt], 0, 0, 0);
            }
        }
    }
    float lt = l_run; lt += __shfl_xor(lt, 16); lt += __shfl_xor(lt, 32);
    const float inv = 1.0f / lt;
    bf16_t* yp = YB + (size_t)(row0 + qpos) * 1024 + head * 128 + fq * 4;
#pragma unroll
    for (int dt = 0; dt < 8; ++dt) { uint2 pk; pk.x = pack2(o[dt][0] * inv, o[dt][1] * inv); pk.y = pack2(o[dt][2] * inv, o[dt][3] * inv); *(uint2*)(yp + dt * 16) = pk; }
}

constexpr int YT_OFF = 256 * 272;
template <int MODE, int D, int NSC>
__device__ __forceinline__ void lru_dir(const Params& P, int l, int s, int cchunk, int h, LAS unsigned char* lds, int w, int fr, int fq) {
    const bool lat = s >= 32; const int row0 = lat ? MCTX + (s - 32) * 2048 : s * 256; const int t0 = cchunk * (NSC * 64);
    constexpr int NCH = 2048 / (NSC * 64);
    const bf16_t* GW = (const bf16_t*)(P.ws + OFF_GW);
    bf16_t* YA = (bf16_t*)(P.ws + OFF_YA);
    float* SUMM = (float*)(P.ws + OFF_SUMM);
    const int chl = 16 * w + fr, ch = h * 128 + chl;
    bf16x8 bwa[4], bwx[4];
    { const bf16_t* gp = GW + ((size_t)(D * 8 + h) * 256 + chl) * 128 + fq * 8;
#pragma unroll
      for (int kk = 0; kk < 4; ++kk) { bwa[kk] = *(const bf16x8*)(gp + kk * 32); bwx[kk] = *(const bf16x8*)(gp + 128 * 128 + kk * 32); } }
    const int pidx = (l * 2 + D) * 1024 + ch;
    const float ba = P.lru_ba[pidx], bx = P.lru_bx[pidx];
    const float lam = P.lru_lambda[pidx];
    const float c8 = -8.0f * log1pf(expf(-lam));
    float carry = 0.f;
    if (MODE == 0 && lat) {
        const int b = s - 32;
        carry = P.state_lru[((size_t)(b * 2 + l) * 2 + D) * 1024 + ch];
        if (D == 0) { for (int cc = 0; cc < cchunk; ++cc) { const float* sp = SUMM + ((size_t)((b * 2 + 0) * 16 + cc) * 1024 + ch) * 2; carry = sp[1] + sp[0] * carry; } }
        else { for (int cc = NCH - 1; cc > cchunk; --cc) { const float* sp = SUMM + ((size_t)((b * 2 + 1) * 16 + cc) * 1024 + ch) * 2; carry = sp[1] + sp[0] * carry; } }
    }
    float ptot = 1.0f;
#pragma unroll 1
    for (int sci = 0; sci < NSC; ++sci) {
        const int sc = D == 0 ? sci : NSC - 1 - sci;
        f32x4 r[4], g[4];
#pragma unroll
        for (int m = 0; m < 4; ++m) { r[m] = (f32x4){0.f, 0.f, 0.f, 0.f}; g[m] = (f32x4){0.f, 0.f, 0.f, 0.f};
#pragma unroll
            for (int kk = 0; kk < 4; ++kk) { const bf16x8 a = *(const LAS bf16x8*)(lds + (sc * 64 + m * 16 + fr) * 272 + kk * 64 + fq * 16);
                r[m] = __builtin_amdgcn_mfma_f32_16x16x32_bf16(a, bwa[kk], r[m], 0, 0, 0); g[m] = __builtin_amdgcn_mfma_f32_16x16x32_bf16(a, bwx[kk], g[m], 0, 0, 0); } }
#pragma unroll
        for (int mi = 0; mi < 4; ++mi) {
            const int m = D == 0 ? mi : 3 - mi;
            float av[4], bv[4];
#pragma unroll
            for (int j = 0; j < 4; ++j) {
                const float ea = 1.0f + __expf(-(r[m][j] + ba)), eb = 1.0f + __expf(-(g[m][j] + bx));
                const float inv = __builtin_amdgcn_rcpf(ea * eb);
                const float rr = inv * eb, ii = inv * ea;
                const float la = c8 * rr; const float a = __expf(la); const float z = 2.0f * la;
                const float em = (z > -0.05f) ? -z * (1.0f + z * (0.5f + z * (0.16666667f + z * 0.041666667f))) : 1.0f - a * a;
                const float x = bf2f(*(const LAS bf16_t*)(lds + (sc * 64 + m * 16 + fq * 4 + j) * 272 + chl * 2));
                av[j] = a; bv[j] = __builtin_amdgcn_sqrtf(em) * ii * x;
            }
            float p4, h4;
            p4 = av[0] * av[1] * av[2] * av[3];
            if (D == 0) h4 = ((bv[0] * av[1] + bv[1]) * av[2] + bv[2]) * av[3] + bv[3];
            else h4 = ((bv[3] * av[2] + bv[2]) * av[1] + bv[1]) * av[0] + bv[0];
            float pq[4], hq[4];
#pragma unroll
            for (int f = 0; f < 4; ++f) { pq[f] = __shfl(p4, fr + 16 * f); hq[f] = __shfl(h4, fr + 16 * f); }
            float cin = carry, mycin = 0.f;
#pragma unroll
            for (int fi = 0; fi < 4; ++fi) { const int f = D == 0 ? fi : 3 - fi; if (f == fq) mycin = cin; cin = hq[f] + pq[f] * cin; }
            carry = cin;
            if (MODE == 1) ptot *= pq[0] * pq[1] * pq[2] * pq[3];
            if (MODE == 0) {
                float hh = mycin; float y[4];
#pragma unroll
                for (int ji = 0; ji < 4; ++ji) { const int j = D == 0 ? ji : 3 - ji; hh = av[j] * hh + bv[j]; y[j] = hh; }
#pragma unroll
                for (int j = 0; j < 4; ++j) {
                    LAS bf16_t* yp = (LAS bf16_t*)(lds + YT_OFF + (sc * 64 + m * 16 + fq * 4 + j) * 272 + chl * 2);
                    if (D == 0) *yp = f2bf(y[j]);
                    else *yp = f2bf(bf2f(*yp) + y[j]);
                }
            }
        }
    }
    if (MODE == 0 && !lat && fq == 0) P.out[OUT_H + ((size_t)(s * 2 + l) * 2 + D) * 1024 + ch] = carry;
    if (MODE == 1 && fq == 0) { float* sp = SUMM + ((size_t)(((s - 32) * 2 + D) * 16 + cchunk) * 1024 + ch) * 2; sp[0] = ptot; sp[1] = carry; }
}
template <int MODE, int NSC>
__device__ void lru_unit(const Params& P, int l, int s, int cchunk, int h, LAS unsigned char* lds) {
    int tid_ = threadIdx.x; asm volatile("" : "+v"(tid_));
    const int tid = tid_, w = tid >> 6, lane = tid & 63, fr = lane & 15, fq = lane >> 4;
    const bool lat = s >= 32; const int T = lat ? 2048 : 256; const int row0 = lat ? MCTX + (s - 32) * 2048 : s * 256; const int t0 = cchunk * (NSC * 64);
    const bf16_t* XA = (const bf16_t*)(P.ws + OFF_XAQ);
    constexpr int RUN = NSC * 2;
    {
        const int ck = tid & 15, ch = h * 128 + ck * 8, tr = (tid >> 4) * RUN;
        const float* cw = P.lru_conv + (size_t)l * 4096 + ch; const float* cb = P.lru_conv_b + l * 1024 + ch;
        bf16x8 xr[RUN + 3];
#pragma unroll
        for (int i = 0; i < RUN + 3; ++i) { const int tt = t0 + tr + i - 2; xr[i] = (bf16x8){0, 0, 0, 0, 0, 0, 0, 0};
            if (tt >= 0 && tt < T) xr[i] = *(const bf16x8*)(XA + (size_t)(row0 + tt) * 1024 + ch); }
        float wk[4][8], bk[8];
#pragma unroll
        for (int e = 0; e < 8; ++e) { bk[e] = cb[e];
#pragma unroll
            for (int k = 0; k < 4; ++k) wk[k][e] = cw[k * 1024 + e]; }
        __syncthreads();
#pragma unroll
        for (int i = 0; i < RUN; ++i) {
            float a8[8];
#pragma unroll
            for (int e = 0; e < 8; ++e) { a8[e] = bk[e];
#pragma unroll
                for (int k = 0; k < 4; ++k) a8[e] += wk[k][e] * bf2f((unsigned short)xr[i + k][e]); }
            u32x4 o; o.x = pack2(a8[0], a8[1]); o.y = pack2(a8[2], a8[3]); o.z = pack2(a8[4], a8[5]); o.w = pack2(a8[6], a8[7]);
            *(LAS u32x4*)(lds + (tr + i) * 272 + ck * 16) = o;
        }
    }
    __syncthreads();
    lru_dir<MODE, 0, NSC>(P, l, s, cchunk, h, lds, w, fr, fq);
    lru_dir<MODE, 1, NSC>(P, l, s, cchunk, h, lds, w, fr, fq);
    if (MODE == 0) {
        bf16_t* YA = (bf16_t*)(P.ws + OFF_YA);
        __syncthreads();
#pragma unroll
        for (int it = 0; it < 2 * NSC; ++it) { const int t = (tid >> 4) + it * 32, ck = tid & 15;
            const u32x4 v = *(const LAS u32x4*)(lds + YT_OFF + t * 272 + ck * 16);
            *(u32x4*)(YA + (size_t)(row0 + t0 + t) * 1024 + h * 128 + ck * 8) = v; }
    }
}

#define XB_TMO      128
#define XB_XCNT(j)  (256  + 64 * (j))
#define XB_XSUB(j)  (1280 + 64 * (j))
#define XB_XGEN(j)  (2304 + 64 * (j))
#define XB_TOP      3328
#define XB_TOPGEN   3392
#define XCD_BAR_WORDS 3456
#define XB_SPIN_CAP (1u << 18)
__device__ __forceinline__ unsigned xb_ld(unsigned* p)              { return __hip_atomic_load(p, __ATOMIC_RELAXED, __HIP_MEMORY_SCOPE_AGENT); }
__device__ __forceinline__ unsigned xb_add(unsigned* p, unsigned v) { return __hip_atomic_fetch_add(p, v, __ATOMIC_RELAXED, __HIP_MEMORY_SCOPE_AGENT); }
__device__ __forceinline__ unsigned xb_xcc_id() { return (unsigned)__builtin_amdgcn_s_getreg((3 << 11) | 20) & 0xFu; }
#define XB_SPIN(cond, bar) do { unsigned _sp = 0; while (cond) { __builtin_amdgcn_s_sleep(1); \
    if ((++_sp & 255u) == 0u) { if (xb_ld(&(bar)[XB_TMO])) break; if (_sp > XB_SPIN_CAP) { atomicAdd(&(bar)[XB_TMO], 1u); break; } } } } while (0)
struct XcdBarrier { unsigned* bar; unsigned x; volatile LAS unsigned* st; };
__device__ __forceinline__ XcdBarrier xcd_barrier_post(unsigned* bar, volatile LAS unsigned* st) {
    XcdBarrier b; b.bar = bar; b.x = xb_xcc_id(); b.st = st;
    if (threadIdx.x == 0) (void)xb_add(&bar[XB_XCNT(b.x)], 1u);
    return b;
}
__device__ __forceinline__ void xcd_barrier_complete(unsigned* bar, unsigned x, unsigned& nloc, unsigned& nx) {
    const unsigned G = gridDim.x * gridDim.y * gridDim.z;
    unsigned sum, cnt, mine, sp = 0u;
    for (;;) {
        sum = 0u; cnt = 0u; mine = 0u;
#pragma unroll
        for (unsigned j = 0; j < 16; ++j) { const unsigned c = xb_ld(&bar[XB_XCNT(j)]); sum += c; cnt += (c > 0u) ? 1u : 0u; mine = (j == x) ? c : mine; }
        if (sum == G) break;
        __builtin_amdgcn_s_sleep(1);
        if ((++sp & 255u) == 0u) { if (xb_ld(&bar[XB_TMO])) break; if (sp > XB_SPIN_CAP) { atomicAdd(&bar[XB_TMO], 1u); break; } }
    }
    nloc = mine > 0u ? mine : 1u; nx = cnt > 0u ? cnt : 1u;
}
__device__ __noinline__ void xcd_barrier_(unsigned* bbar, unsigned bx, volatile LAS unsigned* bst) {
    XcdBarrier b; b.bar = bbar; b.x = bx; b.st = bst;
    asm volatile("s_waitcnt vmcnt(0)" ::: "memory");
    __syncthreads();
    if (threadIdx.x == 0) {
        unsigned* bar = b.bar;
        __builtin_amdgcn_s_waitcnt(0);
        unsigned nloc = b.st[0], nx = b.st[1];
        if (nloc == 0u) { xcd_barrier_complete(bar, b.x, nloc, nx); b.st[0] = nloc; b.st[1] = nx; }
        const unsigned old = xb_add(&bar[XB_XSUB(b.x)], 1u);
        const unsigned gen = old / nloc;
        if (old + 1u == (gen + 1u) * nloc) {
            __builtin_amdgcn_fence(__ATOMIC_RELEASE, "agent");
            asm volatile("s_waitcnt vmcnt(0)" ::: "memory");
            const unsigned og = xb_add(&bar[XB_TOP], 1u);
            const unsigned tg = og / nx;
            if (og + 1u == (tg + 1u) * nx) xb_add(&bar[XB_TOPGEN], 1u);
            else XB_SPIN(xb_ld(&bar[XB_TOPGEN]) == tg, bar);
            __builtin_amdgcn_fence(__ATOMIC_ACQUIRE, "agent");
            xb_add(&bar[XB_XGEN(b.x)], 1u);
            asm volatile("s_waitcnt vmcnt(0)" ::: "memory");
        } else {
            XB_SPIN(xb_ld(&bar[XB_XGEN(b.x)]) == gen, bar);
            __builtin_amdgcn_fence(__ATOMIC_ACQUIRE, "agent");
            asm volatile("s_waitcnt vmcnt(0)" ::: "memory");
        }
    }
    __syncthreads();
}

#ifndef REPMASK
#define REPMASK 0
#endif
#define REPLOOP(i) _Pragma("unroll 1") for (int rep_ = 0; rep_ < 1 + ((REPMASK >> (i)) & 1); ++rep_)
__global__ __launch_bounds__(512, 2) void mega(Params P) {
    extern __shared__ __attribute__((aligned(16))) unsigned char shm[];
    LAS unsigned char* lds = (LAS unsigned char*)shm;
    cg::grid_group grid = cg::this_grid();
    if (threadIdx.x == 0) *(LAS u32x4*)(lds + 147456) = (u32x4){0u, 0u, 0u, 0u};
    __syncthreads();
    const XcdBarrier xb = xcd_barrier_post((unsigned*)(P.ws + OFF_BAR), (volatile LAS unsigned*)(lds + 147456));
    const int G = gridDim.x, c = blockIdx.x;
    unsigned char* ws = P.ws;
    float* X = P.out;
    bf16_t* H = (bf16_t*)(ws + OFF_H);
    const float* MOD = (const float*)(ws + OFF_MOD);

    phase0(P, lds);
    grid.sync();
    for (int l = 0; l < 2; ++l) {
        const float* mod = MOD + (size_t)l * 3 * 6144;
        const bool hide = (G == 256);
        { const int te = hide ? (l == 0 ? 1856 : 0) : 4992; if (te > 0) convert_weights(P, l, lds, 0, te, c, G); }
        REPLOOP(1) norm_phase(X, P.norm1 + l * 1024, mod, 0, 1024, H);
        xcd_barrier_(xb.bar, xb.x, xb.st);
        REPLOOP(2) { Sched S{(const char*)H, (const char*)(ws + OFF_WIN), 1024, 1024, 0, 48, 14, G, c, 256};
          EpiIn E{(bf16_t*)(ws + OFF_XAQ), (bf16_t*)(ws + OFF_XC), (bf16_t*)(ws + OFF_KB), (bf16_t*)(ws + OFF_VB), P.out + OUT_K, P.out + OUT_V, (const float*)(ws + OFF_ROPE), l};
          gemm_phase(lds, S, 1024, E); }
        if (hide && l == 0 && c >= 160) convert_weights(P, l, lds, 1856, 2624, c - 160, G - 160);
        xcd_barrier_(xb.bar, xb.x, xb.st);
        REPLOOP(3) pool_phase((const bf16_t*)(ws + OFF_XC), (bf16_t*)(ws + OFF_PL));
        for (int it = c; it < 1280; it += G) {
            if (it < 256) { REPLOOP(4) attn_unit(P, l, it, lds); }
            else if (it < 512) { const int v = it - 256; REPLOOP(5) lru_unit<0, 4>(P, l, v >> 3, 0, v & 7, lds); }
            else if (it < 768) { const int q = it - 512; REPLOOP(5) lru_unit<1, 2>(P, l, 32 + (q >> 7), (q >> 3) & 15, q & 7, lds); }
            else { REPLOOP(7) attn_unit(P, l, it - 768 + 256, lds); }
        }
        xcd_barrier_(xb.bar, xb.x, xb.st);
        { Sched S{(const char*)(ws + OFF_PL), (const char*)(ws + OFF_PW), 1024, 256, 256, 48, 4, G, c, 256};
          EpiPool E{(bf16_t*)(ws + OFF_XC), P.pool_scale + l * 1024};
          gemm_phase(lds, S, 256, E); }
#ifndef NO_LRU
        for (int it = G - 1 - c; it < 256; it += G) lru_unit<0, 2>(P, l, 32 + (it >> 7), (it >> 3) & 15, it & 7, lds);
#endif
        xcd_barrier_(xb.bar, xb.x, xb.st);
        REPLOOP(6) { MergeSched S{(const char*)ws, 1024, 1024, c};
          EpiMerge E{(bf16_t*)(ws + OFF_GT), P.b_gate + l * 3072, (float*)(ws + OFF_XAQ), (bf16_t*)(ws + OFF_PL)};
          gemm_phase(lds, S, 1024, E); }
        if (hide && c >= 192) convert_weights(P, l, lds, 2624, 4992, c - 192, G - 192);
        xcd_barrier_(xb.bar, xb.x, xb.st);
        { Sched S{(const char*)(ws + OFF_PL), (const char*)(ws + OFF_WOUT), 1024, 1024, 0, 64, 4, G, c, 192};
          EpiRes E{X, mod, 2048};
          gemm_phase<EpiRes, Sched, true>(lds, S, 1024, E); }
        xcd_barrier_(xb.bar, xb.x, xb.st);
        norm_phase(X, P.norm2 + l * 1024, mod, 3072, 4096, H);
        xcd_barrier_(xb.bar, xb.x, xb.st);
        REPLOOP(9) { Sched S{(const char*)H, (const char*)(ws + OFF_WUP), 1024, 1024, 0, 48, 22, G, c, 256};
          EpiBf E{(bf16_t*)(ws + OFF_U), 5632};
          gemm_phase(lds, S, 1024, E); }
        if (hide && l == 0 && c >= 32) convert_weights(P, l + 1, lds, 0, 2624, c - 32, G - 32);
        xcd_barrier_(xb.bar, xb.x, xb.st);
        REPLOOP(10) act_phase((const bf16_t*)(ws + OFF_U), (bf16_t*)(ws + OFF_ACT), P.ffn_conv + (size_t)l * 3 * 2816, P.ffn_conv_b + l * 2816);
        xcd_barrier_(xb.bar, xb.x, xb.st);
        { Sched S{(const char*)(ws + OFF_ACT), (const char*)(ws + OFF_WDN), 2816, 2816, 0, 64, 4, G, c, 192};
          EpiRes E{X, mod, 5120};
          gemm_phase<EpiRes, Sched, true>(lds, S, 2816, E); }
        xcd_barrier_(xb.bar, xb.x, xb.st);
    }
    final_norm_phase(X, P.final_norm);
}

extern "C" void kernel_launch(void* const* d_in, const int* in_sizes, int n_in, void* d_out, int out_size, void* d_ws, size_t ws_size, hipStream_t stream) {
    constexpr size_t kDynLds = 147456 + 16;
    static int grid_blocks = 0;
    if (!grid_blocks) {
        int dev = 0, cus = 0, per_cu = 0;
        hipGetDevice(&dev);
        hipDeviceGetAttribute(&cus, hipDeviceAttributeMultiprocessorCount, dev);
        hipFuncSetAttribute((const void*)mega, hipFuncAttributeMaxDynamicSharedMemorySize, (int)kDynLds);
        hipOccupancyMaxActiveBlocksPerMultiprocessor(&per_cu, mega, 512, kDynLds);
        if (per_cu < 1) per_cu = 1;
        if (per_cu > 1) per_cu = 1;
        grid_blocks = cus * per_cu;
    }
    Params p{};
    const float** pp = (const float**)&p;
    for (int i = 0; i < 30; ++i) pp[i] = (const float*)d_in[i];
    p.out = (float*)d_out; p.ws = (unsigned char*)d_ws;
    if (ws_size < OFF_END) { fprintf(stderr, "workspace too small: %zu < %zu\n", ws_size, (size_t)OFF_END); }
    hipMemsetAsync((unsigned char*)d_ws + OFF_BAR, 0, 16384, stream);
    void* args[] = {&p};
    hipError_t e = hipLaunchCooperativeKernel((void*)mega, dim3(grid_blocks), dim3(512), args, kDynLds, stream);
    if (e != hipSuccess) fprintf(stderr, "cooperative launch failed: %s (grid %d)\n", hipGetErrorString(e), grid_blocks);
}
```

```cpp
#include <hip/hip_runtime.h>
#include <hip/hip_cooperative_groups.h>
#include <cstdio>
namespace cg = cooperative_groups;

#define LAS __attribute__((address_space(3)))
typedef unsigned short bf16_t;
typedef short bf16x8 __attribute__((ext_vector_type(8)));
typedef float f32x4 __attribute__((ext_vector_type(4)));
typedef unsigned u32x4 __attribute__((ext_vector_type(4)));
typedef unsigned u32x2 __attribute__((ext_vector_type(2)));
typedef short bf16x4 __attribute__((ext_vector_type(4)));

constexpr int MROWS = 12288, MCTX = 8192;
constexpr size_t S24 = (size_t)MROWS * 1024 * 2;
constexpr size_t OFF_WIN = 0;
constexpr size_t OFF_WBR = OFF_WIN + (size_t)6656 * 1024 * 2;
constexpr size_t OFF_WOUT = OFF_WBR + (size_t)3 * 1024 * 1024 * 2;
constexpr size_t OFF_WUP = OFF_WOUT + (size_t)1024 * 1024 * 2;
constexpr size_t OFF_WDN = OFF_WUP + (size_t)5632 * 1024 * 2;
constexpr size_t OFF_GW = OFF_WDN + (size_t)1024 * 2816 * 2;
constexpr size_t OFF_PW = OFF_GW + (size_t)2 * 8 * 256 * 128 * 2;
constexpr size_t OFF_MOD = OFF_PW + (size_t)4 * 256 * 256 * 2;
constexpr size_t OFF_CK = OFF_MOD + (size_t)2 * 3 * 6144 * 4;
constexpr size_t OFF_CV = OFF_CK + (size_t)2 * 2 * 512 * 256 * 2;
constexpr size_t OFF_ROPE = OFF_CV + (size_t)2 * 2 * 512 * 256 * 2;
constexpr size_t OFF_SUMM = OFF_ROPE + (size_t)2 * 64 * 32 * 4;
constexpr size_t OFF_BAR = OFF_SUMM + (size_t)2 * 2 * 16 * 1024 * 2 * 4;
constexpr size_t OFF_ACT0 = OFF_BAR + 16384;
constexpr size_t OFF_XAQ = OFF_ACT0;
constexpr size_t OFF_XC = OFF_XAQ + 2 * S24;
constexpr size_t OFF_KB = OFF_XC + S24;
constexpr size_t OFF_VB = OFF_KB + (size_t)MROWS * 256 * 2;
constexpr size_t OFF_GT = OFF_VB + (size_t)MROWS * 256 * 2;
constexpr size_t OFF_YB = OFF_GT + S24;
constexpr size_t OFF_PL = OFF_YB + S24;
constexpr size_t OFF_YA = OFF_PL + S24;
constexpr size_t OFF_H = OFF_YA + S24;
constexpr size_t OFF_END = OFF_H + S24;
constexpr size_t OFF_U = OFF_XAQ;
constexpr size_t OFF_ACT = OFF_PL;
constexpr size_t OUT_K = (size_t)MROWS * 1024;
constexpr size_t OUT_V = OUT_K + (size_t)32 * 2 * 256 * 256;
constexpr size_t OUT_H = OUT_V + (size_t)32 * 2 * 256 * 256;

struct Params {
    const float *x_prompt, *x_sample, *cache_k, *cache_v, *state_lru, *c, *c_ctx, *w_ada, *b_ada, *norm1, *norm2,
        *w_in, *b_gate, *lru_conv, *lru_conv_b, *lru_wa, *lru_ba, *lru_wx, *lru_bx, *lru_lambda, *attn_sink,
        *pool_w, *pool_scale, *w_branch, *w_out, *ffn_up, *ffn_conv, *ffn_conv_b, *ffn_down, *final_norm;
    float* out; unsigned char* ws;
};

typedef float f32x2_ __attribute__((ext_vector_type(2)));
typedef __bf16 bf16x2_ __attribute__((ext_vector_type(2)));
__device__ __forceinline__ unsigned pack2(float a, float b) { const f32x2_ v = {a, b}; const bf16x2_ r = __builtin_convertvector(v, bf16x2_); return __builtin_bit_cast(unsigned, r); }
__device__ __forceinline__ unsigned short f2bf(float f) { return (unsigned short)(pack2(f, f) & 0xffffu); }
__device__ __forceinline__ float bf2f(unsigned short b) { return __uint_as_float(((unsigned)b) << 16); }
__device__ __forceinline__ int otid() { int t = threadIdx.x; asm volatile("" : "+v"(t)); return t; }
__device__ __forceinline__ float sigmoidf_(float x) { return __builtin_amdgcn_rcpf(1.0f + __expf(-x)); }

constexpr int HTB = 128 * 64 * 2;
__device__ __forceinline__ int lds_byte(int r, int c) { const int st = (r >> 4) * 2 + (c >> 5), rr = r & 15, cc = c & 31, ob = rr * 64 + cc * 2; return st * 1024 + (ob ^ (((ob >> 9) & 1) << 5)); }
__device__ __forceinline__ void stage_rc(int b, int& R, int& C) { const int st = b / 1024, sb = b % 1024, swz = sb ^ (((sb >> 9) & 1) << 5); R = (st >> 1) * 16 + swz / 64; C = (st & 1) * 32 + (swz % 64) / 2; }

struct Unit { const char* a; const char* b; int pm, pn, z, row0, m192; };
struct Sched {
    const char* A; const char* B; int lda, ldb, acol, nM, nN, G, c, tm;
    __device__ __forceinline__ bool next(int i, Unit& u) const {
        const long L = (long)i * G + c; const int nwg = nM * nN; if (L >= nwg) return false;
        int wgid = (int)L; { const int q = nwg / 8, r = nwg % 8, xcd = wgid % 8, off = wgid / 8; wgid = (xcd < r ? xcd * (q + 1) : r * (q + 1) + (xcd - r) * q) + off; }
        const int nig = 8 * nN, gid = wgid / nig, fm = gid * 8, gsz = (nM - fm) < 8 ? (nM - fm) : 8;
        u.pm = fm + ((wgid % nig) % gsz); u.pn = (wgid % nig) / gsz;
        u.a = A + ((size_t)u.pm * tm * lda + (size_t)u.pn * acol) * 2; u.b = B + (size_t)u.pn * 256 * ldb * 2; u.z = 0; u.row0 = u.pm * tm; u.m192 = (tm == 192); return true;
    }
};
struct MergeSched {
    const char* ws; int lda, ldb, c;
    __device__ __forceinline__ bool next(int i, Unit& u) const {
        if (c >= 192 || i >= 6) return false;
        const int nN = 4;
        int wgid = c; { const int q = 24, xcd = wgid % 8, off = wgid / 8; wgid = xcd * q + off; }
        const int nig = 8 * nN, gid = wgid / nig, fm = gid * 8;
        u.pm = fm + ((wgid % nig) % 8); u.pn = (wgid % nig) / 8; u.z = i; u.row0 = u.pm * 256; u.m192 = 0;
        const int j = i >> 1;
        const size_t aoff = (size_t)u.row0 * 1024 * 2;
        size_t ao = OFF_H, bo = OFF_WIN + (size_t)3584 * 1024 * 2;
        if (i & 1) { bo = OFF_WBR; ao = OFF_YA; if (j == 1) ao = OFF_YB; if (j == 2) ao = OFF_XC; }
        u.a = ws + ao + aoff; u.b = ws + bo + ((size_t)j * 1024 + (size_t)u.pn * 256) * 1024 * 2;
        return true;
    }
};

template <class Epi, class SchedT, bool M192 = false>
__device__ __forceinline__ void gemm_phase(LAS unsigned char* lds, const SchedT& S, const int K_, const Epi& E) {
    int K = K_; asm volatile("" : "+s"(K));
    int tid_ = threadIdx.x; asm volatile("" : "+v"(tid_));
    const int tid = tid_, wid = __builtin_amdgcn_readfirstlane(tid >> 6), lane = tid & 63, wr = wid >> 2, wc = wid & 3, fr = lane & 15, fq = lane >> 4;
    const int nt = K / 64;
    unsigned voffA[2], voffB[2];
#pragma unroll
    for (int i = 0; i < 2; ++i) { int R, C; stage_rc(tid * 16 + i * 8192, R, C); voffA[i] = (unsigned)(R * S.lda + C) * 2u; voffB[i] = (unsigned)(R * S.ldb + C) * 2u; }
    const size_t kstep = 128;
    const size_t hstepA = (size_t)128 * S.lda * 2, hstepB = (size_t)128 * S.ldb * 2;
    const unsigned ldsw = (unsigned)wid * 1024u;
    const int aoff = lds_byte(wr * 64 + fr, fq * 8), boff = lds_byte(wc * 32 + fr, fq * 8);
#define G_SA(b, h) (((b) * 2 + (h)) * HTB)
#define G_SB(b, h) ((4 + (b) * 2 + (h)) * HTB)
#define G_STAGE(bufoff, gbase, voff) do { _Pragma("unroll") for (int _i = 0; _i < 2; ++_i) \
        __builtin_amdgcn_global_load_lds((const unsigned*)((const char*)(gbase) + (voff)[_i]), (LAS unsigned*)(lds + (bufoff) + ldsw + _i * 8192), 16, 0, 0); } while (0)
#define G_LDA(dst, b, h) do { _Pragma("unroll") for (int m = 0; m < 4; ++m) _Pragma("unroll") for (int k = 0; k < 2; ++k) dst[m][k] = *(const LAS bf16x8*)(lds + G_SA(b, h) + aoff + m * 2048 + k * 1024); } while (0)
#define G_LDB(dst, b, h) do { _Pragma("unroll") for (int n = 0; n < 2; ++n) _Pragma("unroll") for (int k = 0; k < 2; ++k) dst[n][k] = *(const LAS bf16x8*)(lds + G_SB(b, h) + boff + n * 2048 + k * 1024); } while (0)
#define G_MMA(ai, bj, At, Bt) do { if (M192 && (ai) == 1 && wr == 1) break; __builtin_amdgcn_s_setprio(1); _Pragma("unroll") for (int m = 0; m < 4; ++m) _Pragma("unroll") for (int n = 0; n < 2; ++n) _Pragma("unroll") for (int k = 0; k < 2; ++k) \
        acc[ai][bj][m][n] = __builtin_amdgcn_mfma_f32_16x16x32_bf16(Bt[n][k], At[m][k], acc[ai][bj][m][n], 0, 0, 0); __builtin_amdgcn_s_setprio(0); } while (0)
#define G_WAIT_V(n) asm volatile("s_waitcnt vmcnt(" #n ")" ::: "memory")
#define G_WAIT_L(n) asm volatile("s_waitcnt lgkmcnt(" #n ")" ::: "memory")
#define G_BAR __builtin_amdgcn_s_barrier()
#define G_SCHED __builtin_amdgcn_sched_barrier(0)
    Unit cur, nxt; int ui = 0;
    if (!S.next(0, cur)) return;
    f32x4 acc[2][2][4][2];
#pragma unroll
    for (int a = 0; a < 2; ++a)
#pragma unroll
        for (int b = 0; b < 2; ++b)
#pragma unroll
            for (int m = 0; m < 4; ++m)
#pragma unroll
                for (int n = 0; n < 2; ++n) acc[a][b][m][n] = (f32x4){0.f, 0.f, 0.f, 0.f};
    bf16x8 At[4][2], B0[2][2], B1[2][2];
    const char* cA = cur.a; const char* cB = cur.b;
    G_STAGE(G_SB(0, 0), cB, voffB); G_STAGE(G_SA(0, 0), cA, voffA); G_STAGE(G_SB(0, 1), cB + hstepB, voffB); G_STAGE(G_SA(0, 1), cA + hstepA, voffA);
    if (wr == 1) G_BAR;
    G_WAIT_V(4); G_BAR;
    G_STAGE(G_SB(1, 0), cB + kstep, voffB); G_STAGE(G_SA(1, 0), cA + kstep, voffA); G_STAGE(G_SB(1, 1), cB + hstepB + kstep, voffB);
    G_WAIT_V(6); G_BAR;
    for (;;) {
        const bool has_next = S.next(ui + 1, nxt);
        const char* nA = has_next ? nxt.a : cA; const char* nB = has_next ? nxt.b : cB;
        for (int t = 0; t < nt; t += 2) {
            const bool last = (t == nt - 2);
            const char* a1 = cA + (size_t)(t + 1) * kstep;
            const char* a2 = last ? nA : cA + (size_t)(t + 2) * kstep; const char* b2 = last ? nB : cB + (size_t)(t + 2) * kstep;
            const char* a3 = a2 + kstep; const char* b3 = b2 + kstep;
            G_LDB(B0, 0, 0); G_SCHED; G_LDA(At, 0, 0); G_STAGE(G_SA(1, 1), a1 + hstepA, voffA);
            G_WAIT_L(8); G_BAR; G_WAIT_L(0); G_MMA(0, 0, At, B0); G_BAR; G_SCHED;
            G_LDB(B1, 0, 1); G_STAGE(G_SB(0, 0), b2, voffB);
            G_BAR; G_WAIT_L(0); G_MMA(0, 1, At, B1); G_BAR;
            G_LDA(At, 0, 1); G_STAGE(G_SA(0, 0), a2, voffA);
            G_BAR; G_WAIT_L(0); G_MMA(1, 0, At, B0); G_BAR; G_SCHED;
            G_STAGE(G_SB(0, 1), b2 + hstepB, voffB);
            G_WAIT_V(6); G_BAR; G_MMA(1, 1, At, B1); G_BAR;
            G_LDB(B0, 1, 0); G_SCHED; G_LDA(At, 1, 0); G_STAGE(G_SA(0, 1), a2 + hstepA, voffA);
            G_WAIT_L(8); G_BAR; G_WAIT_L(0); G_MMA(0, 0, At, B0); G_BAR; G_SCHED;
            G_LDB(B1, 1, 1); G_STAGE(G_SB(1, 0), b3, voffB);
            G_BAR; G_WAIT_L(0); G_MMA(0, 1, At, B1); G_BAR;
            G_LDA(At, 1, 1); G_STAGE(G_SA(1, 0), a3, voffA);
            G_BAR; G_WAIT_L(0); G_MMA(1, 0, At, B0); G_BAR; G_SCHED;
            G_STAGE(G_SB(1, 1), b3 + hstepB, voffB);
            G_WAIT_V(6); G_BAR; G_MMA(1, 1, At, B1); G_BAR;
        }
        E(acc, cur, wr, wc, fr, fq);
        if (!has_next) break;
#pragma unroll
        for (int a = 0; a < 2; ++a)
#pragma unroll
            for (int b = 0; b < 2; ++b)
#pragma unroll
                for (int m = 0; m < 4; ++m)
#pragma unroll
                    for (int n = 0; n < 2; ++n) acc[a][b][m][n] = (f32x4){0.f, 0.f, 0.f, 0.f};
        cur = nxt; cA = nA; cB = nB; ++ui;
    }
    G_WAIT_V(0);
    if (wr == 0) G_BAR;
    G_BAR;
#undef G_SA
#undef G_SB
#undef G_STAGE
#undef G_LDA
#undef G_LDB
#undef G_MMA
#undef G_WAIT_V
#undef G_WAIT_L
#undef G_BAR
#undef G_SCHED
}

#define EPI_LOOP_BEGIN \
    _Pragma("unroll") for (int ai = 0; ai < 2; ++ai) _Pragma("unroll") for (int m = 0; m < 4; ++m) { const int row = u.pm * 256 + wr * 64 + fr + ai * 128 + m * 16; \
    _Pragma("unroll") for (int bj = 0; bj < 2; ++bj) _Pragma("unroll") for (int n = 0; n < 2; ++n) { const int cl = wc * 32 + 4 * fq + bj * 128 + n * 16; const f32x4 v = acc[ai][bj][m][n];
#define EPI_LOOP_END } }

__device__ __forceinline__ int seq_group(int row) { return row < MCTX ? 0 : 1 + ((row - MCTX) >> 11); }

struct EpiIn {
    bf16_t* xaq; bf16_t* xc; bf16_t* kb; bf16_t* vb; float* outk; float* outv; const float* rc; int l;
    __device__ __forceinline__ void operator()(const f32x4 (&acc)[2][2][4][2], const Unit& u, int wr, int wc, int fr, int fq) const {
        const int pn = u.pn; const bool qk = pn >= 4 && pn <= 8;
        bf16_t* dst; int ld, cbase; float* fo = nullptr;
        if (pn < 4) { dst = xaq; ld = 1024; cbase = pn * 256; }
        else if (pn < 8) { dst = xaq + (size_t)MROWS * 1024; ld = 1024; cbase = pn * 256 - 1024; }
        else if (pn == 8) { dst = kb; ld = 256; cbase = 0; fo = outk; }
        else if (pn == 9) { dst = vb; ld = 256; cbase = 0; fo = outv; }
        else { dst = xc; ld = 1024; cbase = pn * 256 - 2560; }
        const int hh = wc >> 1, i0 = 16 * (wc & 1) + 4 * fq;
        const int c1 = cbase + (qk ? 64 * hh + i0 : wc * 32 + 4 * fq), dc = qk ? 32 : 16;
        const bool rope = qk && u.pm >= 32;
#pragma unroll
        for (int ai = 0; ai < 2; ++ai) {
            f32x4 csm[4], snm[4];
#pragma unroll
            for (int m = 0; m < 4; ++m) { csm[m] = (f32x4){1.f, 1.f, 1.f, 1.f}; snm[m] = (f32x4){0.f, 0.f, 0.f, 0.f};
                if (rope) { const int row = u.pm * 256 + wr * 64 + fr + ai * 128 + m * 16; const int t = (row - MCTX) & 2047; const int pos = hh == 0 ? (t >> 6) : (t & 63);
                    csm[m] = *(const f32x4*)(rc + pos * 32 + i0); snm[m] = *(const f32x4*)(rc + 2048 + pos * 32 + i0); } }
#pragma unroll
            for (int m = 0; m < 4; ++m) {
                const int row = u.pm * 256 + wr * 64 + fr + ai * 128 + m * 16;
                const f32x4 cs = csm[m], sn = snm[m];
                bf16_t* dp = dst + (size_t)row * ld + c1;
                float* fp = fo + ((size_t)(((row >> 8) * 2 + l) * 256 + (row & 255))) * 256 + c1;
#pragma unroll
                for (int bj = 0; bj < 2; ++bj) {
                    const f32x4 x1 = acc[ai][bj][m][0], x2 = acc[ai][bj][m][1];
                    const f32x4 o1 = x1 * cs - x2 * sn, o2 = x1 * sn + x2 * cs;
                    uint2 p1, p2; p1.x = pack2(o1[0], o1[1]); p1.y = pack2(o1[2], o1[3]); p2.x = pack2(o2[0], o2[1]); p2.y = pack2(o2[2], o2[3]);
                    *(uint2*)(dp + bj * 128) = p1; *(uint2*)(dp + bj * 128 + dc) = p2;
                    if (fo != nullptr && row < MCTX) { *(f32x4*)(fp + bj * 128) = o1; *(f32x4*)(fp + bj * 128 + dc) = o2; }
                }
            }
        }
    }
};
struct EpiGate {
    bf16_t* gt; const float* bias;
    __device__ __forceinline__ void operator()(const f32x4 (&acc)[2][2][4][2], const Unit& u, int wr, int wc, int fr, int fq) const {
        const int c0 = u.pn * 256 + wc * 32 + 4 * fq;
        f32x4 bb[4];
#pragma unroll
        for (int g = 0; g < 4; ++g) bb[g] = *(const f32x4*)(bias + c0 + (g >> 1) * 128 + (g & 1) * 16);
#pragma unroll
        for (int ai = 0; ai < 2; ++ai) { if (ai == 1 && u.m192 && wr == 1) continue;
#pragma unroll
            for (int m = 0; m < 4; ++m) { const int row = u.row0 + wr * 64 + fr + ai * 128 + m * 16;
#pragma unroll
                for (int g = 0; g < 4; ++g) { const f32x4 v = acc[ai][g >> 1][m][g & 1];
                    uint2 pk; pk.x = pack2(sigmoidf_(v[0] + bb[g][0]), sigmoidf_(v[1] + bb[g][1])); pk.y = pack2(sigmoidf_(v[2] + bb[g][2]), sigmoidf_(v[3] + bb[g][3]));
                    *(uint2*)(gt + (size_t)row * 1024 + c0 + (g >> 1) * 128 + (g & 1) * 16) = pk; } } }
    }
};
template <int j> struct EpiBranch {
    const bf16_t* gt; float* tmp; bf16_t* mg;
    __device__ __forceinline__ void operator()(const f32x4 (&acc)[2][2][4][2], const Unit& u, int wr, int wc, int fr, int fq) const {
        const int c0 = u.pn * 256 + wc * 32 + 4 * fq;
#pragma unroll
        for (int ai = 0; ai < 2; ++ai) { if (ai == 1 && u.m192 && wr == 1) continue;
#pragma unroll
            for (int m = 0; m < 4; ++m) {
                const unsigned ro = (unsigned)(u.row0 + wr * 64 + fr + ai * 128 + m * 16) * 1024u + (unsigned)c0;
                uint2 gp[4]; f32x4 tv[4];
#pragma unroll
                for (int g = 0; g < 4; ++g) { const unsigned o = ro + (g >> 1) * 128 + (g & 1) * 16;
                    gp[g] = *(const uint2*)(gt + o); tv[g] = (f32x4){0.f, 0.f, 0.f, 0.f}; if (j != 0) tv[g] = *(const f32x4*)(tmp + o); }
#pragma unroll
                for (int g = 0; g < 4; ++g) { const unsigned o = ro + (g >> 1) * 128 + (g & 1) * 16;
                    const f32x4 v = acc[ai][g >> 1][m][g & 1];
                    f32x4 r = tv[g];
                    r[0] += v[0] * bf2f((unsigned short)(gp[g].x & 0xffff)); r[1] += v[1] * bf2f((unsigned short)(gp[g].x >> 16));
                    r[2] += v[2] * bf2f((unsigned short)(gp[g].y & 0xffff)); r[3] += v[3] * bf2f((unsigned short)(gp[g].y >> 16));
                    if (j != 2) *(f32x4*)(tmp + o) = r;
                    else { uint2 pk; pk.x = pack2(r[0], r[1]); pk.y = pack2(r[2], r[3]); *(uint2*)(mg + o) = pk; } }
            } }
    }
};
struct EpiMerge {
    bf16_t* gt; const float* bgate; float* tmp; bf16_t* mg;
    __device__ __forceinline__ void operator()(const f32x4 (&acc)[2][2][4][2], const Unit& u, int wr, int wc, int fr, int fq) const {
        const int j = u.z >> 1;
        if ((u.z & 1) == 0) { EpiGate E{gt, bgate + j * 1024}; E(acc, u, wr, wc, fr, fq); }
        else if (j == 0) { EpiBranch<0> E{gt, tmp, mg}; E(acc, u, wr, wc, fr, fq); }
        else if (j == 1) { EpiBranch<1> E{gt, tmp, mg}; E(acc, u, wr, wc, fr, fq); }
        else { EpiBranch<2> E{gt, tmp, mg}; E(acc, u, wr, wc, fr, fq); }
    }
};
struct EpiRes {
    float* x; const float* mod; int goff;
    __device__ __forceinline__ void operator()(const f32x4 (&acc)[2][2][4][2], const Unit& u, int wr, int wc, int fr, int fq) const {
        const int c0 = u.pn * 256 + wc * 32 + 4 * fq;
        const int sg0 = seq_group(u.row0), sg1 = seq_group(u.row0 + (u.m192 ? 191 : 255));
        if (sg0 == sg1) {
            const float* gsrc = mod + sg0 * 6144 + goff;
            f32x4 gg[4];
#pragma unroll
            for (int g = 0; g < 4; ++g) gg[g] = *(const f32x4*)(gsrc + c0 + (g >> 1) * 128 + (g & 1) * 16);
#pragma unroll
            for (int ai = 0; ai < 2; ++ai) { if (ai == 1 && u.m192 && wr == 1) continue;
#pragma unroll
                for (int mp = 0; mp < 2; ++mp) {
                    const unsigned ro = (unsigned)(u.row0 + wr * 64 + fr + ai * 128 + mp * 32) * 1024u + (unsigned)c0;
                    f32x4 xv[8];
#pragma unroll
                    for (int k = 0; k < 8; ++k) { const int g = k & 3; xv[k] = *(const f32x4*)(x + (ro + (k >> 2) * 16384 + (g >> 1) * 128 + (g & 1) * 16)); }
#pragma unroll
                    for (int k = 0; k < 8; ++k) { const int g = k & 3, m = mp * 2 + (k >> 2); *(f32x4*)(x + (ro + (k >> 2) * 16384 + (g >> 1) * 128 + (g & 1) * 16)) = xv[k] + gg[g] * acc[ai][g >> 1][m][g & 1]; }
                } }
        } else {
#pragma unroll
            for (int ai = 0; ai < 2; ++ai) { if (ai == 1 && u.m192 && wr == 1) continue;
#pragma unroll
                for (int m = 0; m < 4; ++m) {
                    const int row = u.row0 + wr * 64 + fr + ai * 128 + m * 16;
                    const float* gsrc = mod + seq_group(row) * 6144 + goff + c0;
                    const unsigned ro = (unsigned)row * 1024u + (unsigned)c0;
                    f32x4 xv[4], gv[4];
#pragma unroll
                    for (int g = 0; g < 4; ++g) { xv[g] = *(const f32x4*)(x + (ro + (g >> 1) * 128 + (g & 1) * 16)); gv[g] = *(const f32x4*)(gsrc + (g >> 1) * 128 + (g & 1) * 16); }
#pragma unroll
                    for (int g = 0; g < 4; ++g) *(f32x4*)(x + (ro + (g >> 1) * 128 + (g & 1) * 16)) = xv[g] + gv[g] * acc[ai][g >> 1][m][g & 1];
                } }
        }
    }
};
struct EpiBf {
    bf16_t* dst; int ld;
    __device__ __forceinline__ void operator()(const f32x4 (&acc)[2][2][4][2], const Unit& u, int wr, int wc, int fr, int fq) const {
        EPI_LOOP_BEGIN
            const int col = u.pn * 256 + cl;
            uint2 pk; pk.x = pack2(v[0], v[1]); pk.y = pack2(v[2], v[3]);
            *(uint2*)(dst + (size_t)row * ld + col) = pk;
        EPI_LOOP_END
    }
};
struct EpiPool {
    bf16_t* dst; const float* scale;
    __device__ __forceinline__ void operator()(const f32x4 (&acc)[2][2][4][2], const Unit& u, int wr, int wc, int fr, int fq) const {
        const int c0 = u.pn * 256 + wc * 32 + 4 * fq;
        f32x4 sc[4];
#pragma unroll
        for (int g = 0; g < 4; ++g) sc[g] = *(const f32x4*)(scale + c0 + (g >> 1) * 128 + (g & 1) * 16);
#pragma unroll
        for (int ai = 0; ai < 2; ++ai)
#pragma unroll
            for (int m = 0; m < 4; ++m) { const int row = u.pm * 256 + wr * 64 + fr + ai * 128 + m * 16;
#pragma unroll
                for (int g = 0; g < 4; ++g) { const f32x4 v = acc[ai][g >> 1][m][g & 1] * sc[g];
                    uint2 pk; pk.x = pack2(v[0], v[1]); pk.y = pack2(v[2], v[3]);
                    *(uint2*)(dst + (size_t)row * 1024 + c0 + (g >> 1) * 128 + (g & 1) * 16) = pk; } }
    }
};

struct WPtrs { const float *w_in, *w_branch, *lru_wa, *lru_wx, *pool_w, *w_out, *ffn_up, *ffn_down; unsigned char* ws; };
struct TileDesc { const float* src; int lds_; bf16_t* dst; int ldd, k0, n0, perm; };
__device__ __forceinline__ int swap45(int p) { return (p & ~48) | ((p & 16) << 1) | ((p & 32) >> 1); }
__device__ __forceinline__ TileDesc weight_tile(const WPtrs& P, int l, int t) {
    unsigned char* ws = P.ws; TileDesc d; int r = t; d.perm = 0;
    if (r < 1664) { d.src = P.w_in + (size_t)l * 1024 * 6656; d.lds_ = 6656; d.dst = (bf16_t*)(ws + OFF_WIN); d.ldd = 1024; d.k0 = (r / 104) * 64; d.n0 = (r % 104) * 64; d.perm = (d.n0 >= 1024 && d.n0 < 2304) ? 1 : 0; }
    else if ((r -= 1664) < 128) { const int mat = r / 64; r %= 64; const int dh = r / 4; r %= 4;
        d.src = (mat ? P.lru_wx : P.lru_wa) + (size_t)(l * 16 + dh) * 128 * 128; d.lds_ = 128; d.dst = (bf16_t*)(ws + OFF_GW) + (size_t)dh * 256 * 128 + (size_t)mat * 128 * 128; d.ldd = 128; d.k0 = (r / 2) * 64; d.n0 = (r % 2) * 64; }
    else if ((r -= 128) < 64) { const int g = r / 16; r %= 16; d.src = P.pool_w + (size_t)(l * 4 + g) * 256 * 256; d.lds_ = 256; d.dst = (bf16_t*)(ws + OFF_PW) + (size_t)g * 256 * 256; d.ldd = 256; d.k0 = (r / 4) * 64; d.n0 = (r % 4) * 64; }
    else if ((r -= 64) < 768) { const int j = r / 256; r %= 256; d.src = P.w_branch + (size_t)(l * 3 + j) * 1024 * 1024; d.lds_ = 1024; d.dst = (bf16_t*)(ws + OFF_WBR) + (size_t)j * 1024 * 1024; d.ldd = 1024; d.k0 = (r / 16) * 64; d.n0 = (r % 16) * 64; }
    else if ((r -= 768) < 256) { d.src = P.w_out + (size_t)l * 1024 * 1024; d.lds_ = 1024; d.dst = (bf16_t*)(ws + OFF_WOUT); d.ldd = 1024; d.k0 = (r / 16) * 64; d.n0 = (r % 16) * 64; }
    else if ((r -= 256) < 1408) { d.src = P.ffn_up + (size_t)l * 1024 * 5632; d.lds_ = 5632; d.dst = (bf16_t*)(ws + OFF_WUP); d.ldd = 1024; d.k0 = (r / 88) * 64; d.n0 = (r % 88) * 64; }
    else { r -= 1408; d.src = P.ffn_down + (size_t)l * 2816 * 1024; d.lds_ = 1024; d.dst = (bf16_t*)(ws + OFF_WDN); d.ldd = 2816; d.k0 = (r / 16) * 64; d.n0 = (r % 16) * 64; }
    return d;
}
__device__ __noinline__ void convert_weights_(const float* p0, const float* p1, const float* p2, const float* p3, const float* p4, const float* p5, const float* p6, const float* p7, unsigned char* pws,
                                              int l, LAS unsigned char* lds, int t_begin, int t_end, int first, int stride) {
    const WPtrs P{p0, p1, p2, p3, p4, p5, p6, p7, pws};
    LAS bf16_t* sm = (LAS bf16_t*)lds;
    const int tid = otid();
    const int kk0 = tid >> 4, n4 = (tid & 15) * 4, nn = tid >> 3, ck = tid & 7;
    int t = t_begin + first;
    if (t >= t_end) return;
    TileDesc d = weight_tile(P, l, t);
    f32x4 v0 = *(const f32x4*)(d.src + (size_t)(d.k0 + kk0) * d.lds_ + d.n0 + n4), v1 = *(const f32x4*)(d.src + (size_t)(d.k0 + kk0 + 32) * d.lds_ + d.n0 + n4);
    for (;;) {
        __syncthreads();
#pragma unroll
        for (int e = 0; e < 4; ++e) { sm[(n4 + e) * 72 + kk0] = f2bf(v0[e]); sm[(n4 + e) * 72 + kk0 + 32] = f2bf(v1[e]); }
        __syncthreads();
        const TileDesc cur = d; const int tn = t + stride; const bool more = tn < t_end;
        if (more) { d = weight_tile(P, l, tn); v0 = *(const f32x4*)(d.src + (size_t)(d.k0 + kk0) * d.lds_ + d.n0 + n4); v1 = *(const f32x4*)(d.src + (size_t)(d.k0 + kk0 + 32) * d.lds_ + d.n0 + n4); }
        const u32x4 o = *(const LAS u32x4*)(sm + nn * 72 + ck * 8);
        const int nrow = cur.perm ? swap45(cur.n0 + nn) : (cur.n0 + nn);
        *(u32x4*)(cur.dst + (size_t)nrow * cur.ldd + cur.k0 + ck * 8) = o;
        if (!more) break;
        t = tn;
    }
    __syncthreads();
}

__device__ __forceinline__ void convert_weights(const Params& P, int l, LAS unsigned char* lds, int t_begin, int t_end, int first, int stride) {
    convert_weights_(P.w_in, P.w_branch, P.lru_wa, P.lru_wx, P.pool_w, P.w_out, P.ffn_up, P.ffn_down, P.ws, l, lds, t_begin, t_end, first, stride);
}

__device__ void phase0(const Params& P, LAS unsigned char* lds) {
    const int tid = otid(), G = gridDim.x, c = blockIdx.x;
    { const size_t n4 = (size_t)MROWS * 1024 / 4, nc4 = (size_t)MCTX * 1024 / 4;
      for (size_t i = (size_t)c * 512 + tid; i < n4; i += (size_t)G * 512) {
          const float4 v = i < nc4 ? ((const float4*)P.x_prompt)[i] : ((const float4*)P.x_sample)[i - nc4];
          ((float4*)P.out)[i] = v; } }
    { bf16_t* ck = (bf16_t*)(P.ws + OFF_CK); bf16_t* cv = (bf16_t*)(P.ws + OFF_CV);
      for (int i = c * 512 + tid; i < 2 * 2 * 512 * 256; i += G * 512) {
          const int e = i & 255, t = (i >> 8) & 511, b = (i >> 17) & 1, l = i >> 18;
          const size_t si = ((size_t)((b * 2 + l) * 512 + t)) * 256 + e;
          ck[i] = f2bf(P.cache_k[si]); cv[i] = f2bf(P.cache_v[si]); } }
    { float* rc = (float*)(P.ws + OFF_ROPE); float* rs = rc + 2048;
      for (int i = c * 512 + tid; i < 2048; i += G * 512) {
          const int pos = i >> 5, k = i & 31; const float fr = powf(10000.0f, -(float)k / 32.0f); const float ang = (float)pos * fr;
          rc[i] = cosf(ang); rs[i] = sinf(ang); } }
    { LAS float* sv = (LAS float*)lds;
      LAS float* red = sv + 3072;
      __syncthreads();
      for (int i = tid; i < 3072; i += 512) { const int s = i >> 10, k = i & 1023; const float x = s == 0 ? P.c_ctx[k] : P.c[(s - 1) * 1024 + k]; sv[i] = x / (1.0f + expf(-x)); }
      __syncthreads();
      float* mod = (float*)(P.ws + OFF_MOD);
      for (int it = c; it < 384; it += G) {
          const int l = it / 192, cg_ = it % 192, cl = tid & 31, kg = tid >> 5, col = cg_ * 32 + cl;
          const float* w = P.w_ada + (size_t)l * 1024 * 6144 + col;
          float a0 = 0.f, a1 = 0.f, a2 = 0.f;
#pragma unroll 16
          for (int k = kg * 64; k < kg * 64 + 64; ++k) { const float wv = w[(size_t)k * 6144]; a0 += sv[k] * wv; a1 += sv[1024 + k] * wv; a2 += sv[2048 + k] * wv; }
          red[(kg * 3 + 0) * 32 + cl] = a0; red[(kg * 3 + 1) * 32 + cl] = a1; red[(kg * 3 + 2) * 32 + cl] = a2;
          __syncthreads();
          if (tid < 96) { const int s = tid >> 5, cc = tid & 31; float sum = 0.f;
#pragma unroll
              for (int g = 0; g < 16; ++g) sum += red[(g * 3 + s) * 32 + cc];
              mod[(size_t)(l * 3 + s) * 6144 + cg_ * 32 + cc] = sum + P.b_ada[l * 6144 + cg_ * 32 + cc]; }
          __syncthreads();
      } }
}

__device__ void norm_phase(const float* __restrict__ X, const float* __restrict__ gw, const float* __restrict__ mod, int shift_off, int scale_off, bf16_t* __restrict__ H) {
    const int tid = otid(); const int lane = tid & 63, wv = blockIdx.x * 8 + (tid >> 6), nw = gridDim.x * 8;
    for (int row = wv; row < MROWS; row += nw) {
        const float* md = mod + seq_group(row) * 6144;
        f32x4 v[4]; float ss = 0.f;
#pragma unroll
        for (int i = 0; i < 4; ++i) { v[i] = *(const f32x4*)(X + (size_t)row * 1024 + i * 256 + lane * 4); ss += v[i][0] * v[i][0] + v[i][1] * v[i][1] + v[i][2] * v[i][2] + v[i][3] * v[i][3]; }
#pragma unroll
        for (int o = 32; o >= 1; o >>= 1) ss += __shfl_xor(ss, o);
        const float rstd = rsqrtf(ss * (1.0f / 1024.0f) + 1e-6f);
#pragma unroll
        for (int i = 0; i < 4; ++i) { const int col = i * 256 + lane * 4;
            const f32x4 g = *(const f32x4*)(gw + col), sc = *(const f32x4*)(md + scale_off + col), sh = *(const f32x4*)(md + shift_off + col);
            f32x4 h;
#pragma unroll
            for (int e = 0; e < 4; ++e) h[e] = v[i][e] * rstd * g[e] * (1.0f + sc[e]) + sh[e];
            uint2 pk; pk.x = pack2(h[0], h[1]); pk.y = pack2(h[2], h[3]);
            *(uint2*)(H + (size_t)row * 1024 + col) = pk; }
    }
}
__device__ void final_norm_phase(float* X, const float* __restrict__ gw) {
    const int tid = otid(); const int lane = tid & 63, wv = blockIdx.x * 8 + (tid >> 6), nw = gridDim.x * 8;
    for (int row = wv; row < MROWS; row += nw) {
        f32x4 v[4]; float ss = 0.f;
#pragma unroll
        for (int i = 0; i < 4; ++i) { v[i] = *(const f32x4*)(X + (size_t)row * 1024 + i * 256 + lane * 4); ss += v[i][0] * v[i][0] + v[i][1] * v[i][1] + v[i][2] * v[i][2] + v[i][3] * v[i][3]; }
#pragma unroll
        for (int o = 32; o >= 1; o >>= 1) ss += __shfl_xor(ss, o);
        const float rstd = rsqrtf(ss * (1.0f / 1024.0f) + 1e-6f);
#pragma unroll
        for (int i = 0; i < 4; ++i) { const int col = i * 256 + lane * 4; const f32x4 g = *(const f32x4*)(gw + col);
            f32x4 h;
#pragma unroll
            for (int e = 0; e < 4; ++e) h[e] = v[i][e] * rstd * g[e];
            *(f32x4*)(X + (size_t)row * 1024 + col) = h; }
    }
}

__device__ void pool_phase(const bf16_t* __restrict__ XC, bf16_t* __restrict__ PL) {
    const int tid = otid();
    for (int idx = blockIdx.x * 512 + tid; idx < (MROWS / 16) * 128; idx += gridDim.x * 512) {
        const int rs = (idx >> 7) * 16, ch = (idx & 127) * 8, g = ch >> 8, half = 1 << g;
        const int T = rs < MCTX ? 256 : 2048, row0 = rs < MCTX ? (rs & ~255) : MCTX + ((rs - MCTX) & ~2047), tl0 = rs - row0;
        const bf16_t* base = XC + (size_t)row0 * 1024 + ch;
        float s[8];
#pragma unroll
        for (int e = 0; e < 8; ++e) s[e] = 0.f;
        { const int lo = max(tl0 - half, 0), hi = min(tl0 + half, T);
          for (int t = lo; t < hi; ++t) { const bf16x8 x = *(const bf16x8*)(base + (size_t)t * 1024);
#pragma unroll
              for (int e = 0; e < 8; ++e) s[e] += bf2f((unsigned short)x[e]); } }
#pragma unroll 4
        for (int i = 0; i < 16; ++i) {
            const int t = tl0 + i;
            const int lo = max(t - half, 0), hi = min(t + half, T);
            const bf16x8 xs = *(const bf16x8*)(base + (size_t)t * 1024);
            const float inv = 1.0f / (float)(hi - lo);
            u32x4 o; o.x = pack2(s[0] * inv - bf2f((unsigned short)xs[0]), s[1] * inv - bf2f((unsigned short)xs[1])); o.y = pack2(s[2] * inv - bf2f((unsigned short)xs[2]), s[3] * inv - bf2f((unsigned short)xs[3]));
            o.z = pack2(s[4] * inv - bf2f((unsigned short)xs[4]), s[5] * inv - bf2f((unsigned short)xs[5])); o.w = pack2(s[6] * inv - bf2f((unsigned short)xs[6]), s[7] * inv - bf2f((unsigned short)xs[7]));
            *(u32x4*)(PL + (size_t)(row0 + t) * 1024 + ch) = o;
            if (t + half < T) { const bf16x8 x = *(const bf16x8*)(base + (size_t)(t + half) * 1024);
#pragma unroll
                for (int e = 0; e < 8; ++e) s[e] += bf2f((unsigned short)x[e]); }
            if (t - half >= 0) { const bf16x8 x = *(const bf16x8*)(base + (size_t)(t - half) * 1024);
#pragma unroll
                for (int e = 0; e < 8; ++e) s[e] -= bf2f((unsigned short)x[e]); }
        }
    }
}
__device__ __forceinline__ float gelu_tanh(float x) { const float y = 0.7978845608028654f * (x + 0.044715f * x * x * x); const float t = 1.0f - 2.0f * __builtin_amdgcn_rcpf(1.0f + __expf(2.0f * y)); return 0.5f * x * (1.0f + t); }
__device__ void act_phase(const bf16_t* __restrict__ U, bf16_t* __restrict__ ACT, const float* __restrict__ cw, const float* __restrict__ cb) {
    const int tid = otid();
    for (int idx = blockIdx.x * 512 + tid; idx < (MROWS / 16) * 352; idx += gridDim.x * 512) {
        const int rs = (idx / 352) * 16, ch = (idx % 352) * 8;
        const int T = rs < MCTX ? 256 : 2048, row0 = rs < MCTX ? (rs & ~255) : MCTX + ((rs - MCTX) & ~2047), tl0 = rs - row0;
        float w0[8], w1[8], w2[8], bb[8];
#pragma unroll
        for (int e = 0; e < 8; ++e) { w0[e] = cw[ch + e]; w1[e] = cw[2816 + ch + e]; w2[e] = cw[5632 + ch + e]; bb[e] = cb[ch + e]; }
        const bf16_t* up = U + (size_t)rs * 5632 + ch;
        const bf16x8 zero = (bf16x8){0, 0, 0, 0, 0, 0, 0, 0};
        bf16x8 um = tl0 > 0 ? *(const bf16x8*)(up - 5632) : zero;
        bf16x8 u0 = *(const bf16x8*)up;
#pragma unroll 4
        for (int i = 0; i < 16; ++i) {
            const bf16x8 un = (tl0 + i < T - 1) ? *(const bf16x8*)(up + (size_t)(i + 1) * 5632) : zero;
            const bf16x8 vv = *(const bf16x8*)(up + (size_t)i * 5632 + 2816);
            float r[8];
#pragma unroll
            for (int e = 0; e < 8; ++e) { const float gff = w0[e] * bf2f((unsigned short)um[e]) + w1[e] * bf2f((unsigned short)u0[e]) + w2[e] * bf2f((unsigned short)un[e]) + bb[e];
                r[e] = gelu_tanh(gff) * bf2f((unsigned short)vv[e]); }
            u32x4 o; o.x = pack2(r[0], r[1]); o.y = pack2(r[2], r[3]); o.z = pack2(r[4], r[5]); o.w = pack2(r[6], r[7]);
            *(u32x4*)(ACT + (size_t)(rs + i) * 2816 + ch) = o;
            um = u0; u0 = un;
        }
    }
}

__device__ __forceinline__ void rope8(bf16x8& x1, bf16x8& x2, const float* __restrict__ cs, const float* __restrict__ sn) {
#pragma unroll
    for (int e = 0; e < 8; ++e) { const float a = bf2f((unsigned short)x1[e]), b = bf2f((unsigned short)x2[e]); const float c = cs[e], s = sn[e];
        x1[e] = (short)f2bf(a * c - b * s); x2[e] = (short)f2bf(a * s + b * c); }
}
constexpr int VT_OFF = 64 * 272;
constexpr int ABUF = 64 * 272 + 64 * 288;
__device__ void attn_unit(const Params& P, int l, int u, LAS unsigned char* lds) {
    int tid_ = threadIdx.x; asm volatile("" : "+v"(tid_));
    const int tid = tid_, w = tid >> 6, lane = tid & 63, fr = lane & 15, fq = lane >> 4;
    const bf16_t* Q = (const bf16_t*)(P.ws + OFF_XAQ) + (size_t)MROWS * 1024;
    const bf16_t* KB = (const bf16_t*)(P.ws + OFF_KB); const bf16_t* VB = (const bf16_t*)(P.ws + OFF_VB);
    const bf16_t* CK = (const bf16_t*)(P.ws + OFF_CK); const bf16_t* CV = (const bf16_t*)(P.ws + OFF_CV);
    bf16_t* YB = (bf16_t*)(P.ws + OFF_YB);
    bool lat; int head, row0, T, qstart, bidx;
    if (u < 256) { lat = true; bidx = u >> 7; const int rem = u & 127; head = rem >> 4; qstart = (rem & 15) * 128; T = 2048; row0 = MCTX + bidx * 2048; }
    else { const int v = u - 256; lat = false; bidx = 0; const int seq = v >> 4, rem = v & 15; head = rem >> 1; qstart = (rem & 1) * 128; T = 256; row0 = seq * 256; }
    const int kvh = head >> 2;
    const int qpos = qstart + w * 16 + fr;
    bf16x8 qf[4];
    { const bf16_t* qp = Q + (size_t)(row0 + qpos) * 1024 + head * 128 + fq * 8;
#pragma unroll
      for (int kk = 0; kk < 4; ++kk) qf[kk] = *(const bf16x8*)(qp + kk * 32); }
    float m_run = P.attn_sink[l * 8 + head]; float l_run = (fq == 0) ? 1.0f : 0.0f;
    f32x4 o[8];
#pragma unroll
    for (int dt = 0; dt < 8; ++dt) o[dt] = (f32x4){0.f, 0.f, 0.f, 0.f};
    int wlo = 0, nwt = 4;
    if (lat) { wlo = max(0, qstart - 128); const int whi = min(T, qstart + 256); nwt = (whi - wlo) >> 6; }
    const int ntiles = nwt + (lat ? 8 : 0);
    const float scale = 0.08838834764831845f;
    const int lkey = tid >> 3, lp = tid & 7;
    bf16x8 rk[2][2], rv[2][2];
    auto tile_load = [&](int ti, bf16x8 (&k_)[2], bf16x8 (&v_)[2]) {
        const bf16_t* ksrc; const bf16_t* vsrc;
        if (ti < nwt) { const int k0 = wlo + ti * 64; ksrc = KB + (size_t)(row0 + k0) * 256 + kvh * 128; vsrc = VB + (size_t)(row0 + k0) * 256 + kvh * 128; }
        else { const int k0 = (ti - nwt) * 64; const size_t o_ = ((size_t)((l * 2 + bidx) * 512 + k0)) * 256 + kvh * 128; ksrc = CK + o_; vsrc = CV + o_; }
        const bf16_t* kr = ksrc + (size_t)lkey * 256; k_[0] = *(const bf16x8*)(kr + lp * 8); k_[1] = *(const bf16x8*)(kr + (lp + 8) * 8);
        const bf16_t* vr = vsrc + (size_t)lkey * 256; v_[0] = *(const bf16x8*)(vr + lp * 8); v_[1] = *(const bf16x8*)(vr + (lp + 8) * 8); };
    const int krow = (lkey & 32) | ((lkey & 4) << 2) | ((lkey & 24) >> 1) | (lkey & 3);
    auto tile_store = [&](int b, const bf16x8 (&k_)[2], const bf16x8 (&v_)[2]) {
        LAS unsigned char* kb_ = lds + b * ABUF; LAS unsigned char* vb_ = kb_ + VT_OFF;
        *(LAS bf16x8*)(kb_ + krow * 272 + lp * 16) = k_[0]; *(LAS bf16x8*)(kb_ + krow * 272 + (lp + 8) * 16) = k_[1];
        *(LAS bf16x8*)(vb_ + lkey * 288 + lp * 16) = v_[0]; *(LAS bf16x8*)(vb_ + lkey * 288 + (lp + 8) * 16) = v_[1]; };
    tile_load(0, rk[0], rv[0]);
    tile_load(1, rk[1], rv[1]);
    __syncthreads();
    tile_store(0, rk[0], rv[0]);
    tile_load(2, rk[0], rv[0]);
#pragma unroll 2
    for (int ti = 0; ti < ntiles; ++ti) {
        const bool win = ti < nwt; const int k0 = win ? wlo + ti * 64 : (ti - nwt) * 64;
        __syncthreads();
        if ((ti & 1) == 0) { if (ti + 1 < ntiles) tile_store(1, rk[1], rv[1]); if (ti + 3 < ntiles) tile_load(ti + 3, rk[1], rv[1]); }
        else { if (ti + 1 < ntiles) tile_store(0, rk[0], rv[0]); if (ti + 3 < ntiles) tile_load(ti + 3, rk[0], rv[0]); }
        LAS unsigned char* kb_ = lds + (ti & 1) * ABUF; LAS unsigned char* vb_ = kb_ + VT_OFF;
        f32x4 s[4];
#pragma unroll
        for (int nt = 0; nt < 4; ++nt) { s[nt] = (f32x4){0.f, 0.f, 0.f, 0.f};
#pragma unroll
            for (int kk = 0; kk < 4; ++kk) { const bf16x8 a = *(const LAS bf16x8*)(kb_ + (nt * 16 + fr) * 272 + kk * 64 + fq * 16); s[nt] = __builtin_amdgcn_mfma_f32_16x16x32_bf16(a, qf[kk], s[nt], 0, 0, 0); } }
        float mt = -3.0e38f;
#pragma unroll
        for (int nt = 0; nt < 4; ++nt)
#pragma unroll
            for (int j = 0; j < 4; ++j) { float v = s[nt][j] * scale;
                if (lat && win) { const int kp = k0 + 32 * (nt >> 1) + 8 * fq + 4 * (nt & 1) + j; const int dd = qpos - kp; if (dd > 128 || dd < -128) v = -1.0e30f; }
                s[nt][j] = v; mt = fmaxf(mt, v); }
        mt = fmaxf(mt, __shfl_xor(mt, 16)); mt = fmaxf(mt, __shfl_xor(mt, 32));
        const float mn = fmaxf(m_run, mt); const float alpha = __expf(m_run - mn); m_run = mn;
        float ps = 0.f;
#pragma unroll
        for (int nt = 0; nt < 4; ++nt)
#pragma unroll
            for (int j = 0; j < 4; ++j) { const float p = __expf(s[nt][j] - mn); ps += p; s[nt][j] = p; }
        l_run = l_run * alpha + ps;
#pragma unroll
        for (int dt = 0; dt < 8; ++dt) o[dt] = o[dt] * alpha;
#pragma unroll
        for (int s2 = 0; s2 < 2; ++s2) {
            u32x4 pu; pu[0] = pack2(s[2 * s2][0], s[2 * s2][1]); pu[1] = pack2(s[2 * s2][2], s[2 * s2][3]); pu[2] = pack2(s[2 * s2 + 1][0], s[2 * s2 + 1][1]); pu[3] = pack2(s[2 * s2 + 1][2], s[2 * s2 + 1][3]);
            const bf16x8 pf = __builtin_bit_cast(bf16x8, pu);
#pragma unroll
            for (int dt = 0; dt < 8; ++dt) {
                const bf16x4 lo = __builtin_amdgcn_ds_read_tr16_b64_v4i16((LAS bf16x4*)(vb_ + (s2 * 32 + fq * 8 + (fr >> 2)) * 288 + (dt * 16 + (fr & 3) * 4) * 2));
                const bf16x4 hi = __builtin_amdgcn_ds_read_tr16_b64_v4i16((LAS bf16x4*)(vb_ + (s2 * 32 + fq * 8 + 4 + (fr >> 2)) * 288 + (dt * 16 + (fr & 3) * 4) * 2));
                const bf16x8 af = __builtin_shufflevector(lo, hi, 0, 1, 2, 3, 4, 5, 6, 7);
                o[dt] = __builtin_amdgcn_mfma_f32_16x16x32_bf16(af, pf, o[dt], 0, 0, 0);
            }
        }
    }
    float lt = l_run; lt += __shfl_xor(lt, 16); lt += __shfl_xor(lt, 32);
    const float inv = 1.0f / lt;
    bf16_t* yp = YB + (size_t)(row0 + qpos) * 1024 + head * 128 + fq * 4;
#pragma unroll
    for (int dt = 0; dt < 8; ++dt) { uint2 pk; pk.x = pack2(o[dt][0] * inv, o[dt][1] * inv); pk.y = pack2(o[dt][2] * inv, o[dt][3] * inv); *(uint2*)(yp + dt * 16) = pk; }
}

constexpr int YT_OFF = 256 * 272;
template <int MODE, int D, int NSC>
__device__ __forceinline__ void lru_dir(const Params& P, int l, int s, int cchunk, int h, LAS unsigned char* lds, int w, int fr, int fq) {
    const bool lat = s >= 32; const int row0 = lat ? MCTX + (s - 32) * 2048 : s * 256; const int t0 = cchunk * (NSC * 64);
    constexpr int NCH = 2048 / (NSC * 64);
    const bf16_t* GW = (const bf16_t*)(P.ws + OFF_GW);
    bf16_t* YA = (bf16_t*)(P.ws + OFF_YA);
    float* SUMM = (float*)(P.ws + OFF_SUMM);
    const int chl = 16 * w + fr, ch = h * 128 + chl;
    bf16x8 bwa[4], bwx[4];
    { const bf16_t* gp = GW + ((size_t)(D * 8 + h) * 256 + chl) * 128 + fq * 8;
#pragma unroll
      for (int kk = 0; kk < 4; ++kk) { bwa[kk] = *(const bf16x8*)(gp + kk * 32); bwx[kk] = *(const bf16x8*)(gp + 128 * 128 + kk * 32); } }
    const int pidx = (l * 2 + D) * 1024 + ch;
    const float ba = P.lru_ba[pidx], bx = P.lru_bx[pidx];
    const float lam = P.lru_lambda[pidx];
    const float c8 = -8.0f * log1pf(expf(-lam));
    float carry = 0.f;
    if (MODE == 0 && lat) {
        const int b = s - 32;
        carry = P.state_lru[((size_t)(b * 2 + l) * 2 + D) * 1024 + ch];
        if (D == 0) { for (int cc = 0; cc < cchunk; ++cc) { const float* sp = SUMM + ((size_t)((b * 2 + 0) * 16 + cc) * 1024 + ch) * 2; carry = sp[1] + sp[0] * carry; } }
        else { for (int cc = NCH - 1; cc > cchunk; --cc) { const float* sp = SUMM + ((size_t)((b * 2 + 1) * 16 + cc) * 1024 + ch) * 2; carry = sp[1] + sp[0] * carry; } }
    }
    float ptot = 1.0f;
#pragma unroll 1
    for (int sci = 0; sci < NSC; ++sci) {
        const int sc = D == 0 ? sci : NSC - 1 - sci;
        f32x4 r[4], g[4];
#pragma unroll
        for (int m = 0; m < 4; ++m) { r[m] = (f32x4){0.f, 0.f, 0.f, 0.f}; g[m] = (f32x4){0.f, 0.f, 0.f, 0.f};
#pragma unroll
            for (int kk = 0; kk < 4; ++kk) { const bf16x8 a = *(const LAS bf16x8*)(lds + (sc * 64 + m * 16 + fr) * 272 + kk * 64 + fq * 16);
                r[m] = __builtin_amdgcn_mfma_f32_16x16x32_bf16(a, bwa[kk], r[m], 0, 0, 0); g[m] = __builtin_amdgcn_mfma_f32_16x16x32_bf16(a, bwx[kk], g[m], 0, 0, 0); } }
#pragma unroll
        for (int mi = 0; mi < 4; ++mi) {
            const int m = D == 0 ? mi : 3 - mi;
            float av[4], bv[4];
#pragma unroll
            for (int j = 0; j < 4; ++j) {
                const float ea = 1.0f + __expf(-(r[m][j] + ba)), eb = 1.0f + __expf(-(g[m][j] + bx));
                const float inv = __builtin_amdgcn_rcpf(ea * eb);
                const float rr = inv * eb, ii = inv * ea;
                const float la = c8 * rr; const float a = __expf(la); const float z = 2.0f * la;
                const float em = (z > -0.05f) ? -z * (1.0f + z * (0.5f + z * (0.16666667f + z * 0.041666667f))) : 1.0f - a * a;
                const float x = bf2f(*(const LAS bf16_t*)(lds + (sc * 64 + m * 16 + fq * 4 + j) * 272 + chl * 2));
                av[j] = a; bv[j] = __builtin_amdgcn_sqrtf(em) * ii * x;
            }
            float p4, h4;
            p4 = av[0] * av[1] * av[2] * av[3];
            if (D == 0) h4 = ((bv[0] * av[1] + bv[1]) * av[2] + bv[2]) * av[3] + bv[3];
            else h4 = ((bv[3] * av[2] + bv[2]) * av[1] + bv[1]) * av[0] + bv[0];
            float pq[4], hq[4];
#pragma unroll
            for (int f = 0; f < 4; ++f) { pq[f] = __shfl(p4, fr + 16 * f); hq[f] = __shfl(h4, fr + 16 * f); }
            float cin = carry, mycin = 0.f;
#pragma unroll
            for (int fi = 0; fi < 4; ++fi) { const int f = D == 0 ? fi : 3 - fi; if (f == fq) mycin = cin; cin = hq[f] + pq[f] * cin; }
            carry = cin;
            if (MODE == 1) ptot *= pq[0] * pq[1] * pq[2] * pq[3];
            if (MODE == 0) {
                float hh = mycin; float y[4];
#pragma unroll
                for (int ji = 0; ji < 4; ++ji) { const int j = D == 0 ? ji : 3 - ji; hh = av[j] * hh + bv[j]; y[j] = hh; }
#pragma unroll
                for (int j = 0; j < 4; ++j) {
                    LAS bf16_t* yp = (LAS bf16_t*)(lds + YT_OFF + (sc * 64 + m * 16 + fq * 4 + j) * 272 + chl * 2);
                    if (D == 0) *yp = f2bf(y[j]);
                    else *yp = f2bf(bf2f(*yp) + y[j]);
                }
            }
        }
    }
    if (MODE == 0 && !lat && fq == 0) P.out[OUT_H + ((size_t)(s * 2 + l) * 2 + D) * 1024 + ch] = carry;
    if (MODE == 1 && fq == 0) { float* sp = SUMM + ((size_t)(((s - 32) * 2 + D) * 16 + cchunk) * 1024 + ch) * 2; sp[0] = ptot; sp[1] = carry; }
}
template <int MODE, int NSC>
__device__ void lru_unit(const Params& P, int l, int s, int cchunk, int h, LAS unsigned char* lds) {
    int tid_ = threadIdx.x; asm volatile("" : "+v"(tid_));
    const int tid = tid_, w = tid >> 6, lane = tid & 63, fr = lane & 15, fq = lane >> 4;
    const bool lat = s >= 32; const int T = lat ? 2048 : 256; const int row0 = lat ? MCTX + (s - 32) * 2048 : s * 256; const int t0 = cchunk * (NSC * 64);
    const bf16_t* XA = (const bf16_t*)(P.ws + OFF_XAQ);
    constexpr int RUN = NSC * 2;
    {
        const int ck = tid & 15, ch = h * 128 + ck * 8, tr = (tid >> 4) * RUN;
        const float* cw = P.lru_conv + (size_t)l * 4096 + ch; const float* cb = P.lru_conv_b + l * 1024 + ch;
        bf16x8 xr[RUN + 3];
#pragma unroll
        for (int i = 0; i < RUN + 3; ++i) { const int tt = t0 + tr + i - 2; xr[i] = (bf16x8){0, 0, 0, 0, 0, 0, 0, 0};
            if (tt >= 0 && tt < T) xr[i] = *(const bf16x8*)(XA + (size_t)(row0 + tt) * 1024 + ch); }
        float wk[4][8], bk[8];
#pragma unroll
        for (int e = 0; e < 8; ++e) { bk[e] = cb[e];
#pragma unroll
            for (int k = 0; k < 4; ++k) wk[k][e] = cw[k * 1024 + e]; }
        __syncthreads();
#pragma unroll
        for (int i = 0; i < RUN; ++i) {
            float a8[8];
#pragma unroll
            for (int e = 0; e < 8; ++e) { a8[e] = bk[e];
#pragma unroll
                for (int k = 0; k < 4; ++k) a8[e] += wk[k][e] * bf2f((unsigned short)xr[i + k][e]); }
            u32x4 o; o.x = pack2(a8[0], a8[1]); o.y = pack2(a8[2], a8[3]); o.z = pack2(a8[4], a8[5]); o.w = pack2(a8[6], a8[7]);
            *(LAS u32x4*)(lds + (tr + i) * 272 + ck * 16) = o;
        }
    }
    __syncthreads();
    lru_dir<MODE, 0, NSC>(P, l, s, cchunk, h, lds, w, fr, fq);
    lru_dir<MODE, 1, NSC>(P, l, s, cchunk, h, lds, w, fr, fq);
    if (MODE == 0) {
        bf16_t* YA = (bf16_t*)(P.ws + OFF_YA);
        __syncthreads();
#pragma unroll
        for (int it = 0; it < 2 * NSC; ++it) { const int t = (tid >> 4) + it * 32, ck = tid & 15;
            const u32x4 v = *(const LAS u32x4*)(lds + YT_OFF + t * 272 + ck * 16);
            *(u32x4*)(YA + (size_t)(row0 + t0 + t) * 1024 + h * 128 + ck * 8) = v; }
    }
}

#define XB_TMO      128
#define XB_XCNT(j)  (256  + 64 * (j))
#define XB_XSUB(j)  (1280 + 64 * (j))
#define XB_XGEN(j)  (2304 + 64 * (j))
#define XB_TOP      3328
#define XB_TOPGEN   3392
#define XCD_BAR_WORDS 3456
#define XB_SPIN_CAP (1u << 18)
__device__ __forceinline__ unsigned xb_ld(unsigned* p)              { return __hip_atomic_load(p, __ATOMIC_RELAXED, __HIP_MEMORY_SCOPE_AGENT); }
__device__ __forceinline__ unsigned xb_add(unsigned* p, unsigned v) { return __hip_atomic_fetch_add(p, v, __ATOMIC_RELAXED, __HIP_MEMORY_SCOPE_AGENT); }
__device__ __forceinline__ unsigned xb_xcc_id() { return (unsigned)__builtin_amdgcn_s_getreg((3 << 11) | 20) & 0xFu; }
#define XB_SPIN(cond, bar) do { unsigned _sp = 0; while (cond) { __builtin_amdgcn_s_sleep(1); \
    if ((++_sp & 255u) == 0u) { if (xb_ld(&(bar)[XB_TMO])) break; if (_sp > XB_SPIN_CAP) { atomicAdd(&(bar)[XB_TMO], 1u); break; } } } } while (0)
struct XcdBarrier { unsigned* bar; unsigned x; volatile LAS unsigned* st; };
__device__ __forceinline__ XcdBarrier xcd_barrier_post(unsigned* bar, volatile LAS unsigned* st) {
    XcdBarrier b; b.bar = bar; b.x = xb_xcc_id(); b.st = st;
    if (threadIdx.x == 0) (void)xb_add(&bar[XB_XCNT(b.x)], 1u);
    return b;
}
__device__ __forceinline__ void xcd_barrier_complete(unsigned* bar, unsigned x, unsigned& nloc, unsigned& nx) {
    const unsigned G = gridDim.x * gridDim.y * gridDim.z;
    unsigned sum, cnt, mine, sp = 0u;
    for (;;) {
        sum = 0u; cnt = 0u; mine = 0u;
#pragma unroll
        for (unsigned j = 0; j < 16; ++j) { const unsigned c = xb_ld(&bar[XB_XCNT(j)]); sum += c; cnt += (c > 0u) ? 1u : 0u; mine = (j == x) ? c : mine; }
        if (sum == G) break;
        __builtin_amdgcn_s_sleep(1);
        if ((++sp & 255u) == 0u) { if (xb_ld(&bar[XB_TMO])) break; if (sp > XB_SPIN_CAP) { atomicAdd(&bar[XB_TMO], 1u); break; } }
    }
    nloc = mine > 0u ? mine : 1u; nx = cnt > 0u ? cnt : 1u;
}
__device__ __noinline__ void xcd_barrier_(unsigned* bbar, unsigned bx, volatile LAS unsigned* bst) {
    XcdBarrier b; b.bar = bbar; b.x = bx; b.st = bst;
    asm volatile("s_waitcnt vmcnt(0)" ::: "memory");
    __syncthreads();
    if (threadIdx.x == 0) {
        unsigned* bar = b.bar;
        __builtin_amdgcn_s_waitcnt(0);
        unsigned nloc = b.st[0], nx = b.st[1];
        if (nloc == 0u) { xcd_barrier_complete(bar, b.x, nloc, nx); b.st[0] = nloc; b.st[1] = nx; }
        const unsigned old = xb_add(&bar[XB_XSUB(b.x)], 1u);
        const unsigned gen = old / nloc;
        if (old + 1u == (gen + 1u) * nloc) {
            __builtin_amdgcn_fence(__ATOMIC_RELEASE, "agent");
            asm volatile("s_waitcnt vmcnt(0)" ::: "memory");
            const unsigned og = xb_add(&bar[XB_TOP], 1u);
            const unsigned tg = og / nx;
            if (og + 1u == (tg + 1u) * nx) xb_add(&bar[XB_TOPGEN], 1u);
            else XB_SPIN(xb_ld(&bar[XB_TOPGEN]) == tg, bar);
            __builtin_amdgcn_fence(__ATOMIC_ACQUIRE, "agent");
            xb_add(&bar[XB_XGEN(b.x)], 1u);
            asm volatile("s_waitcnt vmcnt(0)" ::: "memory");
        } else {
            XB_SPIN(xb_ld(&bar[XB_XGEN(b.x)]) == gen, bar);
            __builtin_amdgcn_fence(__ATOMIC_ACQUIRE, "agent");
            asm volatile("s_waitcnt vmcnt(0)" ::: "memory");
        }
    }
    __syncthreads();
}

#ifndef REPMASK
#define REPMASK 0
#endif
#define REPLOOP(i) _Pragma("unroll 1") for (int rep_ = 0; rep_ < 1 + ((REPMASK >> (i)) & 1); ++rep_)
__global__ __launch_bounds__(512, 2) void mega(Params P) {
    extern __shared__ __attribute__((aligned(16))) unsigned char shm[];
    LAS unsigned char* lds = (LAS unsigned char*)shm;
    cg::grid_group grid = cg::this_grid();
    if (threadIdx.x == 0) *(LAS u32x4*)(lds + 147456) = (u32x4){0u, 0u, 0u, 0u};
    __syncthreads();
    const XcdBarrier xb = xcd_barrier_post((unsigned*)(P.ws + OFF_BAR), (volatile LAS unsigned*)(lds + 147456));
    const int G = gridDim.x, c = blockIdx.x;
    unsigned char* ws = P.ws;
    float* X = P.out;
    bf16_t* H = (bf16_t*)(ws + OFF_H);
    const float* MOD = (const float*)(ws + OFF_MOD);

    REPLOOP(12) phase0(P, lds);
    grid.sync();
    for (int l = 0; l < 2; ++l) {
        const float* mod = MOD + (size_t)l * 3 * 6144;
        const bool hide = (G == 256);
        { const int te = hide ? (l == 0 ? 1856 : 0) : 4992; if (te > 0) convert_weights(P, l, lds, 0, te, c, G); }
        REPLOOP(1) norm_phase(X, P.norm1 + l * 1024, mod, 0, 1024, H);
        REPLOOP(11) xcd_barrier_(xb.bar, xb.x, xb.st);
        REPLOOP(2) { Sched S{(const char*)H, (const char*)(ws + OFF_WIN), 1024, 1024, 0, 48, 14, G, c, 256};
          EpiIn E{(bf16_t*)(ws + OFF_XAQ), (bf16_t*)(ws + OFF_XC), (bf16_t*)(ws + OFF_KB), (bf16_t*)(ws + OFF_VB), P.out + OUT_K, P.out + OUT_V, (const float*)(ws + OFF_ROPE), l};
          gemm_phase(lds, S, 1024, E); }
        if (hide && l == 0 && c >= 160) convert_weights(P, l, lds, 1856, 2624, c - 160, G - 160);
        REPLOOP(11) xcd_barrier_(xb.bar, xb.x, xb.st);
        REPLOOP(3) pool_phase((const bf16_t*)(ws + OFF_XC), (bf16_t*)(ws + OFF_PL));
        for (int it = c; it < 1280; it += G) {
            if (it < 256) { REPLOOP(4) attn_unit(P, l, it, lds); }
            else if (it < 512) { const int v = it - 256; REPLOOP(5) lru_unit<0, 4>(P, l, v >> 3, 0, v & 7, lds); }
            else if (it < 768) { const int q = it - 512; REPLOOP(5) lru_unit<1, 2>(P, l, 32 + (q >> 7), (q >> 3) & 15, q & 7, lds); }
            else { REPLOOP(7) attn_unit(P, l, it - 768 + 256, lds); }
        }
        REPLOOP(11) xcd_barrier_(xb.bar, xb.x, xb.st);
        { Sched S{(const char*)(ws + OFF_PL), (const char*)(ws + OFF_PW), 1024, 256, 256, 48, 4, G, c, 256};
          EpiPool E{(bf16_t*)(ws + OFF_XC), P.pool_scale + l * 1024};
          gemm_phase(lds, S, 256, E); }
#ifndef NO_LRU
        for (int it = G - 1 - c; it < 256; it += G) lru_unit<0, 2>(P, l, 32 + (it >> 7), (it >> 3) & 15, it & 7, lds);
#endif
        REPLOOP(11) xcd_barrier_(xb.bar, xb.x, xb.st);
        REPLOOP(6) { MergeSched S{(const char*)ws, 1024, 1024, c};
          EpiMerge E{(bf16_t*)(ws + OFF_GT), P.b_gate + l * 3072, (float*)(ws + OFF_XAQ), (bf16_t*)(ws + OFF_PL)};
          gemm_phase(lds, S, 1024, E); }
        if (hide && c >= 192) convert_weights(P, l, lds, 2624, 4992, c - 192, G - 192);
        REPLOOP(11) xcd_barrier_(xb.bar, xb.x, xb.st);
        { Sched S{(const char*)(ws + OFF_PL), (const char*)(ws + OFF_WOUT), 1024, 1024, 0, 64, 4, G, c, 192};
          EpiRes E{X, mod, 2048};
          gemm_phase<EpiRes, Sched, true>(lds, S, 1024, E); }
        REPLOOP(11) xcd_barrier_(xb.bar, xb.x, xb.st);
        norm_phase(X, P.norm2 + l * 1024, mod, 3072, 4096, H);
        REPLOOP(11) xcd_barrier_(xb.bar, xb.x, xb.st);
        REPLOOP(9) { Sched S{(const char*)H, (const char*)(ws + OFF_WUP), 1024, 1024, 0, 48, 22, G, c, 256};
          EpiBf E{(bf16_t*)(ws + OFF_U), 5632};
          gemm_phase(lds, S, 1024, E); }
        if (hide && l == 0 && c >= 32) convert_weights(P, l + 1, lds, 0, 2624, c - 32, G - 32);
        REPLOOP(11) xcd_barrier_(xb.bar, xb.x, xb.st);
        REPLOOP(10) act_phase((const bf16_t*)(ws + OFF_U), (bf16_t*)(ws + OFF_ACT), P.ffn_conv + (size_t)l * 3 * 2816, P.ffn_conv_b + l * 2816);
        REPLOOP(11) xcd_barrier_(xb.bar, xb.x, xb.st);
        { Sched S{(const char*)(ws + OFF_ACT), (const char*)(ws + OFF_WDN), 2816, 2816, 0, 64, 4, G, c, 192};
          EpiRes E{X, mod, 5120};
          gemm_phase<EpiRes, Sched, true>(lds, S, 2816, E); }
        REPLOOP(11) xcd_barrier_(xb.bar, xb.x, xb.st);
    }
    final_norm_phase(X, P.final_norm);
}

extern "C" void kernel_launch(void* const* d_in, const int* in_sizes, int n_in, void* d_out, int out_size, void* d_ws, size_t ws_size, hipStream_t stream) {
    constexpr size_t kDynLds = 147456 + 16;
    static int grid_blocks = 0;
    if (!grid_blocks) {
        int dev = 0, cus = 0, per_cu = 0;
        hipGetDevice(&dev);
        hipDeviceGetAttribute(&cus, hipDeviceAttributeMultiprocessorCount, dev);
        hipFuncSetAttribute((const void*)mega, hipFuncAttributeMaxDynamicSharedMemorySize, (int)kDynLds);
        hipOccupancyMaxActiveBlocksPerMultiprocessor(&per_cu, mega, 512, kDynLds);
        if (per_cu < 1) per_cu = 1;
        if (per_cu > 1) per_cu = 1;
        grid_blocks = cus * per_cu;
    }
    Params p{};
    const float** pp = (const float**)&p;
    for (int i = 0; i < 30; ++i) pp[i] = (const float*)d_in[i];
    p.out = (float*)d_out; p.ws = (unsigned char*)d_ws;
    if (ws_size < OFF_END) { fprintf(stderr, "workspace too small: %zu < %zu\n", ws_size, (size_t)OFF_END); }
    hipMemsetAsync((unsigned char*)d_ws + OFF_BAR, 0, 16384, stream);
    void* args[] = {&p};
    hipError_t e = hipLaunchCooperativeKernel((void*)mega, dim3(grid_blocks), dim3(512), args, kDynLds, stream);
    if (e != hipSuccess) fprintf(stderr, "cooperative launch failed: %s (grid %d)\n", hipGetErrorString(e), grid_blocks);
}
```

```cpp
#include <hip/hip_runtime.h>
#include <hip/hip_cooperative_groups.h>
#include <cstdio>
namespace cg = cooperative_groups;

#define LAS __attribute__((address_space(3)))
typedef unsigned short bf16_t;
typedef short bf16x8 __attribute__((ext_vector_type(8)));
typedef float f32x4 __attribute__((ext_vector_type(4)));
typedef unsigned u32x4 __attribute__((ext_vector_type(4)));
typedef unsigned u32x2 __attribute__((ext_vector_type(2)));
typedef short bf16x4 __attribute__((ext_vector_type(4)));

constexpr int MROWS = 12288, MCTX = 8192;
constexpr size_t S24 = (size_t)MROWS * 1024 * 2;
constexpr size_t OFF_WIN = 0;
constexpr size_t OFF_WBR = OFF_WIN + (size_t)6656 * 1024 * 2;
constexpr size_t OFF_WOUT = OFF_WBR + (size_t)3 * 1024 * 1024 * 2;
constexpr size_t OFF_WUP = OFF_WOUT + (size_t)1024 * 1024 * 2;
constexpr size_t OFF_WDN = OFF_WUP + (size_t)5632 * 1024 * 2;
constexpr size_t OFF_GW = OFF_WDN + (size_t)1024 * 2816 * 2;
constexpr size_t OFF_PW = OFF_GW + (size_t)2 * 8 * 256 * 128 * 2;
constexpr size_t OFF_MOD = OFF_PW + (size_t)4 * 256 * 256 * 2;
constexpr size_t OFF_CK = OFF_MOD + (size_t)2 * 3 * 6144 * 4;
constexpr size_t OFF_CV = OFF_CK + (size_t)2 * 2 * 512 * 256 * 2;
constexpr size_t OFF_ROPE = OFF_CV + (size_t)2 * 2 * 512 * 256 * 2;
constexpr size_t OFF_SUMM = OFF_ROPE + (size_t)2 * 64 * 32 * 4;
constexpr size_t OFF_BAR = OFF_SUMM + (size_t)2 * 2 * 16 * 1024 * 2 * 4;
constexpr size_t OFF_ACT0 = OFF_BAR + 16384;
constexpr size_t OFF_XAQ = OFF_ACT0;
constexpr size_t OFF_XC = OFF_XAQ + 2 * S24;
constexpr size_t OFF_KB = OFF_XC + S24;
constexpr size_t OFF_VB = OFF_KB + (size_t)MROWS * 256 * 2;
constexpr size_t OFF_GT = OFF_VB + (size_t)MROWS * 256 * 2;
constexpr size_t OFF_YB = OFF_GT + S24;
constexpr size_t OFF_PL = OFF_YB + S24;
constexpr size_t OFF_YA = OFF_PL + S24;
constexpr size_t OFF_H = OFF_YA + S24;
constexpr size_t OFF_END = OFF_H + S24;
constexpr size_t OFF_U = OFF_XAQ;
constexpr size_t OFF_ACT = OFF_PL;
constexpr size_t OUT_K = (size_t)MROWS * 1024;
constexpr size_t OUT_V = OUT_K + (size_t)32 * 2 * 256 * 256;
constexpr size_t OUT_H = OUT_V + (size_t)32 * 2 * 256 * 256;

struct Params {
    const float *x_prompt, *x_sample, *cache_k, *cache_v, *state_lru, *c, *c_ctx, *w_ada, *b_ada, *norm1, *norm2,
        *w_in, *b_gate, *lru_conv, *lru_conv_b, *lru_wa, *lru_ba, *lru_wx, *lru_bx, *lru_lambda, *attn_sink,
        *pool_w, *pool_scale, *w_branch, *w_out, *ffn_up, *ffn_conv, *ffn_conv_b, *ffn_down, *final_norm;
    float* out; unsigned char* ws;
};

typedef float f32x2_ __attribute__((ext_vector_type(2)));
typedef __bf16 bf16x2_ __attribute__((ext_vector_type(2)));
__device__ __forceinline__ unsigned pack2(float a, float b) { const f32x2_ v = {a, b}; const bf16x2_ r = __builtin_convertvector(v, bf16x2_); return __builtin_bit_cast(unsigned, r); }
__device__ __forceinline__ unsigned short f2bf(float f) { return (unsigned short)(pack2(f, f) & 0xffffu); }
__device__ __forceinline__ float bf2f(unsigned short b) { return __uint_as_float(((unsigned)b) << 16); }
__device__ __forceinline__ int otid() { int t = threadIdx.x; asm volatile("" : "+v"(t)); return t; }
__device__ __forceinline__ float sigmoidf_(float x) { return __builtin_amdgcn_rcpf(1.0f + __expf(-x)); }

constexpr int HTB = 128 * 64 * 2;
__device__ __forceinline__ int lds_byte(int r, int c) { const int st = (r >> 4) * 2 + (c >> 5), rr = r & 15, cc = c & 31, ob = rr * 64 + cc * 2; return st * 1024 + (ob ^ (((ob >> 9) & 1) << 5)); }
__device__ __forceinline__ void stage_rc(int b, int& R, int& C) { const int st = b / 1024, sb = b % 1024, swz = sb ^ (((sb >> 9) & 1) << 5); R = (st >> 1) * 16 + swz / 64; C = (st & 1) * 32 + (swz % 64) / 2; }

struct Unit { const char* a; const char* b; int pm, pn, z, row0, m192; };
struct Sched {
    const char* A; const char* B; int lda, ldb, acol, nM, nN, G, c, tm;
    __device__ __forceinline__ bool next(int i, Unit& u) const {
        const long L = (long)i * G + c; const int nwg = nM * nN; if (L >= nwg) return false;
        int wgid = (int)L; { const int q = nwg / 8, r = nwg % 8, xcd = wgid % 8, off = wgid / 8; wgid = (xcd < r ? xcd * (q + 1) : r * (q + 1) + (xcd - r) * q) + off; }
        const int nig = 8 * nN, gid = wgid / nig, fm = gid * 8, gsz = (nM - fm) < 8 ? (nM - fm) : 8;
        u.pm = fm + ((wgid % nig) % gsz); u.pn = (wgid % nig) / gsz;
        u.a = A + ((size_t)u.pm * tm * lda + (size_t)u.pn * acol) * 2; u.b = B + (size_t)u.pn * 256 * ldb * 2; u.z = 0; u.row0 = u.pm * tm; u.m192 = (tm == 192); return true;
    }
};
struct MergeSched {
    const char* ws; int lda, ldb, c;
    __device__ __forceinline__ bool next(int i, Unit& u) const {
        if (c >= 192 || i >= 6) return false;
        const int nN = 4;
        int wgid = c; { const int q = 24, xcd = wgid % 8, off = wgid / 8; wgid = xcd * q + off; }
        const int nig = 8 * nN, gid = wgid / nig, fm = gid * 8;
        u.pm = fm + ((wgid % nig) % 8); u.pn = (wgid % nig) / 8; u.z = i; u.row0 = u.pm * 256; u.m192 = 0;
        const int j = i >> 1;
        const size_t aoff = (size_t)u.row0 * 1024 * 2;
        size_t ao = OFF_H, bo = OFF_WIN + (size_t)3584 * 1024 * 2;
        if (i & 1) { bo = OFF_WBR; ao = OFF_YA; if (j == 1) ao = OFF_YB; if (j == 2) ao = OFF_XC; }
        u.a = ws + ao + aoff; u.b = ws + bo + ((size_t)j * 1024 + (size_t)u.pn * 256) * 1024 * 2;
        return true;
    }
};

template <class Epi, class SchedT, bool M192 = false>
__device__ __forceinline__ void gemm_phase(LAS unsigned char* lds, const SchedT& S, const int K_, const Epi& E) {
    int K = K_; asm volatile("" : "+s"(K));
    int tid_ = threadIdx.x; asm volatile("" : "+v"(tid_));
    const int tid = tid_, wid = __builtin_amdgcn_readfirstlane(tid >> 6), lane = tid & 63, wr = wid >> 2, wc = wid & 3, fr = lane & 15, fq = lane >> 4;
    const int nt = K / 64;
    unsigned voffA[2], voffB[2];
#pragma unroll
    for (int i = 0; i < 2; ++i) { int R, C; stage_rc(tid * 16 + i * 8192, R, C); voffA[i] = (unsigned)(R * S.lda + C) * 2u; voffB[i] = (unsigned)(R * S.ldb + C) * 2u; }
    const size_t kstep = 128;
    const size_t hstepA = (size_t)128 * S.lda * 2, hstepB = (size_t)128 * S.ldb * 2;
    const unsigned ldsw = (unsigned)wid * 1024u;
    const int aoff = lds_byte(wr * 64 + fr, fq * 8), boff = lds_byte(wc * 32 + fr, fq * 8);
#define G_SA(b, h) (((b) * 2 + (h)) * HTB)
#define G_SB(b, h) ((4 + (b) * 2 + (h)) * HTB)
#define G_STAGE(bufoff, gbase, voff) do { _Pragma("unroll") for (int _i = 0; _i < 2; ++_i) \
        __builtin_amdgcn_global_load_lds((const unsigned*)((const char*)(gbase) + (voff)[_i]), (LAS unsigned*)(lds + (bufoff) + ldsw + _i * 8192), 16, 0, 0); } while (0)
#define G_LDA(dst, b, h) do { _Pragma("unroll") for (int m = 0; m < 4; ++m) _Pragma("unroll") for (int k = 0; k < 2; ++k) dst[m][k] = *(const LAS bf16x8*)(lds + G_SA(b, h) + aoff + m * 2048 + k * 1024); } while (0)
#define G_LDB(dst, b, h) do { _Pragma("unroll") for (int n = 0; n < 2; ++n) _Pragma("unroll") for (int k = 0; k < 2; ++k) dst[n][k] = *(const LAS bf16x8*)(lds + G_SB(b, h) + boff + n * 2048 + k * 1024); } while (0)
#define G_MMA(ai, bj, At, Bt) do { if (M192 && (ai) == 1 && wr == 1) break; __builtin_amdgcn_s_setprio(1); _Pragma("unroll") for (int m = 0; m < 4; ++m) _Pragma("unroll") for (int n = 0; n < 2; ++n) _Pragma("unroll") for (int k = 0; k < 2; ++k) \
        acc[ai][bj][m][n] = __builtin_amdgcn_mfma_f32_16x16x32_bf16(Bt[n][k], At[m][k], acc[ai][bj][m][n], 0, 0, 0); __builtin_amdgcn_s_setprio(0); } while (0)
#define G_WAIT_V(n) asm volatile("s_waitcnt vmcnt(" #n ")" ::: "memory")
#define G_WAIT_L(n) asm volatile("s_waitcnt lgkmcnt(" #n ")" ::: "memory")
#define G_BAR __builtin_amdgcn_s_barrier()
#define G_SCHED __builtin_amdgcn_sched_barrier(0)
    Unit cur, nxt; int ui = 0;
    if (!S.next(0, cur)) return;
    f32x4 acc[2][2][4][2];
#pragma unroll
    for (int a = 0; a < 2; ++a)
#pragma unroll
        for (int b = 0; b < 2; ++b)
#pragma unroll
            for (int m = 0; m < 4; ++m)
#pragma unroll
                for (int n = 0; n < 2; ++n) acc[a][b][m][n] = (f32x4){0.f, 0.f, 0.f, 0.f};
    bf16x8 At[4][2], B0[2][2], B1[2][2];
    const char* cA = cur.a; const char* cB = cur.b;
    G_STAGE(G_SB(0, 0), cB, voffB); G_STAGE(G_SA(0, 0), cA, voffA); G_STAGE(G_SB(0, 1), cB + hstepB, voffB); G_STAGE(G_SA(0, 1), cA + hstepA, voffA);
    if (wr == 1) G_BAR;
    G_WAIT_V(4); G_BAR;
    G_STAGE(G_SB(1, 0), cB + kstep, voffB); G_STAGE(G_SA(1, 0), cA + kstep, voffA); G_STAGE(G_SB(1, 1), cB + hstepB + kstep, voffB);
    G_WAIT_V(6); G_BAR;
    for (;;) {
        const bool has_next = S.next(ui + 1, nxt);
        const char* nA = has_next ? nxt.a : cA; const char* nB = has_next ? nxt.b : cB;
        for (int t = 0; t < nt; t += 2) {
            const bool last = (t == nt - 2);
            const char* a1 = cA + (size_t)(t + 1) * kstep;
            const char* a2 = last ? nA : cA + (size_t)(t + 2) * kstep; const char* b2 = last ? nB : cB + (size_t)(t + 2) * kstep;
            const char* a3 = a2 + kstep; const char* b3 = b2 + kstep;
            G_LDB(B0, 0, 0); G_SCHED; G_LDA(At, 0, 0); G_STAGE(G_SA(1, 1), a1 + hstepA, voffA);
            G_WAIT_L(8); G_BAR; G_WAIT_L(0); G_MMA(0, 0, At, B0); G_BAR; G_SCHED;
            G_LDB(B1, 0, 1); G_STAGE(G_SB(0, 0), b2, voffB);
            G_BAR; G_WAIT_L(0); G_MMA(0, 1, At, B1); G_BAR;
            G_LDA(At, 0, 1); G_STAGE(G_SA(0, 0), a2, voffA);
            G_BAR; G_WAIT_L(0); G_MMA(1, 0, At, B0); G_BAR; G_SCHED;
            G_STAGE(G_SB(0, 1), b2 + hstepB, voffB);
            G_WAIT_V(6); G_BAR; G_MMA(1, 1, At, B1); G_BAR;
            G_LDB(B0, 1, 0); G_SCHED; G_LDA(At, 1, 0); G_STAGE(G_SA(0, 1), a2 + hstepA, voffA);
            G_WAIT_L(8); G_BAR; G_WAIT_L(0); G_MMA(0, 0, At, B0); G_BAR; G_SCHED;
            G_LDB(B1, 1, 1); G_STAGE(G_SB(1, 0), b3, voffB);
            G_BAR; G_WAIT_L(0); G_MMA(0, 1, At, B1); G_BAR;
            G_LDA(At, 1, 1); G_STAGE(G_SA(1, 0), a3, voffA);
            G_BAR; G_WAIT_L(0); G_MMA(1, 0, At, B0); G_BAR; G_SCHED;
            G_STAGE(G_SB(1, 1), b3 + hstepB, voffB);
            G_WAIT_V(6); G_BAR; G_MMA(1, 1, At, B1); G_BAR;
        }
        E(acc, cur, wr, wc, fr, fq);
        if (!has_next) break;
#pragma unroll
        for (int a = 0; a < 2; ++a)
#pragma unroll
            for (int b = 0; b < 2; ++b)
#pragma unroll
                for (int m = 0; m < 4; ++m)
#pragma unroll
                    for (int n = 0; n < 2; ++n) acc[a][b][m][n] = (f32x4){0.f, 0.f, 0.f, 0.f};
        cur = nxt; cA = nA; cB = nB; ++ui;
    }
    G_WAIT_V(0);
    if (wr == 0) G_BAR;
    G_BAR;
#undef G_SA
#undef G_SB
#undef G_STAGE
#undef G_LDA
#undef G_LDB
#undef G_MMA
#undef G_WAIT_V
#undef G_WAIT_L
#undef G_BAR
#undef G_SCHED
}

#define EPI_LOOP_BEGIN \
    _Pragma("unroll") for (int ai = 0; ai < 2; ++ai) _Pragma("unroll") for (int m = 0; m < 4; ++m) { const int row = u.pm * 256 + wr * 64 + fr + ai * 128 + m * 16; \
    _Pragma("unroll") for (int bj = 0; bj < 2; ++bj) _Pragma("unroll") for (int n = 0; n < 2; ++n) { const int cl = wc * 32 + 4 * fq + bj * 128 + n * 16; const f32x4 v = acc[ai][bj][m][n];
#define EPI_LOOP_END } }

__device__ __forceinline__ int seq_group(int row) { return row < MCTX ? 0 : 1 + ((row - MCTX) >> 11); }

struct EpiIn {
    bf16_t* xaq; bf16_t* xc; bf16_t* kb; bf16_t* vb; float* outk; float* outv; const float* rc; int l;
    __device__ __forceinline__ void operator()(const f32x4 (&acc)[2][2][4][2], const Unit& u, int wr, int wc, int fr, int fq) const {
        const int pn = u.pn; const bool qk = pn >= 4 && pn <= 8;
        bf16_t* dst; int ld, cbase; float* fo = nullptr;
        if (pn < 4) { dst = xaq; ld = 1024; cbase = pn * 256; }
        else if (pn < 8) { dst = xaq + (size_t)MROWS * 1024; ld = 1024; cbase = pn * 256 - 1024; }
        else if (pn == 8) { dst = kb; ld = 256; cbase = 0; fo = outk; }
        else if (pn == 9) { dst = vb; ld = 256; cbase = 0; fo = outv; }
        else { dst = xc; ld = 1024; cbase = pn * 256 - 2560; }
        const int hh = wc >> 1, i0 = 16 * (wc & 1) + 4 * fq;
        const int c1 = cbase + (qk ? 64 * hh + i0 : wc * 32 + 4 * fq), dc = qk ? 32 : 16;
        const bool rope = qk && u.pm >= 32;
#pragma unroll
        for (int ai = 0; ai < 2; ++ai) {
            f32x4 csm[4], snm[4];
#pragma unroll
            for (int m = 0; m < 4; ++m) { csm[m] = (f32x4){1.f, 1.f, 1.f, 1.f}; snm[m] = (f32x4){0.f, 0.f, 0.f, 0.f};
                if (rope) { const int row = u.pm * 256 + wr * 64 + fr + ai * 128 + m * 16; const int t = (row - MCTX) & 2047; const int pos = hh == 0 ? (t >> 6) : (t & 63);
                    csm[m] = *(const f32x4*)(rc + pos * 32 + i0); snm[m] = *(const f32x4*)(rc + 2048 + pos * 32 + i0); } }
#pragma unroll
            for (int m = 0; m < 4; ++m) {
                const int row = u.pm * 256 + wr * 64 + fr + ai * 128 + m * 16;
                const f32x4 cs = csm[m], sn = snm[m];
                bf16_t* dp = dst + (size_t)row * ld + c1;
                float* fp = fo + ((size_t)(((row >> 8) * 2 + l) * 256 + (row & 255))) * 256 + c1;
#pragma unroll
                for (int bj = 0; bj < 2; ++bj) {
                    const f32x4 x1 = acc[ai][bj][m][0], x2 = acc[ai][bj][m][1];
                    const f32x4 o1 = x1 * cs - x2 * sn, o2 = x1 * sn + x2 * cs;
                    uint2 p1, p2; p1.x = pack2(o1[0], o1[1]); p1.y = pack2(o1[2], o1[3]); p2.x = pack2(o2[0], o2[1]); p2.y = pack2(o2[2], o2[3]);
                    *(uint2*)(dp + bj * 128) = p1; *(uint2*)(dp + bj * 128 + dc) = p2;
                    if (fo != nullptr && row < MCTX) { *(f32x4*)(fp + bj * 128) = o1; *(f32x4*)(fp + bj * 128 + dc) = o2; }
                }
            }
        }
    }
};
struct EpiGate {
    bf16_t* gt; const float* bias;
    __device__ __forceinline__ void operator()(const f32x4 (&acc)[2][2][4][2], const Unit& u, int wr, int wc, int fr, int fq) const {
        const int c0 = u.pn * 256 + wc * 32 + 4 * fq;
        f32x4 bb[4];
#pragma unroll
        for (int g = 0; g < 4; ++g) bb[g] = *(const f32x4*)(bias + c0 + (g >> 1) * 128 + (g & 1) * 16);
#pragma unroll
        for (int ai = 0; ai < 2; ++ai) { if (ai == 1 && u.m192 && wr == 1) continue;
#pragma unroll
            for (int m = 0; m < 4; ++m) { const int row = u.row0 + wr * 64 + fr + ai * 128 + m * 16;
#pragma unroll
                for (int g = 0; g < 4; ++g) { const f32x4 v = acc[ai][g >> 1][m][g & 1];
                    uint2 pk; pk.x = pack2(sigmoidf_(v[0] + bb[g][0]), sigmoidf_(v[1] + bb[g][1])); pk.y = pack2(sigmoidf_(v[2] + bb[g][2]), sigmoidf_(v[3] + bb[g][3]));
                    *(uint2*)(gt + (size_t)row * 1024 + c0 + (g >> 1) * 128 + (g & 1) * 16) = pk; } } }
    }
};
template <int j> struct EpiBranch {
    const bf16_t* gt; float* tmp; bf16_t* mg;
    __device__ __forceinline__ void operator()(const f32x4 (&acc)[2][2][4][2], const Unit& u, int wr, int wc, int fr, int fq) const {
        const int c0 = u.pn * 256 + wc * 32 + 4 * fq;
#pragma unroll
        for (int ai = 0; ai < 2; ++ai) { if (ai == 1 && u.m192 && wr == 1) continue;
#pragma unroll
            for (int m = 0; m < 4; ++m) {
                const unsigned ro = (unsigned)(u.row0 + wr * 64 + fr + ai * 128 + m * 16) * 1024u + (unsigned)c0;
                uint2 gp[4]; f32x4 tv[4];
#pragma unroll
                for (int g = 0; g < 4; ++g) { const unsigned o = ro + (g >> 1) * 128 + (g & 1) * 16;
                    gp[g] = *(const uint2*)(gt + o); tv[g] = (f32x4){0.f, 0.f, 0.f, 0.f}; if (j != 0) tv[g] = *(const f32x4*)(tmp + o); }
#pragma unroll
                for (int g = 0; g < 4; ++g) { const unsigned o = ro + (g >> 1) * 128 + (g & 1) * 16;
                    const f32x4 v = acc[ai][g >> 1][m][g & 1];
                    f32x4 r = tv[g];
                    r[0] += v[0] * bf2f((unsigned short)(gp[g].x & 0xffff)); r[1] += v[1] * bf2f((unsigned short)(gp[g].x >> 16));
                    r[2] += v[2] * bf2f((unsigned short)(gp[g].y & 0xffff)); r[3] += v[3] * bf2f((unsigned short)(gp[g].y >> 16));
                    if (j != 2) *(f32x4*)(tmp + o) = r;
                    else { uint2 pk; pk.x = pack2(r[0], r[1]); pk.y = pack2(r[2], r[3]); *(uint2*)(mg + o) = pk; } }
            } }
    }
};
struct EpiMerge {
    bf16_t* gt; const float* bgate; float* tmp; bf16_t* mg;
    __device__ __forceinline__ void operator()(const f32x4 (&acc)[2][2][4][2], const Unit& u, int wr, int wc, int fr, int fq) const {
        const int j = u.z >> 1;
        if ((u.z & 1) == 0) { EpiGate E{gt, bgate + j * 1024}; E(acc, u, wr, wc, fr, fq); }
        else if (j == 0) { EpiBranch<0> E{gt, tmp, mg}; E(acc, u, wr, wc, fr, fq); }
        else if (j == 1) { EpiBranch<1> E{gt, tmp, mg}; E(acc, u, wr, wc, fr, fq); }
        else { EpiBranch<2> E{gt, tmp, mg}; E(acc, u, wr, wc, fr, fq); }
    }
};
struct EpiRes {
    float* x; const float* mod; int goff; const float* xa; const float* xb;
    __device__ __forceinline__ const float* src(unsigned o) const { return o < (unsigned)MCTX * 1024u ? xa + o : xb + (o - (unsigned)MCTX * 1024u); }
    __device__ __forceinline__ void operator()(const f32x4 (&acc)[2][2][4][2], const Unit& u, int wr, int wc, int fr, int fq) const {
        const int c0 = u.pn * 256 + wc * 32 + 4 * fq;
        const int sg0 = seq_group(u.row0), sg1 = seq_group(u.row0 + (u.m192 ? 191 : 255));
        if (sg0 == sg1) {
            const float* gsrc = mod + sg0 * 6144 + goff;
            f32x4 gg[4];
#pragma unroll
            for (int g = 0; g < 4; ++g) gg[g] = *(const f32x4*)(gsrc + c0 + (g >> 1) * 128 + (g & 1) * 16);
#pragma unroll
            for (int ai = 0; ai < 2; ++ai) { if (ai == 1 && u.m192 && wr == 1) continue;
#pragma unroll
                for (int mp = 0; mp < 2; ++mp) {
                    const unsigned ro = (unsigned)(u.row0 + wr * 64 + fr + ai * 128 + mp * 32) * 1024u + (unsigned)c0;
                    f32x4 xv[8];
#pragma unroll
                    for (int k = 0; k < 8; ++k) { const int g = k & 3; xv[k] = *(const f32x4*)src(ro + (k >> 2) * 16384 + (g >> 1) * 128 + (g & 1) * 16); }
#pragma unroll
                    for (int k = 0; k < 8; ++k) { const int g = k & 3, m = mp * 2 + (k >> 2); *(f32x4*)(x + (ro + (k >> 2) * 16384 + (g >> 1) * 128 + (g & 1) * 16)) = xv[k] + gg[g] * acc[ai][g >> 1][m][g & 1]; }
                } }
        } else {
#pragma unroll
            for (int ai = 0; ai < 2; ++ai) { if (ai == 1 && u.m192 && wr == 1) continue;
#pragma unroll
                for (int m = 0; m < 4; ++m) {
                    const int row = u.row0 + wr * 64 + fr + ai * 128 + m * 16;
                    const float* gsrc = mod + seq_group(row) * 6144 + goff + c0;
                    const unsigned ro = (unsigned)row * 1024u + (unsigned)c0;
                    f32x4 xv[4], gv[4];
#pragma unroll
                    for (int g = 0; g < 4; ++g) { xv[g] = *(const f32x4*)src(ro + (g >> 1) * 128 + (g & 1) * 16); gv[g] = *(const f32x4*)(gsrc + (g >> 1) * 128 + (g & 1) * 16); }
#pragma unroll
                    for (int g = 0; g < 4; ++g) *(f32x4*)(x + (ro + (g >> 1) * 128 + (g & 1) * 16)) = xv[g] + gv[g] * acc[ai][g >> 1][m][g & 1];
                } }
        }
    }
};
struct EpiBf {
    bf16_t* dst; int ld;
    __device__ __forceinline__ void operator()(const f32x4 (&acc)[2][2][4][2], const Unit& u, int wr, int wc, int fr, int fq) const {
        EPI_LOOP_BEGIN
            const int col = u.pn * 256 + cl;
            uint2 pk; pk.x = pack2(v[0], v[1]); pk.y = pack2(v[2], v[3]);
            *(uint2*)(dst + (size_t)row * ld + col) = pk;
        EPI_LOOP_END
    }
};
struct EpiPool {
    bf16_t* dst; const float* scale;
    __device__ __forceinline__ void operator()(const f32x4 (&acc)[2][2][4][2], const Unit& u, int wr, int wc, int fr, int fq) const {
        const int c0 = u.pn * 256 + wc * 32 + 4 * fq;
        f32x4 sc[4];
#pragma unroll
        for (int g = 0; g < 4; ++g) sc[g] = *(const f32x4*)(scale + c0 + (g >> 1) * 128 + (g & 1) * 16);
#pragma unroll
        for (int ai = 0; ai < 2; ++ai)
#pragma unroll
            for (int m = 0; m < 4; ++m) { const int row = u.pm * 256 + wr * 64 + fr + ai * 128 + m * 16;
#pragma unroll
                for (int g = 0; g < 4; ++g) { const f32x4 v = acc[ai][g >> 1][m][g & 1] * sc[g];
                    uint2 pk; pk.x = pack2(v[0], v[1]); pk.y = pack2(v[2], v[3]);
                    *(uint2*)(dst + (size_t)row * 1024 + c0 + (g >> 1) * 128 + (g & 1) * 16) = pk; } }
    }
};

struct WPtrs { const float *w_in, *w_branch, *lru_wa, *lru_wx, *pool_w, *w_out, *ffn_up, *ffn_down; unsigned char* ws; };
struct TileDesc { const float* src; int lds_; bf16_t* dst; int ldd, k0, n0, perm; };
__device__ __forceinline__ int swap45(int p) { return (p & ~48) | ((p & 16) << 1) | ((p & 32) >> 1); }
__device__ __forceinline__ TileDesc weight_tile(const WPtrs& P, int l, int t) {
    unsigned char* ws = P.ws; TileDesc d; int r = t; d.perm = 0;
    if (r < 1664) { d.src = P.w_in + (size_t)l * 1024 * 6656; d.lds_ = 6656; d.dst = (bf16_t*)(ws + OFF_WIN); d.ldd = 1024; d.k0 = (r / 104) * 64; d.n0 = (r % 104) * 64; d.perm = (d.n0 >= 1024 && d.n0 < 2304) ? 1 : 0; }
    else if ((r -= 1664) < 128) { const int mat = r / 64; r %= 64; const int dh = r / 4; r %= 4;
        d.src = (mat ? P.lru_wx : P.lru_wa) + (size_t)(l * 16 + dh) * 128 * 128; d.lds_ = 128; d.dst = (bf16_t*)(ws + OFF_GW) + (size_t)dh * 256 * 128 + (size_t)mat * 128 * 128; d.ldd = 128; d.k0 = (r / 2) * 64; d.n0 = (r % 2) * 64; }
    else if ((r -= 128) < 64) { const int g = r / 16; r %= 16; d.src = P.pool_w + (size_t)(l * 4 + g) * 256 * 256; d.lds_ = 256; d.dst = (bf16_t*)(ws + OFF_PW) + (size_t)g * 256 * 256; d.ldd = 256; d.k0 = (r / 4) * 64; d.n0 = (r % 4) * 64; }
    else if ((r -= 64) < 768) { const int j = r / 256; r %= 256; d.src = P.w_branch + (size_t)(l * 3 + j) * 1024 * 1024; d.lds_ = 1024; d.dst = (bf16_t*)(ws + OFF_WBR) + (size_t)j * 1024 * 1024; d.ldd = 1024; d.k0 = (r / 16) * 64; d.n0 = (r % 16) * 64; }
    else if ((r -= 768) < 256) { d.src = P.w_out + (size_t)l * 1024 * 1024; d.lds_ = 1024; d.dst = (bf16_t*)(ws + OFF_WOUT); d.ldd = 1024; d.k0 = (r / 16) * 64; d.n0 = (r % 16) * 64; }
    else if ((r -= 256) < 1408) { d.src = P.ffn_up + (size_t)l * 1024 * 5632; d.lds_ = 5632; d.dst = (bf16_t*)(ws + OFF_WUP); d.ldd = 1024; d.k0 = (r / 88) * 64; d.n0 = (r % 88) * 64; }
    else { r -= 1408; d.src = P.ffn_down + (size_t)l * 2816 * 1024; d.lds_ = 1024; d.dst = (bf16_t*)(ws + OFF_WDN); d.ldd = 2816; d.k0 = (r / 16) * 64; d.n0 = (r % 16) * 64; }
    return d;
}
__device__ __noinline__ void convert_weights_(const float* p0, const float* p1, const float* p2, const float* p3, const float* p4, const float* p5, const float* p6, const float* p7, unsigned char* pws,
                                              int l, LAS unsigned char* lds, int t_begin, int t_end, int first, int stride) {
    const WPtrs P{p0, p1, p2, p3, p4, p5, p6, p7, pws};
    LAS bf16_t* sm = (LAS bf16_t*)lds;
    const int tid = otid();
    const int kk0 = tid >> 4, n4 = (tid & 15) * 4, nn = tid >> 3, ck = tid & 7;
    int t = t_begin + first;
    if (t >= t_end) return;
    TileDesc d = weight_tile(P, l, t);
    f32x4 v0 = *(const f32x4*)(d.src + (size_t)(d.k0 + kk0) * d.lds_ + d.n0 + n4), v1 = *(const f32x4*)(d.src + (size_t)(d.k0 + kk0 + 32) * d.lds_ + d.n0 + n4);
    for (;;) {
        __syncthreads();
#pragma unroll
        for (int e = 0; e < 4; ++e) { sm[(n4 + e) * 72 + kk0] = f2bf(v0[e]); sm[(n4 + e) * 72 + kk0 + 32] = f2bf(v1[e]); }
        __syncthreads();
        const TileDesc cur = d; const int tn = t + stride; const bool more = tn < t_end;
        if (more) { d = weight_tile(P, l, tn); v0 = *(const f32x4*)(d.src + (size_t)(d.k0 + kk0) * d.lds_ + d.n0 + n4); v1 = *(const f32x4*)(d.src + (size_t)(d.k0 + kk0 + 32) * d.lds_ + d.n0 + n4); }
        const u32x4 o = *(const LAS u32x4*)(sm + nn * 72 + ck * 8);
        const int nrow = cur.perm ? swap45(cur.n0 + nn) : (cur.n0 + nn);
        *(u32x4*)(cur.dst + (size_t)nrow * cur.ldd + cur.k0 + ck * 8) = o;
        if (!more) break;
        t = tn;
    }
    __syncthreads();
}

__device__ __forceinline__ void convert_weights(const Params& P, int l, LAS unsigned char* lds, int t_begin, int t_end, int first, int stride) {
    convert_weights_(P.w_in, P.w_branch, P.lru_wa, P.lru_wx, P.pool_w, P.w_out, P.ffn_up, P.ffn_down, P.ws, l, lds, t_begin, t_end, first, stride);
}

__device__ void phase0(const Params& P, LAS unsigned char* lds) {
    const int tid = otid(), G = gridDim.x, c = blockIdx.x;
    { bf16_t* ck = (bf16_t*)(P.ws + OFF_CK); bf16_t* cv = (bf16_t*)(P.ws + OFF_CV);
      for (int i = c * 512 + tid; i < 2 * 2 * 512 * 256; i += G * 512) {
          const int e = i & 255, t = (i >> 8) & 511, b = (i >> 17) & 1, l = i >> 18;
          const size_t si = ((size_t)((b * 2 + l) * 512 + t)) * 256 + e;
          ck[i] = f2bf(P.cache_k[si]); cv[i] = f2bf(P.cache_v[si]); } }
    { float* rc = (float*)(P.ws + OFF_ROPE); float* rs = rc + 2048;
      for (int i = c * 512 + tid; i < 2048; i += G * 512) {
          const int pos = i >> 5, k = i & 31; const float fr = powf(10000.0f, -(float)k / 32.0f); const float ang = (float)pos * fr;
          rc[i] = cosf(ang); rs[i] = sinf(ang); } }
    { LAS float* sv = (LAS float*)lds;
      LAS float* red = sv + 3072;
      __syncthreads();
      for (int i = tid; i < 3072; i += 512) { const int s = i >> 10, k = i & 1023; const float x = s == 0 ? P.c_ctx[k] : P.c[(s - 1) * 1024 + k]; sv[i] = x / (1.0f + expf(-x)); }
      __syncthreads();
      float* mod = (float*)(P.ws + OFF_MOD);
      for (int it = c; it < 384; it += G) {
          const int l = it / 192, cg_ = it % 192, cl = tid & 31, kg = tid >> 5, col = cg_ * 32 + cl;
          const float* w = P.w_ada + (size_t)l * 1024 * 6144 + col;
          float a0 = 0.f, a1 = 0.f, a2 = 0.f;
#pragma unroll 16
          for (int k = kg * 64; k < kg * 64 + 64; ++k) { const float wv = w[(size_t)k * 6144]; a0 += sv[k] * wv; a1 += sv[1024 + k] * wv; a2 += sv[2048 + k] * wv; }
          red[(kg * 3 + 0) * 32 + cl] = a0; red[(kg * 3 + 1) * 32 + cl] = a1; red[(kg * 3 + 2) * 32 + cl] = a2;
          __syncthreads();
          if (tid < 96) { const int s = tid >> 5, cc = tid & 31; float sum = 0.f;
#pragma unroll
              for (int g = 0; g < 16; ++g) sum += red[(g * 3 + s) * 32 + cc];
              mod[(size_t)(l * 3 + s) * 6144 + cg_ * 32 + cc] = sum + P.b_ada[l * 6144 + cg_ * 32 + cc]; }
          __syncthreads();
      } }
}

template <bool FINAL>
__device__ __forceinline__ void norm_rows(float* X, const float* xa, const float* xb, const float* __restrict__ gw, const float* __restrict__ mod, int shift_off, int scale_off, bf16_t* __restrict__ H) {
    const int tid = otid(); const int lane = tid & 63, wv = blockIdx.x * 8 + (tid >> 6), nw = gridDim.x * 8;
    constexpr int R = 3;
    for (int row0 = wv; row0 < MROWS; row0 += R * nw) {
        f32x4 v[R][4];
#pragma unroll
        for (int r = 0; r < R; ++r) { const int row = row0 + r * nw;
#pragma unroll
            for (int i = 0; i < 4; ++i) v[r][i] = row < MROWS ? *(const f32x4*)((row < MCTX ? xa + (size_t)row * 1024 : xb + (size_t)(row - MCTX) * 1024) + i * 256 + lane * 4) : (f32x4){0.f, 0.f, 0.f, 0.f}; }
#pragma unroll
        for (int r = 0; r < R; ++r) { const int row = row0 + r * nw; if (row >= MROWS) continue;
            float ss = 0.f;
#pragma unroll
            for (int i = 0; i < 4; ++i) ss += v[r][i][0] * v[r][i][0] + v[r][i][1] * v[r][i][1] + v[r][i][2] * v[r][i][2] + v[r][i][3] * v[r][i][3];
#pragma unroll
            for (int o = 32; o >= 1; o >>= 1) ss += __shfl_xor(ss, o);
            const float rstd = rsqrtf(ss * (1.0f / 1024.0f) + 1e-6f);
            const float* md = mod + seq_group(row) * 6144;
#pragma unroll
            for (int i = 0; i < 4; ++i) { const int col = i * 256 + lane * 4;
                const f32x4 g = *(const f32x4*)(gw + col);
                if (FINAL) { f32x4 h;
#pragma unroll
                    for (int e = 0; e < 4; ++e) h[e] = v[r][i][e] * rstd * g[e];
                    *(f32x4*)(X + (size_t)row * 1024 + col) = h; }
                else { const f32x4 sc = *(const f32x4*)(md + scale_off + col), sh = *(const f32x4*)(md + shift_off + col);
                    f32x4 h;
#pragma unroll
                    for (int e = 0; e < 4; ++e) h[e] = v[r][i][e] * rstd * g[e] * (1.0f + sc[e]) + sh[e];
                    uint2 pk; pk.x = pack2(h[0], h[1]); pk.y = pack2(h[2], h[3]);
                    *(uint2*)(H + (size_t)row * 1024 + col) = pk; } }
        }
    }
}
__device__ void norm_phase(const float* xa, const float* xb, const float* __restrict__ gw, const float* __restrict__ mod, int shift_off, int scale_off, bf16_t* __restrict__ H) { norm_rows<false>(nullptr, xa, xb, gw, mod, shift_off, scale_off, H); }
__device__ void final_norm_phase(float* X, const float* __restrict__ gw) { norm_rows<true>(X, X, X + (size_t)MCTX * 1024, gw, nullptr, 0, 0, nullptr); }

__device__ void pool_phase(const bf16_t* __restrict__ XC, bf16_t* __restrict__ PL) {
    const int tid = otid();
    for (int idx = blockIdx.x * 512 + tid; idx < (MROWS / 16) * 128; idx += gridDim.x * 512) {
        const int rs = (idx >> 7) * 16, ch = (idx & 127) * 8, g = ch >> 8, half = 1 << g;
        const int T = rs < MCTX ? 256 : 2048, row0 = rs < MCTX ? (rs & ~255) : MCTX + ((rs - MCTX) & ~2047), tl0 = rs - row0;
        const bf16_t* base = XC + (size_t)row0 * 1024 + ch;
        float s[8];
#pragma unroll
        for (int e = 0; e < 8; ++e) s[e] = 0.f;
        { const int lo = max(tl0 - half, 0), hi = min(tl0 + half, T);
          for (int t = lo; t < hi; ++t) { const bf16x8 x = *(const bf16x8*)(base + (size_t)t * 1024);
#pragma unroll
              for (int e = 0; e < 8; ++e) s[e] += bf2f((unsigned short)x[e]); } }
#pragma unroll 4
        for (int i = 0; i < 16; ++i) {
            const int t = tl0 + i;
            const int lo = max(t - half, 0), hi = min(t + half, T);
            const bf16x8 xs = *(const bf16x8*)(base + (size_t)t * 1024);
            const float inv = 1.0f / (float)(hi - lo);
            u32x4 o; o.x = pack2(s[0] * inv - bf2f((unsigned short)xs[0]), s[1] * inv - bf2f((unsigned short)xs[1])); o.y = pack2(s[2] * inv - bf2f((unsigned short)xs[2]), s[3] * inv - bf2f((unsigned short)xs[3]));
            o.z = pack2(s[4] * inv - bf2f((unsigned short)xs[4]), s[5] * inv - bf2f((unsigned short)xs[5])); o.w = pack2(s[6] * inv - bf2f((unsigned short)xs[6]), s[7] * inv - bf2f((unsigned short)xs[7]));
            *(u32x4*)(PL + (size_t)(row0 + t) * 1024 + ch) = o;
            if (t + half < T) { const bf16x8 x = *(const bf16x8*)(base + (size_t)(t + half) * 1024);
#pragma unroll
                for (int e = 0; e < 8; ++e) s[e] += bf2f((unsigned short)x[e]); }
            if (t - half >= 0) { const bf16x8 x = *(const bf16x8*)(base + (size_t)(t - half) * 1024);
#pragma unroll
                for (int e = 0; e < 8; ++e) s[e] -= bf2f((unsigned short)x[e]); }
        }
    }
}
__device__ __forceinline__ float gelu_tanh(float x) { const float y = 0.7978845608028654f * (x + 0.044715f * x * x * x); const float t = 1.0f - 2.0f * __builtin_amdgcn_rcpf(1.0f + __expf(2.0f * y)); return 0.5f * x * (1.0f + t); }
__device__ void act_phase(const bf16_t* __restrict__ U, bf16_t* __restrict__ ACT, const float* __restrict__ cw, const float* __restrict__ cb) {
    const int tid = otid();
    for (int idx = blockIdx.x * 512 + tid; idx < (MROWS / 16) * 352; idx += gridDim.x * 512) {
        const int rs = (idx / 352) * 16, ch = (idx % 352) * 8;
        const int T = rs < MCTX ? 256 : 2048, row0 = rs < MCTX ? (rs & ~255) : MCTX + ((rs - MCTX) & ~2047), tl0 = rs - row0;
        float w0[8], w1[8], w2[8], bb[8];
#pragma unroll
        for (int e = 0; e < 8; ++e) { w0[e] = cw[ch + e]; w1[e] = cw[2816 + ch + e]; w2[e] = cw[5632 + ch + e]; bb[e] = cb[ch + e]; }
        const bf16_t* up = U + (size_t)rs * 5632 + ch;
        const bf16x8 zero = (bf16x8){0, 0, 0, 0, 0, 0, 0, 0};
        bf16x8 um = tl0 > 0 ? *(const bf16x8*)(up - 5632) : zero;
        bf16x8 u0 = *(const bf16x8*)up;
#pragma unroll 4
        for (int i = 0; i < 16; ++i) {
            const bf16x8 un = (tl0 + i < T - 1) ? *(const bf16x8*)(up + (size_t)(i + 1) * 5632) : zero;
            const bf16x8 vv = *(const bf16x8*)(up + (size_t)i * 5632 + 2816);
            float r[8];
#pragma unroll
            for (int e = 0; e < 8; ++e) { const float gff = w0[e] * bf2f((unsigned short)um[e]) + w1[e] * bf2f((unsigned short)u0[e]) + w2[e] * bf2f((unsigned short)un[e]) + bb[e];
                r[e] = gelu_tanh(gff) * bf2f((unsigned short)vv[e]); }
            u32x4 o; o.x = pack2(r[0], r[1]); o.y = pack2(r[2], r[3]); o.z = pack2(r[4], r[5]); o.w = pack2(r[6], r[7]);
            *(u32x4*)(ACT + (size_t)(rs + i) * 2816 + ch) = o;
            um = u0; u0 = un;
        }
    }
}

__device__ __forceinline__ void rope8(bf16x8& x1, bf16x8& x2, const float* __restrict__ cs, const float* __restrict__ sn) {
#pragma unroll
    for (int e = 0; e < 8; ++e) { const float a = bf2f((unsigned short)x1[e]), b = bf2f((unsigned short)x2[e]); const float c = cs[e], s = sn[e];
        x1[e] = (short)f2bf(a * c - b * s); x2[e] = (short)f2bf(a * s + b * c); }
}
constexpr int VT_OFF = 64 * 272;
constexpr int ABUF = 64 * 272 + 64 * 288;
__device__ void attn_unit(const Params& P, int l, int u, LAS unsigned char* lds) {
    int tid_ = threadIdx.x; asm volatile("" : "+v"(tid_));
    const int tid = tid_, w = tid >> 6, lane = tid & 63, fr = lane & 15, fq = lane >> 4;
    const bf16_t* Q = (const bf16_t*)(P.ws + OFF_XAQ) + (size_t)MROWS * 1024;
    const bf16_t* KB = (const bf16_t*)(P.ws + OFF_KB); const bf16_t* VB = (const bf16_t*)(P.ws + OFF_VB);
    const bf16_t* CK = (const bf16_t*)(P.ws + OFF_CK); const bf16_t* CV = (const bf16_t*)(P.ws + OFF_CV);
    bf16_t* YB = (bf16_t*)(P.ws + OFF_YB);
    bool lat; int head, row0, T, qstart, bidx;
    if (u < 256) { lat = true; bidx = u >> 7; const int rem = u & 127; head = rem >> 4; qstart = (rem & 15) * 128; T = 2048; row0 = MCTX + bidx * 2048; }
    else { const int v = u - 256; lat = false; bidx = 0; const int seq = v >> 4, rem = v & 15; head = rem >> 1; qstart = (rem & 1) * 128; T = 256; row0 = seq * 256; }
    const int kvh = head >> 2;
    const int qpos = qstart + w * 16 + fr;
    bf16x8 qf[4];
    { const bf16_t* qp = Q + (size_t)(row0 + qpos) * 1024 + head * 128 + fq * 8;
#pragma unroll
      for (int kk = 0; kk < 4; ++kk) qf[kk] = *(const bf16x8*)(qp + kk * 32); }
    float m_run = P.attn_sink[l * 8 + head] * 1.4426950408889634f; float l_run = (fq == 0) ? 1.0f : 0.0f;
    f32x4 o[8];
#pragma unroll
    for (int dt = 0; dt < 8; ++dt) o[dt] = (f32x4){0.f, 0.f, 0.f, 0.f};
    int wlo = 0, nwt = 4;
    if (lat) { wlo = max(0, qstart - 128); const int whi = min(T, qstart + 256); nwt = (whi - wlo) >> 6; }
    const int ntiles = nwt + (lat ? 8 : 0);
    const float scale = 0.08838834764831845f * 1.4426950408889634f;
    const int lkey = tid >> 3, lp = tid & 7;
    bf16x8 rk[2][2], rv[2][2];
    auto tile_load = [&](int ti, bf16x8 (&k_)[2], bf16x8 (&v_)[2]) {
        const bf16_t* ksrc; const bf16_t* vsrc;
        if (ti < nwt) { const int k0 = wlo + ti * 64; ksrc = KB + (size_t)(row0 + k0) * 256 + kvh * 128; vsrc = VB + (size_t)(row0 + k0) * 256 + kvh * 128; }
        else { const int k0 = (ti - nwt) * 64; const size_t o_ = ((size_t)((l * 2 + bidx) * 512 + k0)) * 256 + kvh * 128; ksrc = CK + o_; vsrc = CV + o_; }
        const bf16_t* kr = ksrc + (size_t)lkey * 256; k_[0] = *(const bf16x8*)(kr + lp * 8); k_[1] = *(const bf16x8*)(kr + (lp + 8) * 8);
        const bf16_t* vr = vsrc + (size_t)lkey * 256; v_[0] = *(const bf16x8*)(vr + lp * 8); v_[1] = *(const bf16x8*)(vr + (lp + 8) * 8); };
    const int krow = (lkey & 32) | ((lkey & 4) << 2) | ((lkey & 24) >> 1) | (lkey & 3);
    auto tile_store = [&](int b, const bf16x8 (&k_)[2], const bf16x8 (&v_)[2]) {
        LAS unsigned char* kb_ = lds + b * ABUF; LAS unsigned char* vb_ = kb_ + VT_OFF;
        *(LAS bf16x8*)(kb_ + krow * 272 + lp * 16) = k_[0]; *(LAS bf16x8*)(kb_ + krow * 272 + (lp + 8) * 16) = k_[1];
        *(LAS bf16x8*)(vb_ + lkey * 288 + lp * 16) = v_[0]; *(LAS bf16x8*)(vb_ + lkey * 288 + (lp + 8) * 16) = v_[1]; };
    tile_load(0, rk[0], rv[0]);
    tile_load(1, rk[1], rv[1]);
    __syncthreads();
    tile_store(0, rk[0], rv[0]);
    tile_load(2, rk[0], rv[0]);
#pragma unroll 2
    for (int ti = 0; ti < ntiles; ++ti) {
        const bool win = ti < nwt; const int k0 = win ? wlo + ti * 64 : (ti - nwt) * 64;
        __syncthreads();
        if ((ti & 1) == 0) { if (ti + 1 < ntiles) tile_store(1, rk[1], rv[1]); if (ti + 3 < ntiles) tile_load(ti + 3, rk[1], rv[1]); }
        else { if (ti + 1 < ntiles) tile_store(0, rk[0], rv[0]); if (ti + 3 < ntiles) tile_load(ti + 3, rk[0], rv[0]); }
        LAS unsigned char* kb_ = lds + (ti & 1) * ABUF; LAS unsigned char* vb_ = kb_ + VT_OFF;
        f32x4 s[4];
#pragma unroll
        for (int nt = 0; nt < 4; ++nt) { s[nt] = (f32x4){0.f, 0.f, 0.f, 0.f};
#pragma unroll
            for (int kk = 0; kk < 4; ++kk) { const bf16x8 a = *(const LAS bf16x8*)(kb_ + (nt * 16 + fr) * 272 + kk * 64 + fq * 16); s[nt] = __builtin_amdgcn_mfma_f32_16x16x32_bf16(a, qf[kk], s[nt], 0, 0, 0); } }
        float mt = -3.0e38f;
#pragma unroll
        for (int nt = 0; nt < 4; ++nt)
#pragma unroll
            for (int j = 0; j < 4; ++j) { float v = s[nt][j] * scale;
                if (lat && win) { const int kp = k0 + 32 * (nt >> 1) + 8 * fq + 4 * (nt & 1) + j; const int dd = qpos - kp; if (dd > 128 || dd < -128) v = -1.0e30f; }
                s[nt][j] = v; mt = fmaxf(mt, v); }
        mt = fmaxf(mt, __shfl_xor(mt, 16)); mt = fmaxf(mt, __shfl_xor(mt, 32));
        const float mn = fmaxf(m_run, mt); const float alpha = __builtin_amdgcn_exp2f(m_run - mn); m_run = mn;
        float ps = 0.f;
#pragma unroll
        for (int nt = 0; nt < 4; ++nt)
#pragma unroll
            for (int j = 0; j < 4; ++j) { const float p = __builtin_amdgcn_exp2f(s[nt][j] - mn); ps += p; s[nt][j] = p; }
        l_run = l_run * alpha + ps;
#pragma unroll
        for (int dt = 0; dt < 8; ++dt) o[dt] = o[dt] * alpha;
#pragma unroll
        for (int s2 = 0; s2 < 2; ++s2) {
            u32x4 pu; pu[0] = pack2(s[2 * s2][0], s[2 * s2][1]); pu[1] = pack2(s[2 * s2][2], s[2 * s2][3]); pu[2] = pack2(s[2 * s2 + 1][0], s[2 * s2 + 1][1]); pu[3] = pack2(s[2 * s2 + 1][2], s[2 * s2 + 1][3]);
            const bf16x8 pf = __builtin_bit_cast(bf16x8, pu);
#pragma unroll
            for (int dt = 0; dt < 8; ++dt) {
                const bf16x4 lo = __builtin_amdgcn_ds_read_tr16_b64_v4i16((LAS bf16x4*)(vb_ + (s2 * 32 + fq * 8 + (fr >> 2)) * 288 + (dt * 16 + (fr & 3) * 4) * 2));
                const bf16x4 hi = __builtin_amdgcn_ds_read_tr16_b64_v4i16((LAS bf16x4*)(vb_ + (s2 * 32 + fq * 8 + 4 + (fr >> 2)) * 288 + (dt * 16 + (fr & 3) * 4) * 2));
                const bf16x8 af = __builtin_shufflevector(lo, hi, 0, 1, 2, 3, 4, 5, 6, 7);
                o[dt] = __builtin_amdgcn_mfma_f32_16x16x32_bf16(af, pf, o[dt], 0, 0, 0);
            }
        }
    }
    float lt = l_run; lt += __shfl_xor(lt, 16); lt += __shfl_xor(lt, 32);
    const float inv = 1.0f / lt;
    bf16_t* yp = YB + (size_t)(row0 + qpos) * 1024 + head * 128 + fq * 4;
#pragma unroll
    for (int dt = 0; dt < 8; ++dt) { uint2 pk; pk.x = pack2(o[dt][0] * inv, o[dt][1] * inv); pk.y = pack2(o[dt][2] * inv, o[dt][3] * inv); *(uint2*)(yp + dt * 16) = pk; }
}

constexpr int YT_OFF = 256 * 272;
template <int MODE, int D, int NSC>
__device__ __forceinline__ void lru_dir(const Params& P, int l, int s, int cchunk, int h, LAS unsigned char* lds, int w, int fr, int fq) {
    const bool lat = s >= 32; const int row0 = lat ? MCTX + (s - 32) * 2048 : s * 256; const int t0 = cchunk * (NSC * 64);
    constexpr int NCH = 2048 / (NSC * 64);
    const bf16_t* GW = (const bf16_t*)(P.ws + OFF_GW);
    bf16_t* YA = (bf16_t*)(P.ws + OFF_YA);
    float* SUMM = (float*)(P.ws + OFF_SUMM);
    const int chl = 16 * w + fr, ch = h * 128 + chl;
    bf16x8 bwa[4], bwx[4];
    { const bf16_t* gp = GW + ((size_t)(D * 8 + h) * 256 + chl) * 128 + fq * 8;
#pragma unroll
      for (int kk = 0; kk < 4; ++kk) { bwa[kk] = *(const bf16x8*)(gp + kk * 32); bwx[kk] = *(const bf16x8*)(gp + 128 * 128 + kk * 32); } }
    const int pidx = (l * 2 + D) * 1024 + ch;
    const float ba = P.lru_ba[pidx], bx = P.lru_bx[pidx];
    const float lam = P.lru_lambda[pidx];
    const float c8 = -8.0f * log1pf(expf(-lam));
    float carry = 0.f;
    if (MODE == 0 && lat) {
        const int b = s - 32;
        carry = P.state_lru[((size_t)(b * 2 + l) * 2 + D) * 1024 + ch];
        if (D == 0) { for (int cc = 0; cc < cchunk; ++cc) { const float* sp = SUMM + ((size_t)((b * 2 + 0) * 16 + cc) * 1024 + ch) * 2; carry = sp[1] + sp[0] * carry; } }
        else { for (int cc = NCH - 1; cc > cchunk; --cc) { const float* sp = SUMM + ((size_t)((b * 2 + 1) * 16 + cc) * 1024 + ch) * 2; carry = sp[1] + sp[0] * carry; } }
    }
    float ptot = 1.0f;
#pragma unroll 1
    for (int sci = 0; sci < NSC; ++sci) {
        const int sc = D == 0 ? sci : NSC - 1 - sci;
        f32x4 r[4], g[4];
#pragma unroll
        for (int m = 0; m < 4; ++m) { r[m] = (f32x4){0.f, 0.f, 0.f, 0.f}; g[m] = (f32x4){0.f, 0.f, 0.f, 0.f};
#pragma unroll
            for (int kk = 0; kk < 4; ++kk) { const bf16x8 a = *(const LAS bf16x8*)(lds + (sc * 64 + m * 16 + fr) * 272 + kk * 64 + fq * 16);
                r[m] = __builtin_amdgcn_mfma_f32_16x16x32_bf16(a, bwa[kk], r[m], 0, 0, 0); g[m] = __builtin_amdgcn_mfma_f32_16x16x32_bf16(a, bwx[kk], g[m], 0, 0, 0); } }
#pragma unroll
        for (int mi = 0; mi < 4; ++mi) {
            const int m = D == 0 ? mi : 3 - mi;
            float av[4], bv[4];
#pragma unroll
            for (int j = 0; j < 4; ++j) {
                const float ea = 1.0f + __expf(-(r[m][j] + ba)), eb = 1.0f + __expf(-(g[m][j] + bx));
                const float inv = __builtin_amdgcn_rcpf(ea * eb);
                const float rr = inv * eb, ii = inv * ea;
                const float la = c8 * rr; const float a = __expf(la); const float z = 2.0f * la;
                const float em = (z > -0.05f) ? -z * (1.0f + z * (0.5f + z * (0.16666667f + z * 0.041666667f))) : 1.0f - a * a;
                const float x = bf2f(*(const LAS bf16_t*)(lds + (sc * 64 + m * 16 + fq * 4 + j) * 272 + chl * 2));
                av[j] = a; bv[j] = __builtin_amdgcn_sqrtf(em) * ii * x;
            }
            float p4, h4;
            p4 = av[0] * av[1] * av[2] * av[3];
            if (D == 0) h4 = ((bv[0] * av[1] + bv[1]) * av[2] + bv[2]) * av[3] + bv[3];
            else h4 = ((bv[3] * av[2] + bv[2]) * av[1] + bv[1]) * av[0] + bv[0];
            float pq[4], hq[4];
#pragma unroll
            for (int f = 0; f < 4; ++f) { pq[f] = __shfl(p4, fr + 16 * f); hq[f] = __shfl(h4, fr + 16 * f); }
            float cin = carry, mycin = 0.f;
#pragma unroll
            for (int fi = 0; fi < 4; ++fi) { const int f = D == 0 ? fi : 3 - fi; if (f == fq) mycin = cin; cin = hq[f] + pq[f] * cin; }
            carry = cin;
            if (MODE == 1) ptot *= pq[0] * pq[1] * pq[2] * pq[3];
            if (MODE == 0) {
                float hh = mycin; float y[4];
#pragma unroll
                for (int ji = 0; ji < 4; ++ji) { const int j = D == 0 ? ji : 3 - ji; hh = av[j] * hh + bv[j]; y[j] = hh; }
#pragma unroll
                for (int j = 0; j < 4; ++j) {
                    LAS bf16_t* yp = (LAS bf16_t*)(lds + YT_OFF + (sc * 64 + m * 16 + fq * 4 + j) * 272 + chl * 2);
                    if (D == 0) *yp = f2bf(y[j]);
                    else *yp = f2bf(bf2f(*yp) + y[j]);
                }
            }
        }
    }
    if (MODE == 0 && !lat && fq == 0) P.out[OUT_H + ((size_t)(s * 2 + l) * 2 + D) * 1024 + ch] = carry;
    if (MODE == 1 && fq == 0) { float* sp = SUMM + ((size_t)(((s - 32) * 2 + D) * 16 + cchunk) * 1024 + ch) * 2; sp[0] = ptot; sp[1] = carry; }
}
template <int MODE, int NSC>
__device__ void lru_unit(const Params& P, int l, int s, int cchunk, int h, LAS unsigned char* lds) {
    int tid_ = threadIdx.x; asm volatile("" : "+v"(tid_));
    const int tid = tid_, w = tid >> 6, lane = tid & 63, fr = lane & 15, fq = lane >> 4;
    const bool lat = s >= 32; const int T = lat ? 2048 : 256; const int row0 = lat ? MCTX + (s - 32) * 2048 : s * 256; const int t0 = cchunk * (NSC * 64);
    const bf16_t* XA = (const bf16_t*)(P.ws + OFF_XAQ);
    constexpr int RUN = NSC * 2;
    {
        const int ck = tid & 15, ch = h * 128 + ck * 8, tr = (tid >> 4) * RUN;
        const float* cw = P.lru_conv + (size_t)l * 4096 + ch; const float* cb = P.lru_conv_b + l * 1024 + ch;
        bf16x8 xr[RUN + 3];
#pragma unroll
        for (int i = 0; i < RUN + 3; ++i) { const int tt = t0 + tr + i - 2; xr[i] = (bf16x8){0, 0, 0, 0, 0, 0, 0, 0};
            if (tt >= 0 && tt < T) xr[i] = *(const bf16x8*)(XA + (size_t)(row0 + tt) * 1024 + ch); }
        float wk[4][8], bk[8];
#pragma unroll
        for (int e = 0; e < 8; ++e) { bk[e] = cb[e];
#pragma unroll
            for (int k = 0; k < 4; ++k) wk[k][e] = cw[k * 1024 + e]; }
        __syncthreads();
#pragma unroll
        for (int i = 0; i < RUN; ++i) {
            float a8[8];
#pragma unroll
            for (int e = 0; e < 8; ++e) { a8[e] = bk[e];
#pragma unroll
                for (int k = 0; k < 4; ++k) a8[e] += wk[k][e] * bf2f((unsigned short)xr[i + k][e]); }
            u32x4 o; o.x = pack2(a8[0], a8[1]); o.y = pack2(a8[2], a8[3]); o.z = pack2(a8[4], a8[5]); o.w = pack2(a8[6], a8[7]);
            *(LAS u32x4*)(lds + (tr + i) * 272 + ck * 16) = o;
        }
    }
    __syncthreads();
    lru_dir<MODE, 0, NSC>(P, l, s, cchunk, h, lds, w, fr, fq);
    lru_dir<MODE, 1, NSC>(P, l, s, cchunk, h, lds, w, fr, fq);
    if (MODE == 0) {
        bf16_t* YA = (bf16_t*)(P.ws + OFF_YA);
        __syncthreads();
#pragma unroll
        for (int it = 0; it < 2 * NSC; ++it) { const int t = (tid >> 4) + it * 32, ck = tid & 15;
            const u32x4 v = *(const LAS u32x4*)(lds + YT_OFF + t * 272 + ck * 16);
            *(u32x4*)(YA + (size_t)(row0 + t0 + t) * 1024 + h * 128 + ck * 8) = v; }
    }
}

#define XB_TMO      128
#define XB_XCNT(j)  (256  + 64 * (j))
#define XB_XSUB(j)  (1280 + 64 * (j))
#define XB_XGEN(j)  (2304 + 64 * (j))
#define XB_TOP      3328
#define XB_TOPGEN   3392
#define XCD_BAR_WORDS 3456
#define XB_SPIN_CAP (1u << 18)
__device__ __forceinline__ unsigned xb_ld(unsigned* p)              { return __hip_atomic_load(p, __ATOMIC_RELAXED, __HIP_MEMORY_SCOPE_AGENT); }
__device__ __forceinline__ unsigned xb_add(unsigned* p, unsigned v) { return __hip_atomic_fetch_add(p, v, __ATOMIC_RELAXED, __HIP_MEMORY_SCOPE_AGENT); }
__device__ __forceinline__ unsigned xb_xcc_id() { return (unsigned)__builtin_amdgcn_s_getreg((3 << 11) | 20) & 0xFu; }
#define XB_SPIN(cond, bar) do { unsigned _sp = 0; while (cond) { __builtin_amdgcn_s_sleep(1); \
    if ((++_sp & 255u) == 0u) { if (xb_ld(&(bar)[XB_TMO])) break; if (_sp > XB_SPIN_CAP) { atomicAdd(&(bar)[XB_TMO], 1u); break; } } } } while (0)
struct XcdBarrier { unsigned* bar; unsigned x; volatile LAS unsigned* st; };
__device__ __forceinline__ XcdBarrier xcd_barrier_post(unsigned* bar, volatile LAS unsigned* st) {
    XcdBarrier b; b.bar = bar; b.x = xb_xcc_id(); b.st = st;
    if (threadIdx.x == 0) (void)xb_add(&bar[XB_XCNT(b.x)], 1u);
    return b;
}
__device__ __forceinline__ void xcd_barrier_complete(unsigned* bar, unsigned x, unsigned& nloc, unsigned& nx) {
    const unsigned G = gridDim.x * gridDim.y * gridDim.z;
    unsigned sum, cnt, mine, sp = 0u;
    for (;;) {
        sum = 0u; cnt = 0u; mine = 0u;
#pragma unroll
        for (unsigned j = 0; j < 16; ++j) { const unsigned c = xb_ld(&bar[XB_XCNT(j)]); sum += c; cnt += (c > 0u) ? 1u : 0u; mine = (j == x) ? c : mine; }
        if (sum == G) break;
        __builtin_amdgcn_s_sleep(1);
        if ((++sp & 255u) == 0u) { if (xb_ld(&bar[XB_TMO])) break; if (sp > XB_SPIN_CAP) { atomicAdd(&bar[XB_TMO], 1u); break; } }
    }
    nloc = mine > 0u ? mine : 1u; nx = cnt > 0u ? cnt : 1u;
}
__device__ __noinline__ void xcd_barrier_(unsigned* bbar, unsigned bx, volatile LAS unsigned* bst) {
    XcdBarrier b; b.bar = bbar; b.x = bx; b.st = bst;
    asm volatile("s_waitcnt vmcnt(0)" ::: "memory");
    __syncthreads();
    if (threadIdx.x == 0) {
        unsigned* bar = b.bar;
        __builtin_amdgcn_s_waitcnt(0);
        unsigned nloc = b.st[0], nx = b.st[1];
        if (nloc == 0u) { xcd_barrier_complete(bar, b.x, nloc, nx); b.st[0] = nloc; b.st[1] = nx; }
        const unsigned old = xb_add(&bar[XB_XSUB(b.x)], 1u);
        const unsigned gen = old / nloc;
        if (old + 1u == (gen + 1u) * nloc) {
            __builtin_amdgcn_fence(__ATOMIC_RELEASE, "agent");
            asm volatile("s_waitcnt vmcnt(0)" ::: "memory");
            const unsigned og = xb_add(&bar[XB_TOP], 1u);
            const unsigned tg = og / nx;
            if (og + 1u == (tg + 1u) * nx) xb_add(&bar[XB_TOPGEN], 1u);
            else XB_SPIN(xb_ld(&bar[XB_TOPGEN]) == tg, bar);
            __builtin_amdgcn_fence(__ATOMIC_ACQUIRE, "agent");
            xb_add(&bar[XB_XGEN(b.x)], 1u);
            asm volatile("s_waitcnt vmcnt(0)" ::: "memory");
        } else {
            XB_SPIN(xb_ld(&bar[XB_XGEN(b.x)]) == gen, bar);
            __builtin_amdgcn_fence(__ATOMIC_ACQUIRE, "agent");
            asm volatile("s_waitcnt vmcnt(0)" ::: "memory");
        }
    }
    __syncthreads();
}

#ifndef REPMASK
#define REPMASK 0
#endif
#define REPLOOP(i) _Pragma("unroll 1") for (int rep_ = 0; rep_ < 1 + ((REPMASK >> (i)) & 1); ++rep_)
__global__ __launch_bounds__(512, 2) void mega(Params P) {
    extern __shared__ __attribute__((aligned(16))) unsigned char shm[];
    LAS unsigned char* lds = (LAS unsigned char*)shm;
    cg::grid_group grid = cg::this_grid();
    if (threadIdx.x == 0) *(LAS u32x4*)(lds + 147456) = (u32x4){0u, 0u, 0u, 0u};
    __syncthreads();
    const XcdBarrier xb = xcd_barrier_post((unsigned*)(P.ws + OFF_BAR), (volatile LAS unsigned*)(lds + 147456));
    const int G = gridDim.x, c = blockIdx.x;
    unsigned char* ws = P.ws;
    float* X = P.out;
    bf16_t* H = (bf16_t*)(ws + OFF_H);
    const float* MOD = (const float*)(ws + OFF_MOD);

    REPLOOP(12) phase0(P, lds);
    grid.sync();
    for (int l = 0; l < 2; ++l) {
        const float* mod = MOD + (size_t)l * 3 * 6144;
        const bool hide = (G == 256);
        { const int te = hide ? (l == 0 ? 1856 : 0) : 4992; if (te > 0) convert_weights(P, l, lds, 0, te, c, G); }
        const float* xa0 = l == 0 ? P.x_prompt : X; const float* xb0 = l == 0 ? P.x_sample : X + (size_t)MCTX * 1024;
        REPLOOP(1) norm_phase(xa0, xb0, P.norm1 + l * 1024, mod, 0, 1024, H);
        REPLOOP(11) xcd_barrier_(xb.bar, xb.x, xb.st);
        REPLOOP(2) { Sched S{(const char*)H, (const char*)(ws + OFF_WIN), 1024, 1024, 0, 48, 14, G, c, 256};
          EpiIn E{(bf16_t*)(ws + OFF_XAQ), (bf16_t*)(ws + OFF_XC), (bf16_t*)(ws + OFF_KB), (bf16_t*)(ws + OFF_VB), P.out + OUT_K, P.out + OUT_V, (const float*)(ws + OFF_ROPE), l};
          gemm_phase(lds, S, 1024, E); }
        if (hide && l == 0 && c >= 160) convert_weights(P, l, lds, 1856, 2624, c - 160, G - 160);
        REPLOOP(11) xcd_barrier_(xb.bar, xb.x, xb.st);
        REPLOOP(3) pool_phase((const bf16_t*)(ws + OFF_XC), (bf16_t*)(ws + OFF_PL));
        for (int it = c; it < 1280; it += G) {
            if (it < 256) { REPLOOP(4) attn_unit(P, l, it, lds); }
            else if (it < 512) { const int v = it - 256; REPLOOP(5) lru_unit<0, 4>(P, l, v >> 3, 0, v & 7, lds); }
            else if (it < 768) { const int q = it - 512; REPLOOP(5) lru_unit<1, 2>(P, l, 32 + (q >> 7), (q >> 3) & 15, q & 7, lds); }
            else { REPLOOP(7) attn_unit(P, l, it - 768 + 256, lds); }
        }
        REPLOOP(11) xcd_barrier_(xb.bar, xb.x, xb.st);
        { Sched S{(const char*)(ws + OFF_PL), (const char*)(ws + OFF_PW), 1024, 256, 256, 48, 4, G, c, 256};
          EpiPool E{(bf16_t*)(ws + OFF_XC), P.pool_scale + l * 1024};
          gemm_phase(lds, S, 256, E); }
#ifndef NO_LRU
        for (int it = G - 1 - c; it < 256; it += G) lru_unit<0, 2>(P, l, 32 + (it >> 7), (it >> 3) & 15, it & 7, lds);
#endif
        REPLOOP(11) xcd_barrier_(xb.bar, xb.x, xb.st);
        REPLOOP(6) { MergeSched S{(const char*)ws, 1024, 1024, c};
          EpiMerge E{(bf16_t*)(ws + OFF_GT), P.b_gate + l * 3072, (float*)(ws + OFF_XAQ), (bf16_t*)(ws + OFF_PL)};
          gemm_phase(lds, S, 1024, E); }
        if (hide && c >= 192) convert_weights(P, l, lds, 2624, 4992, c - 192, G - 192);
        REPLOOP(11) xcd_barrier_(xb.bar, xb.x, xb.st);
        { Sched S{(const char*)(ws + OFF_PL), (const char*)(ws + OFF_WOUT), 1024, 1024, 0, 64, 4, G, c, 192};
          EpiRes E{X, mod, 2048, xa0, xb0};
          gemm_phase<EpiRes, Sched, true>(lds, S, 1024, E); }
        REPLOOP(11) xcd_barrier_(xb.bar, xb.x, xb.st);
        norm_phase(X, X + (size_t)MCTX * 1024, P.norm2 + l * 1024, mod, 3072, 4096, H);
        REPLOOP(11) xcd_barrier_(xb.bar, xb.x, xb.st);
        REPLOOP(9) { Sched S{(const char*)H, (const char*)(ws + OFF_WUP), 1024, 1024, 0, 48, 22, G, c, 256};
          EpiBf E{(bf16_t*)(ws + OFF_U), 5632};
          gemm_phase(lds, S, 1024, E); }
        if (hide && l == 0 && c >= 32) convert_weights(P, l + 1, lds, 0, 2624, c - 32, G - 32);
        REPLOOP(11) xcd_barrier_(xb.bar, xb.x, xb.st);
        REPLOOP(10) act_phase((const bf16_t*)(ws + OFF_U), (bf16_t*)(ws + OFF_ACT), P.ffn_conv + (size_t)l * 3 * 2816, P.ffn_conv_b + l * 2816);
        REPLOOP(11) xcd_barrier_(xb.bar, xb.x, xb.st);
        { Sched S{(const char*)(ws + OFF_ACT), (const char*)(ws + OFF_WDN), 2816, 2816, 0, 64, 4, G, c, 192};
          EpiRes E{X, mod, 5120, X, X + (size_t)MCTX * 1024};
          gemm_phase<EpiRes, Sched, true>(lds, S, 2816, E); }
        REPLOOP(11) xcd_barrier_(xb.bar, xb.x, xb.st);
    }
    final_norm_phase(X, P.final_norm);
}

extern "C" void kernel_launch(void* const* d_in, const int* in_sizes, int n_in, void* d_out, int out_size, void* d_ws, size_t ws_size, hipStream_t stream) {
    constexpr size_t kDynLds = 147456 + 16;
    static int grid_blocks = 0;
    if (!grid_blocks) {
        int dev = 0, cus = 0, per_cu = 0;
        hipGetDevice(&dev);
        hipDeviceGetAttribute(&cus, hipDeviceAttributeMultiprocessorCount, dev);
        hipFuncSetAttribute((const void*)mega, hipFuncAttributeMaxDynamicSharedMemorySize, (int)kDynLds);
        hipOccupancyMaxActiveBlocksPerMultiprocessor(&per_cu, mega, 512, kDynLds);
        if (per_cu < 1) per_cu = 1;
        if (per_cu > 1) per_cu = 1;
        grid_blocks = cus * per_cu;
    }
    Params p{};
    const float** pp = (const float**)&p;
    for (int i = 0; i < 30; ++i) pp[i] = (const float*)d_in[i];
    p.out = (float*)d_out; p.ws = (unsigned char*)d_ws;
    if (ws_size < OFF_END) { fprintf(stderr, "workspace too small: %zu < %zu\n", ws_size, (size_t)OFF_END); }
    hipMemsetAsync((unsigned char*)d_ws + OFF_BAR, 0, 16384, stream);
    void* args[] = {&p};
    hipError_t e = hipLaunchCooperativeKernel((void*)mega, dim3(grid_blocks), dim3(512), args, kDynLds, stream);
    if (e != hipSuccess) fprintf(stderr, "cooperative launch failed: %s (grid %d)\n", hipGetErrorString(e), grid_blocks);
}
```

```cpp
#include <hip/hip_runtime.h>
#include <hip/hip_cooperative_groups.h>
#include <cstdio>
namespace cg = cooperative_groups;

#define LAS __attribute__((address_space(3)))
typedef unsigned short bf16_t;
typedef short bf16x8 __attribute__((ext_vector_type(8)));
typedef float f32x4 __attribute__((ext_vector_type(4)));
typedef unsigned u32x4 __attribute__((ext_vector_type(4)));
typedef unsigned u32x2 __attribute__((ext_vector_type(2)));
typedef short bf16x4 __attribute__((ext_vector_type(4)));

constexpr int MROWS = 12288, MCTX = 8192;
constexpr size_t S24 = (size_t)MROWS * 1024 * 2;
constexpr size_t OFF_WIN = 0;
constexpr size_t OFF_WBR = OFF_WIN + (size_t)6656 * 1024 * 2;
constexpr size_t OFF_WOUT = OFF_WBR + (size_t)3 * 1024 * 1024 * 2;
constexpr size_t OFF_WUP = OFF_WOUT + (size_t)1024 * 1024 * 2;
constexpr size_t OFF_WDN = OFF_WUP + (size_t)5632 * 1024 * 2;
constexpr size_t OFF_GW = OFF_WDN + (size_t)1024 * 2816 * 2;
constexpr size_t OFF_PW = OFF_GW + (size_t)2 * 8 * 256 * 128 * 2;
constexpr size_t OFF_MOD = OFF_PW + (size_t)4 * 256 * 256 * 2;
constexpr size_t OFF_CK = OFF_MOD + (size_t)2 * 3 * 6144 * 4;
constexpr size_t OFF_CV = OFF_CK + (size_t)2 * 2 * 512 * 256 * 2;
constexpr size_t OFF_ROPE = OFF_CV + (size_t)2 * 2 * 512 * 256 * 2;
constexpr size_t OFF_SUMM = OFF_ROPE + (size_t)2 * 64 * 32 * 4;
constexpr size_t OFF_BAR = OFF_SUMM + (size_t)2 * 2 * 16 * 1024 * 2 * 4;
constexpr size_t OFF_ACT0 = OFF_BAR + 16384;
constexpr size_t OFF_XAQ = OFF_ACT0;
constexpr size_t OFF_XC = OFF_XAQ + 2 * S24;
constexpr size_t OFF_KB = OFF_XC + S24;
constexpr size_t OFF_VB = OFF_KB + (size_t)MROWS * 256 * 2;
constexpr size_t OFF_GT = OFF_VB + (size_t)MROWS * 256 * 2;
constexpr size_t OFF_YB = OFF_GT + S24;
constexpr size_t OFF_PL = OFF_YB + S24;
constexpr size_t OFF_YA = OFF_PL + S24;
constexpr size_t OFF_H = OFF_YA + S24;
constexpr size_t OFF_END = OFF_H + S24;
constexpr size_t OFF_U = OFF_XAQ;
constexpr size_t OFF_ACT = OFF_PL;
constexpr size_t OUT_K = (size_t)MROWS * 1024;
constexpr size_t OUT_V = OUT_K + (size_t)32 * 2 * 256 * 256;
constexpr size_t OUT_H = OUT_V + (size_t)32 * 2 * 256 * 256;

struct Params {
    const float *x_prompt, *x_sample, *cache_k, *cache_v, *state_lru, *c, *c_ctx, *w_ada, *b_ada, *norm1, *norm2,
        *w_in, *b_gate, *lru_conv, *lru_conv_b, *lru_wa, *lru_ba, *lru_wx, *lru_bx, *lru_lambda, *attn_sink,
        *pool_w, *pool_scale, *w_branch, *w_out, *ffn_up, *ffn_conv, *ffn_conv_b, *ffn_down, *final_norm;
    float* out; unsigned char* ws;
};

typedef float f32x2_ __attribute__((ext_vector_type(2)));
typedef __bf16 bf16x2_ __attribute__((ext_vector_type(2)));
__device__ __forceinline__ unsigned pack2(float a, float b) { const f32x2_ v = {a, b}; const bf16x2_ r = __builtin_convertvector(v, bf16x2_); return __builtin_bit_cast(unsigned, r); }
__device__ __forceinline__ unsigned short f2bf(float f) { return (unsigned short)(pack2(f, f) & 0xffffu); }
__device__ __forceinline__ float bf2f(unsigned short b) { return __uint_as_float(((unsigned)b) << 16); }
__device__ __forceinline__ int otid() { int t = threadIdx.x; asm volatile("" : "+v"(t)); return t; }
__device__ __forceinline__ float sigmoidf_(float x) { return __builtin_amdgcn_rcpf(1.0f + __expf(-x)); }

constexpr int HTB = 128 * 64 * 2;
__device__ __forceinline__ int lds_byte(int r, int c) { const int st = (r >> 4) * 2 + (c >> 5), rr = r & 15, cc = c & 31, ob = rr * 64 + cc * 2; return st * 1024 + (ob ^ (((ob >> 9) & 1) << 5)); }
__device__ __forceinline__ void stage_rc(int b, int& R, int& C) { const int st = b / 1024, sb = b % 1024, swz = sb ^ (((sb >> 9) & 1) << 5); R = (st >> 1) * 16 + swz / 64; C = (st & 1) * 32 + (swz % 64) / 2; }

struct Unit { const char* a; const char* b; int pm, pn, z, row0, m192; };
struct Sched {
    const char* A; const char* B; int lda, ldb, acol, nM, nN, G, c, tm;
    __device__ __forceinline__ bool next(int i, Unit& u) const {
        const long L = (long)i * G + c; const int nwg = nM * nN; if (L >= nwg) return false;
        int wgid = (int)L; { const int q = nwg / 8, r = nwg % 8, xcd = wgid % 8, off = wgid / 8; wgid = (xcd < r ? xcd * (q + 1) : r * (q + 1) + (xcd - r) * q) + off; }
        const int nig = 8 * nN, gid = wgid / nig, fm = gid * 8, gsz = (nM - fm) < 8 ? (nM - fm) : 8;
        u.pm = fm + ((wgid % nig) % gsz); u.pn = (wgid % nig) / gsz;
        u.a = A + ((size_t)u.pm * tm * lda + (size_t)u.pn * acol) * 2; u.b = B + (size_t)u.pn * 256 * ldb * 2; u.z = 0; u.row0 = u.pm * tm; u.m192 = (tm == 192); return true;
    }
};
struct MergeSched {
    const char* ws; int lda, ldb, c;
    __device__ __forceinline__ bool next(int i, Unit& u) const {
        if (c >= 192 || i >= 6) return false;
        const int nN = 4;
        int wgid = c; { const int q = 24, xcd = wgid % 8, off = wgid / 8; wgid = xcd * q + off; }
        const int nig = 8 * nN, gid = wgid / nig, fm = gid * 8;
        u.pm = fm + ((wgid % nig) % 8); u.pn = (wgid % nig) / 8; u.z = i; u.row0 = u.pm * 256; u.m192 = 0;
        const int j = i >> 1;
        const size_t aoff = (size_t)u.row0 * 1024 * 2;
        size_t ao = OFF_H, bo = OFF_WIN + (size_t)3584 * 1024 * 2;
        if (i & 1) { bo = OFF_WBR; ao = OFF_YA; if (j == 1) ao = OFF_YB; if (j == 2) ao = OFF_XC; }
        u.a = ws + ao + aoff; u.b = ws + bo + ((size_t)j * 1024 + (size_t)u.pn * 256) * 1024 * 2;
        return true;
    }
};

template <class Epi, class SchedT, bool M192 = false>
__device__ __forceinline__ void gemm_phase(LAS unsigned char* lds, const SchedT& S, const int K_, const Epi& E) {
    int K = K_; asm volatile("" : "+s"(K));
    int tid_ = threadIdx.x; asm volatile("" : "+v"(tid_));
    const int tid = tid_, wid = __builtin_amdgcn_readfirstlane(tid >> 6), lane = tid & 63, wr = wid >> 2, wc = wid & 3, fr = lane & 15, fq = lane >> 4;
    const int nt = K / 64;
    unsigned voffA[2], voffB[2];
#pragma unroll
    for (int i = 0; i < 2; ++i) { int R, C; stage_rc(tid * 16 + i * 8192, R, C); voffA[i] = (unsigned)(R * S.lda + C) * 2u; voffB[i] = (unsigned)(R * S.ldb + C) * 2u; }
    const size_t kstep = 128;
    const size_t hstepA = (size_t)128 * S.lda * 2, hstepB = (size_t)128 * S.ldb * 2;
    const unsigned ldsw = (unsigned)wid * 1024u;
    const int aoff = lds_byte(wr * 64 + fr, fq * 8), boff = lds_byte(wc * 32 + fr, fq * 8);
#define G_SA(b, h) (((b) * 2 + (h)) * HTB)
#define G_SB(b, h) ((4 + (b) * 2 + (h)) * HTB)
#define G_STAGE(bufoff, gbase, voff) do { _Pragma("unroll") for (int _i = 0; _i < 2; ++_i) \
        __builtin_amdgcn_global_load_lds((const unsigned*)((const char*)(gbase) + (voff)[_i]), (LAS unsigned*)(lds + (bufoff) + ldsw + _i * 8192), 16, 0, 0); } while (0)
#define G_LDA(dst, b, h) do { _Pragma("unroll") for (int m = 0; m < 4; ++m) _Pragma("unroll") for (int k = 0; k < 2; ++k) dst[m][k] = *(const LAS bf16x8*)(lds + G_SA(b, h) + aoff + m * 2048 + k * 1024); } while (0)
#define G_LDB(dst, b, h) do { _Pragma("unroll") for (int n = 0; n < 2; ++n) _Pragma("unroll") for (int k = 0; k < 2; ++k) dst[n][k] = *(const LAS bf16x8*)(lds + G_SB(b, h) + boff + n * 2048 + k * 1024); } while (0)
#define G_MMA(ai, bj, At, Bt) do { if (M192 && (ai) == 1 && wr == 1) break; __builtin_amdgcn_s_setprio(1); _Pragma("unroll") for (int m = 0; m < 4; ++m) _Pragma("unroll") for (int n = 0; n < 2; ++n) _Pragma("unroll") for (int k = 0; k < 2; ++k) \
        acc[ai][bj][m][n] = __builtin_amdgcn_mfma_f32_16x16x32_bf16(Bt[n][k], At[m][k], acc[ai][bj][m][n], 0, 0, 0); __builtin_amdgcn_s_setprio(0); } while (0)
#define G_WAIT_V(n) asm volatile("s_waitcnt vmcnt(" #n ")" ::: "memory")
#define G_WAIT_L(n) asm volatile("s_waitcnt lgkmcnt(" #n ")" ::: "memory")
#define G_BAR __builtin_amdgcn_s_barrier()
#define G_SCHED __builtin_amdgcn_sched_barrier(0)
    Unit cur, nxt; int ui = 0;
    if (!S.next(0, cur)) return;
    f32x4 acc[2][2][4][2];
#pragma unroll
    for (int a = 0; a < 2; ++a)
#pragma unroll
        for (int b = 0; b < 2; ++b)
#pragma unroll
            for (int m = 0; m < 4; ++m)
#pragma unroll
                for (int n = 0; n < 2; ++n) acc[a][b][m][n] = (f32x4){0.f, 0.f, 0.f, 0.f};
    bf16x8 At[4][2], B0[2][2], B1[2][2];
    const char* cA = cur.a; const char* cB = cur.b;
    G_STAGE(G_SB(0, 0), cB, voffB); G_STAGE(G_SA(0, 0), cA, voffA); G_STAGE(G_SB(0, 1), cB + hstepB, voffB); G_STAGE(G_SA(0, 1), cA + hstepA, voffA);
    if (wr == 1) G_BAR;
    G_WAIT_V(4); G_BAR;
    G_STAGE(G_SB(1, 0), cB + kstep, voffB); G_STAGE(G_SA(1, 0), cA + kstep, voffA); G_STAGE(G_SB(1, 1), cB + hstepB + kstep, voffB);
    G_WAIT_V(6); G_BAR;
    for (;;) {
        const bool has_next = S.next(ui + 1, nxt);
        const char* nA = has_next ? nxt.a : cA; const char* nB = has_next ? nxt.b : cB;
        for (int t = 0; t < nt; t += 2) {
            const bool last = (t == nt - 2);
            const char* a1 = cA + (size_t)(t + 1) * kstep;
            const char* a2 = last ? nA : cA + (size_t)(t + 2) * kstep; const char* b2 = last ? nB : cB + (size_t)(t + 2) * kstep;
            const char* a3 = a2 + kstep; const char* b3 = b2 + kstep;
            G_LDB(B0, 0, 0); G_SCHED; G_LDA(At, 0, 0); G_STAGE(G_SA(1, 1), a1 + hstepA, voffA);
            G_WAIT_L(8); G_BAR; G_WAIT_L(0); G_MMA(0, 0, At, B0); G_BAR; G_SCHED;
            G_LDB(B1, 0, 1); G_STAGE(G_SB(0, 0), b2, voffB);
            G_BAR; G_WAIT_L(0); G_MMA(0, 1, At, B1); G_BAR;
            G_LDA(At, 0, 1); G_STAGE(G_SA(0, 0), a2, voffA);
            G_BAR; G_WAIT_L(0); G_MMA(1, 0, At, B0); G_BAR; G_SCHED;
            G_STAGE(G_SB(0, 1), b2 + hstepB, voffB);
            G_WAIT_V(6); G_BAR; G_MMA(1, 1, At, B1); G_BAR;
            G_LDB(B0, 1, 0); G_SCHED; G_LDA(At, 1, 0); G_STAGE(G_SA(0, 1), a2 + hstepA, voffA);
            G_WAIT_L(8); G_BAR; G_WAIT_L(0); G_MMA(0, 0, At, B0); G_BAR; G_SCHED;
            G_LDB(B1, 1, 1); G_STAGE(G_SB(1, 0), b3, voffB);
            G_BAR; G_WAIT_L(0); G_MMA(0, 1, At, B1); G_BAR;
            G_LDA(At, 1, 1); G_STAGE(G_SA(1, 0), a3, voffA);
            G_BAR; G_WAIT_L(0); G_MMA(1, 0, At, B0); G_BAR; G_SCHED;
            G_STAGE(G_SB(1, 1), b3 + hstepB, voffB);
            G_WAIT_V(6); G_BAR; G_MMA(1, 1, At, B1); G_BAR;
        }
        E(acc, cur, wr, wc, fr, fq);
        if (!has_next) break;
#pragma unroll
        for (int a = 0; a < 2; ++a)
#pragma unroll
            for (int b = 0; b < 2; ++b)
#pragma unroll
                for (int m = 0; m < 4; ++m)
#pragma unroll
                    for (int n = 0; n < 2; ++n) acc[a][b][m][n] = (f32x4){0.f, 0.f, 0.f, 0.f};
        cur = nxt; cA = nA; cB = nB; ++ui;
    }
    G_WAIT_V(0);
    if (wr == 0) G_BAR;
    G_BAR;
#undef G_SA
#undef G_SB
#undef G_STAGE
#undef G_LDA
#undef G_LDB
#undef G_MMA
#undef G_WAIT_V
#undef G_WAIT_L
#undef G_BAR
#undef G_SCHED
}

#define EPI_LOOP_BEGIN \
    _Pragma("unroll") for (int ai = 0; ai < 2; ++ai) _Pragma("unroll") for (int m = 0; m < 4; ++m) { const int row = u.pm * 256 + wr * 64 + fr + ai * 128 + m * 16; \
    _Pragma("unroll") for (int bj = 0; bj < 2; ++bj) _Pragma("unroll") for (int n = 0; n < 2; ++n) { const int cl = wc * 32 + 4 * fq + bj * 128 + n * 16; const f32x4 v = acc[ai][bj][m][n];
#define EPI_LOOP_END } }

__device__ __forceinline__ int seq_group(int row) { return row < MCTX ? 0 : 1 + ((row - MCTX) >> 11); }

struct EpiIn {
    bf16_t* xaq; bf16_t* xc; bf16_t* kb; bf16_t* vb; float* outk; float* outv; const float* rc; int l;
    __device__ __forceinline__ void operator()(const f32x4 (&acc)[2][2][4][2], const Unit& u, int wr, int wc, int fr, int fq) const {
        const int pn = u.pn; const bool qk = pn >= 4 && pn <= 8;
        bf16_t* dst; int ld, cbase; float* fo = nullptr;
        if (pn < 4) { dst = xaq; ld = 1024; cbase = pn * 256; }
        else if (pn < 8) { dst = xaq + (size_t)MROWS * 1024; ld = 1024; cbase = pn * 256 - 1024; }
        else if (pn == 8) { dst = kb; ld = 256; cbase = 0; fo = outk; }
        else if (pn == 9) { dst = vb; ld = 256; cbase = 0; fo = outv; }
        else { dst = xc; ld = 1024; cbase = pn * 256 - 2560; }
        const int hh = wc >> 1, i0 = 16 * (wc & 1) + 4 * fq;
        const int c1 = cbase + (qk ? 64 * hh + i0 : wc * 32 + 4 * fq), dc = qk ? 32 : 16;
        const bool rope = qk && u.pm >= 32;
#pragma unroll
        for (int ai = 0; ai < 2; ++ai) {
            f32x4 csm[4], snm[4];
#pragma unroll
            for (int m = 0; m < 4; ++m) { csm[m] = (f32x4){1.f, 1.f, 1.f, 1.f}; snm[m] = (f32x4){0.f, 0.f, 0.f, 0.f};
                if (rope) { const int row = u.pm * 256 + wr * 64 + fr + ai * 128 + m * 16; const int t = (row - MCTX) & 2047; const int pos = hh == 0 ? (t >> 6) : (t & 63);
                    csm[m] = *(const f32x4*)(rc + pos * 32 + i0); snm[m] = *(const f32x4*)(rc + 2048 + pos * 32 + i0); } }
#pragma unroll
            for (int m = 0; m < 4; ++m) {
                const int row = u.pm * 256 + wr * 64 + fr + ai * 128 + m * 16;
                const f32x4 cs = csm[m], sn = snm[m];
                bf16_t* dp = dst + (size_t)row * ld + c1;
                float* fp = fo + ((size_t)(((row >> 8) * 2 + l) * 256 + (row & 255))) * 256 + c1;
#pragma unroll
                for (int bj = 0; bj < 2; ++bj) {
                    const f32x4 x1 = acc[ai][bj][m][0], x2 = acc[ai][bj][m][1];
                    const f32x4 o1 = x1 * cs - x2 * sn, o2 = x1 * sn + x2 * cs;
                    uint2 p1, p2; p1.x = pack2(o1[0], o1[1]); p1.y = pack2(o1[2], o1[3]); p2.x = pack2(o2[0], o2[1]); p2.y = pack2(o2[2], o2[3]);
                    *(uint2*)(dp + bj * 128) = p1; *(uint2*)(dp + bj * 128 + dc) = p2;
                    if (fo != nullptr && row < MCTX) { *(f32x4*)(fp + bj * 128) = o1; *(f32x4*)(fp + bj * 128 + dc) = o2; }
                }
            }
        }
    }
};
struct EpiGate {
    bf16_t* gt; const float* bias;
    __device__ __forceinline__ void operator()(const f32x4 (&acc)[2][2][4][2], const Unit& u, int wr, int wc, int fr, int fq) const {
        const int c0 = u.pn * 256 + wc * 32 + 4 * fq;
        f32x4 bb[4];
#pragma unroll
        for (int g = 0; g < 4; ++g) bb[g] = *(const f32x4*)(bias + c0 + (g >> 1) * 128 + (g & 1) * 16);
#pragma unroll
        for (int ai = 0; ai < 2; ++ai) { if (ai == 1 && u.m192 && wr == 1) continue;
#pragma unroll
            for (int m = 0; m < 4; ++m) { const int row = u.row0 + wr * 64 + fr + ai * 128 + m * 16;
#pragma unroll
                for (int g = 0; g < 4; ++g) { const f32x4 v = acc[ai][g >> 1][m][g & 1];
                    uint2 pk; pk.x = pack2(sigmoidf_(v[0] + bb[g][0]), sigmoidf_(v[1] + bb[g][1])); pk.y = pack2(sigmoidf_(v[2] + bb[g][2]), sigmoidf_(v[3] + bb[g][3]));
                    *(uint2*)(gt + (size_t)row * 1024 + c0 + (g >> 1) * 128 + (g & 1) * 16) = pk; } } }
    }
};
template <int j> struct EpiBranch {
    const bf16_t* gt; float* tmp; bf16_t* mg;
    __device__ __forceinline__ void operator()(const f32x4 (&acc)[2][2][4][2], const Unit& u, int wr, int wc, int fr, int fq) const {
        const int c0 = u.pn * 256 + wc * 32 + 4 * fq;
#pragma unroll
        for (int ai = 0; ai < 2; ++ai) { if (ai == 1 && u.m192 && wr == 1) continue;
#pragma unroll
            for (int m = 0; m < 4; ++m) {
                const unsigned ro = (unsigned)(u.row0 + wr * 64 + fr + ai * 128 + m * 16) * 1024u + (unsigned)c0;
                uint2 gp[4]; f32x4 tv[4];
#pragma unroll
                for (int g = 0; g < 4; ++g) { const unsigned o = ro + (g >> 1) * 128 + (g & 1) * 16;
                    gp[g] = *(const uint2*)(gt + o); tv[g] = (f32x4){0.f, 0.f, 0.f, 0.f}; if (j != 0) tv[g] = *(const f32x4*)(tmp + o); }
#pragma unroll
                for (int g = 0; g < 4; ++g) { const unsigned o = ro + (g >> 1) * 128 + (g & 1) * 16;
                    const f32x4 v = acc[ai][g >> 1][m][g & 1];
                    f32x4 r = tv[g];
                    r[0] += v[0] * bf2f((unsigned short)(gp[g].x & 0xffff)); r[1] += v[1] * bf2f((unsigned short)(gp[g].x >> 16));
                    r[2] += v[2] * bf2f((unsigned short)(gp[g].y & 0xffff)); r[3] += v[3] * bf2f((unsigned short)(gp[g].y >> 16));
                    if (j != 2) *(f32x4*)(tmp + o) = r;
                    else { uint2 pk; pk.x = pack2(r[0], r[1]); pk.y = pack2(r[2], r[3]); *(uint2*)(mg + o) = pk; } }
            } }
    }
};
struct EpiMerge {
    bf16_t* gt; const float* bgate; float* tmp; bf16_t* mg;
    __device__ __forceinline__ void operator()(const f32x4 (&acc)[2][2][4][2], const Unit& u, int wr, int wc, int fr, int fq) const {
        const int j = u.z >> 1;
        if ((u.z & 1) == 0) { EpiGate E{gt, bgate + j * 1024}; E(acc, u, wr, wc, fr, fq); }
        else if (j == 0) { EpiBranch<0> E{gt, tmp, mg}; E(acc, u, wr, wc, fr, fq); }
        else if (j == 1) { EpiBranch<1> E{gt, tmp, mg}; E(acc, u, wr, wc, fr, fq); }
        else { EpiBranch<2> E{gt, tmp, mg}; E(acc, u, wr, wc, fr, fq); }
    }
};
struct EpiRes {
    float* x; const float* mod; int goff; const float* xa; const float* xb;
    __device__ __forceinline__ const float* src(unsigned o) const { return o < (unsigned)MCTX * 1024u ? xa + o : xb + (o - (unsigned)MCTX * 1024u); }
    __device__ __forceinline__ void operator()(const f32x4 (&acc)[2][2][4][2], const Unit& u, int wr, int wc, int fr, int fq) const {
        const int c0 = u.pn * 256 + wc * 32 + 4 * fq;
        const int sg0 = seq_group(u.row0), sg1 = seq_group(u.row0 + (u.m192 ? 191 : 255));
        if (sg0 == sg1) {
            const float* gsrc = mod + sg0 * 6144 + goff;
            f32x4 gg[4];
#pragma unroll
            for (int g = 0; g < 4; ++g) gg[g] = *(const f32x4*)(gsrc + c0 + (g >> 1) * 128 + (g & 1) * 16);
#pragma unroll
            for (int ai = 0; ai < 2; ++ai) { if (ai == 1 && u.m192 && wr == 1) continue;
#pragma unroll
                for (int mp = 0; mp < 2; ++mp) {
                    const unsigned ro = (unsigned)(u.row0 + wr * 64 + fr + ai * 128 + mp * 32) * 1024u + (unsigned)c0;
                    f32x4 xv[8];
#pragma unroll
                    for (int k = 0; k < 8; ++k) { const int g = k & 3; xv[k] = *(const f32x4*)src(ro + (k >> 2) * 16384 + (g >> 1) * 128 + (g & 1) * 16); }
#pragma unroll
                    for (int k = 0; k < 8; ++k) { const int g = k & 3, m = mp * 2 + (k >> 2); *(f32x4*)(x + (ro + (k >> 2) * 16384 + (g >> 1) * 128 + (g & 1) * 16)) = xv[k] + gg[g] * acc[ai][g >> 1][m][g & 1]; }
                } }
        } else {
#pragma unroll
            for (int ai = 0; ai < 2; ++ai) { if (ai == 1 && u.m192 && wr == 1) continue;
#pragma unroll
                for (int m = 0; m < 4; ++m) {
                    const int row = u.row0 + wr * 64 + fr + ai * 128 + m * 16;
                    const float* gsrc = mod + seq_group(row) * 6144 + goff + c0;
                    const unsigned ro = (unsigned)row * 1024u + (unsigned)c0;
                    f32x4 xv[4], gv[4];
#pragma unroll
                    for (int g = 0; g < 4; ++g) { xv[g] = *(const f32x4*)src(ro + (g >> 1) * 128 + (g & 1) * 16); gv[g] = *(const f32x4*)(gsrc + (g >> 1) * 128 + (g & 1) * 16); }
#pragma unroll
                    for (int g = 0; g < 4; ++g) *(f32x4*)(x + (ro + (g >> 1) * 128 + (g & 1) * 16)) = xv[g] + gv[g] * acc[ai][g >> 1][m][g & 1];
                } }
        }
    }
};
struct EpiBf {
    bf16_t* dst; int ld;
    __device__ __forceinline__ void operator()(const f32x4 (&acc)[2][2][4][2], const Unit& u, int wr, int wc, int fr, int fq) const {
        EPI_LOOP_BEGIN
            const int col = u.pn * 256 + cl;
            uint2 pk; pk.x = pack2(v[0], v[1]); pk.y = pack2(v[2], v[3]);
            *(uint2*)(dst + (size_t)row * ld + col) = pk;
        EPI_LOOP_END
    }
};
struct EpiPool {
    bf16_t* dst; const float* scale;
    __device__ __forceinline__ void operator()(const f32x4 (&acc)[2][2][4][2], const Unit& u, int wr, int wc, int fr, int fq) const {
        const int c0 = u.pn * 256 + wc * 32 + 4 * fq;
        f32x4 sc[4];
#pragma unroll
        for (int g = 0; g < 4; ++g) sc[g] = *(const f32x4*)(scale + c0 + (g >> 1) * 128 + (g & 1) * 16);
#pragma unroll
        for (int ai = 0; ai < 2; ++ai)
#pragma unroll
            for (int m = 0; m < 4; ++m) { const int row = u.pm * 256 + wr * 64 + fr + ai * 128 + m * 16;
#pragma unroll
                for (int g = 0; g < 4; ++g) { const f32x4 v = acc[ai][g >> 1][m][g & 1] * sc[g];
                    uint2 pk; pk.x = pack2(v[0], v[1]); pk.y = pack2(v[2], v[3]);
                    *(uint2*)(dst + (size_t)row * 1024 + c0 + (g >> 1) * 128 + (g & 1) * 16) = pk; } }
    }
};

struct WPtrs { const float *w_in, *w_branch, *lru_wa, *lru_wx, *pool_w, *w_out, *ffn_up, *ffn_down; unsigned char* ws; };
struct TileDesc { const float* src; int lds_; bf16_t* dst; int ldd, k0, n0, perm; };
__device__ __forceinline__ int swap45(int p) { return (p & ~48) | ((p & 16) << 1) | ((p & 32) >> 1); }
__device__ __forceinline__ TileDesc weight_tile(const WPtrs& P, int l, int t) {
    unsigned char* ws = P.ws; TileDesc d; int r = t; d.perm = 0;
    if (r < 1664) { d.src = P.w_in + (size_t)l * 1024 * 6656; d.lds_ = 6656; d.dst = (bf16_t*)(ws + OFF_WIN); d.ldd = 1024; d.k0 = (r / 104) * 64; d.n0 = (r % 104) * 64; d.perm = (d.n0 >= 1024 && d.n0 < 2304) ? 1 : 0; }
    else if ((r -= 1664) < 128) { const int mat = r / 64; r %= 64; const int dh = r / 4; r %= 4;
        d.src = (mat ? P.lru_wx : P.lru_wa) + (size_t)(l * 16 + dh) * 128 * 128; d.lds_ = 128; d.dst = (bf16_t*)(ws + OFF_GW) + (size_t)dh * 256 * 128 + (size_t)mat * 128 * 128; d.ldd = 128; d.k0 = (r / 2) * 64; d.n0 = (r % 2) * 64; }
    else if ((r -= 128) < 64) { const int g = r / 16; r %= 16; d.src = P.pool_w + (size_t)(l * 4 + g) * 256 * 256; d.lds_ = 256; d.dst = (bf16_t*)(ws + OFF_PW) + (size_t)g * 256 * 256; d.ldd = 256; d.k0 = (r / 4) * 64; d.n0 = (r % 4) * 64; }
    else if ((r -= 64) < 768) { const int j = r / 256; r %= 256; d.src = P.w_branch + (size_t)(l * 3 + j) * 1024 * 1024; d.lds_ = 1024; d.dst = (bf16_t*)(ws + OFF_WBR) + (size_t)j * 1024 * 1024; d.ldd = 1024; d.k0 = (r / 16) * 64; d.n0 = (r % 16) * 64; }
    else if ((r -= 768) < 256) { d.src = P.w_out + (size_t)l * 1024 * 1024; d.lds_ = 1024; d.dst = (bf16_t*)(ws + OFF_WOUT); d.ldd = 1024; d.k0 = (r / 16) * 64; d.n0 = (r % 16) * 64; }
    else if ((r -= 256) < 1408) { d.src = P.ffn_up + (size_t)l * 1024 * 5632; d.lds_ = 5632; d.dst = (bf16_t*)(ws + OFF_WUP); d.ldd = 1024; d.k0 = (r / 88) * 64; d.n0 = (r % 88) * 64; }
    else { r -= 1408; d.src = P.ffn_down + (size_t)l * 2816 * 1024; d.lds_ = 1024; d.dst = (bf16_t*)(ws + OFF_WDN); d.ldd = 2816; d.k0 = (r / 16) * 64; d.n0 = (r % 16) * 64; }
    return d;
}
__device__ __noinline__ void convert_weights_(const float* p0, const float* p1, const float* p2, const float* p3, const float* p4, const float* p5, const float* p6, const float* p7, unsigned char* pws,
                                              int l, LAS unsigned char* lds, int t_begin, int t_end, int first, int stride) {
    const WPtrs P{p0, p1, p2, p3, p4, p5, p6, p7, pws};
    LAS bf16_t* sm = (LAS bf16_t*)lds;
    const int tid = otid();
    const int kk0 = tid >> 4, n4 = (tid & 15) * 4, nn = tid >> 3, ck = tid & 7;
    int t = t_begin + first;
    if (t >= t_end) return;
    TileDesc d = weight_tile(P, l, t);
    f32x4 v0 = *(const f32x4*)(d.src + (size_t)(d.k0 + kk0) * d.lds_ + d.n0 + n4), v1 = *(const f32x4*)(d.src + (size_t)(d.k0 + kk0 + 32) * d.lds_ + d.n0 + n4);
    for (;;) {
        __syncthreads();
#pragma unroll
        for (int e = 0; e < 4; ++e) { sm[(n4 + e) * 72 + kk0] = f2bf(v0[e]); sm[(n4 + e) * 72 + kk0 + 32] = f2bf(v1[e]); }
        __syncthreads();
        const TileDesc cur = d; const int tn = t + stride; const bool more = tn < t_end;
        if (more) { d = weight_tile(P, l, tn); v0 = *(const f32x4*)(d.src + (size_t)(d.k0 + kk0) * d.lds_ + d.n0 + n4); v1 = *(const f32x4*)(d.src + (size_t)(d.k0 + kk0 + 32) * d.lds_ + d.n0 + n4); }
        const u32x4 o = *(const LAS u32x4*)(sm + nn * 72 + ck * 8);
        const int nrow = cur.perm ? swap45(cur.n0 + nn) : (cur.n0 + nn);
        *(u32x4*)(cur.dst + (size_t)nrow * cur.ldd + cur.k0 + ck * 8) = o;
        if (!more) break;
        t = tn;
    }
    __syncthreads();
}

__device__ __forceinline__ void convert_weights(const Params& P, int l, LAS unsigned char* lds, int t_begin, int t_end, int first, int stride) {
    convert_weights_(P.w_in, P.w_branch, P.lru_wa, P.lru_wx, P.pool_w, P.w_out, P.ffn_up, P.ffn_down, P.ws, l, lds, t_begin, t_end, first, stride);
}

__device__ void phase0(const Params& P, LAS unsigned char* lds) {
    const int tid = otid(), G = gridDim.x, c = blockIdx.x;
    { bf16_t* ck = (bf16_t*)(P.ws + OFF_CK); bf16_t* cv = (bf16_t*)(P.ws + OFF_CV);
      for (int i = c * 512 + tid; i < 2 * 2 * 512 * 256; i += G * 512) {
          const int e = i & 255, t = (i >> 8) & 511, b = (i >> 17) & 1, l = i >> 18;
          const size_t si = ((size_t)((b * 2 + l) * 512 + t)) * 256 + e;
          ck[i] = f2bf(P.cache_k[si]); cv[i] = f2bf(P.cache_v[si]); } }
    { float* rc = (float*)(P.ws + OFF_ROPE); float* rs = rc + 2048;
      for (int i = c * 512 + tid; i < 2048; i += G * 512) {
          const int pos = i >> 5, k = i & 31; const float fr = powf(10000.0f, -(float)k / 32.0f); const float ang = (float)pos * fr;
          rc[i] = cosf(ang); rs[i] = sinf(ang); } }
    { LAS float* sv = (LAS float*)lds;
      LAS float* red = sv + 3072;
      __syncthreads();
      for (int i = tid; i < 3072; i += 512) { const int s = i >> 10, k = i & 1023; const float x = s == 0 ? P.c_ctx[k] : P.c[(s - 1) * 1024 + k]; sv[i] = x / (1.0f + expf(-x)); }
      __syncthreads();
      float* mod = (float*)(P.ws + OFF_MOD);
      for (int it = c; it < 384; it += G) {
          const int l = it / 192, cg_ = it % 192, cl = tid & 31, kg = tid >> 5, col = cg_ * 32 + cl;
          const float* w = P.w_ada + (size_t)l * 1024 * 6144 + col;
          float a0 = 0.f, a1 = 0.f, a2 = 0.f;
#pragma unroll 16
          for (int k = kg * 64; k < kg * 64 + 64; ++k) { const float wv = w[(size_t)k * 6144]; a0 += sv[k] * wv; a1 += sv[1024 + k] * wv; a2 += sv[2048 + k] * wv; }
          red[(kg * 3 + 0) * 32 + cl] = a0; red[(kg * 3 + 1) * 32 + cl] = a1; red[(kg * 3 + 2) * 32 + cl] = a2;
          __syncthreads();
          if (tid < 96) { const int s = tid >> 5, cc = tid & 31; float sum = 0.f;
#pragma unroll
              for (int g = 0; g < 16; ++g) sum += red[(g * 3 + s) * 32 + cc];
              mod[(size_t)(l * 3 + s) * 6144 + cg_ * 32 + cc] = sum + P.b_ada[l * 6144 + cg_ * 32 + cc]; }
          __syncthreads();
      } }
}

template <bool FINAL>
__device__ __forceinline__ void norm_rows(float* X, const float* xa, const float* xb, const float* __restrict__ gw, const float* __restrict__ mod, int shift_off, int scale_off, bf16_t* __restrict__ H) {
    const int tid = otid(); const int lane = tid & 63, wv = blockIdx.x * 8 + (tid >> 6), nw = gridDim.x * 8;
    constexpr int R = 3;
    for (int row0 = wv; row0 < MROWS; row0 += R * nw) {
        f32x4 v[R][4];
#pragma unroll
        for (int r = 0; r < R; ++r) { const int row = row0 + r * nw;
#pragma unroll
            for (int i = 0; i < 4; ++i) v[r][i] = row < MROWS ? *(const f32x4*)((row < MCTX ? xa + (size_t)row * 1024 : xb + (size_t)(row - MCTX) * 1024) + i * 256 + lane * 4) : (f32x4){0.f, 0.f, 0.f, 0.f}; }
#pragma unroll
        for (int r = 0; r < R; ++r) { const int row = row0 + r * nw; if (row >= MROWS) continue;
            float ss = 0.f;
#pragma unroll
            for (int i = 0; i < 4; ++i) ss += v[r][i][0] * v[r][i][0] + v[r][i][1] * v[r][i][1] + v[r][i][2] * v[r][i][2] + v[r][i][3] * v[r][i][3];
#pragma unroll
            for (int o = 32; o >= 1; o >>= 1) ss += __shfl_xor(ss, o);
            const float rstd = rsqrtf(ss * (1.0f / 1024.0f) + 1e-6f);
            const float* md = mod + seq_group(row) * 6144;
#pragma unroll
            for (int i = 0; i < 4; ++i) { const int col = i * 256 + lane * 4;
                const f32x4 g = *(const f32x4*)(gw + col);
                if (FINAL) { f32x4 h;
#pragma unroll
                    for (int e = 0; e < 4; ++e) h[e] = v[r][i][e] * rstd * g[e];
                    *(f32x4*)(X + (size_t)row * 1024 + col) = h; }
                else { const f32x4 sc = *(const f32x4*)(md + scale_off + col), sh = *(const f32x4*)(md + shift_off + col);
                    f32x4 h;
#pragma unroll
                    for (int e = 0; e < 4; ++e) h[e] = v[r][i][e] * rstd * g[e] * (1.0f + sc[e]) + sh[e];
                    uint2 pk; pk.x = pack2(h[0], h[1]); pk.y = pack2(h[2], h[3]);
                    *(uint2*)(H + (size_t)row * 1024 + col) = pk; } }
        }
    }
}
__device__ void norm_phase(const float* xa, const float* xb, const float* __restrict__ gw, const float* __restrict__ mod, int shift_off, int scale_off, bf16_t* __restrict__ H) { norm_rows<false>(nullptr, xa, xb, gw, mod, shift_off, scale_off, H); }
__device__ void final_norm_phase(float* X, const float* __restrict__ gw) { norm_rows<true>(X, X, X + (size_t)MCTX * 1024, gw, nullptr, 0, 0, nullptr); }

template <int HALF>
__device__ __forceinline__ void pool_item(const bf16_t* __restrict__ XC, bf16_t* __restrict__ PL, int it) {
    constexpr int G_ = HALF == 1 ? 0 : (HALF == 2 ? 1 : (HALF == 4 ? 2 : 3));
    const int rs = (it >> 5) * 8, ch = G_ * 256 + (it & 31) * 8;
    const int T = rs < MCTX ? 256 : 2048, row0 = rs < MCTX ? (rs & ~255) : MCTX + ((rs - MCTX) & ~2047), tl0 = rs - row0;
    const bf16_t* base = XC + (size_t)row0 * 1024 + ch;
    constexpr int R = 8 + 2 * HALF;
    bf16x8 xr[R];
#pragma unroll
    for (int i = 0; i < R; ++i) { const int t = tl0 - HALF + i; xr[i] = (bf16x8){0, 0, 0, 0, 0, 0, 0, 0}; if (t >= 0 && t < T) xr[i] = *(const bf16x8*)(base + (size_t)t * 1024); }
    float s[8];
#pragma unroll
    for (int e = 0; e < 8; ++e) { s[e] = 0.f;
#pragma unroll
        for (int i = 0; i < 2 * HALF; ++i) s[e] += bf2f((unsigned short)xr[i][e]); }
#pragma unroll
    for (int j = 0; j < 8; ++j) {
        const int t = tl0 + j;
        const float inv = 1.0f / (float)(min(t + HALF, T) - max(t - HALF, 0));
        float r[8];
#pragma unroll
        for (int e = 0; e < 8; ++e) r[e] = s[e] * inv - bf2f((unsigned short)xr[j + HALF][e]);
        u32x4 o; o.x = pack2(r[0], r[1]); o.y = pack2(r[2], r[3]); o.z = pack2(r[4], r[5]); o.w = pack2(r[6], r[7]);
        *(u32x4*)(PL + (size_t)(row0 + t) * 1024 + ch) = o;
#pragma unroll
        for (int e = 0; e < 8; ++e) s[e] += bf2f((unsigned short)xr[j + 2 * HALF][e]) - bf2f((unsigned short)xr[j][e]);
    }
}
__device__ void pool_phase(const bf16_t* __restrict__ XC, bf16_t* __restrict__ PL) {
    const int tid = otid();
    constexpr int PER_G = (MROWS / 8) * 32;
    for (int idx = blockIdx.x * 512 + tid; idx < 4 * PER_G; idx += gridDim.x * 512) {
        const int g = idx / PER_G, it = idx % PER_G;
        if (g == 0) pool_item<1>(XC, PL, it); else if (g == 1) pool_item<2>(XC, PL, it); else if (g == 2) pool_item<4>(XC, PL, it); else pool_item<8>(XC, PL, it);
    }
}
__device__ __forceinline__ float gelu_tanh(float x) { const float y = 0.7978845608028654f * (x + 0.044715f * x * x * x); const float t = 1.0f - 2.0f * __builtin_amdgcn_rcpf(1.0f + __expf(2.0f * y)); return 0.5f * x * (1.0f + t); }
__device__ void act_phase(const bf16_t* __restrict__ U, bf16_t* __restrict__ ACT, const float* __restrict__ cw, const float* __restrict__ cb) {
    const int tid = otid();
    for (int idx = blockIdx.x * 512 + tid; idx < (MROWS / 16) * 352; idx += gridDim.x * 512) {
        const int rs = (idx / 352) * 16, ch = (idx % 352) * 8;
        const int T = rs < MCTX ? 256 : 2048, row0 = rs < MCTX ? (rs & ~255) : MCTX + ((rs - MCTX) & ~2047), tl0 = rs - row0;
        float w0[8], w1[8], w2[8], bb[8];
#pragma unroll
        for (int e = 0; e < 8; ++e) { w0[e] = cw[ch + e]; w1[e] = cw[2816 + ch + e]; w2[e] = cw[5632 + ch + e]; bb[e] = cb[ch + e]; }
        const bf16_t* up = U + (size_t)rs * 5632 + ch;
        const bf16x8 zero = (bf16x8){0, 0, 0, 0, 0, 0, 0, 0};
        bf16x8 um = tl0 > 0 ? *(const bf16x8*)(up - 5632) : zero;
        bf16x8 u0 = *(const bf16x8*)up;
#pragma unroll 4
        for (int i = 0; i < 16; ++i) {
            const bf16x8 un = (tl0 + i < T - 1) ? *(const bf16x8*)(up + (size_t)(i + 1) * 5632) : zero;
            const bf16x8 vv = *(const bf16x8*)(up + (size_t)i * 5632 + 2816);
            float r[8];
#pragma unroll
            for (int e = 0; e < 8; ++e) { const float gff = w0[e] * bf2f((unsigned short)um[e]) + w1[e] * bf2f((unsigned short)u0[e]) + w2[e] * bf2f((unsigned short)un[e]) + bb[e];
                r[e] = gelu_tanh(gff) * bf2f((unsigned short)vv[e]); }
            u32x4 o; o.x = pack2(r[0], r[1]); o.y = pack2(r[2], r[3]); o.z = pack2(r[4], r[5]); o.w = pack2(r[6], r[7]);
            *(u32x4*)(ACT + (size_t)(rs + i) * 2816 + ch) = o;
            um = u0; u0 = un;
        }
    }
}

__device__ __forceinline__ void rope8(bf16x8& x1, bf16x8& x2, const float* __restrict__ cs, const float* __restrict__ sn) {
#pragma unroll
    for (int e = 0; e < 8; ++e) { const float a = bf2f((unsigned short)x1[e]), b = bf2f((unsigned short)x2[e]); const float c = cs[e], s = sn[e];
        x1[e] = (short)f2bf(a * c - b * s); x2[e] = (short)f2bf(a * s + b * c); }
}
constexpr int VT_OFF = 64 * 272;
constexpr int ABUF = 64 * 272 + 64 * 288;
__device__ void attn_unit(const Params& P, int l, int u, LAS unsigned char* lds) {
    int tid_ = threadIdx.x; asm volatile("" : "+v"(tid_));
    const int tid = tid_, w = tid >> 6, lane = tid & 63, fr = lane & 15, fq = lane >> 4;
    const bf16_t* Q = (const bf16_t*)(P.ws + OFF_XAQ) + (size_t)MROWS * 1024;
    const bf16_t* KB = (const bf16_t*)(P.ws + OFF_KB); const bf16_t* VB = (const bf16_t*)(P.ws + OFF_VB);
    const bf16_t* CK = (const bf16_t*)(P.ws + OFF_CK); const bf16_t* CV = (const bf16_t*)(P.ws + OFF_CV);
    bf16_t* YB = (bf16_t*)(P.ws + OFF_YB);
    bool lat; int head, row0, T, qstart, bidx;
    if (u < 256) { lat = true; bidx = u >> 7; const int rem = u & 127; head = rem >> 4; qstart = (rem & 15) * 128; T = 2048; row0 = MCTX + bidx * 2048; }
    else { const int v = u - 256; lat = false; bidx = 0; const int seq = v >> 4, rem = v & 15; head = rem >> 1; qstart = (rem & 1) * 128; T = 256; row0 = seq * 256; }
    const int kvh = head >> 2;
    const int qpos = qstart + w * 16 + fr;
    bf16x8 qf[4];
    { const bf16_t* qp = Q + (size_t)(row0 + qpos) * 1024 + head * 128 + fq * 8;
#pragma unroll
      for (int kk = 0; kk < 4; ++kk) qf[kk] = *(const bf16x8*)(qp + kk * 32); }
    float m_run = P.attn_sink[l * 8 + head] * 1.4426950408889634f; float l_run = (fq == 0) ? 1.0f : 0.0f;
    f32x4 o[8];
#pragma unroll
    for (int dt = 0; dt < 8; ++dt) o[dt] = (f32x4){0.f, 0.f, 0.f, 0.f};
    int wlo = 0, nwt = 4;
    if (lat) { wlo = max(0, qstart - 128); const int whi = min(T, qstart + 256); nwt = (whi - wlo) >> 6; }
    const int ntiles = nwt + (lat ? 8 : 0);
    const float scale = 0.08838834764831845f * 1.4426950408889634f;
    const int lkey = tid >> 3, lp = tid & 7;
    bf16x8 rk[2][2], rv[2][2];
    auto tile_load = [&](int ti, bf16x8 (&k_)[2], bf16x8 (&v_)[2]) {
        const bf16_t* ksrc; const bf16_t* vsrc;
        if (ti < nwt) { const int k0 = wlo + ti * 64; ksrc = KB + (size_t)(row0 + k0) * 256 + kvh * 128; vsrc = VB + (size_t)(row0 + k0) * 256 + kvh * 128; }
        else { const int k0 = (ti - nwt) * 64; const size_t o_ = ((size_t)((l * 2 + bidx) * 512 + k0)) * 256 + kvh * 128; ksrc = CK + o_; vsrc = CV + o_; }
        const bf16_t* kr = ksrc + (size_t)lkey * 256; k_[0] = *(const bf16x8*)(kr + lp * 8); k_[1] = *(const bf16x8*)(kr + (lp + 8) * 8);
        const bf16_t* vr = vsrc + (size_t)lkey * 256; v_[0] = *(const bf16x8*)(vr + lp * 8); v_[1] = *(const bf16x8*)(vr + (lp + 8) * 8); };
    const int krow = (lkey & 32) | ((lkey & 4) << 2) | ((lkey & 24) >> 1) | (lkey & 3);
    auto tile_store = [&](int b, const bf16x8 (&k_)[2], const bf16x8 (&v_)[2]) {
        LAS unsigned char* kb_ = lds + b * ABUF; LAS unsigned char* vb_ = kb_ + VT_OFF;
        *(LAS bf16x8*)(kb_ + krow * 272 + lp * 16) = k_[0]; *(LAS bf16x8*)(kb_ + krow * 272 + (lp + 8) * 16) = k_[1];
        *(LAS bf16x8*)(vb_ + lkey * 288 + lp * 16) = v_[0]; *(LAS bf16x8*)(vb_ + lkey * 288 + (lp + 8) * 16) = v_[1]; };
    tile_load(0, rk[0], rv[0]);
    tile_load(1, rk[1], rv[1]);
    __syncthreads();
    tile_store(0, rk[0], rv[0]);
    tile_load(2, rk[0], rv[0]);
#pragma unroll 2
    for (int ti = 0; ti < ntiles; ++ti) {
        const bool win = ti < nwt; const int k0 = win ? wlo + ti * 64 : (ti - nwt) * 64;
        __syncthreads();
        if ((ti & 1) == 0) { if (ti + 1 < ntiles) tile_store(1, rk[1], rv[1]); if (ti + 3 < ntiles) tile_load(ti + 3, rk[1], rv[1]); }
        else { if (ti + 1 < ntiles) tile_store(0, rk[0], rv[0]); if (ti + 3 < ntiles) tile_load(ti + 3, rk[0], rv[0]); }
        LAS unsigned char* kb_ = lds + (ti & 1) * ABUF; LAS unsigned char* vb_ = kb_ + VT_OFF;
        f32x4 s[4];
#pragma unroll
        for (int nt = 0; nt < 4; ++nt) { s[nt] = (f32x4){0.f, 0.f, 0.f, 0.f};
#pragma unroll
            for (int kk = 0; kk < 4; ++kk) { const bf16x8 a = *(const LAS bf16x8*)(kb_ + (nt * 16 + fr) * 272 + kk * 64 + fq * 16); s[nt] = __builtin_amdgcn_mfma_f32_16x16x32_bf16(a, qf[kk], s[nt], 0, 0, 0); } }
        float mt = -3.0e38f;
#pragma unroll
        for (int nt = 0; nt < 4; ++nt)
#pragma unroll
            for (int j = 0; j < 4; ++j) { float v = s[nt][j] * scale;
                if (lat && win) { const int kp = k0 + 32 * (nt >> 1) + 8 * fq + 4 * (nt & 1) + j; const int dd = qpos - kp; if (dd > 128 || dd < -128) v = -1.0e30f; }
                s[nt][j] = v; mt = fmaxf(mt, v); }
        mt = fmaxf(mt, __shfl_xor(mt, 16)); mt = fmaxf(mt, __shfl_xor(mt, 32));
        const float mn = fmaxf(m_run, mt); const float alpha = __builtin_amdgcn_exp2f(m_run - mn); m_run = mn;
        float ps = 0.f;
#pragma unroll
        for (int nt = 0; nt < 4; ++nt)
#pragma unroll
            for (int j = 0; j < 4; ++j) { const float p = __builtin_amdgcn_exp2f(s[nt][j] - mn); ps += p; s[nt][j] = p; }
        l_run = l_run * alpha + ps;
#pragma unroll
        for (int dt = 0; dt < 8; ++dt) o[dt] = o[dt] * alpha;
#pragma unroll
        for (int s2 = 0; s2 < 2; ++s2) {
            u32x4 pu; pu[0] = pack2(s[2 * s2][0], s[2 * s2][1]); pu[1] = pack2(s[2 * s2][2], s[2 * s2][3]); pu[2] = pack2(s[2 * s2 + 1][0], s[2 * s2 + 1][1]); pu[3] = pack2(s[2 * s2 + 1][2], s[2 * s2 + 1][3]);
            const bf16x8 pf = __builtin_bit_cast(bf16x8, pu);
#pragma unroll
            for (int dt = 0; dt < 8; ++dt) {
                const bf16x4 lo = __builtin_amdgcn_ds_read_tr16_b64_v4i16((LAS bf16x4*)(vb_ + (s2 * 32 + fq * 8 + (fr >> 2)) * 288 + (dt * 16 + (fr & 3) * 4) * 2));
                const bf16x4 hi = __builtin_amdgcn_ds_read_tr16_b64_v4i16((LAS bf16x4*)(vb_ + (s2 * 32 + fq * 8 + 4 + (fr >> 2)) * 288 + (dt * 16 + (fr & 3) * 4) * 2));
                const bf16x8 af = __builtin_shufflevector(lo, hi, 0, 1, 2, 3, 4, 5, 6, 7);
                o[dt] = __builtin_amdgcn_mfma_f32_16x16x32_bf16(af, pf, o[dt], 0, 0, 0);
            }
        }
    }
    float lt = l_run; lt += __shfl_xor(lt, 16); lt += __shfl_xor(lt, 32);
    const float inv = 1.0f / lt;
    bf16_t* yp = YB + (size_t)(row0 + qpos) * 1024 + head * 128 + fq * 4;
#pragma unroll
    for (int dt = 0; dt < 8; ++dt) { uint2 pk; pk.x = pack2(o[dt][0] * inv, o[dt][1] * inv); pk.y = pack2(o[dt][2] * inv, o[dt][3] * inv); *(uint2*)(yp + dt * 16) = pk; }
}

constexpr int YT_OFF = 256 * 272;
template <int MODE, int D, int NSC>
__device__ __forceinline__ void lru_dir(const Params& P, int l, int s, int cchunk, int h, LAS unsigned char* lds, int w, int fr, int fq) {
    const bool lat = s >= 32; const int row0 = lat ? MCTX + (s - 32) * 2048 : s * 256; const int t0 = cchunk * (NSC * 64);
    constexpr int NCH = 2048 / (NSC * 64);
    const bf16_t* GW = (const bf16_t*)(P.ws + OFF_GW);
    bf16_t* YA = (bf16_t*)(P.ws + OFF_YA);
    float* SUMM = (float*)(P.ws + OFF_SUMM);
    const int chl = 16 * w + fr, ch = h * 128 + chl;
    bf16x8 bwa[4], bwx[4];
    { const bf16_t* gp = GW + ((size_t)(D * 8 + h) * 256 + chl) * 128 + fq * 8;
#pragma unroll
      for (int kk = 0; kk < 4; ++kk) { bwa[kk] = *(const bf16x8*)(gp + kk * 32); bwx[kk] = *(const bf16x8*)(gp + 128 * 128 + kk * 32); } }
    const int pidx = (l * 2 + D) * 1024 + ch;
    const float ba = P.lru_ba[pidx], bx = P.lru_bx[pidx];
    const float lam = P.lru_lambda[pidx];
    const float c8 = -8.0f * log1pf(expf(-lam));
    float carry = 0.f;
    if (MODE == 0 && lat) {
        const int b = s - 32;
        carry = P.state_lru[((size_t)(b * 2 + l) * 2 + D) * 1024 + ch];
        if (D == 0) { for (int cc = 0; cc < cchunk; ++cc) { const float* sp = SUMM + ((size_t)((b * 2 + 0) * 16 + cc) * 1024 + ch) * 2; carry = sp[1] + sp[0] * carry; } }
        else { for (int cc = NCH - 1; cc > cchunk; --cc) { const float* sp = SUMM + ((size_t)((b * 2 + 1) * 16 + cc) * 1024 + ch) * 2; carry = sp[1] + sp[0] * carry; } }
    }
    float ptot = 1.0f;
#pragma unroll 1
    for (int sci = 0; sci < NSC; ++sci) {
        const int sc = D == 0 ? sci : NSC - 1 - sci;
        f32x4 r[4], g[4];
#pragma unroll
        for (int m = 0; m < 4; ++m) { r[m] = (f32x4){0.f, 0.f, 0.f, 0.f}; g[m] = (f32x4){0.f, 0.f, 0.f, 0.f};
#pragma unroll
            for (int kk = 0; kk < 4; ++kk) { const bf16x8 a = *(const LAS bf16x8*)(lds + (sc * 64 + m * 16 + fr) * 272 + kk * 64 + fq * 16);
                r[m] = __builtin_amdgcn_mfma_f32_16x16x32_bf16(a, bwa[kk], r[m], 0, 0, 0); g[m] = __builtin_amdgcn_mfma_f32_16x16x32_bf16(a, bwx[kk], g[m], 0, 0, 0); } }
#pragma unroll
        for (int mi = 0; mi < 4; ++mi) {
            const int m = D == 0 ? mi : 3 - mi;
            float av[4], bv[4];
#pragma unroll
            for (int j = 0; j < 4; ++j) {
                const float ea = 1.0f + __expf(-(r[m][j] + ba)), eb = 1.0f + __expf(-(g[m][j] + bx));
                const float inv = __builtin_amdgcn_rcpf(ea * eb);
                const float rr = inv * eb, ii = inv * ea;
                const float la = c8 * rr; const float a = __expf(la); const float z = 2.0f * la;
                const float em = (z > -0.05f) ? -z * (1.0f + z * (0.5f + z * (0.16666667f + z * 0.041666667f))) : 1.0f - a * a;
                const float x = bf2f(*(const LAS bf16_t*)(lds + (sc * 64 + m * 16 + fq * 4 + j) * 272 + chl * 2));
                av[j] = a; bv[j] = __builtin_amdgcn_sqrtf(em) * ii * x;
            }
            float p4, h4;
            p4 = av[0] * av[1] * av[2] * av[3];
            if (D == 0) h4 = ((bv[0] * av[1] + bv[1]) * av[2] + bv[2]) * av[3] + bv[3];
            else h4 = ((bv[3] * av[2] + bv[2]) * av[1] + bv[1]) * av[0] + bv[0];
            float pq[4], hq[4];
#pragma unroll
            for (int f = 0; f < 4; ++f) { pq[f] = __shfl(p4, fr + 16 * f); hq[f] = __shfl(h4, fr + 16 * f); }
            float cin = carry, mycin = 0.f;
#pragma unroll
            for (int fi = 0; fi < 4; ++fi) { const int f = D == 0 ? fi : 3 - fi; if (f == fq) mycin = cin; cin = hq[f] + pq[f] * cin; }
            carry = cin;
            if (MODE == 1) ptot *= pq[0] * pq[1] * pq[2] * pq[3];
            if (MODE == 0) {
                float hh = mycin; float y[4];
#pragma unroll
                for (int ji = 0; ji < 4; ++ji) { const int j = D == 0 ? ji : 3 - ji; hh = av[j] * hh + bv[j]; y[j] = hh; }
#pragma unroll
                for (int j = 0; j < 4; ++j) {
                    LAS bf16_t* yp = (LAS bf16_t*)(lds + YT_OFF + (sc * 64 + m * 16 + fq * 4 + j) * 272 + chl * 2);
                    if (D == 0) *yp = f2bf(y[j]);
                    else *yp = f2bf(bf2f(*yp) + y[j]);
                }
            }
        }
    }
    if (MODE == 0 && !lat && fq == 0) P.out[OUT_H + ((size_t)(s * 2 + l) * 2 + D) * 1024 + ch] = carry;
    if (MODE == 1 && fq == 0) { float* sp = SUMM + ((size_t)(((s - 32) * 2 + D) * 16 + cchunk) * 1024 + ch) * 2; sp[0] = ptot; sp[1] = carry; }
}
template <int MODE, int NSC>
__device__ void lru_unit(const Params& P, int l, int s, int cchunk, int h, LAS unsigned char* lds) {
    int tid_ = threadIdx.x; asm volatile("" : "+v"(tid_));
    const int tid = tid_, w = tid >> 6, lane = tid & 63, fr = lane & 15, fq = lane >> 4;
    const bool lat = s >= 32; const int T = lat ? 2048 : 256; const int row0 = lat ? MCTX + (s - 32) * 2048 : s * 256; const int t0 = cchunk * (NSC * 64);
    const bf16_t* XA = (const bf16_t*)(P.ws + OFF_XAQ);
    constexpr int RUN = NSC * 2;
    {
        const int ck = tid & 15, ch = h * 128 + ck * 8, tr = (tid >> 4) * RUN;
        const float* cw = P.lru_conv + (size_t)l * 4096 + ch; const float* cb = P.lru_conv_b + l * 1024 + ch;
        bf16x8 xr[RUN + 3];
#pragma unroll
        for (int i = 0; i < RUN + 3; ++i) { const int tt = t0 + tr + i - 2; xr[i] = (bf16x8){0, 0, 0, 0, 0, 0, 0, 0};
            if (tt >= 0 && tt < T) xr[i] = *(const bf16x8*)(XA + (size_t)(row0 + tt) * 1024 + ch); }
        float wk[4][8], bk[8];
#pragma unroll
        for (int e = 0; e < 8; ++e) { bk[e] = cb[e];
#pragma unroll
            for (int k = 0; k < 4; ++k) wk[k][e] = cw[k * 1024 + e]; }
        __syncthreads();
#pragma unroll
        for (int i = 0; i < RUN; ++i) {
            float a8[8];
#pragma unroll
            for (int e = 0; e < 8; ++e) { a8[e] = bk[e];
#pragma unroll
                for (int k = 0; k < 4; ++k) a8[e] += wk[k][e] * bf2f((unsigned short)xr[i + k][e]); }
            u32x4 o; o.x = pack2(a8[0], a8[1]); o.y = pack2(a8[2], a8[3]); o.z = pack2(a8[4], a8[5]); o.w = pack2(a8[6], a8[7]);
            *(LAS u32x4*)(lds + (tr + i) * 272 + ck * 16) = o;
        }
    }
    __syncthreads();
    lru_dir<MODE, 0, NSC>(P, l, s, cchunk, h, lds, w, fr, fq);
    lru_dir<MODE, 1, NSC>(P, l, s, cchunk, h, lds, w, fr, fq);
    if (MODE == 0) {
        bf16_t* YA = (bf16_t*)(P.ws + OFF_YA);
        __syncthreads();
#pragma unroll
        for (int it = 0; it < 2 * NSC; ++it) { const int t = (tid >> 4) + it * 32, ck = tid & 15;
            const u32x4 v = *(const LAS u32x4*)(lds + YT_OFF + t * 272 + ck * 16);
            *(u32x4*)(YA + (size_t)(row0 + t0 + t) * 1024 + h * 128 + ck * 8) = v; }
    }
}

#define XB_TMO      128
#define XB_XCNT(j)  (256  + 64 * (j))
#define XB_XSUB(j)  (1280 + 64 * (j))
#define XB_XGEN(j)  (2304 + 64 * (j))
#define XB_TOP      3328
#define XB_TOPGEN   3392
#define XCD_BAR_WORDS 3456
#define XB_SPIN_CAP (1u << 18)
__device__ __forceinline__ unsigned xb_ld(unsigned* p)              { return __hip_atomic_load(p, __ATOMIC_RELAXED, __HIP_MEMORY_SCOPE_AGENT); }
__device__ __forceinline__ unsigned xb_add(unsigned* p, unsigned v) { return __hip_atomic_fetch_add(p, v, __ATOMIC_RELAXED, __HIP_MEMORY_SCOPE_AGENT); }
__device__ __forceinline__ unsigned xb_xcc_id() { return (unsigned)__builtin_amdgcn_s_getreg((3 << 11) | 20) & 0xFu; }
#define XB_SPIN(cond, bar) do { unsigned _sp = 0; while (cond) { __builtin_amdgcn_s_sleep(1); \
    if ((++_sp & 255u) == 0u) { if (xb_ld(&(bar)[XB_TMO])) break; if (_sp > XB_SPIN_CAP) { atomicAdd(&(bar)[XB_TMO], 1u); break; } } } } while (0)
struct XcdBarrier { unsigned* bar; unsigned x; volatile LAS unsigned* st; };
__device__ __forceinline__ XcdBarrier xcd_barrier_post(unsigned* bar, volatile LAS unsigned* st) {
    XcdBarrier b; b.bar = bar; b.x = xb_xcc_id(); b.st = st;
    if (threadIdx.x == 0) (void)xb_add(&bar[XB_XCNT(b.x)], 1u);
    return b;
}
__device__ __forceinline__ void xcd_barrier_complete(unsigned* bar, unsigned x, unsigned& nloc, unsigned& nx) {
    const unsigned G = gridDim.x * gridDim.y * gridDim.z;
    unsigned sum, cnt, mine, sp = 0u;
    for (;;) {
        sum = 0u; cnt = 0u; mine = 0u;
#pragma unroll
        for (unsigned j = 0; j < 16; ++j) { const unsigned c = xb_ld(&bar[XB_XCNT(j)]); sum += c; cnt += (c > 0u) ? 1u : 0u; mine = (j == x) ? c : mine; }
        if (sum == G) break;
        __builtin_amdgcn_s_sleep(1);
        if ((++sp & 255u) == 0u) { if (xb_ld(&bar[XB_TMO])) break; if (sp > XB_SPIN_CAP) { atomicAdd(&bar[XB_TMO], 1u); break; } }
    }
    nloc = mine > 0u ? mine : 1u; nx = cnt > 0u ? cnt : 1u;
}
__device__ __noinline__ void xcd_barrier_(unsigned* bbar, unsigned bx, volatile LAS unsigned* bst) {
    XcdBarrier b; b.bar = bbar; b.x = bx; b.st = bst;
    asm volatile("s_waitcnt vmcnt(0)" ::: "memory");
    __syncthreads();
    if (threadIdx.x == 0) {
        unsigned* bar = b.bar;
        __builtin_amdgcn_s_waitcnt(0);
        unsigned nloc = b.st[0], nx = b.st[1];
        if (nloc == 0u) { xcd_barrier_complete(bar, b.x, nloc, nx); b.st[0] = nloc; b.st[1] = nx; }
        const unsigned old = xb_add(&bar[XB_XSUB(b.x)], 1u);
        const unsigned gen = old / nloc;
        if (old + 1u == (gen + 1u) * nloc) {
            __builtin_amdgcn_fence(__ATOMIC_RELEASE, "agent");
            asm volatile("s_waitcnt vmcnt(0)" ::: "memory");
            const unsigned og = xb_add(&bar[XB_TOP], 1u);
            const unsigned tg = og / nx;
            if (og + 1u == (tg + 1u) * nx) xb_add(&bar[XB_TOPGEN], 1u);
            else XB_SPIN(xb_ld(&bar[XB_TOPGEN]) == tg, bar);
            __builtin_amdgcn_fence(__ATOMIC_ACQUIRE, "agent");
            xb_add(&bar[XB_XGEN(b.x)], 1u);
            asm volatile("s_waitcnt vmcnt(0)" ::: "memory");
        } else {
            XB_SPIN(xb_ld(&bar[XB_XGEN(b.x)]) == gen, bar);
            __builtin_amdgcn_fence(__ATOMIC_ACQUIRE, "agent");
            asm volatile("s_waitcnt vmcnt(0)" ::: "memory");
        }
    }
    __syncthreads();
}

#ifndef REPMASK
#define REPMASK 0
#endif
#define REPLOOP(i) _Pragma("unroll 1") for (int rep_ = 0; rep_ < 1 + ((REPMASK >> (i)) & 1); ++rep_)
__global__ __launch_bounds__(512, 2) void mega(Params P) {
    extern __shared__ __attribute__((aligned(16))) unsigned char shm[];
    LAS unsigned char* lds = (LAS unsigned char*)shm;
    cg::grid_group grid = cg::this_grid();
    if (threadIdx.x == 0) *(LAS u32x4*)(lds + 147456) = (u32x4){0u, 0u, 0u, 0u};
    __syncthreads();
    const XcdBarrier xb = xcd_barrier_post((unsigned*)(P.ws + OFF_BAR), (volatile LAS unsigned*)(lds + 147456));
    const int G = gridDim.x, c = blockIdx.x;
    unsigned char* ws = P.ws;
    float* X = P.out;
    bf16_t* H = (bf16_t*)(ws + OFF_H);
    const float* MOD = (const float*)(ws + OFF_MOD);

    REPLOOP(12) phase0(P, lds);
    grid.sync();
    for (int l = 0; l < 2; ++l) {
        const float* mod = MOD + (size_t)l * 3 * 6144;
        const bool hide = (G == 256);
        { const int te = hide ? (l == 0 ? 1856 : 0) : 4992; if (te > 0) convert_weights(P, l, lds, 0, te, c, G); }
        const float* xa0 = l == 0 ? P.x_prompt : X; const float* xb0 = l == 0 ? P.x_sample : X + (size_t)MCTX * 1024;
        REPLOOP(1) norm_phase(xa0, xb0, P.norm1 + l * 1024, mod, 0, 1024, H);
        REPLOOP(11) xcd_barrier_(xb.bar, xb.x, xb.st);
        REPLOOP(2) { Sched S{(const char*)H, (const char*)(ws + OFF_WIN), 1024, 1024, 0, 48, 14, G, c, 256};
          EpiIn E{(bf16_t*)(ws + OFF_XAQ), (bf16_t*)(ws + OFF_XC), (bf16_t*)(ws + OFF_KB), (bf16_t*)(ws + OFF_VB), P.out + OUT_K, P.out + OUT_V, (const float*)(ws + OFF_ROPE), l};
          gemm_phase(lds, S, 1024, E); }
        if (hide && l == 0 && c >= 160) convert_weights(P, l, lds, 1856, 2624, c - 160, G - 160);
        REPLOOP(11) xcd_barrier_(xb.bar, xb.x, xb.st);
        REPLOOP(3) pool_phase((const bf16_t*)(ws + OFF_XC), (bf16_t*)(ws + OFF_PL));
        for (int it = c; it < 1280; it += G) {
            if (it < 256) { REPLOOP(4) attn_unit(P, l, it, lds); }
            else if (it < 512) { const int v = it - 256; REPLOOP(5) lru_unit<0, 4>(P, l, v >> 3, 0, v & 7, lds); }
            else if (it < 768) { const int q = it - 512; REPLOOP(5) lru_unit<1, 2>(P, l, 32 + (q >> 7), (q >> 3) & 15, q & 7, lds); }
            else { REPLOOP(7) attn_unit(P, l, it - 768 + 256, lds); }
        }
        REPLOOP(11) xcd_barrier_(xb.bar, xb.x, xb.st);
        { Sched S{(const char*)(ws + OFF_PL), (const char*)(ws + OFF_PW), 1024, 256, 256, 48, 4, G, c, 256};
          EpiPool E{(bf16_t*)(ws + OFF_XC), P.pool_scale + l * 1024};
          gemm_phase(lds, S, 256, E); }
#ifndef NO_LRU
        for (int it = G - 1 - c; it < 256; it += G) lru_unit<0, 2>(P, l, 32 + (it >> 7), (it >> 3) & 15, it & 7, lds);
#endif
        REPLOOP(11) xcd_barrier_(xb.bar, xb.x, xb.st);
        REPLOOP(6) { MergeSched S{(const char*)ws, 1024, 1024, c};
          EpiMerge E{(bf16_t*)(ws + OFF_GT), P.b_gate + l * 3072, (float*)(ws + OFF_XAQ), (bf16_t*)(ws + OFF_PL)};
          gemm_phase(lds, S, 1024, E); }
        if (hide && c >= 192) convert_weights(P, l, lds, 2624, 4992, c - 192, G - 192);
        REPLOOP(11) xcd_barrier_(xb.bar, xb.x, xb.st);
        { Sched S{(const char*)(ws + OFF_PL), (const char*)(ws + OFF_WOUT), 1024, 1024, 0, 64, 4, G, c, 192};
          EpiRes E{X, mod, 2048, xa0, xb0};
          gemm_phase<EpiRes, Sched, true>(lds, S, 1024, E); }
        REPLOOP(11) xcd_barrier_(xb.bar, xb.x, xb.st);
        norm_phase(X, X + (size_t)MCTX * 1024, P.norm2 + l * 1024, mod, 3072, 4096, H);
        REPLOOP(11) xcd_barrier_(xb.bar, xb.x, xb.st);
        REPLOOP(9) { Sched S{(const char*)H, (const char*)(ws + OFF_WUP), 1024, 1024, 0, 48, 22, G, c, 256};
          EpiBf E{(bf16_t*)(ws + OFF_U), 5632};
          gemm_phase(lds, S, 1024, E); }
        if (hide && l == 0 && c >= 32) convert_weights(P, l + 1, lds, 0, 2624, c - 32, G - 32);
        REPLOOP(11) xcd_barrier_(xb.bar, xb.x, xb.st);
        REPLOOP(10) act_phase((const bf16_t*)(ws + OFF_U), (bf16_t*)(ws + OFF_ACT), P.ffn_conv + (size_t)l * 3 * 2816, P.ffn_conv_b + l * 2816);
        REPLOOP(11) xcd_barrier_(xb.bar, xb.x, xb.st);
        { Sched S{(const char*)(ws + OFF_ACT), (const char*)(ws + OFF_WDN), 2816, 2816, 0, 64, 4, G, c, 192};
          EpiRes E{X, mod, 5120, X, X + (size_t)MCTX * 1024};
          gemm_phase<EpiRes, Sched, true>(lds, S, 2816, E); }
        REPLOOP(11) xcd_barrier_(xb.bar, xb.x, xb.st);
    }
    final_norm_phase(X, P.final_norm);
}

extern "C" void kernel_launch(void* const* d_in, const int* in_sizes, int n_in, void* d_out, int out_size, void* d_ws, size_t ws_size, hipStream_t stream) {
    constexpr size_t kDynLds = 147456 + 16;
    static int grid_blocks = 0;
    if (!grid_blocks) {
        int dev = 0, cus = 0, per_cu = 0;
        hipGetDevice(&dev);
        hipDeviceGetAttribute(&cus, hipDeviceAttributeMultiprocessorCount, dev);
        hipFuncSetAttribute((const void*)mega, hipFuncAttributeMaxDynamicSharedMemorySize, (int)kDynLds);
        hipOccupancyMaxActiveBlocksPerMultiprocessor(&per_cu, mega, 512, kDynLds);
        if (per_cu < 1) per_cu = 1;
        if (per_cu > 1) per_cu = 1;
        grid_blocks = cus * per_cu;
    }
    Params p{};
    const float** pp = (const float**)&p;
    for (int i = 0; i < 30; ++i) pp[i] = (const float*)d_in[i];
    p.out = (float*)d_out; p.ws = (unsigned char*)d_ws;
    if (ws_size < OFF_END) { fprintf(stderr, "workspace too small: %zu < %zu\n", ws_size, (size_t)OFF_END); }
    hipMemsetAsync((unsigned char*)d_ws + OFF_BAR, 0, 16384, stream);
    void* args[] = {&p};
    hipError_t e = hipLaunchCooperativeKernel((void*)mega, dim3(grid_blocks), dim3(512), args, kDynLds, stream);
    if (e != hipSuccess) fprintf(stderr, "cooperative launch failed: %s (grid %d)\n", hipGetErrorString(e), grid_blocks);
}
```

```cpp
#include <hip/hip_runtime.h>
#include <hip/hip_cooperative_groups.h>
#include <cstdio>
namespace cg = cooperative_groups;

#define LAS __attribute__((address_space(3)))
typedef unsigned short bf16_t;
typedef short bf16x8 __attribute__((ext_vector_type(8)));
typedef float f32x4 __attribute__((ext_vector_type(4)));
typedef unsigned u32x4 __attribute__((ext_vector_type(4)));
typedef unsigned u32x2 __attribute__((ext_vector_type(2)));
typedef short bf16x4 __attribute__((ext_vector_type(4)));

constexpr int MROWS = 12288, MCTX = 8192;
constexpr size_t S24 = (size_t)MROWS * 1024 * 2;
constexpr size_t OFF_WIN = 0;
constexpr size_t OFF_WBR = OFF_WIN + (size_t)6656 * 1024 * 2;
constexpr size_t OFF_WOUT = OFF_WBR + (size_t)3 * 1024 * 1024 * 2;
constexpr size_t OFF_WUP = OFF_WOUT + (size_t)1024 * 1024 * 2;
constexpr size_t OFF_WDN = OFF_WUP + (size_t)5632 * 1024 * 2;
constexpr size_t OFF_GW = OFF_WDN + (size_t)1024 * 2816 * 2;
constexpr size_t OFF_PW = OFF_GW + (size_t)2 * 8 * 256 * 128 * 2;
constexpr size_t OFF_MOD = OFF_PW + (size_t)4 * 256 * 256 * 2;
constexpr size_t OFF_CK = OFF_MOD + (size_t)2 * 3 * 6144 * 4;
constexpr size_t OFF_CV = OFF_CK + (size_t)2 * 2 * 512 * 256 * 2;
constexpr size_t OFF_ROPE = OFF_CV + (size_t)2 * 2 * 512 * 256 * 2;
constexpr size_t OFF_SUMM = OFF_ROPE + (size_t)2 * 64 * 32 * 4;
constexpr size_t OFF_BAR = OFF_SUMM + (size_t)2 * 2 * 16 * 1024 * 2 * 4;
constexpr size_t OFF_ACT0 = OFF_BAR + 16384;
constexpr size_t OFF_XAQ = OFF_ACT0;
constexpr size_t OFF_XC = OFF_XAQ + 2 * S24;
constexpr size_t OFF_KB = OFF_XC + S24;
constexpr size_t OFF_VB = OFF_KB + (size_t)MROWS * 256 * 2;
constexpr size_t OFF_GT = OFF_VB + (size_t)MROWS * 256 * 2;
constexpr size_t OFF_YB = OFF_GT + S24;
constexpr size_t OFF_PL = OFF_YB + S24;
constexpr size_t OFF_YA = OFF_PL + S24;
constexpr size_t OFF_H = OFF_YA + S24;
constexpr size_t OFF_END = OFF_H + S24;
constexpr size_t OFF_ACT = OFF_XAQ;
constexpr size_t OFF_SU = OFF_END;
constexpr size_t OFF_SV = OFF_SU + (size_t)192 * 4 * 2816 * 2;
constexpr size_t OFF_END2 = OFF_SV + (size_t)192 * 2 * 2816 * 2;
constexpr size_t OUT_K = (size_t)MROWS * 1024;
constexpr size_t OUT_V = OUT_K + (size_t)32 * 2 * 256 * 256;
constexpr size_t OUT_H = OUT_V + (size_t)32 * 2 * 256 * 256;

struct Params {
    const float *x_prompt, *x_sample, *cache_k, *cache_v, *state_lru, *c, *c_ctx, *w_ada, *b_ada, *norm1, *norm2,
        *w_in, *b_gate, *lru_conv, *lru_conv_b, *lru_wa, *lru_ba, *lru_wx, *lru_bx, *lru_lambda, *attn_sink,
        *pool_w, *pool_scale, *w_branch, *w_out, *ffn_up, *ffn_conv, *ffn_conv_b, *ffn_down, *final_norm;
    float* out; unsigned char* ws;
};

typedef float f32x2_ __attribute__((ext_vector_type(2)));
typedef __bf16 bf16x2_ __attribute__((ext_vector_type(2)));
__device__ __forceinline__ unsigned pack2(float a, float b) { const f32x2_ v = {a, b}; const bf16x2_ r = __builtin_convertvector(v, bf16x2_); return __builtin_bit_cast(unsigned, r); }
__device__ __forceinline__ unsigned short f2bf(float f) { return (unsigned short)(pack2(f, f) & 0xffffu); }
__device__ __forceinline__ float bf2f(unsigned short b) { return __uint_as_float(((unsigned)b) << 16); }
__device__ __forceinline__ int otid() { int t = threadIdx.x; asm volatile("" : "+v"(t)); return t; }
__device__ __forceinline__ float sigmoidf_(float x) { return __builtin_amdgcn_rcpf(1.0f + __expf(-x)); }

constexpr int HTB = 128 * 64 * 2;
__device__ __forceinline__ int lds_byte(int r, int c) { const int st = (r >> 4) * 2 + (c >> 5), rr = r & 15, cc = c & 31, ob = rr * 64 + cc * 2; return st * 1024 + (ob ^ (((ob >> 9) & 1) << 5)); }
__device__ __forceinline__ void stage_rc(int b, int& R, int& C) { const int st = b / 1024, sb = b % 1024, swz = sb ^ (((sb >> 9) & 1) << 5); R = (st >> 1) * 16 + swz / 64; C = (st & 1) * 32 + (swz % 64) / 2; }

struct Unit { const char* a; const char* b; int pm, pn, z, row0, m192; };
struct Sched {
    const char* A; const char* B; int lda, ldb, acol, nM, nN, G, c, tm;
    __device__ __forceinline__ bool next(int i, Unit& u) const {
        const long L = (long)i * G + c; const int nwg = nM * nN; if (L >= nwg) return false;
        int wgid = (int)L; { const int q = nwg / 8, r = nwg % 8, xcd = wgid % 8, off = wgid / 8; wgid = (xcd < r ? xcd * (q + 1) : r * (q + 1) + (xcd - r) * q) + off; }
        const int nig = 8 * nN, gid = wgid / nig, fm = gid * 8, gsz = (nM - fm) < 8 ? (nM - fm) : 8;
        u.pm = fm + ((wgid % nig) % gsz); u.pn = (wgid % nig) / gsz;
        u.a = A + ((size_t)u.pm * tm * lda + (size_t)u.pn * acol) * 2; u.b = B + (size_t)u.pn * 256 * ldb * 2; u.z = 0; u.row0 = u.pm * tm; u.m192 = (tm == 192); return true;
    }
};
struct MergeSched {
    const char* ws; int lda, ldb, c;
    __device__ __forceinline__ bool next(int i, Unit& u) const {
        if (c >= 192 || i >= 6) return false;
        const int nN = 4;
        int wgid = c; { const int q = 24, xcd = wgid % 8, off = wgid / 8; wgid = xcd * q + off; }
        const int nig = 8 * nN, gid = wgid / nig, fm = gid * 8;
        u.pm = fm + ((wgid % nig) % 8); u.pn = (wgid % nig) / 8; u.z = i; u.row0 = u.pm * 256; u.m192 = 0;
        const int j = i >> 1;
        const size_t aoff = (size_t)u.row0 * 1024 * 2;
        size_t ao = OFF_H, bo = OFF_WIN + (size_t)3584 * 1024 * 2;
        if (i & 1) { bo = OFF_WBR; ao = OFF_YA; if (j == 1) ao = OFF_YB; if (j == 2) ao = OFF_XC; }
        u.a = ws + ao + aoff; u.b = ws + bo + ((size_t)j * 1024 + (size_t)u.pn * 256) * 1024 * 2;
        return true;
    }
};

template <class Epi, class SchedT, bool M192 = false>
__device__ __forceinline__ void gemm_phase(LAS unsigned char* lds, const SchedT& S, const int K_, const Epi& E) {
    int K = K_; asm volatile("" : "+s"(K));
    int tid_ = threadIdx.x; asm volatile("" : "+v"(tid_));
    const int tid = tid_, wid = __builtin_amdgcn_readfirstlane(tid >> 6), lane = tid & 63, wr = wid >> 2, wc = wid & 3, fr = lane & 15, fq = lane >> 4;
    const int nt = K / 64;
    unsigned voffA[2], voffB[2];
#pragma unroll
    for (int i = 0; i < 2; ++i) { int R, C; stage_rc(tid * 16 + i * 8192, R, C); voffA[i] = (unsigned)(R * S.lda + C) * 2u; voffB[i] = (unsigned)(R * S.ldb + C) * 2u; }
    const size_t kstep = 128;
    const size_t hstepA = (size_t)128 * S.lda * 2, hstepB = (size_t)128 * S.ldb * 2;
    const unsigned ldsw = (unsigned)wid * 1024u;
    const int aoff = lds_byte(wr * 64 + fr, fq * 8), boff = lds_byte(wc * 32 + fr, fq * 8);
#define G_SA(b, h) (((b) * 2 + (h)) * HTB)
#define G_SB(b, h) ((4 + (b) * 2 + (h)) * HTB)
#define G_STAGE(bufoff, gbase, voff) do { _Pragma("unroll") for (int _i = 0; _i < 2; ++_i) \
        __builtin_amdgcn_global_load_lds((const unsigned*)((const char*)(gbase) + (voff)[_i]), (LAS unsigned*)(lds + (bufoff) + ldsw + _i * 8192), 16, 0, 0); } while (0)
#define G_LDA(dst, b, h) do { _Pragma("unroll") for (int m = 0; m < 4; ++m) _Pragma("unroll") for (int k = 0; k < 2; ++k) dst[m][k] = *(const LAS bf16x8*)(lds + G_SA(b, h) + aoff + m * 2048 + k * 1024); } while (0)
#define G_LDB(dst, b, h) do { _Pragma("unroll") for (int n = 0; n < 2; ++n) _Pragma("unroll") for (int k = 0; k < 2; ++k) dst[n][k] = *(const LAS bf16x8*)(lds + G_SB(b, h) + boff + n * 2048 + k * 1024); } while (0)
#define G_MMA(ai, bj, At, Bt) do { if (M192 && (ai) == 1 && wr == 1) break; __builtin_amdgcn_s_setprio(1); _Pragma("unroll") for (int m = 0; m < 4; ++m) _Pragma("unroll") for (int n = 0; n < 2; ++n) _Pragma("unroll") for (int k = 0; k < 2; ++k) \
        acc[ai][bj][m][n] = __builtin_amdgcn_mfma_f32_16x16x32_bf16(Bt[n][k], At[m][k], acc[ai][bj][m][n], 0, 0, 0); __builtin_amdgcn_s_setprio(0); } while (0)
#define G_WAIT_V(n) asm volatile("s_waitcnt vmcnt(" #n ")" ::: "memory")
#define G_WAIT_L(n) asm volatile("s_waitcnt lgkmcnt(" #n ")" ::: "memory")
#define G_BAR __builtin_amdgcn_s_barrier()
#define G_SCHED __builtin_amdgcn_sched_barrier(0)
    Unit cur, nxt; int ui = 0;
    if (!S.next(0, cur)) return;
    f32x4 acc[2][2][4][2];
#pragma unroll
    for (int a = 0; a < 2; ++a)
#pragma unroll
        for (int b = 0; b < 2; ++b)
#pragma unroll
            for (int m = 0; m < 4; ++m)
#pragma unroll
                for (int n = 0; n < 2; ++n) acc[a][b][m][n] = (f32x4){0.f, 0.f, 0.f, 0.f};
    bf16x8 At[4][2], B0[2][2], B1[2][2];
    const char* cA = cur.a; const char* cB = cur.b;
    G_STAGE(G_SB(0, 0), cB, voffB); G_STAGE(G_SA(0, 0), cA, voffA); G_STAGE(G_SB(0, 1), cB + hstepB, voffB); G_STAGE(G_SA(0, 1), cA + hstepA, voffA);
    if (wr == 1) G_BAR;
    G_WAIT_V(4); G_BAR;
    G_STAGE(G_SB(1, 0), cB + kstep, voffB); G_STAGE(G_SA(1, 0), cA + kstep, voffA); G_STAGE(G_SB(1, 1), cB + hstepB + kstep, voffB);
    G_WAIT_V(6); G_BAR;
    for (;;) {
        const bool has_next = S.next(ui + 1, nxt);
        const char* nA = has_next ? nxt.a : cA; const char* nB = has_next ? nxt.b : cB;
        for (int t = 0; t < nt; t += 2) {
            const bool last = (t == nt - 2);
            const char* a1 = cA + (size_t)(t + 1) * kstep;
            const char* a2 = last ? nA : cA + (size_t)(t + 2) * kstep; const char* b2 = last ? nB : cB + (size_t)(t + 2) * kstep;
            const char* a3 = a2 + kstep; const char* b3 = b2 + kstep;
            G_LDB(B0, 0, 0); G_SCHED; G_LDA(At, 0, 0); G_STAGE(G_SA(1, 1), a1 + hstepA, voffA);
            G_WAIT_L(8); G_BAR; G_WAIT_L(0); G_MMA(0, 0, At, B0); G_BAR; G_SCHED;
            G_LDB(B1, 0, 1); G_STAGE(G_SB(0, 0), b2, voffB);
            G_BAR; G_WAIT_L(0); G_MMA(0, 1, At, B1); G_BAR;
            G_LDA(At, 0, 1); G_STAGE(G_SA(0, 0), a2, voffA);
            G_BAR; G_WAIT_L(0); G_MMA(1, 0, At, B0); G_BAR; G_SCHED;
            G_STAGE(G_SB(0, 1), b2 + hstepB, voffB);
            G_WAIT_V(6); G_BAR; G_MMA(1, 1, At, B1); G_BAR;
            G_LDB(B0, 1, 0); G_SCHED; G_LDA(At, 1, 0); G_STAGE(G_SA(0, 1), a2 + hstepA, voffA);
            G_WAIT_L(8); G_BAR; G_WAIT_L(0); G_MMA(0, 0, At, B0); G_BAR; G_SCHED;
            G_LDB(B1, 1, 1); G_STAGE(G_SB(1, 0), b3, voffB);
            G_BAR; G_WAIT_L(0); G_MMA(0, 1, At, B1); G_BAR;
            G_LDA(At, 1, 1); G_STAGE(G_SA(1, 0), a3, voffA);
            G_BAR; G_WAIT_L(0); G_MMA(1, 0, At, B0); G_BAR; G_SCHED;
            G_STAGE(G_SB(1, 1), b3 + hstepB, voffB);
            G_WAIT_V(6); G_BAR; G_MMA(1, 1, At, B1); G_BAR;
        }
        E(acc, cur, wr, wc, fr, fq);
        if (!has_next) break;
#pragma unroll
        for (int a = 0; a < 2; ++a)
#pragma unroll
            for (int b = 0; b < 2; ++b)
#pragma unroll
                for (int m = 0; m < 4; ++m)
#pragma unroll
                    for (int n = 0; n < 2; ++n) acc[a][b][m][n] = (f32x4){0.f, 0.f, 0.f, 0.f};
        cur = nxt; cA = nA; cB = nB; ++ui;
    }
    G_WAIT_V(0);
    if (wr == 0) G_BAR;
    G_BAR;
#undef G_SA
#undef G_SB
#undef G_STAGE
#undef G_LDA
#undef G_LDB
#undef G_MMA
#undef G_WAIT_V
#undef G_WAIT_L
#undef G_BAR
#undef G_SCHED
}

#define EPI_LOOP_BEGIN \
    _Pragma("unroll") for (int ai = 0; ai < 2; ++ai) _Pragma("unroll") for (int m = 0; m < 4; ++m) { const int row = u.pm * 256 + wr * 64 + fr + ai * 128 + m * 16; \
    _Pragma("unroll") for (int bj = 0; bj < 2; ++bj) _Pragma("unroll") for (int n = 0; n < 2; ++n) { const int cl = wc * 32 + 4 * fq + bj * 128 + n * 16; const f32x4 v = acc[ai][bj][m][n];
#define EPI_LOOP_END } }

__device__ __forceinline__ int seq_group(int row) { return row < MCTX ? 0 : 1 + ((row - MCTX) >> 11); }

struct EpiIn {
    bf16_t* xaq; bf16_t* xc; bf16_t* kb; bf16_t* vb; float* outk; float* outv; const float* rc; int l;
    __device__ __forceinline__ void operator()(const f32x4 (&acc)[2][2][4][2], const Unit& u, int wr, int wc, int fr, int fq) const {
        const int pn = u.pn; const bool qk = pn >= 4 && pn <= 8;
        bf16_t* dst; int ld, cbase; float* fo = nullptr;
        if (pn < 4) { dst = xaq; ld = 1024; cbase = pn * 256; }
        else if (pn < 8) { dst = xaq + (size_t)MROWS * 1024; ld = 1024; cbase = pn * 256 - 1024; }
        else if (pn == 8) { dst = kb; ld = 256; cbase = 0; fo = outk; }
        else if (pn == 9) { dst = vb; ld = 256; cbase = 0; fo = outv; }
        else { dst = xc; ld = 1024; cbase = pn * 256 - 2560; }
        const int hh = wc >> 1, i0 = 16 * (wc & 1) + 4 * fq;
        const int c1 = cbase + (qk ? 64 * hh + i0 : wc * 32 + 4 * fq), dc = qk ? 32 : 16;
        const bool rope = qk && u.pm >= 32;
#pragma unroll
        for (int ai = 0; ai < 2; ++ai) {
            f32x4 csm[4], snm[4];
#pragma unroll
            for (int m = 0; m < 4; ++m) { csm[m] = (f32x4){1.f, 1.f, 1.f, 1.f}; snm[m] = (f32x4){0.f, 0.f, 0.f, 0.f};
                if (rope) { const int row = u.pm * 256 + wr * 64 + fr + ai * 128 + m * 16; const int t = (row - MCTX) & 2047; const int pos = hh == 0 ? (t >> 6) : (t & 63);
                    csm[m] = *(const f32x4*)(rc + pos * 32 + i0); snm[m] = *(const f32x4*)(rc + 2048 + pos * 32 + i0); } }
#pragma unroll
            for (int m = 0; m < 4; ++m) {
                const int row = u.pm * 256 + wr * 64 + fr + ai * 128 + m * 16;
                const f32x4 cs = csm[m], sn = snm[m];
                bf16_t* dp = dst + (size_t)row * ld + c1;
                float* fp = fo + ((size_t)(((row >> 8) * 2 + l) * 256 + (row & 255))) * 256 + c1;
#pragma unroll
                for (int bj = 0; bj < 2; ++bj) {
                    const f32x4 x1 = acc[ai][bj][m][0], x2 = acc[ai][bj][m][1];
                    const f32x4 o1 = x1 * cs - x2 * sn, o2 = x1 * sn + x2 * cs;
                    uint2 p1, p2; p1.x = pack2(o1[0], o1[1]); p1.y = pack2(o1[2], o1[3]); p2.x = pack2(o2[0], o2[1]); p2.y = pack2(o2[2], o2[3]);
                    *(uint2*)(dp + bj * 128) = p1; *(uint2*)(dp + bj * 128 + dc) = p2;
                    if (fo != nullptr && row < MCTX) { *(f32x4*)(fp + bj * 128) = o1; *(f32x4*)(fp + bj * 128 + dc) = o2; }
                }
            }
        }
    }
};
struct EpiGate {
    bf16_t* gt; const float* bias;
    __device__ __forceinline__ void operator()(const f32x4 (&acc)[2][2][4][2], const Unit& u, int wr, int wc, int fr, int fq) const {
        const int c0 = u.pn * 256 + wc * 32 + 4 * fq;
        f32x4 bb[4];
#pragma unroll
        for (int g = 0; g < 4; ++g) bb[g] = *(const f32x4*)(bias + c0 + (g >> 1) * 128 + (g & 1) * 16);
#pragma unroll
        for (int ai = 0; ai < 2; ++ai) { if (ai == 1 && u.m192 && wr == 1) continue;
#pragma unroll
            for (int m = 0; m < 4; ++m) { const int row = u.row0 + wr * 64 + fr + ai * 128 + m * 16;
#pragma unroll
                for (int g = 0; g < 4; ++g) { const f32x4 v = acc[ai][g >> 1][m][g & 1];
                    uint2 pk; pk.x = pack2(sigmoidf_(v[0] + bb[g][0]), sigmoidf_(v[1] + bb[g][1])); pk.y = pack2(sigmoidf_(v[2] + bb[g][2]), sigmoidf_(v[3] + bb[g][3]));
                    *(uint2*)(gt + (size_t)row * 1024 + c0 + (g >> 1) * 128 + (g & 1) * 16) = pk; } } }
    }
};
template <int j> struct EpiBranch {
    const bf16_t* gt; float* tmp; bf16_t* mg;
    __device__ __forceinline__ void operator()(const f32x4 (&acc)[2][2][4][2], const Unit& u, int wr, int wc, int fr, int fq) const {
        const int c0 = u.pn * 256 + wc * 32 + 4 * fq;
#pragma unroll
        for (int ai = 0; ai < 2; ++ai) { if (ai == 1 && u.m192 && wr == 1) continue;
#pragma unroll
            for (int m = 0; m < 4; ++m) {
                const unsigned ro = (unsigned)(u.row0 + wr * 64 + fr + ai * 128 + m * 16) * 1024u + (unsigned)c0;
                uint2 gp[4]; f32x4 tv[4];
#pragma unroll
                for (int g = 0; g < 4; ++g) { const unsigned o = ro + (g >> 1) * 128 + (g & 1) * 16;
                    gp[g] = *(const uint2*)(gt + o); tv[g] = (f32x4){0.f, 0.f, 0.f, 0.f}; if (j != 0) tv[g] = *(const f32x4*)(tmp + o); }
#pragma unroll
                for (int g = 0; g < 4; ++g) { const unsigned o = ro + (g >> 1) * 128 + (g & 1) * 16;
                    const f32x4 v = acc[ai][g >> 1][m][g & 1];
                    f32x4 r = tv[g];
                    r[0] += v[0] * bf2f((unsigned short)(gp[g].x & 0xffff)); r[1] += v[1] * bf2f((unsigned short)(gp[g].x >> 16));
                    r[2] += v[2] * bf2f((unsigned short)(gp[g].y & 0xffff)); r[3] += v[3] * bf2f((unsigned short)(gp[g].y >> 16));
                    if (j != 2) *(f32x4*)(tmp + o) = r;
                    else { uint2 pk; pk.x = pack2(r[0], r[1]); pk.y = pack2(r[2], r[3]); *(uint2*)(mg + o) = pk; } }
            } }
    }
};
struct EpiMerge {
    bf16_t* gt; const float* bgate; float* tmp; bf16_t* mg;
    __device__ __forceinline__ void operator()(const f32x4 (&acc)[2][2][4][2], const Unit& u, int wr, int wc, int fr, int fq) const {
        const int j = u.z >> 1;
        if ((u.z & 1) == 0) { EpiGate E{gt, bgate + j * 1024}; E(acc, u, wr, wc, fr, fq); }
        else if (j == 0) { EpiBranch<0> E{gt, tmp, mg}; E(acc, u, wr, wc, fr, fq); }
        else if (j == 1) { EpiBranch<1> E{gt, tmp, mg}; E(acc, u, wr, wc, fr, fq); }
        else { EpiBranch<2> E{gt, tmp, mg}; E(acc, u, wr, wc, fr, fq); }
    }
};
struct EpiRes {
    float* x; const float* mod; int goff; const float* xa; const float* xb;
    __device__ __forceinline__ const float* src(unsigned o) const { return o < (unsigned)MCTX * 1024u ? xa + o : xb + (o - (unsigned)MCTX * 1024u); }
    __device__ __forceinline__ void operator()(const f32x4 (&acc)[2][2][4][2], const Unit& u, int wr, int wc, int fr, int fq) const {
        const int c0 = u.pn * 256 + wc * 32 + 4 * fq;
        const int sg0 = seq_group(u.row0), sg1 = seq_group(u.row0 + (u.m192 ? 191 : 255));
        if (sg0 == sg1) {
            const float* gsrc = mod + sg0 * 6144 + goff;
            f32x4 gg[4];
#pragma unroll
            for (int g = 0; g < 4; ++g) gg[g] = *(const f32x4*)(gsrc + c0 + (g >> 1) * 128 + (g & 1) * 16);
#pragma unroll
            for (int ai = 0; ai < 2; ++ai) { if (ai == 1 && u.m192 && wr == 1) continue;
#pragma unroll
                for (int mp = 0; mp < 2; ++mp) {
                    const unsigned ro = (unsigned)(u.row0 + wr * 64 + fr + ai * 128 + mp * 32) * 1024u + (unsigned)c0;
                    f32x4 xv[8];
#pragma unroll
                    for (int k = 0; k < 8; ++k) { const int g = k & 3; xv[k] = *(const f32x4*)src(ro + (k >> 2) * 16384 + (g >> 1) * 128 + (g & 1) * 16); }
#pragma unroll
                    for (int k = 0; k < 8; ++k) { const int g = k & 3, m = mp * 2 + (k >> 2); *(f32x4*)(x + (ro + (k >> 2) * 16384 + (g >> 1) * 128 + (g & 1) * 16)) = xv[k] + gg[g] * acc[ai][g >> 1][m][g & 1]; }
                } }
        } else {
#pragma unroll
            for (int ai = 0; ai < 2; ++ai) { if (ai == 1 && u.m192 && wr == 1) continue;
#pragma unroll
                for (int m = 0; m < 4; ++m) {
                    const int row = u.row0 + wr * 64 + fr + ai * 128 + m * 16;
                    const float* gsrc = mod + seq_group(row) * 6144 + goff + c0;
                    const unsigned ro = (unsigned)row * 1024u + (unsigned)c0;
                    f32x4 xv[4], gv[4];
#pragma unroll
                    for (int g = 0; g < 4; ++g) { xv[g] = *(const f32x4*)src(ro + (g >> 1) * 128 + (g & 1) * 16); gv[g] = *(const f32x4*)(gsrc + (g >> 1) * 128 + (g & 1) * 16); }
#pragma unroll
                    for (int g = 0; g < 4; ++g) *(f32x4*)(x + (ro + (g >> 1) * 128 + (g & 1) * 16)) = xv[g] + gv[g] * acc[ai][g >> 1][m][g & 1];
                } }
        }
    }
};
struct EpiBf {
    bf16_t* dst; int ld;
    __device__ __forceinline__ void operator()(const f32x4 (&acc)[2][2][4][2], const Unit& u, int wr, int wc, int fr, int fq) const {
        EPI_LOOP_BEGIN
            const int col = u.pn * 256 + cl;
            uint2 pk; pk.x = pack2(v[0], v[1]); pk.y = pack2(v[2], v[3]);
            *(uint2*)(dst + (size_t)row * ld + col) = pk;
        EPI_LOOP_END
    }
};
__device__ __forceinline__ float dpp_f(float old, float src, const int ctrl_sel) {
    const int o = __float_as_int(old), v = __float_as_int(src);
    int r;
    if (ctrl_sel == 0) r = __builtin_amdgcn_update_dpp(o, v, 0x111, 0xf, 0xf, false);
    else if (ctrl_sel == 1) r = __builtin_amdgcn_update_dpp(o, v, 0x101, 0xf, 0xf, false);
    else if (ctrl_sel == 2) r = __builtin_amdgcn_update_dpp(o, v, 0x121, 0xf, 0xf, false);
    else r = __builtin_amdgcn_update_dpp(o, v, 0x12f, 0xf, 0xf, false);
    return __int_as_float(r);
}
__device__ __forceinline__ float gelu_tanh(float x) { const float y = 0.7978845608028654f * (x + 0.044715f * x * x * x); const float t = 1.0f - 2.0f * __builtin_amdgcn_rcpf(1.0f + __expf(2.0f * y)); return 0.5f * x * (1.0f + t); }
struct EpiUp {
    bf16_t* act; bf16_t* su; bf16_t* sv; const float* cw; const float* cb;
    __device__ __forceinline__ void operator()(const f32x4 (&acc)[2][2][4][2], const Unit& u, int wr, int wc, int fr, int fq) const {
#pragma unroll
        for (int n = 0; n < 2; ++n) {
            const int ch = u.pn * 128 + wc * 32 + 16 * n + 4 * fq;
            const f32x4 w0 = *(const f32x4*)(cw + ch), w1 = *(const f32x4*)(cw + 2816 + ch), w2 = *(const f32x4*)(cw + 5632 + ch), bb = *(const f32x4*)(cb + ch);
#pragma unroll
            for (int ai = 0; ai < 2; ++ai) {
                const int rowg = u.row0 + ai * 128 + wr * 64;
                f32x4 ub[4];
#pragma unroll
                for (int m = 0; m < 4; ++m)
#pragma unroll
                    for (int e = 0; e < 4; ++e) ub[m][e] = bf2f(f2bf(acc[ai][0][m][n][e]));
#pragma unroll
                for (int m = 0; m < 4; ++m) {
                    const int row = rowg + m * 16 + fr;
                    f32x4 r;
#pragma unroll
                    for (int e = 0; e < 4; ++e) {
                        const float pl = m > 0 ? dpp_f(0.f, ub[m > 0 ? m - 1 : 0][e], 2) : 0.f;
                        const float pv = dpp_f(pl, ub[m][e], 0);
                        const float nl = m < 3 ? dpp_f(0.f, ub[m < 3 ? m + 1 : 3][e], 3) : 0.f;
                        const float nv = dpp_f(nl, ub[m][e], 1);
                        const float gff = w0[e] * pv + w1[e] * ub[m][e] + w2[e] * nv + bb[e];
                        r[e] = gelu_tanh(gff) * bf2f(f2bf(acc[ai][1][m][n][e]));
                    }
                    const bool edge = (m == 0 && fr == 0) || (m == 3 && fr == 15);
                    if (!edge) { uint2 pk; pk.x = pack2(r[0], r[1]); pk.y = pack2(r[2], r[3]); *(uint2*)(act + (size_t)row * 2816 + ch) = pk; }
                    if ((m == 0 && fr < 2) || (m == 3 && fr >= 14)) {
                        const int slot = m == 0 ? fr : fr - 12; const int g64 = rowg >> 6;
                        uint2 pk; pk.x = pack2(ub[m][0], ub[m][1]); pk.y = pack2(ub[m][2], ub[m][3]);
                        *(uint2*)(su + ((size_t)g64 * 4 + slot) * 2816 + ch) = pk;
                        if (edge) { const f32x4 vv = acc[ai][1][m][n]; uint2 pv2; pv2.x = pack2(vv[0], vv[1]); pv2.y = pack2(vv[2], vv[3]); *(uint2*)(sv + ((size_t)g64 * 2 + (m == 0 ? 0 : 1)) * 2816 + ch) = pv2; }
                    }
                }
            }
        }
    }
};
struct EpiPool {
    bf16_t* dst; const float* scale;
    __device__ __forceinline__ void operator()(const f32x4 (&acc)[2][2][4][2], const Unit& u, int wr, int wc, int fr, int fq) const {
        const int c0 = u.pn * 256 + wc * 32 + 4 * fq;
        f32x4 sc[4];
#pragma unroll
        for (int g = 0; g < 4; ++g) sc[g] = *(const f32x4*)(scale + c0 + (g >> 1) * 128 + (g & 1) * 16);
#pragma unroll
        for (int ai = 0; ai < 2; ++ai)
#pragma unroll
            for (int m = 0; m < 4; ++m) { const int row = u.pm * 256 + wr * 64 + fr + ai * 128 + m * 16;
#pragma unroll
                for (int g = 0; g < 4; ++g) { const f32x4 v = acc[ai][g >> 1][m][g & 1] * sc[g];
                    uint2 pk; pk.x = pack2(v[0], v[1]); pk.y = pack2(v[2], v[3]);
                    *(uint2*)(dst + (size_t)row * 1024 + c0 + (g >> 1) * 128 + (g & 1) * 16) = pk; } }
    }
};

struct WPtrs { const float *w_in, *w_branch, *lru_wa, *lru_wx, *pool_w, *w_out, *ffn_up, *ffn_down; unsigned char* ws; };
struct TileDesc { const float* src; int lds_; bf16_t* dst; int ldd, k0, n0, perm, nd; };
__device__ __forceinline__ int swap45(int p) { return (p & ~48) | ((p & 16) << 1) | ((p & 32) >> 1); }
__device__ __forceinline__ TileDesc weight_tile(const WPtrs& P, int l, int t) {
    unsigned char* ws = P.ws; TileDesc d; int r = t; d.perm = 0; d.nd = -1;
    if (r < 1664) { d.src = P.w_in + (size_t)l * 1024 * 6656; d.lds_ = 6656; d.dst = (bf16_t*)(ws + OFF_WIN); d.ldd = 1024; d.k0 = (r / 104) * 64; d.n0 = (r % 104) * 64; d.perm = (d.n0 >= 1024 && d.n0 < 2304) ? 1 : 0; }
    else if ((r -= 1664) < 128) { const int mat = r / 64; r %= 64; const int dh = r / 4; r %= 4;
        d.src = (mat ? P.lru_wx : P.lru_wa) + (size_t)(l * 16 + dh) * 128 * 128; d.lds_ = 128; d.dst = (bf16_t*)(ws + OFF_GW) + (size_t)dh * 256 * 128 + (size_t)mat * 128 * 128; d.ldd = 128; d.k0 = (r / 2) * 64; d.n0 = (r % 2) * 64; }
    else if ((r -= 128) < 64) { const int g = r / 16; r %= 16; d.src = P.pool_w + (size_t)(l * 4 + g) * 256 * 256; d.lds_ = 256; d.dst = (bf16_t*)(ws + OFF_PW) + (size_t)g * 256 * 256; d.ldd = 256; d.k0 = (r / 4) * 64; d.n0 = (r % 4) * 64; }
    else if ((r -= 64) < 768) { const int j = r / 256; r %= 256; d.src = P.w_branch + (size_t)(l * 3 + j) * 1024 * 1024; d.lds_ = 1024; d.dst = (bf16_t*)(ws + OFF_WBR) + (size_t)j * 1024 * 1024; d.ldd = 1024; d.k0 = (r / 16) * 64; d.n0 = (r % 16) * 64; }
    else if ((r -= 768) < 256) { d.src = P.w_out + (size_t)l * 1024 * 1024; d.lds_ = 1024; d.dst = (bf16_t*)(ws + OFF_WOUT); d.ldd = 1024; d.k0 = (r / 16) * 64; d.n0 = (r % 16) * 64; }
    else if ((r -= 256) < 1408) { d.src = P.ffn_up + (size_t)l * 1024 * 5632; d.lds_ = 5632; d.dst = (bf16_t*)(ws + OFF_WUP); d.ldd = 1024; d.k0 = (r / 88) * 64; d.n0 = (r % 88) * 64;
        { const int isv = d.n0 >= 2816, c0 = isv ? d.n0 - 2816 : d.n0; d.nd = (c0 >> 7) * 256 + (c0 & 127) + (isv ? 128 : 0); } }
    else { r -= 1408; d.src = P.ffn_down + (size_t)l * 2816 * 1024; d.lds_ = 1024; d.dst = (bf16_t*)(ws + OFF_WDN); d.ldd = 2816; d.k0 = (r / 16) * 64; d.n0 = (r % 16) * 64; }
    return d;
}
__device__ __noinline__ void convert_weights_(const float* p0, const float* p1, const float* p2, const float* p3, const float* p4, const float* p5, const float* p6, const float* p7, unsigned char* pws,
                                              int l, LAS unsigned char* lds, int t_begin, int t_end, int first, int stride) {
    const WPtrs P{p0, p1, p2, p3, p4, p5, p6, p7, pws};
    LAS bf16_t* sm = (LAS bf16_t*)lds;
    const int tid = otid();
    const int kk0 = tid >> 4, n4 = (tid & 15) * 4, nn = tid >> 3, ck = tid & 7;
    int t = t_begin + first;
    if (t >= t_end) return;
    TileDesc d = weight_tile(P, l, t);
    f32x4 v0 = *(const f32x4*)(d.src + (size_t)(d.k0 + kk0) * d.lds_ + d.n0 + n4), v1 = *(const f32x4*)(d.src + (size_t)(d.k0 + kk0 + 32) * d.lds_ + d.n0 + n4);
    for (;;) {
        __syncthreads();
#pragma unroll
        for (int e = 0; e < 4; ++e) { sm[(n4 + e) * 72 + kk0] = f2bf(v0[e]); sm[(n4 + e) * 72 + kk0 + 32] = f2bf(v1[e]); }
        __syncthreads();
        const TileDesc cur = d; const int tn = t + stride; const bool more = tn < t_end;
        if (more) { d = weight_tile(P, l, tn); v0 = *(const f32x4*)(d.src + (size_t)(d.k0 + kk0) * d.lds_ + d.n0 + n4); v1 = *(const f32x4*)(d.src + (size_t)(d.k0 + kk0 + 32) * d.lds_ + d.n0 + n4); }
        const u32x4 o = *(const LAS u32x4*)(sm + nn * 72 + ck * 8);
        const int nrow = cur.perm ? swap45(cur.n0 + nn) : ((cur.nd >= 0 ? cur.nd : cur.n0) + nn);
        *(u32x4*)(cur.dst + (size_t)nrow * cur.ldd + cur.k0 + ck * 8) = o;
        if (!more) break;
        t = tn;
    }
    __syncthreads();
}

__device__ __forceinline__ void convert_weights(const Params& P, int l, LAS unsigned char* lds, int t_begin, int t_end, int first, int stride) {
    convert_weights_(P.w_in, P.w_branch, P.lru_wa, P.lru_wx, P.pool_w, P.w_out, P.ffn_up, P.ffn_down, P.ws, l, lds, t_begin, t_end, first, stride);
}

__device__ void phase0(const Params& P, LAS unsigned char* lds) {
    const int tid = otid(), G = gridDim.x, c = blockIdx.x;
    { bf16_t* ck = (bf16_t*)(P.ws + OFF_CK); bf16_t* cv = (bf16_t*)(P.ws + OFF_CV);
      for (int i = c * 512 + tid; i < 2 * 2 * 512 * 256; i += G * 512) {
          const int e = i & 255, t = (i >> 8) & 511, b = (i >> 17) & 1, l = i >> 18;
          const size_t si = ((size_t)((b * 2 + l) * 512 + t)) * 256 + e;
          ck[i] = f2bf(P.cache_k[si]); cv[i] = f2bf(P.cache_v[si]); } }
    { float* rc = (float*)(P.ws + OFF_ROPE); float* rs = rc + 2048;
      for (int i = c * 512 + tid; i < 2048; i += G * 512) {
          const int pos = i >> 5, k = i & 31; const float fr = powf(10000.0f, -(float)k / 32.0f); const float ang = (float)pos * fr;
          rc[i] = cosf(ang); rs[i] = sinf(ang); } }
    { LAS float* sv = (LAS float*)lds;
      LAS float* red = sv + 3072;
      __syncthreads();
      for (int i = tid; i < 3072; i += 512) { const int s = i >> 10, k = i & 1023; const float x = s == 0 ? P.c_ctx[k] : P.c[(s - 1) * 1024 + k]; sv[i] = x / (1.0f + expf(-x)); }
      __syncthreads();
      float* mod = (float*)(P.ws + OFF_MOD);
      for (int it = c; it < 384; it += G) {
          const int l = it / 192, cg_ = it % 192, cl = tid & 31, kg = tid >> 5, col = cg_ * 32 + cl;
          const float* w = P.w_ada + (size_t)l * 1024 * 6144 + col;
          float a0 = 0.f, a1 = 0.f, a2 = 0.f;
#pragma unroll 16
          for (int k = kg * 64; k < kg * 64 + 64; ++k) { const float wv = w[(size_t)k * 6144]; a0 += sv[k] * wv; a1 += sv[1024 + k] * wv; a2 += sv[2048 + k] * wv; }
          red[(kg * 3 + 0) * 32 + cl] = a0; red[(kg * 3 + 1) * 32 + cl] = a1; red[(kg * 3 + 2) * 32 + cl] = a2;
          __syncthreads();
          if (tid < 96) { const int s = tid >> 5, cc = tid & 31; float sum = 0.f;
#pragma unroll
              for (int g = 0; g < 16; ++g) sum += red[(g * 3 + s) * 32 + cc];
              mod[(size_t)(l * 3 + s) * 6144 + cg_ * 32 + cc] = sum + P.b_ada[l * 6144 + cg_ * 32 + cc]; }
          __syncthreads();
      } }
}

template <bool FINAL>
__device__ __forceinline__ void norm_rows(float* X, const float* xa, const float* xb, const float* __restrict__ gw, const float* __restrict__ mod, int shift_off, int scale_off, bf16_t* __restrict__ H) {
    const int tid = otid(); const int lane = tid & 63, wv = blockIdx.x * 8 + (tid >> 6), nw = gridDim.x * 8;
    constexpr int R = 3;
    for (int row0 = wv; row0 < MROWS; row0 += R * nw) {
        f32x4 v[R][4];
#pragma unroll
        for (int r = 0; r < R; ++r) { const int row = row0 + r * nw;
#pragma unroll
            for (int i = 0; i < 4; ++i) v[r][i] = row < MROWS ? *(const f32x4*)((row < MCTX ? xa + (size_t)row * 1024 : xb + (size_t)(row - MCTX) * 1024) + i * 256 + lane * 4) : (f32x4){0.f, 0.f, 0.f, 0.f}; }
#pragma unroll
        for (int r = 0; r < R; ++r) { const int row = row0 + r * nw; if (row >= MROWS) continue;
            float ss = 0.f;
#pragma unroll
            for (int i = 0; i < 4; ++i) ss += v[r][i][0] * v[r][i][0] + v[r][i][1] * v[r][i][1] + v[r][i][2] * v[r][i][2] + v[r][i][3] * v[r][i][3];
#pragma unroll
            for (int o = 32; o >= 1; o >>= 1) ss += __shfl_xor(ss, o);
            const float rstd = rsqrtf(ss * (1.0f / 1024.0f) + 1e-6f);
            const float* md = mod + seq_group(row) * 6144;
#pragma unroll
            for (int i = 0; i < 4; ++i) { const int col = i * 256 + lane * 4;
                const f32x4 g = *(const f32x4*)(gw + col);
                if (FINAL) { f32x4 h;
#pragma unroll
                    for (int e = 0; e < 4; ++e) h[e] = v[r][i][e] * rstd * g[e];
                    *(f32x4*)(X + (size_t)row * 1024 + col) = h; }
                else { const f32x4 sc = *(const f32x4*)(md + scale_off + col), sh = *(const f32x4*)(md + shift_off + col);
                    f32x4 h;
#pragma unroll
                    for (int e = 0; e < 4; ++e) h[e] = v[r][i][e] * rstd * g[e] * (1.0f + sc[e]) + sh[e];
                    uint2 pk; pk.x = pack2(h[0], h[1]); pk.y = pack2(h[2], h[3]);
                    *(uint2*)(H + (size_t)row * 1024 + col) = pk; } }
        }
    }
}
__device__ void norm_phase(const float* xa, const float* xb, const float* __restrict__ gw, const float* __restrict__ mod, int shift_off, int scale_off, bf16_t* __restrict__ H) { norm_rows<false>(nullptr, xa, xb, gw, mod, shift_off, scale_off, H); }
__device__ void final_norm_phase(float* X, const float* __restrict__ gw) { norm_rows<true>(X, X, X + (size_t)MCTX * 1024, gw, nullptr, 0, 0, nullptr); }

template <int HALF>
__device__ __forceinline__ void pool_item(const bf16_t* __restrict__ XC, bf16_t* __restrict__ PL, int it) {
    constexpr int G_ = HALF == 1 ? 0 : (HALF == 2 ? 1 : (HALF == 4 ? 2 : 3));
    const int rs = (it >> 5) * 8, ch = G_ * 256 + (it & 31) * 8;
    const int T = rs < MCTX ? 256 : 2048, row0 = rs < MCTX ? (rs & ~255) : MCTX + ((rs - MCTX) & ~2047), tl0 = rs - row0;
    const bf16_t* base = XC + (size_t)row0 * 1024 + ch;
    constexpr int R = 8 + 2 * HALF;
    bf16x8 xr[R];
#pragma unroll
    for (int i = 0; i < R; ++i) { const int t = tl0 - HALF + i; xr[i] = (bf16x8){0, 0, 0, 0, 0, 0, 0, 0}; if (t >= 0 && t < T) xr[i] = *(const bf16x8*)(base + (size_t)t * 1024); }
    float s[8];
#pragma unroll
    for (int e = 0; e < 8; ++e) { s[e] = 0.f;
#pragma unroll
        for (int i = 0; i < 2 * HALF; ++i) s[e] += bf2f((unsigned short)xr[i][e]); }
#pragma unroll
    for (int j = 0; j < 8; ++j) {
        const int t = tl0 + j;
        const float inv = 1.0f / (float)(min(t + HALF, T) - max(t - HALF, 0));
        float r[8];
#pragma unroll
        for (int e = 0; e < 8; ++e) r[e] = s[e] * inv - bf2f((unsigned short)xr[j + HALF][e]);
        u32x4 o; o.x = pack2(r[0], r[1]); o.y = pack2(r[2], r[3]); o.z = pack2(r[4], r[5]); o.w = pack2(r[6], r[7]);
        *(u32x4*)(PL + (size_t)(row0 + t) * 1024 + ch) = o;
#pragma unroll
        for (int e = 0; e < 8; ++e) s[e] += bf2f((unsigned short)xr[j + 2 * HALF][e]) - bf2f((unsigned short)xr[j][e]);
    }
}
__device__ void pool_phase(const bf16_t* __restrict__ XC, bf16_t* __restrict__ PL) {
    const int tid = otid();
    constexpr int PER_G = (MROWS / 8) * 32;
    for (int idx = blockIdx.x * 512 + tid; idx < 4 * PER_G; idx += gridDim.x * 512) {
        const int g = idx / PER_G, it = idx % PER_G;
        if (g == 0) pool_item<1>(XC, PL, it); else if (g == 1) pool_item<2>(XC, PL, it); else if (g == 2) pool_item<4>(XC, PL, it); else pool_item<8>(XC, PL, it);
    }
}
__device__ void ffn_fix_phase(const bf16_t* __restrict__ SU, const bf16_t* __restrict__ SV, bf16_t* __restrict__ ACT, const float* __restrict__ cw, const float* __restrict__ cb) {
    const int tid = otid();
    for (int idx = blockIdx.x * 512 + tid; idx < 384 * 352; idx += gridDim.x * 512) {
        const int br = idx / 352, ch = (idx % 352) * 8;
        const int g = br >> 1, last = br & 1;
        const int row = g * 64 + (last ? 63 : 0);
        const int T = row < MCTX ? 256 : 2048, row0 = row < MCTX ? (row & ~255) : MCTX + ((row - MCTX) & ~2047), tl = row - row0;
        const bf16x8 zero = (bf16x8){0, 0, 0, 0, 0, 0, 0, 0};
        bf16x8 um, u0, un;
        if (last) { um = *(const bf16x8*)(SU + ((size_t)g * 4 + 2) * 2816 + ch); u0 = *(const bf16x8*)(SU + ((size_t)g * 4 + 3) * 2816 + ch);
                    un = tl < T - 1 ? *(const bf16x8*)(SU + ((size_t)(g + 1) * 4 + 0) * 2816 + ch) : zero; }
        else { um = tl > 0 ? *(const bf16x8*)(SU + ((size_t)(g - 1) * 4 + 3) * 2816 + ch) : zero; u0 = *(const bf16x8*)(SU + ((size_t)g * 4 + 0) * 2816 + ch);
               un = *(const bf16x8*)(SU + ((size_t)g * 4 + 1) * 2816 + ch); }
        const bf16x8 vv = *(const bf16x8*)(SV + ((size_t)g * 2 + last) * 2816 + ch);
        float r[8];
#pragma unroll
        for (int e = 0; e < 8; ++e) { const float gff = cw[ch + e] * bf2f((unsigned short)um[e]) + cw[2816 + ch + e] * bf2f((unsigned short)u0[e]) + cw[5632 + ch + e] * bf2f((unsigned short)un[e]) + cb[ch + e];
            r[e] = gelu_tanh(gff) * bf2f((unsigned short)vv[e]); }
        u32x4 o; o.x = pack2(r[0], r[1]); o.y = pack2(r[2], r[3]); o.z = pack2(r[4], r[5]); o.w = pack2(r[6], r[7]);
        *(u32x4*)(ACT + (size_t)row * 2816 + ch) = o;
    }
}

__device__ __forceinline__ void rope8(bf16x8& x1, bf16x8& x2, const float* __restrict__ cs, const float* __restrict__ sn) {
#pragma unroll
    for (int e = 0; e < 8; ++e) { const float a = bf2f((unsigned short)x1[e]), b = bf2f((unsigned short)x2[e]); const float c = cs[e], s = sn[e];
        x1[e] = (short)f2bf(a * c - b * s); x2[e] = (short)f2bf(a * s + b * c); }
}
constexpr int VT_OFF = 64 * 272;
constexpr int ABUF = 64 * 272 + 64 * 288;
__device__ void attn_unit(const Params& P, int l, int u, LAS unsigned char* lds) {
    int tid_ = threadIdx.x; asm volatile("" : "+v"(tid_));
    const int tid = tid_, w = tid >> 6, lane = tid & 63, fr = lane & 15, fq = lane >> 4;
    const bf16_t* Q = (const bf16_t*)(P.ws + OFF_XAQ) + (size_t)MROWS * 1024;
    const bf16_t* KB = (const bf16_t*)(P.ws + OFF_KB); const bf16_t* VB = (const bf16_t*)(P.ws + OFF_VB);
    const bf16_t* CK = (const bf16_t*)(P.ws + OFF_CK); const bf16_t* CV = (const bf16_t*)(P.ws + OFF_CV);
    bf16_t* YB = (bf16_t*)(P.ws + OFF_YB);
    bool lat; int head, row0, T, qstart, bidx;
    if (u < 256) { lat = true; bidx = u >> 7; const int rem = u & 127; head = rem >> 4; qstart = (rem & 15) * 128; T = 2048; row0 = MCTX + bidx * 2048; }
    else { const int v = u - 256; lat = false; bidx = 0; const int seq = v >> 4, rem = v & 15; head = rem >> 1; qstart = (rem & 1) * 128; T = 256; row0 = seq * 256; }
    const int kvh = head >> 2;
    const int qpos = qstart + w * 16 + fr;
    bf16x8 qf[4];
    { const bf16_t* qp = Q + (size_t)(row0 + qpos) * 1024 + head * 128 + fq * 8;
#pragma unroll
      for (int kk = 0; kk < 4; ++kk) qf[kk] = *(const bf16x8*)(qp + kk * 32); }
    float m_run = P.attn_sink[l * 8 + head] * 1.4426950408889634f; float l_run = (fq == 0) ? 1.0f : 0.0f;
    f32x4 o[8];
#pragma unroll
    for (int dt = 0; dt < 8; ++dt) o[dt] = (f32x4){0.f, 0.f, 0.f, 0.f};
    int wlo = 0, nwt = 4;
    if (lat) { wlo = max(0, qstart - 128); const int whi = min(T, qstart + 256); nwt = (whi - wlo) >> 6; }
    const int ntiles = nwt + (lat ? 8 : 0);
    const float scale = 0.08838834764831845f * 1.4426950408889634f;
    const int lkey = tid >> 3, lp = tid & 7;
    bf16x8 rk[2][2], rv[2][2];
    auto tile_load = [&](int ti, bf16x8 (&k_)[2], bf16x8 (&v_)[2]) {
        const bf16_t* ksrc; const bf16_t* vsrc;
        if (ti < nwt) { const int k0 = wlo + ti * 64; ksrc = KB + (size_t)(row0 + k0) * 256 + kvh * 128; vsrc = VB + (size_t)(row0 + k0) * 256 + kvh * 128; }
        else { const int k0 = (ti - nwt) * 64; const size_t o_ = ((size_t)((l * 2 + bidx) * 512 + k0)) * 256 + kvh * 128; ksrc = CK + o_; vsrc = CV + o_; }
        const bf16_t* kr = ksrc + (size_t)lkey * 256; k_[0] = *(const bf16x8*)(kr + lp * 8); k_[1] = *(const bf16x8*)(kr + (lp + 8) * 8);
        const bf16_t* vr = vsrc + (size_t)lkey * 256; v_[0] = *(const bf16x8*)(vr + lp * 8); v_[1] = *(const bf16x8*)(vr + (lp + 8) * 8); };
    const int krow = (lkey & 32) | ((lkey & 4) << 2) | ((lkey & 24) >> 1) | (lkey & 3);
    auto tile_store = [&](int b, const bf16x8 (&k_)[2], const bf16x8 (&v_)[2]) {
        LAS unsigned char* kb_ = lds + b * ABUF; LAS unsigned char* vb_ = kb_ + VT_OFF;
        *(LAS bf16x8*)(kb_ + krow * 272 + lp * 16) = k_[0]; *(LAS bf16x8*)(kb_ + krow * 272 + (lp + 8) * 16) = k_[1];
        *(LAS bf16x8*)(vb_ + lkey * 288 + lp * 16) = v_[0]; *(LAS bf16x8*)(vb_ + lkey * 288 + (lp + 8) * 16) = v_[1]; };
    tile_load(0, rk[0], rv[0]);
    tile_load(1, rk[1], rv[1]);
    __syncthreads();
    tile_store(0, rk[0], rv[0]);
    tile_load(2, rk[0], rv[0]);
#pragma unroll 2
    for (int ti = 0; ti < ntiles; ++ti) {
        const bool win = ti < nwt; const int k0 = win ? wlo + ti * 64 : (ti - nwt) * 64;
        __syncthreads();
        if ((ti & 1) == 0) { if (ti + 1 < ntiles) tile_store(1, rk[1], rv[1]); if (ti + 3 < ntiles) tile_load(ti + 3, rk[1], rv[1]); }
        else { if (ti + 1 < ntiles) tile_store(0, rk[0], rv[0]); if (ti + 3 < ntiles) tile_load(ti + 3, rk[0], rv[0]); }
        LAS unsigned char* kb_ = lds + (ti & 1) * ABUF; LAS unsigned char* vb_ = kb_ + VT_OFF;
        f32x4 s[4];
#pragma unroll
        for (int nt = 0; nt < 4; ++nt) { s[nt] = (f32x4){0.f, 0.f, 0.f, 0.f};
#pragma unroll
            for (int kk = 0; kk < 4; ++kk) { const bf16x8 a = *(const LAS bf16x8*)(kb_ + (nt * 16 + fr) * 272 + kk * 64 + fq * 16); s[nt] = __builtin_amdgcn_mfma_f32_16x16x32_bf16(a, qf[kk], s[nt], 0, 0, 0); } }
        float mt = -3.0e38f;
#pragma unroll
        for (int nt = 0; nt < 4; ++nt)
#pragma unroll
            for (int j = 0; j < 4; ++j) { float v = s[nt][j] * scale;
                if (lat && win) { const int kp = k0 + 32 * (nt >> 1) + 8 * fq + 4 * (nt & 1) + j; const int dd = qpos - kp; if (dd > 128 || dd < -128) v = -1.0e30f; }
                s[nt][j] = v; mt = fmaxf(mt, v); }
        mt = fmaxf(mt, __shfl_xor(mt, 16)); mt = fmaxf(mt, __shfl_xor(mt, 32));
        const float mn = fmaxf(m_run, mt); const float alpha = __builtin_amdgcn_exp2f(m_run - mn); m_run = mn;
        float ps = 0.f;
#pragma unroll
        for (int nt = 0; nt < 4; ++nt)
#pragma unroll
            for (int j = 0; j < 4; ++j) { const float p = __builtin_amdgcn_exp2f(s[nt][j] - mn); ps += p; s[nt][j] = p; }
        l_run = l_run * alpha + ps;
#pragma unroll
        for (int dt = 0; dt < 8; ++dt) o[dt] = o[dt] * alpha;
#pragma unroll
        for (int s2 = 0; s2 < 2; ++s2) {
            u32x4 pu; pu[0] = pack2(s[2 * s2][0], s[2 * s2][1]); pu[1] = pack2(s[2 * s2][2], s[2 * s2][3]); pu[2] = pack2(s[2 * s2 + 1][0], s[2 * s2 + 1][1]); pu[3] = pack2(s[2 * s2 + 1][2], s[2 * s2 + 1][3]);
            const bf16x8 pf = __builtin_bit_cast(bf16x8, pu);
#pragma unroll
            for (int dt = 0; dt < 8; ++dt) {
                const bf16x4 lo = __builtin_amdgcn_ds_read_tr16_b64_v4i16((LAS bf16x4*)(vb_ + (s2 * 32 + fq * 8 + (fr >> 2)) * 288 + (dt * 16 + (fr & 3) * 4) * 2));
                const bf16x4 hi = __builtin_amdgcn_ds_read_tr16_b64_v4i16((LAS bf16x4*)(vb_ + (s2 * 32 + fq * 8 + 4 + (fr >> 2)) * 288 + (dt * 16 + (fr & 3) * 4) * 2));
                const bf16x8 af = __builtin_shufflevector(lo, hi, 0, 1, 2, 3, 4, 5, 6, 7);
                o[dt] = __builtin_amdgcn_mfma_f32_16x16x32_bf16(af, pf, o[dt], 0, 0, 0);
            }
        }
    }
    float lt = l_run; lt += __shfl_xor(lt, 16); lt += __shfl_xor(lt, 32);
    const float inv = 1.0f / lt;
    bf16_t* yp = YB + (size_t)(row0 + qpos) * 1024 + head * 128 + fq * 4;
#pragma unroll
    for (int dt = 0; dt < 8; ++dt) { uint2 pk; pk.x = pack2(o[dt][0] * inv, o[dt][1] * inv); pk.y = pack2(o[dt][2] * inv, o[dt][3] * inv); *(uint2*)(yp + dt * 16) = pk; }
}

constexpr int YT_OFF = 256 * 272;
template <int MODE, int D, int NSC>
__device__ __forceinline__ void lru_dir(const Params& P, int l, int s, int cchunk, int h, LAS unsigned char* lds, int w, int fr, int fq) {
    const bool lat = s >= 32; const int row0 = lat ? MCTX + (s - 32) * 2048 : s * 256; const int t0 = cchunk * (NSC * 64);
    constexpr int NCH = 2048 / (NSC * 64);
    const bf16_t* GW = (const bf16_t*)(P.ws + OFF_GW);
    bf16_t* YA = (bf16_t*)(P.ws + OFF_YA);
    float* SUMM = (float*)(P.ws + OFF_SUMM);
    const int chl = 16 * w + fr, ch = h * 128 + chl;
    bf16x8 bwa[4], bwx[4];
    { const bf16_t* gp = GW + ((size_t)(D * 8 + h) * 256 + chl) * 128 + fq * 8;
#pragma unroll
      for (int kk = 0; kk < 4; ++kk) { bwa[kk] = *(const bf16x8*)(gp + kk * 32); bwx[kk] = *(const bf16x8*)(gp + 128 * 128 + kk * 32); } }
    const int pidx = (l * 2 + D) * 1024 + ch;
    const float ba = P.lru_ba[pidx], bx = P.lru_bx[pidx];
    const float lam = P.lru_lambda[pidx];
    const float c8 = -8.0f * log1pf(expf(-lam));
    float carry = 0.f;
    if (MODE == 0 && lat) {
        const int b = s - 32;
        carry = P.state_lru[((size_t)(b * 2 + l) * 2 + D) * 1024 + ch];
        if (D == 0) { for (int cc = 0; cc < cchunk; ++cc) { const float* sp = SUMM + ((size_t)((b * 2 + 0) * 16 + cc) * 1024 + ch) * 2; carry = sp[1] + sp[0] * carry; } }
        else { for (int cc = NCH - 1; cc > cchunk; --cc) { const float* sp = SUMM + ((size_t)((b * 2 + 1) * 16 + cc) * 1024 + ch) * 2; carry = sp[1] + sp[0] * carry; } }
    }
    float ptot = 1.0f;
#pragma unroll 1
    for (int sci = 0; sci < NSC; ++sci) {
        const int sc = D == 0 ? sci : NSC - 1 - sci;
        f32x4 r[4], g[4];
#pragma unroll
        for (int m = 0; m < 4; ++m) { r[m] = (f32x4){0.f, 0.f, 0.f, 0.f}; g[m] = (f32x4){0.f, 0.f, 0.f, 0.f};
#pragma unroll
            for (int kk = 0; kk < 4; ++kk) { const bf16x8 a = *(const LAS bf16x8*)(lds + (sc * 64 + m * 16 + fr) * 272 + kk * 64 + fq * 16);
                r[m] = __builtin_amdgcn_mfma_f32_16x16x32_bf16(a, bwa[kk], r[m], 0, 0, 0); g[m] = __builtin_amdgcn_mfma_f32_16x16x32_bf16(a, bwx[kk], g[m], 0, 0, 0); } }
#pragma unroll
        for (int mi = 0; mi < 4; ++mi) {
            const int m = D == 0 ? mi : 3 - mi;
            float av[4], bv[4];
#pragma unroll
            for (int j = 0; j < 4; ++j) {
                const float ea = 1.0f + __expf(-(r[m][j] + ba)), eb = 1.0f + __expf(-(g[m][j] + bx));
                const float inv = __builtin_amdgcn_rcpf(ea * eb);
                const float rr = inv * eb, ii = inv * ea;
                const float la = c8 * rr; const float a = __expf(la); const float z = 2.0f * la;
                const float em = (z > -0.05f) ? -z * (1.0f + z * (0.5f + z * (0.16666667f + z * 0.041666667f))) : 1.0f - a * a;
                const float x = bf2f(*(const LAS bf16_t*)(lds + (sc * 64 + m * 16 + fq * 4 + j) * 272 + chl * 2));
                av[j] = a; bv[j] = __builtin_amdgcn_sqrtf(em) * ii * x;
            }
            float p4, h4;
            p4 = av[0] * av[1] * av[2] * av[3];
            if (D == 0) h4 = ((bv[0] * av[1] + bv[1]) * av[2] + bv[2]) * av[3] + bv[3];
            else h4 = ((bv[3] * av[2] + bv[2]) * av[1] + bv[1]) * av[0] + bv[0];
            float pq[4], hq[4];
#pragma unroll
            for (int f = 0; f < 4; ++f) { pq[f] = __shfl(p4, fr + 16 * f); hq[f] = __shfl(h4, fr + 16 * f); }
            float cin = carry, mycin = 0.f;
#pragma unroll
            for (int fi = 0; fi < 4; ++fi) { const int f = D == 0 ? fi : 3 - fi; if (f == fq) mycin = cin; cin = hq[f] + pq[f] * cin; }
            carry = cin;
            if (MODE == 1) ptot *= pq[0] * pq[1] * pq[2] * pq[3];
            if (MODE == 0) {
                float hh = mycin; float y[4];
#pragma unroll
                for (int ji = 0; ji < 4; ++ji) { const int j = D == 0 ? ji : 3 - ji; hh = av[j] * hh + bv[j]; y[j] = hh; }
#pragma unroll
                for (int j = 0; j < 4; ++j) {
                    LAS bf16_t* yp = (LAS bf16_t*)(lds + YT_OFF + (sc * 64 + m * 16 + fq * 4 + j) * 272 + chl * 2);
                    if (D == 0) *yp = f2bf(y[j]);
                    else *yp = f2bf(bf2f(*yp) + y[j]);
                }
            }
        }
    }
    if (MODE == 0 && !lat && fq == 0) P.out[OUT_H + ((size_t)(s * 2 + l) * 2 + D) * 1024 + ch] = carry;
    if (MODE == 1 && fq == 0) { float* sp = SUMM + ((size_t)(((s - 32) * 2 + D) * 16 + cchunk) * 1024 + ch) * 2; sp[0] = ptot; sp[1] = carry; }
}
template <int MODE, int NSC>
__device__ void lru_unit(const Params& P, int l, int s, int cchunk, int h, LAS unsigned char* lds) {
    int tid_ = threadIdx.x; asm volatile("" : "+v"(tid_));
    const int tid = tid_, w = tid >> 6, lane = tid & 63, fr = lane & 15, fq = lane >> 4;
    const bool lat = s >= 32; const int T = lat ? 2048 : 256; const int row0 = lat ? MCTX + (s - 32) * 2048 : s * 256; const int t0 = cchunk * (NSC * 64);
    const bf16_t* XA = (const bf16_t*)(P.ws + OFF_XAQ);
    constexpr int RUN = NSC * 2;
    {
        const int ck = tid & 15, ch = h * 128 + ck * 8, tr = (tid >> 4) * RUN;
        const float* cw = P.lru_conv + (size_t)l * 4096 + ch; const float* cb = P.lru_conv_b + l * 1024 + ch;
        bf16x8 xr[RUN + 3];
#pragma unroll
        for (int i = 0; i < RUN + 3; ++i) { const int tt = t0 + tr + i - 2; xr[i] = (bf16x8){0, 0, 0, 0, 0, 0, 0, 0};
            if (tt >= 0 && tt < T) xr[i] = *(const bf16x8*)(XA + (size_t)(row0 + tt) * 1024 + ch); }
        float wk[4][8], bk[8];
#pragma unroll
        for (int e = 0; e < 8; ++e) { bk[e] = cb[e];
#pragma unroll
            for (int k = 0; k < 4; ++k) wk[k][e] = cw[k * 1024 + e]; }
        __syncthreads();
#pragma unroll
        for (int i = 0; i < RUN; ++i) {
            float a8[8];
#pragma unroll
            for (int e = 0; e < 8; ++e) { a8[e] = bk[e];
#pragma unroll
                for (int k = 0; k < 4; ++k) a8[e] += wk[k][e] * bf2f((unsigned short)xr[i + k][e]); }
            u32x4 o; o.x = pack2(a8[0], a8[1]); o.y = pack2(a8[2], a8[3]); o.z = pack2(a8[4], a8[5]); o.w = pack2(a8[6], a8[7]);
            *(LAS u32x4*)(lds + (tr + i) * 272 + ck * 16) = o;
        }
    }
    __syncthreads();
    lru_dir<MODE, 0, NSC>(P, l, s, cchunk, h, lds, w, fr, fq);
    lru_dir<MODE, 1, NSC>(P, l, s, cchunk, h, lds, w, fr, fq);
    if (MODE == 0) {
        bf16_t* YA = (bf16_t*)(P.ws + OFF_YA);
        __syncthreads();
#pragma unroll
        for (int it = 0; it < 2 * NSC; ++it) { const int t = (tid >> 4) + it * 32, ck = tid & 15;
            const u32x4 v = *(const LAS u32x4*)(lds + YT_OFF + t * 272 + ck * 16);
            *(u32x4*)(YA + (size_t)(row0 + t0 + t) * 1024 + h * 128 + ck * 8) = v; }
    }
}

#define XB_TMO      128
#define XB_XCNT(j)  (256  + 64 * (j))
#define XB_XSUB(j)  (1280 + 64 * (j))
#define XB_XGEN(j)  (2304 + 64 * (j))
#define XB_TOP      3328
#define XB_TOPGEN   3392
#define XCD_BAR_WORDS 3456
#define XB_SPIN_CAP (1u << 18)
__device__ __forceinline__ unsigned xb_ld(unsigned* p)              { return __hip_atomic_load(p, __ATOMIC_RELAXED, __HIP_MEMORY_SCOPE_AGENT); }
__device__ __forceinline__ unsigned xb_add(unsigned* p, unsigned v) { return __hip_atomic_fetch_add(p, v, __ATOMIC_RELAXED, __HIP_MEMORY_SCOPE_AGENT); }
__device__ __forceinline__ unsigned xb_xcc_id() { return (unsigned)__builtin_amdgcn_s_getreg((3 << 11) | 20) & 0xFu; }
#define XB_SPIN(cond, bar) do { unsigned _sp = 0; while (cond) { __builtin_amdgcn_s_sleep(1); \
    if ((++_sp & 255u) == 0u) { if (xb_ld(&(bar)[XB_TMO])) break; if (_sp > XB_SPIN_CAP) { atomicAdd(&(bar)[XB_TMO], 1u); break; } } } } while (0)
struct XcdBarrier { unsigned* bar; unsigned x; volatile LAS unsigned* st; };
__device__ __forceinline__ XcdBarrier xcd_barrier_post(unsigned* bar, volatile LAS unsigned* st) {
    XcdBarrier b; b.bar = bar; b.x = xb_xcc_id(); b.st = st;
    if (threadIdx.x == 0) (void)xb_add(&bar[XB_XCNT(b.x)], 1u);
    return b;
}
__device__ __forceinline__ void xcd_barrier_complete(unsigned* bar, unsigned x, unsigned& nloc, unsigned& nx) {
    const unsigned G = gridDim.x * gridDim.y * gridDim.z;
    unsigned sum, cnt, mine, sp = 0u;
    for (;;) {
        sum = 0u; cnt = 0u; mine = 0u;
#pragma unroll
        for (unsigned j = 0; j < 16; ++j) { const unsigned c = xb_ld(&bar[XB_XCNT(j)]); sum += c; cnt += (c > 0u) ? 1u : 0u; mine = (j == x) ? c : mine; }
        if (sum == G) break;
        __builtin_amdgcn_s_sleep(1);
        if ((++sp & 255u) == 0u) { if (xb_ld(&bar[XB_TMO])) break; if (sp > XB_SPIN_CAP) { atomicAdd(&bar[XB_TMO], 1u); break; } }
    }
    nloc = mine > 0u ? mine : 1u; nx = cnt > 0u ? cnt : 1u;
}
__device__ __noinline__ void xcd_barrier_(unsigned* bbar, unsigned bx, volatile LAS unsigned* bst) {
    XcdBarrier b; b.bar = bbar; b.x = bx; b.st = bst;
    asm volatile("s_waitcnt vmcnt(0)" ::: "memory");
    __syncthreads();
    if (threadIdx.x == 0) {
        unsigned* bar = b.bar;
        __builtin_amdgcn_s_waitcnt(0);
        unsigned nloc = b.st[0], nx = b.st[1];
        if (nloc == 0u) { xcd_barrier_complete(bar, b.x, nloc, nx); b.st[0] = nloc; b.st[1] = nx; }
        const unsigned old = xb_add(&bar[XB_XSUB(b.x)], 1u);
        const unsigned gen = old / nloc;
        if (old + 1u == (gen + 1u) * nloc) {
            __builtin_amdgcn_fence(__ATOMIC_RELEASE, "agent");
            asm volatile("s_waitcnt vmcnt(0)" ::: "memory");
            const unsigned og = xb_add(&bar[XB_TOP], 1u);
            const unsigned tg = og / nx;
            if (og + 1u == (tg + 1u) * nx) xb_add(&bar[XB_TOPGEN], 1u);
            else XB_SPIN(xb_ld(&bar[XB_TOPGEN]) == tg, bar);
            __builtin_amdgcn_fence(__ATOMIC_ACQUIRE, "agent");
            xb_add(&bar[XB_XGEN(b.x)], 1u);
            asm volatile("s_waitcnt vmcnt(0)" ::: "memory");
        } else {
            XB_SPIN(xb_ld(&bar[XB_XGEN(b.x)]) == gen, bar);
            __builtin_amdgcn_fence(__ATOMIC_ACQUIRE, "agent");
            asm volatile("s_waitcnt vmcnt(0)" ::: "memory");
        }
    }
    __syncthreads();
}

#ifndef REPMASK
#define REPMASK 0
#endif
#define REPLOOP(i) _Pragma("unroll 1") for (int rep_ = 0; rep_ < 1 + ((REPMASK >> (i)) & 1); ++rep_)
__global__ __launch_bounds__(512, 2) void mega(Params P) {
    extern __shared__ __attribute__((aligned(16))) unsigned char shm[];
    LAS unsigned char* lds = (LAS unsigned char*)shm;
    cg::grid_group grid = cg::this_grid();
    if (threadIdx.x == 0) *(LAS u32x4*)(lds + 147456) = (u32x4){0u, 0u, 0u, 0u};
    __syncthreads();
    const XcdBarrier xb = xcd_barrier_post((unsigned*)(P.ws + OFF_BAR), (volatile LAS unsigned*)(lds + 147456));
    const int G = gridDim.x, c = blockIdx.x;
    unsigned char* ws = P.ws;
    float* X = P.out;
    bf16_t* H = (bf16_t*)(ws + OFF_H);
    const float* MOD = (const float*)(ws + OFF_MOD);

    REPLOOP(12) phase0(P, lds);
    grid.sync();
    for (int l = 0; l < 2; ++l) {
        const float* mod = MOD + (size_t)l * 3 * 6144;
        const bool hide = (G == 256);
        { const int te = hide ? (l == 0 ? 1856 : 0) : 4992; if (te > 0) convert_weights(P, l, lds, 0, te, c, G); }
        const float* xa0 = l == 0 ? P.x_prompt : X; const float* xb0 = l == 0 ? P.x_sample : X + (size_t)MCTX * 1024;
        REPLOOP(1) norm_phase(xa0, xb0, P.norm1 + l * 1024, mod, 0, 1024, H);
        REPLOOP(11) xcd_barrier_(xb.bar, xb.x, xb.st);
        REPLOOP(2) { Sched S{(const char*)H, (const char*)(ws + OFF_WIN), 1024, 1024, 0, 48, 14, G, c, 256};
          EpiIn E{(bf16_t*)(ws + OFF_XAQ), (bf16_t*)(ws + OFF_XC), (bf16_t*)(ws + OFF_KB), (bf16_t*)(ws + OFF_VB), P.out + OUT_K, P.out + OUT_V, (const float*)(ws + OFF_ROPE), l};
          gemm_phase(lds, S, 1024, E); }
        if (hide && l == 0 && c >= 160) convert_weights(P, l, lds, 1856, 2624, c - 160, G - 160);
        REPLOOP(11) xcd_barrier_(xb.bar, xb.x, xb.st);
        REPLOOP(3) pool_phase((const bf16_t*)(ws + OFF_XC), (bf16_t*)(ws + OFF_PL));
        for (int it = c; it < 1280; it += G) {
            if (it < 256) { REPLOOP(4) attn_unit(P, l, it, lds); }
            else if (it < 512) { const int v = it - 256; REPLOOP(5) lru_unit<0, 4>(P, l, v >> 3, 0, v & 7, lds); }
            else if (it < 768) { const int q = it - 512; REPLOOP(5) lru_unit<1, 2>(P, l, 32 + (q >> 7), (q >> 3) & 15, q & 7, lds); }
            else { REPLOOP(7) attn_unit(P, l, it - 768 + 256, lds); }
        }
        REPLOOP(11) xcd_barrier_(xb.bar, xb.x, xb.st);
        { Sched S{(const char*)(ws + OFF_PL), (const char*)(ws + OFF_PW), 1024, 256, 256, 48, 4, G, c, 256};
          EpiPool E{(bf16_t*)(ws + OFF_XC), P.pool_scale + l * 1024};
          gemm_phase(lds, S, 256, E); }
#ifndef NO_LRU
        for (int it = G - 1 - c; it < 256; it += G) lru_unit<0, 2>(P, l, 32 + (it >> 7), (it >> 3) & 15, it & 7, lds);
#endif
        REPLOOP(11) xcd_barrier_(xb.bar, xb.x, xb.st);
        REPLOOP(6) { MergeSched S{(const char*)ws, 1024, 1024, c};
          EpiMerge E{(bf16_t*)(ws + OFF_GT), P.b_gate + l * 3072, (float*)(ws + OFF_XAQ), (bf16_t*)(ws + OFF_PL)};
          gemm_phase(lds, S, 1024, E); }
        if (hide && c >= 192) convert_weights(P, l, lds, 2624, 4992, c - 192, G - 192);
        REPLOOP(11) xcd_barrier_(xb.bar, xb.x, xb.st);
        { Sched S{(const char*)(ws + OFF_PL), (const char*)(ws + OFF_WOUT), 1024, 1024, 0, 64, 4, G, c, 192};
          EpiRes E{X, mod, 2048, xa0, xb0};
          gemm_phase<EpiRes, Sched, true>(lds, S, 1024, E); }
        REPLOOP(11) xcd_barrier_(xb.bar, xb.x, xb.st);
        norm_phase(X, X + (size_t)MCTX * 1024, P.norm2 + l * 1024, mod, 3072, 4096, H);
        REPLOOP(11) xcd_barrier_(xb.bar, xb.x, xb.st);
        REPLOOP(9) { Sched S{(const char*)H, (const char*)(ws + OFF_WUP), 1024, 1024, 0, 48, 22, G, c, 256};
          EpiUp E{(bf16_t*)(ws + OFF_ACT), (bf16_t*)(ws + OFF_SU), (bf16_t*)(ws + OFF_SV), P.ffn_conv + (size_t)l * 3 * 2816, P.ffn_conv_b + l * 2816};
          gemm_phase(lds, S, 1024, E); }
        if (hide && l == 0 && c >= 32) convert_weights(P, l + 1, lds, 0, 2624, c - 32, G - 32);
        REPLOOP(11) xcd_barrier_(xb.bar, xb.x, xb.st);
        REPLOOP(10) ffn_fix_phase((const bf16_t*)(ws + OFF_SU), (const bf16_t*)(ws + OFF_SV), (bf16_t*)(ws + OFF_ACT), P.ffn_conv + (size_t)l * 3 * 2816, P.ffn_conv_b + l * 2816);
        REPLOOP(11) xcd_barrier_(xb.bar, xb.x, xb.st);
        { Sched S{(const char*)(ws + OFF_ACT), (const char*)(ws + OFF_WDN), 2816, 2816, 0, 64, 4, G, c, 192};
          EpiRes E{X, mod, 5120, X, X + (size_t)MCTX * 1024};
          gemm_phase<EpiRes, Sched, true>(lds, S, 2816, E); }
        REPLOOP(11) xcd_barrier_(xb.bar, xb.x, xb.st);
    }
    final_norm_phase(X, P.final_norm);
}

extern "C" void kernel_launch(void* const* d_in, const int* in_sizes, int n_in, void* d_out, int out_size, void* d_ws, size_t ws_size, hipStream_t stream) {
    constexpr size_t kDynLds = 147456 + 16;
    static int grid_blocks = 0;
    if (!grid_blocks) {
        int dev = 0, cus = 0, per_cu = 0;
        hipGetDevice(&dev);
        hipDeviceGetAttribute(&cus, hipDeviceAttributeMultiprocessorCount, dev);
        hipFuncSetAttribute((const void*)mega, hipFuncAttributeMaxDynamicSharedMemorySize, (int)kDynLds);
        hipOccupancyMaxActiveBlocksPerMultiprocessor(&per_cu, mega, 512, kDynLds);
        if (per_cu < 1) per_cu = 1;
        if (per_cu > 1) per_cu = 1;
        grid_blocks = cus * per_cu;
    }
    Params p{};
    const float** pp = (const float**)&p;
    for (int i = 0; i < 30; ++i) pp[i] = (const float*)d_in[i];
    p.out = (float*)d_out; p.ws = (unsigned char*)d_ws;
    if (ws_size < OFF_END2 + 262144) { fprintf(stderr, "workspace too small: %zu < %zu\n", ws_size, (size_t)OFF_END2 + 262144); }
    hipMemsetAsync((unsigned char*)d_ws + OFF_BAR, 0, 16384, stream);
    void* args[] = {&p};
    hipError_t e = hipLaunchCooperativeKernel((void*)mega, dim3(grid_blocks), dim3(512), args, kDynLds, stream);
    if (e != hipSuccess) fprintf(stderr, "cooperative launch failed: %s (grid %d)\n", hipGetErrorString(e), grid_blocks);
}
```

```cpp
#include <hip/hip_runtime.h>
#include <hip/hip_cooperative_groups.h>
#include <cstdio>
namespace cg = cooperative_groups;

#define LAS __attribute__((address_space(3)))
typedef unsigned short bf16_t;
typedef short bf16x8 __attribute__((ext_vector_type(8)));
typedef float f32x4 __attribute__((ext_vector_type(4)));
typedef unsigned u32x4 __attribute__((ext_vector_type(4)));
typedef unsigned u32x2 __attribute__((ext_vector_type(2)));
typedef short bf16x4 __attribute__((ext_vector_type(4)));

constexpr int MROWS = 12288, MCTX = 8192;
constexpr size_t S24 = (size_t)MROWS * 1024 * 2;
constexpr size_t OFF_WIN = 0;
constexpr size_t OFF_WBR = OFF_WIN + (size_t)6656 * 1024 * 2;
constexpr size_t OFF_WOUT = OFF_WBR + (size_t)3 * 1024 * 1024 * 2;
constexpr size_t OFF_WUP = OFF_WOUT + (size_t)1024 * 1024 * 2;
constexpr size_t OFF_WDN = OFF_WUP + (size_t)5632 * 1024 * 2;
constexpr size_t OFF_GW = OFF_WDN + (size_t)1024 * 2816 * 2;
constexpr size_t OFF_PW = OFF_GW + (size_t)2 * 8 * 256 * 128 * 2;
constexpr size_t OFF_MOD = OFF_PW + (size_t)4 * 256 * 256 * 2;
constexpr size_t OFF_CK = OFF_MOD + (size_t)2 * 3 * 6144 * 4;
constexpr size_t OFF_CV = OFF_CK + (size_t)2 * 2 * 512 * 256 * 2;
constexpr size_t OFF_ROPE = OFF_CV + (size_t)2 * 2 * 512 * 256 * 2;
constexpr size_t OFF_SUMM = OFF_ROPE + (size_t)2 * 64 * 32 * 4;
constexpr size_t OFF_BAR = OFF_SUMM + (size_t)2 * 2 * 16 * 1024 * 2 * 4;
constexpr size_t OFF_ACT0 = OFF_BAR + 16384;
constexpr size_t OFF_XAQ = OFF_ACT0;
constexpr size_t OFF_XC = OFF_XAQ + 2 * S24;
constexpr size_t OFF_KB = OFF_XC + S24;
constexpr size_t OFF_VB = OFF_KB + (size_t)MROWS * 256 * 2;
constexpr size_t OFF_GT = OFF_VB + (size_t)MROWS * 256 * 2;
constexpr size_t OFF_YB = OFF_GT + S24;
constexpr size_t OFF_PL = OFF_YB + S24;
constexpr size_t OFF_YA = OFF_PL + S24;
constexpr size_t OFF_H = OFF_YA + S24;
constexpr size_t OFF_END = OFF_H + S24;
constexpr size_t OFF_ACT = OFF_XAQ;
constexpr size_t OFF_SU = OFF_END;
constexpr size_t OFF_SV = OFF_SU + (size_t)192 * 4 * 2816 * 2;
constexpr size_t OFF_END2 = OFF_SV + (size_t)192 * 2 * 2816 * 2;
constexpr size_t OUT_K = (size_t)MROWS * 1024;
constexpr size_t OUT_V = OUT_K + (size_t)32 * 2 * 256 * 256;
constexpr size_t OUT_H = OUT_V + (size_t)32 * 2 * 256 * 256;

struct Params {
    const float *x_prompt, *x_sample, *cache_k, *cache_v, *state_lru, *c, *c_ctx, *w_ada, *b_ada, *norm1, *norm2,
        *w_in, *b_gate, *lru_conv, *lru_conv_b, *lru_wa, *lru_ba, *lru_wx, *lru_bx, *lru_lambda, *attn_sink,
        *pool_w, *pool_scale, *w_branch, *w_out, *ffn_up, *ffn_conv, *ffn_conv_b, *ffn_down, *final_norm;
    float* out; unsigned char* ws;
};

typedef float f32x2_ __attribute__((ext_vector_type(2)));
typedef __bf16 bf16x2_ __attribute__((ext_vector_type(2)));
__device__ __forceinline__ unsigned pack2(float a, float b) { const f32x2_ v = {a, b}; const bf16x2_ r = __builtin_convertvector(v, bf16x2_); return __builtin_bit_cast(unsigned, r); }
__device__ __forceinline__ unsigned short f2bf(float f) { return (unsigned short)(pack2(f, f) & 0xffffu); }
__device__ __forceinline__ float bf2f(unsigned short b) { return __uint_as_float(((unsigned)b) << 16); }
__device__ __forceinline__ int otid() { int t = threadIdx.x; asm volatile("" : "+v"(t)); return t; }
__device__ __forceinline__ float sigmoidf_(float x) { return __builtin_amdgcn_rcpf(1.0f + __expf(-x)); }

constexpr int HTB = 128 * 64 * 2;
__device__ __forceinline__ int lds_byte(int r, int c) { const int st = (r >> 4) * 2 + (c >> 5), rr = r & 15, cc = c & 31, ob = rr * 64 + cc * 2; return st * 1024 + (ob ^ (((ob >> 9) & 1) << 5)); }
__device__ __forceinline__ void stage_rc(int b, int& R, int& C) { const int st = b / 1024, sb = b % 1024, swz = sb ^ (((sb >> 9) & 1) << 5); R = (st >> 1) * 16 + swz / 64; C = (st & 1) * 32 + (swz % 64) / 2; }

struct Unit { const char* a; const char* b; int pm, pn, z, row0, m192; };
struct Sched {
    const char* A; const char* B; int lda, ldb, acol, nM, nN, G, c, tm;
    __device__ __forceinline__ bool next(int i, Unit& u) const {
        const long L = (long)i * G + c; const int nwg = nM * nN; if (L >= nwg) return false;
        int wgid = (int)L; { const int q = nwg / 8, r = nwg % 8, xcd = wgid % 8, off = wgid / 8; wgid = (xcd < r ? xcd * (q + 1) : r * (q + 1) + (xcd - r) * q) + off; }
        const int nig = 8 * nN, gid = wgid / nig, fm = gid * 8, gsz = (nM - fm) < 8 ? (nM - fm) : 8;
        u.pm = fm + ((wgid % nig) % gsz); u.pn = (wgid % nig) / gsz;
        u.a = A + ((size_t)u.pm * tm * lda + (size_t)u.pn * acol) * 2; u.b = B + (size_t)u.pn * 256 * ldb * 2; u.z = 0; u.row0 = u.pm * tm; u.m192 = (tm == 192); return true;
    }
};
struct MergeSched {
    const char* ws; int lda, ldb, c;
    __device__ __forceinline__ bool next(int i, Unit& u) const {
        if (c >= 192 || i >= 6) return false;
        const int nN = 4;
        int wgid = c; { const int q = 24, xcd = wgid % 8, off = wgid / 8; wgid = xcd * q + off; }
        const int nig = 8 * nN, gid = wgid / nig, fm = gid * 8;
        u.pm = fm + ((wgid % nig) % 8); u.pn = (wgid % nig) / 8; u.z = i; u.row0 = u.pm * 256; u.m192 = 0;
        const int j = i >> 1;
        const size_t aoff = (size_t)u.row0 * 1024 * 2;
        size_t ao = OFF_H, bo = OFF_WIN + (size_t)3584 * 1024 * 2;
        if (i & 1) { bo = OFF_WBR; ao = OFF_YA; if (j == 1) ao = OFF_YB; if (j == 2) ao = OFF_XC; }
        u.a = ws + ao + aoff; u.b = ws + bo + ((size_t)j * 1024 + (size_t)u.pn * 256) * 1024 * 2;
        return true;
    }
};

template <class Epi, class SchedT, bool M192 = false>
__device__ __forceinline__ void gemm_phase(LAS unsigned char* lds, const SchedT& S, const int K_, const Epi& E) {
    int K = K_; asm volatile("" : "+s"(K));
    int tid_ = threadIdx.x; asm volatile("" : "+v"(tid_));
    const int tid = tid_, wid = __builtin_amdgcn_readfirstlane(tid >> 6), lane = tid & 63, wr = wid >> 2, wc = wid & 3, fr = lane & 15, fq = lane >> 4;
    const int nt = K / 64;
    unsigned voffA[2], voffB[2];
#pragma unroll
    for (int i = 0; i < 2; ++i) { int R, C; stage_rc(tid * 16 + i * 8192, R, C); voffA[i] = (unsigned)(R * S.lda + C) * 2u; voffB[i] = (unsigned)(R * S.ldb + C) * 2u; }
    const size_t kstep = 128;
    const size_t hstepA = (size_t)128 * S.lda * 2, hstepB = (size_t)128 * S.ldb * 2;
    const unsigned ldsw = (unsigned)wid * 1024u;
    const int aoff = lds_byte(wr * 64 + fr, fq * 8), boff = lds_byte(wc * 32 + fr, fq * 8);
#define G_SA(b, h) (((b) * 2 + (h)) * HTB)
#define G_SB(b, h) ((4 + (b) * 2 + (h)) * HTB)
#define G_STAGE(bufoff, gbase, voff) do { _Pragma("unroll") for (int _i = 0; _i < 2; ++_i) \
        __builtin_amdgcn_global_load_lds((const unsigned*)((const char*)(gbase) + (voff)[_i]), (LAS unsigned*)(lds + (bufoff) + ldsw + _i * 8192), 16, 0, 0); } while (0)
#define G_LDA(dst, b, h) do { _Pragma("unroll") for (int m = 0; m < 4; ++m) _Pragma("unroll") for (int k = 0; k < 2; ++k) dst[m][k] = *(const LAS bf16x8*)(lds + G_SA(b, h) + aoff + m * 2048 + k * 1024); } while (0)
#define G_LDB(dst, b, h) do { _Pragma("unroll") for (int n = 0; n < 2; ++n) _Pragma("unroll") for (int k = 0; k < 2; ++k) dst[n][k] = *(const LAS bf16x8*)(lds + G_SB(b, h) + boff + n * 2048 + k * 1024); } while (0)
#define G_MMA(ai, bj, At, Bt) do { if (M192 && (ai) == 1 && wr == 1) break; __builtin_amdgcn_s_setprio(1); _Pragma("unroll") for (int m = 0; m < 4; ++m) _Pragma("unroll") for (int n = 0; n < 2; ++n) _Pragma("unroll") for (int k = 0; k < 2; ++k) \
        acc[ai][bj][m][n] = __builtin_amdgcn_mfma_f32_16x16x32_bf16(Bt[n][k], At[m][k], acc[ai][bj][m][n], 0, 0, 0); __builtin_amdgcn_s_setprio(0); } while (0)
#define G_WAIT_V(n) asm volatile("s_waitcnt vmcnt(" #n ")" ::: "memory")
#define G_WAIT_L(n) asm volatile("s_waitcnt lgkmcnt(" #n ")" ::: "memory")
#define G_BAR __builtin_amdgcn_s_barrier()
#define G_SCHED __builtin_amdgcn_sched_barrier(0)
    Unit cur, nxt; int ui = 0;
    if (!S.next(0, cur)) return;
    f32x4 acc[2][2][4][2];
#pragma unroll
    for (int a = 0; a < 2; ++a)
#pragma unroll
        for (int b = 0; b < 2; ++b)
#pragma unroll
            for (int m = 0; m < 4; ++m)
#pragma unroll
                for (int n = 0; n < 2; ++n) acc[a][b][m][n] = (f32x4){0.f, 0.f, 0.f, 0.f};
    bf16x8 At[4][2], B0[2][2], B1[2][2];
    const char* cA = cur.a; const char* cB = cur.b;
    G_STAGE(G_SB(0, 0), cB, voffB); G_STAGE(G_SA(0, 0), cA, voffA); G_STAGE(G_SB(0, 1), cB + hstepB, voffB); G_STAGE(G_SA(0, 1), cA + hstepA, voffA);
    if (wr == 1) G_BAR;
    G_WAIT_V(4); G_BAR;
    G_STAGE(G_SB(1, 0), cB + kstep, voffB); G_STAGE(G_SA(1, 0), cA + kstep, voffA); G_STAGE(G_SB(1, 1), cB + hstepB + kstep, voffB);
    G_WAIT_V(6); G_BAR;
    for (;;) {
        const bool has_next = S.next(ui + 1, nxt);
        const char* nA = has_next ? nxt.a : cA; const char* nB = has_next ? nxt.b : cB;
        for (int t = 0; t < nt; t += 2) {
            const bool last = (t == nt - 2);
            const char* a1 = cA + (size_t)(t + 1) * kstep;
            const char* a2 = last ? nA : cA + (size_t)(t + 2) * kstep; const char* b2 = last ? nB : cB + (size_t)(t + 2) * kstep;
            const char* a3 = a2 + kstep; const char* b3 = b2 + kstep;
            G_LDB(B0, 0, 0); G_SCHED; G_LDA(At, 0, 0); G_STAGE(G_SA(1, 1), a1 + hstepA, voffA);
            G_WAIT_L(8); G_BAR; G_WAIT_L(0); G_MMA(0, 0, At, B0); G_BAR; G_SCHED;
            G_LDB(B1, 0, 1); G_STAGE(G_SB(0, 0), b2, voffB);
            G_BAR; G_WAIT_L(0); G_MMA(0, 1, At, B1); G_BAR;
            G_LDA(At, 0, 1); G_STAGE(G_SA(0, 0), a2, voffA);
            G_BAR; G_WAIT_L(0); G_MMA(1, 0, At, B0); G_BAR; G_SCHED;
            G_STAGE(G_SB(0, 1), b2 + hstepB, voffB);
            G_WAIT_V(6); G_BAR; G_MMA(1, 1, At, B1); G_BAR;
            G_LDB(B0, 1, 0); G_SCHED; G_LDA(At, 1, 0); G_STAGE(G_SA(0, 1), a2 + hstepA, voffA);
            G_WAIT_L(8); G_BAR; G_WAIT_L(0); G_MMA(0, 0, At, B0); G_BAR; G_SCHED;
            G_LDB(B1, 1, 1); G_STAGE(G_SB(1, 0), b3, voffB);
            G_BAR; G_WAIT_L(0); G_MMA(0, 1, At, B1); G_BAR;
            G_LDA(At, 1, 1); G_STAGE(G_SA(1, 0), a3, voffA);
            G_BAR; G_WAIT_L(0); G_MMA(1, 0, At, B0); G_BAR; G_SCHED;
            G_STAGE(G_SB(1, 1), b3 + hstepB, voffB);
            G_WAIT_V(6); G_BAR; G_MMA(1, 1, At, B1); G_BAR;
        }
        E(acc, cur, wr, wc, fr, fq);
        if (!has_next) break;
#pragma unroll
        for (int a = 0; a < 2; ++a)
#pragma unroll
            for (int b = 0; b < 2; ++b)
#pragma unroll
                for (int m = 0; m < 4; ++m)
#pragma unroll
                    for (int n = 0; n < 2; ++n) acc[a][b][m][n] = (f32x4){0.f, 0.f, 0.f, 0.f};
        cur = nxt; cA = nA; cB = nB; ++ui;
    }
    G_WAIT_V(0);
    if (wr == 0) G_BAR;
    G_BAR;
#undef G_SA
#undef G_SB
#undef G_STAGE
#undef G_LDA
#undef G_LDB
#undef G_MMA
#undef G_WAIT_V
#undef G_WAIT_L
#undef G_BAR
#undef G_SCHED
}

#define EPI_LOOP_BEGIN \
    _Pragma("unroll") for (int ai = 0; ai < 2; ++ai) _Pragma("unroll") for (int m = 0; m < 4; ++m) { const int row = u.pm * 256 + wr * 64 + fr + ai * 128 + m * 16; \
    _Pragma("unroll") for (int bj = 0; bj < 2; ++bj) _Pragma("unroll") for (int n = 0; n < 2; ++n) { const int cl = wc * 32 + 4 * fq + bj * 128 + n * 16; const f32x4 v = acc[ai][bj][m][n];
#define EPI_LOOP_END } }

__device__ __forceinline__ int seq_group(int row) { return row < MCTX ? 0 : 1 + ((row - MCTX) >> 11); }

struct EpiIn {
    bf16_t* xaq; bf16_t* xc; bf16_t* kb; bf16_t* vb; float* outk; float* outv; const float* rc; int l;
    __device__ __forceinline__ void operator()(const f32x4 (&acc)[2][2][4][2], const Unit& u, int wr, int wc, int fr, int fq) const {
        const int pn = u.pn; const bool qk = pn >= 4 && pn <= 8;
        bf16_t* dst; int ld, cbase; float* fo = nullptr;
        if (pn < 4) { dst = xaq; ld = 1024; cbase = pn * 256; }
        else if (pn < 8) { dst = xaq + (size_t)MROWS * 1024; ld = 1024; cbase = pn * 256 - 1024; }
        else if (pn == 8) { dst = kb; ld = 256; cbase = 0; fo = outk; }
        else if (pn == 9) { dst = vb; ld = 256; cbase = 0; fo = outv; }
        else { dst = xc; ld = 1024; cbase = pn * 256 - 2560; }
        const int hh = wc >> 1, i0 = 16 * (wc & 1) + 4 * fq;
        const int c1 = cbase + (qk ? 64 * hh + i0 : wc * 32 + 4 * fq), dc = qk ? 32 : 16;
        const bool rope = qk && u.pm >= 32;
#pragma unroll
        for (int ai = 0; ai < 2; ++ai) {
            f32x4 csm[4], snm[4];
#pragma unroll
            for (int m = 0; m < 4; ++m) { csm[m] = (f32x4){1.f, 1.f, 1.f, 1.f}; snm[m] = (f32x4){0.f, 0.f, 0.f, 0.f};
                if (rope) { const int row = u.pm * 256 + wr * 64 + fr + ai * 128 + m * 16; const int t = (row - MCTX) & 2047; const int pos = hh == 0 ? (t >> 6) : (t & 63);
                    csm[m] = *(const f32x4*)(rc + pos * 32 + i0); snm[m] = *(const f32x4*)(rc + 2048 + pos * 32 + i0); } }
#pragma unroll
            for (int m = 0; m < 4; ++m) {
                const int row = u.pm * 256 + wr * 64 + fr + ai * 128 + m * 16;
                const f32x4 cs = csm[m], sn = snm[m];
                bf16_t* dp = dst + (size_t)row * ld + c1;
                float* fp = fo + ((size_t)(((row >> 8) * 2 + l) * 256 + (row & 255))) * 256 + c1;
#pragma unroll
                for (int bj = 0; bj < 2; ++bj) {
                    const f32x4 x1 = acc[ai][bj][m][0], x2 = acc[ai][bj][m][1];
                    const f32x4 o1 = x1 * cs - x2 * sn, o2 = x1 * sn + x2 * cs;
                    uint2 p1, p2; p1.x = pack2(o1[0], o1[1]); p1.y = pack2(o1[2], o1[3]); p2.x = pack2(o2[0], o2[1]); p2.y = pack2(o2[2], o2[3]);
                    *(uint2*)(dp + bj * 128) = p1; *(uint2*)(dp + bj * 128 + dc) = p2;
                    if (fo != nullptr && row < MCTX) { *(f32x4*)(fp + bj * 128) = o1; *(f32x4*)(fp + bj * 128 + dc) = o2; }
                }
            }
        }
    }
};
struct EpiGate {
    bf16_t* gt; const float* bias;
    __device__ __forceinline__ void operator()(const f32x4 (&acc)[2][2][4][2], const Unit& u, int wr, int wc, int fr, int fq) const {
        const int c0 = u.pn * 256 + wc * 32 + 4 * fq;
        f32x4 bb[4];
#pragma unroll
        for (int g = 0; g < 4; ++g) bb[g] = *(const f32x4*)(bias + c0 + (g >> 1) * 128 + (g & 1) * 16);
#pragma unroll
        for (int ai = 0; ai < 2; ++ai) { if (ai == 1 && u.m192 && wr == 1) continue;
#pragma unroll
            for (int m = 0; m < 4; ++m) { const int row = u.row0 + wr * 64 + fr + ai * 128 + m * 16;
#pragma unroll
                for (int g = 0; g < 4; ++g) { const f32x4 v = acc[ai][g >> 1][m][g & 1];
                    uint2 pk; pk.x = pack2(sigmoidf_(v[0] + bb[g][0]), sigmoidf_(v[1] + bb[g][1])); pk.y = pack2(sigmoidf_(v[2] + bb[g][2]), sigmoidf_(v[3] + bb[g][3]));
                    *(uint2*)(gt + (size_t)row * 1024 + c0 + (g >> 1) * 128 + (g & 1) * 16) = pk; } } }
    }
};
template <int j> struct EpiBranch {
    const bf16_t* gt; float* tmp; bf16_t* mg;
    __device__ __forceinline__ void operator()(const f32x4 (&acc)[2][2][4][2], const Unit& u, int wr, int wc, int fr, int fq) const {
        const int c0 = u.pn * 256 + wc * 32 + 4 * fq;
#pragma unroll
        for (int ai = 0; ai < 2; ++ai) { if (ai == 1 && u.m192 && wr == 1) continue;
#pragma unroll
            for (int m = 0; m < 4; ++m) {
                const unsigned ro = (unsigned)(u.row0 + wr * 64 + fr + ai * 128 + m * 16) * 1024u + (unsigned)c0;
                uint2 gp[4]; f32x4 tv[4];
#pragma unroll
                for (int g = 0; g < 4; ++g) { const unsigned o = ro + (g >> 1) * 128 + (g & 1) * 16;
                    gp[g] = *(const uint2*)(gt + o); tv[g] = (f32x4){0.f, 0.f, 0.f, 0.f}; if (j != 0) tv[g] = *(const f32x4*)(tmp + o); }
#pragma unroll
                for (int g = 0; g < 4; ++g) { const unsigned o = ro + (g >> 1) * 128 + (g & 1) * 16;
                    const f32x4 v = acc[ai][g >> 1][m][g & 1];
                    f32x4 r = tv[g];
                    r[0] += v[0] * bf2f((unsigned short)(gp[g].x & 0xffff)); r[1] += v[1] * bf2f((unsigned short)(gp[g].x >> 16));
                    r[2] += v[2] * bf2f((unsigned short)(gp[g].y & 0xffff)); r[3] += v[3] * bf2f((unsigned short)(gp[g].y >> 16));
                    if (j != 2) *(f32x4*)(tmp + o) = r;
                    else { uint2 pk; pk.x = pack2(r[0], r[1]); pk.y = pack2(r[2], r[3]); *(uint2*)(mg + o) = pk; } }
            } }
    }
};
struct EpiMerge {
    bf16_t* gt; const float* bgate; float* tmp; bf16_t* mg;
    __device__ __forceinline__ void operator()(const f32x4 (&acc)[2][2][4][2], const Unit& u, int wr, int wc, int fr, int fq) const {
        const int j = u.z >> 1;
        if ((u.z & 1) == 0) { EpiGate E{gt, bgate + j * 1024}; E(acc, u, wr, wc, fr, fq); }
        else if (j == 0) { EpiBranch<0> E{gt, tmp, mg}; E(acc, u, wr, wc, fr, fq); }
        else if (j == 1) { EpiBranch<1> E{gt, tmp, mg}; E(acc, u, wr, wc, fr, fq); }
        else { EpiBranch<2> E{gt, tmp, mg}; E(acc, u, wr, wc, fr, fq); }
    }
};
struct EpiRes {
    float* x; const float* mod; int goff; const float* xa; const float* xb;
    __device__ __forceinline__ const float* src(unsigned o) const { return o < (unsigned)MCTX * 1024u ? xa + o : xb + (o - (unsigned)MCTX * 1024u); }
    __device__ __forceinline__ void operator()(const f32x4 (&acc)[2][2][4][2], const Unit& u, int wr, int wc, int fr, int fq) const {
        const int c0 = u.pn * 256 + wc * 32 + 4 * fq;
        const int sg0 = seq_group(u.row0), sg1 = seq_group(u.row0 + (u.m192 ? 191 : 255));
        if (sg0 == sg1) {
            const float* gsrc = mod + sg0 * 6144 + goff;
            f32x4 gg[4];
#pragma unroll
            for (int g = 0; g < 4; ++g) gg[g] = *(const f32x4*)(gsrc + c0 + (g >> 1) * 128 + (g & 1) * 16);
#pragma unroll
            for (int ai = 0; ai < 2; ++ai) { if (ai == 1 && u.m192 && wr == 1) continue;
#pragma unroll
                for (int mp = 0; mp < 2; ++mp) {
                    const unsigned ro = (unsigned)(u.row0 + wr * 64 + fr + ai * 128 + mp * 32) * 1024u + (unsigned)c0;
                    f32x4 xv[8];
#pragma unroll
                    for (int k = 0; k < 8; ++k) { const int g = k & 3; xv[k] = *(const f32x4*)src(ro + (k >> 2) * 16384 + (g >> 1) * 128 + (g & 1) * 16); }
#pragma unroll
                    for (int k = 0; k < 8; ++k) { const int g = k & 3, m = mp * 2 + (k >> 2); *(f32x4*)(x + (ro + (k >> 2) * 16384 + (g >> 1) * 128 + (g & 1) * 16)) = xv[k] + gg[g] * acc[ai][g >> 1][m][g & 1]; }
                } }
        } else {
#pragma unroll
            for (int ai = 0; ai < 2; ++ai) { if (ai == 1 && u.m192 && wr == 1) continue;
#pragma unroll
                for (int m = 0; m < 4; ++m) {
                    const int row = u.row0 + wr * 64 + fr + ai * 128 + m * 16;
                    const float* gsrc = mod + seq_group(row) * 6144 + goff + c0;
                    const unsigned ro = (unsigned)row * 1024u + (unsigned)c0;
                    f32x4 xv[4], gv[4];
#pragma unroll
                    for (int g = 0; g < 4; ++g) { xv[g] = *(const f32x4*)src(ro + (g >> 1) * 128 + (g & 1) * 16); gv[g] = *(const f32x4*)(gsrc + (g >> 1) * 128 + (g & 1) * 16); }
#pragma unroll
                    for (int g = 0; g < 4; ++g) *(f32x4*)(x + (ro + (g >> 1) * 128 + (g & 1) * 16)) = xv[g] + gv[g] * acc[ai][g >> 1][m][g & 1];
                } }
        }
    }
};
struct EpiBf {
    bf16_t* dst; int ld;
    __device__ __forceinline__ void operator()(const f32x4 (&acc)[2][2][4][2], const Unit& u, int wr, int wc, int fr, int fq) const {
        EPI_LOOP_BEGIN
            const int col = u.pn * 256 + cl;
            uint2 pk; pk.x = pack2(v[0], v[1]); pk.y = pack2(v[2], v[3]);
            *(uint2*)(dst + (size_t)row * ld + col) = pk;
        EPI_LOOP_END
    }
};
__device__ __forceinline__ float dpp_f(float old, float src, const int ctrl_sel) {
    const int o = __float_as_int(old), v = __float_as_int(src);
    int r;
    if (ctrl_sel == 0) r = __builtin_amdgcn_update_dpp(o, v, 0x111, 0xf, 0xf, false);
    else if (ctrl_sel == 1) r = __builtin_amdgcn_update_dpp(o, v, 0x101, 0xf, 0xf, false);
    else if (ctrl_sel == 2) r = __builtin_amdgcn_update_dpp(o, v, 0x121, 0xf, 0xf, false);
    else r = __builtin_amdgcn_update_dpp(o, v, 0x12f, 0xf, 0xf, false);
    return __int_as_float(r);
}
__device__ __forceinline__ float gelu_tanh(float x) { const float y = 0.7978845608028654f * (x + 0.044715f * x * x * x); const float t = 1.0f - 2.0f * __builtin_amdgcn_rcpf(1.0f + __expf(2.0f * y)); return 0.5f * x * (1.0f + t); }
struct EpiUp {
    bf16_t* act; bf16_t* su; bf16_t* sv; const float* cw; const float* cb;
    __device__ __forceinline__ void operator()(const f32x4 (&acc)[2][2][4][2], const Unit& u, int wr, int wc, int fr, int fq) const {
#pragma unroll
        for (int n = 0; n < 2; ++n) {
            const int ch = u.pn * 128 + wc * 32 + 16 * n + 4 * fq;
            const f32x4 w0 = *(const f32x4*)(cw + ch), w1 = *(const f32x4*)(cw + 2816 + ch), w2 = *(const f32x4*)(cw + 5632 + ch), bb = *(const f32x4*)(cb + ch);
#pragma unroll
            for (int ai = 0; ai < 2; ++ai) {
                const int rowg = u.row0 + ai * 128 + wr * 64;
                f32x4 ub[4];
#pragma unroll
                for (int m = 0; m < 4; ++m)
#pragma unroll
                    for (int e = 0; e < 4; ++e) ub[m][e] = bf2f(f2bf(acc[ai][0][m][n][e]));
#pragma unroll
                for (int m = 0; m < 4; ++m) {
                    const int row = rowg + m * 16 + fr;
                    f32x4 r;
#pragma unroll
                    for (int e = 0; e < 4; ++e) {
                        const float pl = m > 0 ? dpp_f(0.f, ub[m > 0 ? m - 1 : 0][e], 2) : 0.f;
                        const float pv = dpp_f(pl, ub[m][e], 0);
                        const float nl = m < 3 ? dpp_f(0.f, ub[m < 3 ? m + 1 : 3][e], 3) : 0.f;
                        const float nv = dpp_f(nl, ub[m][e], 1);
                        const float gff = w0[e] * pv + w1[e] * ub[m][e] + w2[e] * nv + bb[e];
                        r[e] = gelu_tanh(gff) * bf2f(f2bf(acc[ai][1][m][n][e]));
                    }
                    const bool edge = (m == 0 && fr == 0) || (m == 3 && fr == 15);
                    if (!edge) { uint2 pk; pk.x = pack2(r[0], r[1]); pk.y = pack2(r[2], r[3]); *(uint2*)(act + (size_t)row * 2816 + ch) = pk; }
                    if ((m == 0 && fr < 2) || (m == 3 && fr >= 14)) {
                        const int slot = m == 0 ? fr : fr - 12; const int g64 = rowg >> 6;
                        uint2 pk; pk.x = pack2(ub[m][0], ub[m][1]); pk.y = pack2(ub[m][2], ub[m][3]);
                        *(uint2*)(su + ((size_t)g64 * 4 + slot) * 2816 + ch) = pk;
                        if (edge) { const f32x4 vv = acc[ai][1][m][n]; uint2 pv2; pv2.x = pack2(vv[0], vv[1]); pv2.y = pack2(vv[2], vv[3]); *(uint2*)(sv + ((size_t)g64 * 2 + (m == 0 ? 0 : 1)) * 2816 + ch) = pv2; }
                    }
                }
            }
        }
    }
};
struct EpiPool {
    bf16_t* dst; const float* scale;
    __device__ __forceinline__ void operator()(const f32x4 (&acc)[2][2][4][2], const Unit& u, int wr, int wc, int fr, int fq) const {
        const int c0 = u.pn * 256 + wc * 32 + 4 * fq;
        f32x4 sc[4];
#pragma unroll
        for (int g = 0; g < 4; ++g) sc[g] = *(const f32x4*)(scale + c0 + (g >> 1) * 128 + (g & 1) * 16);
#pragma unroll
        for (int ai = 0; ai < 2; ++ai)
#pragma unroll
            for (int m = 0; m < 4; ++m) { const int row = u.pm * 256 + wr * 64 + fr + ai * 128 + m * 16;
#pragma unroll
                for (int g = 0; g < 4; ++g) { const f32x4 v = acc[ai][g >> 1][m][g & 1] * sc[g];
                    uint2 pk; pk.x = pack2(v[0], v[1]); pk.y = pack2(v[2], v[3]);
                    *(uint2*)(dst + (size_t)row * 1024 + c0 + (g >> 1) * 128 + (g & 1) * 16) = pk; } }
    }
};

struct WPtrs { const float *w_in, *w_branch, *lru_wa, *lru_wx, *pool_w, *w_out, *ffn_up, *ffn_down; unsigned char* ws; };
struct TileDesc { const float* src; int lds_; bf16_t* dst; int ldd, k0, n0, perm, nd; };
__device__ __forceinline__ int swap45(int p) { return (p & ~48) | ((p & 16) << 1) | ((p & 32) >> 1); }
__device__ __forceinline__ TileDesc weight_tile(const WPtrs& P, int l, int t) {
    unsigned char* ws = P.ws; TileDesc d; int r = t; d.perm = 0; d.nd = -1;
    if (r < 1664) { d.src = P.w_in + (size_t)l * 1024 * 6656; d.lds_ = 6656; d.dst = (bf16_t*)(ws + OFF_WIN); d.ldd = 1024; d.k0 = (r / 104) * 64; d.n0 = (r % 104) * 64; d.perm = (d.n0 >= 1024 && d.n0 < 2304) ? 1 : 0; }
    else if ((r -= 1664) < 128) { const int mat = r / 64; r %= 64; const int dh = r / 4; r %= 4;
        d.src = (mat ? P.lru_wx : P.lru_wa) + (size_t)(l * 16 + dh) * 128 * 128; d.lds_ = 128; d.dst = (bf16_t*)(ws + OFF_GW) + (size_t)dh * 256 * 128 + (size_t)mat * 128 * 128; d.ldd = 128; d.k0 = (r / 2) * 64; d.n0 = (r % 2) * 64; }
    else if ((r -= 128) < 64) { const int g = r / 16; r %= 16; d.src = P.pool_w + (size_t)(l * 4 + g) * 256 * 256; d.lds_ = 256; d.dst = (bf16_t*)(ws + OFF_PW) + (size_t)g * 256 * 256; d.ldd = 256; d.k0 = (r / 4) * 64; d.n0 = (r % 4) * 64; }
    else if ((r -= 64) < 768) { const int j = r / 256; r %= 256; d.src = P.w_branch + (size_t)(l * 3 + j) * 1024 * 1024; d.lds_ = 1024; d.dst = (bf16_t*)(ws + OFF_WBR) + (size_t)j * 1024 * 1024; d.ldd = 1024; d.k0 = (r / 16) * 64; d.n0 = (r % 16) * 64; }
    else if ((r -= 768) < 256) { d.src = P.w_out + (size_t)l * 1024 * 1024; d.lds_ = 1024; d.dst = (bf16_t*)(ws + OFF_WOUT); d.ldd = 1024; d.k0 = (r / 16) * 64; d.n0 = (r % 16) * 64; }
    else if ((r -= 256) < 1408) { d.src = P.ffn_up + (size_t)l * 1024 * 5632; d.lds_ = 5632; d.dst = (bf16_t*)(ws + OFF_WUP); d.ldd = 1024; d.k0 = (r / 88) * 64; d.n0 = (r % 88) * 64;
        { const int isv = d.n0 >= 2816, c0 = isv ? d.n0 - 2816 : d.n0; d.nd = (c0 >> 7) * 256 + (c0 & 127) + (isv ? 128 : 0); } }
    else { r -= 1408; d.src = P.ffn_down + (size_t)l * 2816 * 1024; d.lds_ = 1024; d.dst = (bf16_t*)(ws + OFF_WDN); d.ldd = 2816; d.k0 = (r / 16) * 64; d.n0 = (r % 16) * 64; }
    return d;
}
__device__ __noinline__ void convert_weights_(const float* p0, const float* p1, const float* p2, const float* p3, const float* p4, const float* p5, const float* p6, const float* p7, unsigned char* pws,
                                              int l, LAS unsigned char* lds, int t_begin, int t_end, int first, int stride) {
    const WPtrs P{p0, p1, p2, p3, p4, p5, p6, p7, pws};
    LAS bf16_t* sm = (LAS bf16_t*)lds;
    const int tid = otid();
    const int kk0 = tid >> 4, n4 = (tid & 15) * 4, nn = tid >> 3, ck = tid & 7;
    int t = t_begin + first;
    if (t >= t_end) return;
    TileDesc d = weight_tile(P, l, t);
    f32x4 v0 = *(const f32x4*)(d.src + (size_t)(d.k0 + kk0) * d.lds_ + d.n0 + n4), v1 = *(const f32x4*)(d.src + (size_t)(d.k0 + kk0 + 32) * d.lds_ + d.n0 + n4);
    for (;;) {
        __syncthreads();
#pragma unroll
        for (int e = 0; e < 4; ++e) { sm[(n4 + e) * 72 + kk0] = f2bf(v0[e]); sm[(n4 + e) * 72 + kk0 + 32] = f2bf(v1[e]); }
        __syncthreads();
        const TileDesc cur = d; const int tn = t + stride; const bool more = tn < t_end;
        if (more) { d = weight_tile(P, l, tn); v0 = *(const f32x4*)(d.src + (size_t)(d.k0 + kk0) * d.lds_ + d.n0 + n4); v1 = *(const f32x4*)(d.src + (size_t)(d.k0 + kk0 + 32) * d.lds_ + d.n0 + n4); }
        const u32x4 o = *(const LAS u32x4*)(sm + nn * 72 + ck * 8);
        const int nrow = cur.perm ? swap45(cur.n0 + nn) : ((cur.nd >= 0 ? cur.nd : cur.n0) + nn);
        *(u32x4*)(cur.dst + (size_t)nrow * cur.ldd + cur.k0 + ck * 8) = o;
        if (!more) break;
        t = tn;
    }
    __syncthreads();
}

__device__ __forceinline__ void convert_weights(const Params& P, int l, LAS unsigned char* lds, int t_begin, int t_end, int first, int stride) {
    convert_weights_(P.w_in, P.w_branch, P.lru_wa, P.lru_wx, P.pool_w, P.w_out, P.ffn_up, P.ffn_down, P.ws, l, lds, t_begin, t_end, first, stride);
}

__device__ void phase0(const Params& P, LAS unsigned char* lds) {
    const int tid = otid(), G = gridDim.x, c = blockIdx.x;
    { bf16_t* ck = (bf16_t*)(P.ws + OFF_CK); bf16_t* cv = (bf16_t*)(P.ws + OFF_CV);
      for (int i = c * 512 + tid; i < 2 * 2 * 512 * 256; i += G * 512) {
          const int e = i & 255, t = (i >> 8) & 511, b = (i >> 17) & 1, l = i >> 18;
          const size_t si = ((size_t)((b * 2 + l) * 512 + t)) * 256 + e;
          ck[i] = f2bf(P.cache_k[si]); cv[i] = f2bf(P.cache_v[si]); } }
    { float* rc = (float*)(P.ws + OFF_ROPE); float* rs = rc + 2048;
      for (int i = c * 512 + tid; i < 2048; i += G * 512) {
          const int pos = i >> 5, k = i & 31; const float fr = powf(10000.0f, -(float)k / 32.0f); const float ang = (float)pos * fr;
          rc[i] = cosf(ang); rs[i] = sinf(ang); } }
    { LAS float* sv = (LAS float*)lds;
      LAS float* red = sv + 3072;
      __syncthreads();
      for (int i = tid; i < 3072; i += 512) { const int s = i >> 10, k = i & 1023; const float x = s == 0 ? P.c_ctx[k] : P.c[(s - 1) * 1024 + k]; sv[i] = x / (1.0f + expf(-x)); }
      __syncthreads();
      float* mod = (float*)(P.ws + OFF_MOD);
      for (int it = c; it < 384; it += G) {
          const int l = it / 192, cg_ = it % 192, cl = tid & 31, kg = tid >> 5, col = cg_ * 32 + cl;
          const float* w = P.w_ada + (size_t)l * 1024 * 6144 + col;
          float a0 = 0.f, a1 = 0.f, a2 = 0.f;
#pragma unroll 16
          for (int k = kg * 64; k < kg * 64 + 64; ++k) { const float wv = w[(size_t)k * 6144]; a0 += sv[k] * wv; a1 += sv[1024 + k] * wv; a2 += sv[2048 + k] * wv; }
          red[(kg * 3 + 0) * 32 + cl] = a0; red[(kg * 3 + 1) * 32 + cl] = a1; red[(kg * 3 + 2) * 32 + cl] = a2;
          __syncthreads();
          if (tid < 96) { const int s = tid >> 5, cc = tid & 31; float sum = 0.f;
#pragma unroll
              for (int g = 0; g < 16; ++g) sum += red[(g * 3 + s) * 32 + cc];
              mod[(size_t)(l * 3 + s) * 6144 + cg_ * 32 + cc] = sum + P.b_ada[l * 6144 + cg_ * 32 + cc]; }
          __syncthreads();
      } }
}

template <bool FINAL>
__device__ __forceinline__ void norm_rows(float* X, const float* xa, const float* xb, const float* __restrict__ gw, const float* __restrict__ mod, int shift_off, int scale_off, bf16_t* __restrict__ H) {
    const int tid = otid(); const int lane = tid & 63, wv = blockIdx.x * 8 + (tid >> 6), nw = gridDim.x * 8;
    constexpr int R = 3;
    for (int row0 = wv; row0 < MROWS; row0 += R * nw) {
        f32x4 v[R][4];
#pragma unroll
        for (int r = 0; r < R; ++r) { const int row = row0 + r * nw;
#pragma unroll
            for (int i = 0; i < 4; ++i) v[r][i] = row < MROWS ? *(const f32x4*)((row < MCTX ? xa + (size_t)row * 1024 : xb + (size_t)(row - MCTX) * 1024) + i * 256 + lane * 4) : (f32x4){0.f, 0.f, 0.f, 0.f}; }
#pragma unroll
        for (int r = 0; r < R; ++r) { const int row = row0 + r * nw; if (row >= MROWS) continue;
            float ss = 0.f;
#pragma unroll
            for (int i = 0; i < 4; ++i) ss += v[r][i][0] * v[r][i][0] + v[r][i][1] * v[r][i][1] + v[r][i][2] * v[r][i][2] + v[r][i][3] * v[r][i][3];
#pragma unroll
            for (int o = 32; o >= 1; o >>= 1) ss += __shfl_xor(ss, o);
            const float rstd = rsqrtf(ss * (1.0f / 1024.0f) + 1e-6f);
            const float* md = mod + seq_group(row) * 6144;
#pragma unroll
            for (int i = 0; i < 4; ++i) { const int col = i * 256 + lane * 4;
                const f32x4 g = *(const f32x4*)(gw + col);
                if (FINAL) { f32x4 h;
#pragma unroll
                    for (int e = 0; e < 4; ++e) h[e] = v[r][i][e] * rstd * g[e];
                    *(f32x4*)(X + (size_t)row * 1024 + col) = h; }
                else { const f32x4 sc = *(const f32x4*)(md + scale_off + col), sh = *(const f32x4*)(md + shift_off + col);
                    f32x4 h;
#pragma unroll
                    for (int e = 0; e < 4; ++e) h[e] = v[r][i][e] * rstd * g[e] * (1.0f + sc[e]) + sh[e];
                    uint2 pk; pk.x = pack2(h[0], h[1]); pk.y = pack2(h[2], h[3]);
                    *(uint2*)(H + (size_t)row * 1024 + col) = pk; } }
        }
    }
}
__device__ void norm_phase(const float* xa, const float* xb, const float* __restrict__ gw, const float* __restrict__ mod, int shift_off, int scale_off, bf16_t* __restrict__ H) { norm_rows<false>(nullptr, xa, xb, gw, mod, shift_off, scale_off, H); }
__device__ void final_norm_phase(float* X, const float* __restrict__ gw) { norm_rows<true>(X, X, X + (size_t)MCTX * 1024, gw, nullptr, 0, 0, nullptr); }

template <int HALF>
__device__ __forceinline__ void pool_item(const bf16_t* __restrict__ XC, bf16_t* __restrict__ PL, int it) {
    constexpr int G_ = HALF == 1 ? 0 : (HALF == 2 ? 1 : (HALF == 4 ? 2 : 3));
    const int rs = (it >> 5) * 8, ch = G_ * 256 + (it & 31) * 8;
    const int T = rs < MCTX ? 256 : 2048, row0 = rs < MCTX ? (rs & ~255) : MCTX + ((rs - MCTX) & ~2047), tl0 = rs - row0;
    const bf16_t* base = XC + (size_t)row0 * 1024 + ch;
    constexpr int R = 8 + 2 * HALF;
    bf16x8 xr[R];
#pragma unroll
    for (int i = 0; i < R; ++i) { const int t = tl0 - HALF + i; xr[i] = (bf16x8){0, 0, 0, 0, 0, 0, 0, 0}; if (t >= 0 && t < T) xr[i] = *(const bf16x8*)(base + (size_t)t * 1024); }
    float s[8];
#pragma unroll
    for (int e = 0; e < 8; ++e) { s[e] = 0.f;
#pragma unroll
        for (int i = 0; i < 2 * HALF; ++i) s[e] += bf2f((unsigned short)xr[i][e]); }
#pragma unroll
    for (int j = 0; j < 8; ++j) {
        const int t = tl0 + j;
        const float inv = 1.0f / (float)(min(t + HALF, T) - max(t - HALF, 0));
        float r[8];
#pragma unroll
        for (int e = 0; e < 8; ++e) r[e] = s[e] * inv - bf2f((unsigned short)xr[j + HALF][e]);
        u32x4 o; o.x = pack2(r[0], r[1]); o.y = pack2(r[2], r[3]); o.z = pack2(r[4], r[5]); o.w = pack2(r[6], r[7]);
        *(u32x4*)(PL + (size_t)(row0 + t) * 1024 + ch) = o;
#pragma unroll
        for (int e = 0; e < 8; ++e) s[e] += bf2f((unsigned short)xr[j + 2 * HALF][e]) - bf2f((unsigned short)xr[j][e]);
    }
}
__device__ void pool_phase(const bf16_t* __restrict__ XC, bf16_t* __restrict__ PL) {
    const int tid = otid();
    constexpr int PER_G = (MROWS / 8) * 32;
    for (int idx = blockIdx.x * 512 + tid; idx < 4 * PER_G; idx += gridDim.x * 512) {
        const int g = idx / PER_G, it = idx % PER_G;
        if (g == 0) pool_item<1>(XC, PL, it); else if (g == 1) pool_item<2>(XC, PL, it); else if (g == 2) pool_item<4>(XC, PL, it); else pool_item<8>(XC, PL, it);
    }
}
__device__ void ffn_fix_groups(const bf16_t* __restrict__ SU, const bf16_t* __restrict__ SV, bf16_t* __restrict__ ACT, const float* __restrict__ cw, const float* __restrict__ cb, int g0, int ng) {
    const int tid = otid();
    for (int idx = tid; idx < ng * 2 * 352; idx += 512) {
        const int br = idx / 352, ch = (idx % 352) * 8;
        const int g = g0 + (br >> 1), last = br & 1;
        const int row = g * 64 + (last ? 63 : 0);
        const int T = row < MCTX ? 256 : 2048, row0 = row < MCTX ? (row & ~255) : MCTX + ((row - MCTX) & ~2047), tl = row - row0;
        const bf16x8 zero = (bf16x8){0, 0, 0, 0, 0, 0, 0, 0};
        bf16x8 um, u0, un;
        if (last) { um = *(const bf16x8*)(SU + ((size_t)g * 4 + 2) * 2816 + ch); u0 = *(const bf16x8*)(SU + ((size_t)g * 4 + 3) * 2816 + ch);
                    un = tl < T - 1 ? *(const bf16x8*)(SU + ((size_t)(g + 1) * 4 + 0) * 2816 + ch) : zero; }
        else { um = tl > 0 ? *(const bf16x8*)(SU + ((size_t)(g - 1) * 4 + 3) * 2816 + ch) : zero; u0 = *(const bf16x8*)(SU + ((size_t)g * 4 + 0) * 2816 + ch);
               un = *(const bf16x8*)(SU + ((size_t)g * 4 + 1) * 2816 + ch); }
        const bf16x8 vv = *(const bf16x8*)(SV + ((size_t)g * 2 + last) * 2816 + ch);
        float r[8];
#pragma unroll
        for (int e = 0; e < 8; ++e) { const float gff = cw[ch + e] * bf2f((unsigned short)um[e]) + cw[2816 + ch + e] * bf2f((unsigned short)u0[e]) + cw[5632 + ch + e] * bf2f((unsigned short)un[e]) + cb[ch + e];
            r[e] = gelu_tanh(gff) * bf2f((unsigned short)vv[e]); }
        u32x4 o; o.x = pack2(r[0], r[1]); o.y = pack2(r[2], r[3]); o.z = pack2(r[4], r[5]); o.w = pack2(r[6], r[7]);
        *(u32x4*)(ACT + (size_t)row * 2816 + ch) = o;
    }
}

__device__ __forceinline__ void rope8(bf16x8& x1, bf16x8& x2, const float* __restrict__ cs, const float* __restrict__ sn) {
#pragma unroll
    for (int e = 0; e < 8; ++e) { const float a = bf2f((unsigned short)x1[e]), b = bf2f((unsigned short)x2[e]); const float c = cs[e], s = sn[e];
        x1[e] = (short)f2bf(a * c - b * s); x2[e] = (short)f2bf(a * s + b * c); }
}
constexpr int VT_OFF = 64 * 272;
constexpr int ABUF = 64 * 272 + 64 * 288;
__device__ void attn_unit(const Params& P, int l, int u, LAS unsigned char* lds) {
    int tid_ = threadIdx.x; asm volatile("" : "+v"(tid_));
    const int tid = tid_, w = tid >> 6, lane = tid & 63, fr = lane & 15, fq = lane >> 4;
    const bf16_t* Q = (const bf16_t*)(P.ws + OFF_XAQ) + (size_t)MROWS * 1024;
    const bf16_t* KB = (const bf16_t*)(P.ws + OFF_KB); const bf16_t* VB = (const bf16_t*)(P.ws + OFF_VB);
    const bf16_t* CK = (const bf16_t*)(P.ws + OFF_CK); const bf16_t* CV = (const bf16_t*)(P.ws + OFF_CV);
    bf16_t* YB = (bf16_t*)(P.ws + OFF_YB);
    bool lat; int head, row0, T, qstart, bidx;
    if (u < 256) { lat = true; bidx = u >> 7; const int rem = u & 127; head = rem >> 4; qstart = (rem & 15) * 128; T = 2048; row0 = MCTX + bidx * 2048; }
    else { const int v = u - 256; lat = false; bidx = 0; const int seq = v >> 4, rem = v & 15; head = rem >> 1; qstart = (rem & 1) * 128; T = 256; row0 = seq * 256; }
    const int kvh = head >> 2;
    const int qpos = qstart + w * 16 + fr;
    bf16x8 qf[4];
    { const bf16_t* qp = Q + (size_t)(row0 + qpos) * 1024 + head * 128 + fq * 8;
#pragma unroll
      for (int kk = 0; kk < 4; ++kk) qf[kk] = *(const bf16x8*)(qp + kk * 32); }
    float m_run = P.attn_sink[l * 8 + head] * 1.4426950408889634f; float l_run = (fq == 0) ? 1.0f : 0.0f;
    f32x4 o[8];
#pragma unroll
    for (int dt = 0; dt < 8; ++dt) o[dt] = (f32x4){0.f, 0.f, 0.f, 0.f};
    int wlo = 0, nwt = 4;
    if (lat) { wlo = max(0, qstart - 128); const int whi = min(T, qstart + 256); nwt = (whi - wlo) >> 6; }
    const int ntiles = nwt + (lat ? 8 : 0);
    const float scale = 0.08838834764831845f * 1.4426950408889634f;
    const int lkey = tid >> 3, lp = tid & 7;
    bf16x8 rk[2][2], rv[2][2];
    auto tile_load = [&](int ti, bf16x8 (&k_)[2], bf16x8 (&v_)[2]) {
        const bf16_t* ksrc; const bf16_t* vsrc;
        if (ti < nwt) { const int k0 = wlo + ti * 64; ksrc = KB + (size_t)(row0 + k0) * 256 + kvh * 128; vsrc = VB + (size_t)(row0 + k0) * 256 + kvh * 128; }
        else { const int k0 = (ti - nwt) * 64; const size_t o_ = ((size_t)((l * 2 + bidx) * 512 + k0)) * 256 + kvh * 128; ksrc = CK + o_; vsrc = CV + o_; }
        const bf16_t* kr = ksrc + (size_t)lkey * 256; k_[0] = *(const bf16x8*)(kr + lp * 8); k_[1] = *(const bf16x8*)(kr + (lp + 8) * 8);
        const bf16_t* vr = vsrc + (size_t)lkey * 256; v_[0] = *(const bf16x8*)(vr + lp * 8); v_[1] = *(const bf16x8*)(vr + (lp + 8) * 8); };
    const int krow = (lkey & 32) | ((lkey & 4) << 2) | ((lkey & 24) >> 1) | (lkey & 3);
    auto tile_store = [&](int b, const bf16x8 (&k_)[2], const bf16x8 (&v_)[2]) {
        LAS unsigned char* kb_ = lds + b * ABUF; LAS unsigned char* vb_ = kb_ + VT_OFF;
        *(LAS bf16x8*)(kb_ + krow * 272 + lp * 16) = k_[0]; *(LAS bf16x8*)(kb_ + krow * 272 + (lp + 8) * 16) = k_[1];
        *(LAS bf16x8*)(vb_ + lkey * 288 + lp * 16) = v_[0]; *(LAS bf16x8*)(vb_ + lkey * 288 + (lp + 8) * 16) = v_[1]; };
    tile_load(0, rk[0], rv[0]);
    tile_load(1, rk[1], rv[1]);
    __syncthreads();
    tile_store(0, rk[0], rv[0]);
    tile_load(2, rk[0], rv[0]);
#pragma unroll 2
    for (int ti = 0; ti < ntiles; ++ti) {
        const bool win = ti < nwt; const int k0 = win ? wlo + ti * 64 : (ti - nwt) * 64;
        __syncthreads();
        if ((ti & 1) == 0) { if (ti + 1 < ntiles) tile_store(1, rk[1], rv[1]); if (ti + 3 < ntiles) tile_load(ti + 3, rk[1], rv[1]); }
        else { if (ti + 1 < ntiles) tile_store(0, rk[0], rv[0]); if (ti + 3 < ntiles) tile_load(ti + 3, rk[0], rv[0]); }
        LAS unsigned char* kb_ = lds + (ti & 1) * ABUF; LAS unsigned char* vb_ = kb_ + VT_OFF;
        f32x4 s[4];
#pragma unroll
        for (int nt = 0; nt < 4; ++nt) { s[nt] = (f32x4){0.f, 0.f, 0.f, 0.f};
#pragma unroll
            for (int kk = 0; kk < 4; ++kk) { const bf16x8 a = *(const LAS bf16x8*)(kb_ + (nt * 16 + fr) * 272 + kk * 64 + fq * 16); s[nt] = __builtin_amdgcn_mfma_f32_16x16x32_bf16(a, qf[kk], s[nt], 0, 0, 0); } }
        float mt = -3.0e38f;
#pragma unroll
        for (int nt = 0; nt < 4; ++nt)
#pragma unroll
            for (int j = 0; j < 4; ++j) { float v = s[nt][j] * scale;
                if (lat && win) { const int kp = k0 + 32 * (nt >> 1) + 8 * fq + 4 * (nt & 1) + j; const int dd = qpos - kp; if (dd > 128 || dd < -128) v = -1.0e30f; }
                s[nt][j] = v; mt = fmaxf(mt, v); }
        mt = fmaxf(mt, __shfl_xor(mt, 16)); mt = fmaxf(mt, __shfl_xor(mt, 32));
        const float mn = fmaxf(m_run, mt); const float alpha = __builtin_amdgcn_exp2f(m_run - mn); m_run = mn;
        float ps = 0.f;
#pragma unroll
        for (int nt = 0; nt < 4; ++nt)
#pragma unroll
            for (int j = 0; j < 4; ++j) { const float p = __builtin_amdgcn_exp2f(s[nt][j] - mn); ps += p; s[nt][j] = p; }
        l_run = l_run * alpha + ps;
#pragma unroll
        for (int dt = 0; dt < 8; ++dt) o[dt] = o[dt] * alpha;
#pragma unroll
        for (int s2 = 0; s2 < 2; ++s2) {
            u32x4 pu; pu[0] = pack2(s[2 * s2][0], s[2 * s2][1]); pu[1] = pack2(s[2 * s2][2], s[2 * s2][3]); pu[2] = pack2(s[2 * s2 + 1][0], s[2 * s2 + 1][1]); pu[3] = pack2(s[2 * s2 + 1][2], s[2 * s2 + 1][3]);
            const bf16x8 pf = __builtin_bit_cast(bf16x8, pu);
#pragma unroll
            for (int dt = 0; dt < 8; ++dt) {
                const bf16x4 lo = __builtin_amdgcn_ds_read_tr16_b64_v4i16((LAS bf16x4*)(vb_ + (s2 * 32 + fq * 8 + (fr >> 2)) * 288 + (dt * 16 + (fr & 3) * 4) * 2));
                const bf16x4 hi = __builtin_amdgcn_ds_read_tr16_b64_v4i16((LAS bf16x4*)(vb_ + (s2 * 32 + fq * 8 + 4 + (fr >> 2)) * 288 + (dt * 16 + (fr & 3) * 4) * 2));
                const bf16x8 af = __builtin_shufflevector(lo, hi, 0, 1, 2, 3, 4, 5, 6, 7);
                o[dt] = __builtin_amdgcn_mfma_f32_16x16x32_bf16(af, pf, o[dt], 0, 0, 0);
            }
        }
    }
    float lt = l_run; lt += __shfl_xor(lt, 16); lt += __shfl_xor(lt, 32);
    const float inv = 1.0f / lt;
    bf16_t* yp = YB + (size_t)(row0 + qpos) * 1024 + head * 128 + fq * 4;
#pragma unroll
    for (int dt = 0; dt < 8; ++dt) { uint2 pk; pk.x = pack2(o[dt][0] * inv, o[dt][1] * inv); pk.y = pack2(o[dt][2] * inv, o[dt][3] * inv); *(uint2*)(yp + dt * 16) = pk; }
}

constexpr int YT_OFF = 256 * 272;
template <int MODE, int D, int NSC>
__device__ __forceinline__ void lru_dir(const Params& P, int l, int s, int cchunk, int h, LAS unsigned char* lds, int w, int fr, int fq) {
    const bool lat = s >= 32; const int row0 = lat ? MCTX + (s - 32) * 2048 : s * 256; const int t0 = cchunk * (NSC * 64);
    constexpr int NCH = 2048 / (NSC * 64);
    const bf16_t* GW = (const bf16_t*)(P.ws + OFF_GW);
    bf16_t* YA = (bf16_t*)(P.ws + OFF_YA);
    float* SUMM = (float*)(P.ws + OFF_SUMM);
    const int chl = 16 * w + fr, ch = h * 128 + chl;
    bf16x8 bwa[4], bwx[4];
    { const bf16_t* gp = GW + ((size_t)(D * 8 + h) * 256 + chl) * 128 + fq * 8;
#pragma unroll
      for (int kk = 0; kk < 4; ++kk) { bwa[kk] = *(const bf16x8*)(gp + kk * 32); bwx[kk] = *(const bf16x8*)(gp + 128 * 128 + kk * 32); } }
    const int pidx = (l * 2 + D) * 1024 + ch;
    const float ba = P.lru_ba[pidx], bx = P.lru_bx[pidx];
    const float lam = P.lru_lambda[pidx];
    const float c8 = -8.0f * log1pf(expf(-lam));
    float carry = 0.f;
    if (MODE == 0 && lat) {
        const int b = s - 32;
        carry = P.state_lru[((size_t)(b * 2 + l) * 2 + D) * 1024 + ch];
        if (D == 0) { for (int cc = 0; cc < cchunk; ++cc) { const float* sp = SUMM + ((size_t)((b * 2 + 0) * 16 + cc) * 1024 + ch) * 2; carry = sp[1] + sp[0] * carry; } }
        else { for (int cc = NCH - 1; cc > cchunk; --cc) { const float* sp = SUMM + ((size_t)((b * 2 + 1) * 16 + cc) * 1024 + ch) * 2; carry = sp[1] + sp[0] * carry; } }
    }
    float ptot = 1.0f;
#pragma unroll 1
    for (int sci = 0; sci < NSC; ++sci) {
        const int sc = D == 0 ? sci : NSC - 1 - sci;
        f32x4 r[4], g[4];
#pragma unroll
        for (int m = 0; m < 4; ++m) { r[m] = (f32x4){0.f, 0.f, 0.f, 0.f}; g[m] = (f32x4){0.f, 0.f, 0.f, 0.f};
#pragma unroll
            for (int kk = 0; kk < 4; ++kk) { const bf16x8 a = *(const LAS bf16x8*)(lds + (sc * 64 + m * 16 + fr) * 272 + kk * 64 + fq * 16);
                r[m] = __builtin_amdgcn_mfma_f32_16x16x32_bf16(a, bwa[kk], r[m], 0, 0, 0); g[m] = __builtin_amdgcn_mfma_f32_16x16x32_bf16(a, bwx[kk], g[m], 0, 0, 0); } }
#pragma unroll
        for (int mi = 0; mi < 4; ++mi) {
            const int m = D == 0 ? mi : 3 - mi;
            float av[4], bv[4];
#pragma unroll
            for (int j = 0; j < 4; ++j) {
                const float ea = 1.0f + __expf(-(r[m][j] + ba)), eb = 1.0f + __expf(-(g[m][j] + bx));
                const float inv = __builtin_amdgcn_rcpf(ea * eb);
                const float rr = inv * eb, ii = inv * ea;
                const float la = c8 * rr; const float a = __expf(la); const float z = 2.0f * la;
                const float em = (z > -0.05f) ? -z * (1.0f + z * (0.5f + z * (0.16666667f + z * 0.041666667f))) : 1.0f - a * a;
                const float x = bf2f(*(const LAS bf16_t*)(lds + (sc * 64 + m * 16 + fq * 4 + j) * 272 + chl * 2));
                av[j] = a; bv[j] = __builtin_amdgcn_sqrtf(em) * ii * x;
            }
            float p4, h4;
            p4 = av[0] * av[1] * av[2] * av[3];
            if (D == 0) h4 = ((bv[0] * av[1] + bv[1]) * av[2] + bv[2]) * av[3] + bv[3];
            else h4 = ((bv[3] * av[2] + bv[2]) * av[1] + bv[1]) * av[0] + bv[0];
            float pq[4], hq[4];
#pragma unroll
            for (int f = 0; f < 4; ++f) { pq[f] = __shfl(p4, fr + 16 * f); hq[f] = __shfl(h4, fr + 16 * f); }
            float cin = carry, mycin = 0.f;
#pragma unroll
            for (int fi = 0; fi < 4; ++fi) { const int f = D == 0 ? fi : 3 - fi; if (f == fq) mycin = cin; cin = hq[f] + pq[f] * cin; }
            carry = cin;
            if (MODE == 1) ptot *= pq[0] * pq[1] * pq[2] * pq[3];
            if (MODE == 0) {
                float hh = mycin; float y[4];
#pragma unroll
                for (int ji = 0; ji < 4; ++ji) { const int j = D == 0 ? ji : 3 - ji; hh = av[j] * hh + bv[j]; y[j] = hh; }
#pragma unroll
                for (int j = 0; j < 4; ++j) {
                    LAS bf16_t* yp = (LAS bf16_t*)(lds + YT_OFF + (sc * 64 + m * 16 + fq * 4 + j) * 272 + chl * 2);
                    if (D == 0) *yp = f2bf(y[j]);
                    else *yp = f2bf(bf2f(*yp) + y[j]);
                }
            }
        }
    }
    if (MODE == 0 && !lat && fq == 0) P.out[OUT_H + ((size_t)(s * 2 + l) * 2 + D) * 1024 + ch] = carry;
    if (MODE == 1 && fq == 0) { float* sp = SUMM + ((size_t)(((s - 32) * 2 + D) * 16 + cchunk) * 1024 + ch) * 2; sp[0] = ptot; sp[1] = carry; }
}
template <int MODE, int NSC>
__device__ void lru_unit(const Params& P, int l, int s, int cchunk, int h, LAS unsigned char* lds) {
    int tid_ = threadIdx.x; asm volatile("" : "+v"(tid_));
    const int tid = tid_, w = tid >> 6, lane = tid & 63, fr = lane & 15, fq = lane >> 4;
    const bool lat = s >= 32; const int T = lat ? 2048 : 256; const int row0 = lat ? MCTX + (s - 32) * 2048 : s * 256; const int t0 = cchunk * (NSC * 64);
    const bf16_t* XA = (const bf16_t*)(P.ws + OFF_XAQ);
    constexpr int RUN = NSC * 2;
    {
        const int ck = tid & 15, ch = h * 128 + ck * 8, tr = (tid >> 4) * RUN;
        const float* cw = P.lru_conv + (size_t)l * 4096 + ch; const float* cb = P.lru_conv_b + l * 1024 + ch;
        bf16x8 xr[RUN + 3];
#pragma unroll
        for (int i = 0; i < RUN + 3; ++i) { const int tt = t0 + tr + i - 2; xr[i] = (bf16x8){0, 0, 0, 0, 0, 0, 0, 0};
            if (tt >= 0 && tt < T) xr[i] = *(const bf16x8*)(XA + (size_t)(row0 + tt) * 1024 + ch); }
        float wk[4][8], bk[8];
#pragma unroll
        for (int e = 0; e < 8; ++e) { bk[e] = cb[e];
#pragma unroll
            for (int k = 0; k < 4; ++k) wk[k][e] = cw[k * 1024 + e]; }
        __syncthreads();
#pragma unroll
        for (int i = 0; i < RUN; ++i) {
            float a8[8];
#pragma unroll
            for (int e = 0; e < 8; ++e) { a8[e] = bk[e];
#pragma unroll
                for (int k = 0; k < 4; ++k) a8[e] += wk[k][e] * bf2f((unsigned short)xr[i + k][e]); }
            u32x4 o; o.x = pack2(a8[0], a8[1]); o.y = pack2(a8[2], a8[3]); o.z = pack2(a8[4], a8[5]); o.w = pack2(a8[6], a8[7]);
            *(LAS u32x4*)(lds + (tr + i) * 272 + ck * 16) = o;
        }
    }
    __syncthreads();
    lru_dir<MODE, 0, NSC>(P, l, s, cchunk, h, lds, w, fr, fq);
    lru_dir<MODE, 1, NSC>(P, l, s, cchunk, h, lds, w, fr, fq);
    if (MODE == 0) {
        bf16_t* YA = (bf16_t*)(P.ws + OFF_YA);
        __syncthreads();
#pragma unroll
        for (int it = 0; it < 2 * NSC; ++it) { const int t = (tid >> 4) + it * 32, ck = tid & 15;
            const u32x4 v = *(const LAS u32x4*)(lds + YT_OFF + t * 272 + ck * 16);
            *(u32x4*)(YA + (size_t)(row0 + t0 + t) * 1024 + h * 128 + ck * 8) = v; }
    }
}

#define XB_TMO      128
#define XB_XCNT(j)  (256  + 64 * (j))
#define XB_XSUB(j)  (1280 + 64 * (j))
#define XB_XGEN(j)  (2304 + 64 * (j))
#define XB_TOP      3328
#define XB_TOPGEN   3392
#define XCD_BAR_WORDS 3456
#define XB_SPIN_CAP (1u << 18)
__device__ __forceinline__ unsigned xb_ld(unsigned* p)              { return __hip_atomic_load(p, __ATOMIC_RELAXED, __HIP_MEMORY_SCOPE_AGENT); }
__device__ __forceinline__ unsigned xb_add(unsigned* p, unsigned v) { return __hip_atomic_fetch_add(p, v, __ATOMIC_RELAXED, __HIP_MEMORY_SCOPE_AGENT); }
__device__ __forceinline__ unsigned xb_xcc_id() { return (unsigned)__builtin_amdgcn_s_getreg((3 << 11) | 20) & 0xFu; }
#define XB_SPIN(cond, bar) do { unsigned _sp = 0; while (cond) { __builtin_amdgcn_s_sleep(1); \
    if ((++_sp & 255u) == 0u) { if (xb_ld(&(bar)[XB_TMO])) break; if (_sp > XB_SPIN_CAP) { atomicAdd(&(bar)[XB_TMO], 1u); break; } } } } while (0)
struct XcdBarrier { unsigned* bar; unsigned x; volatile LAS unsigned* st; };
__device__ __forceinline__ XcdBarrier xcd_barrier_post(unsigned* bar, volatile LAS unsigned* st) {
    XcdBarrier b; b.bar = bar; b.x = xb_xcc_id(); b.st = st;
    if (threadIdx.x == 0) (void)xb_add(&bar[XB_XCNT(b.x)], 1u);
    return b;
}
__device__ __forceinline__ void xcd_barrier_complete(unsigned* bar, unsigned x, unsigned& nloc, unsigned& nx) {
    const unsigned G = gridDim.x * gridDim.y * gridDim.z;
    unsigned sum, cnt, mine, sp = 0u;
    for (;;) {
        sum = 0u; cnt = 0u; mine = 0u;
#pragma unroll
        for (unsigned j = 0; j < 16; ++j) { const unsigned c = xb_ld(&bar[XB_XCNT(j)]); sum += c; cnt += (c > 0u) ? 1u : 0u; mine = (j == x) ? c : mine; }
        if (sum == G) break;
        __builtin_amdgcn_s_sleep(1);
        if ((++sp & 255u) == 0u) { if (xb_ld(&bar[XB_TMO])) break; if (sp > XB_SPIN_CAP) { atomicAdd(&bar[XB_TMO], 1u); break; } }
    }
    nloc = mine > 0u ? mine : 1u; nx = cnt > 0u ? cnt : 1u;
}
__device__ __noinline__ void xcd_barrier_(unsigned* bbar, unsigned bx, volatile LAS unsigned* bst) {
    XcdBarrier b; b.bar = bbar; b.x = bx; b.st = bst;
    asm volatile("s_waitcnt vmcnt(0)" ::: "memory");
    __syncthreads();
    if (threadIdx.x == 0) {
        unsigned* bar = b.bar;
        __builtin_amdgcn_s_waitcnt(0);
        unsigned nloc = b.st[0], nx = b.st[1];
        if (nloc == 0u) { xcd_barrier_complete(bar, b.x, nloc, nx); b.st[0] = nloc; b.st[1] = nx; }
        const unsigned old = xb_add(&bar[XB_XSUB(b.x)], 1u);
        const unsigned gen = old / nloc;
        if (old + 1u == (gen + 1u) * nloc) {
            __builtin_amdgcn_fence(__ATOMIC_RELEASE, "agent");
            asm volatile("s_waitcnt vmcnt(0)" ::: "memory");
            const unsigned og = xb_add(&bar[XB_TOP], 1u);
            const unsigned tg = og / nx;
            if (og + 1u == (tg + 1u) * nx) xb_add(&bar[XB_TOPGEN], 1u);
            else XB_SPIN(xb_ld(&bar[XB_TOPGEN]) == tg, bar);
            __builtin_amdgcn_fence(__ATOMIC_ACQUIRE, "agent");
            xb_add(&bar[XB_XGEN(b.x)], 1u);
            asm volatile("s_waitcnt vmcnt(0)" ::: "memory");
        } else {
            XB_SPIN(xb_ld(&bar[XB_XGEN(b.x)]) == gen, bar);
            __builtin_amdgcn_fence(__ATOMIC_ACQUIRE, "agent");
            asm volatile("s_waitcnt vmcnt(0)" ::: "memory");
        }
    }
    __syncthreads();
}

#ifndef REPMASK
#define REPMASK 0
#endif
#define REPLOOP(i) _Pragma("unroll 1") for (int rep_ = 0; rep_ < 1 + ((REPMASK >> (i)) & 1); ++rep_)
__global__ __launch_bounds__(512, 2) void mega(Params P) {
    extern __shared__ __attribute__((aligned(16))) unsigned char shm[];
    LAS unsigned char* lds = (LAS unsigned char*)shm;
    cg::grid_group grid = cg::this_grid();
    if (threadIdx.x == 0) *(LAS u32x4*)(lds + 147456) = (u32x4){0u, 0u, 0u, 0u};
    __syncthreads();
    const XcdBarrier xb = xcd_barrier_post((unsigned*)(P.ws + OFF_BAR), (volatile LAS unsigned*)(lds + 147456));
    const int G = gridDim.x, c = blockIdx.x;
    unsigned char* ws = P.ws;
    float* X = P.out;
    bf16_t* H = (bf16_t*)(ws + OFF_H);
    const float* MOD = (const float*)(ws + OFF_MOD);

    REPLOOP(12) phase0(P, lds);
    if (gridDim.x == 0x7fffffffu) grid.sync();
    REPLOOP(11) xcd_barrier_(xb.bar, xb.x, xb.st);
    for (int l = 0; l < 2; ++l) {
        const float* mod = MOD + (size_t)l * 3 * 6144;
        const bool hide = (G == 256);
        { const int te = hide ? (l == 0 ? 1856 : 0) : 4992; if (te > 0) convert_weights(P, l, lds, 0, te, c, G); }
        const float* xa0 = l == 0 ? P.x_prompt : X; const float* xb0 = l == 0 ? P.x_sample : X + (size_t)MCTX * 1024;
        REPLOOP(1) norm_phase(xa0, xb0, P.norm1 + l * 1024, mod, 0, 1024, H);
        REPLOOP(11) xcd_barrier_(xb.bar, xb.x, xb.st);
        REPLOOP(2) { Sched S{(const char*)H, (const char*)(ws + OFF_WIN), 1024, 1024, 0, 48, 14, G, c, 256};
          EpiIn E{(bf16_t*)(ws + OFF_XAQ), (bf16_t*)(ws + OFF_XC), (bf16_t*)(ws + OFF_KB), (bf16_t*)(ws + OFF_VB), P.out + OUT_K, P.out + OUT_V, (const float*)(ws + OFF_ROPE), l};
          gemm_phase(lds, S, 1024, E); }
        if (hide && l == 0 && c >= 160) convert_weights(P, l, lds, 1856, 2624, c - 160, G - 160);
        REPLOOP(11) xcd_barrier_(xb.bar, xb.x, xb.st);
        REPLOOP(3) pool_phase((const bf16_t*)(ws + OFF_XC), (bf16_t*)(ws + OFF_PL));
        for (int it = c; it < 1280; it += G) {
            if (it < 256) { REPLOOP(4) attn_unit(P, l, it, lds); }
            else if (it < 512) { const int v = it - 256; REPLOOP(5) lru_unit<0, 4>(P, l, v >> 3, 0, v & 7, lds); }
            else if (it < 768) { const int q = it - 512; REPLOOP(5) lru_unit<1, 2>(P, l, 32 + (q >> 7), (q >> 3) & 15, q & 7, lds); }
            else { REPLOOP(7) attn_unit(P, l, it - 768 + 256, lds); }
        }
        REPLOOP(11) xcd_barrier_(xb.bar, xb.x, xb.st);
        { Sched S{(const char*)(ws + OFF_PL), (const char*)(ws + OFF_PW), 1024, 256, 256, 48, 4, G, c, 256};
          EpiPool E{(bf16_t*)(ws + OFF_XC), P.pool_scale + l * 1024};
          gemm_phase(lds, S, 256, E); }
#ifndef NO_LRU
        for (int it = G - 1 - c; it < 256; it += G) lru_unit<0, 2>(P, l, 32 + (it >> 7), (it >> 3) & 15, it & 7, lds);
#endif
        REPLOOP(11) xcd_barrier_(xb.bar, xb.x, xb.st);
        REPLOOP(6) { MergeSched S{(const char*)ws, 1024, 1024, c};
          EpiMerge E{(bf16_t*)(ws + OFF_GT), P.b_gate + l * 3072, (float*)(ws + OFF_XAQ), (bf16_t*)(ws + OFF_PL)};
          gemm_phase(lds, S, 1024, E); }
        if (hide && c >= 192) convert_weights(P, l, lds, 2624, 4992, c - 192, G - 192);
        REPLOOP(11) xcd_barrier_(xb.bar, xb.x, xb.st);
        { Sched S{(const char*)(ws + OFF_PL), (const char*)(ws + OFF_WOUT), 1024, 1024, 0, 64, 4, G, c, 192};
          EpiRes E{X, mod, 2048, xa0, xb0};
          gemm_phase<EpiRes, Sched, true>(lds, S, 1024, E); }
        REPLOOP(11) xcd_barrier_(xb.bar, xb.x, xb.st);
        norm_phase(X, X + (size_t)MCTX * 1024, P.norm2 + l * 1024, mod, 3072, 4096, H);
        REPLOOP(11) xcd_barrier_(xb.bar, xb.x, xb.st);
        REPLOOP(9) { Sched S{(const char*)H, (const char*)(ws + OFF_WUP), 1024, 1024, 0, 48, 22, G, c, 256};
          EpiUp E{(bf16_t*)(ws + OFF_ACT), (bf16_t*)(ws + OFF_SU), (bf16_t*)(ws + OFF_SV), P.ffn_conv + (size_t)l * 3 * 2816, P.ffn_conv_b + l * 2816};
          gemm_phase(lds, S, 1024, E); }
        if (hide && l == 0 && c >= 32) convert_weights(P, l + 1, lds, 0, 2624, c - 32, G - 32);
        REPLOOP(11) xcd_barrier_(xb.bar, xb.x, xb.st);
        { Sched S{(const char*)(ws + OFF_ACT), (const char*)(ws + OFF_WDN), 2816, 2816, 0, 64, 4, G, c, 192};
          { Unit uu; for (int i = 0; S.next(i, uu); ++i) ffn_fix_groups((const bf16_t*)(ws + OFF_SU), (const bf16_t*)(ws + OFF_SV), (bf16_t*)(ws + OFF_ACT), P.ffn_conv + (size_t)l * 3 * 2816, P.ffn_conv_b + l * 2816, uu.row0 >> 6, 3);
            asm volatile("s_waitcnt vmcnt(0)" ::: "memory"); __syncthreads(); }
          EpiRes E{X, mod, 5120, X, X + (size_t)MCTX * 1024};
          gemm_phase<EpiRes, Sched, true>(lds, S, 2816, E); }
        REPLOOP(11) xcd_barrier_(xb.bar, xb.x, xb.st);
    }
    final_norm_phase(X, P.final_norm);
}

extern "C" void kernel_launch(void* const* d_in, const int* in_sizes, int n_in, void* d_out, int out_size, void* d_ws, size_t ws_size, hipStream_t stream) {
    constexpr size_t kDynLds = 147456 + 16;
    static int grid_blocks = 0;
    if (!grid_blocks) {
        int dev = 0, cus = 0, per_cu = 0;
        hipGetDevice(&dev);
        hipDeviceGetAttribute(&cus, hipDeviceAttributeMultiprocessorCount, dev);
        hipFuncSetAttribute((const void*)mega, hipFuncAttributeMaxDynamicSharedMemorySize, (int)kDynLds);
        hipOccupancyMaxActiveBlocksPerMultiprocessor(&per_cu, mega, 512, kDynLds);
        if (per_cu < 1) per_cu = 1;
        if (per_cu > 1) per_cu = 1;
        grid_blocks = cus * per_cu;
    }
    Params p{};
    const float** pp = (const float**)&p;
    for (int i = 0; i < 30; ++i) pp[i] = (const float*)d_in[i];
    p.out = (float*)d_out; p.ws = (unsigned char*)d_ws;
    if (ws_size < OFF_END2 + 262144) { fprintf(stderr, "workspace too small: %zu < %zu\n", ws_size, (size_t)OFF_END2 + 262144); }
    hipMemsetAsync((unsigned char*)d_ws + OFF_BAR, 0, 16384, stream);
    void* args[] = {&p};
    hipError_t e = hipLaunchCooperativeKernel((void*)mega, dim3(grid_blocks), dim3(512), args, kDynLds, stream);
    if (e != hipSuccess) fprintf(stderr, "cooperative launch failed: %s (grid %d)\n", hipGetErrorString(e), grid_blocks);
}
```

```cpp
#include <hip/hip_runtime.h>
#include <hip/hip_cooperative_groups.h>
#include <cstdio>
namespace cg = cooperative_groups;

#define LAS __attribute__((address_space(3)))
typedef unsigned short bf16_t;
typedef short bf16x8 __attribute__((ext_vector_type(8)));
typedef float f32x4 __attribute__((ext_vector_type(4)));
typedef unsigned u32x4 __attribute__((ext_vector_type(4)));
typedef unsigned u32x2 __attribute__((ext_vector_type(2)));
typedef short bf16x4 __attribute__((ext_vector_type(4)));

constexpr int MROWS = 12288, MCTX = 8192;
constexpr size_t S24 = (size_t)MROWS * 1024 * 2;
constexpr size_t OFF_WIN = 0;
constexpr size_t OFF_WBR = OFF_WIN + (size_t)6656 * 1024 * 2;
constexpr size_t OFF_WOUT = OFF_WBR + (size_t)3 * 1024 * 1024 * 2;
constexpr size_t OFF_WUP = OFF_WOUT + (size_t)1024 * 1024 * 2;
constexpr size_t OFF_WDN = OFF_WUP + (size_t)5632 * 1024 * 2;
constexpr size_t OFF_GW = OFF_WDN + (size_t)1024 * 2816 * 2;
constexpr size_t OFF_PW = OFF_GW + (size_t)2 * 8 * 256 * 128 * 2;
constexpr size_t OFF_MOD = OFF_PW + (size_t)4 * 256 * 256 * 2;
constexpr size_t OFF_CK = OFF_MOD + (size_t)2 * 3 * 6144 * 4;
constexpr size_t OFF_CV = OFF_CK + (size_t)2 * 2 * 512 * 256 * 2;
constexpr size_t OFF_ROPE = OFF_CV + (size_t)2 * 2 * 512 * 256 * 2;
constexpr size_t OFF_SUMM = OFF_ROPE + (size_t)2 * 64 * 32 * 4;
constexpr size_t OFF_BAR = OFF_SUMM + (size_t)2 * 2 * 16 * 1024 * 2 * 4;
constexpr size_t OFF_ACT0 = OFF_BAR + 16384;
constexpr size_t OFF_XAQ = OFF_ACT0;
constexpr size_t OFF_XC = OFF_XAQ + 2 * S24;
constexpr size_t OFF_KB = OFF_XC + S24;
constexpr size_t OFF_VB = OFF_KB + (size_t)MROWS * 256 * 2;
constexpr size_t OFF_GT = OFF_VB + (size_t)MROWS * 256 * 2;
constexpr size_t OFF_YB = OFF_GT + S24;
constexpr size_t OFF_PL = OFF_YB + S24;
constexpr size_t OFF_YA = OFF_PL + S24;
constexpr size_t OFF_H = OFF_YA + S24;
constexpr size_t OFF_END = OFF_H + S24;
constexpr size_t OFF_ACT = OFF_XAQ;
constexpr size_t OFF_SU = OFF_END;
constexpr size_t OFF_SV = OFF_SU + (size_t)192 * 4 * 2816 * 2;
constexpr size_t OFF_END2 = OFF_SV + (size_t)192 * 2 * 2816 * 2;
constexpr size_t OUT_K = (size_t)MROWS * 1024;
constexpr size_t OUT_V = OUT_K + (size_t)32 * 2 * 256 * 256;
constexpr size_t OUT_H = OUT_V + (size_t)32 * 2 * 256 * 256;

struct Params {
    const float *x_prompt, *x_sample, *cache_k, *cache_v, *state_lru, *c, *c_ctx, *w_ada, *b_ada, *norm1, *norm2,
        *w_in, *b_gate, *lru_conv, *lru_conv_b, *lru_wa, *lru_ba, *lru_wx, *lru_bx, *lru_lambda, *attn_sink,
        *pool_w, *pool_scale, *w_branch, *w_out, *ffn_up, *ffn_conv, *ffn_conv_b, *ffn_down, *final_norm;
    float* out; unsigned char* ws;
};

typedef float f32x2_ __attribute__((ext_vector_type(2)));
typedef __bf16 bf16x2_ __attribute__((ext_vector_type(2)));
__device__ __forceinline__ unsigned pack2(float a, float b) { const f32x2_ v = {a, b}; const bf16x2_ r = __builtin_convertvector(v, bf16x2_); return __builtin_bit_cast(unsigned, r); }
__device__ __forceinline__ unsigned short f2bf(float f) { return (unsigned short)(pack2(f, f) & 0xffffu); }
__device__ __forceinline__ float bf2f(unsigned short b) { return __uint_as_float(((unsigned)b) << 16); }
__device__ __forceinline__ int otid() { int t = threadIdx.x; asm volatile("" : "+v"(t)); return t; }
__device__ __forceinline__ float sigmoidf_(float x) { return __builtin_amdgcn_rcpf(1.0f + __expf(-x)); }

constexpr int HTB = 128 * 64 * 2;
__device__ __forceinline__ int lds_byte(int r, int c) { const int st = (r >> 4) * 2 + (c >> 5), rr = r & 15, cc = c & 31, ob = rr * 64 + cc * 2; return st * 1024 + (ob ^ (((ob >> 9) & 1) << 5)); }
__device__ __forceinline__ void stage_rc(int b, int& R, int& C) { const int st = b / 1024, sb = b % 1024, swz = sb ^ (((sb >> 9) & 1) << 5); R = (st >> 1) * 16 + swz / 64; C = (st & 1) * 32 + (swz % 64) / 2; }

struct Unit { const char* a; const char* b; int pm, pn, z, row0, m192; };
struct Sched {
    const char* A; const char* B; int lda, ldb, acol, nM, nN, G, c, tm;
    __device__ __forceinline__ bool next(int i, Unit& u) const {
        const long L = (long)i * G + c; const int nwg = nM * nN; if (L >= nwg) return false;
        int wgid = (int)L; { const int q = nwg / 8, r = nwg % 8, xcd = wgid % 8, off = wgid / 8; wgid = (xcd < r ? xcd * (q + 1) : r * (q + 1) + (xcd - r) * q) + off; }
        const int nig = 8 * nN, gid = wgid / nig, fm = gid * 8, gsz = (nM - fm) < 8 ? (nM - fm) : 8;
        u.pm = fm + ((wgid % nig) % gsz); u.pn = (wgid % nig) / gsz;
        u.a = A + ((size_t)u.pm * tm * lda + (size_t)u.pn * acol) * 2; u.b = B + (size_t)u.pn * 256 * ldb * 2; u.z = 0; u.row0 = u.pm * tm; u.m192 = (tm == 192); return true;
    }
};
struct MergeSched {
    const char* ws; int lda, ldb, c; bool helper;
    __device__ __forceinline__ bool next(int i, Unit& u) const {
        int owner, z; int c = this->c; asm volatile("" : "+s"(c));
        if (!helper) { if (c >= 192 || i >= 5) return false; owner = c; z = i < 4 ? i : 5; }
        else { const int hi = c - 192; if (hi < 0 || hi >= 64 || i >= 3) return false; owner = hi + 64 * i; z = 4; }
        const int nN = 4;
        int wgid = owner; { const int q = 24, xcd = wgid % 8, off = wgid / 8; wgid = xcd * q + off; }
        const int nig = 8 * nN, gid = wgid / nig, fm = gid * 8;
        u.pm = fm + ((wgid % nig) % 8); u.pn = (wgid % nig) / 8; u.z = z; u.row0 = u.pm * 256; u.m192 = 0;
        const int j = z >> 1;
        const size_t aoff = (size_t)u.row0 * 1024 * 2;
        size_t ao = OFF_H, bo = OFF_WIN + (size_t)3584 * 1024 * 2;
        if (z & 1) { bo = OFF_WBR; ao = OFF_YA; if (j == 1) ao = OFF_YB; if (j == 2) ao = OFF_XC; }
        u.a = ws + ao + aoff; u.b = ws + bo + ((size_t)j * 1024 + (size_t)u.pn * 256) * 1024 * 2;
        return true;
    }
};

template <class Epi, class SchedT, bool M192 = false>
__device__ __forceinline__ void gemm_phase(LAS unsigned char* lds, const SchedT& S, const int K_, const Epi& E) {
    int K = K_; asm volatile("" : "+s"(K));
    int tid_ = threadIdx.x; asm volatile("" : "+v"(tid_));
    const int tid = tid_, wid = __builtin_amdgcn_readfirstlane(tid >> 6), lane = tid & 63, wr = wid >> 2, wc = wid & 3, fr = lane & 15, fq = lane >> 4;
    const int nt = K / 64;
    unsigned voffA[2], voffB[2];
#pragma unroll
    for (int i = 0; i < 2; ++i) { int R, C; stage_rc(tid * 16 + i * 8192, R, C); voffA[i] = (unsigned)(R * S.lda + C) * 2u; voffB[i] = (unsigned)(R * S.ldb + C) * 2u; }
    const size_t kstep = 128;
    const size_t hstepA = (size_t)128 * S.lda * 2, hstepB = (size_t)128 * S.ldb * 2;
    const unsigned ldsw = (unsigned)wid * 1024u;
    const int aoff = lds_byte(wr * 64 + fr, fq * 8), boff = lds_byte(wc * 32 + fr, fq * 8);
#define G_SA(b, h) (((b) * 2 + (h)) * HTB)
#define G_SB(b, h) ((4 + (b) * 2 + (h)) * HTB)
#define G_STAGE(bufoff, gbase, voff) do { _Pragma("unroll") for (int _i = 0; _i < 2; ++_i) \
        __builtin_amdgcn_global_load_lds((const unsigned*)((const char*)(gbase) + (voff)[_i]), (LAS unsigned*)(lds + (bufoff) + ldsw + _i * 8192), 16, 0, 0); } while (0)
#define G_LDA(dst, b, h) do { _Pragma("unroll") for (int m = 0; m < 4; ++m) _Pragma("unroll") for (int k = 0; k < 2; ++k) dst[m][k] = *(const LAS bf16x8*)(lds + G_SA(b, h) + aoff + m * 2048 + k * 1024); } while (0)
#define G_LDB(dst, b, h) do { _Pragma("unroll") for (int n = 0; n < 2; ++n) _Pragma("unroll") for (int k = 0; k < 2; ++k) dst[n][k] = *(const LAS bf16x8*)(lds + G_SB(b, h) + boff + n * 2048 + k * 1024); } while (0)
#define G_MMA(ai, bj, At, Bt) do { if (M192 && (ai) == 1 && wr == 1) break; __builtin_amdgcn_s_setprio(1); _Pragma("unroll") for (int m = 0; m < 4; ++m) _Pragma("unroll") for (int n = 0; n < 2; ++n) _Pragma("unroll") for (int k = 0; k < 2; ++k) \
        acc[ai][bj][m][n] = __builtin_amdgcn_mfma_f32_16x16x32_bf16(Bt[n][k], At[m][k], acc[ai][bj][m][n], 0, 0, 0); __builtin_amdgcn_s_setprio(0); } while (0)
#define G_WAIT_V(n) asm volatile("s_waitcnt vmcnt(" #n ")" ::: "memory")
#define G_WAIT_L(n) asm volatile("s_waitcnt lgkmcnt(" #n ")" ::: "memory")
#define G_BAR __builtin_amdgcn_s_barrier()
#define G_SCHED __builtin_amdgcn_sched_barrier(0)
    Unit cur, nxt; int ui = 0;
    if (!S.next(0, cur)) return;
    f32x4 acc[2][2][4][2];
#pragma unroll
    for (int a = 0; a < 2; ++a)
#pragma unroll
        for (int b = 0; b < 2; ++b)
#pragma unroll
            for (int m = 0; m < 4; ++m)
#pragma unroll
                for (int n = 0; n < 2; ++n) acc[a][b][m][n] = (f32x4){0.f, 0.f, 0.f, 0.f};
    bf16x8 At[4][2], B0[2][2], B1[2][2];
    const char* cA = cur.a; const char* cB = cur.b;
    G_STAGE(G_SB(0, 0), cB, voffB); G_STAGE(G_SA(0, 0), cA, voffA); G_STAGE(G_SB(0, 1), cB + hstepB, voffB); G_STAGE(G_SA(0, 1), cA + hstepA, voffA);
    if (wr == 1) G_BAR;
    G_WAIT_V(4); G_BAR;
    G_STAGE(G_SB(1, 0), cB + kstep, voffB); G_STAGE(G_SA(1, 0), cA + kstep, voffA); G_STAGE(G_SB(1, 1), cB + hstepB + kstep, voffB);
    G_WAIT_V(6); G_BAR;
    for (;;) {
        const bool has_next = S.next(ui + 1, nxt);
        const char* nA = has_next ? nxt.a : cA; const char* nB = has_next ? nxt.b : cB;
        for (int t = 0; t < nt; t += 2) {
            const bool last = (t == nt - 2);
            const char* a1 = cA + (size_t)(t + 1) * kstep;
            const char* a2 = last ? nA : cA + (size_t)(t + 2) * kstep; const char* b2 = last ? nB : cB + (size_t)(t + 2) * kstep;
            const char* a3 = a2 + kstep; const char* b3 = b2 + kstep;
            G_LDB(B0, 0, 0); G_SCHED; G_LDA(At, 0, 0); G_STAGE(G_SA(1, 1), a1 + hstepA, voffA);
            G_WAIT_L(8); G_BAR; G_WAIT_L(0); G_MMA(0, 0, At, B0); G_BAR; G_SCHED;
            G_LDB(B1, 0, 1); G_STAGE(G_SB(0, 0), b2, voffB);
            G_BAR; G_WAIT_L(0); G_MMA(0, 1, At, B1); G_BAR;
            G_LDA(At, 0, 1); G_STAGE(G_SA(0, 0), a2, voffA);
            G_BAR; G_WAIT_L(0); G_MMA(1, 0, At, B0); G_BAR; G_SCHED;
            G_STAGE(G_SB(0, 1), b2 + hstepB, voffB);
            G_WAIT_V(6); G_BAR; G_MMA(1, 1, At, B1); G_BAR;
            G_LDB(B0, 1, 0); G_SCHED; G_LDA(At, 1, 0); G_STAGE(G_SA(0, 1), a2 + hstepA, voffA);
            G_WAIT_L(8); G_BAR; G_WAIT_L(0); G_MMA(0, 0, At, B0); G_BAR; G_SCHED;
            G_LDB(B1, 1, 1); G_STAGE(G_SB(1, 0), b3, voffB);
            G_BAR; G_WAIT_L(0); G_MMA(0, 1, At, B1); G_BAR;
            G_LDA(At, 1, 1); G_STAGE(G_SA(1, 0), a3, voffA);
            G_BAR; G_WAIT_L(0); G_MMA(1, 0, At, B0); G_BAR; G_SCHED;
            G_STAGE(G_SB(1, 1), b3 + hstepB, voffB);
            G_WAIT_V(6); G_BAR; G_MMA(1, 1, At, B1); G_BAR;
        }
        E(acc, cur, wr, wc, fr, fq);
        if (!has_next) break;
#pragma unroll
        for (int a = 0; a < 2; ++a)
#pragma unroll
            for (int b = 0; b < 2; ++b)
#pragma unroll
                for (int m = 0; m < 4; ++m)
#pragma unroll
                    for (int n = 0; n < 2; ++n) acc[a][b][m][n] = (f32x4){0.f, 0.f, 0.f, 0.f};
        cur = nxt; cA = nA; cB = nB; ++ui;
    }
    G_WAIT_V(0);
    if (wr == 0) G_BAR;
    G_BAR;
#undef G_SA
#undef G_SB
#undef G_STAGE
#undef G_LDA
#undef G_LDB
#undef G_MMA
#undef G_WAIT_V
#undef G_WAIT_L
#undef G_BAR
#undef G_SCHED
}

#define EPI_LOOP_BEGIN \
    _Pragma("unroll") for (int ai = 0; ai < 2; ++ai) _Pragma("unroll") for (int m = 0; m < 4; ++m) { const int row = u.pm * 256 + wr * 64 + fr + ai * 128 + m * 16; \
    _Pragma("unroll") for (int bj = 0; bj < 2; ++bj) _Pragma("unroll") for (int n = 0; n < 2; ++n) { const int cl = wc * 32 + 4 * fq + bj * 128 + n * 16; const f32x4 v = acc[ai][bj][m][n];
#define EPI_LOOP_END } }

__device__ __forceinline__ int seq_group(int row) { return row < MCTX ? 0 : 1 + ((row - MCTX) >> 11); }

struct EpiIn {
    bf16_t* xaq; bf16_t* xc; bf16_t* kb; bf16_t* vb; float* outk; float* outv; const float* rc; int l;
    __device__ __forceinline__ void operator()(const f32x4 (&acc)[2][2][4][2], const Unit& u, int wr, int wc, int fr, int fq) const {
        const int pn = u.pn; const bool qk = pn >= 4 && pn <= 8;
        bf16_t* dst; int ld, cbase; float* fo = nullptr;
        if (pn < 4) { dst = xaq; ld = 1024; cbase = pn * 256; }
        else if (pn < 8) { dst = xaq + (size_t)MROWS * 1024; ld = 1024; cbase = pn * 256 - 1024; }
        else if (pn == 8) { dst = kb; ld = 256; cbase = 0; fo = outk; }
        else if (pn == 9) { dst = vb; ld = 256; cbase = 0; fo = outv; }
        else { dst = xc; ld = 1024; cbase = pn * 256 - 2560; }
        const int hh = wc >> 1, i0 = 16 * (wc & 1) + 4 * fq;
        const int c1 = cbase + (qk ? 64 * hh + i0 : wc * 32 + 4 * fq), dc = qk ? 32 : 16;
        const bool rope = qk && u.pm >= 32;
#pragma unroll
        for (int ai = 0; ai < 2; ++ai) {
            f32x4 csm[4], snm[4];
#pragma unroll
            for (int m = 0; m < 4; ++m) { csm[m] = (f32x4){1.f, 1.f, 1.f, 1.f}; snm[m] = (f32x4){0.f, 0.f, 0.f, 0.f};
                if (rope) { const int row = u.pm * 256 + wr * 64 + fr + ai * 128 + m * 16; const int t = (row - MCTX) & 2047; const int pos = hh == 0 ? (t >> 6) : (t & 63);
                    csm[m] = *(const f32x4*)(rc + pos * 32 + i0); snm[m] = *(const f32x4*)(rc + 2048 + pos * 32 + i0); } }
#pragma unroll
            for (int m = 0; m < 4; ++m) {
                const int row = u.pm * 256 + wr * 64 + fr + ai * 128 + m * 16;
                const f32x4 cs = csm[m], sn = snm[m];
                bf16_t* dp = dst + (size_t)row * ld + c1;
                float* fp = fo + ((size_t)(((row >> 8) * 2 + l) * 256 + (row & 255))) * 256 + c1;
#pragma unroll
                for (int bj = 0; bj < 2; ++bj) {
                    const f32x4 x1 = acc[ai][bj][m][0], x2 = acc[ai][bj][m][1];
                    const f32x4 o1 = x1 * cs - x2 * sn, o2 = x1 * sn + x2 * cs;
                    uint2 p1, p2; p1.x = pack2(o1[0], o1[1]); p1.y = pack2(o1[2], o1[3]); p2.x = pack2(o2[0], o2[1]); p2.y = pack2(o2[2], o2[3]);
                    *(uint2*)(dp + bj * 128) = p1; *(uint2*)(dp + bj * 128 + dc) = p2;
                    if (fo != nullptr && row < MCTX) { *(f32x4*)(fp + bj * 128) = o1; *(f32x4*)(fp + bj * 128 + dc) = o2; }
                }
            }
        }
    }
};
struct EpiGate {
    bf16_t* gt; const float* bias;
    __device__ __forceinline__ void operator()(const f32x4 (&acc)[2][2][4][2], const Unit& u, int wr, int wc, int fr, int fq) const {
        const int c0 = u.pn * 256 + wc * 32 + 4 * fq;
        f32x4 bb[4];
#pragma unroll
        for (int g = 0; g < 4; ++g) bb[g] = *(const f32x4*)(bias + c0 + (g >> 1) * 128 + (g & 1) * 16);
#pragma unroll
        for (int ai = 0; ai < 2; ++ai) { if (ai == 1 && u.m192 && wr == 1) continue;
#pragma unroll
            for (int m = 0; m < 4; ++m) { const int row = u.row0 + wr * 64 + fr + ai * 128 + m * 16;
#pragma unroll
                for (int g = 0; g < 4; ++g) { const f32x4 v = acc[ai][g >> 1][m][g & 1];
                    uint2 pk; pk.x = pack2(sigmoidf_(v[0] + bb[g][0]), sigmoidf_(v[1] + bb[g][1])); pk.y = pack2(sigmoidf_(v[2] + bb[g][2]), sigmoidf_(v[3] + bb[g][3]));
                    *(uint2*)(gt + (size_t)row * 1024 + c0 + (g >> 1) * 128 + (g & 1) * 16) = pk; } } }
    }
};
template <int j> struct EpiBranch {
    const bf16_t* gt; float* tmp; bf16_t* mg;
    __device__ __forceinline__ void operator()(const f32x4 (&acc)[2][2][4][2], const Unit& u, int wr, int wc, int fr, int fq) const {
        const int c0 = u.pn * 256 + wc * 32 + 4 * fq;
#pragma unroll
        for (int ai = 0; ai < 2; ++ai) { if (ai == 1 && u.m192 && wr == 1) continue;
#pragma unroll
            for (int m = 0; m < 4; ++m) {
                const unsigned ro = (unsigned)(u.row0 + wr * 64 + fr + ai * 128 + m * 16) * 1024u + (unsigned)c0;
                uint2 gp[4]; f32x4 tv[4];
#pragma unroll
                for (int g = 0; g < 4; ++g) { const unsigned o = ro + (g >> 1) * 128 + (g & 1) * 16;
                    gp[g] = *(const uint2*)(gt + o); tv[g] = (f32x4){0.f, 0.f, 0.f, 0.f}; if (j != 0) tv[g] = *(const f32x4*)(tmp + o); }
#pragma unroll
                for (int g = 0; g < 4; ++g) { const unsigned o = ro + (g >> 1) * 128 + (g & 1) * 16;
                    const f32x4 v = acc[ai][g >> 1][m][g & 1];
                    f32x4 r = tv[g];
                    r[0] += v[0] * bf2f((unsigned short)(gp[g].x & 0xffff)); r[1] += v[1] * bf2f((unsigned short)(gp[g].x >> 16));
                    r[2] += v[2] * bf2f((unsigned short)(gp[g].y & 0xffff)); r[3] += v[3] * bf2f((unsigned short)(gp[g].y >> 16));
                    if (j != 2) *(f32x4*)(tmp + o) = r;
                    else { uint2 pk; pk.x = pack2(r[0], r[1]); pk.y = pack2(r[2], r[3]); *(uint2*)(mg + o) = pk; } }
            } }
    }
};
struct EpiMerge {
    bf16_t* gt; const float* bgate; float* tmp; bf16_t* mg; unsigned* flags;
    __device__ __forceinline__ void operator()(const f32x4 (&acc)[2][2][4][2], const Unit& u, int wr, int wc, int fr, int fq) const {
        const int j = u.z >> 1;
        if ((u.z & 1) == 0) {
            EpiGate E{u.z == 4 ? mg : gt, bgate + j * 1024}; E(acc, u, wr, wc, fr, fq);
            if (u.z == 4) {
                asm volatile("s_waitcnt vmcnt(0)" ::: "memory");
                unsigned old_ = 0u;
                if (fr == 0 && fq == 0) old_ = __hip_atomic_fetch_add(flags + u.pm * 4 + u.pn, 1u, __ATOMIC_RELAXED, __HIP_MEMORY_SCOPE_AGENT);
                old_ = (unsigned)__builtin_amdgcn_readfirstlane(old_);
                if (old_ == 7u) {
                    __builtin_amdgcn_fence(__ATOMIC_RELEASE, "agent");
                    asm volatile("s_waitcnt vmcnt(0)" ::: "memory");
                    if (fr == 0 && fq == 0) __hip_atomic_fetch_add(flags + u.pm * 4 + u.pn, 256u, __ATOMIC_RELAXED, __HIP_MEMORY_SCOPE_AGENT);
                }
            }
        }
        else if (j == 0) { EpiBranch<0> E{gt, tmp, mg}; E(acc, u, wr, wc, fr, fq); }
        else if (j == 1) { EpiBranch<1> E{gt, tmp, mg}; E(acc, u, wr, wc, fr, fq); }
        else {
            { unsigned* f = flags + u.pm * 4 + u.pn; unsigned sp = 0;
              while ((unsigned)__builtin_amdgcn_readfirstlane(__hip_atomic_load(f, __ATOMIC_RELAXED, __HIP_MEMORY_SCOPE_AGENT)) < 256u) { __builtin_amdgcn_s_sleep(2); if (++sp > (1u << 20)) break; }
              __builtin_amdgcn_fence(__ATOMIC_ACQUIRE, "agent");
              asm volatile("s_waitcnt vmcnt(0)" ::: "memory"); }
            EpiBranch<2> E{mg, tmp, mg}; E(acc, u, wr, wc, fr, fq);
        }
    }
};
struct EpiRes {
    float* x; const float* mod; int goff; const float* xa; const float* xb;
    __device__ __forceinline__ const float* src(unsigned o) const { return o < (unsigned)MCTX * 1024u ? xa + o : xb + (o - (unsigned)MCTX * 1024u); }
    __device__ __forceinline__ void operator()(const f32x4 (&acc)[2][2][4][2], const Unit& u, int wr, int wc, int fr, int fq) const {
        const int c0 = u.pn * 256 + wc * 32 + 4 * fq;
        const int sg0 = seq_group(u.row0), sg1 = seq_group(u.row0 + (u.m192 ? 191 : 255));
        if (sg0 == sg1) {
            const float* gsrc = mod + sg0 * 6144 + goff;
            f32x4 gg[4];
#pragma unroll
            for (int g = 0; g < 4; ++g) gg[g] = *(const f32x4*)(gsrc + c0 + (g >> 1) * 128 + (g & 1) * 16);
#pragma unroll
            for (int ai = 0; ai < 2; ++ai) { if (ai == 1 && u.m192 && wr == 1) continue;
#pragma unroll
                for (int mp = 0; mp < 2; ++mp) {
                    const unsigned ro = (unsigned)(u.row0 + wr * 64 + fr + ai * 128 + mp * 32) * 1024u + (unsigned)c0;
                    f32x4 xv[8];
#pragma unroll
                    for (int k = 0; k < 8; ++k) { const int g = k & 3; xv[k] = *(const f32x4*)src(ro + (k >> 2) * 16384 + (g >> 1) * 128 + (g & 1) * 16); }
#pragma unroll
                    for (int k = 0; k < 8; ++k) { const int g = k & 3, m = mp * 2 + (k >> 2); *(f32x4*)(x + (ro + (k >> 2) * 16384 + (g >> 1) * 128 + (g & 1) * 16)) = xv[k] + gg[g] * acc[ai][g >> 1][m][g & 1]; }
                } }
        } else {
#pragma unroll
            for (int ai = 0; ai < 2; ++ai) { if (ai == 1 && u.m192 && wr == 1) continue;
#pragma unroll
                for (int m = 0; m < 4; ++m) {
                    const int row = u.row0 + wr * 64 + fr + ai * 128 + m * 16;
                    const float* gsrc = mod + seq_group(row) * 6144 + goff + c0;
                    const unsigned ro = (unsigned)row * 1024u + (unsigned)c0;
                    f32x4 xv[4], gv[4];
#pragma unroll
                    for (int g = 0; g < 4; ++g) { xv[g] = *(const f32x4*)src(ro + (g >> 1) * 128 + (g & 1) * 16); gv[g] = *(const f32x4*)(gsrc + (g >> 1) * 128 + (g & 1) * 16); }
#pragma unroll
                    for (int g = 0; g < 4; ++g) *(f32x4*)(x + (ro + (g >> 1) * 128 + (g & 1) * 16)) = xv[g] + gv[g] * acc[ai][g >> 1][m][g & 1];
                } }
        }
    }
};
struct EpiBf {
    bf16_t* dst; int ld;
    __device__ __forceinline__ void operator()(const f32x4 (&acc)[2][2][4][2], const Unit& u, int wr, int wc, int fr, int fq) const {
        EPI_LOOP_BEGIN
            const int col = u.pn * 256 + cl;
            uint2 pk; pk.x = pack2(v[0], v[1]); pk.y = pack2(v[2], v[3]);
            *(uint2*)(dst + (size_t)row * ld + col) = pk;
        EPI_LOOP_END
    }
};
__device__ __forceinline__ float dpp_f(float old, float src, const int ctrl_sel) {
    const int o = __float_as_int(old), v = __float_as_int(src);
    int r;
    if (ctrl_sel == 0) r = __builtin_amdgcn_update_dpp(o, v, 0x111, 0xf, 0xf, false);
    else if (ctrl_sel == 1) r = __builtin_amdgcn_update_dpp(o, v, 0x101, 0xf, 0xf, false);
    else if (ctrl_sel == 2) r = __builtin_amdgcn_update_dpp(o, v, 0x121, 0xf, 0xf, false);
    else r = __builtin_amdgcn_update_dpp(o, v, 0x12f, 0xf, 0xf, false);
    return __int_as_float(r);
}
__device__ __forceinline__ float gelu_tanh(float x) { const float y = 0.7978845608028654f * (x + 0.044715f * x * x * x); const float t = 1.0f - 2.0f * __builtin_amdgcn_rcpf(1.0f + __expf(2.0f * y)); return 0.5f * x * (1.0f + t); }
struct EpiUp {
    bf16_t* act; bf16_t* su; bf16_t* sv; const float* cw; const float* cb;
    __device__ __forceinline__ void operator()(const f32x4 (&acc)[2][2][4][2], const Unit& u, int wr, int wc, int fr, int fq) const {
#pragma unroll
        for (int n = 0; n < 2; ++n) {
            const int ch = u.pn * 128 + wc * 32 + 16 * n + 4 * fq;
            const f32x4 w0 = *(const f32x4*)(cw + ch), w1 = *(const f32x4*)(cw + 2816 + ch), w2 = *(const f32x4*)(cw + 5632 + ch), bb = *(const f32x4*)(cb + ch);
#pragma unroll
            for (int ai = 0; ai < 2; ++ai) {
                const int rowg = u.row0 + ai * 128 + wr * 64;
                f32x4 ub[4];
#pragma unroll
                for (int m = 0; m < 4; ++m)
#pragma unroll
                    for (int e = 0; e < 4; ++e) ub[m][e] = bf2f(f2bf(acc[ai][0][m][n][e]));
#pragma unroll
                for (int m = 0; m < 4; ++m) {
                    const int row = rowg + m * 16 + fr;
                    f32x4 r;
#pragma unroll
                    for (int e = 0; e < 4; ++e) {
                        const float pl = m > 0 ? dpp_f(0.f, ub[m > 0 ? m - 1 : 0][e], 2) : 0.f;
                        const float pv = dpp_f(pl, ub[m][e], 0);
                        const float nl = m < 3 ? dpp_f(0.f, ub[m < 3 ? m + 1 : 3][e], 3) : 0.f;
                        const float nv = dpp_f(nl, ub[m][e], 1);
                        const float gff = w0[e] * pv + w1[e] * ub[m][e] + w2[e] * nv + bb[e];
                        r[e] = gelu_tanh(gff) * bf2f(f2bf(acc[ai][1][m][n][e]));
                    }
                    const bool edge = (m == 0 && fr == 0) || (m == 3 && fr == 15);
                    if (!edge) { uint2 pk; pk.x = pack2(r[0], r[1]); pk.y = pack2(r[2], r[3]); *(uint2*)(act + (size_t)row * 2816 + ch) = pk; }
                    if ((m == 0 && fr < 2) || (m == 3 && fr >= 14)) {
                        const int slot = m == 0 ? fr : fr - 12; const int g64 = rowg >> 6;
                        uint2 pk; pk.x = pack2(ub[m][0], ub[m][1]); pk.y = pack2(ub[m][2], ub[m][3]);
                        *(uint2*)(su + ((size_t)g64 * 4 + slot) * 2816 + ch) = pk;
                        if (edge) { const f32x4 vv = acc[ai][1][m][n]; uint2 pv2; pv2.x = pack2(vv[0], vv[1]); pv2.y = pack2(vv[2], vv[3]); *(uint2*)(sv + ((size_t)g64 * 2 + (m == 0 ? 0 : 1)) * 2816 + ch) = pv2; }
                    }
                }
            }
        }
    }
};
struct EpiPool {
    bf16_t* dst; const float* scale;
    __device__ __forceinline__ void operator()(const f32x4 (&acc)[2][2][4][2], const Unit& u, int wr, int wc, int fr, int fq) const {
        const int c0 = u.pn * 256 + wc * 32 + 4 * fq;
        f32x4 sc[4];
#pragma unroll
        for (int g = 0; g < 4; ++g) sc[g] = *(const f32x4*)(scale + c0 + (g >> 1) * 128 + (g & 1) * 16);
#pragma unroll
        for (int ai = 0; ai < 2; ++ai)
#pragma unroll
            for (int m = 0; m < 4; ++m) { const int row = u.pm * 256 + wr * 64 + fr + ai * 128 + m * 16;
#pragma unroll
                for (int g = 0; g < 4; ++g) { const f32x4 v = acc[ai][g >> 1][m][g & 1] * sc[g];
                    uint2 pk; pk.x = pack2(v[0], v[1]); pk.y = pack2(v[2], v[3]);
                    *(uint2*)(dst + (size_t)row * 1024 + c0 + (g >> 1) * 128 + (g & 1) * 16) = pk; } }
    }
};

struct WPtrs { const float *w_in, *w_branch, *lru_wa, *lru_wx, *pool_w, *w_out, *ffn_up, *ffn_down; unsigned char* ws; };
struct TileDesc { const float* src; int lds_; bf16_t* dst; int ldd, k0, n0, perm, nd; };
__device__ __forceinline__ int swap45(int p) { return (p & ~48) | ((p & 16) << 1) | ((p & 32) >> 1); }
__device__ __forceinline__ TileDesc weight_tile(const WPtrs& P, int l, int t) {
    unsigned char* ws = P.ws; TileDesc d; int r = t; d.perm = 0; d.nd = -1;
    if (r < 1664) { d.src = P.w_in + (size_t)l * 1024 * 6656; d.lds_ = 6656; d.dst = (bf16_t*)(ws + OFF_WIN); d.ldd = 1024; d.k0 = (r / 104) * 64; d.n0 = (r % 104) * 64; d.perm = (d.n0 >= 1024 && d.n0 < 2304) ? 1 : 0; }
    else if ((r -= 1664) < 128) { const int mat = r / 64; r %= 64; const int dh = r / 4; r %= 4;
        d.src = (mat ? P.lru_wx : P.lru_wa) + (size_t)(l * 16 + dh) * 128 * 128; d.lds_ = 128; d.dst = (bf16_t*)(ws + OFF_GW) + (size_t)dh * 256 * 128 + (size_t)mat * 128 * 128; d.ldd = 128; d.k0 = (r / 2) * 64; d.n0 = (r % 2) * 64; }
    else if ((r -= 128) < 64) { const int g = r / 16; r %= 16; d.src = P.pool_w + (size_t)(l * 4 + g) * 256 * 256; d.lds_ = 256; d.dst = (bf16_t*)(ws + OFF_PW) + (size_t)g * 256 * 256; d.ldd = 256; d.k0 = (r / 4) * 64; d.n0 = (r % 4) * 64; }
    else if ((r -= 64) < 768) { const int j = r / 256; r %= 256; d.src = P.w_branch + (size_t)(l * 3 + j) * 1024 * 1024; d.lds_ = 1024; d.dst = (bf16_t*)(ws + OFF_WBR) + (size_t)j * 1024 * 1024; d.ldd = 1024; d.k0 = (r / 16) * 64; d.n0 = (r % 16) * 64; }
    else if ((r -= 768) < 256) { d.src = P.w_out + (size_t)l * 1024 * 1024; d.lds_ = 1024; d.dst = (bf16_t*)(ws + OFF_WOUT); d.ldd = 1024; d.k0 = (r / 16) * 64; d.n0 = (r % 16) * 64; }
    else if ((r -= 256) < 1408) { d.src = P.ffn_up + (size_t)l * 1024 * 5632; d.lds_ = 5632; d.dst = (bf16_t*)(ws + OFF_WUP); d.ldd = 1024; d.k0 = (r / 88) * 64; d.n0 = (r % 88) * 64;
        { const int isv = d.n0 >= 2816, c0 = isv ? d.n0 - 2816 : d.n0; d.nd = (c0 >> 7) * 256 + (c0 & 127) + (isv ? 128 : 0); } }
    else { r -= 1408; d.src = P.ffn_down + (size_t)l * 2816 * 1024; d.lds_ = 1024; d.dst = (bf16_t*)(ws + OFF_WDN); d.ldd = 2816; d.k0 = (r / 16) * 64; d.n0 = (r % 16) * 64; }
    return d;
}
__device__ __noinline__ void convert_weights_(const float* p0, const float* p1, const float* p2, const float* p3, const float* p4, const float* p5, const float* p6, const float* p7, unsigned char* pws,
                                              int l, LAS unsigned char* lds, int t_begin, int t_end, int first, int stride) {
    const WPtrs P{p0, p1, p2, p3, p4, p5, p6, p7, pws};
    LAS bf16_t* sm = (LAS bf16_t*)lds;
    const int tid = otid();
    const int kk0 = tid >> 4, n4 = (tid & 15) * 4, nn = tid >> 3, ck = tid & 7;
    int t = t_begin + first;
    if (t >= t_end) return;
    TileDesc d = weight_tile(P, l, t);
    f32x4 v0 = *(const f32x4*)(d.src + (size_t)(d.k0 + kk0) * d.lds_ + d.n0 + n4), v1 = *(const f32x4*)(d.src + (size_t)(d.k0 + kk0 + 32) * d.lds_ + d.n0 + n4);
    for (;;) {
        __syncthreads();
#pragma unroll
        for (int e = 0; e < 4; ++e) { sm[(n4 + e) * 72 + kk0] = f2bf(v0[e]); sm[(n4 + e) * 72 + kk0 + 32] = f2bf(v1[e]); }
        __syncthreads();
        const TileDesc cur = d; const int tn = t + stride; const bool more = tn < t_end;
        if (more) { d = weight_tile(P, l, tn); v0 = *(const f32x4*)(d.src + (size_t)(d.k0 + kk0) * d.lds_ + d.n0 + n4); v1 = *(const f32x4*)(d.src + (size_t)(d.k0 + kk0 + 32) * d.lds_ + d.n0 + n4); }
        const u32x4 o = *(const LAS u32x4*)(sm + nn * 72 + ck * 8);
        const int nrow = cur.perm ? swap45(cur.n0 + nn) : ((cur.nd >= 0 ? cur.nd : cur.n0) + nn);
        *(u32x4*)(cur.dst + (size_t)nrow * cur.ldd + cur.k0 + ck * 8) = o;
        if (!more) break;
        t = tn;
    }
    __syncthreads();
}

__device__ __forceinline__ void convert_weights(const Params& P, int l, LAS unsigned char* lds, int t_begin, int t_end, int first, int stride) {
    convert_weights_(P.w_in, P.w_branch, P.lru_wa, P.lru_wx, P.pool_w, P.w_out, P.ffn_up, P.ffn_down, P.ws, l, lds, t_begin, t_end, first, stride);
}

__device__ void phase0(const Params& P, LAS unsigned char* lds) {
    const int tid = otid(), G = gridDim.x, c = blockIdx.x;
    { bf16_t* ck = (bf16_t*)(P.ws + OFF_CK); bf16_t* cv = (bf16_t*)(P.ws + OFF_CV);
      for (int i = c * 512 + tid; i < 2 * 2 * 512 * 256; i += G * 512) {
          const int e = i & 255, t = (i >> 8) & 511, b = (i >> 17) & 1, l = i >> 18;
          const size_t si = ((size_t)((b * 2 + l) * 512 + t)) * 256 + e;
          ck[i] = f2bf(P.cache_k[si]); cv[i] = f2bf(P.cache_v[si]); } }
    { float* rc = (float*)(P.ws + OFF_ROPE); float* rs = rc + 2048;
      for (int i = c * 512 + tid; i < 2048; i += G * 512) {
          const int pos = i >> 5, k = i & 31; const float fr = powf(10000.0f, -(float)k / 32.0f); const float ang = (float)pos * fr;
          rc[i] = cosf(ang); rs[i] = sinf(ang); } }
    { LAS float* sv = (LAS float*)lds;
      LAS float* red = sv + 3072;
      __syncthreads();
      for (int i = tid; i < 3072; i += 512) { const int s = i >> 10, k = i & 1023; const float x = s == 0 ? P.c_ctx[k] : P.c[(s - 1) * 1024 + k]; sv[i] = x / (1.0f + expf(-x)); }
      __syncthreads();
      float* mod = (float*)(P.ws + OFF_MOD);
      for (int it = c; it < 384; it += G) {
          const int l = it / 192, cg_ = it % 192, cl = tid & 31, kg = tid >> 5, col = cg_ * 32 + cl;
          const float* w = P.w_ada + (size_t)l * 1024 * 6144 + col;
          float a0 = 0.f, a1 = 0.f, a2 = 0.f;
#pragma unroll 16
          for (int k = kg * 64; k < kg * 64 + 64; ++k) { const float wv = w[(size_t)k * 6144]; a0 += sv[k] * wv; a1 += sv[1024 + k] * wv; a2 += sv[2048 + k] * wv; }
          red[(kg * 3 + 0) * 32 + cl] = a0; red[(kg * 3 + 1) * 32 + cl] = a1; red[(kg * 3 + 2) * 32 + cl] = a2;
          __syncthreads();
          if (tid < 96) { const int s = tid >> 5, cc = tid & 31; float sum = 0.f;
#pragma unroll
              for (int g = 0; g < 16; ++g) sum += red[(g * 3 + s) * 32 + cc];
              mod[(size_t)(l * 3 + s) * 6144 + cg_ * 32 + cc] = sum + P.b_ada[l * 6144 + cg_ * 32 + cc]; }
          __syncthreads();
      } }
}

template <bool FINAL>
__device__ __forceinline__ void norm_rows(float* X, const float* xa, const float* xb, const float* __restrict__ gw, const float* __restrict__ mod, int shift_off, int scale_off, bf16_t* __restrict__ H) {
    const int tid = otid(); const int lane = tid & 63, wv = blockIdx.x * 8 + (tid >> 6), nw = gridDim.x * 8;
    constexpr int R = 3;
    for (int row0 = wv; row0 < MROWS; row0 += R * nw) {
        f32x4 v[R][4];
#pragma unroll
        for (int r = 0; r < R; ++r) { const int row = row0 + r * nw;
#pragma unroll
            for (int i = 0; i < 4; ++i) v[r][i] = row < MROWS ? *(const f32x4*)((row < MCTX ? xa + (size_t)row * 1024 : xb + (size_t)(row - MCTX) * 1024) + i * 256 + lane * 4) : (f32x4){0.f, 0.f, 0.f, 0.f}; }
#pragma unroll
        for (int r = 0; r < R; ++r) { const int row = row0 + r * nw; if (row >= MROWS) continue;
            float ss = 0.f;
#pragma unroll
            for (int i = 0; i < 4; ++i) ss += v[r][i][0] * v[r][i][0] + v[r][i][1] * v[r][i][1] + v[r][i][2] * v[r][i][2] + v[r][i][3] * v[r][i][3];
#pragma unroll
            for (int o = 32; o >= 1; o >>= 1) ss += __shfl_xor(ss, o);
            const float rstd = rsqrtf(ss * (1.0f / 1024.0f) + 1e-6f);
            const float* md = mod + seq_group(row) * 6144;
#pragma unroll
            for (int i = 0; i < 4; ++i) { const int col = i * 256 + lane * 4;
                const f32x4 g = *(const f32x4*)(gw + col);
                if (FINAL) { f32x4 h;
#pragma unroll
                    for (int e = 0; e < 4; ++e) h[e] = v[r][i][e] * rstd * g[e];
                    *(f32x4*)(X + (size_t)row * 1024 + col) = h; }
                else { const f32x4 sc = *(const f32x4*)(md + scale_off + col), sh = *(const f32x4*)(md + shift_off + col);
                    f32x4 h;
#pragma unroll
                    for (int e = 0; e < 4; ++e) h[e] = v[r][i][e] * rstd * g[e] * (1.0f + sc[e]) + sh[e];
                    uint2 pk; pk.x = pack2(h[0], h[1]); pk.y = pack2(h[2], h[3]);
                    *(uint2*)(H + (size_t)row * 1024 + col) = pk; } }
        }
    }
}
__device__ void norm_phase(const float* xa, const float* xb, const float* __restrict__ gw, const float* __restrict__ mod, int shift_off, int scale_off, bf16_t* __restrict__ H) { norm_rows<false>(nullptr, xa, xb, gw, mod, shift_off, scale_off, H); }
__device__ void final_norm_phase(float* X, const float* __restrict__ gw) { norm_rows<true>(X, X, X + (size_t)MCTX * 1024, gw, nullptr, 0, 0, nullptr); }

template <int HALF>
__device__ __forceinline__ void pool_item(const bf16_t* __restrict__ XC, bf16_t* __restrict__ PL, int it) {
    constexpr int G_ = HALF == 1 ? 0 : (HALF == 2 ? 1 : (HALF == 4 ? 2 : 3));
    const int rs = (it >> 5) * 8, ch = G_ * 256 + (it & 31) * 8;
    const int T = rs < MCTX ? 256 : 2048, row0 = rs < MCTX ? (rs & ~255) : MCTX + ((rs - MCTX) & ~2047), tl0 = rs - row0;
    const bf16_t* base = XC + (size_t)row0 * 1024 + ch;
    constexpr int R = 8 + 2 * HALF;
    bf16x8 xr[R];
#pragma unroll
    for (int i = 0; i < R; ++i) { const int t = tl0 - HALF + i; xr[i] = (bf16x8){0, 0, 0, 0, 0, 0, 0, 0}; if (t >= 0 && t < T) xr[i] = *(const bf16x8*)(base + (size_t)t * 1024); }
    float s[8];
#pragma unroll
    for (int e = 0; e < 8; ++e) { s[e] = 0.f;
#pragma unroll
        for (int i = 0; i < 2 * HALF; ++i) s[e] += bf2f((unsigned short)xr[i][e]); }
#pragma unroll
    for (int j = 0; j < 8; ++j) {
        const int t = tl0 + j;
        const float inv = 1.0f / (float)(min(t + HALF, T) - max(t - HALF, 0));
        float r[8];
#pragma unroll
        for (int e = 0; e < 8; ++e) r[e] = s[e] * inv - bf2f((unsigned short)xr[j + HALF][e]);
        u32x4 o; o.x = pack2(r[0], r[1]); o.y = pack2(r[2], r[3]); o.z = pack2(r[4], r[5]); o.w = pack2(r[6], r[7]);
        *(u32x4*)(PL + (size_t)(row0 + t) * 1024 + ch) = o;
#pragma unroll
        for (int e = 0; e < 8; ++e) s[e] += bf2f((unsigned short)xr[j + 2 * HALF][e]) - bf2f((unsigned short)xr[j][e]);
    }
}
__device__ void pool_phase(const bf16_t* __restrict__ XC, bf16_t* __restrict__ PL) {
    const int tid = otid();
    constexpr int PER_G = (MROWS / 8) * 32;
    for (int idx = blockIdx.x * 512 + tid; idx < 4 * PER_G; idx += gridDim.x * 512) {
        const int g = idx / PER_G, it = idx % PER_G;
        if (g == 0) pool_item<1>(XC, PL, it); else if (g == 1) pool_item<2>(XC, PL, it); else if (g == 2) pool_item<4>(XC, PL, it); else pool_item<8>(XC, PL, it);
    }
}
__device__ void ffn_fix_groups(const bf16_t* __restrict__ SU, const bf16_t* __restrict__ SV, bf16_t* __restrict__ ACT, const float* __restrict__ cw, const float* __restrict__ cb, int g0, int ng) {
    const int tid = otid();
    for (int idx = tid; idx < ng * 2 * 352; idx += 512) {
        const int br = idx / 352, ch = (idx % 352) * 8;
        const int g = g0 + (br >> 1), last = br & 1;
        const int row = g * 64 + (last ? 63 : 0);
        const int T = row < MCTX ? 256 : 2048, row0 = row < MCTX ? (row & ~255) : MCTX + ((row - MCTX) & ~2047), tl = row - row0;
        const bf16x8 zero = (bf16x8){0, 0, 0, 0, 0, 0, 0, 0};
        bf16x8 um, u0, un;
        if (last) { um = *(const bf16x8*)(SU + ((size_t)g * 4 + 2) * 2816 + ch); u0 = *(const bf16x8*)(SU + ((size_t)g * 4 + 3) * 2816 + ch);
                    un = tl < T - 1 ? *(const bf16x8*)(SU + ((size_t)(g + 1) * 4 + 0) * 2816 + ch) : zero; }
        else { um = tl > 0 ? *(const bf16x8*)(SU + ((size_t)(g - 1) * 4 + 3) * 2816 + ch) : zero; u0 = *(const bf16x8*)(SU + ((size_t)g * 4 + 0) * 2816 + ch);
               un = *(const bf16x8*)(SU + ((size_t)g * 4 + 1) * 2816 + ch); }
        const bf16x8 vv = *(const bf16x8*)(SV + ((size_t)g * 2 + last) * 2816 + ch);
        float r[8];
#pragma unroll
        for (int e = 0; e < 8; ++e) { const float gff = cw[ch + e] * bf2f((unsigned short)um[e]) + cw[2816 + ch + e] * bf2f((unsigned short)u0[e]) + cw[5632 + ch + e] * bf2f((unsigned short)un[e]) + cb[ch + e];
            r[e] = gelu_tanh(gff) * bf2f((unsigned short)vv[e]); }
        u32x4 o; o.x = pack2(r[0], r[1]); o.y = pack2(r[2], r[3]); o.z = pack2(r[4], r[5]); o.w = pack2(r[6], r[7]);
        *(u32x4*)(ACT + (size_t)row * 2816 + ch) = o;
    }
}

__device__ __forceinline__ void rope8(bf16x8& x1, bf16x8& x2, const float* __restrict__ cs, const float* __restrict__ sn) {
#pragma unroll
    for (int e = 0; e < 8; ++e) { const float a = bf2f((unsigned short)x1[e]), b = bf2f((unsigned short)x2[e]); const float c = cs[e], s = sn[e];
        x1[e] = (short)f2bf(a * c - b * s); x2[e] = (short)f2bf(a * s + b * c); }
}
constexpr int VT_OFF = 64 * 272;
constexpr int ABUF = 64 * 272 + 64 * 288;
__device__ void attn_unit(const Params& P, int l, int u, LAS unsigned char* lds) {
    int tid_ = threadIdx.x; asm volatile("" : "+v"(tid_));
    const int tid = tid_, w = tid >> 6, lane = tid & 63, fr = lane & 15, fq = lane >> 4;
    const bf16_t* Q = (const bf16_t*)(P.ws + OFF_XAQ) + (size_t)MROWS * 1024;
    const bf16_t* KB = (const bf16_t*)(P.ws + OFF_KB); const bf16_t* VB = (const bf16_t*)(P.ws + OFF_VB);
    const bf16_t* CK = (const bf16_t*)(P.ws + OFF_CK); const bf16_t* CV = (const bf16_t*)(P.ws + OFF_CV);
    bf16_t* YB = (bf16_t*)(P.ws + OFF_YB);
    bool lat; int head, row0, T, qstart, bidx;
    if (u < 256) { lat = true; bidx = u >> 7; const int rem = u & 127; head = rem >> 4; qstart = (rem & 15) * 128; T = 2048; row0 = MCTX + bidx * 2048; }
    else { const int v = u - 256; lat = false; bidx = 0; const int seq = v >> 4, rem = v & 15; head = rem >> 1; qstart = (rem & 1) * 128; T = 256; row0 = seq * 256; }
    const int kvh = head >> 2;
    const int qpos = qstart + w * 16 + fr;
    bf16x8 qf[4];
    { const bf16_t* qp = Q + (size_t)(row0 + qpos) * 1024 + head * 128 + fq * 8;
#pragma unroll
      for (int kk = 0; kk < 4; ++kk) qf[kk] = *(const bf16x8*)(qp + kk * 32); }
    float m_run = P.attn_sink[l * 8 + head] * 1.4426950408889634f; float l_run = (fq == 0) ? 1.0f : 0.0f;
    f32x4 o[8];
#pragma unroll
    for (int dt = 0; dt < 8; ++dt) o[dt] = (f32x4){0.f, 0.f, 0.f, 0.f};
    int wlo = 0, nwt = 4;
    if (lat) { wlo = max(0, qstart - 128); const int whi = min(T, qstart + 256); nwt = (whi - wlo) >> 6; }
    const int ntiles = nwt + (lat ? 8 : 0);
    const float scale = 0.08838834764831845f * 1.4426950408889634f;
    const int lkey = tid >> 3, lp = tid & 7;
    bf16x8 rk[2][2], rv[2][2];
    auto tile_load = [&](int ti, bf16x8 (&k_)[2], bf16x8 (&v_)[2]) {
        const bf16_t* ksrc; const bf16_t* vsrc;
        if (ti < nwt) { const int k0 = wlo + ti * 64; ksrc = KB + (size_t)(row0 + k0) * 256 + kvh * 128; vsrc = VB + (size_t)(row0 + k0) * 256 + kvh * 128; }
        else { const int k0 = (ti - nwt) * 64; const size_t o_ = ((size_t)((l * 2 + bidx) * 512 + k0)) * 256 + kvh * 128; ksrc = CK + o_; vsrc = CV + o_; }
        const bf16_t* kr = ksrc + (size_t)lkey * 256; k_[0] = *(const bf16x8*)(kr + lp * 8); k_[1] = *(const bf16x8*)(kr + (lp + 8) * 8);
        const bf16_t* vr = vsrc + (size_t)lkey * 256; v_[0] = *(const bf16x8*)(vr + lp * 8); v_[1] = *(const bf16x8*)(vr + (lp + 8) * 8); };
    const int krow = (lkey & 32) | ((lkey & 4) << 2) | ((lkey & 24) >> 1) | (lkey & 3);
    auto tile_store = [&](int b, const bf16x8 (&k_)[2], const bf16x8 (&v_)[2]) {
        LAS unsigned char* kb_ = lds + b * ABUF; LAS unsigned char* vb_ = kb_ + VT_OFF;
        *(LAS bf16x8*)(kb_ + krow * 272 + lp * 16) = k_[0]; *(LAS bf16x8*)(kb_ + krow * 272 + (lp + 8) * 16) = k_[1];
        *(LAS bf16x8*)(vb_ + lkey * 288 + lp * 16) = v_[0]; *(LAS bf16x8*)(vb_ + lkey * 288 + (lp + 8) * 16) = v_[1]; };
    tile_load(0, rk[0], rv[0]);
    tile_load(1, rk[1], rv[1]);
    __syncthreads();
    tile_store(0, rk[0], rv[0]);
    tile_load(2, rk[0], rv[0]);
#pragma unroll 2
    for (int ti = 0; ti < ntiles; ++ti) {
        const bool win = ti < nwt; const int k0 = win ? wlo + ti * 64 : (ti - nwt) * 64;
        __syncthreads();
        if ((ti & 1) == 0) { if (ti + 1 < ntiles) tile_store(1, rk[1], rv[1]); if (ti + 3 < ntiles) tile_load(ti + 3, rk[1], rv[1]); }
        else { if (ti + 1 < ntiles) tile_store(0, rk[0], rv[0]); if (ti + 3 < ntiles) tile_load(ti + 3, rk[0], rv[0]); }
        LAS unsigned char* kb_ = lds + (ti & 1) * ABUF; LAS unsigned char* vb_ = kb_ + VT_OFF;
        f32x4 s[4];
#pragma unroll
        for (int nt = 0; nt < 4; ++nt) { s[nt] = (f32x4){0.f, 0.f, 0.f, 0.f};
#pragma unroll
            for (int kk = 0; kk < 4; ++kk) { const bf16x8 a = *(const LAS bf16x8*)(kb_ + (nt * 16 + fr) * 272 + kk * 64 + fq * 16); s[nt] = __builtin_amdgcn_mfma_f32_16x16x32_bf16(a, qf[kk], s[nt], 0, 0, 0); } }
        float mt = -3.0e38f;
#pragma unroll
        for (int nt = 0; nt < 4; ++nt)
#pragma unroll
            for (int j = 0; j < 4; ++j) { float v = s[nt][j] * scale;
                if (lat && win) { const int kp = k0 + 32 * (nt >> 1) + 8 * fq + 4 * (nt & 1) + j; const int dd = qpos - kp; if (dd > 128 || dd < -128) v = -1.0e30f; }
                s[nt][j] = v; mt = fmaxf(mt, v); }
        mt = fmaxf(mt, __shfl_xor(mt, 16)); mt = fmaxf(mt, __shfl_xor(mt, 32));
        const float mn = fmaxf(m_run, mt); const float alpha = __builtin_amdgcn_exp2f(m_run - mn); m_run = mn;
        float ps = 0.f;
#pragma unroll
        for (int nt = 0; nt < 4; ++nt)
#pragma unroll
            for (int j = 0; j < 4; ++j) { const float p = __builtin_amdgcn_exp2f(s[nt][j] - mn); ps += p; s[nt][j] = p; }
        l_run = l_run * alpha + ps;
#pragma unroll
        for (int dt = 0; dt < 8; ++dt) o[dt] = o[dt] * alpha;
#pragma unroll
        for (int s2 = 0; s2 < 2; ++s2) {
            u32x4 pu; pu[0] = pack2(s[2 * s2][0], s[2 * s2][1]); pu[1] = pack2(s[2 * s2][2], s[2 * s2][3]); pu[2] = pack2(s[2 * s2 + 1][0], s[2 * s2 + 1][1]); pu[3] = pack2(s[2 * s2 + 1][2], s[2 * s2 + 1][3]);
            const bf16x8 pf = __builtin_bit_cast(bf16x8, pu);
#pragma unroll
            for (int dt = 0; dt < 8; ++dt) {
                const bf16x4 lo = __builtin_amdgcn_ds_read_tr16_b64_v4i16((LAS bf16x4*)(vb_ + (s2 * 32 + fq * 8 + (fr >> 2)) * 288 + (dt * 16 + (fr & 3) * 4) * 2));
                const bf16x4 hi = __builtin_amdgcn_ds_read_tr16_b64_v4i16((LAS bf16x4*)(vb_ + (s2 * 32 + fq * 8 + 4 + (fr >> 2)) * 288 + (dt * 16 + (fr & 3) * 4) * 2));
                const bf16x8 af = __builtin_shufflevector(lo, hi, 0, 1, 2, 3, 4, 5, 6, 7);
                o[dt] = __builtin_amdgcn_mfma_f32_16x16x32_bf16(af, pf, o[dt], 0, 0, 0);
            }
        }
    }
    float lt = l_run; lt += __shfl_xor(lt, 16); lt += __shfl_xor(lt, 32);
    const float inv = 1.0f / lt;
    bf16_t* yp = YB + (size_t)(row0 + qpos) * 1024 + head * 128 + fq * 4;
#pragma unroll
    for (int dt = 0; dt < 8; ++dt) { uint2 pk; pk.x = pack2(o[dt][0] * inv, o[dt][1] * inv); pk.y = pack2(o[dt][2] * inv, o[dt][3] * inv); *(uint2*)(yp + dt * 16) = pk; }
}

constexpr int YT_OFF = 256 * 272;
template <int MODE, int D, int NSC>
__device__ __forceinline__ void lru_dir(const Params& P, int l, int s, int cchunk, int h, LAS unsigned char* lds, int w, int fr, int fq) {
    const bool lat = s >= 32; const int row0 = lat ? MCTX + (s - 32) * 2048 : s * 256; const int t0 = cchunk * (NSC * 64);
    constexpr int NCH = 2048 / (NSC * 64);
    const bf16_t* GW = (const bf16_t*)(P.ws + OFF_GW);
    bf16_t* YA = (bf16_t*)(P.ws + OFF_YA);
    float* SUMM = (float*)(P.ws + OFF_SUMM);
    const int chl = 16 * w + fr, ch = h * 128 + chl;
    bf16x8 bwa[4], bwx[4];
    { const bf16_t* gp = GW + ((size_t)(D * 8 + h) * 256 + chl) * 128 + fq * 8;
#pragma unroll
      for (int kk = 0; kk < 4; ++kk) { bwa[kk] = *(const bf16x8*)(gp + kk * 32); bwx[kk] = *(const bf16x8*)(gp + 128 * 128 + kk * 32); } }
    const int pidx = (l * 2 + D) * 1024 + ch;
    const float ba = P.lru_ba[pidx], bx = P.lru_bx[pidx];
    const float lam = P.lru_lambda[pidx];
    const float c8 = -8.0f * log1pf(expf(-lam));
    float carry = 0.f;
    if (MODE == 0 && lat) {
        const int b = s - 32;
        carry = P.state_lru[((size_t)(b * 2 + l) * 2 + D) * 1024 + ch];
        if (D == 0) { for (int cc = 0; cc < cchunk; ++cc) { const float* sp = SUMM + ((size_t)((b * 2 + 0) * 16 + cc) * 1024 + ch) * 2; carry = sp[1] + sp[0] * carry; } }
        else { for (int cc = NCH - 1; cc > cchunk; --cc) { const float* sp = SUMM + ((size_t)((b * 2 + 1) * 16 + cc) * 1024 + ch) * 2; carry = sp[1] + sp[0] * carry; } }
    }
    float ptot = 1.0f;
#pragma unroll 1
    for (int sci = 0; sci < NSC; ++sci) {
        const int sc = D == 0 ? sci : NSC - 1 - sci;
        f32x4 r[4], g[4];
#pragma unroll
        for (int m = 0; m < 4; ++m) { r[m] = (f32x4){0.f, 0.f, 0.f, 0.f}; g[m] = (f32x4){0.f, 0.f, 0.f, 0.f};
#pragma unroll
            for (int kk = 0; kk < 4; ++kk) { const bf16x8 a = *(const LAS bf16x8*)(lds + (sc * 64 + m * 16 + fr) * 272 + kk * 64 + fq * 16);
                r[m] = __builtin_amdgcn_mfma_f32_16x16x32_bf16(a, bwa[kk], r[m], 0, 0, 0); g[m] = __builtin_amdgcn_mfma_f32_16x16x32_bf16(a, bwx[kk], g[m], 0, 0, 0); } }
#pragma unroll
        for (int mi = 0; mi < 4; ++mi) {
            const int m = D == 0 ? mi : 3 - mi;
            float av[4], bv[4];
#pragma unroll
            for (int j = 0; j < 4; ++j) {
                const float ea = 1.0f + __expf(-(r[m][j] + ba)), eb = 1.0f + __expf(-(g[m][j] + bx));
                const float inv = __builtin_amdgcn_rcpf(ea * eb);
                const float rr = inv * eb, ii = inv * ea;
                const float la = c8 * rr; const float a = __expf(la); const float z = 2.0f * la;
                const float em = (z > -0.05f) ? -z * (1.0f + z * (0.5f + z * (0.16666667f + z * 0.041666667f))) : 1.0f - a * a;
                const float x = bf2f(*(const LAS bf16_t*)(lds + (sc * 64 + m * 16 + fq * 4 + j) * 272 + chl * 2));
                av[j] = a; bv[j] = __builtin_amdgcn_sqrtf(em) * ii * x;
            }
            float p4, h4;
            p4 = av[0] * av[1] * av[2] * av[3];
            if (D == 0) h4 = ((bv[0] * av[1] + bv[1]) * av[2] + bv[2]) * av[3] + bv[3];
            else h4 = ((bv[3] * av[2] + bv[2]) * av[1] + bv[1]) * av[0] + bv[0];
            float pq[4], hq[4];
#pragma unroll
            for (int f = 0; f < 4; ++f) { pq[f] = __shfl(p4, fr + 16 * f); hq[f] = __shfl(h4, fr + 16 * f); }
            float cin = carry, mycin = 0.f;
#pragma unroll
            for (int fi = 0; fi < 4; ++fi) { const int f = D == 0 ? fi : 3 - fi; if (f == fq) mycin = cin; cin = hq[f] + pq[f] * cin; }
            carry = cin;
            if (MODE == 1) ptot *= pq[0] * pq[1] * pq[2] * pq[3];
            if (MODE == 0) {
                float hh = mycin; float y[4];
#pragma unroll
                for (int ji = 0; ji < 4; ++ji) { const int j = D == 0 ? ji : 3 - ji; hh = av[j] * hh + bv[j]; y[j] = hh; }
#pragma unroll
                for (int j = 0; j < 4; ++j) {
                    LAS bf16_t* yp = (LAS bf16_t*)(lds + YT_OFF + (sc * 64 + m * 16 + fq * 4 + j) * 272 + chl * 2);
                    if (D == 0) *yp = f2bf(y[j]);
                    else *yp = f2bf(bf2f(*yp) + y[j]);
                }
            }
        }
    }
    if (MODE == 0 && !lat && fq == 0) P.out[OUT_H + ((size_t)(s * 2 + l) * 2 + D) * 1024 + ch] = carry;
    if (MODE == 1 && fq == 0) { float* sp = SUMM + ((size_t)(((s - 32) * 2 + D) * 16 + cchunk) * 1024 + ch) * 2; sp[0] = ptot; sp[1] = carry; }
}
template <int MODE, int NSC>
__device__ void lru_unit(const Params& P, int l, int s, int cchunk, int h, LAS unsigned char* lds) {
    int tid_ = threadIdx.x; asm volatile("" : "+v"(tid_));
    const int tid = tid_, w = tid >> 6, lane = tid & 63, fr = lane & 15, fq = lane >> 4;
    const bool lat = s >= 32; const int T = lat ? 2048 : 256; const int row0 = lat ? MCTX + (s - 32) * 2048 : s * 256; const int t0 = cchunk * (NSC * 64);
    const bf16_t* XA = (const bf16_t*)(P.ws + OFF_XAQ);
    constexpr int RUN = NSC * 2;
    {
        const int ck = tid & 15, ch = h * 128 + ck * 8, tr = (tid >> 4) * RUN;
        const float* cw = P.lru_conv + (size_t)l * 4096 + ch; const float* cb = P.lru_conv_b + l * 1024 + ch;
        bf16x8 xr[RUN + 3];
#pragma unroll
        for (int i = 0; i < RUN + 3; ++i) { const int tt = t0 + tr + i - 2; xr[i] = (bf16x8){0, 0, 0, 0, 0, 0, 0, 0};
            if (tt >= 0 && tt < T) xr[i] = *(const bf16x8*)(XA + (size_t)(row0 + tt) * 1024 + ch); }
        float wk[4][8], bk[8];
#pragma unroll
        for (int e = 0; e < 8; ++e) { bk[e] = cb[e];
#pragma unroll
            for (int k = 0; k < 4; ++k) wk[k][e] = cw[k * 1024 + e]; }
        __syncthreads();
#pragma unroll
        for (int i = 0; i < RUN; ++i) {
            float a8[8];
#pragma unroll
            for (int e = 0; e < 8; ++e) { a8[e] = bk[e];
#pragma unroll
                for (int k = 0; k < 4; ++k) a8[e] += wk[k][e] * bf2f((unsigned short)xr[i + k][e]); }
            u32x4 o; o.x = pack2(a8[0], a8[1]); o.y = pack2(a8[2], a8[3]); o.z = pack2(a8[4], a8[5]); o.w = pack2(a8[6], a8[7]);
            *(LAS u32x4*)(lds + (tr + i) * 272 + ck * 16) = o;
        }
    }
    __syncthreads();
    lru_dir<MODE, 0, NSC>(P, l, s, cchunk, h, lds, w, fr, fq);
    lru_dir<MODE, 1, NSC>(P, l, s, cchunk, h, lds, w, fr, fq);
    if (MODE == 0) {
        bf16_t* YA = (bf16_t*)(P.ws + OFF_YA);
        __syncthreads();
#pragma unroll
        for (int it = 0; it < 2 * NSC; ++it) { const int t = (tid >> 4) + it * 32, ck = tid & 15;
            const u32x4 v = *(const LAS u32x4*)(lds + YT_OFF + t * 272 + ck * 16);
            *(u32x4*)(YA + (size_t)(row0 + t0 + t) * 1024 + h * 128 + ck * 8) = v; }
    }
}

#define XB_TMO      128
#define XB_XCNT(j)  (256  + 64 * (j))
#define XB_XSUB(j)  (1280 + 64 * (j))
#define XB_XGEN(j)  (2304 + 64 * (j))
#define XB_TOP      3328
#define XB_TOPGEN   3392
#define XCD_BAR_WORDS 3456
#define XB_SPIN_CAP (1u << 18)
__device__ __forceinline__ unsigned xb_ld(unsigned* p)              { return __hip_atomic_load(p, __ATOMIC_RELAXED, __HIP_MEMORY_SCOPE_AGENT); }
__device__ __forceinline__ unsigned xb_add(unsigned* p, unsigned v) { return __hip_atomic_fetch_add(p, v, __ATOMIC_RELAXED, __HIP_MEMORY_SCOPE_AGENT); }
__device__ __forceinline__ unsigned xb_xcc_id() { return (unsigned)__builtin_amdgcn_s_getreg((3 << 11) | 20) & 0xFu; }
#define XB_SPIN(cond, bar) do { unsigned _sp = 0; while (cond) { __builtin_amdgcn_s_sleep(1); \
    if ((++_sp & 255u) == 0u) { if (xb_ld(&(bar)[XB_TMO])) break; if (_sp > XB_SPIN_CAP) { atomicAdd(&(bar)[XB_TMO], 1u); break; } } } } while (0)
struct XcdBarrier { unsigned* bar; unsigned x; volatile LAS unsigned* st; };
__device__ __forceinline__ XcdBarrier xcd_barrier_post(unsigned* bar, volatile LAS unsigned* st) {
    XcdBarrier b; b.bar = bar; b.x = xb_xcc_id(); b.st = st;
    if (threadIdx.x == 0) (void)xb_add(&bar[XB_XCNT(b.x)], 1u);
    return b;
}
__device__ __forceinline__ void xcd_barrier_complete(unsigned* bar, unsigned x, unsigned& nloc, unsigned& nx) {
    const unsigned G = gridDim.x * gridDim.y * gridDim.z;
    unsigned sum, cnt, mine, sp = 0u;
    for (;;) {
        sum = 0u; cnt = 0u; mine = 0u;
#pragma unroll
        for (unsigned j = 0; j < 16; ++j) { const unsigned c = xb_ld(&bar[XB_XCNT(j)]); sum += c; cnt += (c > 0u) ? 1u : 0u; mine = (j == x) ? c : mine; }
        if (sum == G) break;
        __builtin_amdgcn_s_sleep(1);
        if ((++sp & 255u) == 0u) { if (xb_ld(&bar[XB_TMO])) break; if (sp > XB_SPIN_CAP) { atomicAdd(&bar[XB_TMO], 1u); break; } }
    }
    nloc = mine > 0u ? mine : 1u; nx = cnt > 0u ? cnt : 1u;
}
__device__ __noinline__ void xcd_barrier_(unsigned* bbar, unsigned bx, volatile LAS unsigned* bst) {
    XcdBarrier b; b.bar = bbar; b.x = bx; b.st = bst;
    asm volatile("s_waitcnt vmcnt(0)" ::: "memory");
    __syncthreads();
    if (threadIdx.x == 0) {
        unsigned* bar = b.bar;
        __builtin_amdgcn_s_waitcnt(0);
        unsigned nloc = b.st[0], nx = b.st[1];
        if (nloc == 0u) { xcd_barrier_complete(bar, b.x, nloc, nx); b.st[0] = nloc; b.st[1] = nx; }
        const unsigned old = xb_add(&bar[XB_XSUB(b.x)], 1u);
        const unsigned gen = old / nloc;
        if (old + 1u == (gen + 1u) * nloc) {
            __builtin_amdgcn_fence(__ATOMIC_RELEASE, "agent");
            asm volatile("s_waitcnt vmcnt(0)" ::: "memory");
            const unsigned og = xb_add(&bar[XB_TOP], 1u);
            const unsigned tg = og / nx;
            if (og + 1u == (tg + 1u) * nx) xb_add(&bar[XB_TOPGEN], 1u);
            else XB_SPIN(xb_ld(&bar[XB_TOPGEN]) == tg, bar);
            __builtin_amdgcn_fence(__ATOMIC_ACQUIRE, "agent");
            xb_add(&bar[XB_XGEN(b.x)], 1u);
            asm volatile("s_waitcnt vmcnt(0)" ::: "memory");
        } else {
            XB_SPIN(xb_ld(&bar[XB_XGEN(b.x)]) == gen, bar);
            __builtin_amdgcn_fence(__ATOMIC_ACQUIRE, "agent");
            asm volatile("s_waitcnt vmcnt(0)" ::: "memory");
        }
    }
    __syncthreads();
}

#ifndef REPMASK
#define REPMASK 0
#endif
#define REPLOOP(i) _Pragma("unroll 1") for (int rep_ = 0; rep_ < 1 + ((REPMASK >> (i)) & 1); ++rep_)
__global__ __launch_bounds__(512, 2) void mega(Params P) {
    extern __shared__ __attribute__((aligned(16))) unsigned char shm[];
    LAS unsigned char* lds = (LAS unsigned char*)shm;
    cg::grid_group grid = cg::this_grid();
    if (threadIdx.x == 0) *(LAS u32x4*)(lds + 147456) = (u32x4){0u, 0u, 0u, 0u};
    __syncthreads();
    const XcdBarrier xb = xcd_barrier_post((unsigned*)(P.ws + OFF_BAR), (volatile LAS unsigned*)(lds + 147456));
    const int G = gridDim.x, c = blockIdx.x;
    unsigned char* ws = P.ws;
    float* X = P.out;
    bf16_t* H = (bf16_t*)(ws + OFF_H);
    const float* MOD = (const float*)(ws + OFF_MOD);

    REPLOOP(12) phase0(P, lds);
    if (gridDim.x == 0x7fffffffu) grid.sync();
    REPLOOP(11) xcd_barrier_(xb.bar, xb.x, xb.st);
    for (int l = 0; l < 2; ++l) {
        const float* mod = MOD + (size_t)l * 3 * 6144;
        const bool hide = (G == 256);
        { const int te = hide ? (l == 0 ? 1856 : 0) : 4992; if (te > 0) convert_weights(P, l, lds, 0, te, c, G); }
        const float* xa0 = l == 0 ? P.x_prompt : X; const float* xb0 = l == 0 ? P.x_sample : X + (size_t)MCTX * 1024;
        REPLOOP(1) norm_phase(xa0, xb0, P.norm1 + l * 1024, mod, 0, 1024, H);
        REPLOOP(11) xcd_barrier_(xb.bar, xb.x, xb.st);
        REPLOOP(2) { Sched S{(const char*)H, (const char*)(ws + OFF_WIN), 1024, 1024, 0, 48, 14, G, c, 256};
          EpiIn E{(bf16_t*)(ws + OFF_XAQ), (bf16_t*)(ws + OFF_XC), (bf16_t*)(ws + OFF_KB), (bf16_t*)(ws + OFF_VB), P.out + OUT_K, P.out + OUT_V, (const float*)(ws + OFF_ROPE), l};
          gemm_phase(lds, S, 1024, E); }
        if (hide && l == 0 && c >= 160) convert_weights(P, l, lds, 1856, 2624, c - 160, G - 160);
        REPLOOP(11) xcd_barrier_(xb.bar, xb.x, xb.st);
        REPLOOP(3) pool_phase((const bf16_t*)(ws + OFF_XC), (bf16_t*)(ws + OFF_PL));
        for (int it = c; it < 1280; it += G) {
            if (it < 256) { REPLOOP(4) attn_unit(P, l, it, lds); }
            else if (it < 512) { const int v = it - 256; REPLOOP(5) lru_unit<0, 4>(P, l, v >> 3, 0, v & 7, lds); }
            else if (it < 768) { const int q = it - 512; REPLOOP(5) lru_unit<1, 2>(P, l, 32 + (q >> 7), (q >> 3) & 15, q & 7, lds); }
            else { REPLOOP(7) attn_unit(P, l, it - 768 + 256, lds); }
        }
        REPLOOP(11) xcd_barrier_(xb.bar, xb.x, xb.st);
        { Sched S{(const char*)(ws + OFF_PL), (const char*)(ws + OFF_PW), 1024, 256, 256, 48, 4, G, c, 256};
          EpiPool E{(bf16_t*)(ws + OFF_XC), P.pool_scale + l * 1024};
          gemm_phase(lds, S, 256, E); }
#ifndef NO_LRU
        for (int it = G - 1 - c; it < 256; it += G) lru_unit<0, 2>(P, l, 32 + (it >> 7), (it >> 3) & 15, it & 7, lds);
#endif
        REPLOOP(11) xcd_barrier_(xb.bar, xb.x, xb.st);
        { unsigned* mflags = (unsigned*)(ws + OFF_BAR) + 3500 + l * 192;
          MergeSched S{(const char*)ws, 1024, 1024, c, c >= 192};
          EpiMerge E{(bf16_t*)(ws + OFF_GT), P.b_gate + l * 3072, (float*)(ws + OFF_XAQ), (bf16_t*)(ws + OFF_PL), mflags};
          gemm_phase(lds, S, 1024, E); }
        if (hide && c >= 192) convert_weights(P, l, lds, 2624, 4992, c - 192, G - 192);
        REPLOOP(11) xcd_barrier_(xb.bar, xb.x, xb.st);
        { Sched S{(const char*)(ws + OFF_PL), (const char*)(ws + OFF_WOUT), 1024, 1024, 0, 64, 4, G, c, 192};
          EpiRes E{X, mod, 2048, xa0, xb0};
          gemm_phase<EpiRes, Sched, true>(lds, S, 1024, E); }
        REPLOOP(11) xcd_barrier_(xb.bar, xb.x, xb.st);
        norm_phase(X, X + (size_t)MCTX * 1024, P.norm2 + l * 1024, mod, 3072, 4096, H);
        REPLOOP(11) xcd_barrier_(xb.bar, xb.x, xb.st);
        REPLOOP(9) { Sched S{(const char*)H, (const char*)(ws + OFF_WUP), 1024, 1024, 0, 48, 22, G, c, 256};
          EpiUp E{(bf16_t*)(ws + OFF_ACT), (bf16_t*)(ws + OFF_SU), (bf16_t*)(ws + OFF_SV), P.ffn_conv + (size_t)l * 3 * 2816, P.ffn_conv_b + l * 2816};
          gemm_phase(lds, S, 1024, E); }
        if (hide && l == 0 && c >= 32) convert_weights(P, l + 1, lds, 0, 2624, c - 32, G - 32);
        REPLOOP(11) xcd_barrier_(xb.bar, xb.x, xb.st);
        { Sched S{(const char*)(ws + OFF_ACT), (const char*)(ws + OFF_WDN), 2816, 2816, 0, 64, 4, G, c, 192};
          { Unit uu; for (int i = 0; S.next(i, uu); ++i) ffn_fix_groups((const bf16_t*)(ws + OFF_SU), (const bf16_t*)(ws + OFF_SV), (bf16_t*)(ws + OFF_ACT), P.ffn_conv + (size_t)l * 3 * 2816, P.ffn_conv_b + l * 2816, uu.row0 >> 6, 3);
            asm volatile("s_waitcnt vmcnt(0)" ::: "memory"); __syncthreads(); }
          EpiRes E{X, mod, 5120, X, X + (size_t)MCTX * 1024};
          gemm_phase<EpiRes, Sched, true>(lds, S, 2816, E); }
        REPLOOP(11) xcd_barrier_(xb.bar, xb.x, xb.st);
    }
    final_norm_phase(X, P.final_norm);
}

extern "C" void kernel_launch(void* const* d_in, const int* in_sizes, int n_in, void* d_out, int out_size, void* d_ws, size_t ws_size, hipStream_t stream) {
    constexpr size_t kDynLds = 147456 + 16;
    static int grid_blocks = 0;
    if (!grid_blocks) {
        int dev = 0, cus = 0, per_cu = 0;
        hipGetDevice(&dev);
        hipDeviceGetAttribute(&cus, hipDeviceAttributeMultiprocessorCount, dev);
        hipFuncSetAttribute((const void*)mega, hipFuncAttributeMaxDynamicSharedMemorySize, (int)kDynLds);
        hipOccupancyMaxActiveBlocksPerMultiprocessor(&per_cu, mega, 512, kDynLds);
        if (per_cu < 1) per_cu = 1;
        if (per_cu > 1) per_cu = 1;
        grid_blocks = cus * per_cu;
    }
    Params p{};
    const float** pp = (const float**)&p;
    for (int i = 0; i < 30; ++i) pp[i] = (const float*)d_in[i];
    p.out = (float*)d_out; p.ws = (unsigned char*)d_ws;
    if (ws_size < OFF_END2 + 262144) { fprintf(stderr, "workspace too small: %zu < %zu\n", ws_size, (size_t)OFF_END2 + 262144); }
    hipMemsetAsync((unsigned char*)d_ws + OFF_BAR, 0, 16384, stream);
    void* args[] = {&p};
    hipError_t e = hipLaunchCooperativeKernel((void*)mega, dim3(grid_blocks), dim3(512), args, kDynLds, stream);
    if (e != hipSuccess) fprintf(stderr, "cooperative launch failed: %s (grid %d)\n", hipGetErrorString(e), grid_blocks);
}
```

```cpp
#include <hip/hip_runtime.h>
#include <hip/hip_cooperative_groups.h>
#include <cstdio>
namespace cg = cooperative_groups;

#define LAS __attribute__((address_space(3)))
typedef unsigned short bf16_t;
typedef short bf16x8 __attribute__((ext_vector_type(8)));
typedef float f32x4 __attribute__((ext_vector_type(4)));
typedef unsigned u32x4 __attribute__((ext_vector_type(4)));
typedef unsigned u32x2 __attribute__((ext_vector_type(2)));
typedef short bf16x4 __attribute__((ext_vector_type(4)));

constexpr int MROWS = 12288, MCTX = 8192;
constexpr size_t S24 = (size_t)MROWS * 1024 * 2;
constexpr size_t OFF_WIN = 0;
constexpr size_t OFF_WBR = OFF_WIN + (size_t)6656 * 1024 * 2;
constexpr size_t OFF_WOUT = OFF_WBR + (size_t)3 * 1024 * 1024 * 2;
constexpr size_t OFF_WUP = OFF_WOUT + (size_t)1024 * 1024 * 2;
constexpr size_t OFF_WDN = OFF_WUP + (size_t)5632 * 1024 * 2;
constexpr size_t OFF_GW = OFF_WDN + (size_t)1024 * 2816 * 2;
constexpr size_t OFF_PW = OFF_GW + (size_t)2 * 8 * 256 * 128 * 2;
constexpr size_t OFF_MOD = OFF_PW + (size_t)4 * 256 * 256 * 2;
constexpr size_t OFF_CK = OFF_MOD + (size_t)2 * 3 * 6144 * 4;
constexpr size_t OFF_CV = OFF_CK + (size_t)2 * 2 * 512 * 256 * 2;
constexpr size_t OFF_ROPE = OFF_CV + (size_t)2 * 2 * 512 * 256 * 2;
constexpr size_t OFF_SUMM = OFF_ROPE + (size_t)2 * 64 * 32 * 4;
constexpr size_t OFF_BAR = OFF_SUMM + (size_t)2 * 2 * 16 * 1024 * 2 * 4;
constexpr size_t OFF_ACT0 = OFF_BAR + 16384;
constexpr size_t OFF_XAQ = OFF_ACT0;
constexpr size_t OFF_XC = OFF_XAQ + 2 * S24;
constexpr size_t OFF_KB = OFF_XC + S24;
constexpr size_t OFF_VB = OFF_KB + (size_t)MROWS * 256 * 2;
constexpr size_t OFF_GT = OFF_VB + (size_t)MROWS * 256 * 2;
constexpr size_t OFF_YB = OFF_GT + S24;
constexpr size_t OFF_PL = OFF_YB + S24;
constexpr size_t OFF_YA = OFF_PL + S24;
constexpr size_t OFF_H = OFF_YA + S24;
constexpr size_t OFF_END = OFF_H + S24;
constexpr size_t OFF_ACT = OFF_XAQ;
constexpr size_t OFF_SU = OFF_END;
constexpr size_t OFF_SV = OFF_SU + (size_t)192 * 4 * 2816 * 2;
constexpr size_t OFF_END2 = OFF_SV + (size_t)192 * 2 * 2816 * 2;
constexpr size_t OUT_K = (size_t)MROWS * 1024;
constexpr size_t OUT_V = OUT_K + (size_t)32 * 2 * 256 * 256;
constexpr size_t OUT_H = OUT_V + (size_t)32 * 2 * 256 * 256;

struct Params {
    const float *x_prompt, *x_sample, *cache_k, *cache_v, *state_lru, *c, *c_ctx, *w_ada, *b_ada, *norm1, *norm2,
        *w_in, *b_gate, *lru_conv, *lru_conv_b, *lru_wa, *lru_ba, *lru_wx, *lru_bx, *lru_lambda, *attn_sink,
        *pool_w, *pool_scale, *w_branch, *w_out, *ffn_up, *ffn_conv, *ffn_conv_b, *ffn_down, *final_norm;
    float* out; unsigned char* ws;
};

typedef float f32x2_ __attribute__((ext_vector_type(2)));
typedef __bf16 bf16x2_ __attribute__((ext_vector_type(2)));
__device__ __forceinline__ unsigned pack2(float a, float b) { const f32x2_ v = {a, b}; const bf16x2_ r = __builtin_convertvector(v, bf16x2_); return __builtin_bit_cast(unsigned, r); }
__device__ __forceinline__ unsigned short f2bf(float f) { return (unsigned short)(pack2(f, f) & 0xffffu); }
__device__ __forceinline__ float bf2f(unsigned short b) { return __uint_as_float(((unsigned)b) << 16); }
__device__ __forceinline__ int otid() { int t = threadIdx.x; asm volatile("" : "+v"(t)); return t; }
__device__ __forceinline__ float sigmoidf_(float x) { return __builtin_amdgcn_rcpf(1.0f + __expf(-x)); }

constexpr int HTB = 128 * 64 * 2;
__device__ __forceinline__ int lds_byte(int r, int c) { const int st = (r >> 4) * 2 + (c >> 5), rr = r & 15, cc = c & 31, ob = rr * 64 + cc * 2; return st * 1024 + (ob ^ (((ob >> 9) & 1) << 5)); }
__device__ __forceinline__ void stage_rc(int b, int& R, int& C) { const int st = b / 1024, sb = b % 1024, swz = sb ^ (((sb >> 9) & 1) << 5); R = (st >> 1) * 16 + swz / 64; C = (st & 1) * 32 + (swz % 64) / 2; }

struct Unit { const char* a; const char* b; int pm, pn, z, row0, m192; };
struct Sched {
    const char* A; const char* B; int lda, ldb, acol, nM, nN, G, c, tm;
    __device__ __forceinline__ bool next(int i, Unit& u) const {
        const long L = (long)i * G + c; const int nwg = nM * nN; if (L >= nwg) return false;
        int wgid = (int)L; { const int q = nwg / 8, r = nwg % 8, xcd = wgid % 8, off = wgid / 8; wgid = (xcd < r ? xcd * (q + 1) : r * (q + 1) + (xcd - r) * q) + off; }
        const int nig = 8 * nN, gid = wgid / nig, fm = gid * 8, gsz = (nM - fm) < 8 ? (nM - fm) : 8;
        u.pm = fm + ((wgid % nig) % gsz); u.pn = (wgid % nig) / gsz;
        u.a = A + ((size_t)u.pm * tm * lda + (size_t)u.pn * acol) * 2; u.b = B + (size_t)u.pn * 256 * ldb * 2; u.z = 0; u.row0 = u.pm * tm; u.m192 = (tm == 192); return true;
    }
};
struct MergeSched {
    const char* ws; int lda, ldb, c; bool helper;
    __device__ __forceinline__ bool next(int i, Unit& u) const {
        int owner, z; int c = this->c; asm volatile("" : "+s"(c));
        if (!helper) { if (c >= 192 || i >= 5) return false; owner = c; z = i < 4 ? i : 5; }
        else { const int hi = c - 192; if (hi < 0 || hi >= 64 || i >= 3) return false; owner = hi + 64 * i; z = 4; }
        const int nN = 4;
        int wgid = owner; { const int q = 24, xcd = wgid % 8, off = wgid / 8; wgid = xcd * q + off; }
        const int nig = 8 * nN, gid = wgid / nig, fm = gid * 8;
        u.pm = fm + ((wgid % nig) % 8); u.pn = (wgid % nig) / 8; u.z = z; u.row0 = u.pm * 256; u.m192 = 0;
        const int j = z >> 1;
        const size_t aoff = (size_t)u.row0 * 1024 * 2;
        size_t ao = OFF_H, bo = OFF_WIN + (size_t)3584 * 1024 * 2;
        if (z & 1) { bo = OFF_WBR; ao = OFF_YA; if (j == 1) ao = OFF_YB; if (j == 2) ao = OFF_XC; }
        u.a = ws + ao + aoff; u.b = ws + bo + ((size_t)j * 1024 + (size_t)u.pn * 256) * 1024 * 2;
        return true;
    }
};

template <class Epi, class SchedT, bool M192 = false>
__device__ __forceinline__ void gemm_phase(LAS unsigned char* lds, const SchedT& S, const int K_, const Epi& E) {
    int K = K_; asm volatile("" : "+s"(K));
    int tid_ = threadIdx.x; asm volatile("" : "+v"(tid_));
    const int tid = tid_, wid = __builtin_amdgcn_readfirstlane(tid >> 6), lane = tid & 63, wr = wid >> 2, wc = wid & 3, fr = lane & 15, fq = lane >> 4;
    const int nt = K / 64;
    unsigned voffA[2], voffB[2];
#pragma unroll
    for (int i = 0; i < 2; ++i) { int R, C; stage_rc(tid * 16 + i * 8192, R, C); voffA[i] = (unsigned)(R * S.lda + C) * 2u; voffB[i] = (unsigned)(R * S.ldb + C) * 2u; }
    const size_t kstep = 128;
    const size_t hstepA = (size_t)128 * S.lda * 2, hstepB = (size_t)128 * S.ldb * 2;
    const unsigned ldsw = (unsigned)wid * 1024u;
    const int aoff = lds_byte(wr * 64 + fr, fq * 8), boff = lds_byte(wc * 32 + fr, fq * 8);
#define G_SA(b, h) (((b) * 2 + (h)) * HTB)
#define G_SB(b, h) ((4 + (b) * 2 + (h)) * HTB)
#define G_STAGE(bufoff, gbase, voff) do { _Pragma("unroll") for (int _i = 0; _i < 2; ++_i) \
        __builtin_amdgcn_global_load_lds((const unsigned*)((const char*)(gbase) + (voff)[_i]), (LAS unsigned*)(lds + (bufoff) + ldsw + _i * 8192), 16, 0, 0); } while (0)
#define G_LDA(dst, b, h) do { _Pragma("unroll") for (int m = 0; m < 4; ++m) _Pragma("unroll") for (int k = 0; k < 2; ++k) dst[m][k] = *(const LAS bf16x8*)(lds + G_SA(b, h) + aoff + m * 2048 + k * 1024); } while (0)
#define G_LDB(dst, b, h) do { _Pragma("unroll") for (int n = 0; n < 2; ++n) _Pragma("unroll") for (int k = 0; k < 2; ++k) dst[n][k] = *(const LAS bf16x8*)(lds + G_SB(b, h) + boff + n * 2048 + k * 1024); } while (0)
#define G_MMA(ai, bj, At, Bt) do { if (M192 && (ai) == 1 && wr == 1) break; __builtin_amdgcn_s_setprio(1); _Pragma("unroll") for (int m = 0; m < 4; ++m) _Pragma("unroll") for (int n = 0; n < 2; ++n) _Pragma("unroll") for (int k = 0; k < 2; ++k) \
        acc[ai][bj][m][n] = __builtin_amdgcn_mfma_f32_16x16x32_bf16(Bt[n][k], At[m][k], acc[ai][bj][m][n], 0, 0, 0); __builtin_amdgcn_s_setprio(0); } while (0)
#define G_WAIT_V(n) asm volatile("s_waitcnt vmcnt(" #n ")" ::: "memory")
#define G_WAIT_L(n) asm volatile("s_waitcnt lgkmcnt(" #n ")" ::: "memory")
#define G_BAR __builtin_amdgcn_s_barrier()
#define G_SCHED __builtin_amdgcn_sched_barrier(0)
    Unit cur, nxt; int ui = 0;
    if (!S.next(0, cur)) return;
    f32x4 acc[2][2][4][2];
#pragma unroll
    for (int a = 0; a < 2; ++a)
#pragma unroll
        for (int b = 0; b < 2; ++b)
#pragma unroll
            for (int m = 0; m < 4; ++m)
#pragma unroll
                for (int n = 0; n < 2; ++n) acc[a][b][m][n] = (f32x4){0.f, 0.f, 0.f, 0.f};
    bf16x8 At[4][2], B0[2][2], B1[2][2];
    const char* cA = cur.a; const char* cB = cur.b;
    G_STAGE(G_SB(0, 0), cB, voffB); G_STAGE(G_SA(0, 0), cA, voffA); G_STAGE(G_SB(0, 1), cB + hstepB, voffB); G_STAGE(G_SA(0, 1), cA + hstepA, voffA);
    if (wr == 1) G_BAR;
    G_WAIT_V(4); G_BAR;
    G_STAGE(G_SB(1, 0), cB + kstep, voffB); G_STAGE(G_SA(1, 0), cA + kstep, voffA); G_STAGE(G_SB(1, 1), cB + hstepB + kstep, voffB);
    G_WAIT_V(6); G_BAR;
    for (;;) {
        const bool has_next = S.next(ui + 1, nxt);
        const char* nA = has_next ? nxt.a : cA; const char* nB = has_next ? nxt.b : cB;
        for (int t = 0; t < nt; t += 2) {
            const bool last = (t == nt - 2);
            const char* a1 = cA + (size_t)(t + 1) * kstep;
            const char* a2 = last ? nA : cA + (size_t)(t + 2) * kstep; const char* b2 = last ? nB : cB + (size_t)(t + 2) * kstep;
            const char* a3 = a2 + kstep; const char* b3 = b2 + kstep;
            G_LDB(B0, 0, 0); G_SCHED; G_LDA(At, 0, 0); G_STAGE(G_SA(1, 1), a1 + hstepA, voffA);
            G_WAIT_L(8); G_BAR; G_WAIT_L(0); G_MMA(0, 0, At, B0); G_BAR; G_SCHED;
            G_LDB(B1, 0, 1); G_STAGE(G_SB(0, 0), b2, voffB);
            G_BAR; G_WAIT_L(0); G_MMA(0, 1, At, B1); G_BAR;
            G_LDA(At, 0, 1); G_STAGE(G_SA(0, 0), a2, voffA);
            G_BAR; G_WAIT_L(0); G_MMA(1, 0, At, B0); G_BAR; G_SCHED;
            G_STAGE(G_SB(0, 1), b2 + hstepB, voffB);
            G_WAIT_V(6); G_BAR; G_MMA(1, 1, At, B1); G_BAR;
            G_LDB(B0, 1, 0); G_SCHED; G_LDA(At, 1, 0); G_STAGE(G_SA(0, 1), a2 + hstepA, voffA);
            G_WAIT_L(8); G_BAR; G_WAIT_L(0); G_MMA(0, 0, At, B0); G_BAR; G_SCHED;
            G_LDB(B1, 1, 1); G_STAGE(G_SB(1, 0), b3, voffB);
            G_BAR; G_WAIT_L(0); G_MMA(0, 1, At, B1); G_BAR;
            G_LDA(At, 1, 1); G_STAGE(G_SA(1, 0), a3, voffA);
            G_BAR; G_WAIT_L(0); G_MMA(1, 0, At, B0); G_BAR; G_SCHED;
            G_STAGE(G_SB(1, 1), b3 + hstepB, voffB);
            G_WAIT_V(6); G_BAR; G_MMA(1, 1, At, B1); G_BAR;
        }
        E(acc, cur, wr, wc, fr, fq);
        if (!has_next) break;
#pragma unroll
        for (int a = 0; a < 2; ++a)
#pragma unroll
            for (int b = 0; b < 2; ++b)
#pragma unroll
                for (int m = 0; m < 4; ++m)
#pragma unroll
                    for (int n = 0; n < 2; ++n) acc[a][b][m][n] = (f32x4){0.f, 0.f, 0.f, 0.f};
        cur = nxt; cA = nA; cB = nB; ++ui;
    }
    G_WAIT_V(0);
    if (wr == 0) G_BAR;
    G_BAR;
#undef G_SA
#undef G_SB
#undef G_STAGE
#undef G_LDA
#undef G_LDB
#undef G_MMA
#undef G_WAIT_V
#undef G_WAIT_L
#undef G_BAR
#undef G_SCHED
}

#define EPI_LOOP_BEGIN \
    _Pragma("unroll") for (int ai = 0; ai < 2; ++ai) _Pragma("unroll") for (int m = 0; m < 4; ++m) { const int row = u.pm * 256 + wr * 64 + fr + ai * 128 + m * 16; \
    _Pragma("unroll") for (int bj = 0; bj < 2; ++bj) _Pragma("unroll") for (int n = 0; n < 2; ++n) { const int cl = wc * 32 + 4 * fq + bj * 128 + n * 16; const f32x4 v = acc[ai][bj][m][n];
#define EPI_LOOP_END } }

__device__ __forceinline__ int seq_group(int row) { return row < MCTX ? 0 : 1 + ((row - MCTX) >> 11); }

struct EpiIn {
    bf16_t* xaq; bf16_t* xc; bf16_t* kb; bf16_t* vb; float* outk; float* outv; const float* rc; int l;
    __device__ __forceinline__ void operator()(const f32x4 (&acc)[2][2][4][2], const Unit& u, int wr, int wc, int fr, int fq) const {
        const int pn = u.pn; const bool qk = pn >= 4 && pn <= 8;
        bf16_t* dst; int ld, cbase; float* fo = nullptr;
        if (pn < 4) { dst = xaq; ld = 1024; cbase = pn * 256; }
        else if (pn < 8) { dst = xaq + (size_t)MROWS * 1024; ld = 1024; cbase = pn * 256 - 1024; }
        else if (pn == 8) { dst = kb; ld = 256; cbase = 0; fo = outk; }
        else if (pn == 9) { dst = vb; ld = 256; cbase = 0; fo = outv; }
        else { dst = xc; ld = 1024; cbase = pn * 256 - 2560; }
        const int hh = wc >> 1, i0 = 16 * (wc & 1) + 4 * fq;
        const int c1 = cbase + (qk ? 64 * hh + i0 : wc * 32 + 4 * fq), dc = qk ? 32 : 16;
        const bool rope = qk && u.pm >= 32;
#pragma unroll
        for (int ai = 0; ai < 2; ++ai) {
            f32x4 csm[4], snm[4];
#pragma unroll
            for (int m = 0; m < 4; ++m) { csm[m] = (f32x4){1.f, 1.f, 1.f, 1.f}; snm[m] = (f32x4){0.f, 0.f, 0.f, 0.f};
                if (rope) { const int row = u.pm * 256 + wr * 64 + fr + ai * 128 + m * 16; const int t = (row - MCTX) & 2047; const int pos = hh == 0 ? (t >> 6) : (t & 63);
                    csm[m] = *(const f32x4*)(rc + pos * 32 + i0); snm[m] = *(const f32x4*)(rc + 2048 + pos * 32 + i0); } }
#pragma unroll
            for (int m = 0; m < 4; ++m) {
                const int row = u.pm * 256 + wr * 64 + fr + ai * 128 + m * 16;
                const f32x4 cs = csm[m], sn = snm[m];
                bf16_t* dp = dst + (size_t)row * ld + c1;
                float* fp = fo + ((size_t)(((row >> 8) * 2 + l) * 256 + (row & 255))) * 256 + c1;
#pragma unroll
                for (int bj = 0; bj < 2; ++bj) {
                    const f32x4 x1 = acc[ai][bj][m][0], x2 = acc[ai][bj][m][1];
                    const f32x4 o1 = x1 * cs - x2 * sn, o2 = x1 * sn + x2 * cs;
                    uint2 p1, p2; p1.x = pack2(o1[0], o1[1]); p1.y = pack2(o1[2], o1[3]); p2.x = pack2(o2[0], o2[1]); p2.y = pack2(o2[2], o2[3]);
                    *(uint2*)(dp + bj * 128) = p1; *(uint2*)(dp + bj * 128 + dc) = p2;
                    if (fo != nullptr && row < MCTX) { *(f32x4*)(fp + bj * 128) = o1; *(f32x4*)(fp + bj * 128 + dc) = o2; }
                }
            }
        }
    }
};
struct EpiGate {
    bf16_t* gt; const float* bias;
    __device__ __forceinline__ void operator()(const f32x4 (&acc)[2][2][4][2], const Unit& u, int wr, int wc, int fr, int fq) const {
        const int c0 = u.pn * 256 + wc * 32 + 4 * fq;
        f32x4 bb[4];
#pragma unroll
        for (int g = 0; g < 4; ++g) bb[g] = *(const f32x4*)(bias + c0 + (g >> 1) * 128 + (g & 1) * 16);
#pragma unroll
        for (int ai = 0; ai < 2; ++ai) { if (ai == 1 && u.m192 && wr == 1) continue;
#pragma unroll
            for (int m = 0; m < 4; ++m) { const int row = u.row0 + wr * 64 + fr + ai * 128 + m * 16;
#pragma unroll
                for (int g = 0; g < 4; ++g) { const f32x4 v = acc[ai][g >> 1][m][g & 1];
                    uint2 pk; pk.x = pack2(sigmoidf_(v[0] + bb[g][0]), sigmoidf_(v[1] + bb[g][1])); pk.y = pack2(sigmoidf_(v[2] + bb[g][2]), sigmoidf_(v[3] + bb[g][3]));
                    *(uint2*)(gt + (size_t)row * 1024 + c0 + (g >> 1) * 128 + (g & 1) * 16) = pk; } } }
    }
};
template <int j> struct EpiBranch {
    const bf16_t* gt; float* tmp; bf16_t* mg;
    __device__ __forceinline__ void operator()(const f32x4 (&acc)[2][2][4][2], const Unit& u, int wr, int wc, int fr, int fq) const {
        const int c0 = u.pn * 256 + wc * 32 + 4 * fq;
#pragma unroll
        for (int ai = 0; ai < 2; ++ai) { if (ai == 1 && u.m192 && wr == 1) continue;
#pragma unroll
            for (int m = 0; m < 4; ++m) {
                const unsigned ro = (unsigned)(u.row0 + wr * 64 + fr + ai * 128 + m * 16) * 1024u + (unsigned)c0;
                uint2 gp[4]; f32x4 tv[4];
#pragma unroll
                for (int g = 0; g < 4; ++g) { const unsigned o = ro + (g >> 1) * 128 + (g & 1) * 16;
                    gp[g] = *(const uint2*)(gt + o); tv[g] = (f32x4){0.f, 0.f, 0.f, 0.f}; if (j != 0) tv[g] = *(const f32x4*)(tmp + o); }
#pragma unroll
                for (int g = 0; g < 4; ++g) { const unsigned o = ro + (g >> 1) * 128 + (g & 1) * 16;
                    const f32x4 v = acc[ai][g >> 1][m][g & 1];
                    f32x4 r = tv[g];
                    r[0] += v[0] * bf2f((unsigned short)(gp[g].x & 0xffff)); r[1] += v[1] * bf2f((unsigned short)(gp[g].x >> 16));
                    r[2] += v[2] * bf2f((unsigned short)(gp[g].y & 0xffff)); r[3] += v[3] * bf2f((unsigned short)(gp[g].y >> 16));
                    if (j != 2) *(f32x4*)(tmp + o) = r;
                    else { uint2 pk; pk.x = pack2(r[0], r[1]); pk.y = pack2(r[2], r[3]); *(uint2*)(mg + o) = pk; } }
            } }
    }
};
struct EpiMerge {
    bf16_t* gt; const float* bgate; float* tmp; bf16_t* mg; unsigned* flags;
    __device__ __forceinline__ void operator()(const f32x4 (&acc)[2][2][4][2], const Unit& u, int wr, int wc, int fr, int fq) const {
        const int j = u.z >> 1;
        if ((u.z & 1) == 0) {
            EpiGate E{u.z == 4 ? mg : gt, bgate + j * 1024}; E(acc, u, wr, wc, fr, fq);
            if (u.z == 4) {
                asm volatile("s_waitcnt vmcnt(0)" ::: "memory");
                unsigned old_ = 0u;
                if (fr == 0 && fq == 0) old_ = __hip_atomic_fetch_add(flags + u.pm * 4 + u.pn, 1u, __ATOMIC_RELAXED, __HIP_MEMORY_SCOPE_AGENT);
                old_ = (unsigned)__builtin_amdgcn_readfirstlane(old_);
                if (old_ == 7u) {
                    __builtin_amdgcn_fence(__ATOMIC_RELEASE, "agent");
                    asm volatile("s_waitcnt vmcnt(0)" ::: "memory");
                    if (fr == 0 && fq == 0) __hip_atomic_fetch_add(flags + u.pm * 4 + u.pn, 256u, __ATOMIC_RELAXED, __HIP_MEMORY_SCOPE_AGENT);
                }
            }
        }
        else if (j == 0) { EpiBranch<0> E{gt, tmp, mg}; E(acc, u, wr, wc, fr, fq); }
        else if (j == 1) { EpiBranch<1> E{gt, tmp, mg}; E(acc, u, wr, wc, fr, fq); }
        else {
            { unsigned* f = flags + u.pm * 4 + u.pn; unsigned sp = 0;
              while ((unsigned)__builtin_amdgcn_readfirstlane(__hip_atomic_load(f, __ATOMIC_RELAXED, __HIP_MEMORY_SCOPE_AGENT)) < 256u) { __builtin_amdgcn_s_sleep(2); if (++sp > (1u << 20)) break; }
              __builtin_amdgcn_fence(__ATOMIC_ACQUIRE, "agent");
              asm volatile("s_waitcnt vmcnt(0)" ::: "memory"); }
            EpiBranch<2> E{mg, tmp, mg}; E(acc, u, wr, wc, fr, fq);
        }
    }
};
struct EpiRes {
    float* x; const float* mod; int goff; const float* xa; const float* xb;
    __device__ __forceinline__ const float* src(unsigned o) const { return o < (unsigned)MCTX * 1024u ? xa + o : xb + (o - (unsigned)MCTX * 1024u); }
    __device__ __forceinline__ void operator()(const f32x4 (&acc)[2][2][4][2], const Unit& u, int wr, int wc, int fr, int fq) const {
        const int c0 = u.pn * 256 + wc * 32 + 4 * fq;
        const int sg0 = seq_group(u.row0), sg1 = seq_group(u.row0 + (u.m192 ? 191 : 255));
        if (sg0 == sg1) {
            const float* gsrc = mod + sg0 * 6144 + goff;
            f32x4 gg[4];
#pragma unroll
            for (int g = 0; g < 4; ++g) gg[g] = *(const f32x4*)(gsrc + c0 + (g >> 1) * 128 + (g & 1) * 16);
#pragma unroll
            for (int ai = 0; ai < 2; ++ai) { if (ai == 1 && u.m192 && wr == 1) continue;
#pragma unroll
                for (int mp = 0; mp < 2; ++mp) {
                    const unsigned ro = (unsigned)(u.row0 + wr * 64 + fr + ai * 128 + mp * 32) * 1024u + (unsigned)c0;
                    f32x4 xv[8];
#pragma unroll
                    for (int k = 0; k < 8; ++k) { const int g = k & 3; xv[k] = *(const f32x4*)src(ro + (k >> 2) * 16384 + (g >> 1) * 128 + (g & 1) * 16); }
#pragma unroll
                    for (int k = 0; k < 8; ++k) { const int g = k & 3, m = mp * 2 + (k >> 2); *(f32x4*)(x + (ro + (k >> 2) * 16384 + (g >> 1) * 128 + (g & 1) * 16)) = xv[k] + gg[g] * acc[ai][g >> 1][m][g & 1]; }
                } }
        } else {
#pragma unroll
            for (int ai = 0; ai < 2; ++ai) { if (ai == 1 && u.m192 && wr == 1) continue;
#pragma unroll
                for (int m = 0; m < 4; ++m) {
                    const int row = u.row0 + wr * 64 + fr + ai * 128 + m * 16;
                    const float* gsrc = mod + seq_group(row) * 6144 + goff + c0;
                    const unsigned ro = (unsigned)row * 1024u + (unsigned)c0;
                    f32x4 xv[4], gv[4];
#pragma unroll
                    for (int g = 0; g < 4; ++g) { xv[g] = *(const f32x4*)src(ro + (g >> 1) * 128 + (g & 1) * 16); gv[g] = *(const f32x4*)(gsrc + (g >> 1) * 128 + (g & 1) * 16); }
#pragma unroll
                    for (int g = 0; g < 4; ++g) *(f32x4*)(x + (ro + (g >> 1) * 128 + (g & 1) * 16)) = xv[g] + gv[g] * acc[ai][g >> 1][m][g & 1];
                } }
        }
    }
};
struct EpiBf {
    bf16_t* dst; int ld;
    __device__ __forceinline__ void operator()(const f32x4 (&acc)[2][2][4][2], const Unit& u, int wr, int wc, int fr, int fq) const {
        EPI_LOOP_BEGIN
            const int col = u.pn * 256 + cl;
            uint2 pk; pk.x = pack2(v[0], v[1]); pk.y = pack2(v[2], v[3]);
            *(uint2*)(dst + (size_t)row * ld + col) = pk;
        EPI_LOOP_END
    }
};
__device__ __forceinline__ float dpp_f(float old, float src, const int ctrl_sel) {
    const int o = __float_as_int(old), v = __float_as_int(src);
    int r;
    if (ctrl_sel == 0) r = __builtin_amdgcn_update_dpp(o, v, 0x111, 0xf, 0xf, false);
    else if (ctrl_sel == 1) r = __builtin_amdgcn_update_dpp(o, v, 0x101, 0xf, 0xf, false);
    else if (ctrl_sel == 2) r = __builtin_amdgcn_update_dpp(o, v, 0x121, 0xf, 0xf, false);
    else r = __builtin_amdgcn_update_dpp(o, v, 0x12f, 0xf, 0xf, false);
    return __int_as_float(r);
}
__device__ __forceinline__ float gelu_tanh(float x) { const float y = 0.7978845608028654f * (x + 0.044715f * x * x * x); const float t = 1.0f - 2.0f * __builtin_amdgcn_rcpf(1.0f + __expf(2.0f * y)); return 0.5f * x * (1.0f + t); }
struct EpiUp {
    bf16_t* act; bf16_t* su; bf16_t* sv; const float* cw; const float* cb;
    __device__ __forceinline__ void operator()(const f32x4 (&acc)[2][2][4][2], const Unit& u, int wr, int wc, int fr, int fq) const {
#pragma unroll
        for (int n = 0; n < 2; ++n) {
            const int ch = u.pn * 128 + wc * 32 + 16 * n + 4 * fq;
            const f32x4 w0 = *(const f32x4*)(cw + ch), w1 = *(const f32x4*)(cw + 2816 + ch), w2 = *(const f32x4*)(cw + 5632 + ch), bb = *(const f32x4*)(cb + ch);
#pragma unroll
            for (int ai = 0; ai < 2; ++ai) {
                const int rowg = u.row0 + ai * 128 + wr * 64;
                f32x4 ub[4];
#pragma unroll
                for (int m = 0; m < 4; ++m)
#pragma unroll
                    for (int e = 0; e < 4; ++e) ub[m][e] = bf2f(f2bf(acc[ai][0][m][n][e]));
#pragma unroll
                for (int m = 0; m < 4; ++m) {
                    const int row = rowg + m * 16 + fr;
                    f32x4 r;
#pragma unroll
                    for (int e = 0; e < 4; ++e) {
                        const float pl = m > 0 ? dpp_f(0.f, ub[m > 0 ? m - 1 : 0][e], 2) : 0.f;
                        const float pv = dpp_f(pl, ub[m][e], 0);
                        const float nl = m < 3 ? dpp_f(0.f, ub[m < 3 ? m + 1 : 3][e], 3) : 0.f;
                        const float nv = dpp_f(nl, ub[m][e], 1);
                        const float gff = w0[e] * pv + w1[e] * ub[m][e] + w2[e] * nv + bb[e];
                        r[e] = gelu_tanh(gff) * bf2f(f2bf(acc[ai][1][m][n][e]));
                    }
                    const bool edge = (m == 0 && fr == 0) || (m == 3 && fr == 15);
                    if (!edge) { uint2 pk; pk.x = pack2(r[0], r[1]); pk.y = pack2(r[2], r[3]); *(uint2*)(act + (size_t)row * 2816 + ch) = pk; }
                    if ((m == 0 && fr < 2) || (m == 3 && fr >= 14)) {
                        const int slot = m == 0 ? fr : fr - 12; const int g64 = rowg >> 6;
                        uint2 pk; pk.x = pack2(ub[m][0], ub[m][1]); pk.y = pack2(ub[m][2], ub[m][3]);
                        *(uint2*)(su + ((size_t)g64 * 4 + slot) * 2816 + ch) = pk;
                        if (edge) { const f32x4 vv = acc[ai][1][m][n]; uint2 pv2; pv2.x = pack2(vv[0], vv[1]); pv2.y = pack2(vv[2], vv[3]); *(uint2*)(sv + ((size_t)g64 * 2 + (m == 0 ? 0 : 1)) * 2816 + ch) = pv2; }
                    }
                }
            }
        }
    }
};
struct EpiPool {
    bf16_t* dst; const float* scale;
    __device__ __forceinline__ void operator()(const f32x4 (&acc)[2][2][4][2], const Unit& u, int wr, int wc, int fr, int fq) const {
        const int c0 = u.pn * 256 + wc * 32 + 4 * fq;
        f32x4 sc[4];
#pragma unroll
        for (int g = 0; g < 4; ++g) sc[g] = *(const f32x4*)(scale + c0 + (g >> 1) * 128 + (g & 1) * 16);
#pragma unroll
        for (int ai = 0; ai < 2; ++ai)
#pragma unroll
            for (int m = 0; m < 4; ++m) { const int row = u.pm * 256 + wr * 64 + fr + ai * 128 + m * 16;
#pragma unroll
                for (int g = 0; g < 4; ++g) { const f32x4 v = acc[ai][g >> 1][m][g & 1] * sc[g];
                    uint2 pk; pk.x = pack2(v[0], v[1]); pk.y = pack2(v[2], v[3]);
                    *(uint2*)(dst + (size_t)row * 1024 + c0 + (g >> 1) * 128 + (g & 1) * 16) = pk; } }
    }
};

struct WPtrs { const float *w_in, *w_branch, *lru_wa, *lru_wx, *pool_w, *w_out, *ffn_up, *ffn_down; unsigned char* ws; };
struct TileDesc { const float* src; int lds_; bf16_t* dst; int ldd, k0, n0, perm, nd; };
__device__ __forceinline__ int swap45(int p) { return (p & ~48) | ((p & 16) << 1) | ((p & 32) >> 1); }
__device__ __forceinline__ TileDesc weight_tile(const WPtrs& P, int l, int t) {
    unsigned char* ws = P.ws; TileDesc d; int r = t; d.perm = 0; d.nd = -1;
    if (r < 1664) { d.src = P.w_in + (size_t)l * 1024 * 6656; d.lds_ = 6656; d.dst = (bf16_t*)(ws + OFF_WIN); d.ldd = 1024; d.k0 = (r / 104) * 64; d.n0 = (r % 104) * 64; d.perm = (d.n0 >= 1024 && d.n0 < 2304) ? 1 : 0; }
    else if ((r -= 1664) < 128) { const int mat = r / 64; r %= 64; const int dh = r / 4; r %= 4;
        d.src = (mat ? P.lru_wx : P.lru_wa) + (size_t)(l * 16 + dh) * 128 * 128; d.lds_ = 128; d.dst = (bf16_t*)(ws + OFF_GW) + (size_t)dh * 256 * 128 + (size_t)mat * 128 * 128; d.ldd = 128; d.k0 = (r / 2) * 64; d.n0 = (r % 2) * 64; }
    else if ((r -= 128) < 64) { const int g = r / 16; r %= 16; d.src = P.pool_w + (size_t)(l * 4 + g) * 256 * 256; d.lds_ = 256; d.dst = (bf16_t*)(ws + OFF_PW) + (size_t)g * 256 * 256; d.ldd = 256; d.k0 = (r / 4) * 64; d.n0 = (r % 4) * 64; }
    else if ((r -= 64) < 768) { const int j = r / 256; r %= 256; d.src = P.w_branch + (size_t)(l * 3 + j) * 1024 * 1024; d.lds_ = 1024; d.dst = (bf16_t*)(ws + OFF_WBR) + (size_t)j * 1024 * 1024; d.ldd = 1024; d.k0 = (r / 16) * 64; d.n0 = (r % 16) * 64; }
    else if ((r -= 768) < 256) { d.src = P.w_out + (size_t)l * 1024 * 1024; d.lds_ = 1024; d.dst = (bf16_t*)(ws + OFF_WOUT); d.ldd = 1024; d.k0 = (r / 16) * 64; d.n0 = (r % 16) * 64; }
    else if ((r -= 256) < 1408) { d.src = P.ffn_up + (size_t)l * 1024 * 5632; d.lds_ = 5632; d.dst = (bf16_t*)(ws + OFF_WUP); d.ldd = 1024; d.k0 = (r / 88) * 64; d.n0 = (r % 88) * 64;
        { const int isv = d.n0 >= 2816, c0 = isv ? d.n0 - 2816 : d.n0; d.nd = (c0 >> 7) * 256 + (c0 & 127) + (isv ? 128 : 0); } }
    else { r -= 1408; d.src = P.ffn_down + (size_t)l * 2816 * 1024; d.lds_ = 1024; d.dst = (bf16_t*)(ws + OFF_WDN); d.ldd = 2816; d.k0 = (r / 16) * 64; d.n0 = (r % 16) * 64; }
    return d;
}
__device__ __noinline__ void convert_weights_(const float* p0, const float* p1, const float* p2, const float* p3, const float* p4, const float* p5, const float* p6, const float* p7, unsigned char* pws,
                                              int l, LAS unsigned char* lds, int t_begin, int t_end, int first, int stride) {
    const WPtrs P{p0, p1, p2, p3, p4, p5, p6, p7, pws};
    LAS bf16_t* sm = (LAS bf16_t*)lds;
    const int tid = otid();
    const int kk0 = tid >> 4, n4 = (tid & 15) * 4, nn = tid >> 3, ck = tid & 7;
    int t = t_begin + first;
    if (t >= t_end) return;
    TileDesc d = weight_tile(P, l, t);
    f32x4 v0 = *(const f32x4*)(d.src + (size_t)(d.k0 + kk0) * d.lds_ + d.n0 + n4), v1 = *(const f32x4*)(d.src + (size_t)(d.k0 + kk0 + 32) * d.lds_ + d.n0 + n4);
    for (;;) {
        __syncthreads();
#pragma unroll
        for (int e = 0; e < 4; ++e) { sm[(n4 + e) * 72 + kk0] = f2bf(v0[e]); sm[(n4 + e) * 72 + kk0 + 32] = f2bf(v1[e]); }
        __syncthreads();
        const TileDesc cur = d; const int tn = t + stride; const bool more = tn < t_end;
        if (more) { d = weight_tile(P, l, tn); v0 = *(const f32x4*)(d.src + (size_t)(d.k0 + kk0) * d.lds_ + d.n0 + n4); v1 = *(const f32x4*)(d.src + (size_t)(d.k0 + kk0 + 32) * d.lds_ + d.n0 + n4); }
        const u32x4 o = *(const LAS u32x4*)(sm + nn * 72 + ck * 8);
        const int nrow = cur.perm ? swap45(cur.n0 + nn) : ((cur.nd >= 0 ? cur.nd : cur.n0) + nn);
        *(u32x4*)(cur.dst + (size_t)nrow * cur.ldd + cur.k0 + ck * 8) = o;
        if (!more) break;
        t = tn;
    }
    __syncthreads();
}

__device__ __forceinline__ void convert_weights(const Params& P, int l, LAS unsigned char* lds, int t_begin, int t_end, int first, int stride) {
    convert_weights_(P.w_in, P.w_branch, P.lru_wa, P.lru_wx, P.pool_w, P.w_out, P.ffn_up, P.ffn_down, P.ws, l, lds, t_begin, t_end, first, stride);
}

__device__ void phase0(const Params& P, LAS unsigned char* lds) {
    const int tid = otid(), G = gridDim.x, c = blockIdx.x;
    { bf16_t* ck = (bf16_t*)(P.ws + OFF_CK); bf16_t* cv = (bf16_t*)(P.ws + OFF_CV);
      for (int i = c * 512 + tid; i < 2 * 2 * 512 * 256; i += G * 512) {
          const int e = i & 255, t = (i >> 8) & 511, b = (i >> 17) & 1, l = i >> 18;
          const size_t si = ((size_t)((b * 2 + l) * 512 + t)) * 256 + e;
          ck[i] = f2bf(P.cache_k[si]); cv[i] = f2bf(P.cache_v[si]); } }
    { float* rc = (float*)(P.ws + OFF_ROPE); float* rs = rc + 2048;
      for (int i = c * 512 + tid; i < 2048; i += G * 512) {
          const int pos = i >> 5, k = i & 31; const float fr = powf(10000.0f, -(float)k / 32.0f); const float ang = (float)pos * fr;
          rc[i] = cosf(ang); rs[i] = sinf(ang); } }
    { LAS float* sv = (LAS float*)lds;
      LAS float* red = sv + 3072;
      __syncthreads();
      for (int i = tid; i < 3072; i += 512) { const int s = i >> 10, k = i & 1023; const float x = s == 0 ? P.c_ctx[k] : P.c[(s - 1) * 1024 + k]; sv[i] = x / (1.0f + expf(-x)); }
      __syncthreads();
      float* mod = (float*)(P.ws + OFF_MOD);
      for (int it = c; it < 384; it += G) {
          const int l = it / 192, cg_ = it % 192, cl = tid & 31, kg = tid >> 5, col = cg_ * 32 + cl;
          const float* w = P.w_ada + (size_t)l * 1024 * 6144 + col;
          float a0 = 0.f, a1 = 0.f, a2 = 0.f;
#pragma unroll 16
          for (int k = kg * 64; k < kg * 64 + 64; ++k) { const float wv = w[(size_t)k * 6144]; a0 += sv[k] * wv; a1 += sv[1024 + k] * wv; a2 += sv[2048 + k] * wv; }
          red[(kg * 3 + 0) * 32 + cl] = a0; red[(kg * 3 + 1) * 32 + cl] = a1; red[(kg * 3 + 2) * 32 + cl] = a2;
          __syncthreads();
          if (tid < 96) { const int s = tid >> 5, cc = tid & 31; float sum = 0.f;
#pragma unroll
              for (int g = 0; g < 16; ++g) sum += red[(g * 3 + s) * 32 + cc];
              mod[(size_t)(l * 3 + s) * 6144 + cg_ * 32 + cc] = sum + P.b_ada[l * 6144 + cg_ * 32 + cc]; }
          __syncthreads();
      } }
}

template <bool FINAL>
__device__ __forceinline__ void norm_rows(float* X, const float* xa, const float* xb, const float* __restrict__ gw, const float* __restrict__ mod, int shift_off, int scale_off, bf16_t* __restrict__ H) {
    const int tid = otid(); const int lane = tid & 63, wv = blockIdx.x * 8 + (tid >> 6), nw = gridDim.x * 8;
    constexpr int R = 3;
    for (int row0 = wv; row0 < MROWS; row0 += R * nw) {
        f32x4 v[R][4];
#pragma unroll
        for (int r = 0; r < R; ++r) { const int row = row0 + r * nw;
#pragma unroll
            for (int i = 0; i < 4; ++i) v[r][i] = row < MROWS ? *(const f32x4*)((row < MCTX ? xa + (size_t)row * 1024 : xb + (size_t)(row - MCTX) * 1024) + i * 256 + lane * 4) : (f32x4){0.f, 0.f, 0.f, 0.f}; }
#pragma unroll
        for (int r = 0; r < R; ++r) { const int row = row0 + r * nw; if (row >= MROWS) continue;
            float ss = 0.f;
#pragma unroll
            for (int i = 0; i < 4; ++i) ss += v[r][i][0] * v[r][i][0] + v[r][i][1] * v[r][i][1] + v[r][i][2] * v[r][i][2] + v[r][i][3] * v[r][i][3];
#pragma unroll
            for (int o = 32; o >= 1; o >>= 1) ss += __shfl_xor(ss, o);
            const float rstd = rsqrtf(ss * (1.0f / 1024.0f) + 1e-6f);
            const float* md = mod + seq_group(row) * 6144;
#pragma unroll
            for (int i = 0; i < 4; ++i) { const int col = i * 256 + lane * 4;
                const f32x4 g = *(const f32x4*)(gw + col);
                if (FINAL) { f32x4 h;
#pragma unroll
                    for (int e = 0; e < 4; ++e) h[e] = v[r][i][e] * rstd * g[e];
                    *(f32x4*)(X + (size_t)row * 1024 + col) = h; }
                else { const f32x4 sc = *(const f32x4*)(md + scale_off + col), sh = *(const f32x4*)(md + shift_off + col);
                    f32x4 h;
#pragma unroll
                    for (int e = 0; e < 4; ++e) h[e] = v[r][i][e] * rstd * g[e] * (1.0f + sc[e]) + sh[e];
                    uint2 pk; pk.x = pack2(h[0], h[1]); pk.y = pack2(h[2], h[3]);
                    *(uint2*)(H + (size_t)row * 1024 + col) = pk; } }
        }
    }
}
__device__ void norm_phase(const float* xa, const float* xb, const float* __restrict__ gw, const float* __restrict__ mod, int shift_off, int scale_off, bf16_t* __restrict__ H) { norm_rows<false>(nullptr, xa, xb, gw, mod, shift_off, scale_off, H); }
__device__ void final_norm_phase(float* X, const float* __restrict__ gw) { norm_rows<true>(X, X, X + (size_t)MCTX * 1024, gw, nullptr, 0, 0, nullptr); }

template <int HALF>
__device__ __forceinline__ void pool_item(const bf16_t* __restrict__ XC, bf16_t* __restrict__ PL, int it) {
    constexpr int G_ = HALF == 1 ? 0 : (HALF == 2 ? 1 : (HALF == 4 ? 2 : 3));
    const int rs = (it >> 5) * 8, ch = G_ * 256 + (it & 31) * 8;
    const int T = rs < MCTX ? 256 : 2048, row0 = rs < MCTX ? (rs & ~255) : MCTX + ((rs - MCTX) & ~2047), tl0 = rs - row0;
    const bf16_t* base = XC + (size_t)row0 * 1024 + ch;
    constexpr int R = 8 + 2 * HALF;
    bf16x8 xr[R];
#pragma unroll
    for (int i = 0; i < R; ++i) { const int t = tl0 - HALF + i; xr[i] = (bf16x8){0, 0, 0, 0, 0, 0, 0, 0}; if (t >= 0 && t < T) xr[i] = *(const bf16x8*)(base + (size_t)t * 1024); }
    float s[8];
#pragma unroll
    for (int e = 0; e < 8; ++e) { s[e] = 0.f;
#pragma unroll
        for (int i = 0; i < 2 * HALF; ++i) s[e] += bf2f((unsigned short)xr[i][e]); }
#pragma unroll
    for (int j = 0; j < 8; ++j) {
        const int t = tl0 + j;
        const float inv = 1.0f / (float)(min(t + HALF, T) - max(t - HALF, 0));
        float r[8];
#pragma unroll
        for (int e = 0; e < 8; ++e) r[e] = s[e] * inv - bf2f((unsigned short)xr[j + HALF][e]);
        u32x4 o; o.x = pack2(r[0], r[1]); o.y = pack2(r[2], r[3]); o.z = pack2(r[4], r[5]); o.w = pack2(r[6], r[7]);
        *(u32x4*)(PL + (size_t)(row0 + t) * 1024 + ch) = o;
#pragma unroll
        for (int e = 0; e < 8; ++e) s[e] += bf2f((unsigned short)xr[j + 2 * HALF][e]) - bf2f((unsigned short)xr[j][e]);
    }
}
__device__ void pool_phase(const bf16_t* __restrict__ XC, bf16_t* __restrict__ PL) {
    const int tid = otid();
    constexpr int PER_G = (MROWS / 8) * 32;
    for (int idx = blockIdx.x * 512 + tid; idx < 4 * PER_G; idx += gridDim.x * 512) {
        const int g = idx / PER_G, it = idx % PER_G;
        if (g == 0) pool_item<1>(XC, PL, it); else if (g == 1) pool_item<2>(XC, PL, it); else if (g == 2) pool_item<4>(XC, PL, it); else pool_item<8>(XC, PL, it);
    }
}
__device__ void ffn_fix_groups(const bf16_t* __restrict__ SU, const bf16_t* __restrict__ SV, bf16_t* __restrict__ ACT, const float* __restrict__ cw, const float* __restrict__ cb, int g0, int ng) {
    const int tid = otid();
    for (int idx = tid; idx < ng * 2 * 352; idx += 512) {
        const int br = idx / 352, ch = (idx % 352) * 8;
        const int g = g0 + (br >> 1), last = br & 1;
        const int row = g * 64 + (last ? 63 : 0);
        const int T = row < MCTX ? 256 : 2048, row0 = row < MCTX ? (row & ~255) : MCTX + ((row - MCTX) & ~2047), tl = row - row0;
        const bf16x8 zero = (bf16x8){0, 0, 0, 0, 0, 0, 0, 0};
        bf16x8 um, u0, un;
        if (last) { um = *(const bf16x8*)(SU + ((size_t)g * 4 + 2) * 2816 + ch); u0 = *(const bf16x8*)(SU + ((size_t)g * 4 + 3) * 2816 + ch);
                    un = tl < T - 1 ? *(const bf16x8*)(SU + ((size_t)(g + 1) * 4 + 0) * 2816 + ch) : zero; }
        else { um = tl > 0 ? *(const bf16x8*)(SU + ((size_t)(g - 1) * 4 + 3) * 2816 + ch) : zero; u0 = *(const bf16x8*)(SU + ((size_t)g * 4 + 0) * 2816 + ch);
               un = *(const bf16x8*)(SU + ((size_t)g * 4 + 1) * 2816 + ch); }
        const bf16x8 vv = *(const bf16x8*)(SV + ((size_t)g * 2 + last) * 2816 + ch);
        float r[8];
#pragma unroll
        for (int e = 0; e < 8; ++e) { const float gff = cw[ch + e] * bf2f((unsigned short)um[e]) + cw[2816 + ch + e] * bf2f((unsigned short)u0[e]) + cw[5632 + ch + e] * bf2f((unsigned short)un[e]) + cb[ch + e];
            r[e] = gelu_tanh(gff) * bf2f((unsigned short)vv[e]); }
        u32x4 o; o.x = pack2(r[0], r[1]); o.y = pack2(r[2], r[3]); o.z = pack2(r[4], r[5]); o.w = pack2(r[6], r[7]);
        *(u32x4*)(ACT + (size_t)row * 2816 + ch) = o;
    }
}

__device__ __forceinline__ void rope8(bf16x8& x1, bf16x8& x2, const float* __restrict__ cs, const float* __restrict__ sn) {
#pragma unroll
    for (int e = 0; e < 8; ++e) { const float a = bf2f((unsigned short)x1[e]), b = bf2f((unsigned short)x2[e]); const float c = cs[e], s = sn[e];
        x1[e] = (short)f2bf(a * c - b * s); x2[e] = (short)f2bf(a * s + b * c); }
}
constexpr int VT_OFF = 64 * 272;
constexpr int ABUF = 64 * 272 + 64 * 288;
__device__ void attn_unit(const Params& P, int l, int u, LAS unsigned char* lds) {
    int tid_ = threadIdx.x; asm volatile("" : "+v"(tid_));
    const int tid = tid_, w = tid >> 6, lane = tid & 63, fr = lane & 15, fq = lane >> 4;
    const bf16_t* Q = (const bf16_t*)(P.ws + OFF_XAQ) + (size_t)MROWS * 1024;
    const bf16_t* KB = (const bf16_t*)(P.ws + OFF_KB); const bf16_t* VB = (const bf16_t*)(P.ws + OFF_VB);
    const bf16_t* CK = (const bf16_t*)(P.ws + OFF_CK); const bf16_t* CV = (const bf16_t*)(P.ws + OFF_CV);
    bf16_t* YB = (bf16_t*)(P.ws + OFF_YB);
    bool lat; int head, row0, T, qstart, bidx;
    if (u < 256) { lat = true; bidx = u >> 7; const int rem = u & 127; head = rem >> 4; qstart = (rem & 15) * 128; T = 2048; row0 = MCTX + bidx * 2048; }
    else { const int v = u - 256; lat = false; bidx = 0; const int seq = v >> 4, rem = v & 15; head = rem >> 1; qstart = (rem & 1) * 128; T = 256; row0 = seq * 256; }
    const int kvh = head >> 2;
    const int qpos = qstart + w * 16 + fr;
    bf16x8 qf[4];
    { const bf16_t* qp = Q + (size_t)(row0 + qpos) * 1024 + head * 128 + fq * 8;
#pragma unroll
      for (int kk = 0; kk < 4; ++kk) qf[kk] = *(const bf16x8*)(qp + kk * 32); }
    float m_run = P.attn_sink[l * 8 + head] * 1.4426950408889634f; float l_run = (fq == 0) ? 1.0f : 0.0f;
    f32x4 o[8];
#pragma unroll
    for (int dt = 0; dt < 8; ++dt) o[dt] = (f32x4){0.f, 0.f, 0.f, 0.f};
    int wlo = 0, nwt = 4;
    if (lat) { wlo = max(0, qstart - 128); const int whi = min(T, qstart + 256); nwt = (whi - wlo) >> 6; }
    const int ntiles = nwt + (lat ? 8 : 0);
    const float scale = 0.08838834764831845f * 1.4426950408889634f;
    const int lkey = tid >> 3, lp = tid & 7;
    bf16x8 rk[2][2], rv[2][2];
    auto tile_load = [&](int ti, bf16x8 (&k_)[2], bf16x8 (&v_)[2]) {
        const bf16_t* ksrc; const bf16_t* vsrc;
        if (ti < nwt) { const int k0 = wlo + ti * 64; ksrc = KB + (size_t)(row0 + k0) * 256 + kvh * 128; vsrc = VB + (size_t)(row0 + k0) * 256 + kvh * 128; }
        else { const int k0 = (ti - nwt) * 64; const size_t o_ = ((size_t)((l * 2 + bidx) * 512 + k0)) * 256 + kvh * 128; ksrc = CK + o_; vsrc = CV + o_; }
        const bf16_t* kr = ksrc + (size_t)lkey * 256; k_[0] = *(const bf16x8*)(kr + lp * 8); k_[1] = *(const bf16x8*)(kr + (lp + 8) * 8);
        const bf16_t* vr = vsrc + (size_t)lkey * 256; v_[0] = *(const bf16x8*)(vr + lp * 8); v_[1] = *(const bf16x8*)(vr + (lp + 8) * 8); };
    const int krow = (lkey & 32) | ((lkey & 4) << 2) | ((lkey & 24) >> 1) | (lkey & 3);
    auto tile_store = [&](int b, const bf16x8 (&k_)[2], const bf16x8 (&v_)[2]) {
        LAS unsigned char* kb_ = lds + b * ABUF; LAS unsigned char* vb_ = kb_ + VT_OFF;
        *(LAS bf16x8*)(kb_ + krow * 272 + lp * 16) = k_[0]; *(LAS bf16x8*)(kb_ + krow * 272 + (lp + 8) * 16) = k_[1];
        *(LAS bf16x8*)(vb_ + lkey * 288 + lp * 16) = v_[0]; *(LAS bf16x8*)(vb_ + lkey * 288 + (lp + 8) * 16) = v_[1]; };
    tile_load(0, rk[0], rv[0]);
    tile_load(1, rk[1], rv[1]);
    __syncthreads();
    tile_store(0, rk[0], rv[0]);
    tile_load(2, rk[0], rv[0]);
#pragma unroll 2
    for (int ti = 0; ti < ntiles; ++ti) {
        const bool win = ti < nwt; const int k0 = win ? wlo + ti * 64 : (ti - nwt) * 64;
        __syncthreads();
        if ((ti & 1) == 0) { if (ti + 1 < ntiles) tile_store(1, rk[1], rv[1]); if (ti + 3 < ntiles) tile_load(ti + 3, rk[1], rv[1]); }
        else { if (ti + 1 < ntiles) tile_store(0, rk[0], rv[0]); if (ti + 3 < ntiles) tile_load(ti + 3, rk[0], rv[0]); }
        LAS unsigned char* kb_ = lds + (ti & 1) * ABUF; LAS unsigned char* vb_ = kb_ + VT_OFF;
        f32x4 s[4];
#pragma unroll
        for (int nt = 0; nt < 4; ++nt) { s[nt] = (f32x4){0.f, 0.f, 0.f, 0.f};
#pragma unroll
            for (int kk = 0; kk < 4; ++kk) { const bf16x8 a = *(const LAS bf16x8*)(kb_ + (nt * 16 + fr) * 272 + kk * 64 + fq * 16); s[nt] = __builtin_amdgcn_mfma_f32_16x16x32_bf16(a, qf[kk], s[nt], 0, 0, 0); } }
        float mt = -3.0e38f;
#pragma unroll
        for (int nt = 0; nt < 4; ++nt)
#pragma unroll
            for (int j = 0; j < 4; ++j) { float v = s[nt][j] * scale;
                if (lat && win) { const int kp = k0 + 32 * (nt >> 1) + 8 * fq + 4 * (nt & 1) + j; const int dd = qpos - kp; if (dd > 128 || dd < -128) v = -1.0e30f; }
                s[nt][j] = v; mt = fmaxf(mt, v); }
        mt = fmaxf(mt, __shfl_xor(mt, 16)); mt = fmaxf(mt, __shfl_xor(mt, 32));
        const float mn = fmaxf(m_run, mt); const float alpha = __builtin_amdgcn_exp2f(m_run - mn); m_run = mn;
        float ps = 0.f;
#pragma unroll
        for (int nt = 0; nt < 4; ++nt)
#pragma unroll
            for (int j = 0; j < 4; ++j) { const float p = __builtin_amdgcn_exp2f(s[nt][j] - mn); ps += p; s[nt][j] = p; }
        l_run = l_run * alpha + ps;
#pragma unroll
        for (int dt = 0; dt < 8; ++dt) o[dt] = o[dt] * alpha;
#pragma unroll
        for (int s2 = 0; s2 < 2; ++s2) {
            u32x4 pu; pu[0] = pack2(s[2 * s2][0], s[2 * s2][1]); pu[1] = pack2(s[2 * s2][2], s[2 * s2][3]); pu[2] = pack2(s[2 * s2 + 1][0], s[2 * s2 + 1][1]); pu[3] = pack2(s[2 * s2 + 1][2], s[2 * s2 + 1][3]);
            const bf16x8 pf = __builtin_bit_cast(bf16x8, pu);
#pragma unroll
            for (int dt = 0; dt < 8; ++dt) {
                const bf16x4 lo = __builtin_amdgcn_ds_read_tr16_b64_v4i16((LAS bf16x4*)(vb_ + (s2 * 32 + fq * 8 + (fr >> 2)) * 288 + (dt * 16 + (fr & 3) * 4) * 2));
                const bf16x4 hi = __builtin_amdgcn_ds_read_tr16_b64_v4i16((LAS bf16x4*)(vb_ + (s2 * 32 + fq * 8 + 4 + (fr >> 2)) * 288 + (dt * 16 + (fr & 3) * 4) * 2));
                const bf16x8 af = __builtin_shufflevector(lo, hi, 0, 1, 2, 3, 4, 5, 6, 7);
                o[dt] = __builtin_amdgcn_mfma_f32_16x16x32_bf16(af, pf, o[dt], 0, 0, 0);
            }
        }
    }
    float lt = l_run; lt += __shfl_xor(lt, 16); lt += __shfl_xor(lt, 32);
    const float inv = 1.0f / lt;
    bf16_t* yp = YB + (size_t)(row0 + qpos) * 1024 + head * 128 + fq * 4;
#pragma unroll
    for (int dt = 0; dt < 8; ++dt) { uint2 pk; pk.x = pack2(o[dt][0] * inv, o[dt][1] * inv); pk.y = pack2(o[dt][2] * inv, o[dt][3] * inv); *(uint2*)(yp + dt * 16) = pk; }
}

constexpr int YT_OFF = 256 * 272;
template <int MODE, int D, int NSC>
__device__ __forceinline__ void lru_dir(const Params& P, int l, int s, int cchunk, int h, LAS unsigned char* lds, int w, int fr, int fq) {
    const bool lat = s >= 32; const int row0 = lat ? MCTX + (s - 32) * 2048 : s * 256; const int t0 = cchunk * (NSC * 64);
    constexpr int NCH = 2048 / (NSC * 64);
    const bf16_t* GW = (const bf16_t*)(P.ws + OFF_GW);
    bf16_t* YA = (bf16_t*)(P.ws + OFF_YA);
    float* SUMM = (float*)(P.ws + OFF_SUMM);
    const int chl = 16 * w + fr, ch = h * 128 + chl;
    bf16x8 bwa[4], bwx[4];
    { const bf16_t* gp = GW + ((size_t)(D * 8 + h) * 256 + chl) * 128 + fq * 8;
#pragma unroll
      for (int kk = 0; kk < 4; ++kk) { bwa[kk] = *(const bf16x8*)(gp + kk * 32); bwx[kk] = *(const bf16x8*)(gp + 128 * 128 + kk * 32); } }
    const int pidx = (l * 2 + D) * 1024 + ch;
    const float ba = P.lru_ba[pidx], bx = P.lru_bx[pidx];
    const float lam = P.lru_lambda[pidx];
    const float c8 = -8.0f * log1pf(expf(-lam));
    float carry = 0.f;
    if (MODE == 0 && lat) {
        const int b = s - 32;
        carry = P.state_lru[((size_t)(b * 2 + l) * 2 + D) * 1024 + ch];
        if (D == 0) { for (int cc = 0; cc < cchunk; ++cc) { const float* sp = SUMM + ((size_t)((b * 2 + 0) * 16 + cc) * 1024 + ch) * 2; carry = sp[1] + sp[0] * carry; } }
        else { for (int cc = NCH - 1; cc > cchunk; --cc) { const float* sp = SUMM + ((size_t)((b * 2 + 1) * 16 + cc) * 1024 + ch) * 2; carry = sp[1] + sp[0] * carry; } }
    }
    float ptot = 1.0f;
#pragma unroll 1
    for (int sci = 0; sci < NSC; ++sci) {
        const int sc = D == 0 ? sci : NSC - 1 - sci;
        f32x4 r[4], g[4];
#pragma unroll
        for (int m = 0; m < 4; ++m) { r[m] = (f32x4){0.f, 0.f, 0.f, 0.f}; g[m] = (f32x4){0.f, 0.f, 0.f, 0.f};
#pragma unroll
            for (int kk = 0; kk < 4; ++kk) { const bf16x8 a = *(const LAS bf16x8*)(lds + (sc * 64 + m * 16 + fr) * 272 + kk * 64 + fq * 16);
                r[m] = __builtin_amdgcn_mfma_f32_16x16x32_bf16(a, bwa[kk], r[m], 0, 0, 0); g[m] = __builtin_amdgcn_mfma_f32_16x16x32_bf16(a, bwx[kk], g[m], 0, 0, 0); } }
#pragma unroll
        for (int mi = 0; mi < 4; ++mi) {
            const int m = D == 0 ? mi : 3 - mi;
            float av[4], bv[4];
#pragma unroll
            for (int j = 0; j < 4; ++j) {
                const float ea = 1.0f + __expf(-(r[m][j] + ba)), eb = 1.0f + __expf(-(g[m][j] + bx));
                const float inv = __builtin_amdgcn_rcpf(ea * eb);
                const float rr = inv * eb, ii = inv * ea;
                const float la = c8 * rr; const float a = __expf(la); const float z = 2.0f * la;
                const float em = (z > -0.05f) ? -z * (1.0f + z * (0.5f + z * (0.16666667f + z * 0.041666667f))) : 1.0f - a * a;
                const float x = bf2f(*(const LAS bf16_t*)(lds + (sc * 64 + m * 16 + fq * 4 + j) * 272 + chl * 2));
                av[j] = a; bv[j] = __builtin_amdgcn_sqrtf(em) * ii * x;
            }
            float p4, h4;
            p4 = av[0] * av[1] * av[2] * av[3];
            if (D == 0) h4 = ((bv[0] * av[1] + bv[1]) * av[2] + bv[2]) * av[3] + bv[3];
            else h4 = ((bv[3] * av[2] + bv[2]) * av[1] + bv[1]) * av[0] + bv[0];
            float pq[4], hq[4];
#pragma unroll
            for (int f = 0; f < 4; ++f) { pq[f] = __shfl(p4, fr + 16 * f); hq[f] = __shfl(h4, fr + 16 * f); }
            float cin = carry, mycin = 0.f;
#pragma unroll
            for (int fi = 0; fi < 4; ++fi) { const int f = D == 0 ? fi : 3 - fi; if (f == fq) mycin = cin; cin = hq[f] + pq[f] * cin; }
            carry = cin;
            if (MODE == 1) ptot *= pq[0] * pq[1] * pq[2] * pq[3];
            if (MODE == 0) {
                float hh = mycin; float y[4];
#pragma unroll
                for (int ji = 0; ji < 4; ++ji) { const int j = D == 0 ? ji : 3 - ji; hh = av[j] * hh + bv[j]; y[j] = hh; }
#pragma unroll
                for (int j = 0; j < 4; ++j) {
                    LAS bf16_t* yp = (LAS bf16_t*)(lds + YT_OFF + (sc * 64 + m * 16 + fq * 4 + j) * 272 + chl * 2);
                    if (D == 0) *yp = f2bf(y[j]);
                    else *yp = f2bf(bf2f(*yp) + y[j]);
                }
            }
        }
    }
    if (MODE == 0 && !lat && fq == 0) P.out[OUT_H + ((size_t)(s * 2 + l) * 2 + D) * 1024 + ch] = carry;
    if (MODE == 1 && fq == 0) { float* sp = SUMM + ((size_t)(((s - 32) * 2 + D) * 16 + cchunk) * 1024 + ch) * 2; sp[0] = ptot; sp[1] = carry; }
}
template <int MODE, int NSC>
__device__ void lru_unit(const Params& P, int l, int s, int cchunk, int h, LAS unsigned char* lds) {
    int tid_ = threadIdx.x; asm volatile("" : "+v"(tid_));
    const int tid = tid_, w = tid >> 6, lane = tid & 63, fr = lane & 15, fq = lane >> 4;
    const bool lat = s >= 32; const int T = lat ? 2048 : 256; const int row0 = lat ? MCTX + (s - 32) * 2048 : s * 256; const int t0 = cchunk * (NSC * 64);
    const bf16_t* XA = (const bf16_t*)(P.ws + OFF_XAQ);
    constexpr int RUN = NSC * 2;
    {
        const int ck = tid & 15, ch = h * 128 + ck * 8, tr = (tid >> 4) * RUN;
        const float* cw = P.lru_conv + (size_t)l * 4096 + ch; const float* cb = P.lru_conv_b + l * 1024 + ch;
        bf16x8 xr[RUN + 3];
#pragma unroll
        for (int i = 0; i < RUN + 3; ++i) { const int tt = t0 + tr + i - 2; xr[i] = (bf16x8){0, 0, 0, 0, 0, 0, 0, 0};
            if (tt >= 0 && tt < T) xr[i] = *(const bf16x8*)(XA + (size_t)(row0 + tt) * 1024 + ch); }
        float wk[4][8], bk[8];
#pragma unroll
        for (int e = 0; e < 8; ++e) { bk[e] = cb[e];
#pragma unroll
            for (int k = 0; k < 4; ++k) wk[k][e] = cw[k * 1024 + e]; }
        __syncthreads();
#pragma unroll
        for (int i = 0; i < RUN; ++i) {
            float a8[8];
#pragma unroll
            for (int e = 0; e < 8; ++e) { a8[e] = bk[e];
#pragma unroll
                for (int k = 0; k < 4; ++k) a8[e] += wk[k][e] * bf2f((unsigned short)xr[i + k][e]); }
            u32x4 o; o.x = pack2(a8[0], a8[1]); o.y = pack2(a8[2], a8[3]); o.z = pack2(a8[4], a8[5]); o.w = pack2(a8[6], a8[7]);
            *(LAS u32x4*)(lds + (tr + i) * 272 + ck * 16) = o;
        }
    }
    __syncthreads();
    lru_dir<MODE, 0, NSC>(P, l, s, cchunk, h, lds, w, fr, fq);
    lru_dir<MODE, 1, NSC>(P, l, s, cchunk, h, lds, w, fr, fq);
    if (MODE == 0) {
        bf16_t* YA = (bf16_t*)(P.ws + OFF_YA);
        __syncthreads();
#pragma unroll
        for (int it = 0; it < 2 * NSC; ++it) { const int t = (tid >> 4) + it * 32, ck = tid & 15;
            const u32x4 v = *(const LAS u32x4*)(lds + YT_OFF + t * 272 + ck * 16);
            *(u32x4*)(YA + (size_t)(row0 + t0 + t) * 1024 + h * 128 + ck * 8) = v; }
    }
}

#define XB_TMO      128
#define XB_XCNT(j)  (256  + 64 * (j))
#define XB_XSUB(j)  (1280 + 64 * (j))
#define XB_XGEN(j)  (2304 + 64 * (j))
#define XB_TOP      3328
#define XB_TOPGEN   3392
#define XCD_BAR_WORDS 3456
#define XB_SPIN_CAP (1u << 18)
__device__ __forceinline__ unsigned xb_ld(unsigned* p)              { return __hip_atomic_load(p, __ATOMIC_RELAXED, __HIP_MEMORY_SCOPE_AGENT); }
__device__ __forceinline__ unsigned xb_add(unsigned* p, unsigned v) { return __hip_atomic_fetch_add(p, v, __ATOMIC_RELAXED, __HIP_MEMORY_SCOPE_AGENT); }
__device__ __forceinline__ unsigned xb_xcc_id() { return (unsigned)__builtin_amdgcn_s_getreg((3 << 11) | 20) & 0xFu; }
#define XB_SPIN(cond, bar) do { unsigned _sp = 0; while (cond) { __builtin_amdgcn_s_sleep(1); \
    if ((++_sp & 255u) == 0u) { if (xb_ld(&(bar)[XB_TMO])) break; if (_sp > XB_SPIN_CAP) { atomicAdd(&(bar)[XB_TMO], 1u); break; } } } } while (0)
struct XcdBarrier { unsigned* bar; unsigned x; volatile LAS unsigned* st; };
__device__ __forceinline__ XcdBarrier xcd_barrier_post(unsigned* bar, volatile LAS unsigned* st) {
    XcdBarrier b; b.bar = bar; b.x = xb_xcc_id(); b.st = st;
    if (threadIdx.x == 0) (void)xb_add(&bar[XB_XCNT(b.x)], 1u);
    return b;
}
__device__ __forceinline__ void xcd_barrier_complete(unsigned* bar, unsigned x, unsigned& nloc, unsigned& nx) {
    const unsigned G = gridDim.x * gridDim.y * gridDim.z;
    unsigned sum, cnt, mine, sp = 0u;
    for (;;) {
        sum = 0u; cnt = 0u; mine = 0u;
#pragma unroll
        for (unsigned j = 0; j < 16; ++j) { const unsigned c = xb_ld(&bar[XB_XCNT(j)]); sum += c; cnt += (c > 0u) ? 1u : 0u; mine = (j == x) ? c : mine; }
        if (sum == G) break;
        __builtin_amdgcn_s_sleep(1);
        if ((++sp & 255u) == 0u) { if (xb_ld(&bar[XB_TMO])) break; if (sp > XB_SPIN_CAP) { atomicAdd(&bar[XB_TMO], 1u); break; } }
    }
    nloc = mine > 0u ? mine : 1u; nx = cnt > 0u ? cnt : 1u;
}
__device__ __noinline__ void xcd_barrier_(unsigned* bbar, unsigned bx, volatile LAS unsigned* bst) {
    XcdBarrier b; b.bar = bbar; b.x = bx; b.st = bst;
    asm volatile("s_waitcnt vmcnt(0)" ::: "memory");
    __syncthreads();
    if (threadIdx.x == 0) {
        unsigned* bar = b.bar;
        __builtin_amdgcn_s_waitcnt(0);
        unsigned nloc = b.st[0], nx = b.st[1];
        if (nloc == 0u) { xcd_barrier_complete(bar, b.x, nloc, nx); b.st[0] = nloc; b.st[1] = nx; }
        const unsigned old = xb_add(&bar[XB_XSUB(b.x)], 1u);
        const unsigned gen = old / nloc;
        if (old + 1u == (gen + 1u) * nloc) {
            __builtin_amdgcn_fence(__ATOMIC_RELEASE, "agent");
            asm volatile("s_waitcnt vmcnt(0)" ::: "memory");
            const unsigned og = xb_add(&bar[XB_TOP], 1u);
            const unsigned tg = og / nx;
            if (og + 1u == (tg + 1u) * nx) xb_add(&bar[XB_TOPGEN], 1u);
            else XB_SPIN(xb_ld(&bar[XB_TOPGEN]) == tg, bar);
            __builtin_amdgcn_fence(__ATOMIC_ACQUIRE, "agent");
            xb_add(&bar[XB_XGEN(b.x)], 1u);
            asm volatile("s_waitcnt vmcnt(0)" ::: "memory");
        } else {
            XB_SPIN(xb_ld(&bar[XB_XGEN(b.x)]) == gen, bar);
            __builtin_amdgcn_fence(__ATOMIC_ACQUIRE, "agent");
            asm volatile("s_waitcnt vmcnt(0)" ::: "memory");
        }
    }
    __syncthreads();
}

#ifndef REPMASK
#define REPMASK 0
#endif
#define REPLOOP(i) _Pragma("unroll 1") for (int rep_ = 0; rep_ < 1 + ((REPMASK >> (i)) & 1); ++rep_)
__global__ __launch_bounds__(512, 2) void mega(Params P) {
    extern __shared__ __attribute__((aligned(16))) unsigned char shm[];
    LAS unsigned char* lds = (LAS unsigned char*)shm;
    cg::grid_group grid = cg::this_grid();
    if (threadIdx.x == 0) *(LAS u32x4*)(lds + 147456) = (u32x4){0u, 0u, 0u, 0u};
    __syncthreads();
    const XcdBarrier xb = xcd_barrier_post((unsigned*)(P.ws + OFF_BAR), (volatile LAS unsigned*)(lds + 147456));
    const int G = gridDim.x, c = blockIdx.x;
    unsigned char* ws = P.ws;
    float* X = P.out;
    bf16_t* H = (bf16_t*)(ws + OFF_H);
    const float* MOD = (const float*)(ws + OFF_MOD);

    REPLOOP(12) phase0(P, lds);
    if (gridDim.x == 0x7fffffffu) grid.sync();
    REPLOOP(11) xcd_barrier_(xb.bar, xb.x, xb.st);
    for (int l = 0; l < 2; ++l) {
        const float* mod = MOD + (size_t)l * 3 * 6144;
        const bool hide = (G == 256);
        { const int te = hide ? (l == 0 ? 1856 : 0) : 4992; if (te > 0) convert_weights(P, l, lds, 0, te, c, G); }
        const float* xa0 = l == 0 ? P.x_prompt : X; const float* xb0 = l == 0 ? P.x_sample : X + (size_t)MCTX * 1024;
        REPLOOP(1) norm_phase(xa0, xb0, P.norm1 + l * 1024, mod, 0, 1024, H);
        REPLOOP(11) xcd_barrier_(xb.bar, xb.x, xb.st);
        REPLOOP(2) { Sched S{(const char*)H, (const char*)(ws + OFF_WIN), 1024, 1024, 0, 48, 14, G, c, 256};
          EpiIn E{(bf16_t*)(ws + OFF_XAQ), (bf16_t*)(ws + OFF_XC), (bf16_t*)(ws + OFF_KB), (bf16_t*)(ws + OFF_VB), P.out + OUT_K, P.out + OUT_V, (const float*)(ws + OFF_ROPE), l};
          gemm_phase(lds, S, 1024, E); }
        if (hide && l == 0 && c >= 160) convert_weights(P, l, lds, 1856, 2624, c - 160, G - 160);
        REPLOOP(11) xcd_barrier_(xb.bar, xb.x, xb.st);
        REPLOOP(3) pool_phase((const bf16_t*)(ws + OFF_XC), (bf16_t*)(ws + OFF_PL));
        for (int it = c; it < 1280; it += G) {
            if (it < 256) { REPLOOP(4) attn_unit(P, l, it, lds); }
            else if (it < 512) { const int v = it - 256; REPLOOP(5) lru_unit<0, 4>(P, l, v >> 3, 0, v & 7, lds); }
            else if (it < 768) { const int q = it - 512; REPLOOP(5) lru_unit<1, 2>(P, l, 32 + (q >> 7), (q >> 3) & 15, q & 7, lds); }
            else { REPLOOP(7) attn_unit(P, l, it - 768 + 256, lds); }
        }
        REPLOOP(11) xcd_barrier_(xb.bar, xb.x, xb.st);
        { Sched S{(const char*)(ws + OFF_PL), (const char*)(ws + OFF_PW), 1024, 256, 256, 48, 4, G, c, 256};
          EpiPool E{(bf16_t*)(ws + OFF_XC), P.pool_scale + l * 1024};
          gemm_phase(lds, S, 256, E); }
#ifndef NO_LRU
        for (int it = G - 1 - c; it < 256; it += G) lru_unit<0, 2>(P, l, 32 + (it >> 7), (it >> 3) & 15, it & 7, lds);
#endif
        REPLOOP(11) xcd_barrier_(xb.bar, xb.x, xb.st);
        { unsigned* mflags = (unsigned*)(ws + OFF_BAR) + 3500 + l * 192;
          MergeSched S{(const char*)ws, 1024, 1024, c, c >= 192};
          EpiMerge E{(bf16_t*)(ws + OFF_GT), P.b_gate + l * 3072, (float*)(ws + OFF_XAQ), (bf16_t*)(ws + OFF_PL), mflags};
          gemm_phase(lds, S, 1024, E); }
        if (hide && c >= 192) convert_weights(P, l, lds, 2624, 4288, c - 192, G - 192);
        REPLOOP(11) xcd_barrier_(xb.bar, xb.x, xb.st);
        { Sched S{(const char*)(ws + OFF_PL), (const char*)(ws + OFF_WOUT), 1024, 1024, 0, 64, 4, G, c, 192};
          EpiRes E{X, mod, 2048, xa0, xb0};
          gemm_phase<EpiRes, Sched, true>(lds, S, 1024, E); }
        REPLOOP(11) xcd_barrier_(xb.bar, xb.x, xb.st);
        norm_phase(X, X + (size_t)MCTX * 1024, P.norm2 + l * 1024, mod, 3072, 4096, H);
        REPLOOP(11) xcd_barrier_(xb.bar, xb.x, xb.st);
        REPLOOP(9) { Sched S{(const char*)H, (const char*)(ws + OFF_WUP), 1024, 1024, 0, 48, 22, G, c, 256};
          EpiUp E{(bf16_t*)(ws + OFF_ACT), (bf16_t*)(ws + OFF_SU), (bf16_t*)(ws + OFF_SV), P.ffn_conv + (size_t)l * 3 * 2816, P.ffn_conv_b + l * 2816};
          gemm_phase(lds, S, 1024, E); }
        if (hide && c >= 32) { convert_weights(P, l, lds, 4288, 4992, c - 32, G - 32);
          if (l == 0) convert_weights(P, l + 1, lds, 0, 2624, c - 32, G - 32); }
        REPLOOP(11) xcd_barrier_(xb.bar, xb.x, xb.st);
        { Sched S{(const char*)(ws + OFF_ACT), (const char*)(ws + OFF_WDN), 2816, 2816, 0, 64, 4, G, c, 192};
          { Unit uu; for (int i = 0; S.next(i, uu); ++i) ffn_fix_groups((const bf16_t*)(ws + OFF_SU), (const bf16_t*)(ws + OFF_SV), (bf16_t*)(ws + OFF_ACT), P.ffn_conv + (size_t)l * 3 * 2816, P.ffn_conv_b + l * 2816, uu.row0 >> 6, 3);
            asm volatile("s_waitcnt vmcnt(0)" ::: "memory"); __syncthreads(); }
          EpiRes E{X, mod, 5120, X, X + (size_t)MCTX * 1024};
          gemm_phase<EpiRes, Sched, true>(lds, S, 2816, E); }
        REPLOOP(11) xcd_barrier_(xb.bar, xb.x, xb.st);
    }
    final_norm_phase(X, P.final_norm);
}

extern "C" void kernel_launch(void* const* d_in, const int* in_sizes, int n_in, void* d_out, int out_size, void* d_ws, size_t ws_size, hipStream_t stream) {
    constexpr size_t kDynLds = 147456 + 16;
    static int grid_blocks = 0;
    if (!grid_blocks) {
        int dev = 0, cus = 0, per_cu = 0;
        hipGetDevice(&dev);
        hipDeviceGetAttribute(&cus, hipDeviceAttributeMultiprocessorCount, dev);
        hipFuncSetAttribute((const void*)mega, hipFuncAttributeMaxDynamicSharedMemorySize, (int)kDynLds);
        hipOccupancyMaxActiveBlocksPerMultiprocessor(&per_cu, mega, 512, kDynLds);
        if (per_cu < 1) per_cu = 1;
        if (per_cu > 1) per_cu = 1;
        grid_blocks = cus * per_cu;
    }
    Params p{};
    const float** pp = (const float**)&p;
    for (int i = 0; i < 30; ++i) pp[i] = (const float*)d_in[i];
    p.out = (float*)d_out; p.ws = (unsigned char*)d_ws;
    if (ws_size < OFF_END2 + 262144) { fprintf(stderr, "workspace too small: %zu < %zu\n", ws_size, (size_t)OFF_END2 + 262144); }
    hipMemsetAsync((unsigned char*)d_ws + OFF_BAR, 0, 16384, stream);
    void* args[] = {&p};
    hipError_t e = hipLaunchCooperativeKernel((void*)mega, dim3(grid_blocks), dim3(512), args, kDynLds, stream);
    if (e != hipSuccess) fprintf(stderr, "cooperative launch failed: %s (grid %d)\n", hipGetErrorString(e), grid_blocks);
}
```

```cpp
#include <hip/hip_runtime.h>
#include <hip/hip_cooperative_groups.h>
#include <cstdio>
namespace cg = cooperative_groups;

#define LAS __attribute__((address_space(3)))
typedef unsigned short bf16_t;
typedef short bf16x8 __attribute__((ext_vector_type(8)));
typedef float f32x4 __attribute__((ext_vector_type(4)));
typedef unsigned u32x4 __attribute__((ext_vector_type(4)));
typedef unsigned u32x2 __attribute__((ext_vector_type(2)));
typedef short bf16x4 __attribute__((ext_vector_type(4)));

constexpr int MROWS = 12288, MCTX = 8192;
constexpr size_t S24 = (size_t)MROWS * 1024 * 2;
constexpr size_t OFF_WIN = 0;
constexpr size_t OFF_WBR = OFF_WIN + (size_t)6656 * 1024 * 2;
constexpr size_t OFF_WOUT = OFF_WBR + (size_t)3 * 1024 * 1024 * 2;
constexpr size_t OFF_WUP = OFF_WOUT + (size_t)1024 * 1024 * 2;
constexpr size_t OFF_WDN = OFF_WUP + (size_t)5632 * 1024 * 2;
constexpr size_t OFF_GW = OFF_WDN + (size_t)1024 * 2816 * 2;
constexpr size_t OFF_PW = OFF_GW + (size_t)2 * 8 * 256 * 128 * 2;
constexpr size_t OFF_MOD = OFF_PW + (size_t)4 * 256 * 256 * 2;
constexpr size_t OFF_CK = OFF_MOD + (size_t)2 * 3 * 6144 * 4;
constexpr size_t OFF_CV = OFF_CK + (size_t)2 * 2 * 512 * 256 * 2;
constexpr size_t OFF_ROPE = OFF_CV + (size_t)2 * 2 * 512 * 256 * 2;
constexpr size_t OFF_SUMM = OFF_ROPE + (size_t)2 * 64 * 32 * 4;
constexpr size_t OFF_BAR = OFF_SUMM + (size_t)2 * 2 * 16 * 1024 * 2 * 4;
constexpr size_t OFF_ACT0 = OFF_BAR + 16384;
constexpr size_t OFF_XAQ = OFF_ACT0;
constexpr size_t OFF_XC = OFF_XAQ + 2 * S24;
constexpr size_t OFF_KB = OFF_XC + S24;
constexpr size_t OFF_VB = OFF_KB + (size_t)MROWS * 256 * 2;
constexpr size_t OFF_GT = OFF_VB + (size_t)MROWS * 256 * 2;
constexpr size_t OFF_YB = OFF_GT + S24;
constexpr size_t OFF_PL = OFF_YB + S24;
constexpr size_t OFF_YA = OFF_PL + S24;
constexpr size_t OFF_H = OFF_YA + S24;
constexpr size_t OFF_END = OFF_H + S24;
constexpr size_t OFF_ACT = OFF_XAQ;
constexpr size_t OFF_SU = OFF_END;
constexpr size_t OFF_SV = OFF_SU + (size_t)192 * 4 * 2816 * 2;
constexpr size_t OFF_END2 = OFF_SV + (size_t)192 * 2 * 2816 * 2;
constexpr size_t OUT_K = (size_t)MROWS * 1024;
constexpr size_t OUT_V = OUT_K + (size_t)32 * 2 * 256 * 256;
constexpr size_t OUT_H = OUT_V + (size_t)32 * 2 * 256 * 256;

struct Params {
    const float *x_prompt, *x_sample, *cache_k, *cache_v, *state_lru, *c, *c_ctx, *w_ada, *b_ada, *norm1, *norm2,
        *w_in, *b_gate, *lru_conv, *lru_conv_b, *lru_wa, *lru_ba, *lru_wx, *lru_bx, *lru_lambda, *attn_sink,
        *pool_w, *pool_scale, *w_branch, *w_out, *ffn_up, *ffn_conv, *ffn_conv_b, *ffn_down, *final_norm;
    float* out; unsigned char* ws;
};

typedef float f32x2_ __attribute__((ext_vector_type(2)));
typedef __bf16 bf16x2_ __attribute__((ext_vector_type(2)));
__device__ __forceinline__ unsigned pack2(float a, float b) { const f32x2_ v = {a, b}; const bf16x2_ r = __builtin_convertvector(v, bf16x2_); return __builtin_bit_cast(unsigned, r); }
__device__ __forceinline__ unsigned short f2bf(float f) { return (unsigned short)(pack2(f, f) & 0xffffu); }
__device__ __forceinline__ float bf2f(unsigned short b) { return __uint_as_float(((unsigned)b) << 16); }
__device__ __forceinline__ int otid() { int t = threadIdx.x; asm volatile("" : "+v"(t)); return t; }
__device__ __forceinline__ float sigmoidf_(float x) { return __builtin_amdgcn_rcpf(1.0f + __expf(-x)); }

constexpr int HTB = 128 * 64 * 2;
__device__ __forceinline__ int lds_byte(int r, int c) { const int st = (r >> 4) * 2 + (c >> 5), rr = r & 15, cc = c & 31, ob = rr * 64 + cc * 2; return st * 1024 + (ob ^ (((ob >> 9) & 1) << 5)); }
__device__ __forceinline__ void stage_rc(int b, int& R, int& C) { const int st = b / 1024, sb = b % 1024, swz = sb ^ (((sb >> 9) & 1) << 5); R = (st >> 1) * 16 + swz / 64; C = (st & 1) * 32 + (swz % 64) / 2; }

struct Unit { const char* a; const char* b; int pm, pn, z, row0, m192; };
struct Sched {
    const char* A; const char* B; int lda, ldb, acol, nM, nN, G, c, tm;
    __device__ __forceinline__ bool next(int i, Unit& u) const {
        const long L = (long)i * G + c; const int nwg = nM * nN; if (L >= nwg) return false;
        int wgid = (int)L; { const int q = nwg / 8, r = nwg % 8, xcd = wgid % 8, off = wgid / 8; wgid = (xcd < r ? xcd * (q + 1) : r * (q + 1) + (xcd - r) * q) + off; }
        const int nig = 8 * nN, gid = wgid / nig, fm = gid * 8, gsz = (nM - fm) < 8 ? (nM - fm) : 8;
        u.pm = fm + ((wgid % nig) % gsz); u.pn = (wgid % nig) / gsz;
        u.a = A + ((size_t)u.pm * tm * lda + (size_t)u.pn * acol) * 2; u.b = B + (size_t)u.pn * 256 * ldb * 2; u.z = 0; u.row0 = u.pm * tm; u.m192 = (tm == 192); return true;
    }
};
struct MergeSched {
    const char* ws; int lda, ldb, c; bool helper;
    __device__ __forceinline__ bool next(int i, Unit& u) const {
        int owner, z; int c = this->c; asm volatile("" : "+s"(c));
        if (!helper) { if (c >= 192 || i >= 5) return false; owner = c; z = i < 4 ? i : 5; }
        else { const int hi = c - 192; if (hi < 0 || hi >= 64 || i >= 3) return false; owner = hi + 64 * i; z = 4; }
        const int nN = 4;
        int wgid = owner; { const int q = 24, xcd = wgid % 8, off = wgid / 8; wgid = xcd * q + off; }
        const int nig = 8 * nN, gid = wgid / nig, fm = gid * 8;
        u.pm = fm + ((wgid % nig) % 8); u.pn = (wgid % nig) / 8; u.z = z; u.row0 = u.pm * 256; u.m192 = 0;
        const int j = z >> 1;
        const size_t aoff = (size_t)u.row0 * 1024 * 2;
        size_t ao = OFF_H, bo = OFF_WIN + (size_t)3584 * 1024 * 2;
        if (z & 1) { bo = OFF_WBR; ao = OFF_YA; if (j == 1) ao = OFF_YB; if (j == 2) ao = OFF_XC; }
        u.a = ws + ao + aoff; u.b = ws + bo + ((size_t)j * 1024 + (size_t)u.pn * 256) * 1024 * 2;
        return true;
    }
};

template <class Epi, class SchedT, bool M192 = false>
__device__ __forceinline__ void gemm_phase(LAS unsigned char* lds, const SchedT& S, const int K_, const Epi& E) {
    int K = K_; asm volatile("" : "+s"(K));
    int tid_ = threadIdx.x; asm volatile("" : "+v"(tid_));
    const int tid = tid_, wid = __builtin_amdgcn_readfirstlane(tid >> 6), lane = tid & 63, wr = wid >> 2, wc = wid & 3, fr = lane & 15, fq = lane >> 4;
    const int nt = K / 64;
    unsigned voffA[2], voffB[2];
#pragma unroll
    for (int i = 0; i < 2; ++i) { int R, C; stage_rc(tid * 16 + i * 8192, R, C); voffA[i] = (unsigned)(R * S.lda + C) * 2u; voffB[i] = (unsigned)(R * S.ldb + C) * 2u; }
    const size_t kstep = 128;
    const size_t hstepA = (size_t)128 * S.lda * 2, hstepB = (size_t)128 * S.ldb * 2;
    const unsigned ldsw = (unsigned)wid * 1024u;
    const int aoff = lds_byte(wr * 64 + fr, fq * 8), boff = lds_byte(wc * 32 + fr, fq * 8);
#define G_SA(b, h) (((b) * 2 + (h)) * HTB)
#define G_SB(b, h) ((4 + (b) * 2 + (h)) * HTB)
#define G_STAGE(bufoff, gbase, voff) do { _Pragma("unroll") for (int _i = 0; _i < 2; ++_i) \
        __builtin_amdgcn_global_load_lds((const unsigned*)((const char*)(gbase) + (voff)[_i]), (LAS unsigned*)(lds + (bufoff) + ldsw + _i * 8192), 16, 0, 0); } while (0)
#define G_LDA(dst, b, h) do { _Pragma("unroll") for (int m = 0; m < 4; ++m) _Pragma("unroll") for (int k = 0; k < 2; ++k) dst[m][k] = *(const LAS bf16x8*)(lds + G_SA(b, h) + aoff + m * 2048 + k * 1024); } while (0)
#define G_LDB(dst, b, h) do { _Pragma("unroll") for (int n = 0; n < 2; ++n) _Pragma("unroll") for (int k = 0; k < 2; ++k) dst[n][k] = *(const LAS bf16x8*)(lds + G_SB(b, h) + boff + n * 2048 + k * 1024); } while (0)
#define G_MMA(ai, bj, At, Bt) do { if (M192 && (ai) == 1 && wr == 1) break; __builtin_amdgcn_s_setprio(1); _Pragma("unroll") for (int m = 0; m < 4; ++m) _Pragma("unroll") for (int n = 0; n < 2; ++n) _Pragma("unroll") for (int k = 0; k < 2; ++k) \
        acc[ai][bj][m][n] = __builtin_amdgcn_mfma_f32_16x16x32_bf16(Bt[n][k], At[m][k], acc[ai][bj][m][n], 0, 0, 0); __builtin_amdgcn_s_setprio(0); } while (0)
#define G_WAIT_V(n) asm volatile("s_waitcnt vmcnt(" #n ")" ::: "memory")
#define G_WAIT_L(n) asm volatile("s_waitcnt lgkmcnt(" #n ")" ::: "memory")
#define G_BAR __builtin_amdgcn_s_barrier()
#define G_SCHED __builtin_amdgcn_sched_barrier(0)
    Unit cur, nxt; int ui = 0;
    if (!S.next(0, cur)) return;
    f32x4 acc[2][2][4][2];
#pragma unroll
    for (int a = 0; a < 2; ++a)
#pragma unroll
        for (int b = 0; b < 2; ++b)
#pragma unroll
            for (int m = 0; m < 4; ++m)
#pragma unroll
                for (int n = 0; n < 2; ++n) acc[a][b][m][n] = (f32x4){0.f, 0.f, 0.f, 0.f};
    bf16x8 At[4][2], B0[2][2], B1[2][2];
    const char* cA = cur.a; const char* cB = cur.b;
    G_STAGE(G_SB(0, 0), cB, voffB); G_STAGE(G_SA(0, 0), cA, voffA); G_STAGE(G_SB(0, 1), cB + hstepB, voffB); G_STAGE(G_SA(0, 1), cA + hstepA, voffA);
    if (wr == 1) G_BAR;
    G_WAIT_V(4); G_BAR;
    G_STAGE(G_SB(1, 0), cB + kstep, voffB); G_STAGE(G_SA(1, 0), cA + kstep, voffA); G_STAGE(G_SB(1, 1), cB + hstepB + kstep, voffB);
    G_WAIT_V(6); G_BAR;
    for (;;) {
        const bool has_next = S.next(ui + 1, nxt);
        const char* nA = has_next ? nxt.a : cA; const char* nB = has_next ? nxt.b : cB;
        for (int t = 0; t < nt; t += 2) {
            const bool last = (t == nt - 2);
            const char* a1 = cA + (size_t)(t + 1) * kstep;
            const char* a2 = last ? nA : cA + (size_t)(t + 2) * kstep; const char* b2 = last ? nB : cB + (size_t)(t + 2) * kstep;
            const char* a3 = a2 + kstep; const char* b3 = b2 + kstep;
            G_LDB(B0, 0, 0); G_SCHED; G_LDA(At, 0, 0); G_STAGE(G_SA(1, 1), a1 + hstepA, voffA);
            G_WAIT_L(8); G_BAR; G_WAIT_L(0); G_MMA(0, 0, At, B0); G_BAR; G_SCHED;
            G_LDB(B1, 0, 1); G_STAGE(G_SB(0, 0), b2, voffB);
            G_BAR; G_WAIT_L(0); G_MMA(0, 1, At, B1); G_BAR;
            G_LDA(At, 0, 1); G_STAGE(G_SA(0, 0), a2, voffA);
            G_BAR; G_WAIT_L(0); G_MMA(1, 0, At, B0); G_BAR; G_SCHED;
            G_STAGE(G_SB(0, 1), b2 + hstepB, voffB);
            G_WAIT_V(6); G_BAR; G_MMA(1, 1, At, B1); G_BAR;
            G_LDB(B0, 1, 0); G_SCHED; G_LDA(At, 1, 0); G_STAGE(G_SA(0, 1), a2 + hstepA, voffA);
            G_WAIT_L(8); G_BAR; G_WAIT_L(0); G_MMA(0, 0, At, B0); G_BAR; G_SCHED;
            G_LDB(B1, 1, 1); G_STAGE(G_SB(1, 0), b3, voffB);
            G_BAR; G_WAIT_L(0); G_MMA(0, 1, At, B1); G_BAR;
            G_LDA(At, 1, 1); G_STAGE(G_SA(1, 0), a3, voffA);
            G_BAR; G_WAIT_L(0); G_MMA(1, 0, At, B0); G_BAR; G_SCHED;
            G_STAGE(G_SB(1, 1), b3 + hstepB, voffB);
            G_WAIT_V(6); G_BAR; G_MMA(1, 1, At, B1); G_BAR;
        }
        E(acc, cur, wr, wc, fr, fq);
        if (!has_next) break;
#pragma unroll
        for (int a = 0; a < 2; ++a)
#pragma unroll
            for (int b = 0; b < 2; ++b)
#pragma unroll
                for (int m = 0; m < 4; ++m)
#pragma unroll
                    for (int n = 0; n < 2; ++n) acc[a][b][m][n] = (f32x4){0.f, 0.f, 0.f, 0.f};
        cur = nxt; cA = nA; cB = nB; ++ui;
    }
    G_WAIT_V(0);
    if (wr == 0) G_BAR;
    G_BAR;
#undef G_SA
#undef G_SB
#undef G_STAGE
#undef G_LDA
#undef G_LDB
#undef G_MMA
#undef G_WAIT_V
#undef G_WAIT_L
#undef G_BAR
#undef G_SCHED
}

#define EPI_LOOP_BEGIN \
    _Pragma("unroll") for (int ai = 0; ai < 2; ++ai) _Pragma("unroll") for (int m = 0; m < 4; ++m) { const int row = u.pm * 256 + wr * 64 + fr + ai * 128 + m * 16; \
    _Pragma("unroll") for (int bj = 0; bj < 2; ++bj) _Pragma("unroll") for (int n = 0; n < 2; ++n) { const int cl = wc * 32 + 4 * fq + bj * 128 + n * 16; const f32x4 v = acc[ai][bj][m][n];
#define EPI_LOOP_END } }

__device__ __forceinline__ int seq_group(int row) { return row < MCTX ? 0 : 1 + ((row - MCTX) >> 11); }

struct EpiIn {
    bf16_t* xaq; bf16_t* xc; bf16_t* kb; bf16_t* vb; float* outk; float* outv; const float* rc; int l;
    __device__ __forceinline__ void operator()(const f32x4 (&acc)[2][2][4][2], const Unit& u, int wr, int wc, int fr, int fq) const {
        const int pn = u.pn; const bool qk = pn >= 4 && pn <= 8;
        bf16_t* dst; int ld, cbase; float* fo = nullptr;
        if (pn < 4) { dst = xaq; ld = 1024; cbase = pn * 256; }
        else if (pn < 8) { dst = xaq + (size_t)MROWS * 1024; ld = 1024; cbase = pn * 256 - 1024; }
        else if (pn == 8) { dst = kb; ld = 256; cbase = 0; fo = outk; }
        else if (pn == 9) { dst = vb; ld = 256; cbase = 0; fo = outv; }
        else { dst = xc; ld = 1024; cbase = pn * 256 - 2560; }
        const int hh = wc >> 1, i0 = 16 * (wc & 1) + 4 * fq;
        const int c1 = cbase + (qk ? 64 * hh + i0 : wc * 32 + 4 * fq), dc = qk ? 32 : 16;
        const bool rope = qk && u.pm >= 32;
#pragma unroll
        for (int ai = 0; ai < 2; ++ai) {
            f32x4 csm[4], snm[4];
#pragma unroll
            for (int m = 0; m < 4; ++m) { csm[m] = (f32x4){1.f, 1.f, 1.f, 1.f}; snm[m] = (f32x4){0.f, 0.f, 0.f, 0.f};
                if (rope) { const int row = u.pm * 256 + wr * 64 + fr + ai * 128 + m * 16; const int t = (row - MCTX) & 2047; const int pos = hh == 0 ? (t >> 6) : (t & 63);
                    csm[m] = *(const f32x4*)(rc + pos * 32 + i0); snm[m] = *(const f32x4*)(rc + 2048 + pos * 32 + i0); } }
#pragma unroll
            for (int m = 0; m < 4; ++m) {
                const int row = u.pm * 256 + wr * 64 + fr + ai * 128 + m * 16;
                const f32x4 cs = csm[m], sn = snm[m];
                bf16_t* dp = dst + (size_t)row * ld + c1;
                float* fp = fo + ((size_t)(((row >> 8) * 2 + l) * 256 + (row & 255))) * 256 + c1;
#pragma unroll
                for (int bj = 0; bj < 2; ++bj) {
                    const f32x4 x1 = acc[ai][bj][m][0], x2 = acc[ai][bj][m][1];
                    const f32x4 o1 = x1 * cs - x2 * sn, o2 = x1 * sn + x2 * cs;
                    uint2 p1, p2; p1.x = pack2(o1[0], o1[1]); p1.y = pack2(o1[2], o1[3]); p2.x = pack2(o2[0], o2[1]); p2.y = pack2(o2[2], o2[3]);
                    *(uint2*)(dp + bj * 128) = p1; *(uint2*)(dp + bj * 128 + dc) = p2;
                    if (fo != nullptr && row < MCTX) { *(f32x4*)(fp + bj * 128) = o1; *(f32x4*)(fp + bj * 128 + dc) = o2; }
                }
            }
        }
    }
};
struct EpiGate {
    bf16_t* gt; const float* bias;
    __device__ __forceinline__ void operator()(const f32x4 (&acc)[2][2][4][2], const Unit& u, int wr, int wc, int fr, int fq) const {
        const int c0 = u.pn * 256 + wc * 32 + 4 * fq;
        f32x4 bb[4];
#pragma unroll
        for (int g = 0; g < 4; ++g) bb[g] = *(const f32x4*)(bias + c0 + (g >> 1) * 128 + (g & 1) * 16);
#pragma unroll
        for (int ai = 0; ai < 2; ++ai) { if (ai == 1 && u.m192 && wr == 1) continue;
#pragma unroll
            for (int m = 0; m < 4; ++m) { const int row = u.row0 + wr * 64 + fr + ai * 128 + m * 16;
#pragma unroll
                for (int g = 0; g < 4; ++g) { const f32x4 v = acc[ai][g >> 1][m][g & 1];
                    uint2 pk; pk.x = pack2(sigmoidf_(v[0] + bb[g][0]), sigmoidf_(v[1] + bb[g][1])); pk.y = pack2(sigmoidf_(v[2] + bb[g][2]), sigmoidf_(v[3] + bb[g][3]));
                    *(uint2*)(gt + (size_t)row * 1024 + c0 + (g >> 1) * 128 + (g & 1) * 16) = pk; } } }
    }
};
template <int j> struct EpiBranch {
    const bf16_t* gt; float* tmp; bf16_t* mg;
    __device__ __forceinline__ void operator()(const f32x4 (&acc)[2][2][4][2], const Unit& u, int wr, int wc, int fr, int fq) const {
        const int c0 = u.pn * 256 + wc * 32 + 4 * fq;
#pragma unroll
        for (int ai = 0; ai < 2; ++ai) { if (ai == 1 && u.m192 && wr == 1) continue;
#pragma unroll
            for (int m = 0; m < 4; ++m) {
                const unsigned ro = (unsigned)(u.row0 + wr * 64 + fr + ai * 128 + m * 16) * 1024u + (unsigned)c0;
                uint2 gp[4]; f32x4 tv[4];
#pragma unroll
                for (int g = 0; g < 4; ++g) { const unsigned o = ro + (g >> 1) * 128 + (g & 1) * 16;
                    gp[g] = *(const uint2*)(gt + o); tv[g] = (f32x4){0.f, 0.f, 0.f, 0.f}; if (j != 0) tv[g] = *(const f32x4*)(tmp + o); }
#pragma unroll
                for (int g = 0; g < 4; ++g) { const unsigned o = ro + (g >> 1) * 128 + (g & 1) * 16;
                    const f32x4 v = acc[ai][g >> 1][m][g & 1];
                    f32x4 r = tv[g];
                    r[0] += v[0] * bf2f((unsigned short)(gp[g].x & 0xffff)); r[1] += v[1] * bf2f((unsigned short)(gp[g].x >> 16));
                    r[2] += v[2] * bf2f((unsigned short)(gp[g].y & 0xffff)); r[3] += v[3] * bf2f((unsigned short)(gp[g].y >> 16));
                    if (j != 2) *(f32x4*)(tmp + o) = r;
                    else { uint2 pk; pk.x = pack2(r[0], r[1]); pk.y = pack2(r[2], r[3]); *(uint2*)(mg + o) = pk; } }
            } }
    }
};
struct EpiMerge {
    bf16_t* gt; const float* bgate; float* tmp; bf16_t* mg; unsigned* flags;
    __device__ __forceinline__ void operator()(const f32x4 (&acc)[2][2][4][2], const Unit& u, int wr, int wc, int fr, int fq) const {
        const int j = u.z >> 1;
        if ((u.z & 1) == 0) {
            EpiGate E{u.z == 4 ? mg : gt, bgate + j * 1024}; E(acc, u, wr, wc, fr, fq);
            if (u.z == 4) {
                asm volatile("s_waitcnt vmcnt(0)" ::: "memory");
                unsigned old_ = 0u;
                if (fr == 0 && fq == 0) old_ = __hip_atomic_fetch_add(flags + u.pm * 4 + u.pn, 1u, __ATOMIC_RELAXED, __HIP_MEMORY_SCOPE_AGENT);
                old_ = (unsigned)__builtin_amdgcn_readfirstlane(old_);
                if (old_ == 7u) {
                    __builtin_amdgcn_fence(__ATOMIC_RELEASE, "agent");
                    asm volatile("s_waitcnt vmcnt(0)" ::: "memory");
                    if (fr == 0 && fq == 0) __hip_atomic_fetch_add(flags + u.pm * 4 + u.pn, 256u, __ATOMIC_RELAXED, __HIP_MEMORY_SCOPE_AGENT);
                }
            }
        }
        else if (j == 0) { EpiBranch<0> E{gt, tmp, mg}; E(acc, u, wr, wc, fr, fq); }
        else if (j == 1) { EpiBranch<1> E{gt, tmp, mg}; E(acc, u, wr, wc, fr, fq); }
        else {
            { unsigned* f = flags + u.pm * 4 + u.pn; unsigned sp = 0;
              while ((unsigned)__builtin_amdgcn_readfirstlane(__hip_atomic_load(f, __ATOMIC_RELAXED, __HIP_MEMORY_SCOPE_AGENT)) < 256u) { __builtin_amdgcn_s_sleep(2); if (++sp > (1u << 20)) break; }
              __builtin_amdgcn_fence(__ATOMIC_ACQUIRE, "agent");
              asm volatile("s_waitcnt vmcnt(0)" ::: "memory"); }
            EpiBranch<2> E{mg, tmp, mg}; E(acc, u, wr, wc, fr, fq);
        }
    }
};
struct EpiRes {
    float* x; const float* mod; int goff; const float* xa; const float* xb;
    __device__ __forceinline__ const float* src(unsigned o) const { return o < (unsigned)MCTX * 1024u ? xa + o : xb + (o - (unsigned)MCTX * 1024u); }
    __device__ __forceinline__ void operator()(const f32x4 (&acc)[2][2][4][2], const Unit& u, int wr, int wc, int fr, int fq) const {
        const int c0 = u.pn * 256 + wc * 32 + 4 * fq;
        const int sg0 = seq_group(u.row0), sg1 = seq_group(u.row0 + (u.m192 ? 191 : 255));
        if (sg0 == sg1) {
            const float* gsrc = mod + sg0 * 6144 + goff;
            f32x4 gg[4];
#pragma unroll
            for (int g = 0; g < 4; ++g) gg[g] = *(const f32x4*)(gsrc + c0 + (g >> 1) * 128 + (g & 1) * 16);
#pragma unroll
            for (int ai = 0; ai < 2; ++ai) { if (ai == 1 && u.m192 && wr == 1) continue;
#pragma unroll
                for (int mp = 0; mp < 2; ++mp) {
                    const unsigned ro = (unsigned)(u.row0 + wr * 64 + fr + ai * 128 + mp * 32) * 1024u + (unsigned)c0;
                    f32x4 xv[8];
#pragma unroll
                    for (int k = 0; k < 8; ++k) { const int g = k & 3; xv[k] = *(const f32x4*)src(ro + (k >> 2) * 16384 + (g >> 1) * 128 + (g & 1) * 16); }
#pragma unroll
                    for (int k = 0; k < 8; ++k) { const int g = k & 3, m = mp * 2 + (k >> 2); *(f32x4*)(x + (ro + (k >> 2) * 16384 + (g >> 1) * 128 + (g & 1) * 16)) = xv[k] + gg[g] * acc[ai][g >> 1][m][g & 1]; }
                } }
        } else {
#pragma unroll
            for (int ai = 0; ai < 2; ++ai) { if (ai == 1 && u.m192 && wr == 1) continue;
#pragma unroll
                for (int m = 0; m < 4; ++m) {
                    const int row = u.row0 + wr * 64 + fr + ai * 128 + m * 16;
                    const float* gsrc = mod + seq_group(row) * 6144 + goff + c0;
                    const unsigned ro = (unsigned)row * 1024u + (unsigned)c0;
                    f32x4 xv[4], gv[4];
#pragma unroll
                    for (int g = 0; g < 4; ++g) { xv[g] = *(const f32x4*)src(ro + (g >> 1) * 128 + (g & 1) * 16); gv[g] = *(const f32x4*)(gsrc + (g >> 1) * 128 + (g & 1) * 16); }
#pragma unroll
                    for (int g = 0; g < 4; ++g) *(f32x4*)(x + (ro + (g >> 1) * 128 + (g & 1) * 16)) = xv[g] + gv[g] * acc[ai][g >> 1][m][g & 1];
                } }
        }
    }
};
struct EpiBf {
    bf16_t* dst; int ld;
    __device__ __forceinline__ void operator()(const f32x4 (&acc)[2][2][4][2], const Unit& u, int wr, int wc, int fr, int fq) const {
        EPI_LOOP_BEGIN
            const int col = u.pn * 256 + cl;
            uint2 pk; pk.x = pack2(v[0], v[1]); pk.y = pack2(v[2], v[3]);
            *(uint2*)(dst + (size_t)row * ld + col) = pk;
        EPI_LOOP_END
    }
};
__device__ __forceinline__ float dpp_f(float old, float src, const int ctrl_sel) {
    const int o = __float_as_int(old), v = __float_as_int(src);
    int r;
    if (ctrl_sel == 0) r = __builtin_amdgcn_update_dpp(o, v, 0x111, 0xf, 0xf, false);
    else if (ctrl_sel == 1) r = __builtin_amdgcn_update_dpp(o, v, 0x101, 0xf, 0xf, false);
    else if (ctrl_sel == 2) r = __builtin_amdgcn_update_dpp(o, v, 0x121, 0xf, 0xf, false);
    else r = __builtin_amdgcn_update_dpp(o, v, 0x12f, 0xf, 0xf, false);
    return __int_as_float(r);
}
__device__ __forceinline__ float gelu_tanh(float x) { const float y = 0.7978845608028654f * (x + 0.044715f * x * x * x); const float t = 1.0f - 2.0f * __builtin_amdgcn_rcpf(1.0f + __expf(2.0f * y)); return 0.5f * x * (1.0f + t); }
struct EpiUp {
    bf16_t* act; bf16_t* su; bf16_t* sv; const float* cw; const float* cb;
    __device__ __forceinline__ void operator()(const f32x4 (&acc)[2][2][4][2], const Unit& u, int wr, int wc, int fr, int fq) const {
#pragma unroll
        for (int n = 0; n < 2; ++n) {
            const int ch = u.pn * 128 + wc * 32 + 16 * n + 4 * fq;
            const f32x4 w0 = *(const f32x4*)(cw + ch), w1 = *(const f32x4*)(cw + 2816 + ch), w2 = *(const f32x4*)(cw + 5632 + ch), bb = *(const f32x4*)(cb + ch);
#pragma unroll
            for (int ai = 0; ai < 2; ++ai) {
                const int rowg = u.row0 + ai * 128 + wr * 64;
                f32x4 ub[4];
#pragma unroll
                for (int m = 0; m < 4; ++m)
#pragma unroll
                    for (int e = 0; e < 4; ++e) ub[m][e] = bf2f(f2bf(acc[ai][0][m][n][e]));
#pragma unroll
                for (int m = 0; m < 4; ++m) {
                    const int row = rowg + m * 16 + fr;
                    f32x4 r;
#pragma unroll
                    for (int e = 0; e < 4; ++e) {
                        const float pl = m > 0 ? dpp_f(0.f, ub[m > 0 ? m - 1 : 0][e], 2) : 0.f;
                        const float pv = dpp_f(pl, ub[m][e], 0);
                        const float nl = m < 3 ? dpp_f(0.f, ub[m < 3 ? m + 1 : 3][e], 3) : 0.f;
                        const float nv = dpp_f(nl, ub[m][e], 1);
                        const float gff = w0[e] * pv + w1[e] * ub[m][e] + w2[e] * nv + bb[e];
                        r[e] = gelu_tanh(gff) * bf2f(f2bf(acc[ai][1][m][n][e]));
                    }
                    const bool edge = (m == 0 && fr == 0) || (m == 3 && fr == 15);
                    if (!edge) { uint2 pk; pk.x = pack2(r[0], r[1]); pk.y = pack2(r[2], r[3]); *(uint2*)(act + (size_t)row * 2816 + ch) = pk; }
                    if ((m == 0 && fr < 2) || (m == 3 && fr >= 14)) {
                        const int slot = m == 0 ? fr : fr - 12; const int g64 = rowg >> 6;
                        uint2 pk; pk.x = pack2(ub[m][0], ub[m][1]); pk.y = pack2(ub[m][2], ub[m][3]);
                        *(uint2*)(su + ((size_t)g64 * 4 + slot) * 2816 + ch) = pk;
                        if (edge) { const f32x4 vv = acc[ai][1][m][n]; uint2 pv2; pv2.x = pack2(vv[0], vv[1]); pv2.y = pack2(vv[2], vv[3]); *(uint2*)(sv + ((size_t)g64 * 2 + (m == 0 ? 0 : 1)) * 2816 + ch) = pv2; }
                    }
                }
            }
        }
    }
};
struct EpiPool {
    bf16_t* dst; const float* scale;
    __device__ __forceinline__ void operator()(const f32x4 (&acc)[2][2][4][2], const Unit& u, int wr, int wc, int fr, int fq) const {
        const int c0 = u.pn * 256 + wc * 32 + 4 * fq;
        f32x4 sc[4];
#pragma unroll
        for (int g = 0; g < 4; ++g) sc[g] = *(const f32x4*)(scale + c0 + (g >> 1) * 128 + (g & 1) * 16);
#pragma unroll
        for (int ai = 0; ai < 2; ++ai)
#pragma unroll
            for (int m = 0; m < 4; ++m) { const int row = u.pm * 256 + wr * 64 + fr + ai * 128 + m * 16;
#pragma unroll
                for (int g = 0; g < 4; ++g) { const f32x4 v = acc[ai][g >> 1][m][g & 1] * sc[g];
                    uint2 pk; pk.x = pack2(v[0], v[1]); pk.y = pack2(v[2], v[3]);
                    *(uint2*)(dst + (size_t)row * 1024 + c0 + (g >> 1) * 128 + (g & 1) * 16) = pk; } }
    }
};

struct WPtrs { const float *w_in, *w_branch, *lru_wa, *lru_wx, *pool_w, *w_out, *ffn_up, *ffn_down; unsigned char* ws; };
struct TileDesc { const float* src; int lds_; bf16_t* dst; int ldd, k0, n0, perm, nd; };
__device__ __forceinline__ int swap45(int p) { return (p & ~48) | ((p & 16) << 1) | ((p & 32) >> 1); }
__device__ __forceinline__ TileDesc weight_tile(const WPtrs& P, int l, int t) {
    unsigned char* ws = P.ws; TileDesc d; int r = t; d.perm = 0; d.nd = -1;
    if (r < 1664) { d.src = P.w_in + (size_t)l * 1024 * 6656; d.lds_ = 6656; d.dst = (bf16_t*)(ws + OFF_WIN); d.ldd = 1024; d.k0 = (r / 104) * 64; d.n0 = (r % 104) * 64; d.perm = (d.n0 >= 1024 && d.n0 < 2304) ? 1 : 0; }
    else if ((r -= 1664) < 128) { const int mat = r / 64; r %= 64; const int dh = r / 4; r %= 4;
        d.src = (mat ? P.lru_wx : P.lru_wa) + (size_t)(l * 16 + dh) * 128 * 128; d.lds_ = 128; d.dst = (bf16_t*)(ws + OFF_GW) + (size_t)dh * 256 * 128 + (size_t)mat * 128 * 128; d.ldd = 128; d.k0 = (r / 2) * 64; d.n0 = (r % 2) * 64; }
    else if ((r -= 128) < 64) { const int g = r / 16; r %= 16; d.src = P.pool_w + (size_t)(l * 4 + g) * 256 * 256; d.lds_ = 256; d.dst = (bf16_t*)(ws + OFF_PW) + (size_t)g * 256 * 256; d.ldd = 256; d.k0 = (r / 4) * 64; d.n0 = (r % 4) * 64; }
    else if ((r -= 64) < 768) { const int j = r / 256; r %= 256; d.src = P.w_branch + (size_t)(l * 3 + j) * 1024 * 1024; d.lds_ = 1024; d.dst = (bf16_t*)(ws + OFF_WBR) + (size_t)j * 1024 * 1024; d.ldd = 1024; d.k0 = (r / 16) * 64; d.n0 = (r % 16) * 64; }
    else if ((r -= 768) < 256) { d.src = P.w_out + (size_t)l * 1024 * 1024; d.lds_ = 1024; d.dst = (bf16_t*)(ws + OFF_WOUT); d.ldd = 1024; d.k0 = (r / 16) * 64; d.n0 = (r % 16) * 64; }
    else if ((r -= 256) < 1408) { d.src = P.ffn_up + (size_t)l * 1024 * 5632; d.lds_ = 5632; d.dst = (bf16_t*)(ws + OFF_WUP); d.ldd = 1024; d.k0 = (r / 88) * 64; d.n0 = (r % 88) * 64;
        { const int isv = d.n0 >= 2816, c0 = isv ? d.n0 - 2816 : d.n0; d.nd = (c0 >> 7) * 256 + (c0 & 127) + (isv ? 128 : 0); } }
    else { r -= 1408; d.src = P.ffn_down + (size_t)l * 2816 * 1024; d.lds_ = 1024; d.dst = (bf16_t*)(ws + OFF_WDN); d.ldd = 2816; d.k0 = (r / 16) * 64; d.n0 = (r % 16) * 64; }
    return d;
}
__device__ __noinline__ void convert_weights_(const float* p0, const float* p1, const float* p2, const float* p3, const float* p4, const float* p5, const float* p6, const float* p7, unsigned char* pws,
                                              int l, LAS unsigned char* lds, int t_begin, int t_end, int first, int stride) {
    const WPtrs P{p0, p1, p2, p3, p4, p5, p6, p7, pws};
    LAS bf16_t* sm = (LAS bf16_t*)lds;
    const int tid = otid();
    const int kk0 = tid >> 4, n4 = (tid & 15) * 4, nn = tid >> 3, ck = tid & 7;
    int t = t_begin + first;
    if (t >= t_end) return;
    TileDesc d = weight_tile(P, l, t);
    f32x4 v0 = __builtin_nontemporal_load((const f32x4*)(d.src + (size_t)(d.k0 + kk0) * d.lds_ + d.n0 + n4)), v1 = __builtin_nontemporal_load((const f32x4*)(d.src + (size_t)(d.k0 + kk0 + 32) * d.lds_ + d.n0 + n4));
    for (;;) {
        __syncthreads();
#pragma unroll
        for (int e = 0; e < 4; ++e) { sm[(n4 + e) * 72 + kk0] = f2bf(v0[e]); sm[(n4 + e) * 72 + kk0 + 32] = f2bf(v1[e]); }
        __syncthreads();
        const TileDesc cur = d; const int tn = t + stride; const bool more = tn < t_end;
        if (more) { d = weight_tile(P, l, tn); v0 = __builtin_nontemporal_load((const f32x4*)(d.src + (size_t)(d.k0 + kk0) * d.lds_ + d.n0 + n4)); v1 = __builtin_nontemporal_load((const f32x4*)(d.src + (size_t)(d.k0 + kk0 + 32) * d.lds_ + d.n0 + n4)); }
        const u32x4 o = *(const LAS u32x4*)(sm + nn * 72 + ck * 8);
        const int nrow = cur.perm ? swap45(cur.n0 + nn) : ((cur.nd >= 0 ? cur.nd : cur.n0) + nn);
        *(u32x4*)(cur.dst + (size_t)nrow * cur.ldd + cur.k0 + ck * 8) = o;
        if (!more) break;
        t = tn;
    }
    __syncthreads();
}

__device__ __forceinline__ void convert_weights(const Params& P, int l, LAS unsigned char* lds, int t_begin, int t_end, int first, int stride) {
    convert_weights_(P.w_in, P.w_branch, P.lru_wa, P.lru_wx, P.pool_w, P.w_out, P.ffn_up, P.ffn_down, P.ws, l, lds, t_begin, t_end, first, stride);
}

__device__ void phase0(const Params& P, LAS unsigned char* lds) {
    const int tid = otid(), G = gridDim.x, c = blockIdx.x;
    { bf16_t* ck = (bf16_t*)(P.ws + OFF_CK); bf16_t* cv = (bf16_t*)(P.ws + OFF_CV);
      for (int i = c * 512 + tid; i < 2 * 2 * 512 * 256; i += G * 512) {
          const int e = i & 255, t = (i >> 8) & 511, b = (i >> 17) & 1, l = i >> 18;
          const size_t si = ((size_t)((b * 2 + l) * 512 + t)) * 256 + e;
          ck[i] = f2bf(P.cache_k[si]); cv[i] = f2bf(P.cache_v[si]); } }
    { float* rc = (float*)(P.ws + OFF_ROPE); float* rs = rc + 2048;
      for (int i = c * 512 + tid; i < 2048; i += G * 512) {
          const int pos = i >> 5, k = i & 31; const float fr = powf(10000.0f, -(float)k / 32.0f); const float ang = (float)pos * fr;
          rc[i] = cosf(ang); rs[i] = sinf(ang); } }
    { LAS float* sv = (LAS float*)lds;
      LAS float* red = sv + 3072;
      __syncthreads();
      for (int i = tid; i < 3072; i += 512) { const int s = i >> 10, k = i & 1023; const float x = s == 0 ? P.c_ctx[k] : P.c[(s - 1) * 1024 + k]; sv[i] = x / (1.0f + expf(-x)); }
      __syncthreads();
      float* mod = (float*)(P.ws + OFF_MOD);
      for (int it = c; it < 384; it += G) {
          const int l = it / 192, cg_ = it % 192, cl = tid & 31, kg = tid >> 5, col = cg_ * 32 + cl;
          const float* w = P.w_ada + (size_t)l * 1024 * 6144 + col;
          float a0 = 0.f, a1 = 0.f, a2 = 0.f;
#pragma unroll 16
          for (int k = kg * 64; k < kg * 64 + 64; ++k) { const float wv = __builtin_nontemporal_load(w + (size_t)k * 6144); a0 += sv[k] * wv; a1 += sv[1024 + k] * wv; a2 += sv[2048 + k] * wv; }
          red[(kg * 3 + 0) * 32 + cl] = a0; red[(kg * 3 + 1) * 32 + cl] = a1; red[(kg * 3 + 2) * 32 + cl] = a2;
          __syncthreads();
          if (tid < 96) { const int s = tid >> 5, cc = tid & 31; float sum = 0.f;
#pragma unroll
              for (int g = 0; g < 16; ++g) sum += red[(g * 3 + s) * 32 + cc];
              mod[(size_t)(l * 3 + s) * 6144 + cg_ * 32 + cc] = sum + P.b_ada[l * 6144 + cg_ * 32 + cc]; }
          __syncthreads();
      } }
}

template <bool FINAL>
__device__ __forceinline__ void norm_rows(float* X, const float* xa, const float* xb, const float* __restrict__ gw, const float* __restrict__ mod, int shift_off, int scale_off, bf16_t* __restrict__ H) {
    const int tid = otid(); const int lane = tid & 63, wv = blockIdx.x * 8 + (tid >> 6), nw = gridDim.x * 8;
    constexpr int R = 3;
    for (int row0 = wv; row0 < MROWS; row0 += R * nw) {
        f32x4 v[R][4];
#pragma unroll
        for (int r = 0; r < R; ++r) { const int row = row0 + r * nw;
#pragma unroll
            for (int i = 0; i < 4; ++i) v[r][i] = row < MROWS ? *(const f32x4*)((row < MCTX ? xa + (size_t)row * 1024 : xb + (size_t)(row - MCTX) * 1024) + i * 256 + lane * 4) : (f32x4){0.f, 0.f, 0.f, 0.f}; }
#pragma unroll
        for (int r = 0; r < R; ++r) { const int row = row0 + r * nw; if (row >= MROWS) continue;
            float ss = 0.f;
#pragma unroll
            for (int i = 0; i < 4; ++i) ss += v[r][i][0] * v[r][i][0] + v[r][i][1] * v[r][i][1] + v[r][i][2] * v[r][i][2] + v[r][i][3] * v[r][i][3];
#pragma unroll
            for (int o = 32; o >= 1; o >>= 1) ss += __shfl_xor(ss, o);
            const float rstd = rsqrtf(ss * (1.0f / 1024.0f) + 1e-6f);
            const float* md = mod + seq_group(row) * 6144;
#pragma unroll
            for (int i = 0; i < 4; ++i) { const int col = i * 256 + lane * 4;
                const f32x4 g = *(const f32x4*)(gw + col);
                if (FINAL) { f32x4 h;
#pragma unroll
                    for (int e = 0; e < 4; ++e) h[e] = v[r][i][e] * rstd * g[e];
                    *(f32x4*)(X + (size_t)row * 1024 + col) = h; }
                else { const f32x4 sc = *(const f32x4*)(md + scale_off + col), sh = *(const f32x4*)(md + shift_off + col);
                    f32x4 h;
#pragma unroll
                    for (int e = 0; e < 4; ++e) h[e] = v[r][i][e] * rstd * g[e] * (1.0f + sc[e]) + sh[e];
                    uint2 pk; pk.x = pack2(h[0], h[1]); pk.y = pack2(h[2], h[3]);
                    *(uint2*)(H + (size_t)row * 1024 + col) = pk; } }
        }
    }
}
__device__ void norm_phase(const float* xa, const float* xb, const float* __restrict__ gw, const float* __restrict__ mod, int shift_off, int scale_off, bf16_t* __restrict__ H) { norm_rows<false>(nullptr, xa, xb, gw, mod, shift_off, scale_off, H); }
__device__ void final_norm_phase(float* X, const float* __restrict__ gw) { norm_rows<true>(X, X, X + (size_t)MCTX * 1024, gw, nullptr, 0, 0, nullptr); }

template <int HALF>
__device__ __forceinline__ void pool_item(const bf16_t* __restrict__ XC, bf16_t* __restrict__ PL, int it) {
    constexpr int G_ = HALF == 1 ? 0 : (HALF == 2 ? 1 : (HALF == 4 ? 2 : 3));
    const int rs = (it >> 5) * 8, ch = G_ * 256 + (it & 31) * 8;
    const int T = rs < MCTX ? 256 : 2048, row0 = rs < MCTX ? (rs & ~255) : MCTX + ((rs - MCTX) & ~2047), tl0 = rs - row0;
    const bf16_t* base = XC + (size_t)row0 * 1024 + ch;
    constexpr int R = 8 + 2 * HALF;
    bf16x8 xr[R];
#pragma unroll
    for (int i = 0; i < R; ++i) { const int t = tl0 - HALF + i; xr[i] = (bf16x8){0, 0, 0, 0, 0, 0, 0, 0}; if (t >= 0 && t < T) xr[i] = *(const bf16x8*)(base + (size_t)t * 1024); }
    float s[8];
#pragma unroll
    for (int e = 0; e < 8; ++e) { s[e] = 0.f;
#pragma unroll
        for (int i = 0; i < 2 * HALF; ++i) s[e] += bf2f((unsigned short)xr[i][e]); }
#pragma unroll
    for (int j = 0; j < 8; ++j) {
        const int t = tl0 + j;
        const float inv = 1.0f / (float)(min(t + HALF, T) - max(t - HALF, 0));
        float r[8];
#pragma unroll
        for (int e = 0; e < 8; ++e) r[e] = s[e] * inv - bf2f((unsigned short)xr[j + HALF][e]);
        u32x4 o; o.x = pack2(r[0], r[1]); o.y = pack2(r[2], r[3]); o.z = pack2(r[4], r[5]); o.w = pack2(r[6], r[7]);
        *(u32x4*)(PL + (size_t)(row0 + t) * 1024 + ch) = o;
#pragma unroll
        for (int e = 0; e < 8; ++e) s[e] += bf2f((unsigned short)xr[j + 2 * HALF][e]) - bf2f((unsigned short)xr[j][e]);
    }
}
__device__ void pool_phase(const bf16_t* __restrict__ XC, bf16_t* __restrict__ PL) {
    const int tid = otid();
    constexpr int PER_G = (MROWS / 8) * 32;
    for (int idx = blockIdx.x * 512 + tid; idx < 4 * PER_G; idx += gridDim.x * 512) {
        const int g = idx / PER_G, it = idx % PER_G;
        if (g == 0) pool_item<1>(XC, PL, it); else if (g == 1) pool_item<2>(XC, PL, it); else if (g == 2) pool_item<4>(XC, PL, it); else pool_item<8>(XC, PL, it);
    }
}
__device__ void ffn_fix_groups(const bf16_t* __restrict__ SU, const bf16_t* __restrict__ SV, bf16_t* __restrict__ ACT, const float* __restrict__ cw, const float* __restrict__ cb, int g0, int ng) {
    const int tid = otid();
    for (int idx = tid; idx < ng * 2 * 352; idx += 512) {
        const int br = idx / 352, ch = (idx % 352) * 8;
        const int g = g0 + (br >> 1), last = br & 1;
        const int row = g * 64 + (last ? 63 : 0);
        const int T = row < MCTX ? 256 : 2048, row0 = row < MCTX ? (row & ~255) : MCTX + ((row - MCTX) & ~2047), tl = row - row0;
        const bf16x8 zero = (bf16x8){0, 0, 0, 0, 0, 0, 0, 0};
        bf16x8 um, u0, un;
        if (last) { um = *(const bf16x8*)(SU + ((size_t)g * 4 + 2) * 2816 + ch); u0 = *(const bf16x8*)(SU + ((size_t)g * 4 + 3) * 2816 + ch);
                    un = tl < T - 1 ? *(const bf16x8*)(SU + ((size_t)(g + 1) * 4 + 0) * 2816 + ch) : zero; }
        else { um = tl > 0 ? *(const bf16x8*)(SU + ((size_t)(g - 1) * 4 + 3) * 2816 + ch) : zero; u0 = *(const bf16x8*)(SU + ((size_t)g * 4 + 0) * 2816 + ch);
               un = *(const bf16x8*)(SU + ((size_t)g * 4 + 1) * 2816 + ch); }
        const bf16x8 vv = *(const bf16x8*)(SV + ((size_t)g * 2 + last) * 2816 + ch);
        float r[8];
#pragma unroll
        for (int e = 0; e < 8; ++e) { const float gff = cw[ch + e] * bf2f((unsigned short)um[e]) + cw[2816 + ch + e] * bf2f((unsigned short)u0[e]) + cw[5632 + ch + e] * bf2f((unsigned short)un[e]) + cb[ch + e];
            r[e] = gelu_tanh(gff) * bf2f((unsigned short)vv[e]); }
        u32x4 o; o.x = pack2(r[0], r[1]); o.y = pack2(r[2], r[3]); o.z = pack2(r[4], r[5]); o.w = pack2(r[6], r[7]);
        *(u32x4*)(ACT + (size_t)row * 2816 + ch) = o;
    }
}

__device__ __forceinline__ void rope8(bf16x8& x1, bf16x8& x2, const float* __restrict__ cs, const float* __restrict__ sn) {
#pragma unroll
    for (int e = 0; e < 8; ++e) { const float a = bf2f((unsigned short)x1[e]), b = bf2f((unsigned short)x2[e]); const float c = cs[e], s = sn[e];
        x1[e] = (short)f2bf(a * c - b * s); x2[e] = (short)f2bf(a * s + b * c); }
}
constexpr int VT_OFF = 64 * 272;
constexpr int ABUF = 64 * 272 + 64 * 288;
__device__ void attn_unit(const Params& P, int l, int u, LAS unsigned char* lds) {
    int tid_ = threadIdx.x; asm volatile("" : "+v"(tid_));
    const int tid = tid_, w = tid >> 6, lane = tid & 63, fr = lane & 15, fq = lane >> 4;
    const bf16_t* Q = (const bf16_t*)(P.ws + OFF_XAQ) + (size_t)MROWS * 1024;
    const bf16_t* KB = (const bf16_t*)(P.ws + OFF_KB); const bf16_t* VB = (const bf16_t*)(P.ws + OFF_VB);
    const bf16_t* CK = (const bf16_t*)(P.ws + OFF_CK); const bf16_t* CV = (const bf16_t*)(P.ws + OFF_CV);
    bf16_t* YB = (bf16_t*)(P.ws + OFF_YB);
    bool lat; int head, row0, T, qstart, bidx;
    if (u < 256) { lat = true; bidx = u >> 7; const int rem = u & 127; head = rem >> 4; qstart = (rem & 15) * 128; T = 2048; row0 = MCTX + bidx * 2048; }
    else { const int v = u - 256; lat = false; bidx = 0; const int seq = v >> 4, rem = v & 15; head = rem >> 1; qstart = (rem & 1) * 128; T = 256; row0 = seq * 256; }
    const int kvh = head >> 2;
    const int qpos = qstart + w * 16 + fr;
    bf16x8 qf[4];
    { const bf16_t* qp = Q + (size_t)(row0 + qpos) * 1024 + head * 128 + fq * 8;
#pragma unroll
      for (int kk = 0; kk < 4; ++kk) qf[kk] = *(const bf16x8*)(qp + kk * 32); }
    float m_run = P.attn_sink[l * 8 + head] * 1.4426950408889634f; float l_run = (fq == 0) ? 1.0f : 0.0f;
    f32x4 o[8];
#pragma unroll
    for (int dt = 0; dt < 8; ++dt) o[dt] = (f32x4){0.f, 0.f, 0.f, 0.f};
    int wlo = 0, nwt = 4;
    if (lat) { wlo = max(0, qstart - 128); const int whi = min(T, qstart + 256); nwt = (whi - wlo) >> 6; }
    const int ntiles = nwt + (lat ? 8 : 0);
    const float scale = 0.08838834764831845f * 1.4426950408889634f;
    const int lkey = tid >> 3, lp = tid & 7;
    bf16x8 rk[2][2], rv[2][2];
    auto tile_load = [&](int ti, bf16x8 (&k_)[2], bf16x8 (&v_)[2]) {
        const bf16_t* ksrc; const bf16_t* vsrc;
        if (ti < nwt) { const int k0 = wlo + ti * 64; ksrc = KB + (size_t)(row0 + k0) * 256 + kvh * 128; vsrc = VB + (size_t)(row0 + k0) * 256 + kvh * 128; }
        else { const int k0 = (ti - nwt) * 64; const size_t o_ = ((size_t)((l * 2 + bidx) * 512 + k0)) * 256 + kvh * 128; ksrc = CK + o_; vsrc = CV + o_; }
        const bf16_t* kr = ksrc + (size_t)lkey * 256; k_[0] = *(const bf16x8*)(kr + lp * 8); k_[1] = *(const bf16x8*)(kr + (lp + 8) * 8);
        const bf16_t* vr = vsrc + (size_t)lkey * 256; v_[0] = *(const bf16x8*)(vr + lp * 8); v_[1] = *(const bf16x8*)(vr + (lp + 8) * 8); };
    const int krow = (lkey & 32) | ((lkey & 4) << 2) | ((lkey & 24) >> 1) | (lkey & 3);
    auto tile_store = [&](int b, const bf16x8 (&k_)[2], const bf16x8 (&v_)[2]) {
        LAS unsigned char* kb_ = lds + b * ABUF; LAS unsigned char* vb_ = kb_ + VT_OFF;
        *(LAS bf16x8*)(kb_ + krow * 272 + lp * 16) = k_[0]; *(LAS bf16x8*)(kb_ + krow * 272 + (lp + 8) * 16) = k_[1];
        *(LAS bf16x8*)(vb_ + lkey * 288 + lp * 16) = v_[0]; *(LAS bf16x8*)(vb_ + lkey * 288 + (lp + 8) * 16) = v_[1]; };
    tile_load(0, rk[0], rv[0]);
    tile_load(1, rk[1], rv[1]);
    __syncthreads();
    tile_store(0, rk[0], rv[0]);
    tile_load(2, rk[0], rv[0]);
#pragma unroll 2
    for (int ti = 0; ti < ntiles; ++ti) {
        const bool win = ti < nwt; const int k0 = win ? wlo + ti * 64 : (ti - nwt) * 64;
        __syncthreads();
        if ((ti & 1) == 0) { if (ti + 1 < ntiles) tile_store(1, rk[1], rv[1]); if (ti + 3 < ntiles) tile_load(ti + 3, rk[1], rv[1]); }
        else { if (ti + 1 < ntiles) tile_store(0, rk[0], rv[0]); if (ti + 3 < ntiles) tile_load(ti + 3, rk[0], rv[0]); }
        LAS unsigned char* kb_ = lds + (ti & 1) * ABUF; LAS unsigned char* vb_ = kb_ + VT_OFF;
        f32x4 s[4];
#pragma unroll
        for (int nt = 0; nt < 4; ++nt) { s[nt] = (f32x4){0.f, 0.f, 0.f, 0.f};
#pragma unroll
            for (int kk = 0; kk < 4; ++kk) { const bf16x8 a = *(const LAS bf16x8*)(kb_ + (nt * 16 + fr) * 272 + kk * 64 + fq * 16); s[nt] = __builtin_amdgcn_mfma_f32_16x16x32_bf16(a, qf[kk], s[nt], 0, 0, 0); } }
        float mt = -3.0e38f;
#pragma unroll
        for (int nt = 0; nt < 4; ++nt)
#pragma unroll
            for (int j = 0; j < 4; ++j) { float v = s[nt][j] * scale;
                if (lat && win) { const int kp = k0 + 32 * (nt >> 1) + 8 * fq + 4 * (nt & 1) + j; const int dd = qpos - kp; if (dd > 128 || dd < -128) v = -1.0e30f; }
                s[nt][j] = v; mt = fmaxf(mt, v); }
        mt = fmaxf(mt, __shfl_xor(mt, 16)); mt = fmaxf(mt, __shfl_xor(mt, 32));
        const float mn = fmaxf(m_run, mt); const float alpha = __builtin_amdgcn_exp2f(m_run - mn); m_run = mn;
        float ps = 0.f;
#pragma unroll
        for (int nt = 0; nt < 4; ++nt)
#pragma unroll
            for (int j = 0; j < 4; ++j) { const float p = __builtin_amdgcn_exp2f(s[nt][j] - mn); ps += p; s[nt][j] = p; }
        l_run = l_run * alpha + ps;
#pragma unroll
        for (int dt = 0; dt < 8; ++dt) o[dt] = o[dt] * alpha;
#pragma unroll
        for (int s2 = 0; s2 < 2; ++s2) {
            u32x4 pu; pu[0] = pack2(s[2 * s2][0], s[2 * s2][1]); pu[1] = pack2(s[2 * s2][2], s[2 * s2][3]); pu[2] = pack2(s[2 * s2 + 1][0], s[2 * s2 + 1][1]); pu[3] = pack2(s[2 * s2 + 1][2], s[2 * s2 + 1][3]);
            const bf16x8 pf = __builtin_bit_cast(bf16x8, pu);
#pragma unroll
            for (int dt = 0; dt < 8; ++dt) {
                const bf16x4 lo = __builtin_amdgcn_ds_read_tr16_b64_v4i16((LAS bf16x4*)(vb_ + (s2 * 32 + fq * 8 + (fr >> 2)) * 288 + (dt * 16 + (fr & 3) * 4) * 2));
                const bf16x4 hi = __builtin_amdgcn_ds_read_tr16_b64_v4i16((LAS bf16x4*)(vb_ + (s2 * 32 + fq * 8 + 4 + (fr >> 2)) * 288 + (dt * 16 + (fr & 3) * 4) * 2));
                const bf16x8 af = __builtin_shufflevector(lo, hi, 0, 1, 2, 3, 4, 5, 6, 7);
                o[dt] = __builtin_amdgcn_mfma_f32_16x16x32_bf16(af, pf, o[dt], 0, 0, 0);
            }
        }
    }
    float lt = l_run; lt += __shfl_xor(lt, 16); lt += __shfl_xor(lt, 32);
    const float inv = 1.0f / lt;
    bf16_t* yp = YB + (size_t)(row0 + qpos) * 1024 + head * 128 + fq * 4;
#pragma unroll
    for (int dt = 0; dt < 8; ++dt) { uint2 pk; pk.x = pack2(o[dt][0] * inv, o[dt][1] * inv); pk.y = pack2(o[dt][2] * inv, o[dt][3] * inv); *(uint2*)(yp + dt * 16) = pk; }
}

constexpr int YT_OFF = 256 * 272;
template <int MODE, int D, int NSC>
__device__ __forceinline__ void lru_dir(const Params& P, int l, int s, int cchunk, int h, LAS unsigned char* lds, int w, int fr, int fq) {
    const bool lat = s >= 32; const int row0 = lat ? MCTX + (s - 32) * 2048 : s * 256; const int t0 = cchunk * (NSC * 64);
    constexpr int NCH = 2048 / (NSC * 64);
    const bf16_t* GW = (const bf16_t*)(P.ws + OFF_GW);
    bf16_t* YA = (bf16_t*)(P.ws + OFF_YA);
    float* SUMM = (float*)(P.ws + OFF_SUMM);
    const int chl = 16 * w + fr, ch = h * 128 + chl;
    bf16x8 bwa[4], bwx[4];
    { const bf16_t* gp = GW + ((size_t)(D * 8 + h) * 256 + chl) * 128 + fq * 8;
#pragma unroll
      for (int kk = 0; kk < 4; ++kk) { bwa[kk] = *(const bf16x8*)(gp + kk * 32); bwx[kk] = *(const bf16x8*)(gp + 128 * 128 + kk * 32); } }
    const int pidx = (l * 2 + D) * 1024 + ch;
    const float ba = P.lru_ba[pidx], bx = P.lru_bx[pidx];
    const float lam = P.lru_lambda[pidx];
    const float c8 = -8.0f * log1pf(expf(-lam));
    float carry = 0.f;
    if (MODE == 0 && lat) {
        const int b = s - 32;
        carry = P.state_lru[((size_t)(b * 2 + l) * 2 + D) * 1024 + ch];
        if (D == 0) { for (int cc = 0; cc < cchunk; ++cc) { const float* sp = SUMM + ((size_t)((b * 2 + 0) * 16 + cc) * 1024 + ch) * 2; carry = sp[1] + sp[0] * carry; } }
        else { for (int cc = NCH - 1; cc > cchunk; --cc) { const float* sp = SUMM + ((size_t)((b * 2 + 1) * 16 + cc) * 1024 + ch) * 2; carry = sp[1] + sp[0] * carry; } }
    }
    float ptot = 1.0f;
#pragma unroll 1
    for (int sci = 0; sci < NSC; ++sci) {
        const int sc = D == 0 ? sci : NSC - 1 - sci;
        f32x4 r[4], g[4];
#pragma unroll
        for (int m = 0; m < 4; ++m) { r[m] = (f32x4){0.f, 0.f, 0.f, 0.f}; g[m] = (f32x4){0.f, 0.f, 0.f, 0.f};
#pragma unroll
            for (int kk = 0; kk < 4; ++kk) { const bf16x8 a = *(const LAS bf16x8*)(lds + (sc * 64 + m * 16 + fr) * 272 + kk * 64 + fq * 16);
                r[m] = __builtin_amdgcn_mfma_f32_16x16x32_bf16(a, bwa[kk], r[m], 0, 0, 0); g[m] = __builtin_amdgcn_mfma_f32_16x16x32_bf16(a, bwx[kk], g[m], 0, 0, 0); } }
#pragma unroll
        for (int mi = 0; mi < 4; ++mi) {
            const int m = D == 0 ? mi : 3 - mi;
            float av[4], bv[4];
#pragma unroll
            for (int j = 0; j < 4; ++j) {
                const float ea = 1.0f + __expf(-(r[m][j] + ba)), eb = 1.0f + __expf(-(g[m][j] + bx));
                const float inv = __builtin_amdgcn_rcpf(ea * eb);
                const float rr = inv * eb, ii = inv * ea;
                const float la = c8 * rr; const float a = __expf(la); const float z = 2.0f * la;
                const float em = (z > -0.05f) ? -z * (1.0f + z * (0.5f + z * (0.16666667f + z * 0.041666667f))) : 1.0f - a * a;
                const float x = bf2f(*(const LAS bf16_t*)(lds + (sc * 64 + m * 16 + fq * 4 + j) * 272 + chl * 2));
                av[j] = a; bv[j] = __builtin_amdgcn_sqrtf(em) * ii * x;
            }
            float p4, h4;
            p4 = av[0] * av[1] * av[2] * av[3];
            if (D == 0) h4 = ((bv[0] * av[1] + bv[1]) * av[2] + bv[2]) * av[3] + bv[3];
            else h4 = ((bv[3] * av[2] + bv[2]) * av[1] + bv[1]) * av[0] + bv[0];
            float pq[4], hq[4];
#pragma unroll
            for (int f = 0; f < 4; ++f) { pq[f] = __shfl(p4, fr + 16 * f); hq[f] = __shfl(h4, fr + 16 * f); }
            float cin = carry, mycin = 0.f;
#pragma unroll
            for (int fi = 0; fi < 4; ++fi) { const int f = D == 0 ? fi : 3 - fi; if (f == fq) mycin = cin; cin = hq[f] + pq[f] * cin; }
            carry = cin;
            if (MODE == 1) ptot *= pq[0] * pq[1] * pq[2] * pq[3];
            if (MODE == 0) {
                float hh = mycin; float y[4];
#pragma unroll
                for (int ji = 0; ji < 4; ++ji) { const int j = D == 0 ? ji : 3 - ji; hh = av[j] * hh + bv[j]; y[j] = hh; }
#pragma unroll
                for (int j = 0; j < 4; ++j) {
                    LAS bf16_t* yp = (LAS bf16_t*)(lds + YT_OFF + (sc * 64 + m * 16 + fq * 4 + j) * 272 + chl * 2);
                    if (D == 0) *yp = f2bf(y[j]);
                    else *yp = f2bf(bf2f(*yp) + y[j]);
                }
            }
        }
    }
    if (MODE == 0 && !lat && fq == 0) P.out[OUT_H + ((size_t)(s * 2 + l) * 2 + D) * 1024 + ch] = carry;
    if (MODE == 1 && fq == 0) { float* sp = SUMM + ((size_t)(((s - 32) * 2 + D) * 16 + cchunk) * 1024 + ch) * 2; sp[0] = ptot; sp[1] = carry; }
}
template <int MODE, int NSC>
__device__ void lru_unit(const Params& P, int l, int s, int cchunk, int h, LAS unsigned char* lds) {
    int tid_ = threadIdx.x; asm volatile("" : "+v"(tid_));
    const int tid = tid_, w = tid >> 6, lane = tid & 63, fr = lane & 15, fq = lane >> 4;
    const bool lat = s >= 32; const int T = lat ? 2048 : 256; const int row0 = lat ? MCTX + (s - 32) * 2048 : s * 256; const int t0 = cchunk * (NSC * 64);
    const bf16_t* XA = (const bf16_t*)(P.ws + OFF_XAQ);
    constexpr int RUN = NSC * 2;
    {
        const int ck = tid & 15, ch = h * 128 + ck * 8, tr = (tid >> 4) * RUN;
        const float* cw = P.lru_conv + (size_t)l * 4096 + ch; const float* cb = P.lru_conv_b + l * 1024 + ch;
        bf16x8 xr[RUN + 3];
#pragma unroll
        for (int i = 0; i < RUN + 3; ++i) { const int tt = t0 + tr + i - 2; xr[i] = (bf16x8){0, 0, 0, 0, 0, 0, 0, 0};
            if (tt >= 0 && tt < T) xr[i] = *(const bf16x8*)(XA + (size_t)(row0 + tt) * 1024 + ch); }
        float wk[4][8], bk[8];
#pragma unroll
        for (int e = 0; e < 8; ++e) { bk[e] = cb[e];
#pragma unroll
            for (int k = 0; k < 4; ++k) wk[k][e] = cw[k * 1024 + e]; }
        __syncthreads();
#pragma unroll
        for (int i = 0; i < RUN; ++i) {
            float a8[8];
#pragma unroll
            for (int e = 0; e < 8; ++e) { a8[e] = bk[e];
#pragma unroll
                for (int k = 0; k < 4; ++k) a8[e] += wk[k][e] * bf2f((unsigned short)xr[i + k][e]); }
            u32x4 o; o.x = pack2(a8[0], a8[1]); o.y = pack2(a8[2], a8[3]); o.z = pack2(a8[4], a8[5]); o.w = pack2(a8[6], a8[7]);
            *(LAS u32x4*)(lds + (tr + i) * 272 + ck * 16) = o;
        }
    }
    __syncthreads();
    lru_dir<MODE, 0, NSC>(P, l, s, cchunk, h, lds, w, fr, fq);
    lru_dir<MODE, 1, NSC>(P, l, s, cchunk, h, lds, w, fr, fq);
    if (MODE == 0) {
        bf16_t* YA = (bf16_t*)(P.ws + OFF_YA);
        __syncthreads();
#pragma unroll
        for (int it = 0; it < 2 * NSC; ++it) { const int t = (tid >> 4) + it * 32, ck = tid & 15;
            const u32x4 v = *(const LAS u32x4*)(lds + YT_OFF + t * 272 + ck * 16);
            *(u32x4*)(YA + (size_t)(row0 + t0 + t) * 1024 + h * 128 + ck * 8) = v; }
    }
}

#define XB_TMO      128
#define XB_XCNT(j)  (256  + 64 * (j))
#define XB_XSUB(j)  (1280 + 64 * (j))
#define XB_XGEN(j)  (2304 + 64 * (j))
#define XB_TOP      3328
#define XB_TOPGEN   3392
#define XCD_BAR_WORDS 3456
#define XB_SPIN_CAP (1u << 18)
__device__ __forceinline__ unsigned xb_ld(unsigned* p)              { return __hip_atomic_load(p, __ATOMIC_RELAXED, __HIP_MEMORY_SCOPE_AGENT); }
__device__ __forceinline__ unsigned xb_add(unsigned* p, unsigned v) { return __hip_atomic_fetch_add(p, v, __ATOMIC_RELAXED, __HIP_MEMORY_SCOPE_AGENT); }
__device__ __forceinline__ unsigned xb_xcc_id() { return (unsigned)__builtin_amdgcn_s_getreg((3 << 11) | 20) & 0xFu; }
#define XB_SPIN(cond, bar) do { unsigned _sp = 0; while (cond) { __builtin_amdgcn_s_sleep(1); \
    if ((++_sp & 255u) == 0u) { if (xb_ld(&(bar)[XB_TMO])) break; if (_sp > XB_SPIN_CAP) { atomicAdd(&(bar)[XB_TMO], 1u); break; } } } } while (0)
struct XcdBarrier { unsigned* bar; unsigned x; volatile LAS unsigned* st; };
__device__ __forceinline__ XcdBarrier xcd_barrier_post(unsigned* bar, volatile LAS unsigned* st) {
    XcdBarrier b; b.bar = bar; b.x = xb_xcc_id(); b.st = st;
    if (threadIdx.x == 0) (void)xb_add(&bar[XB_XCNT(b.x)], 1u);
    return b;
}
__device__ __forceinline__ void xcd_barrier_complete(unsigned* bar, unsigned x, unsigned& nloc, unsigned& nx) {
    const unsigned G = gridDim.x * gridDim.y * gridDim.z;
    unsigned sum, cnt, mine, sp = 0u;
    for (;;) {
        sum = 0u; cnt = 0u; mine = 0u;
#pragma unroll
        for (unsigned j = 0; j < 16; ++j) { const unsigned c = xb_ld(&bar[XB_XCNT(j)]); sum += c; cnt += (c > 0u) ? 1u : 0u; mine = (j == x) ? c : mine; }
        if (sum == G) break;
        __builtin_amdgcn_s_sleep(1);
        if ((++sp & 255u) == 0u) { if (xb_ld(&bar[XB_TMO])) break; if (sp > XB_SPIN_CAP) { atomicAdd(&bar[XB_TMO], 1u); break; } }
    }
    nloc = mine > 0u ? mine : 1u; nx = cnt > 0u ? cnt : 1u;
}
__device__ __noinline__ void xcd_barrier_(unsigned* bbar, unsigned bx, volatile LAS unsigned* bst) {
    XcdBarrier b; b.bar = bbar; b.x = bx; b.st = bst;
    asm volatile("s_waitcnt vmcnt(0)" ::: "memory");
    __syncthreads();
    if (threadIdx.x == 0) {
        unsigned* bar = b.bar;
        __builtin_amdgcn_s_waitcnt(0);
        unsigned nloc = b.st[0], nx = b.st[1];
        if (nloc == 0u) { xcd_barrier_complete(bar, b.x, nloc, nx); b.st[0] = nloc; b.st[1] = nx; }
        const unsigned old = xb_add(&bar[XB_XSUB(b.x)], 1u);
        const unsigned gen = old / nloc;
        if (old + 1u == (gen + 1u) * nloc) {
            __builtin_amdgcn_fence(__ATOMIC_RELEASE, "agent");
            asm volatile("s_waitcnt vmcnt(0)" ::: "memory");
            const unsigned og = xb_add(&bar[XB_TOP], 1u);
            const unsigned tg = og / nx;
            if (og + 1u == (tg + 1u) * nx) xb_add(&bar[XB_TOPGEN], 1u);
            else XB_SPIN(xb_ld(&bar[XB_TOPGEN]) == tg, bar);
            __builtin_amdgcn_fence(__ATOMIC_ACQUIRE, "agent");
            xb_add(&bar[XB_XGEN(b.x)], 1u);
            asm volatile("s_waitcnt vmcnt(0)" ::: "memory");
        } else {
            XB_SPIN(xb_ld(&bar[XB_XGEN(b.x)]) == gen, bar);
            __builtin_amdgcn_fence(__ATOMIC_ACQUIRE, "agent");
            asm volatile("s_waitcnt vmcnt(0)" ::: "memory");
        }
    }
    __syncthreads();
}

#ifndef REPMASK
#define REPMASK 0
#endif
#define REPLOOP(i) _Pragma("unroll 1") for (int rep_ = 0; rep_ < 1 + ((REPMASK >> (i)) & 1); ++rep_)
__global__ __launch_bounds__(512, 2) void mega(Params P) {
    extern __shared__ __attribute__((aligned(16))) unsigned char shm[];
    LAS unsigned char* lds = (LAS unsigned char*)shm;
    cg::grid_group grid = cg::this_grid();
    if (threadIdx.x == 0) *(LAS u32x4*)(lds + 147456) = (u32x4){0u, 0u, 0u, 0u};
    __syncthreads();
    const XcdBarrier xb = xcd_barrier_post((unsigned*)(P.ws + OFF_BAR), (volatile LAS unsigned*)(lds + 147456));
    const int G = gridDim.x, c = blockIdx.x;
    unsigned char* ws = P.ws;
    float* X = P.out;
    bf16_t* H = (bf16_t*)(ws + OFF_H);
    const float* MOD = (const float*)(ws + OFF_MOD);

    REPLOOP(12) phase0(P, lds);
    if (gridDim.x == 0x7fffffffu) grid.sync();
    REPLOOP(11) xcd_barrier_(xb.bar, xb.x, xb.st);
    for (int l = 0; l < 2; ++l) {
        const float* mod = MOD + (size_t)l * 3 * 6144;
        const bool hide = (G == 256);
        { const int te = hide ? (l == 0 ? 1856 : 0) : 4992; if (te > 0) convert_weights(P, l, lds, 0, te, c, G); }
        const float* xa0 = l == 0 ? P.x_prompt : X; const float* xb0 = l == 0 ? P.x_sample : X + (size_t)MCTX * 1024;
        REPLOOP(1) norm_phase(xa0, xb0, P.norm1 + l * 1024, mod, 0, 1024, H);
        REPLOOP(11) xcd_barrier_(xb.bar, xb.x, xb.st);
        REPLOOP(2) { Sched S{(const char*)H, (const char*)(ws + OFF_WIN), 1024, 1024, 0, 48, 14, G, c, 256};
          EpiIn E{(bf16_t*)(ws + OFF_XAQ), (bf16_t*)(ws + OFF_XC), (bf16_t*)(ws + OFF_KB), (bf16_t*)(ws + OFF_VB), P.out + OUT_K, P.out + OUT_V, (const float*)(ws + OFF_ROPE), l};
          gemm_phase(lds, S, 1024, E); }
        if (hide && l == 0 && c >= 160) convert_weights(P, l, lds, 1856, 2624, c - 160, G - 160);
        REPLOOP(11) xcd_barrier_(xb.bar, xb.x, xb.st);
        REPLOOP(3) pool_phase((const bf16_t*)(ws + OFF_XC), (bf16_t*)(ws + OFF_PL));
        for (int it = c; it < 1280; it += G) {
            if (it < 256) { REPLOOP(4) attn_unit(P, l, it, lds); }
            else if (it < 512) { const int v = it - 256; REPLOOP(5) lru_unit<0, 4>(P, l, v >> 3, 0, v & 7, lds); }
            else if (it < 768) { const int q = it - 512; REPLOOP(5) lru_unit<1, 2>(P, l, 32 + (q >> 7), (q >> 3) & 15, q & 7, lds); }
            else { REPLOOP(7) attn_unit(P, l, it - 768 + 256, lds); }
        }
        REPLOOP(11) xcd_barrier_(xb.bar, xb.x, xb.st);
        { Sched S{(const char*)(ws + OFF_PL), (const char*)(ws + OFF_PW), 1024, 256, 256, 48, 4, G, c, 256};
          EpiPool E{(bf16_t*)(ws + OFF_XC), P.pool_scale + l * 1024};
          gemm_phase(lds, S, 256, E); }
#ifndef NO_LRU
        for (int it = G - 1 - c; it < 256; it += G) lru_unit<0, 2>(P, l, 32 + (it >> 7), (it >> 3) & 15, it & 7, lds);
#endif
        REPLOOP(11) xcd_barrier_(xb.bar, xb.x, xb.st);
        { unsigned* mflags = (unsigned*)(ws + OFF_BAR) + 3500 + l * 192;
          MergeSched S{(const char*)ws, 1024, 1024, c, c >= 192};
          EpiMerge E{(bf16_t*)(ws + OFF_GT), P.b_gate + l * 3072, (float*)(ws + OFF_XAQ), (bf16_t*)(ws + OFF_PL), mflags};
          gemm_phase(lds, S, 1024, E); }
        if (hide && c >= 192) convert_weights(P, l, lds, 2624, 4288, c - 192, G - 192);
        REPLOOP(11) xcd_barrier_(xb.bar, xb.x, xb.st);
        { Sched S{(const char*)(ws + OFF_PL), (const char*)(ws + OFF_WOUT), 1024, 1024, 0, 64, 4, G, c, 192};
          EpiRes E{X, mod, 2048, xa0, xb0};
          gemm_phase<EpiRes, Sched, true>(lds, S, 1024, E); }
        REPLOOP(11) xcd_barrier_(xb.bar, xb.x, xb.st);
        norm_phase(X, X + (size_t)MCTX * 1024, P.norm2 + l * 1024, mod, 3072, 4096, H);
        REPLOOP(11) xcd_barrier_(xb.bar, xb.x, xb.st);
        REPLOOP(9) { Sched S{(const char*)H, (const char*)(ws + OFF_WUP), 1024, 1024, 0, 48, 22, G, c, 256};
          EpiUp E{(bf16_t*)(ws + OFF_ACT), (bf16_t*)(ws + OFF_SU), (bf16_t*)(ws + OFF_SV), P.ffn_conv + (size_t)l * 3 * 2816, P.ffn_conv_b + l * 2816};
          gemm_phase(lds, S, 1024, E); }
        if (hide && c >= 32) { convert_weights(P, l, lds, 4288, 4992, c - 32, G - 32);
          if (l == 0) convert_weights(P, l + 1, lds, 0, 2624, c - 32, G - 32); }
        REPLOOP(11) xcd_barrier_(xb.bar, xb.x, xb.st);
        { Sched S{(const char*)(ws + OFF_ACT), (const char*)(ws + OFF_WDN), 2816, 2816, 0, 64, 4, G, c, 192};
          { Unit uu; for (int i = 0; S.next(i, uu); ++i) ffn_fix_groups((const bf16_t*)(ws + OFF_SU), (const bf16_t*)(ws + OFF_SV), (bf16_t*)(ws + OFF_ACT), P.ffn_conv + (size_t)l * 3 * 2816, P.ffn_conv_b + l * 2816, uu.row0 >> 6, 3);
            asm volatile("s_waitcnt vmcnt(0)" ::: "memory"); __syncthreads(); }
          EpiRes E{X, mod, 5120, X, X + (size_t)MCTX * 1024};
          gemm_phase<EpiRes, Sched, true>(lds, S, 2816, E); }
        REPLOOP(11) xcd_barrier_(xb.bar, xb.x, xb.st);
    }
    final_norm_phase(X, P.final_norm);
}

extern "C" void kernel_launch(void* const* d_in, const int* in_sizes, int n_in, void* d_out, int out_size, void* d_ws, size_t ws_size, hipStream_t stream) {
    constexpr size_t kDynLds = 147456 + 16;
    static int grid_blocks = 0;
    if (!grid_blocks) {
        int dev = 0, cus = 0, per_cu = 0;
        hipGetDevice(&dev);
        hipDeviceGetAttribute(&cus, hipDeviceAttributeMultiprocessorCount, dev);
        hipFuncSetAttribute((const void*)mega, hipFuncAttributeMaxDynamicSharedMemorySize, (int)kDynLds);
        hipOccupancyMaxActiveBlocksPerMultiprocessor(&per_cu, mega, 512, kDynLds);
        if (per_cu < 1) per_cu = 1;
        if (per_cu > 1) per_cu = 1;
        grid_blocks = cus * per_cu;
    }
    Params p{};
    const float** pp = (const float**)&p;
    for (int i = 0; i < 30; ++i) pp[i] = (const float*)d_in[i];
    p.out = (float*)d_out; p.ws = (unsigned char*)d_ws;
    if (ws_size < OFF_END2 + 262144) { fprintf(stderr, "workspace too small: %zu < %zu\n", ws_size, (size_t)OFF_END2 + 262144); }
    hipMemsetAsync((unsigned char*)d_ws + OFF_BAR, 0, 16384, stream);
    void* args[] = {&p};
    hipError_t e = hipLaunchCooperativeKernel((void*)mega, dim3(grid_blocks), dim3(512), args, kDynLds, stream);
    if (e != hipSuccess) fprintf(stderr, "cooperative launch failed: %s (grid %d)\n", hipGetErrorString(e), grid_blocks);
}
```

```cpp
#include <hip/hip_runtime.h>
#include <hip/hip_cooperative_groups.h>
#include <cstdio>
namespace cg = cooperative_groups;

#define LAS __attribute__((address_space(3)))
typedef unsigned short bf16_t;
typedef short bf16x8 __attribute__((ext_vector_type(8)));
typedef float f32x4 __attribute__((ext_vector_type(4)));
typedef unsigned u32x4 __attribute__((ext_vector_type(4)));
typedef unsigned u32x2 __attribute__((ext_vector_type(2)));
typedef short bf16x4 __attribute__((ext_vector_type(4)));

constexpr int MROWS = 12288, MCTX = 8192;
constexpr size_t S24 = (size_t)MROWS * 1024 * 2;
constexpr size_t OFF_WIN = 0;
constexpr size_t OFF_WBR = OFF_WIN + (size_t)6656 * 1024 * 2;
constexpr size_t OFF_WOUT = OFF_WBR + (size_t)3 * 1024 * 1024 * 2;
constexpr size_t OFF_WUP = OFF_WOUT + (size_t)1024 * 1024 * 2;
constexpr size_t OFF_WDN = OFF_WUP + (size_t)5632 * 1024 * 2;
constexpr size_t OFF_GW = OFF_WDN + (size_t)1024 * 2816 * 2;
constexpr size_t OFF_PW = OFF_GW + (size_t)2 * 8 * 256 * 128 * 2;
constexpr size_t OFF_MOD = OFF_PW + (size_t)4 * 256 * 256 * 2;
constexpr size_t OFF_CK = OFF_MOD + (size_t)2 * 3 * 6144 * 4;
constexpr size_t OFF_CV = OFF_CK + (size_t)2 * 2 * 512 * 256 * 2;
constexpr size_t OFF_ROPE = OFF_CV + (size_t)2 * 2 * 512 * 256 * 2;
constexpr size_t OFF_SUMM = OFF_ROPE + (size_t)2 * 64 * 32 * 4;
constexpr size_t OFF_BAR = OFF_SUMM + (size_t)2 * 2 * 16 * 1024 * 2 * 4;
constexpr size_t OFF_ACT0 = OFF_BAR + 16384;
constexpr size_t OFF_XAQ = OFF_ACT0;
constexpr size_t OFF_XC = OFF_XAQ + 2 * S24;
constexpr size_t OFF_KB = OFF_XC + S24;
constexpr size_t OFF_VB = OFF_KB + (size_t)MROWS * 256 * 2;
constexpr size_t OFF_GT = OFF_VB + (size_t)MROWS * 256 * 2;
constexpr size_t OFF_YB = OFF_GT + S24;
constexpr size_t OFF_PL = OFF_YB + S24;
constexpr size_t OFF_YA = OFF_PL + S24;
constexpr size_t OFF_H = OFF_YA + S24;
constexpr size_t OFF_END = OFF_H + S24;
constexpr size_t OFF_ACT = OFF_XAQ;
constexpr size_t OFF_SU = OFF_END;
constexpr size_t OFF_SV = OFF_SU + (size_t)192 * 4 * 2816 * 2;
constexpr size_t OFF_END2 = OFF_SV + (size_t)192 * 2 * 2816 * 2;
constexpr size_t OUT_K = (size_t)MROWS * 1024;
constexpr size_t OUT_V = OUT_K + (size_t)32 * 2 * 256 * 256;
constexpr size_t OUT_H = OUT_V + (size_t)32 * 2 * 256 * 256;

struct Params {
    const float *x_prompt, *x_sample, *cache_k, *cache_v, *state_lru, *c, *c_ctx, *w_ada, *b_ada, *norm1, *norm2,
        *w_in, *b_gate, *lru_conv, *lru_conv_b, *lru_wa, *lru_ba, *lru_wx, *lru_bx, *lru_lambda, *attn_sink,
        *pool_w, *pool_scale, *w_branch, *w_out, *ffn_up, *ffn_conv, *ffn_conv_b, *ffn_down, *final_norm;
    float* out; unsigned char* ws;
};

typedef float f32x2_ __attribute__((ext_vector_type(2)));
typedef __bf16 bf16x2_ __attribute__((ext_vector_type(2)));
__device__ __forceinline__ unsigned pack2(float a, float b) { const f32x2_ v = {a, b}; const bf16x2_ r = __builtin_convertvector(v, bf16x2_); return __builtin_bit_cast(unsigned, r); }
__device__ __forceinline__ unsigned short f2bf(float f) { return (unsigned short)(pack2(f, f) & 0xffffu); }
__device__ __forceinline__ float bf2f(unsigned short b) { return __uint_as_float(((unsigned)b) << 16); }
__device__ __forceinline__ int otid() { int t = threadIdx.x; asm volatile("" : "+v"(t)); return t; }
__device__ __forceinline__ float sigmoidf_(float x) { return __builtin_amdgcn_rcpf(1.0f + __expf(-x)); }

constexpr int HTB = 128 * 64 * 2;
__device__ __forceinline__ int lds_byte(int r, int c) { const int st = (r >> 4) * 2 + (c >> 5), rr = r & 15, cc = c & 31, ob = rr * 64 + cc * 2; return st * 1024 + (ob ^ (((ob >> 9) & 1) << 5)); }
__device__ __forceinline__ void stage_rc(int b, int& R, int& C) { const int st = b / 1024, sb = b % 1024, swz = sb ^ (((sb >> 9) & 1) << 5); R = (st >> 1) * 16 + swz / 64; C = (st & 1) * 32 + (swz % 64) / 2; }

struct Unit { const char* a; const char* b; int pm, pn, z, row0, m192; };
struct Sched {
    const char* A; const char* B; int lda, ldb, acol, nM, nN, G, c, tm;
    __device__ __forceinline__ bool next(int i, Unit& u) const {
        const long L = (long)i * G + c; const int nwg = nM * nN; if (L >= nwg) return false;
        int wgid = (int)L; { const int q = nwg / 8, r = nwg % 8, xcd = wgid % 8, off = wgid / 8; wgid = (xcd < r ? xcd * (q + 1) : r * (q + 1) + (xcd - r) * q) + off; }
        const int nig = 8 * nN, gid = wgid / nig, fm = gid * 8, gsz = (nM - fm) < 8 ? (nM - fm) : 8;
        u.pm = fm + ((wgid % nig) % gsz); u.pn = (wgid % nig) / gsz;
        u.a = A + ((size_t)u.pm * tm * lda + (size_t)u.pn * acol) * 2; u.b = B + (size_t)u.pn * 256 * ldb * 2; u.z = 0; u.row0 = u.pm * tm; u.m192 = (tm == 192); return true;
    }
};
struct MergeSched {
    const char* ws; int lda, ldb, c; bool helper;
    __device__ __forceinline__ bool next(int i, Unit& u) const {
        int owner, z; int c = this->c; asm volatile("" : "+s"(c));
        if (!helper) { if (c >= 192 || i >= 5) return false; owner = c; z = i < 4 ? i : 5; }
        else { const int hi = c - 192; if (hi < 0 || hi >= 64 || i >= 3) return false; owner = hi + 64 * i; z = 4; }
        const int nN = 4;
        int wgid = owner; { const int q = 24, xcd = wgid % 8, off = wgid / 8; wgid = xcd * q + off; }
        const int nig = 8 * nN, gid = wgid / nig, fm = gid * 8;
        u.pm = fm + ((wgid % nig) % 8); u.pn = (wgid % nig) / 8; u.z = z; u.row0 = u.pm * 256; u.m192 = 0;
        const int j = z >> 1;
        const size_t aoff = (size_t)u.row0 * 1024 * 2;
        size_t ao = OFF_H, bo = OFF_WIN + (size_t)3584 * 1024 * 2;
        if (z & 1) { bo = OFF_WBR; ao = OFF_YA; if (j == 1) ao = OFF_YB; if (j == 2) ao = OFF_XC; }
        u.a = ws + ao + aoff; u.b = ws + bo + ((size_t)j * 1024 + (size_t)u.pn * 256) * 1024 * 2;
        return true;
    }
};

template <class Epi, class SchedT, bool M192 = false>
__device__ __forceinline__ void gemm_phase(LAS unsigned char* lds, const SchedT& S, const int K_, const Epi& E) {
    int K = K_; asm volatile("" : "+s"(K));
    int tid_ = threadIdx.x; asm volatile("" : "+v"(tid_));
    const int tid = tid_, wid = __builtin_amdgcn_readfirstlane(tid >> 6), lane = tid & 63, wr = wid >> 2, wc = wid & 3, fr = lane & 15, fq = lane >> 4;
    const int nt = K / 64;
    unsigned voffA[2], voffB[2];
#pragma unroll
    for (int i = 0; i < 2; ++i) { int R, C; stage_rc(tid * 16 + i * 8192, R, C); voffA[i] = (unsigned)(R * S.lda + C) * 2u; voffB[i] = (unsigned)(R * S.ldb + C) * 2u; }
    const size_t kstep = 128;
    const size_t hstepA = (size_t)128 * S.lda * 2, hstepB = (size_t)128 * S.ldb * 2;
    const unsigned ldsw = (unsigned)wid * 1024u;
    const int aoff = lds_byte(wr * 64 + fr, fq * 8), boff = lds_byte(wc * 32 + fr, fq * 8);
#define G_SA(b, h) (((b) * 2 + (h)) * HTB)
#define G_SB(b, h) ((4 + (b) * 2 + (h)) * HTB)
#define G_STAGE(bufoff, gbase, voff) do { _Pragma("unroll") for (int _i = 0; _i < 2; ++_i) \
        __builtin_amdgcn_global_load_lds((const unsigned*)((const char*)(gbase) + (voff)[_i]), (LAS unsigned*)(lds + (bufoff) + ldsw + _i * 8192), 16, 0, 0); } while (0)
#define G_LDA(dst, b, h) do { _Pragma("unroll") for (int m = 0; m < 4; ++m) _Pragma("unroll") for (int k = 0; k < 2; ++k) dst[m][k] = *(const LAS bf16x8*)(lds + G_SA(b, h) + aoff + m * 2048 + k * 1024); } while (0)
#define G_LDB(dst, b, h) do { _Pragma("unroll") for (int n = 0; n < 2; ++n) _Pragma("unroll") for (int k = 0; k < 2; ++k) dst[n][k] = *(const LAS bf16x8*)(lds + G_SB(b, h) + boff + n * 2048 + k * 1024); } while (0)
#define G_MMA(ai, bj, At, Bt) do { if (M192 && (ai) == 1 && wr == 1) break; __builtin_amdgcn_s_setprio(1); _Pragma("unroll") for (int m = 0; m < 4; ++m) _Pragma("unroll") for (int n = 0; n < 2; ++n) _Pragma("unroll") for (int k = 0; k < 2; ++k) \
        acc[ai][bj][m][n] = __builtin_amdgcn_mfma_f32_16x16x32_bf16(Bt[n][k], At[m][k], acc[ai][bj][m][n], 0, 0, 0); __builtin_amdgcn_s_setprio(0); } while (0)
#define G_WAIT_V(n) asm volatile("s_waitcnt vmcnt(" #n ")" ::: "memory")
#define G_WAIT_L(n) asm volatile("s_waitcnt lgkmcnt(" #n ")" ::: "memory")
#define G_BAR __builtin_amdgcn_s_barrier()
#define G_SCHED __builtin_amdgcn_sched_barrier(0)
    Unit cur, nxt; int ui = 0;
    if (!S.next(0, cur)) return;
    f32x4 acc[2][2][4][2];
#pragma unroll
    for (int a = 0; a < 2; ++a)
#pragma unroll
        for (int b = 0; b < 2; ++b)
#pragma unroll
            for (int m = 0; m < 4; ++m)
#pragma unroll
                for (int n = 0; n < 2; ++n) acc[a][b][m][n] = (f32x4){0.f, 0.f, 0.f, 0.f};
    bf16x8 At[4][2], B0[2][2], B1[2][2];
    const char* cA = cur.a; const char* cB = cur.b;
    G_STAGE(G_SB(0, 0), cB, voffB); G_STAGE(G_SA(0, 0), cA, voffA); G_STAGE(G_SB(0, 1), cB + hstepB, voffB); G_STAGE(G_SA(0, 1), cA + hstepA, voffA);
    if (wr == 1) G_BAR;
    G_WAIT_V(4); G_BAR;
    G_STAGE(G_SB(1, 0), cB + kstep, voffB); G_STAGE(G_SA(1, 0), cA + kstep, voffA); G_STAGE(G_SB(1, 1), cB + hstepB + kstep, voffB);
    G_WAIT_V(6); G_BAR;
    for (;;) {
        const bool has_next = S.next(ui + 1, nxt);
        const char* nA = has_next ? nxt.a : cA; const char* nB = has_next ? nxt.b : cB;
        for (int t = 0; t < nt; t += 2) {
            const bool last = (t == nt - 2);
            const char* a1 = cA + (size_t)(t + 1) * kstep;
            const char* a2 = last ? nA : cA + (size_t)(t + 2) * kstep; const char* b2 = last ? nB : cB + (size_t)(t + 2) * kstep;
            const char* a3 = a2 + kstep; const char* b3 = b2 + kstep;
            G_LDB(B0, 0, 0); G_SCHED; G_LDA(At, 0, 0); G_STAGE(G_SA(1, 1), a1 + hstepA, voffA);
            G_WAIT_L(8); G_BAR; G_WAIT_L(0); G_MMA(0, 0, At, B0); G_BAR; G_SCHED;
            G_LDB(B1, 0, 1); G_STAGE(G_SB(0, 0), b2, voffB);
            G_BAR; G_WAIT_L(0); G_MMA(0, 1, At, B1); G_BAR;
            G_LDA(At, 0, 1); G_STAGE(G_SA(0, 0), a2, voffA);
            G_BAR; G_WAIT_L(0); G_MMA(1, 0, At, B0); G_BAR; G_SCHED;
            G_STAGE(G_SB(0, 1), b2 + hstepB, voffB);
            G_WAIT_V(6); G_BAR; G_MMA(1, 1, At, B1); G_BAR;
            G_LDB(B0, 1, 0); G_SCHED; G_LDA(At, 1, 0); G_STAGE(G_SA(0, 1), a2 + hstepA, voffA);
            G_WAIT_L(8); G_BAR; G_WAIT_L(0); G_MMA(0, 0, At, B0); G_BAR; G_SCHED;
            G_LDB(B1, 1, 1); G_STAGE(G_SB(1, 0), b3, voffB);
            G_BAR; G_WAIT_L(0); G_MMA(0, 1, At, B1); G_BAR;
            G_LDA(At, 1, 1); G_STAGE(G_SA(1, 0), a3, voffA);
            G_BAR; G_WAIT_L(0); G_MMA(1, 0, At, B0); G_BAR; G_SCHED;
            G_STAGE(G_SB(1, 1), b3 + hstepB, voffB);
            G_WAIT_V(6); G_BAR; G_MMA(1, 1, At, B1); G_BAR;
        }
        E(acc, cur, wr, wc, fr, fq);
        if (!has_next) break;
#pragma unroll
        for (int a = 0; a < 2; ++a)
#pragma unroll
            for (int b = 0; b < 2; ++b)
#pragma unroll
                for (int m = 0; m < 4; ++m)
#pragma unroll
                    for (int n = 0; n < 2; ++n) acc[a][b][m][n] = (f32x4){0.f, 0.f, 0.f, 0.f};
        cur = nxt; cA = nA; cB = nB; ++ui;
    }
    G_WAIT_V(0);
    if (wr == 0) G_BAR;
    G_BAR;
#undef G_SA
#undef G_SB
#undef G_STAGE
#undef G_LDA
#undef G_LDB
#undef G_MMA
#undef G_WAIT_V
#undef G_WAIT_L
#undef G_BAR
#undef G_SCHED
}

#define EPI_LOOP_BEGIN \
    _Pragma("unroll") for (int ai = 0; ai < 2; ++ai) _Pragma("unroll") for (int m = 0; m < 4; ++m) { const int row = u.pm * 256 + wr * 64 + fr + ai * 128 + m * 16; \
    _Pragma("unroll") for (int bj = 0; bj < 2; ++bj) _Pragma("unroll") for (int n = 0; n < 2; ++n) { const int cl = wc * 32 + 4 * fq + bj * 128 + n * 16; const f32x4 v = acc[ai][bj][m][n];
#define EPI_LOOP_END } }

__device__ __forceinline__ int seq_group(int row) { return row < MCTX ? 0 : 1 + ((row - MCTX) >> 11); }

struct EpiIn {
    bf16_t* xaq; bf16_t* xc; bf16_t* kb; bf16_t* vb; float* outk; float* outv; const float* rc; int l;
    __device__ __forceinline__ void operator()(const f32x4 (&acc)[2][2][4][2], const Unit& u, int wr, int wc, int fr, int fq) const {
        const int pn = u.pn; const bool qk = pn >= 4 && pn <= 8;
        bf16_t* dst; int ld, cbase; float* fo = nullptr;
        if (pn < 4) { dst = xaq; ld = 1024; cbase = pn * 256; }
        else if (pn < 8) { dst = xaq + (size_t)MROWS * 1024; ld = 1024; cbase = pn * 256 - 1024; }
        else if (pn == 8) { dst = kb; ld = 256; cbase = 0; fo = outk; }
        else if (pn == 9) { dst = vb; ld = 256; cbase = 0; fo = outv; }
        else { dst = xc; ld = 1024; cbase = pn * 256 - 2560; }
        const int hh = wc >> 1, i0 = 16 * (wc & 1) + 4 * fq;
        const int c1 = cbase + (qk ? 64 * hh + i0 : wc * 32 + 4 * fq), dc = qk ? 32 : 16;
        const bool rope = qk && u.pm >= 32;
#pragma unroll
        for (int ai = 0; ai < 2; ++ai) {
            f32x4 csm[4], snm[4];
#pragma unroll
            for (int m = 0; m < 4; ++m) { csm[m] = (f32x4){1.f, 1.f, 1.f, 1.f}; snm[m] = (f32x4){0.f, 0.f, 0.f, 0.f};
                if (rope) { const int row = u.pm * 256 + wr * 64 + fr + ai * 128 + m * 16; const int t = (row - MCTX) & 2047; const int pos = hh == 0 ? (t >> 6) : (t & 63);
                    csm[m] = *(const f32x4*)(rc + pos * 32 + i0); snm[m] = *(const f32x4*)(rc + 2048 + pos * 32 + i0); } }
#pragma unroll
            for (int m = 0; m < 4; ++m) {
                const int row = u.pm * 256 + wr * 64 + fr + ai * 128 + m * 16;
                const f32x4 cs = csm[m], sn = snm[m];
                bf16_t* dp = dst + (size_t)row * ld + c1;
                float* fp = fo + ((size_t)(((row >> 8) * 2 + l) * 256 + (row & 255))) * 256 + c1;
#pragma unroll
                for (int bj = 0; bj < 2; ++bj) {
                    const f32x4 x1 = acc[ai][bj][m][0], x2 = acc[ai][bj][m][1];
                    const f32x4 o1 = x1 * cs - x2 * sn, o2 = x1 * sn + x2 * cs;
                    uint2 p1, p2; p1.x = pack2(o1[0], o1[1]); p1.y = pack2(o1[2], o1[3]); p2.x = pack2(o2[0], o2[1]); p2.y = pack2(o2[2], o2[3]);
                    *(uint2*)(dp + bj * 128) = p1; *(uint2*)(dp + bj * 128 + dc) = p2;
                    if (fo != nullptr && row < MCTX) { *(f32x4*)(fp + bj * 128) = o1; *(f32x4*)(fp + bj * 128 + dc) = o2; }
                }
            }
        }
    }
};
struct EpiGate {
    bf16_t* gt; const float* bias;
    __device__ __forceinline__ void operator()(const f32x4 (&acc)[2][2][4][2], const Unit& u, int wr, int wc, int fr, int fq) const {
        const int c0 = u.pn * 256 + wc * 32 + 4 * fq;
        f32x4 bb[4];
#pragma unroll
        for (int g = 0; g < 4; ++g) bb[g] = *(const f32x4*)(bias + c0 + (g >> 1) * 128 + (g & 1) * 16);
#pragma unroll
        for (int ai = 0; ai < 2; ++ai) { if (ai == 1 && u.m192 && wr == 1) continue;
#pragma unroll
            for (int m = 0; m < 4; ++m) { const int row = u.row0 + wr * 64 + fr + ai * 128 + m * 16;
#pragma unroll
                for (int g = 0; g < 4; ++g) { const f32x4 v = acc[ai][g >> 1][m][g & 1];
                    uint2 pk; pk.x = pack2(sigmoidf_(v[0] + bb[g][0]), sigmoidf_(v[1] + bb[g][1])); pk.y = pack2(sigmoidf_(v[2] + bb[g][2]), sigmoidf_(v[3] + bb[g][3]));
                    *(uint2*)(gt + (size_t)row * 1024 + c0 + (g >> 1) * 128 + (g & 1) * 16) = pk; } } }
    }
};
template <int j> struct EpiBranch {
    const bf16_t* gt; float* tmp; bf16_t* mg;
    __device__ __forceinline__ void operator()(const f32x4 (&acc)[2][2][4][2], const Unit& u, int wr, int wc, int fr, int fq) const {
        const int c0 = u.pn * 256 + wc * 32 + 4 * fq;
#pragma unroll
        for (int ai = 0; ai < 2; ++ai) { if (ai == 1 && u.m192 && wr == 1) continue;
#pragma unroll
            for (int m = 0; m < 4; ++m) {
                const unsigned ro = (unsigned)(u.row0 + wr * 64 + fr + ai * 128 + m * 16) * 1024u + (unsigned)c0;
                uint2 gp[4]; f32x4 tv[4];
#pragma unroll
                for (int g = 0; g < 4; ++g) { const unsigned o = ro + (g >> 1) * 128 + (g & 1) * 16;
                    gp[g] = *(const uint2*)(gt + o); tv[g] = (f32x4){0.f, 0.f, 0.f, 0.f}; if (j != 0) tv[g] = *(const f32x4*)(tmp + o); }
#pragma unroll
                for (int g = 0; g < 4; ++g) { const unsigned o = ro + (g >> 1) * 128 + (g & 1) * 16;
                    const f32x4 v = acc[ai][g >> 1][m][g & 1];
                    f32x4 r = tv[g];
                    r[0] += v[0] * bf2f((unsigned short)(gp[g].x & 0xffff)); r[1] += v[1] * bf2f((unsigned short)(gp[g].x >> 16));
                    r[2] += v[2] * bf2f((unsigned short)(gp[g].y & 0xffff)); r[3] += v[3] * bf2f((unsigned short)(gp[g].y >> 16));
                    if (j != 2) *(f32x4*)(tmp + o) = r;
                    else { uint2 pk; pk.x = pack2(r[0], r[1]); pk.y = pack2(r[2], r[3]); *(uint2*)(mg + o) = pk; } }
            } }
    }
};
struct EpiMerge {
    bf16_t* gt; const float* bgate; float* tmp; bf16_t* mg; unsigned* flags;
    __device__ __forceinline__ void operator()(const f32x4 (&acc)[2][2][4][2], const Unit& u, int wr, int wc, int fr, int fq) const {
        const int j = u.z >> 1;
        if ((u.z & 1) == 0) {
            EpiGate E{u.z == 4 ? mg : gt, bgate + j * 1024}; E(acc, u, wr, wc, fr, fq);
            if (u.z == 4) {
                asm volatile("s_waitcnt vmcnt(0)" ::: "memory");
                unsigned old_ = 0u;
                if (fr == 0 && fq == 0) old_ = __hip_atomic_fetch_add(flags + u.pm * 4 + u.pn, 1u, __ATOMIC_RELAXED, __HIP_MEMORY_SCOPE_AGENT);
                old_ = (unsigned)__builtin_amdgcn_readfirstlane(old_);
                if (old_ == 7u) {
                    __builtin_amdgcn_fence(__ATOMIC_RELEASE, "agent");
                    asm volatile("s_waitcnt vmcnt(0)" ::: "memory");
                    if (fr == 0 && fq == 0) __hip_atomic_fetch_add(flags + u.pm * 4 + u.pn, 256u, __ATOMIC_RELAXED, __HIP_MEMORY_SCOPE_AGENT);
                }
            }
        }
        else if (j == 0) { EpiBranch<0> E{gt, tmp, mg}; E(acc, u, wr, wc, fr, fq); }
        else if (j == 1) { EpiBranch<1> E{gt, tmp, mg}; E(acc, u, wr, wc, fr, fq); }
        else {
            { unsigned* f = flags + u.pm * 4 + u.pn; unsigned sp = 0;
              while ((unsigned)__builtin_amdgcn_readfirstlane(__hip_atomic_load(f, __ATOMIC_RELAXED, __HIP_MEMORY_SCOPE_AGENT)) < 256u) { __builtin_amdgcn_s_sleep(2); if (++sp > (1u << 20)) break; }
              __builtin_amdgcn_fence(__ATOMIC_ACQUIRE, "agent");
              asm volatile("s_waitcnt vmcnt(0)" ::: "memory"); }
            EpiBranch<2> E{mg, tmp, mg}; E(acc, u, wr, wc, fr, fq);
        }
    }
};
struct EpiRes {
    float* x; const float* mod; int goff; const float* xa; const float* xb;
    __device__ __forceinline__ const float* src(unsigned o) const { return o < (unsigned)MCTX * 1024u ? xa + o : xb + (o - (unsigned)MCTX * 1024u); }
    __device__ __forceinline__ void operator()(const f32x4 (&acc)[2][2][4][2], const Unit& u, int wr, int wc, int fr, int fq) const {
        const int c0 = u.pn * 256 + wc * 32 + 4 * fq;
        const int sg0 = seq_group(u.row0), sg1 = seq_group(u.row0 + (u.m192 ? 191 : 255));
        if (sg0 == sg1) {
            const float* gsrc = mod + sg0 * 6144 + goff;
            f32x4 gg[4];
#pragma unroll
            for (int g = 0; g < 4; ++g) gg[g] = *(const f32x4*)(gsrc + c0 + (g >> 1) * 128 + (g & 1) * 16);
#pragma unroll
            for (int ai = 0; ai < 2; ++ai) { if (ai == 1 && u.m192 && wr == 1) continue;
#pragma unroll
                for (int mp = 0; mp < 2; ++mp) {
                    const unsigned ro = (unsigned)(u.row0 + wr * 64 + fr + ai * 128 + mp * 32) * 1024u + (unsigned)c0;
                    f32x4 xv[8];
#pragma unroll
                    for (int k = 0; k < 8; ++k) { const int g = k & 3; xv[k] = *(const f32x4*)src(ro + (k >> 2) * 16384 + (g >> 1) * 128 + (g & 1) * 16); }
#pragma unroll
                    for (int k = 0; k < 8; ++k) { const int g = k & 3, m = mp * 2 + (k >> 2); *(f32x4*)(x + (ro + (k >> 2) * 16384 + (g >> 1) * 128 + (g & 1) * 16)) = xv[k] + gg[g] * acc[ai][g >> 1][m][g & 1]; }
                } }
        } else {
#pragma unroll
            for (int ai = 0; ai < 2; ++ai) { if (ai == 1 && u.m192 && wr == 1) continue;
#pragma unroll
                for (int m = 0; m < 4; ++m) {
                    const int row = u.row0 + wr * 64 + fr + ai * 128 + m * 16;
                    const float* gsrc = mod + seq_group(row) * 6144 + goff + c0;
                    const unsigned ro = (unsigned)row * 1024u + (unsigned)c0;
                    f32x4 xv[4], gv[4];
#pragma unroll
                    for (int g = 0; g < 4; ++g) { xv[g] = *(const f32x4*)src(ro + (g >> 1) * 128 + (g & 1) * 16); gv[g] = *(const f32x4*)(gsrc + (g >> 1) * 128 + (g & 1) * 16); }
#pragma unroll
                    for (int g = 0; g < 4; ++g) *(f32x4*)(x + (ro + (g >> 1) * 128 + (g & 1) * 16)) = xv[g] + gv[g] * acc[ai][g >> 1][m][g & 1];
                } }
        }
    }
};
struct EpiBf {
    bf16_t* dst; int ld;
    __device__ __forceinline__ void operator()(const f32x4 (&acc)[2][2][4][2], const Unit& u, int wr, int wc, int fr, int fq) const {
        EPI_LOOP_BEGIN
            const int col = u.pn * 256 + cl;
            uint2 pk; pk.x = pack2(v[0], v[1]); pk.y = pack2(v[2], v[3]);
            *(uint2*)(dst + (size_t)row * ld + col) = pk;
        EPI_LOOP_END
    }
};
__device__ __forceinline__ float dpp_f(float old, float src, const int ctrl_sel) {
    const int o = __float_as_int(old), v = __float_as_int(src);
    int r;
    if (ctrl_sel == 0) r = __builtin_amdgcn_update_dpp(o, v, 0x111, 0xf, 0xf, false);
    else if (ctrl_sel == 1) r = __builtin_amdgcn_update_dpp(o, v, 0x101, 0xf, 0xf, false);
    else if (ctrl_sel == 2) r = __builtin_amdgcn_update_dpp(o, v, 0x121, 0xf, 0xf, false);
    else r = __builtin_amdgcn_update_dpp(o, v, 0x12f, 0xf, 0xf, false);
    return __int_as_float(r);
}
__device__ __forceinline__ float gelu_tanh(float x) { const float y = 0.7978845608028654f * (x + 0.044715f * x * x * x); const float t = 1.0f - 2.0f * __builtin_amdgcn_rcpf(1.0f + __expf(2.0f * y)); return 0.5f * x * (1.0f + t); }
struct EpiUp {
    bf16_t* act; bf16_t* su; bf16_t* sv; const float* cw; const float* cb;
    __device__ __forceinline__ void operator()(const f32x4 (&acc)[2][2][4][2], const Unit& u, int wr, int wc, int fr, int fq) const {
#pragma unroll
        for (int n = 0; n < 2; ++n) {
            const int ch = u.pn * 128 + wc * 32 + 16 * n + 4 * fq;
            const f32x4 w0 = *(const f32x4*)(cw + ch), w1 = *(const f32x4*)(cw + 2816 + ch), w2 = *(const f32x4*)(cw + 5632 + ch), bb = *(const f32x4*)(cb + ch);
#pragma unroll
            for (int ai = 0; ai < 2; ++ai) {
                const int rowg = u.row0 + ai * 128 + wr * 64;
                f32x4 ub[4];
#pragma unroll
                for (int m = 0; m < 4; ++m)
#pragma unroll
                    for (int e = 0; e < 4; ++e) ub[m][e] = bf2f(f2bf(acc[ai][0][m][n][e]));
#pragma unroll
                for (int m = 0; m < 4; ++m) {
                    const int row = rowg + m * 16 + fr;
                    f32x4 r;
#pragma unroll
                    for (int e = 0; e < 4; ++e) {
                        const float pl = m > 0 ? dpp_f(0.f, ub[m > 0 ? m - 1 : 0][e], 2) : 0.f;
                        const float pv = dpp_f(pl, ub[m][e], 0);
                        const float nl = m < 3 ? dpp_f(0.f, ub[m < 3 ? m + 1 : 3][e], 3) : 0.f;
                        const float nv = dpp_f(nl, ub[m][e], 1);
                        const float gff = w0[e] * pv + w1[e] * ub[m][e] + w2[e] * nv + bb[e];
                        r[e] = gelu_tanh(gff) * bf2f(f2bf(acc[ai][1][m][n][e]));
                    }
                    const bool edge = (m == 0 && fr == 0) || (m == 3 && fr == 15);
                    if (!edge) { uint2 pk; pk.x = pack2(r[0], r[1]); pk.y = pack2(r[2], r[3]); *(uint2*)(act + (size_t)row * 2816 + ch) = pk; }
                    if ((m == 0 && fr < 2) || (m == 3 && fr >= 14)) {
                        const int slot = m == 0 ? fr : fr - 12; const int g64 = rowg >> 6;
                        uint2 pk; pk.x = pack2(ub[m][0], ub[m][1]); pk.y = pack2(ub[m][2], ub[m][3]);
                        *(uint2*)(su + ((size_t)g64 * 4 + slot) * 2816 + ch) = pk;
                        if (edge) { const f32x4 vv = acc[ai][1][m][n]; uint2 pv2; pv2.x = pack2(vv[0], vv[1]); pv2.y = pack2(vv[2], vv[3]); *(uint2*)(sv + ((size_t)g64 * 2 + (m == 0 ? 0 : 1)) * 2816 + ch) = pv2; }
                    }
                }
            }
        }
    }
};
struct EpiPool {
    bf16_t* dst; const float* scale;
    __device__ __forceinline__ void operator()(const f32x4 (&acc)[2][2][4][2], const Unit& u, int wr, int wc, int fr, int fq) const {
        const int c0 = u.pn * 256 + wc * 32 + 4 * fq;
        f32x4 sc[4];
#pragma unroll
        for (int g = 0; g < 4; ++g) sc[g] = *(const f32x4*)(scale + c0 + (g >> 1) * 128 + (g & 1) * 16);
#pragma unroll
        for (int ai = 0; ai < 2; ++ai)
#pragma unroll
            for (int m = 0; m < 4; ++m) { const int row = u.pm * 256 + wr * 64 + fr + ai * 128 + m * 16;
#pragma unroll
                for (int g = 0; g < 4; ++g) { const f32x4 v = acc[ai][g >> 1][m][g & 1] * sc[g];
                    uint2 pk; pk.x = pack2(v[0], v[1]); pk.y = pack2(v[2], v[3]);
                    *(uint2*)(dst + (size_t)row * 1024 + c0 + (g >> 1) * 128 + (g & 1) * 16) = pk; } }
    }
};

struct WPtrs { const float *w_in, *w_branch, *lru_wa, *lru_wx, *pool_w, *w_out, *ffn_up, *ffn_down; unsigned char* ws; };
struct TileDesc { const float* src; int lds_; bf16_t* dst; int ldd, k0, n0, perm, nd; };
__device__ __forceinline__ int swap45(int p) { return (p & ~48) | ((p & 16) << 1) | ((p & 32) >> 1); }
__device__ __forceinline__ TileDesc weight_tile(const WPtrs& P, int l, int t) {
    unsigned char* ws = P.ws; TileDesc d; int r = t; d.perm = 0; d.nd = -1;
    if (r < 1664) { d.src = P.w_in + (size_t)l * 1024 * 6656; d.lds_ = 6656; d.dst = (bf16_t*)(ws + OFF_WIN); d.ldd = 1024; d.k0 = (r / 104) * 64; d.n0 = (r % 104) * 64; d.perm = (d.n0 >= 1024 && d.n0 < 2304) ? 1 : 0; }
    else if ((r -= 1664) < 128) { const int mat = r / 64; r %= 64; const int dh = r / 4; r %= 4;
        d.src = (mat ? P.lru_wx : P.lru_wa) + (size_t)(l * 16 + dh) * 128 * 128; d.lds_ = 128; d.dst = (bf16_t*)(ws + OFF_GW) + (size_t)dh * 256 * 128 + (size_t)mat * 128 * 128; d.ldd = 128; d.k0 = (r / 2) * 64; d.n0 = (r % 2) * 64; }
    else if ((r -= 128) < 64) { const int g = r / 16; r %= 16; d.src = P.pool_w + (size_t)(l * 4 + g) * 256 * 256; d.lds_ = 256; d.dst = (bf16_t*)(ws + OFF_PW) + (size_t)g * 256 * 256; d.ldd = 256; d.k0 = (r / 4) * 64; d.n0 = (r % 4) * 64; }
    else if ((r -= 64) < 768) { const int j = r / 256; r %= 256; d.src = P.w_branch + (size_t)(l * 3 + j) * 1024 * 1024; d.lds_ = 1024; d.dst = (bf16_t*)(ws + OFF_WBR) + (size_t)j * 1024 * 1024; d.ldd = 1024; d.k0 = (r / 16) * 64; d.n0 = (r % 16) * 64; }
    else if ((r -= 768) < 256) { d.src = P.w_out + (size_t)l * 1024 * 1024; d.lds_ = 1024; d.dst = (bf16_t*)(ws + OFF_WOUT); d.ldd = 1024; d.k0 = (r / 16) * 64; d.n0 = (r % 16) * 64; }
    else if ((r -= 256) < 1408) { d.src = P.ffn_up + (size_t)l * 1024 * 5632; d.lds_ = 5632; d.dst = (bf16_t*)(ws + OFF_WUP); d.ldd = 1024; d.k0 = (r / 88) * 64; d.n0 = (r % 88) * 64;
        { const int isv = d.n0 >= 2816, c0 = isv ? d.n0 - 2816 : d.n0; d.nd = (c0 >> 7) * 256 + (c0 & 127) + (isv ? 128 : 0); } }
    else { r -= 1408; d.src = P.ffn_down + (size_t)l * 2816 * 1024; d.lds_ = 1024; d.dst = (bf16_t*)(ws + OFF_WDN); d.ldd = 2816; d.k0 = (r / 16) * 64; d.n0 = (r % 16) * 64; }
    return d;
}
__device__ __noinline__ void convert_weights_(const float* p0, const float* p1, const float* p2, const float* p3, const float* p4, const float* p5, const float* p6, const float* p7, unsigned char* pws,
                                              int l, LAS unsigned char* lds, int t_begin, int t_end, int first, int stride) {
    const WPtrs P{p0, p1, p2, p3, p4, p5, p6, p7, pws};
    LAS bf16_t* sm = (LAS bf16_t*)lds;
    const int tid = otid();
    const int kk0 = tid >> 4, n4 = (tid & 15) * 4, nn = tid >> 3, ck = tid & 7;
    int t = t_begin + first;
    if (t >= t_end) return;
    TileDesc d = weight_tile(P, l, t);
    f32x4 v0 = __builtin_nontemporal_load((const f32x4*)(d.src + (size_t)(d.k0 + kk0) * d.lds_ + d.n0 + n4)), v1 = __builtin_nontemporal_load((const f32x4*)(d.src + (size_t)(d.k0 + kk0 + 32) * d.lds_ + d.n0 + n4));
    for (;;) {
        __syncthreads();
#pragma unroll
        for (int e = 0; e < 4; ++e) { sm[(n4 + e) * 72 + kk0] = f2bf(v0[e]); sm[(n4 + e) * 72 + kk0 + 32] = f2bf(v1[e]); }
        __syncthreads();
        const TileDesc cur = d; const int tn = t + stride; const bool more = tn < t_end;
        if (more) { d = weight_tile(P, l, tn); v0 = __builtin_nontemporal_load((const f32x4*)(d.src + (size_t)(d.k0 + kk0) * d.lds_ + d.n0 + n4)); v1 = __builtin_nontemporal_load((const f32x4*)(d.src + (size_t)(d.k0 + kk0 + 32) * d.lds_ + d.n0 + n4)); }
        const u32x4 o = *(const LAS u32x4*)(sm + nn * 72 + ck * 8);
        const int nrow = cur.perm ? swap45(cur.n0 + nn) : ((cur.nd >= 0 ? cur.nd : cur.n0) + nn);
        *(u32x4*)(cur.dst + (size_t)nrow * cur.ldd + cur.k0 + ck * 8) = o;
        if (!more) break;
        t = tn;
    }
    __syncthreads();
}

__device__ __forceinline__ void convert_weights(const Params& P, int l, LAS unsigned char* lds, int t_begin, int t_end, int first, int stride) {
    convert_weights_(P.w_in, P.w_branch, P.lru_wa, P.lru_wx, P.pool_w, P.w_out, P.ffn_up, P.ffn_down, P.ws, l, lds, t_begin, t_end, first, stride);
}

__device__ void phase0(const Params& P, LAS unsigned char* lds) {
    const int tid = otid(), G = gridDim.x, c = blockIdx.x;
    { bf16_t* ck = (bf16_t*)(P.ws + OFF_CK); bf16_t* cv = (bf16_t*)(P.ws + OFF_CV);
      for (int i = c * 512 + tid; i < 2 * 2 * 512 * 256; i += G * 512) {
          const int e = i & 255, t = (i >> 8) & 511, b = (i >> 17) & 1, l = i >> 18;
          const size_t si = ((size_t)((b * 2 + l) * 512 + t)) * 256 + e;
          ck[i] = f2bf(P.cache_k[si]); cv[i] = f2bf(P.cache_v[si]); } }
    { float* rc = (float*)(P.ws + OFF_ROPE); float* rs = rc + 2048;
      for (int i = c * 512 + tid; i < 2048; i += G * 512) {
          const int pos = i >> 5, k = i & 31; const float fr = powf(10000.0f, -(float)k / 32.0f); const float ang = (float)pos * fr;
          rc[i] = cosf(ang); rs[i] = sinf(ang); } }
    { LAS float* sv = (LAS float*)lds;
      LAS float* red = sv + 3072;
      __syncthreads();
      for (int i = tid; i < 3072; i += 512) { const int s = i >> 10, k = i & 1023; const float x = s == 0 ? P.c_ctx[k] : P.c[(s - 1) * 1024 + k]; sv[i] = x / (1.0f + expf(-x)); }
      __syncthreads();
      float* mod = (float*)(P.ws + OFF_MOD);
      for (int it = c; it < 384; it += G) {
          const int l = it / 192, cg_ = it % 192, cl = tid & 31, kg = tid >> 5, col = cg_ * 32 + cl;
          const float* w = P.w_ada + (size_t)l * 1024 * 6144 + col;
          float a0 = 0.f, a1 = 0.f, a2 = 0.f;
#pragma unroll 16
          for (int k = kg * 64; k < kg * 64 + 64; ++k) { const float wv = __builtin_nontemporal_load(w + (size_t)k * 6144); a0 += sv[k] * wv; a1 += sv[1024 + k] * wv; a2 += sv[2048 + k] * wv; }
          red[(kg * 3 + 0) * 32 + cl] = a0; red[(kg * 3 + 1) * 32 + cl] = a1; red[(kg * 3 + 2) * 32 + cl] = a2;
          __syncthreads();
          if (tid < 96) { const int s = tid >> 5, cc = tid & 31; float sum = 0.f;
#pragma unroll
              for (int g = 0; g < 16; ++g) sum += red[(g * 3 + s) * 32 + cc];
              mod[(size_t)(l * 3 + s) * 6144 + cg_ * 32 + cc] = sum + P.b_ada[l * 6144 + cg_ * 32 + cc]; }
          __syncthreads();
      } }
}

template <bool FINAL>
__device__ __forceinline__ void norm_rows(float* X, const float* xa, const float* xb, const float* __restrict__ gw, const float* __restrict__ mod, int shift_off, int scale_off, bf16_t* __restrict__ H) {
    const int tid = otid(); const int lane = tid & 63, wv = blockIdx.x * 8 + (tid >> 6), nw = gridDim.x * 8;
    constexpr int R = 3;
    for (int row0 = wv; row0 < MROWS; row0 += R * nw) {
        f32x4 v[R][4];
#pragma unroll
        for (int r = 0; r < R; ++r) { const int row = row0 + r * nw;
#pragma unroll
            for (int i = 0; i < 4; ++i) v[r][i] = row < MROWS ? *(const f32x4*)((row < MCTX ? xa + (size_t)row * 1024 : xb + (size_t)(row - MCTX) * 1024) + i * 256 + lane * 4) : (f32x4){0.f, 0.f, 0.f, 0.f}; }
#pragma unroll
        for (int r = 0; r < R; ++r) { const int row = row0 + r * nw; if (row >= MROWS) continue;
            float ss = 0.f;
#pragma unroll
            for (int i = 0; i < 4; ++i) ss += v[r][i][0] * v[r][i][0] + v[r][i][1] * v[r][i][1] + v[r][i][2] * v[r][i][2] + v[r][i][3] * v[r][i][3];
#pragma unroll
            for (int o = 32; o >= 1; o >>= 1) ss += __shfl_xor(ss, o);
            const float rstd = rsqrtf(ss * (1.0f / 1024.0f) + 1e-6f);
            const float* md = mod + seq_group(row) * 6144;
#pragma unroll
            for (int i = 0; i < 4; ++i) { const int col = i * 256 + lane * 4;
                const f32x4 g = *(const f32x4*)(gw + col);
                if (FINAL) { f32x4 h;
#pragma unroll
                    for (int e = 0; e < 4; ++e) h[e] = v[r][i][e] * rstd * g[e];
                    *(f32x4*)(X + (size_t)row * 1024 + col) = h; }
                else { const f32x4 sc = *(const f32x4*)(md + scale_off + col), sh = *(const f32x4*)(md + shift_off + col);
                    f32x4 h;
#pragma unroll
                    for (int e = 0; e < 4; ++e) h[e] = v[r][i][e] * rstd * g[e] * (1.0f + sc[e]) + sh[e];
                    uint2 pk; pk.x = pack2(h[0], h[1]); pk.y = pack2(h[2], h[3]);
                    *(uint2*)(H + (size_t)row * 1024 + col) = pk; } }
        }
    }
}
__device__ void norm_phase(const float* xa, const float* xb, const float* __restrict__ gw, const float* __restrict__ mod, int shift_off, int scale_off, bf16_t* __restrict__ H) { norm_rows<false>(nullptr, xa, xb, gw, mod, shift_off, scale_off, H); }
__device__ void final_norm_phase(float* X, const float* __restrict__ gw) { norm_rows<true>(X, X, X + (size_t)MCTX * 1024, gw, nullptr, 0, 0, nullptr); }

template <int HALF>
__device__ __forceinline__ void pool_item(const bf16_t* __restrict__ XC, bf16_t* __restrict__ PL, int it) {
    constexpr int G_ = HALF == 1 ? 0 : (HALF == 2 ? 1 : (HALF == 4 ? 2 : 3));
    const int rs = (it >> 5) * 8, ch = G_ * 256 + (it & 31) * 8;
    const int T = rs < MCTX ? 256 : 2048, row0 = rs < MCTX ? (rs & ~255) : MCTX + ((rs - MCTX) & ~2047), tl0 = rs - row0;
    const bf16_t* base = XC + (size_t)row0 * 1024 + ch;
    constexpr int R = 8 + 2 * HALF;
    bf16x8 xr[R];
#pragma unroll
    for (int i = 0; i < R; ++i) { const int t = tl0 - HALF + i; xr[i] = (bf16x8){0, 0, 0, 0, 0, 0, 0, 0}; if (t >= 0 && t < T) xr[i] = *(const bf16x8*)(base + (size_t)t * 1024); }
    float s[8];
#pragma unroll
    for (int e = 0; e < 8; ++e) { s[e] = 0.f;
#pragma unroll
        for (int i = 0; i < 2 * HALF; ++i) s[e] += bf2f((unsigned short)xr[i][e]); }
#pragma unroll
    for (int j = 0; j < 8; ++j) {
        const int t = tl0 + j;
        const float inv = 1.0f / (float)(min(t + HALF, T) - max(t - HALF, 0));
        float r[8];
#pragma unroll
        for (int e = 0; e < 8; ++e) r[e] = s[e] * inv - bf2f((unsigned short)xr[j + HALF][e]);
        u32x4 o; o.x = pack2(r[0], r[1]); o.y = pack2(r[2], r[3]); o.z = pack2(r[4], r[5]); o.w = pack2(r[6], r[7]);
        *(u32x4*)(PL + (size_t)(row0 + t) * 1024 + ch) = o;
#pragma unroll
        for (int e = 0; e < 8; ++e) s[e] += bf2f((unsigned short)xr[j + 2 * HALF][e]) - bf2f((unsigned short)xr[j][e]);
    }
}
__device__ void pool_phase(const bf16_t* __restrict__ XC, bf16_t* __restrict__ PL) {
    const int tid = otid();
    constexpr int PER_G = (MROWS / 8) * 32;
    for (int idx = blockIdx.x * 512 + tid; idx < 4 * PER_G; idx += gridDim.x * 512) {
        const int g = idx / PER_G, it = idx % PER_G;
        if (g == 0) pool_item<1>(XC, PL, it); else if (g == 1) pool_item<2>(XC, PL, it); else if (g == 2) pool_item<4>(XC, PL, it); else pool_item<8>(XC, PL, it);
    }
}
__device__ void ffn_fix_groups(const bf16_t* __restrict__ SU, const bf16_t* __restrict__ SV, bf16_t* __restrict__ ACT, const float* __restrict__ cw, const float* __restrict__ cb, int g0, int ng) {
    const int tid = otid();
    for (int idx = tid; idx < ng * 2 * 352; idx += 512) {
        const int br = idx / 352, ch = (idx % 352) * 8;
        const int g = g0 + (br >> 1), last = br & 1;
        const int row = g * 64 + (last ? 63 : 0);
        const int T = row < MCTX ? 256 : 2048, row0 = row < MCTX ? (row & ~255) : MCTX + ((row - MCTX) & ~2047), tl = row - row0;
        const bf16x8 zero = (bf16x8){0, 0, 0, 0, 0, 0, 0, 0};
        bf16x8 um, u0, un;
        if (last) { um = *(const bf16x8*)(SU + ((size_t)g * 4 + 2) * 2816 + ch); u0 = *(const bf16x8*)(SU + ((size_t)g * 4 + 3) * 2816 + ch);
                    un = tl < T - 1 ? *(const bf16x8*)(SU + ((size_t)(g + 1) * 4 + 0) * 2816 + ch) : zero; }
        else { um = tl > 0 ? *(const bf16x8*)(SU + ((size_t)(g - 1) * 4 + 3) * 2816 + ch) : zero; u0 = *(const bf16x8*)(SU + ((size_t)g * 4 + 0) * 2816 + ch);
               un = *(const bf16x8*)(SU + ((size_t)g * 4 + 1) * 2816 + ch); }
        const bf16x8 vv = *(const bf16x8*)(SV + ((size_t)g * 2 + last) * 2816 + ch);
        float r[8];
#pragma unroll
        for (int e = 0; e < 8; ++e) { const float gff = cw[ch + e] * bf2f((unsigned short)um[e]) + cw[2816 + ch + e] * bf2f((unsigned short)u0[e]) + cw[5632 + ch + e] * bf2f((unsigned short)un[e]) + cb[ch + e];
            r[e] = gelu_tanh(gff) * bf2f((unsigned short)vv[e]); }
        u32x4 o; o.x = pack2(r[0], r[1]); o.y = pack2(r[2], r[3]); o.z = pack2(r[4], r[5]); o.w = pack2(r[6], r[7]);
        *(u32x4*)(ACT + (size_t)row * 2816 + ch) = o;
    }
}

__device__ __forceinline__ void rope8(bf16x8& x1, bf16x8& x2, const float* __restrict__ cs, const float* __restrict__ sn) {
#pragma unroll
    for (int e = 0; e < 8; ++e) { const float a = bf2f((unsigned short)x1[e]), b = bf2f((unsigned short)x2[e]); const float c = cs[e], s = sn[e];
        x1[e] = (short)f2bf(a * c - b * s); x2[e] = (short)f2bf(a * s + b * c); }
}
constexpr int VT_OFF = 64 * 272;
constexpr int ABUF = 64 * 272 + 64 * 288;
__device__ void attn_unit(const Params& P, int l, int u, LAS unsigned char* lds) {
    int tid_ = threadIdx.x; asm volatile("" : "+v"(tid_));
    const int tid = tid_, w = tid >> 6, lane = tid & 63, fr = lane & 15, fq = lane >> 4;
    const bf16_t* Q = (const bf16_t*)(P.ws + OFF_XAQ) + (size_t)MROWS * 1024;
    const bf16_t* KB = (const bf16_t*)(P.ws + OFF_KB); const bf16_t* VB = (const bf16_t*)(P.ws + OFF_VB);
    const bf16_t* CK = (const bf16_t*)(P.ws + OFF_CK); const bf16_t* CV = (const bf16_t*)(P.ws + OFF_CV);
    bf16_t* YB = (bf16_t*)(P.ws + OFF_YB);
    bool lat; int head, row0, T, qstart, bidx;
    if (u < 256) { lat = true; bidx = u >> 7; const int rem = u & 127; head = rem >> 4; qstart = (rem & 15) * 128; T = 2048; row0 = MCTX + bidx * 2048; }
    else { const int v = u - 256; lat = false; bidx = 0;
           const int r = v >> 6, g = v & 63; const int seq = g >> 1; head = (g & 1) * 4 + (r >> 1); qstart = (r & 1) * 128; T = 256; row0 = seq * 256; }
    const int kvh = head >> 2;
    const int qpos = qstart + w * 16 + fr;
    bf16x8 qf[4];
    { const bf16_t* qp = Q + (size_t)(row0 + qpos) * 1024 + head * 128 + fq * 8;
#pragma unroll
      for (int kk = 0; kk < 4; ++kk) qf[kk] = *(const bf16x8*)(qp + kk * 32); }
    float m_run = P.attn_sink[l * 8 + head] * 1.4426950408889634f; float l_run = (fq == 0) ? 1.0f : 0.0f;
    f32x4 o[8];
#pragma unroll
    for (int dt = 0; dt < 8; ++dt) o[dt] = (f32x4){0.f, 0.f, 0.f, 0.f};
    int wlo = 0, nwt = 4;
    if (lat) { wlo = max(0, qstart - 128); const int whi = min(T, qstart + 256); nwt = (whi - wlo) >> 6; }
    const int ntiles = nwt + (lat ? 8 : 0);
    const float scale = 0.08838834764831845f * 1.4426950408889634f;
    const int lkey = tid >> 3, lp = tid & 7;
    bf16x8 rk[2][2], rv[2][2];
    auto tile_load = [&](int ti, bf16x8 (&k_)[2], bf16x8 (&v_)[2]) {
        const bf16_t* ksrc; const bf16_t* vsrc;
        if (ti < nwt) { const int k0 = wlo + ti * 64; ksrc = KB + (size_t)(row0 + k0) * 256 + kvh * 128; vsrc = VB + (size_t)(row0 + k0) * 256 + kvh * 128; }
        else { const int k0 = (ti - nwt) * 64; const size_t o_ = ((size_t)((l * 2 + bidx) * 512 + k0)) * 256 + kvh * 128; ksrc = CK + o_; vsrc = CV + o_; }
        const bf16_t* kr = ksrc + (size_t)lkey * 256; k_[0] = *(const bf16x8*)(kr + lp * 8); k_[1] = *(const bf16x8*)(kr + (lp + 8) * 8);
        const bf16_t* vr = vsrc + (size_t)lkey * 256; v_[0] = *(const bf16x8*)(vr + lp * 8); v_[1] = *(const bf16x8*)(vr + (lp + 8) * 8); };
    const int krow = (lkey & 32) | ((lkey & 4) << 2) | ((lkey & 24) >> 1) | (lkey & 3);
    auto tile_store = [&](int b, const bf16x8 (&k_)[2], const bf16x8 (&v_)[2]) {
        LAS unsigned char* kb_ = lds + b * ABUF; LAS unsigned char* vb_ = kb_ + VT_OFF;
        *(LAS bf16x8*)(kb_ + krow * 272 + lp * 16) = k_[0]; *(LAS bf16x8*)(kb_ + krow * 272 + (lp + 8) * 16) = k_[1];
        *(LAS bf16x8*)(vb_ + lkey * 288 + lp * 16) = v_[0]; *(LAS bf16x8*)(vb_ + lkey * 288 + (lp + 8) * 16) = v_[1]; };
    tile_load(0, rk[0], rv[0]);
    tile_load(1, rk[1], rv[1]);
    __syncthreads();
    tile_store(0, rk[0], rv[0]);
    tile_load(2, rk[0], rv[0]);
#pragma unroll 2
    for (int ti = 0; ti < ntiles; ++ti) {
        const bool win = ti < nwt; const int k0 = win ? wlo + ti * 64 : (ti - nwt) * 64;
        __syncthreads();
        if ((ti & 1) == 0) { if (ti + 1 < ntiles) tile_store(1, rk[1], rv[1]); if (ti + 3 < ntiles) tile_load(ti + 3, rk[1], rv[1]); }
        else { if (ti + 1 < ntiles) tile_store(0, rk[0], rv[0]); if (ti + 3 < ntiles) tile_load(ti + 3, rk[0], rv[0]); }
        LAS unsigned char* kb_ = lds + (ti & 1) * ABUF; LAS unsigned char* vb_ = kb_ + VT_OFF;
        f32x4 s[4];
#pragma unroll
        for (int nt = 0; nt < 4; ++nt) { s[nt] = (f32x4){0.f, 0.f, 0.f, 0.f};
#pragma unroll
            for (int kk = 0; kk < 4; ++kk) { const bf16x8 a = *(const LAS bf16x8*)(kb_ + (nt * 16 + fr) * 272 + kk * 64 + fq * 16); s[nt] = __builtin_amdgcn_mfma_f32_16x16x32_bf16(a, qf[kk], s[nt], 0, 0, 0); } }
        float mt = -3.0e38f;
#pragma unroll
        for (int nt = 0; nt < 4; ++nt)
#pragma unroll
            for (int j = 0; j < 4; ++j) { float v = s[nt][j] * scale;
                if (lat && win) { const int kp = k0 + 32 * (nt >> 1) + 8 * fq + 4 * (nt & 1) + j; const int dd = qpos - kp; if (dd > 128 || dd < -128) v = -1.0e30f; }
                s[nt][j] = v; mt = fmaxf(mt, v); }
        mt = fmaxf(mt, __shfl_xor(mt, 16)); mt = fmaxf(mt, __shfl_xor(mt, 32));
        const float mn = fmaxf(m_run, mt); const float alpha = __builtin_amdgcn_exp2f(m_run - mn); m_run = mn;
        float ps = 0.f;
#pragma unroll
        for (int nt = 0; nt < 4; ++nt)
#pragma unroll
            for (int j = 0; j < 4; ++j) { const float p = __builtin_amdgcn_exp2f(s[nt][j] - mn); ps += p; s[nt][j] = p; }
        l_run = l_run * alpha + ps;
#pragma unroll
        for (int dt = 0; dt < 8; ++dt) o[dt] = o[dt] * alpha;
#pragma unroll
        for (int s2 = 0; s2 < 2; ++s2) {
            u32x4 pu; pu[0] = pack2(s[2 * s2][0], s[2 * s2][1]); pu[1] = pack2(s[2 * s2][2], s[2 * s2][3]); pu[2] = pack2(s[2 * s2 + 1][0], s[2 * s2 + 1][1]); pu[3] = pack2(s[2 * s2 + 1][2], s[2 * s2 + 1][3]);
            const bf16x8 pf = __builtin_bit_cast(bf16x8, pu);
#pragma unroll
            for (int dt = 0; dt < 8; ++dt) {
                const bf16x4 lo = __builtin_amdgcn_ds_read_tr16_b64_v4i16((LAS bf16x4*)(vb_ + (s2 * 32 + fq * 8 + (fr >> 2)) * 288 + (dt * 16 + (fr & 3) * 4) * 2));
                const bf16x4 hi = __builtin_amdgcn_ds_read_tr16_b64_v4i16((LAS bf16x4*)(vb_ + (s2 * 32 + fq * 8 + 4 + (fr >> 2)) * 288 + (dt * 16 + (fr & 3) * 4) * 2));
                const bf16x8 af = __builtin_shufflevector(lo, hi, 0, 1, 2, 3, 4, 5, 6, 7);
                o[dt] = __builtin_amdgcn_mfma_f32_16x16x32_bf16(af, pf, o[dt], 0, 0, 0);
            }
        }
    }
    float lt = l_run; lt += __shfl_xor(lt, 16); lt += __shfl_xor(lt, 32);
    const float inv = 1.0f / lt;
    bf16_t* yp = YB + (size_t)(row0 + qpos) * 1024 + head * 128 + fq * 4;
#pragma unroll
    for (int dt = 0; dt < 8; ++dt) { uint2 pk; pk.x = pack2(o[dt][0] * inv, o[dt][1] * inv); pk.y = pack2(o[dt][2] * inv, o[dt][3] * inv); *(uint2*)(yp + dt * 16) = pk; }
}

constexpr int YT_OFF = 256 * 272;
template <int MODE, int D, int NSC>
__device__ __forceinline__ void lru_dir(const Params& P, int l, int s, int cchunk, int h, LAS unsigned char* lds, int w, int fr, int fq) {
    const bool lat = s >= 32; const int row0 = lat ? MCTX + (s - 32) * 2048 : s * 256; const int t0 = cchunk * (NSC * 64);
    constexpr int NCH = 2048 / (NSC * 64);
    const bf16_t* GW = (const bf16_t*)(P.ws + OFF_GW);
    bf16_t* YA = (bf16_t*)(P.ws + OFF_YA);
    float* SUMM = (float*)(P.ws + OFF_SUMM);
    const int chl = 16 * w + fr, ch = h * 128 + chl;
    bf16x8 bwa[4], bwx[4];
    { const bf16_t* gp = GW + ((size_t)(D * 8 + h) * 256 + chl) * 128 + fq * 8;
#pragma unroll
      for (int kk = 0; kk < 4; ++kk) { bwa[kk] = *(const bf16x8*)(gp + kk * 32); bwx[kk] = *(const bf16x8*)(gp + 128 * 128 + kk * 32); } }
    const int pidx = (l * 2 + D) * 1024 + ch;
    const float ba = P.lru_ba[pidx], bx = P.lru_bx[pidx];
    const float lam = P.lru_lambda[pidx];
    const float c8 = -8.0f * log1pf(expf(-lam));
    float carry = 0.f;
    if (MODE == 0 && lat) {
        const int b = s - 32;
        carry = P.state_lru[((size_t)(b * 2 + l) * 2 + D) * 1024 + ch];
        if (D == 0) { for (int cc = 0; cc < cchunk; ++cc) { const float* sp = SUMM + ((size_t)((b * 2 + 0) * 16 + cc) * 1024 + ch) * 2; carry = sp[1] + sp[0] * carry; } }
        else { for (int cc = NCH - 1; cc > cchunk; --cc) { const float* sp = SUMM + ((size_t)((b * 2 + 1) * 16 + cc) * 1024 + ch) * 2; carry = sp[1] + sp[0] * carry; } }
    }
    float ptot = 1.0f;
#pragma unroll 1
    for (int sci = 0; sci < NSC; ++sci) {
        const int sc = D == 0 ? sci : NSC - 1 - sci;
        f32x4 r[4], g[4];
#pragma unroll
        for (int m = 0; m < 4; ++m) { r[m] = (f32x4){0.f, 0.f, 0.f, 0.f}; g[m] = (f32x4){0.f, 0.f, 0.f, 0.f};
#pragma unroll
            for (int kk = 0; kk < 4; ++kk) { const bf16x8 a = *(const LAS bf16x8*)(lds + (sc * 64 + m * 16 + fr) * 272 + kk * 64 + fq * 16);
                r[m] = __builtin_amdgcn_mfma_f32_16x16x32_bf16(a, bwa[kk], r[m], 0, 0, 0); g[m] = __builtin_amdgcn_mfma_f32_16x16x32_bf16(a, bwx[kk], g[m], 0, 0, 0); } }
#pragma unroll
        for (int mi = 0; mi < 4; ++mi) {
            const int m = D == 0 ? mi : 3 - mi;
            float av[4], bv[4];
#pragma unroll
            for (int j = 0; j < 4; ++j) {
                const float ea = 1.0f + __expf(-(r[m][j] + ba)), eb = 1.0f + __expf(-(g[m][j] + bx));
                const float inv = __builtin_amdgcn_rcpf(ea * eb);
                const float rr = inv * eb, ii = inv * ea;
                const float la = c8 * rr; const float a = __expf(la); const float z = 2.0f * la;
                const float em = (z > -0.05f) ? -z * (1.0f + z * (0.5f + z * (0.16666667f + z * 0.041666667f))) : 1.0f - a * a;
                const float x = bf2f(*(const LAS bf16_t*)(lds + (sc * 64 + m * 16 + fq * 4 + j) * 272 + chl * 2));
                av[j] = a; bv[j] = __builtin_amdgcn_sqrtf(em) * ii * x;
            }
            float p4, h4;
            p4 = av[0] * av[1] * av[2] * av[3];
            if (D == 0) h4 = ((bv[0] * av[1] + bv[1]) * av[2] + bv[2]) * av[3] + bv[3];
            else h4 = ((bv[3] * av[2] + bv[2]) * av[1] + bv[1]) * av[0] + bv[0];
            float pq[4], hq[4];
#pragma unroll
            for (int f = 0; f < 4; ++f) { pq[f] = __shfl(p4, fr + 16 * f); hq[f] = __shfl(h4, fr + 16 * f); }
            float cin = carry, mycin = 0.f;
#pragma unroll
            for (int fi = 0; fi < 4; ++fi) { const int f = D == 0 ? fi : 3 - fi; if (f == fq) mycin = cin; cin = hq[f] + pq[f] * cin; }
            carry = cin;
            if (MODE == 1) ptot *= pq[0] * pq[1] * pq[2] * pq[3];
            if (MODE == 0) {
                float hh = mycin; float y[4];
#pragma unroll
                for (int ji = 0; ji < 4; ++ji) { const int j = D == 0 ? ji : 3 - ji; hh = av[j] * hh + bv[j]; y[j] = hh; }
#pragma unroll
                for (int j = 0; j < 4; ++j) {
                    LAS bf16_t* yp = (LAS bf16_t*)(lds + YT_OFF + (sc * 64 + m * 16 + fq * 4 + j) * 272 + chl * 2);
                    if (D == 0) *yp = f2bf(y[j]);
                    else *yp = f2bf(bf2f(*yp) + y[j]);
                }
            }
        }
    }
    if (MODE == 0 && !lat && fq == 0) P.out[OUT_H + ((size_t)(s * 2 + l) * 2 + D) * 1024 + ch] = carry;
    if (MODE == 1 && fq == 0) { float* sp = SUMM + ((size_t)(((s - 32) * 2 + D) * 16 + cchunk) * 1024 + ch) * 2; sp[0] = ptot; sp[1] = carry; }
}
template <int MODE, int NSC>
__device__ void lru_unit(const Params& P, int l, int s, int cchunk, int h, LAS unsigned char* lds) {
    int tid_ = threadIdx.x; asm volatile("" : "+v"(tid_));
    const int tid = tid_, w = tid >> 6, lane = tid & 63, fr = lane & 15, fq = lane >> 4;
    const bool lat = s >= 32; const int T = lat ? 2048 : 256; const int row0 = lat ? MCTX + (s - 32) * 2048 : s * 256; const int t0 = cchunk * (NSC * 64);
    const bf16_t* XA = (const bf16_t*)(P.ws + OFF_XAQ);
    constexpr int RUN = NSC * 2;
    {
        const int ck = tid & 15, ch = h * 128 + ck * 8, tr = (tid >> 4) * RUN;
        const float* cw = P.lru_conv + (size_t)l * 4096 + ch; const float* cb = P.lru_conv_b + l * 1024 + ch;
        bf16x8 xr[RUN + 3];
#pragma unroll
        for (int i = 0; i < RUN + 3; ++i) { const int tt = t0 + tr + i - 2; xr[i] = (bf16x8){0, 0, 0, 0, 0, 0, 0, 0};
            if (tt >= 0 && tt < T) xr[i] = *(const bf16x8*)(XA + (size_t)(row0 + tt) * 1024 + ch); }
        float wk[4][8], bk[8];
#pragma unroll
        for (int e = 0; e < 8; ++e) { bk[e] = cb[e];
#pragma unroll
            for (int k = 0; k < 4; ++k) wk[k][e] = cw[k * 1024 + e]; }
        __syncthreads();
#pragma unroll
        for (int i = 0; i < RUN; ++i) {
            float a8[8];
#pragma unroll
            for (int e = 0; e < 8; ++e) { a8[e] = bk[e];
#pragma unroll
                for (int k = 0; k < 4; ++k) a8[e] += wk[k][e] * bf2f((unsigned short)xr[i + k][e]); }
            u32x4 o; o.x = pack2(a8[0], a8[1]); o.y = pack2(a8[2], a8[3]); o.z = pack2(a8[4], a8[5]); o.w = pack2(a8[6], a8[7]);
            *(LAS u32x4*)(lds + (tr + i) * 272 + ck * 16) = o;
        }
    }
    __syncthreads();
    lru_dir<MODE, 0, NSC>(P, l, s, cchunk, h, lds, w, fr, fq);
    lru_dir<MODE, 1, NSC>(P, l, s, cchunk, h, lds, w, fr, fq);
    if (MODE == 0) {
        bf16_t* YA = (bf16_t*)(P.ws + OFF_YA);
        __syncthreads();
#pragma unroll
        for (int it = 0; it < 2 * NSC; ++it) { const int t = (tid >> 4) + it * 32, ck = tid & 15;
            const u32x4 v = *(const LAS u32x4*)(lds + YT_OFF + t * 272 + ck * 16);
            *(u32x4*)(YA + (size_t)(row0 + t0 + t) * 1024 + h * 128 + ck * 8) = v; }
    }
}

#define XB_TMO      128
#define XB_XCNT(j)  (256  + 64 * (j))
#define XB_XSUB(j)  (1280 + 64 * (j))
#define XB_XGEN(j)  (2304 + 64 * (j))
#define XB_TOP      3328
#define XB_TOPGEN   3392
#define XCD_BAR_WORDS 3456
#define XB_SPIN_CAP (1u << 18)
__device__ __forceinline__ unsigned xb_ld(unsigned* p)              { return __hip_atomic_load(p, __ATOMIC_RELAXED, __HIP_MEMORY_SCOPE_AGENT); }
__device__ __forceinline__ unsigned xb_add(unsigned* p, unsigned v) { return __hip_atomic_fetch_add(p, v, __ATOMIC_RELAXED, __HIP_MEMORY_SCOPE_AGENT); }
__device__ __forceinline__ unsigned xb_xcc_id() { return (unsigned)__builtin_amdgcn_s_getreg((3 << 11) | 20) & 0xFu; }
#define XB_SPIN(cond, bar) do { unsigned _sp = 0; while (cond) { __builtin_amdgcn_s_sleep(1); \
    if ((++_sp & 255u) == 0u) { if (xb_ld(&(bar)[XB_TMO])) break; if (_sp > XB_SPIN_CAP) { atomicAdd(&(bar)[XB_TMO], 1u); break; } } } } while (0)
struct XcdBarrier { unsigned* bar; unsigned x; volatile LAS unsigned* st; };
__device__ __forceinline__ XcdBarrier xcd_barrier_post(unsigned* bar, volatile LAS unsigned* st) {
    XcdBarrier b; b.bar = bar; b.x = xb_xcc_id(); b.st = st;
    if (threadIdx.x == 0) (void)xb_add(&bar[XB_XCNT(b.x)], 1u);
    return b;
}
__device__ __forceinline__ void xcd_barrier_complete(unsigned* bar, unsigned x, unsigned& nloc, unsigned& nx) {
    const unsigned G = gridDim.x * gridDim.y * gridDim.z;
    unsigned sum, cnt, mine, sp = 0u;
    for (;;) {
        sum = 0u; cnt = 0u; mine = 0u;
#pragma unroll
        for (unsigned j = 0; j < 16; ++j) { const unsigned c = xb_ld(&bar[XB_XCNT(j)]); sum += c; cnt += (c > 0u) ? 1u : 0u; mine = (j == x) ? c : mine; }
        if (sum == G) break;
        __builtin_amdgcn_s_sleep(1);
        if ((++sp & 255u) == 0u) { if (xb_ld(&bar[XB_TMO])) break; if (sp > XB_SPIN_CAP) { atomicAdd(&bar[XB_TMO], 1u); break; } }
    }
    nloc = mine > 0u ? mine : 1u; nx = cnt > 0u ? cnt : 1u;
}
__device__ __noinline__ void xcd_barrier_(unsigned* bbar, unsigned bx, volatile LAS unsigned* bst) {
    XcdBarrier b; b.bar = bbar; b.x = bx; b.st = bst;
    asm volatile("s_waitcnt vmcnt(0)" ::: "memory");
    __syncthreads();
    if (threadIdx.x == 0) {
        unsigned* bar = b.bar;
        __builtin_amdgcn_s_waitcnt(0);
        unsigned nloc = b.st[0], nx = b.st[1];
        if (nloc == 0u) { xcd_barrier_complete(bar, b.x, nloc, nx); b.st[0] = nloc; b.st[1] = nx; }
        const unsigned old = xb_add(&bar[XB_XSUB(b.x)], 1u);
        const unsigned gen = old / nloc;
        if (old + 1u == (gen + 1u) * nloc) {
            __builtin_amdgcn_fence(__ATOMIC_RELEASE, "agent");
            asm volatile("s_waitcnt vmcnt(0)" ::: "memory");
            const unsigned og = xb_add(&bar[XB_TOP], 1u);
            const unsigned tg = og / nx;
            if (og + 1u == (tg + 1u) * nx) xb_add(&bar[XB_TOPGEN], 1u);
            else XB_SPIN(xb_ld(&bar[XB_TOPGEN]) == tg, bar);
            __builtin_amdgcn_fence(__ATOMIC_ACQUIRE, "agent");
            xb_add(&bar[XB_XGEN(b.x)], 1u);
            asm volatile("s_waitcnt vmcnt(0)" ::: "memory");
        } else {
            XB_SPIN(xb_ld(&bar[XB_XGEN(b.x)]) == gen, bar);
            __builtin_amdgcn_fence(__ATOMIC_ACQUIRE, "agent");
            asm volatile("s_waitcnt vmcnt(0)" ::: "memory");
        }
    }
    __syncthreads();
}

#ifndef REPMASK
#define REPMASK 0
#endif
#define REPLOOP(i) _Pragma("unroll 1") for (int rep_ = 0; rep_ < 1 + ((REPMASK >> (i)) & 1); ++rep_)
__global__ __launch_bounds__(512, 2) void mega(Params P) {
    extern __shared__ __attribute__((aligned(16))) unsigned char shm[];
    LAS unsigned char* lds = (LAS unsigned char*)shm;
    cg::grid_group grid = cg::this_grid();
    if (threadIdx.x == 0) *(LAS u32x4*)(lds + 147456) = (u32x4){0u, 0u, 0u, 0u};
    __syncthreads();
    const XcdBarrier xb = xcd_barrier_post((unsigned*)(P.ws + OFF_BAR), (volatile LAS unsigned*)(lds + 147456));
    const int G = gridDim.x, c = blockIdx.x;
    unsigned char* ws = P.ws;
    float* X = P.out;
    bf16_t* H = (bf16_t*)(ws + OFF_H);
    const float* MOD = (const float*)(ws + OFF_MOD);

    REPLOOP(12) phase0(P, lds);
    if (gridDim.x == 0x7fffffffu) grid.sync();
    REPLOOP(11) xcd_barrier_(xb.bar, xb.x, xb.st);
    for (int l = 0; l < 2; ++l) {
        const float* mod = MOD + (size_t)l * 3 * 6144;
        const bool hide = (G == 256);
        { const int te = hide ? (l == 0 ? 1856 : 0) : 4992; if (te > 0) convert_weights(P, l, lds, 0, te, c, G); }
        const float* xa0 = l == 0 ? P.x_prompt : X; const float* xb0 = l == 0 ? P.x_sample : X + (size_t)MCTX * 1024;
        REPLOOP(1) norm_phase(xa0, xb0, P.norm1 + l * 1024, mod, 0, 1024, H);
        REPLOOP(11) xcd_barrier_(xb.bar, xb.x, xb.st);
        REPLOOP(2) { Sched S{(const char*)H, (const char*)(ws + OFF_WIN), 1024, 1024, 0, 48, 14, G, c, 256};
          EpiIn E{(bf16_t*)(ws + OFF_XAQ), (bf16_t*)(ws + OFF_XC), (bf16_t*)(ws + OFF_KB), (bf16_t*)(ws + OFF_VB), P.out + OUT_K, P.out + OUT_V, (const float*)(ws + OFF_ROPE), l};
          gemm_phase(lds, S, 1024, E); }
        if (hide && l == 0 && c >= 160) convert_weights(P, l, lds, 1856, 2624, c - 160, G - 160);
        REPLOOP(11) xcd_barrier_(xb.bar, xb.x, xb.st);
        REPLOOP(3) pool_phase((const bf16_t*)(ws + OFF_XC), (bf16_t*)(ws + OFF_PL));
        for (int it = c; it < 1280; it += G) {
            if (it < 256) { REPLOOP(4) attn_unit(P, l, it, lds); }
            else if (it < 512) { const int v = it - 256; REPLOOP(5) lru_unit<0, 4>(P, l, v >> 3, 0, v & 7, lds); }
            else if (it < 768) { const int q = it - 512; REPLOOP(5) lru_unit<1, 2>(P, l, 32 + (q >> 7), (q >> 3) & 15, q & 7, lds); }
            else { REPLOOP(7) attn_unit(P, l, it - 768 + 256, lds); }
        }
        REPLOOP(11) xcd_barrier_(xb.bar, xb.x, xb.st);
        { Sched S{(const char*)(ws + OFF_PL), (const char*)(ws + OFF_PW), 1024, 256, 256, 48, 4, G, c, 256};
          EpiPool E{(bf16_t*)(ws + OFF_XC), P.pool_scale + l * 1024};
          gemm_phase(lds, S, 256, E); }
#ifndef NO_LRU
        for (int it = G - 1 - c; it < 256; it += G) lru_unit<0, 2>(P, l, 32 + (it >> 7), (it >> 3) & 15, it & 7, lds);
#endif
        REPLOOP(11) xcd_barrier_(xb.bar, xb.x, xb.st);
        { unsigned* mflags = (unsigned*)(ws + OFF_BAR) + 3500 + l * 192;
          MergeSched S{(const char*)ws, 1024, 1024, c, c >= 192};
          EpiMerge E{(bf16_t*)(ws + OFF_GT), P.b_gate + l * 3072, (float*)(ws + OFF_XAQ), (bf16_t*)(ws + OFF_PL), mflags};
          gemm_phase(lds, S, 1024, E); }
        if (hide && c >= 192) convert_weights(P, l, lds, 2624, 4288, c - 192, G - 192);
        REPLOOP(11) xcd_barrier_(xb.bar, xb.x, xb.st);
        { Sched S{(const char*)(ws + OFF_PL), (const char*)(ws + OFF_WOUT), 1024, 1024, 0, 64, 4, G, c, 192};
          EpiRes E{X, mod, 2048, xa0, xb0};
          gemm_phase<EpiRes, Sched, true>(lds, S, 1024, E); }
        REPLOOP(11) xcd_barrier_(xb.bar, xb.x, xb.st);
        norm_phase(X, X + (size_t)MCTX * 1024, P.norm2 + l * 1024, mod, 3072, 4096, H);
        REPLOOP(11) xcd_barrier_(xb.bar, xb.x, xb.st);
        REPLOOP(9) { Sched S{(const char*)H, (const char*)(ws + OFF_WUP), 1024, 1024, 0, 48, 22, G, c, 256};
          EpiUp E{(bf16_t*)(ws + OFF_ACT), (bf16_t*)(ws + OFF_SU), (bf16_t*)(ws + OFF_SV), P.ffn_conv + (size_t)l * 3 * 2816, P.ffn_conv_b + l * 2816};
          gemm_phase(lds, S, 1024, E); }
        if (hide && c >= 32) { convert_weights(P, l, lds, 4288, 4992, c - 32, G - 32);
          if (l == 0) convert_weights(P, l + 1, lds, 0, 2624, c - 32, G - 32); }
        REPLOOP(11) xcd_barrier_(xb.bar, xb.x, xb.st);
        { Sched S{(const char*)(ws + OFF_ACT), (const char*)(ws + OFF_WDN), 2816, 2816, 0, 64, 4, G, c, 192};
          { Unit uu; for (int i = 0; S.next(i, uu); ++i) ffn_fix_groups((const bf16_t*)(ws + OFF_SU), (const bf16_t*)(ws + OFF_SV), (bf16_t*)(ws + OFF_ACT), P.ffn_conv + (size_t)l * 3 * 2816, P.ffn_conv_b + l * 2816, uu.row0 >> 6, 3);
            asm volatile("s_waitcnt vmcnt(0)" ::: "memory"); __syncthreads(); }
          EpiRes E{X, mod, 5120, X, X + (size_t)MCTX * 1024};
          gemm_phase<EpiRes, Sched, true>(lds, S, 2816, E); }
        REPLOOP(11) xcd_barrier_(xb.bar, xb.x, xb.st);
    }
    final_norm_phase(X, P.final_norm);
}

extern "C" void kernel_launch(void* const* d_in, const int* in_sizes, int n_in, void* d_out, int out_size, void* d_ws, size_t ws_size, hipStream_t stream) {
    constexpr size_t kDynLds = 147456 + 16;
    static int grid_blocks = 0;
    if (!grid_blocks) {
        int dev = 0, cus = 0, per_cu = 0;
        hipGetDevice(&dev);
        hipDeviceGetAttribute(&cus, hipDeviceAttributeMultiprocessorCount, dev);
        hipFuncSetAttribute((const void*)mega, hipFuncAttributeMaxDynamicSharedMemorySize, (int)kDynLds);
        hipOccupancyMaxActiveBlocksPerMultiprocessor(&per_cu, mega, 512, kDynLds);
        if (per_cu < 1) per_cu = 1;
        if (per_cu > 1) per_cu = 1;
        grid_blocks = cus * per_cu;
    }
    Params p{};
    const float** pp = (const float**)&p;
    for (int i = 0; i < 30; ++i) pp[i] = (const float*)d_in[i];
    p.out = (float*)d_out; p.ws = (unsigned char*)d_ws;
    if (ws_size < OFF_END2 + 262144) { fprintf(stderr, "workspace too small: %zu < %zu\n", ws_size, (size_t)OFF_END2 + 262144); }
    hipMemsetAsync((unsigned char*)d_ws + OFF_BAR, 0, 16384, stream);
    void* args[] = {&p};
    hipError_t e = hipLaunchCooperativeKernel((void*)mega, dim3(grid_blocks), dim3(512), args, kDynLds, stream);
    if (e != hipSuccess) fprintf(stderr, "cooperative launch failed: %s (grid %d)\n", hipGetErrorString(e), grid_blocks);
}
```

```cpp
#include <hip/hip_runtime.h>
#include <hip/hip_cooperative_groups.h>
#include <cstdio>
namespace cg = cooperative_groups;

#define LAS __attribute__((address_space(3)))
typedef unsigned short bf16_t;
typedef short bf16x8 __attribute__((ext_vector_type(8)));
typedef float f32x4 __attribute__((ext_vector_type(4)));
typedef unsigned u32x4 __attribute__((ext_vector_type(4)));
typedef unsigned u32x2 __attribute__((ext_vector_type(2)));
typedef short bf16x4 __attribute__((ext_vector_type(4)));

constexpr int MROWS = 12288, MCTX = 8192;
constexpr size_t S24 = (size_t)MROWS * 1024 * 2;
constexpr size_t OFF_WIN = 0;
constexpr size_t OFF_WBR = OFF_WIN + (size_t)6656 * 1024 * 2;
constexpr size_t OFF_WOUT = OFF_WBR + (size_t)3 * 1024 * 1024 * 2;
constexpr size_t OFF_WUP = OFF_WOUT + (size_t)1024 * 1024 * 2;
constexpr size_t OFF_WDN = OFF_WUP + (size_t)5632 * 1024 * 2;
constexpr size_t OFF_GW = OFF_WDN + (size_t)1024 * 2816 * 2;
constexpr size_t OFF_PW = OFF_GW + (size_t)2 * 8 * 256 * 128 * 2;
constexpr size_t OFF_MOD = OFF_PW + (size_t)4 * 256 * 256 * 2;
constexpr size_t OFF_CK = OFF_MOD + (size_t)2 * 3 * 6144 * 4;
constexpr size_t OFF_CV = OFF_CK + (size_t)2 * 2 * 512 * 256 * 2;
constexpr size_t OFF_ROPE = OFF_CV + (size_t)2 * 2 * 512 * 256 * 2;
constexpr size_t OFF_SUMM = OFF_ROPE + (size_t)2 * 64 * 32 * 4;
constexpr size_t OFF_BAR = OFF_SUMM + (size_t)2 * 2 * 16 * 1024 * 2 * 4;
constexpr size_t OFF_ACT0 = OFF_BAR + 16384;
constexpr size_t OFF_XAQ = OFF_ACT0;
constexpr size_t OFF_XC = OFF_XAQ + 2 * S24;
constexpr size_t OFF_KB = OFF_XC + S24;
constexpr size_t OFF_VB = OFF_KB + (size_t)MROWS * 256 * 2;
constexpr size_t OFF_GT = OFF_VB + (size_t)MROWS * 256 * 2;
constexpr size_t OFF_YB = OFF_GT + S24;
constexpr size_t OFF_PL = OFF_YB + S24;
constexpr size_t OFF_YA = OFF_PL + S24;
constexpr size_t OFF_H = OFF_YA + S24;
constexpr size_t OFF_END = OFF_H + S24;
constexpr size_t OFF_ACT = OFF_XAQ;
constexpr size_t OFF_SU = OFF_END;
constexpr size_t OFF_SV = OFF_SU + (size_t)192 * 4 * 2816 * 2;
constexpr size_t OFF_END2 = OFF_SV + (size_t)192 * 2 * 2816 * 2;
constexpr size_t OUT_K = (size_t)MROWS * 1024;
constexpr size_t OUT_V = OUT_K + (size_t)32 * 2 * 256 * 256;
constexpr size_t OUT_H = OUT_V + (size_t)32 * 2 * 256 * 256;

struct Params {
    const float *x_prompt, *x_sample, *cache_k, *cache_v, *state_lru, *c, *c_ctx, *w_ada, *b_ada, *norm1, *norm2,
        *w_in, *b_gate, *lru_conv, *lru_conv_b, *lru_wa, *lru_ba, *lru_wx, *lru_bx, *lru_lambda, *attn_sink,
        *pool_w, *pool_scale, *w_branch, *w_out, *ffn_up, *ffn_conv, *ffn_conv_b, *ffn_down, *final_norm;
    float* out; unsigned char* ws;
};

typedef float f32x2_ __attribute__((ext_vector_type(2)));
typedef __bf16 bf16x2_ __attribute__((ext_vector_type(2)));
__device__ __forceinline__ unsigned pack2(float a, float b) { const f32x2_ v = {a, b}; const bf16x2_ r = __builtin_convertvector(v, bf16x2_); return __builtin_bit_cast(unsigned, r); }
__device__ __forceinline__ unsigned short f2bf(float f) { return (unsigned short)(pack2(f, f) & 0xffffu); }
__device__ __forceinline__ float bf2f(unsigned short b) { return __uint_as_float(((unsigned)b) << 16); }
__device__ __forceinline__ int otid() { int t = threadIdx.x; asm volatile("" : "+v"(t)); return t; }
__device__ __forceinline__ float sigmoidf_(float x) { return __builtin_amdgcn_rcpf(1.0f + __expf(-x)); }

constexpr int HTB = 128 * 64 * 2;
__device__ __forceinline__ int lds_byte(int r, int c) { const int st = (r >> 4) * 2 + (c >> 5), rr = r & 15, cc = c & 31, ob = rr * 64 + cc * 2; return st * 1024 + (ob ^ (((ob >> 9) & 1) << 5)); }
__device__ __forceinline__ void stage_rc(int b, int& R, int& C) { const int st = b / 1024, sb = b % 1024, swz = sb ^ (((sb >> 9) & 1) << 5); R = (st >> 1) * 16 + swz / 64; C = (st & 1) * 32 + (swz % 64) / 2; }

struct Unit { const char* a; const char* b; int pm, pn, z, row0, m192; };
struct Sched {
    const char* A; const char* B; int lda, ldb, acol, nM, nN, G, c, tm;
    __device__ __forceinline__ bool next(int i, Unit& u) const {
        const long L = (long)i * G + c; const int nwg = nM * nN; if (L >= nwg) return false;
        int wgid = (int)L; { const int q = nwg / 8, r = nwg % 8, xcd = wgid % 8, off = wgid / 8; wgid = (xcd < r ? xcd * (q + 1) : r * (q + 1) + (xcd - r) * q) + off; }
        const int nig = 8 * nN, gid = wgid / nig, fm = gid * 8, gsz = (nM - fm) < 8 ? (nM - fm) : 8;
        u.pm = fm + ((wgid % nig) % gsz); u.pn = (wgid % nig) / gsz;
        u.a = A + ((size_t)u.pm * tm * lda + (size_t)u.pn * acol) * 2; u.b = B + (size_t)u.pn * 256 * ldb * 2; u.z = 0; u.row0 = u.pm * tm; u.m192 = (tm == 192); return true;
    }
};
struct MergeSched {
    const char* ws; int lda, ldb, c; bool helper;
    __device__ __forceinline__ bool next(int i, Unit& u) const {
        int owner, z; int c = this->c; asm volatile("" : "+s"(c));
        if (!helper) { if (c >= 192 || i >= 5) return false; owner = c; z = i < 4 ? i : 5; }
        else { const int hi = c - 192; if (hi < 0 || hi >= 64 || i >= 3) return false; owner = hi + 64 * i; z = 4; }
        const int nN = 4;
        int wgid = owner; { const int q = 24, xcd = wgid % 8, off = wgid / 8; wgid = xcd * q + off; }
        const int nig = 8 * nN, gid = wgid / nig, fm = gid * 8;
        u.pm = fm + ((wgid % nig) % 8); u.pn = (wgid % nig) / 8; u.z = z; u.row0 = u.pm * 256; u.m192 = 0;
        const int j = z >> 1;
        const size_t aoff = (size_t)u.row0 * 1024 * 2;
        size_t ao = OFF_H, bo = OFF_WIN + (size_t)3584 * 1024 * 2;
        if (z & 1) { bo = OFF_WBR; ao = OFF_YA; if (j == 1) ao = OFF_YB; if (j == 2) ao = OFF_XC; }
        u.a = ws + ao + aoff; u.b = ws + bo + ((size_t)j * 1024 + (size_t)u.pn * 256) * 1024 * 2;
        return true;
    }
};

template <class Epi, class SchedT, bool M192 = false>
__device__ __forceinline__ void gemm_phase(LAS unsigned char* lds, const SchedT& S, const int K_, const Epi& E) {
    int K = K_; asm volatile("" : "+s"(K));
    int tid_ = threadIdx.x; asm volatile("" : "+v"(tid_));
    const int tid = tid_, wid = __builtin_amdgcn_readfirstlane(tid >> 6), lane = tid & 63, wr = wid >> 2, wc = wid & 3, fr = lane & 15, fq = lane >> 4;
    const int nt = K / 64;
    unsigned voffA[2], voffB[2];
#pragma unroll
    for (int i = 0; i < 2; ++i) { int R, C; stage_rc(tid * 16 + i * 8192, R, C); voffA[i] = (unsigned)(R * S.lda + C) * 2u; voffB[i] = (unsigned)(R * S.ldb + C) * 2u; }
    const size_t kstep = 128;
    const size_t hstepA = (size_t)128 * S.lda * 2, hstepB = (size_t)128 * S.ldb * 2;
    const unsigned ldsw = (unsigned)wid * 1024u;
    const int aoff = lds_byte(wr * 64 + fr, fq * 8), boff = lds_byte(wc * 32 + fr, fq * 8);
#define G_SA(b, h) (((b) * 2 + (h)) * HTB)
#define G_SB(b, h) ((4 + (b) * 2 + (h)) * HTB)
#define G_STAGE(bufoff, gbase, voff) do { _Pragma("unroll") for (int _i = 0; _i < 2; ++_i) \
        __builtin_amdgcn_global_load_lds((const unsigned*)((const char*)(gbase) + (voff)[_i]), (LAS unsigned*)(lds + (bufoff) + ldsw + _i * 8192), 16, 0, 0); } while (0)
#define G_LDA(dst, b, h) do { _Pragma("unroll") for (int m = 0; m < 4; ++m) _Pragma("unroll") for (int k = 0; k < 2; ++k) dst[m][k] = *(const LAS bf16x8*)(lds + G_SA(b, h) + aoff + m * 2048 + k * 1024); } while (0)
#define G_LDB(dst, b, h) do { _Pragma("unroll") for (int n = 0; n < 2; ++n) _Pragma("unroll") for (int k = 0; k < 2; ++k) dst[n][k] = *(const LAS bf16x8*)(lds + G_SB(b, h) + boff + n * 2048 + k * 1024); } while (0)
#define G_MMA(ai, bj, At, Bt) do { if (M192 && (ai) == 1 && wr == 1) break; __builtin_amdgcn_s_setprio(1); _Pragma("unroll") for (int m = 0; m < 4; ++m) _Pragma("unroll") for (int n = 0; n < 2; ++n) _Pragma("unroll") for (int k = 0; k < 2; ++k) \
        acc[ai][bj][m][n] = __builtin_amdgcn_mfma_f32_16x16x32_bf16(Bt[n][k], At[m][k], acc[ai][bj][m][n], 0, 0, 0); __builtin_amdgcn_s_setprio(0); } while (0)
#define G_WAIT_V(n) asm volatile("s_waitcnt vmcnt(" #n ")" ::: "memory")
#define G_WAIT_L(n) asm volatile("s_waitcnt lgkmcnt(" #n ")" ::: "memory")
#define G_BAR __builtin_amdgcn_s_barrier()
#define G_SCHED __builtin_amdgcn_sched_barrier(0)
    Unit cur, nxt; int ui = 0;
    if (!S.next(0, cur)) return;
    f32x4 acc[2][2][4][2];
#pragma unroll
    for (int a = 0; a < 2; ++a)
#pragma unroll
        for (int b = 0; b < 2; ++b)
#pragma unroll
            for (int m = 0; m < 4; ++m)
#pragma unroll
                for (int n = 0; n < 2; ++n) acc[a][b][m][n] = (f32x4){0.f, 0.f, 0.f, 0.f};
    bf16x8 At[4][2], B0[2][2], B1[2][2];
    const char* cA = cur.a; const char* cB = cur.b;
    G_STAGE(G_SB(0, 0), cB, voffB); G_STAGE(G_SA(0, 0), cA, voffA); G_STAGE(G_SB(0, 1), cB + hstepB, voffB); G_STAGE(G_SA(0, 1), cA + hstepA, voffA);
    if (wr == 1) G_BAR;
    G_WAIT_V(4); G_BAR;
    G_STAGE(G_SB(1, 0), cB + kstep, voffB); G_STAGE(G_SA(1, 0), cA + kstep, voffA); G_STAGE(G_SB(1, 1), cB + hstepB + kstep, voffB);
    G_WAIT_V(6); G_BAR;
    for (;;) {
        const bool has_next = S.next(ui + 1, nxt);
        const char* nA = has_next ? nxt.a : cA; const char* nB = has_next ? nxt.b : cB;
        for (int t = 0; t < nt; t += 2) {
            const bool last = (t == nt - 2);
            const char* a1 = cA + (size_t)(t + 1) * kstep;
            const char* a2 = last ? nA : cA + (size_t)(t + 2) * kstep; const char* b2 = last ? nB : cB + (size_t)(t + 2) * kstep;
            const char* a3 = a2 + kstep; const char* b3 = b2 + kstep;
            G_LDB(B0, 0, 0); G_SCHED; G_LDA(At, 0, 0); G_STAGE(G_SA(1, 1), a1 + hstepA, voffA);
            G_WAIT_L(8); G_BAR; G_WAIT_L(0); G_MMA(0, 0, At, B0); G_BAR; G_SCHED;
            G_LDB(B1, 0, 1); G_STAGE(G_SB(0, 0), b2, voffB);
            G_BAR; G_WAIT_L(0); G_MMA(0, 1, At, B1); G_BAR;
            G_LDA(At, 0, 1); G_STAGE(G_SA(0, 0), a2, voffA);
            G_BAR; G_WAIT_L(0); G_MMA(1, 0, At, B0); G_BAR; G_SCHED;
            G_STAGE(G_SB(0, 1), b2 + hstepB, voffB);
            G_WAIT_V(6); G_BAR; G_MMA(1, 1, At, B1); G_BAR;
            G_LDB(B0, 1, 0); G_SCHED; G_LDA(At, 1, 0); G_STAGE(G_SA(0, 1), a2 + hstepA, voffA);
            G_WAIT_L(8); G_BAR; G_WAIT_L(0); G_MMA(0, 0, At, B0); G_BAR; G_SCHED;
            G_LDB(B1, 1, 1); G_STAGE(G_SB(1, 0), b3, voffB);
            G_BAR; G_WAIT_L(0); G_MMA(0, 1, At, B1); G_BAR;
            G_LDA(At, 1, 1); G_STAGE(G_SA(1, 0), a3, voffA);
            G_BAR; G_WAIT_L(0); G_MMA(1, 0, At, B0); G_BAR; G_SCHED;
            G_STAGE(G_SB(1, 1), b3 + hstepB, voffB);
            G_WAIT_V(6); G_BAR; G_MMA(1, 1, At, B1); G_BAR;
        }
        E(acc, cur, wr, wc, fr, fq);
        if (!has_next) break;
#pragma unroll
        for (int a = 0; a < 2; ++a)
#pragma unroll
            for (int b = 0; b < 2; ++b)
#pragma unroll
                for (int m = 0; m < 4; ++m)
#pragma unroll
                    for (int n = 0; n < 2; ++n) acc[a][b][m][n] = (f32x4){0.f, 0.f, 0.f, 0.f};
        cur = nxt; cA = nA; cB = nB; ++ui;
    }
    G_WAIT_V(0);
    if (wr == 0) G_BAR;
    G_BAR;
#undef G_SA
#undef G_SB
#undef G_STAGE
#undef G_LDA
#undef G_LDB
#undef G_MMA
#undef G_WAIT_V
#undef G_WAIT_L
#undef G_BAR
#undef G_SCHED
}

#define EPI_LOOP_BEGIN \
    _Pragma("unroll") for (int ai = 0; ai < 2; ++ai) _Pragma("unroll") for (int m = 0; m < 4; ++m) { const int row = u.pm * 256 + wr * 64 + fr + ai * 128 + m * 16; \
    _Pragma("unroll") for (int bj = 0; bj < 2; ++bj) _Pragma("unroll") for (int n = 0; n < 2; ++n) { const int cl = wc * 32 + 4 * fq + bj * 128 + n * 16; const f32x4 v = acc[ai][bj][m][n];
#define EPI_LOOP_END } }

__device__ __forceinline__ int seq_group(int row) { return row < MCTX ? 0 : 1 + ((row - MCTX) >> 11); }

struct EpiIn {
    bf16_t* xaq; bf16_t* xc; bf16_t* kb; bf16_t* vb; float* outk; float* outv; const float* rc; int l;
    __device__ __forceinline__ void operator()(const f32x4 (&acc)[2][2][4][2], const Unit& u, int wr, int wc, int fr, int fq) const {
        const int pn = u.pn; const bool qk = pn >= 4 && pn <= 8;
        bf16_t* dst; int ld, cbase; float* fo = nullptr;
        if (pn < 4) { dst = xaq; ld = 1024; cbase = pn * 256; }
        else if (pn < 8) { dst = xaq + (size_t)MROWS * 1024; ld = 1024; cbase = pn * 256 - 1024; }
        else if (pn == 8) { dst = kb; ld = 256; cbase = 0; fo = outk; }
        else if (pn == 9) { dst = vb; ld = 256; cbase = 0; fo = outv; }
        else { dst = xc; ld = 1024; cbase = pn * 256 - 2560; }
        const int hh = wc >> 1, i0 = 16 * (wc & 1) + 4 * fq;
        const int c1 = cbase + (qk ? 64 * hh + i0 : wc * 32 + 4 * fq), dc = qk ? 32 : 16;
        const bool rope = qk && u.pm >= 32;
#pragma unroll
        for (int ai = 0; ai < 2; ++ai) {
            f32x4 csm[4], snm[4];
#pragma unroll
            for (int m = 0; m < 4; ++m) { csm[m] = (f32x4){1.f, 1.f, 1.f, 1.f}; snm[m] = (f32x4){0.f, 0.f, 0.f, 0.f};
                if (rope) { const int row = u.pm * 256 + wr * 64 + fr + ai * 128 + m * 16; const int t = (row - MCTX) & 2047; const int pos = hh == 0 ? (t >> 6) : (t & 63);
                    csm[m] = *(const f32x4*)(rc + pos * 32 + i0); snm[m] = *(const f32x4*)(rc + 2048 + pos * 32 + i0); } }
#pragma unroll
            for (int m = 0; m < 4; ++m) {
                const int row = u.pm * 256 + wr * 64 + fr + ai * 128 + m * 16;
                const f32x4 cs = csm[m], sn = snm[m];
                bf16_t* dp = dst + (size_t)row * ld + c1;
                float* fp = fo + ((size_t)(((row >> 8) * 2 + l) * 256 + (row & 255))) * 256 + c1;
#pragma unroll
                for (int bj = 0; bj < 2; ++bj) {
                    const f32x4 x1 = acc[ai][bj][m][0], x2 = acc[ai][bj][m][1];
                    const f32x4 o1 = x1 * cs - x2 * sn, o2 = x1 * sn + x2 * cs;
                    uint2 p1, p2; p1.x = pack2(o1[0], o1[1]); p1.y = pack2(o1[2], o1[3]); p2.x = pack2(o2[0], o2[1]); p2.y = pack2(o2[2], o2[3]);
                    *(uint2*)(dp + bj * 128) = p1; *(uint2*)(dp + bj * 128 + dc) = p2;
                    if (fo != nullptr && row < MCTX) { *(f32x4*)(fp + bj * 128) = o1; *(f32x4*)(fp + bj * 128 + dc) = o2; }
                }
            }
        }
    }
};
struct EpiGate {
    bf16_t* gt; const float* bias;
    __device__ __forceinline__ void operator()(const f32x4 (&acc)[2][2][4][2], const Unit& u, int wr, int wc, int fr, int fq) const {
        const int c0 = u.pn * 256 + wc * 32 + 4 * fq;
        f32x4 bb[4];
#pragma unroll
        for (int g = 0; g < 4; ++g) bb[g] = *(const f32x4*)(bias + c0 + (g >> 1) * 128 + (g & 1) * 16);
#pragma unroll
        for (int ai = 0; ai < 2; ++ai) { if (ai == 1 && u.m192 && wr == 1) continue;
#pragma unroll
            for (int m = 0; m < 4; ++m) { const int row = u.row0 + wr * 64 + fr + ai * 128 + m * 16;
#pragma unroll
                for (int g = 0; g < 4; ++g) { const f32x4 v = acc[ai][g >> 1][m][g & 1];
                    uint2 pk; pk.x = pack2(sigmoidf_(v[0] + bb[g][0]), sigmoidf_(v[1] + bb[g][1])); pk.y = pack2(sigmoidf_(v[2] + bb[g][2]), sigmoidf_(v[3] + bb[g][3]));
                    *(uint2*)(gt + (size_t)row * 1024 + c0 + (g >> 1) * 128 + (g & 1) * 16) = pk; } } }
    }
};
template <int j> struct EpiBranch {
    const bf16_t* gt; float* tmp; bf16_t* mg;
    __device__ __forceinline__ void operator()(const f32x4 (&acc)[2][2][4][2], const Unit& u, int wr, int wc, int fr, int fq) const {
        const int c0 = u.pn * 256 + wc * 32 + 4 * fq;
#pragma unroll
        for (int ai = 0; ai < 2; ++ai) { if (ai == 1 && u.m192 && wr == 1) continue;
#pragma unroll
            for (int m = 0; m < 4; ++m) {
                const unsigned ro = (unsigned)(u.row0 + wr * 64 + fr + ai * 128 + m * 16) * 1024u + (unsigned)c0;
                uint2 gp[4]; f32x4 tv[4];
#pragma unroll
                for (int g = 0; g < 4; ++g) { const unsigned o = ro + (g >> 1) * 128 + (g & 1) * 16;
                    gp[g] = *(const uint2*)(gt + o); tv[g] = (f32x4){0.f, 0.f, 0.f, 0.f}; if (j != 0) tv[g] = *(const f32x4*)(tmp + o); }
#pragma unroll
                for (int g = 0; g < 4; ++g) { const unsigned o = ro + (g >> 1) * 128 + (g & 1) * 16;
                    const f32x4 v = acc[ai][g >> 1][m][g & 1];
                    f32x4 r = tv[g];
                    r[0] += v[0] * bf2f((unsigned short)(gp[g].x & 0xffff)); r[1] += v[1] * bf2f((unsigned short)(gp[g].x >> 16));
                    r[2] += v[2] * bf2f((unsigned short)(gp[g].y & 0xffff)); r[3] += v[3] * bf2f((unsigned short)(gp[g].y >> 16));
                    if (j != 2) *(f32x4*)(tmp + o) = r;
                    else { uint2 pk; pk.x = pack2(r[0], r[1]); pk.y = pack2(r[2], r[3]); *(uint2*)(mg + o) = pk; } }
            } }
    }
};
struct EpiMerge {
    bf16_t* gt; const float* bgate; float* tmp; bf16_t* mg; unsigned* flags;
    __device__ __forceinline__ void operator()(const f32x4 (&acc)[2][2][4][2], const Unit& u, int wr, int wc, int fr, int fq) const {
        const int j = u.z >> 1;
        if ((u.z & 1) == 0) {
            EpiGate E{u.z == 4 ? mg : gt, bgate + j * 1024}; E(acc, u, wr, wc, fr, fq);
            if (u.z == 4) {
                asm volatile("s_waitcnt vmcnt(0)" ::: "memory");
                unsigned old_ = 0u;
                if (fr == 0 && fq == 0) old_ = __hip_atomic_fetch_add(flags + u.pm * 4 + u.pn, 1u, __ATOMIC_RELAXED, __HIP_MEMORY_SCOPE_AGENT);
                old_ = (unsigned)__builtin_amdgcn_readfirstlane(old_);
                if (old_ == 7u) {
                    __builtin_amdgcn_fence(__ATOMIC_RELEASE, "agent");
                    asm volatile("s_waitcnt vmcnt(0)" ::: "memory");
                    if (fr == 0 && fq == 0) __hip_atomic_fetch_add(flags + u.pm * 4 + u.pn, 256u, __ATOMIC_RELAXED, __HIP_MEMORY_SCOPE_AGENT);
                }
            }
        }
        else if (j == 0) { EpiBranch<0> E{gt, tmp, mg}; E(acc, u, wr, wc, fr, fq); }
        else if (j == 1) { EpiBranch<1> E{gt, tmp, mg}; E(acc, u, wr, wc, fr, fq); }
        else {
            { unsigned* f = flags + u.pm * 4 + u.pn; unsigned sp = 0;
              while ((unsigned)__builtin_amdgcn_readfirstlane(__hip_atomic_load(f, __ATOMIC_RELAXED, __HIP_MEMORY_SCOPE_AGENT)) < 256u) { __builtin_amdgcn_s_sleep(2); if (++sp > (1u << 20)) break; }
              __builtin_amdgcn_fence(__ATOMIC_ACQUIRE, "agent");
              asm volatile("s_waitcnt vmcnt(0)" ::: "memory"); }
            EpiBranch<2> E{mg, tmp, mg}; E(acc, u, wr, wc, fr, fq);
        }
    }
};
struct EpiRes {
    float* x; const float* mod; int goff; const float* xa; const float* xb;
    __device__ __forceinline__ const float* src(unsigned o) const { return o < (unsigned)MCTX * 1024u ? xa + o : xb + (o - (unsigned)MCTX * 1024u); }
    __device__ __forceinline__ void operator()(const f32x4 (&acc)[2][2][4][2], const Unit& u, int wr, int wc, int fr, int fq) const {
        const int c0 = u.pn * 256 + wc * 32 + 4 * fq;
        const int sg0 = seq_group(u.row0), sg1 = seq_group(u.row0 + (u.m192 ? 191 : 255));
        if (sg0 == sg1) {
            const float* gsrc = mod + sg0 * 6144 + goff;
            f32x4 gg[4];
#pragma unroll
            for (int g = 0; g < 4; ++g) gg[g] = *(const f32x4*)(gsrc + c0 + (g >> 1) * 128 + (g & 1) * 16);
#pragma unroll
            for (int ai = 0; ai < 2; ++ai) { if (ai == 1 && u.m192 && wr == 1) continue;
#pragma unroll
                for (int mp = 0; mp < 2; ++mp) {
                    const unsigned ro = (unsigned)(u.row0 + wr * 64 + fr + ai * 128 + mp * 32) * 1024u + (unsigned)c0;
                    f32x4 xv[8];
#pragma unroll
                    for (int k = 0; k < 8; ++k) { const int g = k & 3; xv[k] = *(const f32x4*)src(ro + (k >> 2) * 16384 + (g >> 1) * 128 + (g & 1) * 16); }
#pragma unroll
                    for (int k = 0; k < 8; ++k) { const int g = k & 3, m = mp * 2 + (k >> 2); *(f32x4*)(x + (ro + (k >> 2) * 16384 + (g >> 1) * 128 + (g & 1) * 16)) = xv[k] + gg[g] * acc[ai][g >> 1][m][g & 1]; }
                } }
        } else {
#pragma unroll
            for (int ai = 0; ai < 2; ++ai) { if (ai == 1 && u.m192 && wr == 1) continue;
#pragma unroll
                for (int m = 0; m < 4; ++m) {
                    const int row = u.row0 + wr * 64 + fr + ai * 128 + m * 16;
                    const float* gsrc = mod + seq_group(row) * 6144 + goff + c0;
                    const unsigned ro = (unsigned)row * 1024u + (unsigned)c0;
                    f32x4 xv[4], gv[4];
#pragma unroll
                    for (int g = 0; g < 4; ++g) { xv[g] = *(const f32x4*)src(ro + (g >> 1) * 128 + (g & 1) * 16); gv[g] = *(const f32x4*)(gsrc + (g >> 1) * 128 + (g & 1) * 16); }
#pragma unroll
                    for (int g = 0; g < 4; ++g) *(f32x4*)(x + (ro + (g >> 1) * 128 + (g & 1) * 16)) = xv[g] + gv[g] * acc[ai][g >> 1][m][g & 1];
                } }
        }
    }
};
struct EpiBf {
    bf16_t* dst; int ld;
    __device__ __forceinline__ void operator()(const f32x4 (&acc)[2][2][4][2], const Unit& u, int wr, int wc, int fr, int fq) const {
        EPI_LOOP_BEGIN
            const int col = u.pn * 256 + cl;
            uint2 pk; pk.x = pack2(v[0], v[1]); pk.y = pack2(v[2], v[3]);
            *(uint2*)(dst + (size_t)row * ld + col) = pk;
        EPI_LOOP_END
    }
};
__device__ __forceinline__ float dpp_f(float old, float src, const int ctrl_sel) {
    const int o = __float_as_int(old), v = __float_as_int(src);
    int r;
    if (ctrl_sel == 0) r = __builtin_amdgcn_update_dpp(o, v, 0x111, 0xf, 0xf, false);
    else if (ctrl_sel == 1) r = __builtin_amdgcn_update_dpp(o, v, 0x101, 0xf, 0xf, false);
    else if (ctrl_sel == 2) r = __builtin_amdgcn_update_dpp(o, v, 0x121, 0xf, 0xf, false);
    else r = __builtin_amdgcn_update_dpp(o, v, 0x12f, 0xf, 0xf, false);
    return __int_as_float(r);
}
__device__ __forceinline__ float gelu_tanh(float x) { const float y = 0.7978845608028654f * (x + 0.044715f * x * x * x); const float t = 1.0f - 2.0f * __builtin_amdgcn_rcpf(1.0f + __expf(2.0f * y)); return 0.5f * x * (1.0f + t); }
struct EpiUp {
    bf16_t* act; bf16_t* su; bf16_t* sv; const float* cw; const float* cb;
    __device__ __forceinline__ void operator()(const f32x4 (&acc)[2][2][4][2], const Unit& u, int wr, int wc, int fr, int fq) const {
#pragma unroll
        for (int n = 0; n < 2; ++n) {
            const int ch = u.pn * 128 + wc * 32 + 16 * n + 4 * fq;
            const f32x4 w0 = *(const f32x4*)(cw + ch), w1 = *(const f32x4*)(cw + 2816 + ch), w2 = *(const f32x4*)(cw + 5632 + ch), bb = *(const f32x4*)(cb + ch);
#pragma unroll
            for (int ai = 0; ai < 2; ++ai) {
                const int rowg = u.row0 + ai * 128 + wr * 64;
                f32x4 ub[4];
#pragma unroll
                for (int m = 0; m < 4; ++m)
#pragma unroll
                    for (int e = 0; e < 4; ++e) ub[m][e] = bf2f(f2bf(acc[ai][0][m][n][e]));
#pragma unroll
                for (int m = 0; m < 4; ++m) {
                    const int row = rowg + m * 16 + fr;
                    f32x4 r;
#pragma unroll
                    for (int e = 0; e < 4; ++e) {
                        const float pl = m > 0 ? dpp_f(0.f, ub[m > 0 ? m - 1 : 0][e], 2) : 0.f;
                        const float pv = dpp_f(pl, ub[m][e], 0);
                        const float nl = m < 3 ? dpp_f(0.f, ub[m < 3 ? m + 1 : 3][e], 3) : 0.f;
                        const float nv = dpp_f(nl, ub[m][e], 1);
                        const float gff = w0[e] * pv + w1[e] * ub[m][e] + w2[e] * nv + bb[e];
                        r[e] = gelu_tanh(gff) * bf2f(f2bf(acc[ai][1][m][n][e]));
                    }
                    const bool edge = (m == 0 && fr == 0) || (m == 3 && fr == 15);
                    if (!edge) { uint2 pk; pk.x = pack2(r[0], r[1]); pk.y = pack2(r[2], r[3]); *(uint2*)(act + (size_t)row * 2816 + ch) = pk; }
                    if ((m == 0 && fr < 2) || (m == 3 && fr >= 14)) {
                        const int slot = m == 0 ? fr : fr - 12; const int g64 = rowg >> 6;
                        uint2 pk; pk.x = pack2(ub[m][0], ub[m][1]); pk.y = pack2(ub[m][2], ub[m][3]);
                        *(uint2*)(su + ((size_t)g64 * 4 + slot) * 2816 + ch) = pk;
                        if (edge) { const f32x4 vv = acc[ai][1][m][n]; uint2 pv2; pv2.x = pack2(vv[0], vv[1]); pv2.y = pack2(vv[2], vv[3]); *(uint2*)(sv + ((size_t)g64 * 2 + (m == 0 ? 0 : 1)) * 2816 + ch) = pv2; }
                    }
                }
            }
        }
    }
};
struct EpiPool {
    bf16_t* dst; const float* scale;
    __device__ __forceinline__ void operator()(const f32x4 (&acc)[2][2][4][2], const Unit& u, int wr, int wc, int fr, int fq) const {
        const int c0 = u.pn * 256 + wc * 32 + 4 * fq;
        f32x4 sc[4];
#pragma unroll
        for (int g = 0; g < 4; ++g) sc[g] = *(const f32x4*)(scale + c0 + (g >> 1) * 128 + (g & 1) * 16);
#pragma unroll
        for (int ai = 0; ai < 2; ++ai)
#pragma unroll
            for (int m = 0; m < 4; ++m) { const int row = u.pm * 256 + wr * 64 + fr + ai * 128 + m * 16;
#pragma unroll
                for (int g = 0; g < 4; ++g) { const f32x4 v = acc[ai][g >> 1][m][g & 1] * sc[g];
                    uint2 pk; pk.x = pack2(v[0], v[1]); pk.y = pack2(v[2], v[3]);
                    *(uint2*)(dst + (size_t)row * 1024 + c0 + (g >> 1) * 128 + (g & 1) * 16) = pk; } }
    }
};

struct WPtrs { const float *w_in, *w_branch, *lru_wa, *lru_wx, *pool_w, *w_out, *ffn_up, *ffn_down; unsigned char* ws; };
struct TileDesc { const float* src; int lds_; bf16_t* dst; int ldd, k0, n0, perm, nd; };
__device__ __forceinline__ int swap45(int p) { return (p & ~48) | ((p & 16) << 1) | ((p & 32) >> 1); }
__device__ __forceinline__ TileDesc weight_tile(const WPtrs& P, int l, int t) {
    unsigned char* ws = P.ws; TileDesc d; int r = t; d.perm = 0; d.nd = -1;
    if (r < 1664) { d.src = P.w_in + (size_t)l * 1024 * 6656; d.lds_ = 6656; d.dst = (bf16_t*)(ws + OFF_WIN); d.ldd = 1024; d.k0 = (r / 104) * 64; d.n0 = (r % 104) * 64; d.perm = (d.n0 >= 1024 && d.n0 < 2304) ? 1 : 0; }
    else if ((r -= 1664) < 128) { const int mat = r / 64; r %= 64; const int dh = r / 4; r %= 4;
        d.src = (mat ? P.lru_wx : P.lru_wa) + (size_t)(l * 16 + dh) * 128 * 128; d.lds_ = 128; d.dst = (bf16_t*)(ws + OFF_GW) + (size_t)dh * 256 * 128 + (size_t)mat * 128 * 128; d.ldd = 128; d.k0 = (r / 2) * 64; d.n0 = (r % 2) * 64; }
    else if ((r -= 128) < 64) { const int g = r / 16; r %= 16; d.src = P.pool_w + (size_t)(l * 4 + g) * 256 * 256; d.lds_ = 256; d.dst = (bf16_t*)(ws + OFF_PW) + (size_t)g * 256 * 256; d.ldd = 256; d.k0 = (r / 4) * 64; d.n0 = (r % 4) * 64; }
    else if ((r -= 64) < 768) { const int j = r / 256; r %= 256; d.src = P.w_branch + (size_t)(l * 3 + j) * 1024 * 1024; d.lds_ = 1024; d.dst = (bf16_t*)(ws + OFF_WBR) + (size_t)j * 1024 * 1024; d.ldd = 1024; d.k0 = (r / 16) * 64; d.n0 = (r % 16) * 64; }
    else if ((r -= 768) < 256) { d.src = P.w_out + (size_t)l * 1024 * 1024; d.lds_ = 1024; d.dst = (bf16_t*)(ws + OFF_WOUT); d.ldd = 1024; d.k0 = (r / 16) * 64; d.n0 = (r % 16) * 64; }
    else if ((r -= 256) < 1408) { d.src = P.ffn_up + (size_t)l * 1024 * 5632; d.lds_ = 5632; d.dst = (bf16_t*)(ws + OFF_WUP); d.ldd = 1024; d.k0 = (r / 88) * 64; d.n0 = (r % 88) * 64;
        { const int isv = d.n0 >= 2816, c0 = isv ? d.n0 - 2816 : d.n0; d.nd = (c0 >> 7) * 256 + (c0 & 127) + (isv ? 128 : 0); } }
    else { r -= 1408; d.src = P.ffn_down + (size_t)l * 2816 * 1024; d.lds_ = 1024; d.dst = (bf16_t*)(ws + OFF_WDN); d.ldd = 2816; d.k0 = (r / 16) * 64; d.n0 = (r % 16) * 64; }
    return d;
}
__device__ __noinline__ void convert_weights_(const float* p0, const float* p1, const float* p2, const float* p3, const float* p4, const float* p5, const float* p6, const float* p7, unsigned char* pws,
                                              int l, LAS unsigned char* lds, int t_begin, int t_end, int first, int stride) {
    const WPtrs P{p0, p1, p2, p3, p4, p5, p6, p7, pws};
    LAS bf16_t* sm = (LAS bf16_t*)lds;
    const int tid = otid();
    const int kk0 = tid >> 4, n4 = (tid & 15) * 4, nn = tid >> 3, ck = tid & 7;
    int t = t_begin + first;
    if (t >= t_end) return;
    TileDesc d = weight_tile(P, l, t);
    f32x4 v0 = __builtin_nontemporal_load((const f32x4*)(d.src + (size_t)(d.k0 + kk0) * d.lds_ + d.n0 + n4)), v1 = __builtin_nontemporal_load((const f32x4*)(d.src + (size_t)(d.k0 + kk0 + 32) * d.lds_ + d.n0 + n4));
    for (;;) {
        __syncthreads();
#pragma unroll
        for (int e = 0; e < 4; ++e) { sm[(n4 + e) * 72 + kk0] = f2bf(v0[e]); sm[(n4 + e) * 72 + kk0 + 32] = f2bf(v1[e]); }
        __syncthreads();
        const TileDesc cur = d; const int tn = t + stride; const bool more = tn < t_end;
        if (more) { d = weight_tile(P, l, tn); v0 = __builtin_nontemporal_load((const f32x4*)(d.src + (size_t)(d.k0 + kk0) * d.lds_ + d.n0 + n4)); v1 = __builtin_nontemporal_load((const f32x4*)(d.src + (size_t)(d.k0 + kk0 + 32) * d.lds_ + d.n0 + n4)); }
        const u32x4 o = *(const LAS u32x4*)(sm + nn * 72 + ck * 8);
        const int nrow = cur.perm ? swap45(cur.n0 + nn) : ((cur.nd >= 0 ? cur.nd : cur.n0) + nn);
        *(u32x4*)(cur.dst + (size_t)nrow * cur.ldd + cur.k0 + ck * 8) = o;
        if (!more) break;
        t = tn;
    }
    __syncthreads();
}

__device__ __forceinline__ void convert_weights(const Params& P, int l, LAS unsigned char* lds, int t_begin, int t_end, int first, int stride) {
    convert_weights_(P.w_in, P.w_branch, P.lru_wa, P.lru_wx, P.pool_w, P.w_out, P.ffn_up, P.ffn_down, P.ws, l, lds, t_begin, t_end, first, stride);
}

__device__ void phase0(const Params& P, LAS unsigned char* lds) {
    const int tid = otid(), G = gridDim.x, c = blockIdx.x;
    { bf16_t* ck = (bf16_t*)(P.ws + OFF_CK); bf16_t* cv = (bf16_t*)(P.ws + OFF_CV);
      for (int i = c * 512 + tid; i < 2 * 2 * 512 * 64; i += G * 512) {
          const int e4 = (i & 63) * 4, t = (i >> 6) & 511, b = (i >> 15) & 1, l = i >> 16;
          const size_t si = ((size_t)((b * 2 + l) * 512 + t)) * 256 + e4, di = ((size_t)((l * 2 + b) * 512 + t)) * 256 + e4;
          const f32x4 kv = __builtin_nontemporal_load((const f32x4*)(P.cache_k + si)), vv = __builtin_nontemporal_load((const f32x4*)(P.cache_v + si));
          uint2 pk, pv; pk.x = pack2(kv[0], kv[1]); pk.y = pack2(kv[2], kv[3]); pv.x = pack2(vv[0], vv[1]); pv.y = pack2(vv[2], vv[3]);
          *(uint2*)(ck + di) = pk; *(uint2*)(cv + di) = pv; } }
    { float* rc = (float*)(P.ws + OFF_ROPE); float* rs = rc + 2048;
      for (int i = c * 512 + tid; i < 2048; i += G * 512) {
          const int pos = i >> 5, k = i & 31; const float fr = powf(10000.0f, -(float)k / 32.0f); const float ang = (float)pos * fr;
          rc[i] = cosf(ang); rs[i] = sinf(ang); } }
    { LAS float* sv = (LAS float*)lds;
      LAS float* red = sv + 3072;
      __syncthreads();
      for (int i = tid; i < 3072; i += 512) { const int s = i >> 10, k = i & 1023; const float x = s == 0 ? P.c_ctx[k] : P.c[(s - 1) * 1024 + k]; sv[i] = x / (1.0f + expf(-x)); }
      __syncthreads();
      float* mod = (float*)(P.ws + OFF_MOD);
      for (int it = c; it < 384; it += G) {
          const int l = it / 192, cg_ = it % 192, cl = tid & 31, kg = tid >> 5, col = cg_ * 32 + cl;
          const float* w = P.w_ada + (size_t)l * 1024 * 6144 + col;
          float a0 = 0.f, a1 = 0.f, a2 = 0.f;
#pragma unroll 16
          for (int k = kg * 64; k < kg * 64 + 64; ++k) { const float wv = __builtin_nontemporal_load(w + (size_t)k * 6144); a0 += sv[k] * wv; a1 += sv[1024 + k] * wv; a2 += sv[2048 + k] * wv; }
          red[(kg * 3 + 0) * 32 + cl] = a0; red[(kg * 3 + 1) * 32 + cl] = a1; red[(kg * 3 + 2) * 32 + cl] = a2;
          __syncthreads();
          if (tid < 96) { const int s = tid >> 5, cc = tid & 31; float sum = 0.f;
#pragma unroll
              for (int g = 0; g < 16; ++g) sum += red[(g * 3 + s) * 32 + cc];
              mod[(size_t)(l * 3 + s) * 6144 + cg_ * 32 + cc] = sum + P.b_ada[l * 6144 + cg_ * 32 + cc]; }
          __syncthreads();
      } }
}

template <bool FINAL>
__device__ __forceinline__ void norm_rows(float* X, const float* xa, const float* xb, const float* __restrict__ gw, const float* __restrict__ mod, int shift_off, int scale_off, bf16_t* __restrict__ H) {
    const int tid = otid(); const int lane = tid & 63, wv = blockIdx.x * 8 + (tid >> 6), nw = gridDim.x * 8;
    constexpr int R = 3;
    for (int row0 = wv; row0 < MROWS; row0 += R * nw) {
        f32x4 v[R][4];
#pragma unroll
        for (int r = 0; r < R; ++r) { const int row = row0 + r * nw;
#pragma unroll
            for (int i = 0; i < 4; ++i) v[r][i] = row < MROWS ? *(const f32x4*)((row < MCTX ? xa + (size_t)row * 1024 : xb + (size_t)(row - MCTX) * 1024) + i * 256 + lane * 4) : (f32x4){0.f, 0.f, 0.f, 0.f}; }
#pragma unroll
        for (int r = 0; r < R; ++r) { const int row = row0 + r * nw; if (row >= MROWS) continue;
            float ss = 0.f;
#pragma unroll
            for (int i = 0; i < 4; ++i) ss += v[r][i][0] * v[r][i][0] + v[r][i][1] * v[r][i][1] + v[r][i][2] * v[r][i][2] + v[r][i][3] * v[r][i][3];
#pragma unroll
            for (int o = 32; o >= 1; o >>= 1) ss += __shfl_xor(ss, o);
            const float rstd = rsqrtf(ss * (1.0f / 1024.0f) + 1e-6f);
            const float* md = mod + seq_group(row) * 6144;
#pragma unroll
            for (int i = 0; i < 4; ++i) { const int col = i * 256 + lane * 4;
                const f32x4 g = *(const f32x4*)(gw + col);
                if (FINAL) { f32x4 h;
#pragma unroll
                    for (int e = 0; e < 4; ++e) h[e] = v[r][i][e] * rstd * g[e];
                    *(f32x4*)(X + (size_t)row * 1024 + col) = h; }
                else { const f32x4 sc = *(const f32x4*)(md + scale_off + col), sh = *(const f32x4*)(md + shift_off + col);
                    f32x4 h;
#pragma unroll
                    for (int e = 0; e < 4; ++e) h[e] = v[r][i][e] * rstd * g[e] * (1.0f + sc[e]) + sh[e];
                    uint2 pk; pk.x = pack2(h[0], h[1]); pk.y = pack2(h[2], h[3]);
                    *(uint2*)(H + (size_t)row * 1024 + col) = pk; } }
        }
    }
}
__device__ void norm_phase(const float* xa, const float* xb, const float* __restrict__ gw, const float* __restrict__ mod, int shift_off, int scale_off, bf16_t* __restrict__ H) { norm_rows<false>(nullptr, xa, xb, gw, mod, shift_off, scale_off, H); }
__device__ void final_norm_phase(float* X, const float* __restrict__ gw) { norm_rows<true>(X, X, X + (size_t)MCTX * 1024, gw, nullptr, 0, 0, nullptr); }

template <int HALF>
__device__ __forceinline__ void pool_item(const bf16_t* __restrict__ XC, bf16_t* __restrict__ PL, int it) {
    constexpr int G_ = HALF == 1 ? 0 : (HALF == 2 ? 1 : (HALF == 4 ? 2 : 3));
    const int rs = (it >> 5) * 8, ch = G_ * 256 + (it & 31) * 8;
    const int T = rs < MCTX ? 256 : 2048, row0 = rs < MCTX ? (rs & ~255) : MCTX + ((rs - MCTX) & ~2047), tl0 = rs - row0;
    const bf16_t* base = XC + (size_t)row0 * 1024 + ch;
    constexpr int R = 8 + 2 * HALF;
    bf16x8 xr[R];
#pragma unroll
    for (int i = 0; i < R; ++i) { const int t = tl0 - HALF + i; xr[i] = (bf16x8){0, 0, 0, 0, 0, 0, 0, 0}; if (t >= 0 && t < T) xr[i] = *(const bf16x8*)(base + (size_t)t * 1024); }
    float s[8];
#pragma unroll
    for (int e = 0; e < 8; ++e) { s[e] = 0.f;
#pragma unroll
        for (int i = 0; i < 2 * HALF; ++i) s[e] += bf2f((unsigned short)xr[i][e]); }
#pragma unroll
    for (int j = 0; j < 8; ++j) {
        const int t = tl0 + j;
        const float inv = 1.0f / (float)(min(t + HALF, T) - max(t - HALF, 0));
        float r[8];
#pragma unroll
        for (int e = 0; e < 8; ++e) r[e] = s[e] * inv - bf2f((unsigned short)xr[j + HALF][e]);
        u32x4 o; o.x = pack2(r[0], r[1]); o.y = pack2(r[2], r[3]); o.z = pack2(r[4], r[5]); o.w = pack2(r[6], r[7]);
        *(u32x4*)(PL + (size_t)(row0 + t) * 1024 + ch) = o;
#pragma unroll
        for (int e = 0; e < 8; ++e) s[e] += bf2f((unsigned short)xr[j + 2 * HALF][e]) - bf2f((unsigned short)xr[j][e]);
    }
}
__device__ void pool_phase(const bf16_t* __restrict__ XC, bf16_t* __restrict__ PL) {
    const int tid = otid();
    constexpr int PER_G = (MROWS / 8) * 32;
    for (int idx = blockIdx.x * 512 + tid; idx < 4 * PER_G; idx += gridDim.x * 512) {
        const int g = idx / PER_G, it = idx % PER_G;
        if (g == 0) pool_item<1>(XC, PL, it); else if (g == 1) pool_item<2>(XC, PL, it); else if (g == 2) pool_item<4>(XC, PL, it); else pool_item<8>(XC, PL, it);
    }
}
__device__ void ffn_fix_groups(const bf16_t* __restrict__ SU, const bf16_t* __restrict__ SV, bf16_t* __restrict__ ACT, const float* __restrict__ cw, const float* __restrict__ cb, int g0, int ng) {
    const int tid = otid();
    for (int idx = tid; idx < ng * 2 * 352; idx += 512) {
        const int br = idx / 352, ch = (idx % 352) * 8;
        const int g = g0 + (br >> 1), last = br & 1;
        const int row = g * 64 + (last ? 63 : 0);
        const int T = row < MCTX ? 256 : 2048, row0 = row < MCTX ? (row & ~255) : MCTX + ((row - MCTX) & ~2047), tl = row - row0;
        const bf16x8 zero = (bf16x8){0, 0, 0, 0, 0, 0, 0, 0};
        bf16x8 um, u0, un;
        if (last) { um = *(const bf16x8*)(SU + ((size_t)g * 4 + 2) * 2816 + ch); u0 = *(const bf16x8*)(SU + ((size_t)g * 4 + 3) * 2816 + ch);
                    un = tl < T - 1 ? *(const bf16x8*)(SU + ((size_t)(g + 1) * 4 + 0) * 2816 + ch) : zero; }
        else { um = tl > 0 ? *(const bf16x8*)(SU + ((size_t)(g - 1) * 4 + 3) * 2816 + ch) : zero; u0 = *(const bf16x8*)(SU + ((size_t)g * 4 + 0) * 2816 + ch);
               un = *(const bf16x8*)(SU + ((size_t)g * 4 + 1) * 2816 + ch); }
        const bf16x8 vv = *(const bf16x8*)(SV + ((size_t)g * 2 + last) * 2816 + ch);
        float r[8];
#pragma unroll
        for (int e = 0; e < 8; ++e) { const float gff = cw[ch + e] * bf2f((unsigned short)um[e]) + cw[2816 + ch + e] * bf2f((unsigned short)u0[e]) + cw[5632 + ch + e] * bf2f((unsigned short)un[e]) + cb[ch + e];
            r[e] = gelu_tanh(gff) * bf2f((unsigned short)vv[e]); }
        u32x4 o; o.x = pack2(r[0], r[1]); o.y = pack2(r[2], r[3]); o.z = pack2(r[4], r[5]); o.w = pack2(r[6], r[7]);
        *(u32x4*)(ACT + (size_t)row * 2816 + ch) = o;
    }
}

__device__ __forceinline__ void rope8(bf16x8& x1, bf16x8& x2, const float* __restrict__ cs, const float* __restrict__ sn) {
#pragma unroll
    for (int e = 0; e < 8; ++e) { const float a = bf2f((unsigned short)x1[e]), b = bf2f((unsigned short)x2[e]); const float c = cs[e], s = sn[e];
        x1[e] = (short)f2bf(a * c - b * s); x2[e] = (short)f2bf(a * s + b * c); }
}
constexpr int VT_OFF = 64 * 272;
constexpr int ABUF = 64 * 272 + 64 * 288;
__device__ void attn_unit(const Params& P, int l, int u, LAS unsigned char* lds) {
    int tid_ = threadIdx.x; asm volatile("" : "+v"(tid_));
    const int tid = tid_, w = tid >> 6, lane = tid & 63, fr = lane & 15, fq = lane >> 4;
    const bf16_t* Q = (const bf16_t*)(P.ws + OFF_XAQ) + (size_t)MROWS * 1024;
    const bf16_t* KB = (const bf16_t*)(P.ws + OFF_KB); const bf16_t* VB = (const bf16_t*)(P.ws + OFF_VB);
    const bf16_t* CK = (const bf16_t*)(P.ws + OFF_CK); const bf16_t* CV = (const bf16_t*)(P.ws + OFF_CV);
    bf16_t* YB = (bf16_t*)(P.ws + OFF_YB);
    bool lat; int head, row0, T, qstart, bidx;
    if (u < 256) { lat = true; bidx = u >> 7; const int rem = u & 127; head = rem >> 4; qstart = (rem & 15) * 128; T = 2048; row0 = MCTX + bidx * 2048; }
    else { const int v = u - 256; lat = false; bidx = 0;
           const int r = v >> 6, g = v & 63; const int seq = g >> 1; head = (g & 1) * 4 + (r >> 1); qstart = (r & 1) * 128; T = 256; row0 = seq * 256; }
    const int kvh = head >> 2;
    const int qpos = qstart + w * 16 + fr;
    bf16x8 qf[4];
    { const bf16_t* qp = Q + (size_t)(row0 + qpos) * 1024 + head * 128 + fq * 8;
#pragma unroll
      for (int kk = 0; kk < 4; ++kk) qf[kk] = *(const bf16x8*)(qp + kk * 32); }
    float m_run = P.attn_sink[l * 8 + head] * 1.4426950408889634f; float l_run = (fq == 0) ? 1.0f : 0.0f;
    f32x4 o[8];
#pragma unroll
    for (int dt = 0; dt < 8; ++dt) o[dt] = (f32x4){0.f, 0.f, 0.f, 0.f};
    int wlo = 0, nwt = 4;
    if (lat) { wlo = max(0, qstart - 128); const int whi = min(T, qstart + 256); nwt = (whi - wlo) >> 6; }
    const int ntiles = nwt + (lat ? 8 : 0);
    const float scale = 0.08838834764831845f * 1.4426950408889634f;
    const int lkey = tid >> 3, lp = tid & 7;
    bf16x8 rk[2][2], rv[2][2];
    auto tile_load = [&](int ti, bf16x8 (&k_)[2], bf16x8 (&v_)[2]) {
        const bf16_t* ksrc; const bf16_t* vsrc;
        if (ti < nwt) { const int k0 = wlo + ti * 64; ksrc = KB + (size_t)(row0 + k0) * 256 + kvh * 128; vsrc = VB + (size_t)(row0 + k0) * 256 + kvh * 128; }
        else { const int k0 = (ti - nwt) * 64; const size_t o_ = ((size_t)((l * 2 + bidx) * 512 + k0)) * 256 + kvh * 128; ksrc = CK + o_; vsrc = CV + o_; }
        const bf16_t* kr = ksrc + (size_t)lkey * 256; k_[0] = *(const bf16x8*)(kr + lp * 8); k_[1] = *(const bf16x8*)(kr + (lp + 8) * 8);
        const bf16_t* vr = vsrc + (size_t)lkey * 256; v_[0] = *(const bf16x8*)(vr + lp * 8); v_[1] = *(const bf16x8*)(vr + (lp + 8) * 8); };
    const int krow = (lkey & 32) | ((lkey & 4) << 2) | ((lkey & 24) >> 1) | (lkey & 3);
    auto tile_store = [&](int b, const bf16x8 (&k_)[2], const bf16x8 (&v_)[2]) {
        LAS unsigned char* kb_ = lds + b * ABUF; LAS unsigned char* vb_ = kb_ + VT_OFF;
        *(LAS bf16x8*)(kb_ + krow * 272 + lp * 16) = k_[0]; *(LAS bf16x8*)(kb_ + krow * 272 + (lp + 8) * 16) = k_[1];
        *(LAS bf16x8*)(vb_ + lkey * 288 + lp * 16) = v_[0]; *(LAS bf16x8*)(vb_ + lkey * 288 + (lp + 8) * 16) = v_[1]; };
    tile_load(0, rk[0], rv[0]);
    tile_load(1, rk[1], rv[1]);
    __syncthreads();
    tile_store(0, rk[0], rv[0]);
    tile_load(2, rk[0], rv[0]);
#pragma unroll 2
    for (int ti = 0; ti < ntiles; ++ti) {
        const bool win = ti < nwt; const int k0 = win ? wlo + ti * 64 : (ti - nwt) * 64;
        __syncthreads();
        if ((ti & 1) == 0) { if (ti + 1 < ntiles) tile_store(1, rk[1], rv[1]); if (ti + 3 < ntiles) tile_load(ti + 3, rk[1], rv[1]); }
        else { if (ti + 1 < ntiles) tile_store(0, rk[0], rv[0]); if (ti + 3 < ntiles) tile_load(ti + 3, rk[0], rv[0]); }
        LAS unsigned char* kb_ = lds + (ti & 1) * ABUF; LAS unsigned char* vb_ = kb_ + VT_OFF;
        f32x4 s[4];
#pragma unroll
        for (int nt = 0; nt < 4; ++nt) { s[nt] = (f32x4){0.f, 0.f, 0.f, 0.f};
#pragma unroll
            for (int kk = 0; kk < 4; ++kk) { const bf16x8 a = *(const LAS bf16x8*)(kb_ + (nt * 16 + fr) * 272 + kk * 64 + fq * 16); s[nt] = __builtin_amdgcn_mfma_f32_16x16x32_bf16(a, qf[kk], s[nt], 0, 0, 0); } }
        float mt = -3.0e38f;
#pragma unroll
        for (int nt = 0; nt < 4; ++nt)
#pragma unroll
            for (int j = 0; j < 4; ++j) { float v = s[nt][j] * scale;
                if (lat && win) { const int kp = k0 + 32 * (nt >> 1) + 8 * fq + 4 * (nt & 1) + j; const int dd = qpos - kp; if (dd > 128 || dd < -128) v = -1.0e30f; }
                s[nt][j] = v; mt = fmaxf(mt, v); }
        mt = fmaxf(mt, __shfl_xor(mt, 16)); mt = fmaxf(mt, __shfl_xor(mt, 32));
        const float mn = fmaxf(m_run, mt); const float alpha = __builtin_amdgcn_exp2f(m_run - mn); m_run = mn;
        float ps = 0.f;
#pragma unroll
        for (int nt = 0; nt < 4; ++nt)
#pragma unroll
            for (int j = 0; j < 4; ++j) { const float p = __builtin_amdgcn_exp2f(s[nt][j] - mn); ps += p; s[nt][j] = p; }
        l_run = l_run * alpha + ps;
#pragma unroll
        for (int dt = 0; dt < 8; ++dt) o[dt] = o[dt] * alpha;
#pragma unroll
        for (int s2 = 0; s2 < 2; ++s2) {
            u32x4 pu; pu[0] = pack2(s[2 * s2][0], s[2 * s2][1]); pu[1] = pack2(s[2 * s2][2], s[2 * s2][3]); pu[2] = pack2(s[2 * s2 + 1][0], s[2 * s2 + 1][1]); pu[3] = pack2(s[2 * s2 + 1][2], s[2 * s2 + 1][3]);
            const bf16x8 pf = __builtin_bit_cast(bf16x8, pu);
#pragma unroll
            for (int dt = 0; dt < 8; ++dt) {
                const bf16x4 lo = __builtin_amdgcn_ds_read_tr16_b64_v4i16((LAS bf16x4*)(vb_ + (s2 * 32 + fq * 8 + (fr >> 2)) * 288 + (dt * 16 + (fr & 3) * 4) * 2));
                const bf16x4 hi = __builtin_amdgcn_ds_read_tr16_b64_v4i16((LAS bf16x4*)(vb_ + (s2 * 32 + fq * 8 + 4 + (fr >> 2)) * 288 + (dt * 16 + (fr & 3) * 4) * 2));
                const bf16x8 af = __builtin_shufflevector(lo, hi, 0, 1, 2, 3, 4, 5, 6, 7);
                o[dt] = __builtin_amdgcn_mfma_f32_16x16x32_bf16(af, pf, o[dt], 0, 0, 0);
            }
        }
    }
    float lt = l_run; lt += __shfl_xor(lt, 16); lt += __shfl_xor(lt, 32);
    const float inv = 1.0f / lt;
    bf16_t* yp = YB + (size_t)(row0 + qpos) * 1024 + head * 128 + fq * 4;
#pragma unroll
    for (int dt = 0; dt < 8; ++dt) { uint2 pk; pk.x = pack2(o[dt][0] * inv, o[dt][1] * inv); pk.y = pack2(o[dt][2] * inv, o[dt][3] * inv); *(uint2*)(yp + dt * 16) = pk; }
}

constexpr int YT_OFF = 256 * 272;
template <int MODE, int D, int NSC>
__device__ __forceinline__ void lru_dir(const Params& P, int l, int s, int cchunk, int h, LAS unsigned char* lds, int w, int fr, int fq) {
    const bool lat = s >= 32; const int row0 = lat ? MCTX + (s - 32) * 2048 : s * 256; const int t0 = cchunk * (NSC * 64);
    constexpr int NCH = 2048 / (NSC * 64);
    const bf16_t* GW = (const bf16_t*)(P.ws + OFF_GW);
    bf16_t* YA = (bf16_t*)(P.ws + OFF_YA);
    float* SUMM = (float*)(P.ws + OFF_SUMM);
    const int chl = 16 * w + fr, ch = h * 128 + chl;
    bf16x8 bwa[4], bwx[4];
    { const bf16_t* gp = GW + ((size_t)(D * 8 + h) * 256 + chl) * 128 + fq * 8;
#pragma unroll
      for (int kk = 0; kk < 4; ++kk) { bwa[kk] = *(const bf16x8*)(gp + kk * 32); bwx[kk] = *(const bf16x8*)(gp + 128 * 128 + kk * 32); } }
    const int pidx = (l * 2 + D) * 1024 + ch;
    const float ba = P.lru_ba[pidx], bx = P.lru_bx[pidx];
    const float lam = P.lru_lambda[pidx];
    const float c8 = -8.0f * log1pf(expf(-lam));
    float carry = 0.f;
    if (MODE == 0 && lat) {
        const int b = s - 32;
        carry = P.state_lru[((size_t)(b * 2 + l) * 2 + D) * 1024 + ch];
        if (D == 0) { for (int cc = 0; cc < cchunk; ++cc) { const float* sp = SUMM + ((size_t)((b * 2 + 0) * 16 + cc) * 1024 + ch) * 2; carry = sp[1] + sp[0] * carry; } }
        else { for (int cc = NCH - 1; cc > cchunk; --cc) { const float* sp = SUMM + ((size_t)((b * 2 + 1) * 16 + cc) * 1024 + ch) * 2; carry = sp[1] + sp[0] * carry; } }
    }
    float ptot = 1.0f;
#pragma unroll 1
    for (int sci = 0; sci < NSC; ++sci) {
        const int sc = D == 0 ? sci : NSC - 1 - sci;
        f32x4 r[4], g[4];
#pragma unroll
        for (int m = 0; m < 4; ++m) { r[m] = (f32x4){0.f, 0.f, 0.f, 0.f}; g[m] = (f32x4){0.f, 0.f, 0.f, 0.f};
#pragma unroll
            for (int kk = 0; kk < 4; ++kk) { const bf16x8 a = *(const LAS bf16x8*)(lds + (sc * 64 + m * 16 + fr) * 272 + kk * 64 + fq * 16);
                r[m] = __builtin_amdgcn_mfma_f32_16x16x32_bf16(a, bwa[kk], r[m], 0, 0, 0); g[m] = __builtin_amdgcn_mfma_f32_16x16x32_bf16(a, bwx[kk], g[m], 0, 0, 0); } }
#pragma unroll
        for (int mi = 0; mi < 4; ++mi) {
            const int m = D == 0 ? mi : 3 - mi;
            float av[4], bv[4];
#pragma unroll
            for (int j = 0; j < 4; ++j) {
                const float ea = 1.0f + __expf(-(r[m][j] + ba)), eb = 1.0f + __expf(-(g[m][j] + bx));
                const float inv = __builtin_amdgcn_rcpf(ea * eb);
                const float rr = inv * eb, ii = inv * ea;
                const float la = c8 * rr; const float a = __expf(la); const float z = 2.0f * la;
                const float em = (z > -0.05f) ? -z * (1.0f + z * (0.5f + z * (0.16666667f + z * 0.041666667f))) : 1.0f - a * a;
                const float x = bf2f(*(const LAS bf16_t*)(lds + (sc * 64 + m * 16 + fq * 4 + j) * 272 + chl * 2));
                av[j] = a; bv[j] = __builtin_amdgcn_sqrtf(em) * ii * x;
            }
            float p4, h4;
            p4 = av[0] * av[1] * av[2] * av[3];
            if (D == 0) h4 = ((bv[0] * av[1] + bv[1]) * av[2] + bv[2]) * av[3] + bv[3];
            else h4 = ((bv[3] * av[2] + bv[2]) * av[1] + bv[1]) * av[0] + bv[0];
            float pq[4], hq[4];
#pragma unroll
            for (int f = 0; f < 4; ++f) { pq[f] = __shfl(p4, fr + 16 * f); hq[f] = __shfl(h4, fr + 16 * f); }
            float cin = carry, mycin = 0.f;
#pragma unroll
            for (int fi = 0; fi < 4; ++fi) { const int f = D == 0 ? fi : 3 - fi; if (f == fq) mycin = cin; cin = hq[f] + pq[f] * cin; }
            carry = cin;
            if (MODE == 1) ptot *= pq[0] * pq[1] * pq[2] * pq[3];
            if (MODE == 0) {
                float hh = mycin; float y[4];
#pragma unroll
                for (int ji = 0; ji < 4; ++ji) { const int j = D == 0 ? ji : 3 - ji; hh = av[j] * hh + bv[j]; y[j] = hh; }
#pragma unroll
                for (int j = 0; j < 4; ++j) {
                    LAS bf16_t* yp = (LAS bf16_t*)(lds + YT_OFF + (sc * 64 + m * 16 + fq * 4 + j) * 272 + chl * 2);
                    if (D == 0) *yp = f2bf(y[j]);
                    else *yp = f2bf(bf2f(*yp) + y[j]);
                }
            }
        }
    }
    if (MODE == 0 && !lat && fq == 0) P.out[OUT_H + ((size_t)(s * 2 + l) * 2 + D) * 1024 + ch] = carry;
    if (MODE == 1 && fq == 0) { float* sp = SUMM + ((size_t)(((s - 32) * 2 + D) * 16 + cchunk) * 1024 + ch) * 2; sp[0] = ptot; sp[1] = carry; }
}
template <int MODE, int NSC>
__device__ void lru_unit(const Params& P, int l, int s, int cchunk, int h, LAS unsigned char* lds) {
    int tid_ = threadIdx.x; asm volatile("" : "+v"(tid_));
    const int tid = tid_, w = tid >> 6, lane = tid & 63, fr = lane & 15, fq = lane >> 4;
    const bool lat = s >= 32; const int T = lat ? 2048 : 256; const int row0 = lat ? MCTX + (s - 32) * 2048 : s * 256; const int t0 = cchunk * (NSC * 64);
    const bf16_t* XA = (const bf16_t*)(P.ws + OFF_XAQ);
    constexpr int RUN = NSC * 2;
    {
        const int ck = tid & 15, ch = h * 128 + ck * 8, tr = (tid >> 4) * RUN;
        const float* cw = P.lru_conv + (size_t)l * 4096 + ch; const float* cb = P.lru_conv_b + l * 1024 + ch;
        bf16x8 xr[RUN + 3];
#pragma unroll
        for (int i = 0; i < RUN + 3; ++i) { const int tt = t0 + tr + i - 2; xr[i] = (bf16x8){0, 0, 0, 0, 0, 0, 0, 0};
            if (tt >= 0 && tt < T) xr[i] = *(const bf16x8*)(XA + (size_t)(row0 + tt) * 1024 + ch); }
        float wk[4][8], bk[8];
#pragma unroll
        for (int e = 0; e < 8; ++e) { bk[e] = cb[e];
#pragma unroll
            for (int k = 0; k < 4; ++k) wk[k][e] = cw[k * 1024 + e]; }
        __syncthreads();
#pragma unroll
        for (int i = 0; i < RUN; ++i) {
            float a8[8];
#pragma unroll
            for (int e = 0; e < 8; ++e) { a8[e] = bk[e];
#pragma unroll
                for (int k = 0; k < 4; ++k) a8[e] += wk[k][e] * bf2f((unsigned short)xr[i + k][e]); }
            u32x4 o; o.x = pack2(a8[0], a8[1]); o.y = pack2(a8[2], a8[3]); o.z = pack2(a8[4], a8[5]); o.w = pack2(a8[6], a8[7]);
            *(LAS u32x4*)(lds + (tr + i) * 272 + ck * 16) = o;
        }
    }
    __syncthreads();
    lru_dir<MODE, 0, NSC>(P, l, s, cchunk, h, lds, w, fr, fq);
    lru_dir<MODE, 1, NSC>(P, l, s, cchunk, h, lds, w, fr, fq);
    if (MODE == 0) {
        bf16_t* YA = (bf16_t*)(P.ws + OFF_YA);
        __syncthreads();
#pragma unroll
        for (int it = 0; it < 2 * NSC; ++it) { const int t = (tid >> 4) + it * 32, ck = tid & 15;
            const u32x4 v = *(const LAS u32x4*)(lds + YT_OFF + t * 272 + ck * 16);
            *(u32x4*)(YA + (size_t)(row0 + t0 + t) * 1024 + h * 128 + ck * 8) = v; }
    }
}

#define XB_TMO      128
#define XB_XCNT(j)  (256  + 64 * (j))
#define XB_XSUB(j)  (1280 + 64 * (j))
#define XB_XGEN(j)  (2304 + 64 * (j))
#define XB_TOP      3328
#define XB_TOPGEN   3392
#define XCD_BAR_WORDS 3456
#define XB_SPIN_CAP (1u << 18)
__device__ __forceinline__ unsigned xb_ld(unsigned* p)              { return __hip_atomic_load(p, __ATOMIC_RELAXED, __HIP_MEMORY_SCOPE_AGENT); }
__device__ __forceinline__ unsigned xb_add(unsigned* p, unsigned v) { return __hip_atomic_fetch_add(p, v, __ATOMIC_RELAXED, __HIP_MEMORY_SCOPE_AGENT); }
__device__ __forceinline__ unsigned xb_xcc_id() { return (unsigned)__builtin_amdgcn_s_getreg((3 << 11) | 20) & 0xFu; }
#define XB_SPIN(cond, bar) do { unsigned _sp = 0; while (cond) { __builtin_amdgcn_s_sleep(1); \
    if ((++_sp & 255u) == 0u) { if (xb_ld(&(bar)[XB_TMO])) break; if (_sp > XB_SPIN_CAP) { atomicAdd(&(bar)[XB_TMO], 1u); break; } } } } while (0)
struct XcdBarrier { unsigned* bar; unsigned x; volatile LAS unsigned* st; };
__device__ __forceinline__ XcdBarrier xcd_barrier_post(unsigned* bar, volatile LAS unsigned* st) {
    XcdBarrier b; b.bar = bar; b.x = xb_xcc_id(); b.st = st;
    if (threadIdx.x == 0) (void)xb_add(&bar[XB_XCNT(b.x)], 1u);
    return b;
}
__device__ __forceinline__ void xcd_barrier_complete(unsigned* bar, unsigned x, unsigned& nloc, unsigned& nx) {
    const unsigned G = gridDim.x * gridDim.y * gridDim.z;
    unsigned sum, cnt, mine, sp = 0u;
    for (;;) {
        sum = 0u; cnt = 0u; mine = 0u;
#pragma unroll
        for (unsigned j = 0; j < 16; ++j) { const unsigned c = xb_ld(&bar[XB_XCNT(j)]); sum += c; cnt += (c > 0u) ? 1u : 0u; mine = (j == x) ? c : mine; }
        if (sum == G) break;
        __builtin_amdgcn_s_sleep(1);
        if ((++sp & 255u) == 0u) { if (xb_ld(&bar[XB_TMO])) break; if (sp > XB_SPIN_CAP) { atomicAdd(&bar[XB_TMO], 1u); break; } }
    }
    nloc = mine > 0u ? mine : 1u; nx = cnt > 0u ? cnt : 1u;
}
__device__ __noinline__ void xcd_barrier_(unsigned* bbar, unsigned bx, volatile LAS unsigned* bst) {
    XcdBarrier b; b.bar = bbar; b.x = bx; b.st = bst;
    asm volatile("s_waitcnt vmcnt(0)" ::: "memory");
    __syncthreads();
    if (threadIdx.x == 0) {
        unsigned* bar = b.bar;
        __builtin_amdgcn_s_waitcnt(0);
        unsigned nloc = b.st[0], nx = b.st[1];
        if (nloc == 0u) { xcd_barrier_complete(bar, b.x, nloc, nx); b.st[0] = nloc; b.st[1] = nx; }
        const unsigned old = xb_add(&bar[XB_XSUB(b.x)], 1u);
        const unsigned gen = old / nloc;
        if (old + 1u == (gen + 1u) * nloc) {
            __builtin_amdgcn_fence(__ATOMIC_RELEASE, "agent");
            asm volatile("s_waitcnt vmcnt(0)" ::: "memory");
            const unsigned og = xb_add(&bar[XB_TOP], 1u);
            const unsigned tg = og / nx;
            if (og + 1u == (tg + 1u) * nx) xb_add(&bar[XB_TOPGEN], 1u);
            else XB_SPIN(xb_ld(&bar[XB_TOPGEN]) == tg, bar);
            __builtin_amdgcn_fence(__ATOMIC_ACQUIRE, "agent");
            xb_add(&bar[XB_XGEN(b.x)], 1u);
            asm volatile("s_waitcnt vmcnt(0)" ::: "memory");
        } else {
            XB_SPIN(xb_ld(&bar[XB_XGEN(b.x)]) == gen, bar);
            __builtin_amdgcn_fence(__ATOMIC_ACQUIRE, "agent");
            asm volatile("s_waitcnt vmcnt(0)" ::: "memory");
        }
    }
    __syncthreads();
}

#ifndef REPMASK
#define REPMASK 0
#endif
#define REPLOOP(i) _Pragma("unroll 1") for (int rep_ = 0; rep_ < 1 + ((REPMASK >> (i)) & 1); ++rep_)
__global__ __launch_bounds__(512, 2) void mega(Params P) {
    extern __shared__ __attribute__((aligned(16))) unsigned char shm[];
    LAS unsigned char* lds = (LAS unsigned char*)shm;
    cg::grid_group grid = cg::this_grid();
    if (threadIdx.x == 0) *(LAS u32x4*)(lds + 147456) = (u32x4){0u, 0u, 0u, 0u};
    __syncthreads();
    const XcdBarrier xb = xcd_barrier_post((unsigned*)(P.ws + OFF_BAR), (volatile LAS unsigned*)(lds + 147456));
    const int G = gridDim.x, c = blockIdx.x;
    unsigned char* ws = P.ws;
    float* X = P.out;
    bf16_t* H = (bf16_t*)(ws + OFF_H);
    const float* MOD = (const float*)(ws + OFF_MOD);

    REPLOOP(12) phase0(P, lds);
    if (gridDim.x == 0x7fffffffu) grid.sync();
    REPLOOP(11) xcd_barrier_(xb.bar, xb.x, xb.st);
    for (int l = 0; l < 2; ++l) {
        const float* mod = MOD + (size_t)l * 3 * 6144;
        const bool hide = (G == 256);
        { const int te = hide ? (l == 0 ? 1856 : 0) : 4992; if (te > 0) convert_weights(P, l, lds, 0, te, c, G); }
        const float* xa0 = l == 0 ? P.x_prompt : X; const float* xb0 = l == 0 ? P.x_sample : X + (size_t)MCTX * 1024;
        REPLOOP(1) norm_phase(xa0, xb0, P.norm1 + l * 1024, mod, 0, 1024, H);
        REPLOOP(11) xcd_barrier_(xb.bar, xb.x, xb.st);
        REPLOOP(2) { Sched S{(const char*)H, (const char*)(ws + OFF_WIN), 1024, 1024, 0, 48, 14, G, c, 256};
          EpiIn E{(bf16_t*)(ws + OFF_XAQ), (bf16_t*)(ws + OFF_XC), (bf16_t*)(ws + OFF_KB), (bf16_t*)(ws + OFF_VB), P.out + OUT_K, P.out + OUT_V, (const float*)(ws + OFF_ROPE), l};
          gemm_phase(lds, S, 1024, E); }
        if (hide && l == 0 && c >= 160) convert_weights(P, l, lds, 1856, 2624, c - 160, G - 160);
        REPLOOP(11) xcd_barrier_(xb.bar, xb.x, xb.st);
        REPLOOP(3) pool_phase((const bf16_t*)(ws + OFF_XC), (bf16_t*)(ws + OFF_PL));
        for (int it = c; it < 1280; it += G) {
            if (it < 256) { REPLOOP(4) attn_unit(P, l, it, lds); }
            else if (it < 512) { const int v = it - 256; REPLOOP(5) lru_unit<0, 4>(P, l, v >> 3, 0, v & 7, lds); }
            else if (it < 768) { const int q = it - 512; REPLOOP(5) lru_unit<1, 2>(P, l, 32 + (q >> 7), (q >> 3) & 15, q & 7, lds); }
            else { REPLOOP(7) attn_unit(P, l, it - 768 + 256, lds); }
        }
        REPLOOP(11) xcd_barrier_(xb.bar, xb.x, xb.st);
        { Sched S{(const char*)(ws + OFF_PL), (const char*)(ws + OFF_PW), 1024, 256, 256, 48, 4, G, c, 256};
          EpiPool E{(bf16_t*)(ws + OFF_XC), P.pool_scale + l * 1024};
          gemm_phase(lds, S, 256, E); }
#ifndef NO_LRU
        for (int it = G - 1 - c; it < 256; it += G) lru_unit<0, 2>(P, l, 32 + (it >> 7), (it >> 3) & 15, it & 7, lds);
#endif
        REPLOOP(11) xcd_barrier_(xb.bar, xb.x, xb.st);
        { unsigned* mflags = (unsigned*)(ws + OFF_BAR) + 3500 + l * 192;
          MergeSched S{(const char*)ws, 1024, 1024, c, c >= 192};
          EpiMerge E{(bf16_t*)(ws + OFF_GT), P.b_gate + l * 3072, (float*)(ws + OFF_XAQ), (bf16_t*)(ws + OFF_PL), mflags};
          gemm_phase(lds, S, 1024, E); }
        if (hide && c >= 192) convert_weights(P, l, lds, 2624, 4288, c - 192, G - 192);
        REPLOOP(11) xcd_barrier_(xb.bar, xb.x, xb.st);
        { Sched S{(const char*)(ws + OFF_PL), (const char*)(ws + OFF_WOUT), 1024, 1024, 0, 64, 4, G, c, 192};
          EpiRes E{X, mod, 2048, xa0, xb0};
          gemm_phase<EpiRes, Sched, true>(lds, S, 1024, E); }
        REPLOOP(11) xcd_barrier_(xb.bar, xb.x, xb.st);
        norm_phase(X, X + (size_t)MCTX * 1024, P.norm2 + l * 1024, mod, 3072, 4096, H);
        REPLOOP(11) xcd_barrier_(xb.bar, xb.x, xb.st);
        REPLOOP(9) { Sched S{(const char*)H, (const char*)(ws + OFF_WUP), 1024, 1024, 0, 48, 22, G, c, 256};
          EpiUp E{(bf16_t*)(ws + OFF_ACT), (bf16_t*)(ws + OFF_SU), (bf16_t*)(ws + OFF_SV), P.ffn_conv + (size_t)l * 3 * 2816, P.ffn_conv_b + l * 2816};
          gemm_phase(lds, S, 1024, E); }
        if (hide && c >= 32) { convert_weights(P, l, lds, 4288, 4992, c - 32, G - 32);
          if (l == 0) convert_weights(P, l + 1, lds, 0, 2624, c - 32, G - 32); }
        REPLOOP(11) xcd_barrier_(xb.bar, xb.x, xb.st);
        { Sched S{(const char*)(ws + OFF_ACT), (const char*)(ws + OFF_WDN), 2816, 2816, 0, 64, 4, G, c, 192};
          { Unit uu; for (int i = 0; S.next(i, uu); ++i) ffn_fix_groups((const bf16_t*)(ws + OFF_SU), (const bf16_t*)(ws + OFF_SV), (bf16_t*)(ws + OFF_ACT), P.ffn_conv + (size_t)l * 3 * 2816, P.ffn_conv_b + l * 2816, uu.row0 >> 6, 3);
            asm volatile("s_waitcnt vmcnt(0)" ::: "memory"); __syncthreads(); }
          EpiRes E{X, mod, 5120, X, X + (size_t)MCTX * 1024};
          gemm_phase<EpiRes, Sched, true>(lds, S, 2816, E); }
        REPLOOP(11) xcd_barrier_(xb.bar, xb.x, xb.st);
    }
    final_norm_phase(X, P.final_norm);
}

extern "C" void kernel_launch(void* const* d_in, const int* in_sizes, int n_in, void* d_out, int out_size, void* d_ws, size_t ws_size, hipStream_t stream) {
    constexpr size_t kDynLds = 147456 + 16;
    static int grid_blocks = 0;
    if (!grid_blocks) {
        int dev = 0, cus = 0, per_cu = 0;
        hipGetDevice(&dev);
        hipDeviceGetAttribute(&cus, hipDeviceAttributeMultiprocessorCount, dev);
        hipFuncSetAttribute((const void*)mega, hipFuncAttributeMaxDynamicSharedMemorySize, (int)kDynLds);
        hipOccupancyMaxActiveBlocksPerMultiprocessor(&per_cu, mega, 512, kDynLds);
        if (per_cu < 1) per_cu = 1;
        if (per_cu > 1) per_cu = 1;
        grid_blocks = cus * per_cu;
    }
    Params p{};
    const float** pp = (const float**)&p;
    for (int i = 0; i < 30; ++i) pp[i] = (const float*)d_in[i];
    p.out = (float*)d_out; p.ws = (unsigned char*)d_ws;
    if (ws_size < OFF_END2 + 262144) { fprintf(stderr, "workspace too small: %zu < %zu\n", ws_size, (size_t)OFF_END2 + 262144); }
    hipMemsetAsync((unsigned char*)d_ws + OFF_BAR, 0, 16384, stream);
    void* args[] = {&p};
    hipError_t e = hipLaunchCooperativeKernel((void*)mega, dim3(grid_blocks), dim3(512), args, kDynLds, stream);
    if (e != hipSuccess) fprintf(stderr, "cooperative launch failed: %s (grid %d)\n", hipGetErrorString(e), grid_blocks);
}
```
